# Optimizing an MI355X kernel written in HIP

```python
import math
import jax, jax.numpy as jnp
from jax import lax
import numpy as np

D_MODEL = 2048
BATCH = 8
SEQ = 4096
DEPTH = 4

N_A_LAYERS = DEPTH // 2
N_B_LAYERS = DEPTH - N_A_LAYERS
GDN_HEADS = 16
GDN_DK = 128
GDN_DV = 128
GDN_QK_WIDTH = GDN_HEADS * GDN_DK
GDN_V_WIDTH = GDN_HEADS * GDN_DV
GDN_CONV_CH = 2 * GDN_QK_WIDTH + GDN_V_WIDTH
GDN_PROJ = GDN_CONV_CH + GDN_V_WIDTH + 2 * GDN_HEADS
CONV_WIDTH = 4
CHUNK = 64
GDN_EPS = 1e-6
DIFF_HEADS = 16
DIFF_DK = D_MODEL // DIFF_HEADS // 2
DIFF_DV = 2 * DIFF_DK
DIFF_Q_WIDTH = 2 * DIFF_HEADS * DIFF_DK
DIFF_V_WIDTH = DIFF_HEADS * DIFF_DV
Q_BLOCK = 128
SUBLN_EPS = 1e-5
D_FF = 4 * D_MODEL
ALPHA = (2 * DEPTH) ** 0.25
BETA = (8 * DEPTH) ** -0.25
LN_EPS = 1e-5

kernel_name = "yoco_gdn_diffattn_hybrid"


def layer_norm(x, g, b):
    xf = x.astype(jnp.float32)
    mu = jnp.mean(xf, axis=-1, keepdims=True)
    var = jnp.mean(jnp.square(xf - mu), axis=-1, keepdims=True)
    return ((xf - mu) * lax.rsqrt(var + LN_EPS) * g + b).astype(x.dtype)


def rms_norm(x, w, eps):
    xf = x.astype(jnp.float32)
    return (xf * lax.rsqrt(jnp.mean(jnp.square(xf), axis=-1, keepdims=True) + eps) * w).astype(x.dtype)


def l2_normalize(x):
    xf = x.astype(jnp.float32)
    return xf * lax.rsqrt(jnp.sum(jnp.square(xf), axis=-1, keepdims=True) + GDN_EPS)


def causal_conv_silu(u, w):
    S = u.shape[1]
    K = w.shape[0]
    up = jnp.pad(u, ((0, 0), (K - 1, 0), (0, 0)))
    y = up[:, 0:S] * w[0]
    for j in range(1, K):
        y = y + up[:, j:j + S] * w[j]
    return jax.nn.silu(y)


def gated_delta_rule_chunked(q, k, v, g, beta):
    B, H, S, dk = q.shape
    dv = v.shape[-1]
    N = S // CHUNK
    q = q.reshape(B, H, N, CHUNK, dk)
    k = k.reshape(B, H, N, CHUNK, dk)
    v = v.reshape(B, H, N, CHUNK, dv)
    beta = beta.reshape(B, H, N, CHUNK)
    g = jnp.cumsum(g.reshape(B, H, N, CHUNK), axis=-1)
    causal = jnp.tril(jnp.ones((CHUNK, CHUNK), dtype=bool))
    strict = jnp.tril(jnp.ones((CHUNK, CHUNK), dtype=bool), k=-1)
    decay = jnp.exp(jnp.where(causal, g[..., :, None] - g[..., None, :], -jnp.inf))
    k_beta = k * beta[..., None]
    lower = jnp.where(strict, jnp.einsum('bhnid,bhnjd->bhnij', k_beta, k) * decay, 0.0)
    tri = lower + jnp.eye(CHUNK, dtype=lower.dtype)
    rhs = jnp.concatenate([v * beta[..., None], k_beta * jnp.exp(g)[..., None]], axis=-1)
    sol = lax.linalg.triangular_solve(tri, rhs, left_side=True, lower=True, unit_diagonal=True)
    u, w = sol[..., :dv], sol[..., dv:]
    attn_intra = jnp.einsum('bhnid,bhnjd->bhnij', q, k) * decay

    def step(state, inp):
        q_n, k_n, u_n, w_n, g_n, a_n = inp
        v_new = u_n - jnp.einsum('bhck,bhkv->bhcv', w_n, state)
        o = (jnp.einsum('bhck,bhkv->bhcv', q_n * jnp.exp(g_n)[..., None], state)
             + jnp.einsum('bhij,bhjv->bhiv', a_n, v_new))
        g_last = g_n[..., -1]
        state = (state * jnp.exp(g_last)[..., None, None]
                 + jnp.einsum('bhck,bhcv->bhkv', k_n * jnp.exp(g_last[..., None] - g_n)[..., None], v_new))
        return state, o

    to_front = lambda t: jnp.moveaxis(t, 2, 0)
    xs = (to_front(q), to_front(k), to_front(u), to_front(w), to_front(g), to_front(attn_intra))
    state0 = jnp.zeros((B, H, dk, dv), jnp.float32)
    _, o = lax.scan(step, state0, xs)
    return jnp.moveaxis(o, 0, 2).reshape(B, H, S, dv)


def gated_deltanet(x, w_in, conv_w, a_log, dt_bias, norm_w, w_out):
    B, S, _ = x.shape
    p = x @ w_in
    qkv = causal_conv_silu(p[..., :GDN_CONV_CH], conv_w)
    z = p[..., GDN_CONV_CH:GDN_CONV_CH + GDN_V_WIDTH]
    b = p[..., GDN_CONV_CH + GDN_V_WIDTH:GDN_CONV_CH + GDN_V_WIDTH + GDN_HEADS]
    a = p[..., GDN_CONV_CH + GDN_V_WIDTH + GDN_HEADS:]
    q = l2_normalize(qkv[..., :GDN_QK_WIDTH].reshape(B, S, GDN_HEADS, GDN_DK)) * (GDN_DK ** -0.5)
    k = l2_normalize(qkv[..., GDN_QK_WIDTH:2 * GDN_QK_WIDTH].reshape(B, S, GDN_HEADS, GDN_DK))
    v = qkv[..., 2 * GDN_QK_WIDTH:].reshape(B, S, GDN_HEADS, GDN_DV).astype(jnp.float32)
    beta = jax.nn.sigmoid(b.astype(jnp.float32))
    g = -jnp.exp(a_log.astype(jnp.float32)) * jax.nn.softplus(a.astype(jnp.float32) + dt_bias.astype(jnp.float32))
    tr = lambda t: jnp.swapaxes(t, 1, 2)
    o = gated_delta_rule_chunked(tr(q), tr(k), tr(v), tr(g), tr(beta))
    o = jnp.swapaxes(o, 1, 2).astype(x.dtype)
    o = rms_norm(o, norm_w, GDN_EPS) * jax.nn.silu(z.reshape(B, S, GDN_HEADS, GDN_DV))
    return o.reshape(B, S, GDN_V_WIDTH) @ w_out


def shared_kv(x, w_kv):
    B, S, _ = x.shape
    kv = x @ w_kv
    k = kv[..., :DIFF_Q_WIDTH].reshape(B, S, DIFF_HEADS, 2, DIFF_DK).transpose(0, 2, 3, 1, 4)
    v = kv[..., DIFF_Q_WIDTH:].reshape(B, S, DIFF_HEADS, DIFF_DV).transpose(0, 2, 1, 3)
    return k, v


def diff_attention(x, w_q, lam_params, subln_w, w_o, k_sh, v_sh, lambda_init):
    B, S, _ = x.shape
    nb = S // Q_BLOCK
    q = (x @ w_q).reshape(B, S, DIFF_HEADS, 2, DIFF_DK).transpose(0, 2, 3, 1, 4)
    qb = q.reshape(B, DIFF_HEADS, 2, nb, Q_BLOCK, DIFF_DK).transpose(3, 0, 1, 2, 4, 5)
    lp = lam_params.astype(jnp.float32)
    lam = jnp.exp(jnp.sum(lp[0] * lp[1])) - jnp.exp(jnp.sum(lp[2] * lp[3])) + lambda_init
    k_pos = jnp.arange(S)
    scale = DIFF_DK ** -0.5

    def block(args):
        q_i, i = args
        s = jnp.einsum('bhcqd,bhckd->bhcqk', q_i, k_sh).astype(jnp.float32) * scale
        q_pos = i * Q_BLOCK + jnp.arange(Q_BLOCK)
        s = jnp.where(k_pos[None, :] <= q_pos[:, None], s, -jnp.inf)
        p = jax.nn.softmax(s, axis=-1)
        attn = p[:, :, 0] - lam * p[:, :, 1]
        return jnp.einsum('bhqk,bhkv->bhqv', attn.astype(v_sh.dtype), v_sh)

    o = lax.map(block, (qb, jnp.arange(nb)))
    o = o.transpose(1, 2, 0, 3, 4).reshape(B, DIFF_HEADS, S, DIFF_DV)
    o = rms_norm(o, subln_w, SUBLN_EPS) * (1.0 - lambda_init)
    return o.transpose(0, 2, 1, 3).reshape(B, S, DIFF_V_WIDTH) @ w_o


def sq_relu_mlp(x, w_up, w_down):
    return jnp.square(jax.nn.relu(x @ w_up)) @ w_down


def setup_inputs(seed: int = 0) -> dict:
    key = jax.random.key(seed)
    ks = jax.random.split(key, 16)
    nrm = lambda k, shape, scale: jax.random.normal(k, shape, jnp.float32) * scale
    x = nrm(ks[0], (BATCH, SEQ, D_MODEL), 1.0)
    gdn_w_in = nrm(ks[1], (N_A_LAYERS, D_MODEL, GDN_PROJ), D_MODEL ** -0.5)
    gdn_conv_w = nrm(ks[2], (N_A_LAYERS, CONV_WIDTH, GDN_CONV_CH), CONV_WIDTH ** -0.5)
    gdn_a_log = jnp.log(jax.random.uniform(ks[3], (N_A_LAYERS, GDN_HEADS), jnp.float32, 1.0, 16.0))
    dt = jnp.exp(jax.random.uniform(ks[4], (N_A_LAYERS, GDN_HEADS), jnp.float32, math.log(1e-3), math.log(1e-1)))
    gdn_dt_bias = dt + jnp.log(-jnp.expm1(-dt))
    gdn_norm_w = 1.0 + nrm(ks[5], (N_A_LAYERS, GDN_DV), 0.02)
    gdn_w_out = nrm(ks[6], (N_A_LAYERS, GDN_V_WIDTH, D_MODEL), GDN_V_WIDTH ** -0.5 * BETA)
    diff_w_q = nrm(ks[7], (N_B_LAYERS, D_MODEL, DIFF_Q_WIDTH), D_MODEL ** -0.5)
    diff_lambda = nrm(ks[8], (N_B_LAYERS, 4, DIFF_DK), 0.1)
    diff_subln_w = 1.0 + nrm(ks[9], (N_B_LAYERS, DIFF_DV), 0.02)
    diff_w_o = nrm(ks[10], (N_B_LAYERS, DIFF_V_WIDTH, D_MODEL), DIFF_V_WIDTH ** -0.5 * BETA)
    shared_w_kv = nrm(ks[11], (D_MODEL, DIFF_Q_WIDTH + DIFF_V_WIDTH), D_MODEL ** -0.5)
    mlp_w_up = nrm(ks[12], (DEPTH, D_MODEL, D_FF), D_MODEL ** -0.5)
    mlp_w_down = nrm(ks[13], (DEPTH, D_FF, D_MODEL), D_FF ** -0.5 * BETA)
    ln_g = 1.0 + nrm(ks[14], (DEPTH, 2, D_MODEL), 0.02)
    ln_b = nrm(ks[15], (DEPTH, 2, D_MODEL), 0.02)
    return {"x": x, "gdn_w_in": gdn_w_in, "gdn_conv_w": gdn_conv_w, "gdn_a_log": gdn_a_log,
            "gdn_dt_bias": gdn_dt_bias, "gdn_norm_w": gdn_norm_w, "gdn_w_out": gdn_w_out,
            "diff_w_q": diff_w_q, "diff_lambda": diff_lambda, "diff_subln_w": diff_subln_w,
            "diff_w_o": diff_w_o, "shared_w_kv": shared_w_kv, "mlp_w_up": mlp_w_up,
            "mlp_w_down": mlp_w_down, "ln_g": ln_g, "ln_b": ln_b}


def reference(x, gdn_w_in, gdn_conv_w, gdn_a_log, gdn_dt_bias, gdn_norm_w, gdn_w_out,
              diff_w_q, diff_lambda, diff_subln_w, diff_w_o, shared_w_kv, mlp_w_up,
              mlp_w_down, ln_g, ln_b):
    k_sh = None
    v_sh = None
    for l in range(DEPTH):
        if l < N_A_LAYERS:
            h = gated_deltanet(x, gdn_w_in[l], gdn_conv_w[l], gdn_a_log[l], gdn_dt_bias[l],
                               gdn_norm_w[l], gdn_w_out[l])
        else:
            j = l - N_A_LAYERS
            lambda_init = 0.8 - 0.6 * math.exp(-0.3 * l)
            h = diff_attention(x, diff_w_q[j], diff_lambda[j], diff_subln_w[j], diff_w_o[j],
                               k_sh, v_sh, lambda_init)
        x = layer_norm(ALPHA * x + h, ln_g[l, 0], ln_b[l, 0])
        x = layer_norm(ALPHA * x + sq_relu_mlp(x, mlp_w_up[l], mlp_w_down[l]), ln_g[l, 1], ln_b[l, 1])
        if l == N_A_LAYERS - 1:
            k_sh, v_sh = shared_kv(x, shared_w_kv)
    return x
```

```cpp
#include <hip/hip_runtime.h>
#include <hip/hip_bf16.h>
#include <cstdio>
#include <cstdint>
#include <cmath>

namespace pg8 {
#define PG8_LAS __attribute__((address_space(3)))
typedef unsigned short bf16_t;
typedef short bf16x8 __attribute__((ext_vector_type(8)));
typedef float f32x4 __attribute__((ext_vector_type(4)));
typedef unsigned u32x4 __attribute__((ext_vector_type(4)));
constexpr int BM = 256, BK = 64, HALF = 128, HTB = HALF * BK * 2  , STAGE_BYTES = 8 * HTB, NXCD = 8, WGM = 8;

__host__ __device__ __forceinline__ int lds_byte(int r, int c) { const int st = (r >> 4) * 2 + (c >> 5), rr = r & 15, cc = c & 31, ob = rr * 64 + cc * 2; return st * 1024 + (ob ^ (((ob >> 9) & 1) << 5)); }
__host__ __device__ __forceinline__ void stage_rc(int b, int& R, int& C) { const int st = b / 1024, sb = b % 1024, swz = sb ^ (((sb >> 9) & 1) << 5); R = (st >> 1) * 16 + swz / 64; C = (st & 1) * 32 + (swz % 64) / 2; }
__host__ __device__ __forceinline__ int perm32(int rho) { const int n = rho >> 4, i = rho & 15; return 8 * (i >> 2) + 4 * n + (i & 3); }

struct Unit { int pm, pn; };
struct Gemm { const bf16_t* A; const bf16_t* Bt; int M, N, K, lda; };

struct StaticOrder {
    int nM, nN, nwg, G, c;
    __host__ __device__ void init(int M, int N, int G_, int c_) { nM = M / BM; nN = N / BM; nwg = nM * nN; G = G_; c = c_; }
    __host__ __device__ bool next(int i, Unit& u) const {
        const long L = (long)i * G + c; if (L >= nwg) return false;
        int wgid = (int)L; { const int q = nwg / NXCD, r = nwg % NXCD, xcd = wgid % NXCD, off = wgid / NXCD; wgid = (xcd < r ? xcd * (q + 1) : r * (q + 1) + (xcd - r) * q) + off; }
        const int nig = WGM * nN, gid = wgid / nig, fm = gid * WGM, gsz = (nM - fm) < WGM ? (nM - fm) : WGM;
        u.pm = fm + ((wgid % nig) % gsz); u.pn = (wgid % nig) / gsz; return true;
    }
    __device__ __forceinline__ void a_ready(const Unit&) const {}
    __device__ __forceinline__ void done(const Unit&) const {}
};

__device__ __forceinline__ unsigned cvt_pk_bf16(float lo, float hi) { unsigned r; asm volatile("v_cvt_pk_bf16_f32 %0, %1, %2" : "=v"(r) : "v"(lo), "v"(hi)); return r; }

template <int ACT> struct EpiStore {
    static constexpr bool PERM = true, AFTER_DRAIN = false;
    bf16_t* O; int ldc; int split_cols; size_t split_stride; int scale_tile; float scale0; bf16_t* halo;
    __device__ __forceinline__ void operator()(const f32x4 (&acc)[2][2][4][2], const Unit& u, int wr, int wc, int fr, int fq) const {
        const int row0 = u.pm * BM + wr * 64 + fr; int colt = u.pn * BM; bf16_t* base = O;
        int t = 0; if (split_cols) { t = colt / split_cols; base += (size_t)t * split_stride; colt -= t * split_cols; }
        const float sc = (t == scale_tile) ? scale0 : 1.f;
        const int col0 = colt + wc * 32 + 8 * fq;
#pragma unroll
        for (int ai = 0; ai < 2; ++ai)
#pragma unroll
            for (int m = 0; m < 4; ++m) { const int row = row0 + ai * HALF + m * 16; bf16_t* rowp = base + (size_t)row * ldc + col0;
#pragma unroll
                for (int bj = 0; bj < 2; ++bj) { f32x4 v0 = acc[ai][bj][m][0], v1 = acc[ai][bj][m][1];
                    if (ACT == 1) {
#pragma unroll
                        for (int e = 0; e < 4; ++e) { const float a = fmaxf(v0[e], 0.f), b = fmaxf(v1[e], 0.f); v0[e] = a * a; v1[e] = b * b; } }
                    v0 = v0 * sc; v1 = v1 * sc; u32x4 w; w.x = cvt_pk_bf16(v0[0], v0[1]); w.y = cvt_pk_bf16(v0[2], v0[3]); w.z = cvt_pk_bf16(v1[0], v1[1]); w.w = cvt_pk_bf16(v1[2], v1[3]);
                    *(u32x4*)(rowp + bj * HALF) = w;
                    if (halo != nullptr && m == 3 && fr >= 13) { const int c = col0 + bj * HALF; if (c < 6144) *(u32x4*)(halo + ((size_t)(row >> 6) * 3 + (fr - 13)) * 6144 + c) = w; }
                } }
    }
};
struct EpiResid {
    static constexpr bool PERM = false, AFTER_DRAIN = false;
    const float* yin; float* yout; const float* mu; const float* rstd; const float* g; const float* b; int ldc; float alpha;
    __device__ __forceinline__ void operator()(const f32x4 (&acc)[2][2][4][2], const Unit& u, int wr, int wc, int fr, int fq) const {
        const int row0 = u.pm * BM + wr * 64 + fr; const int col0 = u.pn * BM + wc * 32 + 4 * fq;
        f32x4 gv[2][2], bv[2][2];
#pragma unroll
        for (int bj = 0; bj < 2; ++bj)
#pragma unroll
            for (int n = 0; n < 2; ++n) { gv[bj][n] = *(const f32x4*)(g + col0 + bj * HALF + n * 16); bv[bj][n] = *(const f32x4*)(b + col0 + bj * HALF + n * 16); }
#pragma unroll
        for (int ai = 0; ai < 2; ++ai)
#pragma unroll
            for (int m = 0; m < 4; ++m) { const int row = row0 + ai * HALF + m * 16; const float mr = mu[row], rs = rstd[row]; const size_t off = (size_t)row * ldc + col0;
#pragma unroll
                for (int bj = 0; bj < 2; ++bj)
#pragma unroll
                    for (int n = 0; n < 2; ++n) { const f32x4 yv = *(const f32x4*)(yin + off + bj * HALF + n * 16);
                        const f32x4 xv = ((yv - mr) * rs) * gv[bj][n] + bv[bj][n];
                        *(f32x4*)(yout + off + bj * HALF + n * 16) = xv * alpha + acc[ai][bj][m][n]; }
                if (m & 1) asm volatile("" ::: "memory"); }
    }
};

template <class Epi, class Sched, bool ALIGN_EPI = false, bool SP2 = false>
__device__ __forceinline__ void gemm_phase(PG8_LAS unsigned char* lds, const Gemm g, const Sched& S, const Epi& E) {
    int tid_ = threadIdx.x; asm volatile("" : "+v"(tid_));
    const int tid = tid_, wid = __builtin_amdgcn_readfirstlane(tid >> 6), lane = tid & 63, wr = wid >> 2, wc = wid & 3, fr = lane & 15, fq = lane >> 4;
    const int K = g.K, nt = K / BK, lda = g.lda;
    unsigned voffA[2], voffB[2];
#pragma unroll
    for (int i = 0; i < 2; ++i) { int R, C; stage_rc(tid * 16 + i * 8192, R, C); const int Rb = Epi::PERM ? ((R & ~31) + perm32(R & 31)) : R;
        voffA[i] = (unsigned)(R * lda + C) * 2u; voffB[i] = (unsigned)(Rb * K + C) * 2u; }
    const size_t kstep = (size_t)(BK * 2);
    const size_t hA = (size_t)HALF * lda * 2, hB = (size_t)HALF * K * 2;
    const size_t tA = 2 * hA, tB = 2 * hB;
    const unsigned ldsw = (unsigned)wid * 1024u;
    const int aoff = lds_byte(wr * 64 + fr, fq * 8), boff = lds_byte(wc * 32 + fr, fq * 8);
#define PG8_SA(b, h) (((b) * 2 + (h)) * HTB)
#define PG8_SB(b, h) ((4 + (b) * 2 + (h)) * HTB)
#define PG8_STAGE(bufoff, gbase, voff) do { _Pragma("unroll") for (int _i = 0; _i < 2; ++_i) \
        __builtin_amdgcn_global_load_lds((const unsigned*)((const char*)(gbase) + (voff)[_i]), (PG8_LAS unsigned*)(lds + (bufoff) + ldsw + _i * 8192), 16, 0, 0); } while (0)
#define PG8_LDA(dst, b, h) do { _Pragma("unroll") for (int m = 0; m < 4; ++m) _Pragma("unroll") for (int k = 0; k < 2; ++k) dst[m][k] = *(const PG8_LAS bf16x8*)(lds + PG8_SA(b, h) + aoff + m * 2048 + k * 1024); } while (0)
#define PG8_LDB(dst, b, h) do { _Pragma("unroll") for (int n = 0; n < 2; ++n) _Pragma("unroll") for (int k = 0; k < 2; ++k) dst[n][k] = *(const PG8_LAS bf16x8*)(lds + PG8_SB(b, h) + boff + n * 2048 + k * 1024); } while (0)
#define PG8_MMA(ai, bj, At, Bt) do { __builtin_amdgcn_s_setprio(1); _Pragma("unroll") for (int m = 0; m < 4; ++m) _Pragma("unroll") for (int n = 0; n < 2; ++n) _Pragma("unroll") for (int k = 0; k < 2; ++k) \
        acc[ai][bj][m][n] = __builtin_amdgcn_mfma_f32_16x16x32_bf16(Bt[n][k], At[m][k], acc[ai][bj][m][n], 0, 0, 0); __builtin_amdgcn_s_setprio(0); } while (0)
#define PG8_WAIT_V(n) asm volatile("s_waitcnt vmcnt(" #n ")" ::: "memory")
#define PG8_WAIT_L(n) asm volatile("s_waitcnt lgkmcnt(" #n ")" ::: "memory")
#define PG8_BAR __builtin_amdgcn_s_barrier()
#define PG8_SCHED __builtin_amdgcn_sched_barrier(0)
    Unit cur, nxt; int ui = 0;
    if (!S.next(0, cur)) return;
    f32x4 acc[2][2][4][2];
#pragma unroll
    for (int a = 0; a < 2; ++a)
#pragma unroll
        for (int b = 0; b < 2; ++b)
#pragma unroll
            for (int m = 0; m < 4; ++m)
#pragma unroll
                for (int n = 0; n < 2; ++n) acc[a][b][m][n] = (f32x4){0.f, 0.f, 0.f, 0.f};
    bf16x8 At[4][2], B0[2][2], B1[2][2];
    const char* cA = (const char*)g.A + (size_t)cur.pm * tA; const char* cB = (const char*)g.Bt + (size_t)cur.pn * tB;
    S.a_ready(cur);
    if constexpr (SP2) {
        PG8_STAGE(PG8_SB(0, 0), cB, voffB); PG8_STAGE(PG8_SB(0, 1), cB + hB, voffB); PG8_STAGE(PG8_SA(0, 0), cA, voffA); PG8_STAGE(PG8_SA(0, 1), cA + hA, voffA);
        if (wr == 1) PG8_BAR;
        PG8_WAIT_V(2); PG8_BAR;
        PG8_STAGE(PG8_SB(1, 0), cB + kstep, voffB); PG8_STAGE(PG8_SA(1, 0), cA + kstep, voffA); PG8_STAGE(PG8_SB(1, 1), cB + hB + kstep, voffB);
        PG8_WAIT_V(6); PG8_BAR;
    } else {
        PG8_STAGE(PG8_SB(0, 0), cB, voffB); PG8_STAGE(PG8_SA(0, 0), cA, voffA); PG8_STAGE(PG8_SB(0, 1), cB + hB, voffB); PG8_STAGE(PG8_SA(0, 1), cA + hA, voffA);
        if (wr == 1) PG8_BAR;
        PG8_WAIT_V(4); PG8_BAR;
        PG8_STAGE(PG8_SB(1, 0), cB + kstep, voffB); PG8_STAGE(PG8_SA(1, 0), cA + kstep, voffA); PG8_STAGE(PG8_SB(1, 1), cB + hB + kstep, voffB);
        PG8_WAIT_V(6); PG8_BAR;
    }
    for (;;) {
        const bool has_next = S.next(ui + 1, nxt);
        const char* nA = has_next ? (const char*)g.A + (size_t)nxt.pm * tA : cA; const char* nB = has_next ? (const char*)g.Bt + (size_t)nxt.pn * tB : cB;
        for (int t = 0; t < nt; t += 2) {
            const bool last = (t == nt - 2);
            const char* a1 = cA + (size_t)(t + 1) * kstep;
            const char* a2 = last ? nA : cA + (size_t)(t + 2) * kstep; const char* b2 = last ? nB : cB + (size_t)(t + 2) * kstep;
            const char* a3 = a2 + kstep; const char* b3 = b2 + kstep;
            if (last && has_next) S.a_ready(nxt);
            if constexpr (SP2) {
            PG8_LDB(B0, 0, 0); PG8_LDB(B1, 0, 1); PG8_SCHED; PG8_LDA(At, 0, 0); PG8_STAGE(PG8_SA(1, 1), a1 + hA, voffA);
            PG8_WAIT_V(8); PG8_WAIT_L(0); PG8_BAR; PG8_MMA(0, 0, At, B0); PG8_MMA(0, 1, At, B1); PG8_BAR; PG8_SCHED;
            PG8_LDA(At, 0, 1); PG8_STAGE(PG8_SB(0, 0), b2, voffB); PG8_STAGE(PG8_SB(0, 1), b2 + hB, voffB); PG8_STAGE(PG8_SA(0, 0), a2, voffA);
            PG8_WAIT_V(8); PG8_WAIT_L(0); PG8_BAR; PG8_MMA(1, 0, At, B0); PG8_MMA(1, 1, At, B1); PG8_BAR; PG8_SCHED;
            PG8_LDB(B0, 1, 0); PG8_LDB(B1, 1, 1); PG8_SCHED; PG8_LDA(At, 1, 0); PG8_STAGE(PG8_SA(0, 1), a2 + hA, voffA);
            PG8_WAIT_V(8); PG8_WAIT_L(0); PG8_BAR; PG8_MMA(0, 0, At, B0); PG8_MMA(0, 1, At, B1); PG8_BAR; PG8_SCHED;
            PG8_LDA(At, 1, 1); PG8_STAGE(PG8_SB(1, 0), b3, voffB); PG8_STAGE(PG8_SB(1, 1), b3 + hB, voffB); PG8_STAGE(PG8_SA(1, 0), a3, voffA);
            PG8_WAIT_V(8); PG8_WAIT_L(0); PG8_BAR; PG8_MMA(1, 0, At, B0); PG8_MMA(1, 1, At, B1); PG8_BAR; PG8_SCHED;
            } else {
            PG8_LDB(B0, 0, 0); PG8_SCHED; PG8_LDA(At, 0, 0); PG8_STAGE(PG8_SA(1, 1), a1 + hA, voffA);
            PG8_WAIT_L(8); PG8_BAR; PG8_WAIT_L(0); PG8_MMA(0, 0, At, B0); PG8_BAR; PG8_SCHED;
            PG8_LDB(B1, 0, 1); PG8_STAGE(PG8_SB(0, 0), b2, voffB);
            PG8_BAR; PG8_WAIT_L(0); PG8_MMA(0, 1, At, B1); PG8_BAR;
            PG8_LDA(At, 0, 1); PG8_STAGE(PG8_SA(0, 0), a2, voffA);
            PG8_BAR; PG8_WAIT_L(0); PG8_MMA(1, 0, At, B0); PG8_BAR; PG8_SCHED;
            PG8_STAGE(PG8_SB(0, 1), b2 + hB, voffB);
            PG8_WAIT_V(6); PG8_BAR; PG8_MMA(1, 1, At, B1); PG8_BAR;
            PG8_LDB(B0, 1, 0); PG8_SCHED; PG8_LDA(At, 1, 0); PG8_STAGE(PG8_SA(0, 1), a2 + hA, voffA);
            PG8_WAIT_L(8); PG8_BAR; PG8_WAIT_L(0); PG8_MMA(0, 0, At, B0); PG8_BAR; PG8_SCHED;
            PG8_LDB(B1, 1, 1); PG8_STAGE(PG8_SB(1, 0), b3, voffB);
            PG8_BAR; PG8_WAIT_L(0); PG8_MMA(0, 1, At, B1); PG8_BAR;
            PG8_LDA(At, 1, 1); PG8_STAGE(PG8_SA(1, 0), a3, voffA);
            PG8_BAR; PG8_WAIT_L(0); PG8_MMA(1, 0, At, B0); PG8_BAR; PG8_SCHED;
            PG8_STAGE(PG8_SB(1, 1), b3 + hB, voffB);
            PG8_WAIT_V(6); PG8_BAR; PG8_MMA(1, 1, At, B1); PG8_BAR;
            }
        }
        if constexpr (ALIGN_EPI) { if (wr == 0) PG8_BAR; }
        if constexpr (!Epi::AFTER_DRAIN) { E(acc, cur, wr, wc, fr, fq); S.done(cur); }
        if (!has_next) break;
#pragma unroll
        for (int a = 0; a < 2; ++a)
#pragma unroll
            for (int b = 0; b < 2; ++b)
#pragma unroll
                for (int m = 0; m < 4; ++m)
#pragma unroll
                    for (int n = 0; n < 2; ++n) acc[a][b][m][n] = (f32x4){0.f, 0.f, 0.f, 0.f};
        cur = nxt; cA = nA; cB = nB; ++ui;
        if constexpr (ALIGN_EPI) { if (wr == 1) PG8_BAR; }
    }
    PG8_WAIT_V(0);
    if constexpr (!ALIGN_EPI) { if (wr == 0) PG8_BAR; }
    PG8_BAR;
#undef PG8_SA
#undef PG8_SB
#undef PG8_STAGE
#undef PG8_LDA
#undef PG8_LDB
#undef PG8_MMA
#undef PG8_WAIT_V
#undef PG8_WAIT_L
#undef PG8_BAR
#undef PG8_SCHED
}
}
#include <hip/hip_bf16.h>
namespace attn_body {
using bf16=__hip_bfloat16;
using bf16x8=__attribute__((ext_vector_type(8)))short;
using s16x4=__attribute__((ext_vector_type(4)))short;
using f32x16=__attribute__((ext_vector_type(16)))float;
using u32x4=__attribute__((ext_vector_type(4)))unsigned;
constexpr int BATCH=8,SEQ=4096,D=64,DM=2048;
constexpr int NW=8,QBLK=32,QB=QBLK*NW,KVBLK=64,NQB=SEQ/QB;
constexpr int ATTN_PITCH=DM, ATTN_UNIT_ROWS=QB;
__device__ __forceinline__ int crow(int r,int hi){return (r&3)+8*(r>>2)+4*hi;}
#define SBAR() __builtin_amdgcn_sched_barrier(0)
__device__ __forceinline__ void cmask(f32x16&p0,f32x16&p1,int jb,int qrel,int hi){
  const float NEG=-INFINITY; int kb=64*jb+4*hi;
  #pragma unroll
  for(int r=0;r<16;++r){int kv=kb+(r&3)+8*(r>>2); if(kv>qrel)p0[r]=NEG; if(kv+32>qrel)p1[r]=NEG;}
}

constexpr int NSLOT=3, SLOTB=8192;
constexpr int LDS_K=0, LDS_V=NSLOT*SLOTB, LDS_WS=2*NSLOT*SLOTB, LDS_OST=LDS_WS+NW*64*4, LDS_BYTES=LDS_OST+NW*4096;
constexpr float C2=0.125f*1.4426950408889634f;
__device__ __forceinline__ void glds16(const void*gsrc,unsigned lds_dst){unsigned keep;
  asm volatile("s_mov_b32 %0, m0\n\ts_mov_b32 m0, %2\n\ts_nop 0\n\tglobal_load_lds_dwordx4 %1, off\n\ts_mov_b32 m0, %0":"=&s"(keep):"v"(gsrc),"s"(lds_dst):"memory");}
__device__ __forceinline__ float max3f(float a,float b,float c){float r;asm("v_max3_f32 %0, %1, %2, %3":"=v"(r):"v"(a),"v"(b),"v"(c));return r;}
__device__ __forceinline__ float max2f(float a,float b){float r;asm("v_max_f32_e32 %0, %1, %2":"=v"(r):"v"(a),"v"(b));return r;}
__device__ __forceinline__ float fadd_s(float a,float b){float r;asm("v_add_f32_e32 %0, %1, %2":"=v"(r):"v"(a),"v"(b));return r;}
__device__ __forceinline__ float fsub_s(float a,float b){float r;asm("v_sub_f32_e32 %0, %1, %2":"=v"(r):"v"(a),"v"(b));return r;}
typedef float f32x2_t __attribute__((ext_vector_type(2))); typedef __bf16 bf16x2_t __attribute__((ext_vector_type(2)));
__device__ __forceinline__ unsigned cvtpk_s(float lo,float hi){f32x2_t v={lo,hi};bf16x2_t b=__builtin_convertvector(v,bf16x2_t);return __builtin_bit_cast(unsigned,b);}
#define WAIT_BAR(N) asm volatile("s_waitcnt vmcnt(" #N ") lgkmcnt(0)\n\ts_barrier":::"memory")

__device__ __forceinline__ void qkt(f32x16&p0,f32x16&p1,const char*Kslot,const bf16x8*qr,const f32x16&negm,int r32,int hi){
  const char*kb=Kslot+hi*1024+r32*16;
  #pragma unroll
  for(int d0=0;d0<4;++d0){
    const bf16x8 b0=*reinterpret_cast<const bf16x8*>(kb+d0*2048);
    const bf16x8 b1=*reinterpret_cast<const bf16x8*>(kb+d0*2048+512);
    if(d0==0){p0=__builtin_amdgcn_mfma_f32_32x32x16_bf16(b0,qr[0],negm,0,0,0);p1=__builtin_amdgcn_mfma_f32_32x32x16_bf16(b1,qr[0],negm,0,0,0);}
    else{p0=__builtin_amdgcn_mfma_f32_32x32x16_bf16(b0,qr[d0],p0,0,0,0);p1=__builtin_amdgcn_mfma_f32_32x32x16_bf16(b1,qr[d0],p1,0,0,0);}}
}
typedef __attribute__((address_space(3))) const char* lds_cptr;
typedef short v4i16_t __attribute__((ext_vector_type(4)));
__device__ __forceinline__ void kload8(bf16x8*kf,lds_cptr kp){
  kf[0]=*(const __attribute__((address_space(3))) bf16x8*)(kp);      kf[1]=*(const __attribute__((address_space(3))) bf16x8*)(kp+512);
  kf[2]=*(const __attribute__((address_space(3))) bf16x8*)(kp+2048); kf[3]=*(const __attribute__((address_space(3))) bf16x8*)(kp+2560);
  kf[4]=*(const __attribute__((address_space(3))) bf16x8*)(kp+4096); kf[5]=*(const __attribute__((address_space(3))) bf16x8*)(kp+4608);
  kf[6]=*(const __attribute__((address_space(3))) bf16x8*)(kp+6144); kf[7]=*(const __attribute__((address_space(3))) bf16x8*)(kp+6656);
}
__device__ __forceinline__ void kload2(bf16x8*kf,lds_cptr kp,int j){ kf[2*j]=*(const __attribute__((address_space(3))) bf16x8*)(kp+j*2048); kf[2*j+1]=*(const __attribute__((address_space(3))) bf16x8*)(kp+j*2048+512); }
__device__ __forceinline__ s16x4 vtr(lds_cptr p){ return __builtin_bit_cast(s16x4,__builtin_amdgcn_ds_read_tr16_b64_v4i16((__attribute__((address_space(3))) v4i16_t*)p)); }
__device__ __forceinline__ float rowmax(const f32x16&p0,const f32x16&p1){
  float a=max3f(p0[0],p0[1],p1[0]),b=max3f(p0[2],p0[3],p1[1]);a=max3f(a,p1[2],p1[3]);
  #pragma unroll
  for(int r=4;r<16;r+=4){a=max3f(a,p0[r],p0[r+1]);b=max3f(b,p0[r+2],p0[r+3]);a=max3f(a,p1[r],p1[r+1]);b=max3f(b,p1[r+2],p1[r+3]);}
  const float m=max2f(a,b);
  auto rr=__builtin_amdgcn_permlane32_swap(__float_as_uint(m),__float_as_uint(m),false,false);
  return max2f(__uint_as_float(rr[0]),__uint_as_float(rr[1]));
}
__device__ __forceinline__ void pv(f32x16*o,int vb,bf16x8 pa0,bf16x8 pa1,bf16x8 pa2,bf16x8 pa3){
  #pragma unroll
  for(int d0=0;d0<2;++d0){s16x4 lo[4],hi[4];
    #pragma unroll
    for(int ks=0;ks<4;++ks){
      asm volatile("ds_read_b64_tr_b16 %0,%1 offset:%c2":"=&v"(lo[ks]):"v"(vb),"i"(d0*4096+ks*1024):"memory");
      asm volatile("ds_read_b64_tr_b16 %0,%1 offset:%c2":"=&v"(hi[ks]):"v"(vb),"i"(d0*4096+ks*1024+512):"memory");}
    asm volatile("s_waitcnt lgkmcnt(0)":::"memory");SBAR();
    #define PK(k) (bf16x8){lo[k][0],lo[k][1],lo[k][2],lo[k][3],hi[k][0],hi[k][1],hi[k][2],hi[k][3]}
    o[d0]=__builtin_amdgcn_mfma_f32_32x32x16_bf16(pa0,PK(0),o[d0],0,0,0);
    o[d0]=__builtin_amdgcn_mfma_f32_32x32x16_bf16(pa1,PK(1),o[d0],0,0,0);
    o[d0]=__builtin_amdgcn_mfma_f32_32x32x16_bf16(pa2,PK(2),o[d0],0,0,0);
    o[d0]=__builtin_amdgcn_mfma_f32_32x32x16_bf16(pa3,PK(3),o[d0],0,0,0);
    #undef PK
  }
}

#ifndef ATTN_STORE16
#define ATTN_STORE16(p,v) (*(u32x4*)(p)=(v))
#endif
template<int THRL> __device__ __forceinline__ void attn_unit(int b,int qkcol,int vcol,int ocol,int qb,const bf16*Q,const bf16*__restrict__ K,const bf16*__restrict__ V,bf16*O,char*shm){
  int tid_=threadIdx.x; asm volatile("":"+v"(tid_));
  const int tid=tid_,lane=tid&63,r32=lane&31,hi=lane>>5; const int wid=__builtin_amdgcn_readfirstlane(tid>>6);
  const long rowbase=(long)b*SEQ; const int q0=qb*QB;
  const bf16*Qw=Q+(rowbase+q0+wid*QBLK)*DM+qkcol;
  const bf16*Kh=K+rowbase*DM+qkcol,*Vh=V+rowbase*DM+vcol;
  const unsigned lds0=(unsigned)(uintptr_t)shm;
  float*wsf=(float*)(shm+LDS_WS)+wid*64;
  const bf16*ksrc=Kh+(long)lane*DM+wid*8;
  const bf16*vsrc=Vh+(long)(16*(wid&3)+(lane>>2))*DM+(wid>>2)*32+(lane&3)*8;
  const unsigned kdst=lds0+LDS_K+wid*1024, vdst=lds0+LDS_V+wid*1024;
  #define DMA_K(t,slot) glds16(ksrc+(long)(t)*KVBLK*DM,(unsigned)__builtin_amdgcn_readfirstlane(kdst+(slot)))
  #define DMA_V(t,slot) glds16(vsrc+(long)(t)*KVBLK*DM,(unsigned)__builtin_amdgcn_readfirstlane(vdst+(slot)))
  const int vb0=(int)(lds0+LDS_V)+((lane>>4)&1)*32+(lane&3)*8+(4*hi+((lane&15)>>2))*64;
  const char*Kbase=shm+LDS_K; bf16x8 kf[8];
  const lds_cptr shm3=(lds_cptr)shm; const lds_cptr kp0=shm3+LDS_K+hi*1024+r32*16; const lds_cptr vp0=shm3+LDS_V+((lane>>4)&1)*32+(lane&3)*8+(4*hi+((lane&15)>>2))*64;
  const int NT=(q0+QB)/KVBLK;
  DMA_K(0,0);DMA_V(0,0);DMA_K(1,SLOTB);
  bf16x8 qr[4];
  #pragma unroll
  for(int d0=0;d0<4;++d0)qr[d0]=*reinterpret_cast<const bf16x8*>(&Qw[(long)r32*DM+d0*16+hi*8]);
  float mhat=0.f,l_reg=0.f;f32x16 o[2];o[0]=f32x16{};o[1]=f32x16{};f32x16 negm=f32x16{};asm volatile("":"+v"(negm));
  const int qrel=wid*QBLK+r32;
  #define CMASK(P0,P1,t) do{int jb_=(t)-(NT-4); if(jb_>=0)cmask(P0,P1,jb_,qrel,hi);}while(0)
  bool resc=false;
  #define START(P0,P1) do{ const float rm=rowmax(P0,P1); resc=false; \
    { const float dl=rm; mhat=fadd_s(mhat,dl); \
      _Pragma("unroll") for(int r=0;r<16;++r){P0[r]=fsub_s(P0[r],dl);P1[r]=fsub_s(P1[r],dl);} \
      _Pragma("unroll") for(int r=0;r<16;++r)negm[r]=-mhat; asm volatile("":"+v"(negm)); } \
    _Pragma("unroll") for(int r=0;r<16;++r)P0[r]=__builtin_amdgcn_exp2f(P0[r]); }while(0)
  #define RESC() do{ if(resc){ asm volatile("s_waitcnt lgkmcnt(0)":::"memory"); \
      _Pragma("unroll") for(int d_=0;d_<2;++d_) _Pragma("unroll") for(int r=0;r<16;++r)o[d_][r]*=wsf[crow(r,hi)]; } }while(0)
  f32x16 pA0,pA1,pB0,pB1;
  int sl_prev=0,sl_cur=0,sl_next=SLOTB;
  #define ROT() do{sl_prev=sl_cur;sl_cur=sl_next;sl_next=(sl_next==(NSLOT-1)*SLOTB)?0:sl_next+SLOTB;}while(0)
  DMA_K(2,2*SLOTB);
  WAIT_BAR(3);
  qkt(pA0,pA1,Kbase,qr,negm,r32,hi);asm volatile("s_nop 15\n\ts_nop 7":"+v"(pA0),"+v"(pA1));CMASK(pA0,pA1,0);
  START(pA0,pA1);
  _Pragma("unroll") for(int r=0;r<16;++r)pA1[r]=__builtin_amdgcn_exp2f(pA1[r]);
  WAIT_BAR(0);
  DMA_K(3,0);DMA_V(1,SLOTB);
  ROT();
  kload8(kf,kp0+sl_cur);
  WAIT_BAR(2);
  s16x4 vlo[8],vhi[8]; u32x4 pw0,pw1,pw2,pw3;
  #define PKW(P,B) cvtpk_s(P[B],P[B+1])
  #define PAF(k) __builtin_bit_cast(bf16x8,pw##k)
  #define VFR(i) (bf16x8){vlo[i][0],vlo[i][1],vlo[i][2],vlo[i][3],vhi[i][0],vhi[i][1],vhi[i][2],vhi[i][3]}
  #define PIN(x) asm volatile("":"+v"(x))
  #define MX3(a,b,c) __builtin_fmaxf(__builtin_fmaxf((a),(b)),(c))
  #define GAPA(MF,A0,A1,A2,A3,W0,W1,PW) do{ MF; sacc+=A0; sacc+=A1; sacc+=A2; sacc+=A3; PIN(sacc); W0; W1; PIN(PW); SBAR(); }while(0)
  #define EX(v) __builtin_amdgcn_exp2f(v)
  #define GAPB(MF,X,B) do{ MF; X[B]=EX(X[B]); X[B+1]=EX(X[B+1]); X[B+2]=EX(X[B+2]); X[B+3]=EX(X[B+3]); PIN(X); SBAR(); }while(0)
  #define VRD(i) do{ vlo[i]=vtr(vp_+(((i)>>2)*4096+((i)&3)*1024)); vhi[i]=vtr(vp_+(((i)>>2)*4096+((i)&3)*1024+512)); }while(0)
  #define KRD(G,j) do{ if(G){ kload2(kf,kp0+sl_next,j); SBAR(); } }while(0)
  #define STEP(C0,C1,P0,P1,t,GK,GV,GL) do{ SBAR(); \
    const lds_cptr vp_=vp0+sl_prev; \
    VRD(0); SBAR(); float sacc=(P0[0]+P0[1]); \
    GAPA(C0=__builtin_amdgcn_mfma_f32_32x32x16_bf16(kf[0],qr[0],negm,0,0,0), P0[2],P0[3],P0[4],P0[5],     pw0[0]=PKW(P0,0), pw0[1]=PKW(P0,2), pw0); \
    VRD(4); SBAR(); GAPA(C1=__builtin_amdgcn_mfma_f32_32x32x16_bf16(kf[1],qr[0],negm,0,0,0), P0[6],P0[7],P0[8],P0[9],     pw0[2]=PKW(P0,4), pw0[3]=PKW(P0,6), pw0); \
    VRD(1); SBAR(); GAPA(C0=__builtin_amdgcn_mfma_f32_32x32x16_bf16(kf[2],qr[1],C0,0,0,0),   P0[10],P0[11],P0[12],P0[13], pw1[0]=PKW(P0,8), pw1[1]=PKW(P0,10), pw1); \
    VRD(5); SBAR(); GAPA(C1=__builtin_amdgcn_mfma_f32_32x32x16_bf16(kf[3],qr[1],C1,0,0,0),   P0[14],P0[15],P1[0],P1[1],   pw1[2]=PKW(P0,12),pw1[3]=PKW(P0,14), pw1); \
    VRD(2); SBAR(); GAPA(C0=__builtin_amdgcn_mfma_f32_32x32x16_bf16(kf[4],qr[2],C0,0,0,0),   P1[2],P1[3],P1[4],P1[5],     pw2[0]=PKW(P1,0), pw2[1]=PKW(P1,2), pw2); \
    VRD(6); SBAR(); GAPA(C1=__builtin_amdgcn_mfma_f32_32x32x16_bf16(kf[5],qr[2],C1,0,0,0),   P1[6],P1[7],P1[8],P1[9],     pw2[2]=PKW(P1,4), pw2[3]=PKW(P1,6), pw2); \
    VRD(3); SBAR(); GAPA(C0=__builtin_amdgcn_mfma_f32_32x32x16_bf16(kf[6],qr[3],C0,0,0,0),   P1[10],P1[11],P1[12],P1[13], pw3[0]=PKW(P1,8), pw3[1]=PKW(P1,10), pw3); \
    VRD(7); SBAR(); GAPA(C1=__builtin_amdgcn_mfma_f32_32x32x16_bf16(kf[7],qr[3],C1,0,0,0),   P1[14],P1[15],0.f,0.f,       pw3[2]=PKW(P1,12),pw3[3]=PKW(P1,14), pw3); \
    l_reg+=sacc; \
    if(GK){DMA_K((t)+3,sl_cur);} if(GV){DMA_V((t)+1,sl_next);} \
    CMASK(C0,C1,t); \
    { float a=MX3(C0[0],C0[1],C1[0]),b=MX3(C0[2],C0[3],C1[1]); a=MX3(a,C1[2],C1[3]); \
      _Pragma("unroll") for(int r=4;r<16;r+=4){a=MX3(a,C0[r],C0[r+1]);b=MX3(b,C0[r+2],C0[r+3]);a=MX3(a,C1[r],C1[r+1]);b=MX3(b,C1[r+2],C1[r+3]);} \
      float rm=__builtin_fmaxf(a,b); { auto rr=__builtin_amdgcn_permlane32_swap(__float_as_uint(rm),__float_as_uint(rm),false,false); rm=__builtin_fmaxf(__uint_as_float(rr[0]),__uint_as_float(rr[1])); } \
      resc=false; \
      if(__builtin_expect(__any(rm>(float)THRL),0)){ const float dl=__builtin_fmaxf(rm,0.f); mhat+=dl; \
        _Pragma("unroll") for(int r=0;r<16;++r){C0[r]-=dl;C1[r]-=dl;} \
        _Pragma("unroll") for(int r=0;r<16;++r)negm[r]=-mhat; asm volatile("":"+v"(negm)); \
        const float f=__builtin_amdgcn_exp2f(-dl); l_reg*=f; if(hi==0)wsf[r32]=f; resc=true; } } \
    SBAR(); \
    GAPB(o[0]=__builtin_amdgcn_mfma_f32_32x32x16_bf16(PAF(0),VFR(0),o[0],0,0,0), C0,0); \
    GAPB(o[1]=__builtin_amdgcn_mfma_f32_32x32x16_bf16(PAF(0),VFR(4),o[1],0,0,0), C0,4); \
    KRD(GL,0); GAPB(o[0]=__builtin_amdgcn_mfma_f32_32x32x16_bf16(PAF(1),VFR(1),o[0],0,0,0), C0,8); \
    KRD(GL,1); GAPB(o[1]=__builtin_amdgcn_mfma_f32_32x32x16_bf16(PAF(1),VFR(5),o[1],0,0,0), C0,12); \
    KRD(GL,2); GAPB(o[0]=__builtin_amdgcn_mfma_f32_32x32x16_bf16(PAF(2),VFR(2),o[0],0,0,0), C1,0); \
    KRD(GL,3); GAPB(o[1]=__builtin_amdgcn_mfma_f32_32x32x16_bf16(PAF(2),VFR(6),o[1],0,0,0), C1,4); \
    GAPB(o[0]=__builtin_amdgcn_mfma_f32_32x32x16_bf16(PAF(3),VFR(3),o[0],0,0,0), C1,8); \
    GAPB(o[1]=__builtin_amdgcn_mfma_f32_32x32x16_bf16(PAF(3),VFR(7),o[1],0,0,0), C1,12); \
    }while(0)
  int t=1;
  #undef CMASK
  #define CMASK(P0,P1,t) do{}while(0)
  for(;t+5<NT;t+=2){
    STEP(pB0,pB1,pA0,pA1,t,true,true,true);     WAIT_BAR(2); RESC(); ROT();
    STEP(pA0,pA1,pB0,pB1,t+1,true,true,true);   WAIT_BAR(2); RESC(); ROT();
  }
  #undef CMASK
  #define CMASK(P0,P1,t) do{int jb_=(t)-(NT-4); if(jb_>=0)cmask(P0,P1,jb_,qrel,hi);}while(0)
  #define ENDW(tt) do{ if((tt)+3<NT){WAIT_BAR(2);} else if((tt)+2<NT){WAIT_BAR(1);} else {WAIT_BAR(0);} }while(0)
  for(;t+1<NT;t+=2){
    STEP(pB0,pB1,pA0,pA1,t,(t+3<NT),(t+1<NT),(t+1<NT));       ENDW(t);   RESC(); ROT();
    STEP(pA0,pA1,pB0,pB1,t+1,(t+4<NT),(t+2<NT),(t+2<NT));     ENDW(t+1); RESC(); ROT();
  }
  STEP(pB0,pB1,pA0,pA1,NT-1,false,false,false); RESC();
  { float sacc=pB0[0]+pB0[1]; _Pragma("unroll") for(int r=2;r<16;++r)sacc+=pB0[r]; _Pragma("unroll") for(int r=0;r<16;++r)sacc+=pB1[r]; l_reg+=sacc;
    pw0=(u32x4){PKW(pB0,0),PKW(pB0,2),PKW(pB0,4),PKW(pB0,6)};pw1=(u32x4){PKW(pB0,8),PKW(pB0,10),PKW(pB0,12),PKW(pB0,14)};pw2=(u32x4){PKW(pB1,0),PKW(pB1,2),PKW(pB1,4),PKW(pB1,6)};pw3=(u32x4){PKW(pB1,8),PKW(pB1,10),PKW(pB1,12),PKW(pB1,14)};
    SBAR(); pv(o,vb0+sl_cur,PAF(0),PAF(1),PAF(2),PAF(3)); }
  #undef PKW
  #undef PAF
  #undef VFR
  #undef PIN
  #undef MX3
  #undef GAPA
  #undef GAPB
  #undef EX
  #undef VRD
  #undef KRD
  #undef STEP
  #undef ENDW
  {auto rr=__builtin_amdgcn_permlane32_swap(__float_as_uint(l_reg),__float_as_uint(l_reg),false,false);l_reg=__uint_as_float(rr[0])+__uint_as_float(rr[1]);}
  if(hi==0)wsf[32+r32]=l_reg;asm volatile("s_waitcnt lgkmcnt(0)":::"memory");
  float rli[16];
  #pragma unroll
  for(int r=0;r<16;++r)rli[r]=__builtin_amdgcn_rcpf(wsf[32+crow(r,hi)]);
  bf16*Ow=O+(rowbase+q0+wid*QBLK)*DM+ocol;
  { bf16*stg=(bf16*)(shm+LDS_OST)+wid*2048;
    #pragma unroll
    for(int r=0;r<16;++r){const int orow=crow(r,hi);
      #pragma unroll
      for(int d0=0;d0<2;++d0)stg[orow*64+d0*32+r32]=__float2bfloat16(o[d0][r]*rli[r]);}
    asm volatile("s_waitcnt lgkmcnt(0)":::"memory");
    #pragma unroll
    for(int i=0;i<4;++i){const int row=i*8+(lane>>3),ch=lane&7; const u32x4 v=*(const u32x4*)(stg+row*64+ch*8); ATTN_STORE16(Ow+(long)row*DM+ch*8,v);} }
  asm volatile("s_waitcnt lgkmcnt(0)\n\ts_barrier":::"memory");
  #undef DMA_K
  #undef DMA_V
  #undef CMASK
  #undef START
  #undef RESC
  #undef ROT
}
constexpr int ATTN_LDS_BYTES=LDS_BYTES;
struct AttnTensors { const bf16* Q; const bf16* K; const bf16* V; bf16* O0; bf16* O1; };
struct AttnUnit { int b, h, c, e, qb; };
struct StaticOrder {
  int vcu, G;
  __device__ __forceinline__ explicit StaticOrder(int grid,int block):vcu((grid%8==0)?(block%8)*(grid/8)+block/8:block),G(grid){}
  __device__ __forceinline__ bool next(int i,AttnUnit&u)const{ const int per=32; const int trip=vcu+(i/per)*G; if(trip>=BATCH*16*2)return false; const int j=i%per;
    u.b=trip>>5; u.h=(trip>>1)&15; u.c=trip&1; u.e=j>>4; u.qb=15-(j&15); return true; }
  __device__ __forceinline__ void a_ready(const AttnUnit&)const{}
  __device__ __forceinline__ void done(const AttnUnit&)const{}
};
template<class Sched,int THRL=8> __device__ __forceinline__ void attn_phase(char*lds,const AttnTensors&T,const Sched&S){
  AttnUnit u;
  for(int i=0;S.next(i,u);++i){ S.a_ready(u); attn_unit<THRL>(u.b,u.h*128+u.c*64,u.h*128+u.e*64,u.h*128+u.e*64,u.qb,T.Q,T.K,T.V,u.c?T.O1:T.O0,lds); S.done(u); }
}
#undef SBAR
#undef WAIT_BAR
}

constexpr int NWAVES = 8;
#ifndef MK_PER_PHASE
#define MK_PER_PHASE 1
#endif

constexpr int BATCH = 8, SEQ = 4096, DMODEL = 2048, MROWS = BATCH * SEQ, DFF = 8192, NHEADS = 16, HD = 128;
constexpr int GDN_PROJ = 8224, GDN_MAIN = 8192, CONVC = 6144, NCG = MROWS / 64;
constexpr float ALPHA_RES = 1.6817928305074292f;
constexpr float LN_EPS = 1e-5f, GDN_EPS = 1e-6f, SUBLN_EPS = 1e-5f;
constexpr int N_PHASES = 39;

constexpr size_t MiB = 1u << 20;
constexpr size_t WS_CTL = 0, CTL_ZERO_BYTES = 1 * MiB;
constexpr size_t WS_ONES = 1 * MiB, WS_ZEROS = WS_ONES + 8192, WS_MU = WS_ONES + 65536, WS_RSTD = WS_MU + 131072;
constexpr size_t WS_BETA = 2 * MiB, WS_G = 4 * MiB;
constexpr size_t WS_HALO = 9 * MiB;
constexpr size_t WS_WA = 27 * MiB, WS_WB = 60 * MiB;
constexpr size_t WS_ATTN = 27 * MiB;
constexpr size_t WS_XB = 92 * MiB;
constexpr size_t WS_Y = 220 * MiB;
constexpr size_t WS_R1 = 476 * MiB;
constexpr size_t WS_END = 988 * MiB;
constexpr size_t QTR = 128 * MiB;
constexpr int CW_TMO = 0;
constexpr int CW_BAR = 4096;

constexpr int RING_OFF = 0, RING_BYTES = 131072;
constexpr int LDSCTL_OFF = RING_BYTES, MISC_OFF = LDSCTL_OFF + 320;
constexpr int LDS_BYTES = 147456;
static_assert(MISC_OFF + 128 <= LDS_BYTES, "LDS map");

#define GAS __attribute__((address_space(1)))
#define LAS __attribute__((address_space(3)))
typedef unsigned short bf16;
typedef unsigned v4u __attribute__((ext_vector_type(4)));
typedef unsigned v2u __attribute__((ext_vector_type(2)));
typedef float f32x4 __attribute__((ext_vector_type(4)));
typedef float f32x16 __attribute__((ext_vector_type(16)));
typedef short bf16x8 __attribute__((ext_vector_type(8)));
typedef GAS unsigned gu32;
typedef GAS unsigned long long gu64;
#define RLX_AGENT __ATOMIC_RELAXED, __HIP_MEMORY_SCOPE_AGENT
#define LDS_WAIT() asm volatile("s_waitcnt lgkmcnt(0)" ::: "memory")
#define VM_WAIT() asm volatile("s_waitcnt vmcnt(0)" ::: "memory")
#define WG_BAR() asm volatile("s_waitcnt lgkmcnt(0)\n\ts_barrier" ::: "memory")
__device__ __forceinline__ unsigned f2bf(float f) { unsigned u = __builtin_bit_cast(unsigned, f); return (u + 0x7fffu + ((u >> 16) & 1u)) >> 16; }
__device__ __forceinline__ unsigned pk2(float lo, float hi) { return f2bf(lo) | (f2bf(hi) << 16); }
__device__ __forceinline__ float bflo(unsigned w) { return __builtin_bit_cast(float, w << 16); }
__device__ __forceinline__ float bfhi(unsigned w) { return __builtin_bit_cast(float, w & 0xffff0000u); }
__device__ __forceinline__ float bf2f(bf16 h) { return __builtin_bit_cast(float, (unsigned)h << 16); }
__device__ __forceinline__ float fast_exp(float x) { return __builtin_amdgcn_exp2f(x * 1.4426950408889634f); }
__device__ __forceinline__ float silu_f(float x) { return x * __builtin_amdgcn_rcpf(1.f + __expf(-x)); }

#define XB_TMO      128
#define XB_XCNT(j)  (256  + 64 * (j))
#define XB_XSUB(j)  (1280 + 64 * (j))
#define XB_XGEN(j)  (2304 + 64 * (j))
#define XB_TOP      3328
#define XB_TOPGEN   3392
#define XCD_BAR_WORDS 3456
#define XB_SPIN_CAP (1u << 18)

__device__ __forceinline__ unsigned xb_ld(unsigned* p)              { return __hip_atomic_load(p, __ATOMIC_RELAXED, __HIP_MEMORY_SCOPE_AGENT); }
__device__ __forceinline__ unsigned xb_add(unsigned* p, unsigned v) { return __hip_atomic_fetch_add(p, v, __ATOMIC_RELAXED, __HIP_MEMORY_SCOPE_AGENT); }
__device__ __forceinline__ unsigned xb_xcc_id() { return (unsigned)__builtin_amdgcn_s_getreg((3 << 11) | 20) & 0xFu; }
#define XB_SPIN(cond, bar) do { unsigned _sp = 0; while (cond) { __builtin_amdgcn_s_sleep(1); \
    if ((++_sp & 255u) == 0u) { if (xb_ld(&(bar)[XB_TMO])) break; if (_sp > XB_SPIN_CAP) { atomicAdd(&(bar)[XB_TMO], 1u); break; } } } } while (0)

struct XcdBarrier {
    unsigned* bar; unsigned x;
    volatile LAS unsigned* st;
};
__device__ __forceinline__ XcdBarrier xcd_barrier_post(unsigned* bar, volatile LAS unsigned* st) {
    XcdBarrier b; b.bar = bar; b.x = xb_xcc_id(); b.st = st;
    if (threadIdx.x == 0) (void)xb_add(&bar[XB_XCNT(b.x)], 1u);
    return b;
}
__device__ __forceinline__ void xcd_barrier_complete(unsigned* bar, unsigned x, unsigned& nloc, unsigned& nx) {
    const unsigned G = gridDim.x * gridDim.y * gridDim.z;
    unsigned sum, cnt, mine, sp = 0u;
    for (;;) {
        sum = 0u; cnt = 0u; mine = 0u;
#pragma unroll
        for (unsigned j = 0; j < 16; ++j) { const unsigned c = xb_ld(&bar[XB_XCNT(j)]); sum += c; cnt += (c > 0u) ? 1u : 0u; mine = (j == x) ? c : mine; }
        if (sum == G) break;
        __builtin_amdgcn_s_sleep(1);
        if ((++sp & 255u) == 0u) { if (xb_ld(&bar[XB_TMO])) break; if (sp > XB_SPIN_CAP) { atomicAdd(&bar[XB_TMO], 1u); break; } }
    }
    nloc = mine > 0u ? mine : 1u; nx = cnt > 0u ? cnt : 1u;
}
__device__ __forceinline__ void xcd_barrier(const XcdBarrier& b) {
    asm volatile("s_waitcnt vmcnt(0)" ::: "memory");
    __syncthreads();
    if (threadIdx.x == 0) {
        unsigned* bar = b.bar;
        __builtin_amdgcn_s_waitcnt(0);
        unsigned nloc = b.st[0], nx = b.st[1];
        if (nloc == 0u) { xcd_barrier_complete(bar, b.x, nloc, nx); b.st[0] = nloc; b.st[1] = nx; }
        const unsigned old = xb_add(&bar[XB_XSUB(b.x)], 1u);
        const unsigned gen = old / nloc;
        if (old + 1u == (gen + 1u) * nloc) {
            __builtin_amdgcn_fence(__ATOMIC_RELEASE, "agent");
            asm volatile("s_waitcnt vmcnt(0)" ::: "memory");
            const unsigned og = xb_add(&bar[XB_TOP], 1u);
            const unsigned tg = og / nx;
            if (og + 1u == (tg + 1u) * nx) xb_add(&bar[XB_TOPGEN], 1u);
            else XB_SPIN(xb_ld(&bar[XB_TOPGEN]) == tg, bar);
            __builtin_amdgcn_fence(__ATOMIC_ACQUIRE, "agent");
            xb_add(&bar[XB_XGEN(b.x)], 1u);
            asm volatile("s_waitcnt vmcnt(0)" ::: "memory");
        } else {
            XB_SPIN(xb_ld(&bar[XB_XGEN(b.x)]) == gen, bar);
            __builtin_amdgcn_fence(__ATOMIC_ACQUIRE, "agent");
            asm volatile("s_waitcnt vmcnt(0)" ::: "memory");
        }
    }
    __syncthreads();
}

__device__ __forceinline__ float wave_sum(float v) {
#pragma unroll
    for (int o = 1; o < 64; o <<= 1) v += __shfl_xor(v, o);
    return v;
}
__device__ __forceinline__ float sum16(float v) {
    v += __shfl_xor(v, 1); v += __shfl_xor(v, 2); v += __shfl_xor(v, 4); v += __shfl_xor(v, 8); return v;
}
__device__ __forceinline__ void transpose_item(const float* W, int K, int ldw, int n_begin, int nblk, bf16* WT, int row_off, LAS float* scr, int item, int lane) {
    const int kb = item / nblk, nb = item % nblk, k0 = 64 * kb, n0 = 32 * nb;
#pragma unroll 8
    for (int i = 0; i < 32; ++i) { const int kk = 2 * i + (lane >> 5); scr[kk * 33 + (lane & 31)] = W[(size_t)(k0 + kk) * ldw + n_begin + n0 + (lane & 31)]; }
    LDS_WAIT(); asm volatile("" ::: "memory");
    const int c = lane & 7;
#pragma unroll
    for (int j = 0; j < 4; ++j) { const int n = (lane >> 3) + 8 * j; const LAS float* s = scr + (8 * c) * 33 + n;
        v4u o; o.x = pk2(s[0 * 33], s[1 * 33]); o.y = pk2(s[2 * 33], s[3 * 33]); o.z = pk2(s[4 * 33], s[5 * 33]); o.w = pk2(s[6 * 33], s[7 * 33]);
        *(GAS v4u*)(WT + (size_t)(row_off + n0 + n) * K + k0 + 8 * c) = o; }
    LDS_WAIT(); asm volatile("" ::: "memory");
}
__device__ __forceinline__ void convert_w(LAS unsigned char* lds, int gw, int NGW, int wave, int lane, const float* W, int K, int ldw, int n_begin, int ncols, bf16* WT, int row_off) {
    LAS float* scr = (LAS float*)(lds + RING_OFF + wave * 16384);
    const int nblk = ncols / 32, nitems = (K / 64) * nblk;
    for (int it = gw; it < nitems; it += NGW) transpose_item(W, K, ldw, n_begin, nblk, WT, row_off, scr, it, lane);
}
__device__ __forceinline__ void row_to_bf16(const float* xrow, bf16* orow, int lane) {
    const GAS f32x4* xr = (const GAS f32x4*)xrow + lane; GAS v2u* o8 = (GAS v2u*)orow + lane;
#pragma unroll
    for (int j = 0; j < 8; ++j) { const f32x4 v = xr[64 * j]; v2u w; w.x = pk2(v.x, v.y); w.y = pk2(v.z, v.w); o8[64 * j] = w; }
}
__device__ __forceinline__ void ln_row(const float* yrow, const float* g, const float* b, float* mu, float* rstd, bf16* xbrow, float* outrow, int lane) {
    const GAS f32x4* yr = (const GAS f32x4*)yrow + lane;
    f32x4 v[8]; float s = 0.f;
#pragma unroll
    for (int j = 0; j < 8; ++j) { v[j] = yr[64 * j]; s += (v[j].x + v[j].y) + (v[j].z + v[j].w); }
    const float mean = wave_sum(s) * (1.f / DMODEL); float s2 = 0.f;
#pragma unroll
    for (int j = 0; j < 8; ++j) { v[j] = v[j] - mean; s2 += (v[j].x * v[j].x + v[j].y * v[j].y) + (v[j].z * v[j].z + v[j].w * v[j].w); }
    const float rs = 1.f / sqrtf(wave_sum(s2) * (1.f / DMODEL) + LN_EPS);
    if (lane == 0) { *mu = mean; *rstd = rs; }
    const GAS f32x4* gr = (const GAS f32x4*)g + lane; const GAS f32x4* br = (const GAS f32x4*)b + lane;
#pragma unroll
    for (int j = 0; j < 8; ++j) { const f32x4 o = (v[j] * rs) * gr[64 * j] + br[64 * j];
        if (xbrow) { v2u w; w.x = pk2(o.x, o.y); w.y = pk2(o.z, o.w); ((GAS v2u*)xbrow + lane)[64 * j] = w; }
        if (outrow) ((GAS f32x4*)outrow + lane)[64 * j] = o; }
}
#define MFMA32(a, b, c) __builtin_amdgcn_mfma_f32_32x32x16_bf16((a), (b), (c), 0, 0, 0)

__device__ __forceinline__ void ba_proj(const bf16* xb, const bf16* wt  , const float* a_log, const float* dt_bias, float* beta, float* g, int gw, int NGW, int lane) {
    const int r32 = lane & 31, hi = lane >> 5;
    for (int wu = gw; wu < MROWS / 32; wu += NGW) {
        const bf16* ap = xb + (size_t)(wu * 32 + r32) * DMODEL + 8 * hi; const bf16* bp = wt + (size_t)(GDN_MAIN + r32) * DMODEL + 8 * hi;
        f32x16 acc = {};
#pragma unroll 1
        for (int s0 = 0; s0 < DMODEL / 16; s0 += 8) {
            bf16x8 a[8], b[8];
#pragma unroll
            for (int s = 0; s < 8; ++s) { a[s] = *(const bf16x8*)(ap + (s0 + s) * 16); b[s] = *(const bf16x8*)(bp + (s0 + s) * 16); }
#pragma unroll
            for (int s = 0; s < 8; ++s) acc = MFMA32(a[s], b[s], acc);
        }
        const int j = r32 & 15; const float al = -__expf(a_log[j]), db = dt_bias[j];
#pragma unroll
        for (int r = 0; r < 16; ++r) { const int t = wu * 32 + (r & 3) + 8 * (r >> 2) + 4 * hi; const float v = acc[r];
            if (r32 < 16) beta[(size_t)t * 16 + j] = __builtin_amdgcn_rcpf(1.f + __expf(-v));
            else { const float z = v + db; const float sp = z > 20.f ? z : log1pf(__expf(z)); g[(size_t)t * 16 + j] = al * sp; } }
    }
}

constexpr int G2_TS = 136;
constexpr int G2_AS = 68, G2_A = 0, G2_GC = G2_A + 64 * G2_AS * 4, G2_BT = G2_GC + 256, G2_Q = G2_BT + 256, G2_K = G2_Q + 64 * G2_TS * 2, G2_V = G2_K + 64 * G2_TS * 2, G2_END = G2_V + 64 * G2_TS * 2;
static_assert(G2_END <= RING_BYTES, "G2 LDS");
__device__ __forceinline__ void gdn_chunk_phase(LAS unsigned char* lds, bf16* p, const bf16* halo, const float* beta, float* g, bf16* wbuf, bf16* attn, const float* conv_w, int vcu, int G) {
    int tid_ = threadIdx.x; asm volatile("" : "+v"(tid_));
    const int tid = tid_, lane = tid & 63, wid = __builtin_amdgcn_readfirstlane(tid >> 6), r32 = lane & 31, hi = lane >> 5;
    LAS bf16* Qs = (LAS bf16*)(lds + G2_Q); LAS bf16* Ks = (LAS bf16*)(lds + G2_K); LAS bf16* Vs = (LAS bf16*)(lds + G2_V);
    LAS float* As = (LAS float*)(lds + G2_A); LAS float* gcs = (LAS float*)(lds + G2_GC); LAS float* bts = (LAS float*)(lds + G2_BT);
    asm volatile("" : "+v"(Qs), "+v"(Ks), "+v"(Vs), "+v"(As), "+v"(gcs), "+v"(bts));
    for (int u = vcu; u < NCG * NHEADS; u += G) {
        const int cg = u >> 4, h = u & 15, n = cg & 63; const size_t row0 = (size_t)cg * 64;
        {
            const int cgp = lane & 15, sub = lane >> 4, tA = 8 * wid + 2 * sub;
#pragma unroll
            for (int X = 0; X < 3; ++X) {
                const int col = X * 2048 + h * HD + 8 * cgp;
                float raw[5][8];
#pragma unroll
                for (int rr = 0; rr < 5; ++rr) { const int rel = tA - 3 + rr; v4u v = {0u, 0u, 0u, 0u};
                    if (rel >= 0) v = *(const v4u*)(p + (row0 + rel) * GDN_MAIN + col);
                    else if (n > 0) v = *(const v4u*)(halo + ((size_t)(cg - 1) * 3 + (rel + 3)) * CONVC + col);
                    raw[rr][0] = bflo(v.x); raw[rr][1] = bfhi(v.x); raw[rr][2] = bflo(v.y); raw[rr][3] = bfhi(v.y); raw[rr][4] = bflo(v.z); raw[rr][5] = bfhi(v.z); raw[rr][6] = bflo(v.w); raw[rr][7] = bfhi(v.w); }
                float o0[8], o1[8];
#pragma unroll
                for (int c = 0; c < 8; ++c) { o0[c] = 0.f; o1[c] = 0.f; }
#pragma unroll
                for (int j = 0; j < 4; ++j) { const f32x4 wa = *(const f32x4*)(conv_w + (size_t)j * CONVC + col), wb = *(const f32x4*)(conv_w + (size_t)j * CONVC + col + 4);
#pragma unroll
                    for (int c = 0; c < 8; ++c) { const float w = c < 4 ? wa[c] : wb[c - 4]; o0[c] += w * raw[j][c]; o1[c] += w * raw[j + 1][c]; } }
                float s0 = 0.f, s1 = 0.f;
#pragma unroll
                for (int c = 0; c < 8; ++c) { o0[c] = silu_f(o0[c]); o1[c] = silu_f(o1[c]); s0 += o0[c] * o0[c]; s1 += o1[c] * o1[c]; }
                if (X < 2) { s0 = sum16(s0); s1 = sum16(s1); const float sc = X == 0 ? 0.08838834764831845f : 1.f; const float f0 = sc * __builtin_amdgcn_rsqf(s0 + GDN_EPS), f1 = sc * __builtin_amdgcn_rsqf(s1 + GDN_EPS);
#pragma unroll
                    for (int c = 0; c < 8; ++c) { o0[c] *= f0; o1[c] *= f1; } }
                LAS bf16* T = X == 0 ? Qs : (X == 1 ? Ks : Vs);
                v4u w0, w1; w0.x = pk2(o0[0], o0[1]); w0.y = pk2(o0[2], o0[3]); w0.z = pk2(o0[4], o0[5]); w0.w = pk2(o0[6], o0[7]);
                w1.x = pk2(o1[0], o1[1]); w1.y = pk2(o1[2], o1[3]); w1.z = pk2(o1[4], o1[5]); w1.w = pk2(o1[6], o1[7]);
                *(LAS v4u*)(T + tA * G2_TS + 8 * cgp) = w0; *(LAS v4u*)(T + (tA + 1) * G2_TS + 8 * cgp) = w1;
            }
            if (wid == 0) {
                float gv = g[(row0 + lane) * 16 + h];
#pragma unroll
                for (int o = 1; o < 64; o <<= 1) { const float t = __shfl_up(gv, o); if (lane >= o) gv += t; }
                gcs[lane] = gv; bts[lane] = beta[(row0 + lane) * 16 + h]; g[(row0 + lane) * 16 + h] = gv;
            }
        }
        __syncthreads();
        {
            const int rb = (wid >> 1) & 1, cb = wid & 1; const bool isA = wid < 4;
            f32x16 acc = {};
            if (!(rb == 0 && cb == 1)) {
                const LAS bf16* Ar = (isA ? Ks : Qs) + (32 * rb + r32) * G2_TS + 8 * hi; const LAS bf16* Br = Ks + (32 * cb + r32) * G2_TS + 8 * hi;
#pragma unroll
                for (int s = 0; s < 8; ++s) acc = MFMA32(*(const LAS bf16x8*)(Ar + 16 * s), *(const LAS bf16x8*)(Br + 16 * s), acc);
            }
            const int j = 32 * cb + r32; const float gj = gcs[j];
            bf16* at = attn + (size_t)u * 4096;
#pragma unroll
            for (int r = 0; r < 16; ++r) { const int i = 32 * rb + (r & 3) + 8 * (r >> 2) + 4 * hi; const float gi = gcs[i];
                if (isA) { const float d = (i > j) ? __expf(gi - gj) : 0.f; As[i * G2_AS + j] = (i > j) ? bts[i] * acc[r] * d : 0.f; }
                else { const float d = (i >= j) ? __expf(gi - gj) : 0.f; at[i * 64 + j] = (bf16)f2bf((i >= j) ? acc[r] * d : 0.f); } }
        }
        __syncthreads();
        if (wid < 4) {
            const int c = tid; float x[64]; const bool isK = c >= 128;
            const LAS bf16* src = isK ? Ks + (c - 128) : Vs + c;
#pragma unroll
            for (int i = 0; i < 64; ++i) { x[i] = bts[i] * bf2f(src[i * G2_TS]); if ((i & 7) == 7) asm volatile("" ::: "memory"); }
            if (isK) {
#pragma unroll
                for (int i = 0; i < 64; ++i) { x[i] *= __expf(gcs[i]); if ((i & 7) == 7) asm volatile("" ::: "memory"); }
            }
#pragma unroll
            for (int i = 1; i < 64; ++i) {
                float xi = x[i];
#pragma unroll
                for (int j4 = 0; j4 < (i + 3) / 4; ++j4) { const f32x4 a = *(const LAS f32x4*)(As + i * G2_AS + 4 * j4);
#pragma unroll
                    for (int k = 0; k < 4; ++k) if (4 * j4 + k < i) xi -= a[k] * x[4 * j4 + k]; }
                x[i] = xi;
                asm volatile("" ::: "memory");
            }
            if (c < 128) {
                bf16* dst = p + (row0 + (c & 63)) * GDN_MAIN + 4096 + h * HD + (c >> 6) * 64;
#pragma unroll
                for (int q = 0; q < 8; ++q) { v4u w; w.x = pk2(x[8 * q], x[8 * q + 1]); w.y = pk2(x[8 * q + 2], x[8 * q + 3]); w.z = pk2(x[8 * q + 4], x[8 * q + 5]); w.w = pk2(x[8 * q + 6], x[8 * q + 7]); *(v4u*)(dst + 8 * q) = w; }
            } else {
                bf16* dst = wbuf + row0 * DMODEL + h * HD + (c - 128);
#pragma unroll
                for (int i = 0; i < 64; ++i) dst[(size_t)i * DMODEL] = (bf16)f2bf(x[i]);
            }
        } else {
            const int tt = tid - 256;
            {
                const int cgp = tt & 15, r0 = tt >> 4;
#pragma unroll
                for (int r = 0; r < 4; ++r) { const int i = r0 + 16 * r; const float e = __expf(gcs[i]); const v4u v = *(const LAS v4u*)(Qs + i * G2_TS + 8 * cgp); v4u w;
                    w.x = pk2(bflo(v.x) * e, bfhi(v.x) * e); w.y = pk2(bflo(v.y) * e, bfhi(v.y) * e); w.z = pk2(bflo(v.z) * e, bfhi(v.z) * e); w.w = pk2(bflo(v.w) * e, bfhi(v.w) * e);
                    *(v4u*)(p + (row0 + i) * GDN_MAIN + h * HD + 8 * cgp) = w; }
            }
            {
                const int dk = tt & 127, th = tt >> 7; const float gl = gcs[63];
                bf16* dst = p + (row0 + (dk >> 1)) * GDN_MAIN + 2048 + h * HD + (dk & 1) * 64 + 32 * th;
#pragma unroll
                for (int q = 0; q < 4; ++q) { float v[8];
#pragma unroll
                    for (int k = 0; k < 8; ++k) { const int tk = 32 * th + 8 * q + k; v[k] = bf2f(Ks[tk * G2_TS + dk]) * __expf(gl - gcs[tk]); }
                    v4u w; w.x = pk2(v[0], v[1]); w.y = pk2(v[2], v[3]); w.z = pk2(v[4], v[5]); w.w = pk2(v[6], v[7]); *(v4u*)(dst + 8 * q) = w; }
            }
        }
        __syncthreads();
    }
}

constexpr int G3_STS = 136, G3_VTS = 72;
constexpr int G3_ST = 0, G3_VT = 64 * G3_STS * 2, G3_END = G3_VT + 64 * G3_VTS * 2;
__device__ __forceinline__ void gdn_scan_phase(LAS unsigned char* lds, bf16* p, const bf16* wbuf, const bf16* attn, const float* g, int vcu, int G) {
    int tid_ = threadIdx.x; asm volatile("" : "+v"(tid_));
    const int tid = tid_, lane = tid & 63, wid = __builtin_amdgcn_readfirstlane(tid >> 6), r32 = lane & 31, hi = lane >> 5;
    const int role = wid >> 2, a = (wid >> 1) & 1, bb = wid & 1, r = wid >> 1;
    LAS bf16* ST = (LAS bf16*)(lds + G3_ST); LAS bf16* VT = (LAS bf16*)(lds + G3_VT);
    for (int unit = vcu; unit < BATCH * NHEADS * 2; unit += G) {
        const int bh = unit >> 1, e = unit & 1, b = bh >> 4, h = bh & 15;
        for (int i = tid; i < G3_VT / 4; i += NWAVES * 64) ((LAS unsigned*)lds)[i] = 0u;
        f32x16 Sacc = {};
        __syncthreads();
        const bf16* aBase = role == 0 ? wbuf + (size_t)(32 * a + r32) * DMODEL + h * HD + 8 * hi : p + (size_t)(32 * a + r32) * GDN_MAIN + h * HD + 8 * hi;
        const size_t aPitch = role == 0 ? DMODEL : GDN_MAIN;
        const int dkr = 32 * r + r32;
        const bf16* kBase = p + (size_t)(dkr >> 1) * GDN_MAIN + 2048 + h * HD + (dkr & 1) * 64 + 8 * hi;
        const bf16* uBase = p + (size_t)(32 * bb + r32) * GDN_MAIN + 4096 + h * HD + e * 64 + 32 * a + 4 * hi;
        const bf16* pBase = attn + (size_t)(32 * a + r32) * 64 + 8 * hi;
        bf16* oBase = p + 4096 + h * HD + e * 64 + 32 * bb + r32;
        const LAS bf16* sRd = ST + (32 * bb + r32) * G3_STS + 8 * hi; const LAS bf16* vRd = VT + (32 * bb + r32) * G3_VTS + 8 * hi;
        LAS bf16* vWr = VT + (32 * bb + r32) * G3_VTS + 32 * a + 4 * hi; LAS bf16* sWr = ST + (32 * bb + r32) * G3_STS + 32 * r + 4 * hi;
#define G3_LOAD_A(nn) do { const size_t row0_ = (size_t)b * SEQ + (size_t)(nn) * 64; \
            _Pragma("unroll") for (int s = 0; s < 8; ++s) Af[s] = *(const bf16x8*)(aBase + row0_ * aPitch + 16 * s); } while (0)
#define G3_LOAD_U(nn) do { const size_t row0_ = (size_t)b * SEQ + (size_t)(nn) * 64; \
            _Pragma("unroll") for (int q = 0; q < 4; ++q) Uf[q] = *(const v2u*)(uBase + row0_ * GDN_MAIN + 8 * q); } while (0)
#define G3_LOAD_PK(nn) do { const size_t row0_ = (size_t)b * SEQ + (size_t)(nn) * 64; \
            if (role == 1) { const bf16* pp_ = pBase + ((size_t)(b * 64 + (nn)) * 16 + h) * 4096; _Pragma("unroll") for (int s = 0; s < 4; ++s) Pf[s] = *(const bf16x8*)(pp_ + 16 * s); } \
            _Pragma("unroll") for (int s = 0; s < 4; ++s) Kf[s] = *(const bf16x8*)(kBase + row0_ * GDN_MAIN + 16 * s); \
            dd = __expf(g[(row0_ + 63) * 16 + h]); } while (0)
        bf16x8 Af[8], Kf[4], Pf[4]; v2u Uf[4]; float dd;
#pragma unroll
        for (int s = 0; s < 4; ++s) { Pf[s] = (bf16x8){0, 0, 0, 0, 0, 0, 0, 0}; Uf[s] = (v2u){0u, 0u}; }
        G3_LOAD_A(0); if (role == 0) G3_LOAD_U(0); G3_LOAD_PK(0);
#pragma unroll 1
        for (int n = 0; n < 64; ++n) {
            const size_t row0_ = (size_t)b * SEQ + (size_t)n * 64; const int nn = (n + 1 < 64) ? n + 1 : n;
            f32x16 acc_ = {};
#pragma unroll
            for (int s = 0; s < 8; ++s) acc_ = MFMA32(Af[s], *(const LAS bf16x8*)(sRd + 16 * s), acc_);
            G3_LOAD_A(nn);
            if (role == 0) {
#pragma unroll
                for (int q = 0; q < 4; ++q) { v2u w_;
                    w_.x = pk2(bflo(Uf[q].x) - acc_[4 * q], bfhi(Uf[q].x) - acc_[4 * q + 1]); w_.y = pk2(bflo(Uf[q].y) - acc_[4 * q + 2], bfhi(Uf[q].y) - acc_[4 * q + 3]);
                    *(LAS v2u*)(vWr + 8 * q) = w_; }
                G3_LOAD_U(nn);
            }
            WG_BAR();
            bf16x8 Vf_[4];
#pragma unroll
            for (int s = 0; s < 4; ++s) Vf_[s] = *(const LAS bf16x8*)(vRd + 16 * s);
            if (role == 1) {
#pragma unroll
                for (int s = 0; s < 4; ++s) acc_ = MFMA32(Pf[s], Vf_[s], acc_);
#pragma unroll
                for (int rr = 0; rr < 16; ++rr) oBase[(row0_ + 32 * a + (rr & 3) + 8 * (rr >> 2) + 4 * hi) * GDN_MAIN] = (bf16)f2bf(acc_[rr]);
            }
            Sacc = Sacc * dd;
#pragma unroll
            for (int s = 0; s < 4; ++s) Sacc = MFMA32(Kf[s], Vf_[s], Sacc);
            G3_LOAD_PK(nn);
#pragma unroll
            for (int q = 0; q < 4; ++q) { v2u w_; w_.x = pk2(Sacc[4 * q], Sacc[4 * q + 1]); w_.y = pk2(Sacc[4 * q + 2], Sacc[4 * q + 3]); *(LAS v2u*)(sWr + 8 * q) = w_; }
            WG_BAR();
        }
#undef G3_LOAD_A
#undef G3_LOAD_U
#undef G3_LOAD_PK
        VM_WAIT(); __syncthreads();
    }
}

__device__ __forceinline__ void gdn_gate_phase(bf16* p, const float* norm_w, int gw, int NGW, int lane) {
    for (int m = gw; m < MROWS; m += NGW) {
        bf16* orow = p + (size_t)m * GDN_MAIN + 4096; const bf16* zrow = p + (size_t)m * GDN_MAIN + 6144;
#pragma unroll
        for (int it = 0; it < 4; ++it) { const int col = it * 512 + lane * 8;
            const v4u ov = *(const v4u*)(orow + col), zv = *(const v4u*)(zrow + col);
            float o[8] = {bflo(ov.x), bfhi(ov.x), bflo(ov.y), bfhi(ov.y), bflo(ov.z), bfhi(ov.z), bflo(ov.w), bfhi(ov.w)};
            float z[8] = {bflo(zv.x), bfhi(zv.x), bflo(zv.y), bfhi(zv.y), bflo(zv.z), bfhi(zv.z), bflo(zv.w), bfhi(zv.w)};
            float s = 0.f;
#pragma unroll
            for (int c = 0; c < 8; ++c) s += o[c] * o[c];
            s = sum16(s); const float rs = __builtin_amdgcn_rsqf(s * (1.f / HD) + GDN_EPS);
            const f32x4 wa = *(const f32x4*)(norm_w + (col & 127)), wb = *(const f32x4*)(norm_w + (col & 127) + 4);
#pragma unroll
            for (int c = 0; c < 8; ++c) o[c] = o[c] * rs * (c < 4 ? wa[c] : wb[c - 4]) * silu_f(z[c]);
            v4u w; w.x = pk2(o[0], o[1]); w.y = pk2(o[2], o[3]); w.z = pk2(o[4], o[5]); w.w = pk2(o[6], o[7]); *(v4u*)(orow + col) = w; }
    }
}

__device__ __forceinline__ void diff_combine_phase(const bf16* o0, const bf16* o1, bf16* og, const float* lam_params  , const float* subln_w, float lambda_init, int gw, int NGW, int lane) {
    const float e1 = wave_sum(lam_params[lane] * lam_params[64 + lane]), e2 = wave_sum(lam_params[128 + lane] * lam_params[192 + lane]);
    const float lam = __expf(e1) - __expf(e2) + lambda_init, post = 1.f - lambda_init;
    for (int m = gw; m < MROWS; m += NGW) {
#pragma unroll
        for (int it = 0; it < 4; ++it) { const int col = it * 512 + lane * 8; const size_t off = (size_t)m * DMODEL + col;
            const v4u av = *(const v4u*)(o0 + off), bv = *(const v4u*)(o1 + off);
            float d[8] = {bflo(av.x) - lam * bflo(bv.x), bfhi(av.x) - lam * bfhi(bv.x), bflo(av.y) - lam * bflo(bv.y), bfhi(av.y) - lam * bfhi(bv.y),
                          bflo(av.z) - lam * bflo(bv.z), bfhi(av.z) - lam * bfhi(bv.z), bflo(av.w) - lam * bflo(bv.w), bfhi(av.w) - lam * bfhi(bv.w)};
            float s = 0.f;
#pragma unroll
            for (int c = 0; c < 8; ++c) s += d[c] * d[c];
            s = sum16(s); const float rs = post * __builtin_amdgcn_rsqf(s * (1.f / HD) + SUBLN_EPS);
            const f32x4 wa = *(const f32x4*)(subln_w + (col & 127)), wb = *(const f32x4*)(subln_w + (col & 127) + 4);
#pragma unroll
            for (int c = 0; c < 8; ++c) d[c] = d[c] * rs * (c < 4 ? wa[c] : wb[c - 4]);
            v4u w; w.x = pk2(d[0], d[1]); w.y = pk2(d[2], d[3]); w.z = pk2(d[4], d[5]); w.w = pk2(d[6], d[7]); *(v4u*)(og + off) = w; }
    }
}
#ifndef PG8_SP2
#define PG8_SP2 true
#endif
#ifndef PG8_ALIGN
#define PG8_ALIGN true
#endif
#ifndef EN_P0
#define EN_P0 1
#endif
#ifndef EN_G1
#define EN_G1 1
#endif
#ifndef EN_G2
#define EN_G2 1
#endif
#ifndef EN_G3
#define EN_G3 1
#endif
#ifndef EN_G4
#define EN_G4 1
#endif
#ifndef EN_G5
#define EN_G5 1
#endif
#ifndef EN_G6
#define EN_G6 1
#endif
#ifndef EN_G7
#define EN_G7 1
#endif
#ifndef EN_G8
#define EN_G8 1
#endif
#ifndef EN_G9
#define EN_G9 1
#endif
#ifndef EN_D1
#define EN_D1 1
#endif
#ifndef EN_D2
#define EN_D2 1
#endif
#ifndef EN_D3
#define EN_D3 1
#endif
#ifndef EN_D4
#define EN_D4 1
#endif
#ifndef EN_D5
#define EN_D5 1
#endif
#ifndef EN_D6U
#define EN_D6U 1
#endif
#ifndef EN_D6D
#define EN_D6D 1
#endif
#ifndef EN_D7
#define EN_D7 1
#endif
struct Args { const float* in[16]; float* out; unsigned char* ws; int ph_lo, ph_hi; };
__global__ void __launch_bounds__(NWAVES * 64, 2) yoco_fwd(Args args) {
    extern __shared__ __attribute__((aligned(16))) unsigned char lds_raw[];
    LAS unsigned char* lds = (LAS unsigned char*)lds_raw;
    volatile LAS unsigned* MISC = (volatile LAS unsigned*)(lds + MISC_OFF);
    const int tid = threadIdx.x, lane = tid & 63, wave = __builtin_amdgcn_readfirstlane(tid >> 6);
    const int G = gridDim.x, bx = blockIdx.x, vcu = (G % 8 == 0) ? (bx % 8) * (G / 8) + bx / 8 : bx;
    const int gw = vcu * NWAVES + wave, NGW = G * NWAVES, gtid = vcu * NWAVES * 64 + tid, NGT = G * NWAVES * 64;
    const float* ln_g = args.in[14]; const float* ln_b = args.in[15];
    for (int u = tid; u < (LDS_BYTES - LDSCTL_OFF) / 4; u += NWAVES * 64) ((LAS unsigned*)(lds + LDSCTL_OFF))[u] = 0u;
    __syncthreads();
    XcdBarrier bar; bar.bar = (unsigned*)(args.ws + WS_CTL) + CW_BAR; bar.x = 0; bar.st = nullptr;
    if (!MK_PER_PHASE) bar = xcd_barrier_post((unsigned*)(args.ws + WS_CTL) + CW_BAR, MISC + 8);
    const int lo = args.ph_lo, hi = args.ph_hi;
#define IN(k) (lo <= (k) && (k) < hi)
#define FRESH_LANE() int ln_ = lane; asm volatile("" : "+v"(ln_)); unsigned char* ws_ = args.ws; asm volatile("" : "+s"(ws_))
#define x_in         (args.in[0])
#define gdn_w_in     (args.in[1])
#define gdn_conv_w   (args.in[2])
#define gdn_a_log    (args.in[3])
#define gdn_dt_bias  (args.in[4])
#define gdn_norm_w   (args.in[5])
#define gdn_w_out    (args.in[6])
#define diff_w_q     (args.in[7])
#define diff_lambda  (args.in[8])
#define diff_subln_w (args.in[9])
#define diff_w_o     (args.in[10])
#define shared_w_kv  (args.in[11])
#define mlp_w_up     (args.in[12])
#define mlp_w_down   (args.in[13])
#define ones  ((float*)(ws_ + WS_ONES))
#define zeros ((float*)(ws_ + WS_ZEROS))
#define mu    ((float*)(ws_ + WS_MU))
#define rstd  ((float*)(ws_ + WS_RSTD))
#define beta  ((float*)(ws_ + WS_BETA))
#define gdec  ((float*)(ws_ + WS_G))
#define halo  ((bf16*)(ws_ + WS_HALO))
#define WA    ((bf16*)(ws_ + WS_WA))
#define WB    ((bf16*)(ws_ + WS_WB))
#define attnb ((bf16*)(ws_ + WS_ATTN))
#define XB    ((bf16*)(ws_ + WS_XB))
#define Y     ((float*)(ws_ + WS_Y))
#define R1    ((bf16*)(ws_ + WS_R1))
#define Kb    (R1)
#define Vb    (R1 + QTR / 2)
#define Qb    (R1 + 2 * (QTR / 2))
#define O0    (R1 + 3 * (QTR / 2))
#define O1    (XB)
#define HID   (Qb)
#define SEAM(k) do { if (!MK_PER_PHASE && (k) + 1 < hi) xcd_barrier(bar); } while (0)

    if (EN_P0 && IN(0)) { FRESH_LANE();
        for (int i = gtid; i < DMODEL; i += NGT) { ones[i] = 1.f; zeros[i] = 0.f; }
        for (int i = gtid; i < MROWS; i += NGT) { mu[i] = 0.f; rstd[i] = 1.f; }
        for (int m = gw; m < MROWS; m += NGW) row_to_bf16(x_in + (size_t)m * DMODEL, XB + (size_t)m * DMODEL, ln_);
        convert_w(lds, gw, NGW, wave, ln_, gdn_w_in, DMODEL, GDN_PROJ, 0, GDN_PROJ, WA, 0);
        SEAM(0);
    }
    for (int l = 0; l < 2; ++l) {
        const int pb = 1 + 9 * l;
        if (EN_G1 && IN(pb + 0)) { FRESH_LANE();
            pg8::Gemm g{XB, WA, MROWS, GDN_MAIN, DMODEL, DMODEL}; pg8::StaticOrder S; S.init(MROWS, GDN_MAIN, G, bx);
            pg8::EpiStore<0> E{R1, GDN_MAIN, 0, 0, -1, 1.f, halo};
            pg8::gemm_phase<pg8::EpiStore<0>, pg8::StaticOrder, PG8_ALIGN, PG8_SP2>(lds + RING_OFF, g, S, E);
            ba_proj(XB, WA, gdn_a_log + l * 16, gdn_dt_bias + l * 16, beta, gdec, gw, NGW, ln_);
            SEAM(pb + 0);
        }
        if (EN_G2 && IN(pb + 1)) { FRESH_LANE(); gdn_chunk_phase(lds, R1, halo, beta, gdec, XB, attnb, gdn_conv_w + (size_t)l * 4 * CONVC, vcu, G); SEAM(pb + 1); }
        if (EN_G3 && IN(pb + 2)) { FRESH_LANE(); gdn_scan_phase(lds, R1, XB, attnb, gdec, vcu, G); SEAM(pb + 2); }
        if (EN_G4 && IN(pb + 3)) { FRESH_LANE();
            gdn_gate_phase(R1, gdn_norm_w + l * HD, gw, NGW, ln_);
            convert_w(lds, gw, NGW, wave, ln_, gdn_w_out + (size_t)l * DMODEL * DMODEL, DMODEL, DMODEL, 0, DMODEL, WA, 0);
            convert_w(lds, gw, NGW, wave, ln_, mlp_w_up + (size_t)l * DMODEL * DFF, DMODEL, DFF, 0, DFF, WB, 0);
            SEAM(pb + 3);
        }
        if (EN_G5 && IN(pb + 4)) { FRESH_LANE();
            pg8::Gemm g{R1 + 4096, WA, MROWS, DMODEL, DMODEL, GDN_MAIN}; pg8::StaticOrder S; S.init(MROWS, DMODEL, G, bx);
            const float* yin = (l == 0) ? x_in : Y; const float* xg = (l == 0) ? ones : ln_g + (size_t)((l - 1) * 2 + 1) * DMODEL; const float* xbt = (l == 0) ? zeros : ln_b + (size_t)((l - 1) * 2 + 1) * DMODEL;
            pg8::EpiResid E{yin, Y, mu, rstd, xg, xbt, DMODEL, ALPHA_RES};
            pg8::gemm_phase<pg8::EpiResid, pg8::StaticOrder, PG8_ALIGN, PG8_SP2>(lds + RING_OFF, g, S, E);
            SEAM(pb + 4);
        }
        const float* g1 = ln_g + (size_t)(l * 2) * DMODEL; const float* b1 = ln_b + (size_t)(l * 2) * DMODEL;
        if (EN_G6 && IN(pb + 5)) { FRESH_LANE();
            for (int m = gw; m < MROWS; m += NGW) ln_row(Y + (size_t)m * DMODEL, g1, b1, mu + m, rstd + m, XB + (size_t)m * DMODEL, nullptr, ln_);
            convert_w(lds, gw, NGW, wave, ln_, mlp_w_down + (size_t)l * DFF * DMODEL, DFF, DMODEL, 0, DMODEL, WA, 0);
            SEAM(pb + 5);
        }
        if (EN_G7 && IN(pb + 6)) { FRESH_LANE();
            pg8::Gemm g{XB, WB, MROWS, DFF, DMODEL, DMODEL}; pg8::StaticOrder S; S.init(MROWS, DFF, G, bx);
            pg8::EpiStore<1> E{R1, DFF, 0, 0, -1, 1.f, nullptr};
            pg8::gemm_phase<pg8::EpiStore<1>, pg8::StaticOrder, PG8_ALIGN, PG8_SP2>(lds + RING_OFF, g, S, E);
            SEAM(pb + 6);
        }
        if (EN_G8 && IN(pb + 7)) { FRESH_LANE();
            pg8::Gemm g{R1, WA, MROWS, DMODEL, DFF, DFF}; pg8::StaticOrder S; S.init(MROWS, DMODEL, G, bx);
            pg8::EpiResid E{Y, Y, mu, rstd, g1, b1, DMODEL, ALPHA_RES};
            pg8::gemm_phase<pg8::EpiResid, pg8::StaticOrder, PG8_ALIGN, PG8_SP2>(lds + RING_OFF, g, S, E);
            SEAM(pb + 7);
        }
        if (EN_G9 && IN(pb + 8)) { FRESH_LANE();
            const float* g2 = ln_g + (size_t)(l * 2 + 1) * DMODEL; const float* b2 = ln_b + (size_t)(l * 2 + 1) * DMODEL;
            for (int m = gw; m < MROWS; m += NGW) ln_row(Y + (size_t)m * DMODEL, g2, b2, mu + m, rstd + m, XB + (size_t)m * DMODEL, nullptr, ln_);
            if (l == 0) convert_w(lds, gw, NGW, wave, ln_, gdn_w_in + (size_t)DMODEL * GDN_PROJ, DMODEL, GDN_PROJ, 0, GDN_PROJ, WA, 0);
            else { convert_w(lds, gw, NGW, wave, ln_, shared_w_kv, DMODEL, 2 * DMODEL, 0, 2 * DMODEL, WA, 0);
                   convert_w(lds, gw, NGW, wave, ln_, diff_w_q, DMODEL, DMODEL, 0, DMODEL, WA, 2 * DMODEL); }
            SEAM(pb + 8);
        }
    }
    for (int j = 0; j < 2; ++j) {
        const int pb = 19 + 10 * j, L = 2 + j;
        const float* xg = ln_g + (size_t)((L - 1) * 2 + 1) * DMODEL; const float* xbt = ln_b + (size_t)((L - 1) * 2 + 1) * DMODEL;
        if (EN_D1 && IN(pb + 0)) { FRESH_LANE();
            const int N = (j == 0) ? 3 * DMODEL : DMODEL;
            pg8::Gemm g{XB, WA, MROWS, N, DMODEL, DMODEL}; pg8::StaticOrder S; S.init(MROWS, N, G, bx);
            pg8::EpiStore<0> E{(j == 0) ? Kb : Qb, DMODEL, (j == 0) ? DMODEL : 0, QTR / 2, (j == 0) ? 2 : 0, attn_body::C2, nullptr};
            pg8::gemm_phase<pg8::EpiStore<0>, pg8::StaticOrder, PG8_ALIGN, PG8_SP2>(lds + RING_OFF, g, S, E);
            SEAM(pb + 0);
        }
        if (EN_D2 && IN(pb + 1)) { FRESH_LANE();
            const attn_body::AttnTensors AT{(const attn_body::bf16*)Qb, (const attn_body::bf16*)Kb, (const attn_body::bf16*)Vb, (attn_body::bf16*)O0, (attn_body::bf16*)O1};
            const attn_body::StaticOrder S(G, bx);
            attn_body::attn_phase<attn_body::StaticOrder>((char*)lds_raw + RING_OFF, AT, S);
            SEAM(pb + 1);
        }
        if (EN_D3 && IN(pb + 2)) { FRESH_LANE();
            const float lambda_init = 0.8f - 0.6f * expf(-0.3f * (float)L);
            diff_combine_phase(O0, O1, Qb, diff_lambda + (size_t)j * 256, diff_subln_w + j * HD, lambda_init, gw, NGW, ln_);
            convert_w(lds, gw, NGW, wave, ln_, diff_w_o + (size_t)j * DMODEL * DMODEL, DMODEL, DMODEL, 0, DMODEL, WB, 0);
            convert_w(lds, gw, NGW, wave, ln_, mlp_w_up + (size_t)L * DMODEL * DFF, DMODEL, DFF, 0, DFF, WA, 0);
            SEAM(pb + 2);
        }
        if (EN_D4 && IN(pb + 3)) { FRESH_LANE();
            pg8::Gemm g{Qb, WB, MROWS, DMODEL, DMODEL, DMODEL}; pg8::StaticOrder S; S.init(MROWS, DMODEL, G, bx);
            pg8::EpiResid E{Y, Y, mu, rstd, xg, xbt, DMODEL, ALPHA_RES};
            pg8::gemm_phase<pg8::EpiResid, pg8::StaticOrder, PG8_ALIGN, PG8_SP2>(lds + RING_OFF, g, S, E);
            SEAM(pb + 3);
        }
        const float* g1 = ln_g + (size_t)(L * 2) * DMODEL; const float* b1 = ln_b + (size_t)(L * 2) * DMODEL;
        if (EN_D5 && IN(pb + 4)) { FRESH_LANE();
            for (int m = gw; m < MROWS; m += NGW) ln_row(Y + (size_t)m * DMODEL, g1, b1, mu + m, rstd + m, XB + (size_t)m * DMODEL, nullptr, ln_);
            convert_w(lds, gw, NGW, wave, ln_, mlp_w_down + (size_t)L * DFF * DMODEL, DFF, DMODEL, 0, DMODEL, WB, 0);
            SEAM(pb + 4);
        }
        for (int hf = 0; hf < 2; ++hf) {
            const size_t roff = (size_t)hf * (MROWS / 2);
            if (EN_D6U && IN(pb + 5 + 2 * hf)) { FRESH_LANE();
                pg8::Gemm g{XB + roff * DMODEL, WA, MROWS / 2, DFF, DMODEL, DMODEL}; pg8::StaticOrder S; S.init(MROWS / 2, DFF, G, bx);
                pg8::EpiStore<1> E{HID, DFF, 0, 0, -1, 1.f, nullptr};
                pg8::gemm_phase<pg8::EpiStore<1>, pg8::StaticOrder, PG8_ALIGN, PG8_SP2>(lds + RING_OFF, g, S, E);
                SEAM(pb + 5 + 2 * hf);
            }
            if (EN_D6D && IN(pb + 6 + 2 * hf)) { FRESH_LANE();
                pg8::Gemm g{HID, WB, MROWS / 2, DMODEL, DFF, DFF}; pg8::StaticOrder S; S.init(MROWS / 2, DMODEL, G, bx);
                pg8::EpiResid E{Y + roff * DMODEL, Y + roff * DMODEL, mu + roff, rstd + roff, g1, b1, DMODEL, ALPHA_RES};
                pg8::gemm_phase<pg8::EpiResid, pg8::StaticOrder, PG8_ALIGN, PG8_SP2>(lds + RING_OFF, g, S, E);
                SEAM(pb + 6 + 2 * hf);
            }
        }
        if (EN_D7 && IN(pb + 9)) { FRESH_LANE();
            const float* g2 = ln_g + (size_t)(L * 2 + 1) * DMODEL; const float* b2 = ln_b + (size_t)(L * 2 + 1) * DMODEL;
            if (j == 0) { for (int m = gw; m < MROWS; m += NGW) ln_row(Y + (size_t)m * DMODEL, g2, b2, mu + m, rstd + m, XB + (size_t)m * DMODEL, nullptr, ln_);
                          convert_w(lds, gw, NGW, wave, ln_, diff_w_q + (size_t)DMODEL * DMODEL, DMODEL, DMODEL, 0, DMODEL, WA, 0); }
            else { for (int m = gw; m < MROWS; m += NGW) ln_row(Y + (size_t)m * DMODEL, g2, b2, mu + m, rstd + m, nullptr, args.out + (size_t)m * DMODEL, ln_); }
            SEAM(pb + 9);
        }
    }
#undef IN
#undef SEAM
}

extern "C" void kernel_launch(void* const* d_in, const int* in_sizes, int n_in, void* d_out, int out_size, void* d_ws, size_t ws_size, hipStream_t stream) {
    static int grid = 0;
    if (grid == 0) {
        if (n_in != 16 || in_sizes[0] != MROWS * DMODEL || out_size != MROWS * DMODEL || ws_size < WS_END) { fprintf(stderr, "kernel_launch: unexpected shapes / workspace (n_in %d, ws %zu < %zu); nothing launched\n", n_in, ws_size, (size_t)WS_END); grid = -1; return; }
        int dev = 0, cus = 0, per_cu = 0;
        if (hipGetDevice(&dev) != hipSuccess || hipDeviceGetAttribute(&cus, hipDeviceAttributeMultiprocessorCount, dev) != hipSuccess) { grid = -1; return; }
        if (hipFuncSetAttribute((const void*)yoco_fwd, hipFuncAttributeMaxDynamicSharedMemorySize, LDS_BYTES) != hipSuccess) { fprintf(stderr, "kernel_launch: hipFuncSetAttribute failed\n"); grid = -1; return; }
        if (hipOccupancyMaxActiveBlocksPerMultiprocessor(&per_cu, (const void*)yoco_fwd, NWAVES * 64, LDS_BYTES) != hipSuccess || per_cu < 1)
            fprintf(stderr, "kernel_launch: note: occupancy query reports %d workgroups per CU\n", per_cu);
        (void)hipGetLastError();
        grid = cus;
    }
    if (grid < 0) return;
    if (hipMemsetAsync((char*)d_ws + WS_CTL, 0, CTL_ZERO_BYTES, stream) != hipSuccess) return;
    Args a{};
    for (int i = 0; i < 16; ++i) a.in[i] = (const float*)d_in[i];
    a.out = (float*)d_out; a.ws = (unsigned char*)d_ws;
#if MK_PER_PHASE
    for (int k = 0; k < N_PHASES; ++k) { a.ph_lo = k; a.ph_hi = k + 1; hipLaunchKernelGGL(yoco_fwd, dim3(grid), dim3(NWAVES * 64), LDS_BYTES, stream, a); }
#else
    a.ph_lo = 0; a.ph_hi = N_PHASES;
    hipLaunchKernelGGL(yoco_fwd, dim3(grid), dim3(NWAVES * 64), LDS_BYTES, stream, a);
#endif
    const hipError_t le = hipPeekAtLastError();
    if (le != hipSuccess) fprintf(stderr, "kernel_launch: launch failed: %s\n", hipGetErrorName(le));
}
```

```cpp
#include <hip/hip_runtime.h>
#include <hip/hip_bf16.h>
#include <cstdio>
#include <cstdint>
#include <cmath>

namespace pg8 {
#define PG8_LAS __attribute__((address_space(3)))
typedef unsigned short bf16_t;
typedef short bf16x8 __attribute__((ext_vector_type(8)));
typedef float f32x4 __attribute__((ext_vector_type(4)));
typedef unsigned u32x4 __attribute__((ext_vector_type(4)));
constexpr int BM = 256, BK = 64, HALF = 128, HTB = HALF * BK * 2  , STAGE_BYTES = 8 * HTB, NXCD = 8, WGM = 8;

__host__ __device__ __forceinline__ int lds_byte(int r, int c) { const int st = (r >> 4) * 2 + (c >> 5), rr = r & 15, cc = c & 31, ob = rr * 64 + cc * 2; return st * 1024 + (ob ^ (((ob >> 9) & 1) << 5)); }
__host__ __device__ __forceinline__ void stage_rc(int b, int& R, int& C) { const int st = b / 1024, sb = b % 1024, swz = sb ^ (((sb >> 9) & 1) << 5); R = (st >> 1) * 16 + swz / 64; C = (st & 1) * 32 + (swz % 64) / 2; }
__host__ __device__ __forceinline__ int perm32(int rho) { const int n = rho >> 4, i = rho & 15; return 8 * (i >> 2) + 4 * n + (i & 3); }

struct Unit { int pm, pn; };
struct Gemm { const bf16_t* A; const bf16_t* Bt; int M, N, K, lda; };

struct StaticOrder {
    int nM, nN, nwg, G, c;
    __host__ __device__ void init(int M, int N, int G_, int c_) { nM = M / BM; nN = N / BM; nwg = nM * nN; G = G_; c = c_; }
    __host__ __device__ bool next(int i, Unit& u) const {
        const long L = (long)i * G + c; if (L >= nwg) return false;
        int wgid = (int)L; { const int q = nwg / NXCD, r = nwg % NXCD, xcd = wgid % NXCD, off = wgid / NXCD; wgid = (xcd < r ? xcd * (q + 1) : r * (q + 1) + (xcd - r) * q) + off; }
        const int nig = WGM * nN, gid = wgid / nig, fm = gid * WGM, gsz = (nM - fm) < WGM ? (nM - fm) : WGM;
        u.pm = fm + ((wgid % nig) % gsz); u.pn = (wgid % nig) / gsz; return true;
    }
    __device__ __forceinline__ void a_ready(const Unit&) const {}
    __device__ __forceinline__ void done(const Unit&) const {}
};

__device__ __forceinline__ unsigned cvt_pk_bf16(float lo, float hi) { unsigned r; asm volatile("v_cvt_pk_bf16_f32 %0, %1, %2" : "=v"(r) : "v"(lo), "v"(hi)); return r; }

template <int ACT> struct EpiStore {
    static constexpr bool PERM = true, AFTER_DRAIN = false;
    bf16_t* O; int ldc; int split_cols; size_t split_stride; int scale_tile; float scale0; bf16_t* halo;
    __device__ __forceinline__ void operator()(const f32x4 (&acc)[2][2][4][2], const Unit& u, int wr, int wc, int fr, int fq) const {
        const int row0 = u.pm * BM + wr * 64 + fr; int colt = u.pn * BM; bf16_t* base = O;
        int t = 0; if (split_cols) { t = colt / split_cols; base += (size_t)t * split_stride; colt -= t * split_cols; }
        const float sc = (t == scale_tile) ? scale0 : 1.f;
        const int col0 = colt + wc * 32 + 8 * fq;
#pragma unroll
        for (int ai = 0; ai < 2; ++ai)
#pragma unroll
            for (int m = 0; m < 4; ++m) { const int row = row0 + ai * HALF + m * 16; bf16_t* rowp = base + (size_t)row * ldc + col0;
#pragma unroll
                for (int bj = 0; bj < 2; ++bj) { f32x4 v0 = acc[ai][bj][m][0], v1 = acc[ai][bj][m][1];
                    if (ACT == 1) {
#pragma unroll
                        for (int e = 0; e < 4; ++e) { const float a = fmaxf(v0[e], 0.f), b = fmaxf(v1[e], 0.f); v0[e] = a * a; v1[e] = b * b; } }
                    v0 = v0 * sc; v1 = v1 * sc; u32x4 w; w.x = cvt_pk_bf16(v0[0], v0[1]); w.y = cvt_pk_bf16(v0[2], v0[3]); w.z = cvt_pk_bf16(v1[0], v1[1]); w.w = cvt_pk_bf16(v1[2], v1[3]);
                    *(u32x4*)(rowp + bj * HALF) = w;
                    if (halo != nullptr && m == 3 && fr >= 13) { const int c = col0 + bj * HALF; if (c < 6144) *(u32x4*)(halo + ((size_t)(row >> 6) * 3 + (fr - 13)) * 6144 + c) = w; }
                } }
    }
};
struct EpiResid {
    static constexpr bool PERM = false, AFTER_DRAIN = false;
    const float* yin; float* yout; const float* mu; const float* rstd; const float* g; const float* b; int ldc; float alpha;
    __device__ __forceinline__ void operator()(const f32x4 (&acc)[2][2][4][2], const Unit& u, int wr, int wc, int fr, int fq) const {
        const int row0 = u.pm * BM + wr * 64 + fr; const int col0 = u.pn * BM + wc * 32 + 4 * fq;
        f32x4 gv[2][2], bv[2][2];
#pragma unroll
        for (int bj = 0; bj < 2; ++bj)
#pragma unroll
            for (int n = 0; n < 2; ++n) { gv[bj][n] = *(const f32x4*)(g + col0 + bj * HALF + n * 16); bv[bj][n] = *(const f32x4*)(b + col0 + bj * HALF + n * 16); }
#pragma unroll
        for (int ai = 0; ai < 2; ++ai)
#pragma unroll
            for (int m = 0; m < 4; ++m) { const int row = row0 + ai * HALF + m * 16; const float mr = mu[row], rs = rstd[row]; const size_t off = (size_t)row * ldc + col0;
#pragma unroll
                for (int bj = 0; bj < 2; ++bj)
#pragma unroll
                    for (int n = 0; n < 2; ++n) { const f32x4 yv = *(const f32x4*)(yin + off + bj * HALF + n * 16);
                        const f32x4 xv = ((yv - mr) * rs) * gv[bj][n] + bv[bj][n];
                        *(f32x4*)(yout + off + bj * HALF + n * 16) = xv * alpha + acc[ai][bj][m][n]; }
                if (m & 1) asm volatile("" ::: "memory"); }
    }
};

template <class Epi, class Sched, bool ALIGN_EPI = false, bool SP2 = false>
__device__ __forceinline__ void gemm_phase(PG8_LAS unsigned char* lds, const Gemm g, const Sched& S, const Epi& E) {
    int tid_ = threadIdx.x; asm volatile("" : "+v"(tid_));
    const int tid = tid_, wid = __builtin_amdgcn_readfirstlane(tid >> 6), lane = tid & 63, wr = wid >> 2, wc = wid & 3, fr = lane & 15, fq = lane >> 4;
    const int K = g.K, nt = K / BK, lda = g.lda;
    unsigned voffA[2], voffB[2];
#pragma unroll
    for (int i = 0; i < 2; ++i) { int R, C; stage_rc(tid * 16 + i * 8192, R, C); const int Rb = Epi::PERM ? ((R & ~31) + perm32(R & 31)) : R;
        voffA[i] = (unsigned)(R * lda + C) * 2u; voffB[i] = (unsigned)(Rb * K + C) * 2u; }
    const size_t kstep = (size_t)(BK * 2);
    const size_t hA = (size_t)HALF * lda * 2, hB = (size_t)HALF * K * 2;
    const size_t tA = 2 * hA, tB = 2 * hB;
    const unsigned ldsw = (unsigned)wid * 1024u;
    const int aoff = lds_byte(wr * 64 + fr, fq * 8), boff = lds_byte(wc * 32 + fr, fq * 8);
#define PG8_SA(b, h) (((b) * 2 + (h)) * HTB)
#define PG8_SB(b, h) ((4 + (b) * 2 + (h)) * HTB)
#define PG8_STAGE(bufoff, gbase, voff) do { _Pragma("unroll") for (int _i = 0; _i < 2; ++_i) \
        __builtin_amdgcn_global_load_lds((const unsigned*)((const char*)(gbase) + (voff)[_i]), (PG8_LAS unsigned*)(lds + (bufoff) + ldsw + _i * 8192), 16, 0, 0); } while (0)
#define PG8_LDA(dst, b, h) do { _Pragma("unroll") for (int m = 0; m < 4; ++m) _Pragma("unroll") for (int k = 0; k < 2; ++k) dst[m][k] = *(const PG8_LAS bf16x8*)(lds + PG8_SA(b, h) + aoff + m * 2048 + k * 1024); } while (0)
#define PG8_LDB(dst, b, h) do { _Pragma("unroll") for (int n = 0; n < 2; ++n) _Pragma("unroll") for (int k = 0; k < 2; ++k) dst[n][k] = *(const PG8_LAS bf16x8*)(lds + PG8_SB(b, h) + boff + n * 2048 + k * 1024); } while (0)
#define PG8_MMA(ai, bj, At, Bt) do { __builtin_amdgcn_s_setprio(1); _Pragma("unroll") for (int m = 0; m < 4; ++m) _Pragma("unroll") for (int n = 0; n < 2; ++n) _Pragma("unroll") for (int k = 0; k < 2; ++k) \
        acc[ai][bj][m][n] = __builtin_amdgcn_mfma_f32_16x16x32_bf16(Bt[n][k], At[m][k], acc[ai][bj][m][n], 0, 0, 0); __builtin_amdgcn_s_setprio(0); } while (0)
#define PG8_WAIT_V(n) asm volatile("s_waitcnt vmcnt(" #n ")" ::: "memory")
#define PG8_WAIT_L(n) asm volatile("s_waitcnt lgkmcnt(" #n ")" ::: "memory")
#define PG8_BAR __builtin_amdgcn_s_barrier()
#define PG8_SCHED __builtin_amdgcn_sched_barrier(0)
    Unit cur, nxt; int ui = 0;
    if (!S.next(0, cur)) return;
    f32x4 acc[2][2][4][2];
#pragma unroll
    for (int a = 0; a < 2; ++a)
#pragma unroll
        for (int b = 0; b < 2; ++b)
#pragma unroll
            for (int m = 0; m < 4; ++m)
#pragma unroll
                for (int n = 0; n < 2; ++n) acc[a][b][m][n] = (f32x4){0.f, 0.f, 0.f, 0.f};
    bf16x8 At[4][2], B0[2][2], B1[2][2];
    const char* cA = (const char*)g.A + (size_t)cur.pm * tA; const char* cB = (const char*)g.Bt + (size_t)cur.pn * tB;
    S.a_ready(cur);
    if constexpr (SP2) {
        PG8_STAGE(PG8_SB(0, 0), cB, voffB); PG8_STAGE(PG8_SB(0, 1), cB + hB, voffB); PG8_STAGE(PG8_SA(0, 0), cA, voffA); PG8_STAGE(PG8_SA(0, 1), cA + hA, voffA);
        if (wr == 1) PG8_BAR;
        PG8_WAIT_V(2); PG8_BAR;
        PG8_STAGE(PG8_SB(1, 0), cB + kstep, voffB); PG8_STAGE(PG8_SA(1, 0), cA + kstep, voffA); PG8_STAGE(PG8_SB(1, 1), cB + hB + kstep, voffB);
        PG8_WAIT_V(6); PG8_BAR;
    } else {
        PG8_STAGE(PG8_SB(0, 0), cB, voffB); PG8_STAGE(PG8_SA(0, 0), cA, voffA); PG8_STAGE(PG8_SB(0, 1), cB + hB, voffB); PG8_STAGE(PG8_SA(0, 1), cA + hA, voffA);
        if (wr == 1) PG8_BAR;
        PG8_WAIT_V(4); PG8_BAR;
        PG8_STAGE(PG8_SB(1, 0), cB + kstep, voffB); PG8_STAGE(PG8_SA(1, 0), cA + kstep, voffA); PG8_STAGE(PG8_SB(1, 1), cB + hB + kstep, voffB);
        PG8_WAIT_V(6); PG8_BAR;
    }
    for (;;) {
        const bool has_next = S.next(ui + 1, nxt);
        const char* nA = has_next ? (const char*)g.A + (size_t)nxt.pm * tA : cA; const char* nB = has_next ? (const char*)g.Bt + (size_t)nxt.pn * tB : cB;
        for (int t = 0; t < nt; t += 2) {
            const bool last = (t == nt - 2);
            const char* a1 = cA + (size_t)(t + 1) * kstep;
            const char* a2 = last ? nA : cA + (size_t)(t + 2) * kstep; const char* b2 = last ? nB : cB + (size_t)(t + 2) * kstep;
            const char* a3 = a2 + kstep; const char* b3 = b2 + kstep;
            if (last && has_next) S.a_ready(nxt);
            if constexpr (SP2) {
            PG8_LDB(B0, 0, 0); PG8_LDB(B1, 0, 1); PG8_SCHED; PG8_LDA(At, 0, 0); PG8_STAGE(PG8_SA(1, 1), a1 + hA, voffA);
            PG8_WAIT_V(8); PG8_WAIT_L(0); PG8_BAR; PG8_MMA(0, 0, At, B0); PG8_MMA(0, 1, At, B1); PG8_BAR; PG8_SCHED;
            PG8_LDA(At, 0, 1); PG8_STAGE(PG8_SB(0, 0), b2, voffB); PG8_STAGE(PG8_SB(0, 1), b2 + hB, voffB); PG8_STAGE(PG8_SA(0, 0), a2, voffA);
            PG8_WAIT_V(8); PG8_WAIT_L(0); PG8_BAR; PG8_MMA(1, 0, At, B0); PG8_MMA(1, 1, At, B1); PG8_BAR; PG8_SCHED;
            PG8_LDB(B0, 1, 0); PG8_LDB(B1, 1, 1); PG8_SCHED; PG8_LDA(At, 1, 0); PG8_STAGE(PG8_SA(0, 1), a2 + hA, voffA);
            PG8_WAIT_V(8); PG8_WAIT_L(0); PG8_BAR; PG8_MMA(0, 0, At, B0); PG8_MMA(0, 1, At, B1); PG8_BAR; PG8_SCHED;
            PG8_LDA(At, 1, 1); PG8_STAGE(PG8_SB(1, 0), b3, voffB); PG8_STAGE(PG8_SB(1, 1), b3 + hB, voffB); PG8_STAGE(PG8_SA(1, 0), a3, voffA);
            PG8_WAIT_V(8); PG8_WAIT_L(0); PG8_BAR; PG8_MMA(1, 0, At, B0); PG8_MMA(1, 1, At, B1); PG8_BAR; PG8_SCHED;
            } else {
            PG8_LDB(B0, 0, 0); PG8_SCHED; PG8_LDA(At, 0, 0); PG8_STAGE(PG8_SA(1, 1), a1 + hA, voffA);
            PG8_WAIT_L(8); PG8_BAR; PG8_WAIT_L(0); PG8_MMA(0, 0, At, B0); PG8_BAR; PG8_SCHED;
            PG8_LDB(B1, 0, 1); PG8_STAGE(PG8_SB(0, 0), b2, voffB);
            PG8_BAR; PG8_WAIT_L(0); PG8_MMA(0, 1, At, B1); PG8_BAR;
            PG8_LDA(At, 0, 1); PG8_STAGE(PG8_SA(0, 0), a2, voffA);
            PG8_BAR; PG8_WAIT_L(0); PG8_MMA(1, 0, At, B0); PG8_BAR; PG8_SCHED;
            PG8_STAGE(PG8_SB(0, 1), b2 + hB, voffB);
            PG8_WAIT_V(6); PG8_BAR; PG8_MMA(1, 1, At, B1); PG8_BAR;
            PG8_LDB(B0, 1, 0); PG8_SCHED; PG8_LDA(At, 1, 0); PG8_STAGE(PG8_SA(0, 1), a2 + hA, voffA);
            PG8_WAIT_L(8); PG8_BAR; PG8_WAIT_L(0); PG8_MMA(0, 0, At, B0); PG8_BAR; PG8_SCHED;
            PG8_LDB(B1, 1, 1); PG8_STAGE(PG8_SB(1, 0), b3, voffB);
            PG8_BAR; PG8_WAIT_L(0); PG8_MMA(0, 1, At, B1); PG8_BAR;
            PG8_LDA(At, 1, 1); PG8_STAGE(PG8_SA(1, 0), a3, voffA);
            PG8_BAR; PG8_WAIT_L(0); PG8_MMA(1, 0, At, B0); PG8_BAR; PG8_SCHED;
            PG8_STAGE(PG8_SB(1, 1), b3 + hB, voffB);
            PG8_WAIT_V(6); PG8_BAR; PG8_MMA(1, 1, At, B1); PG8_BAR;
            }
        }
        if constexpr (ALIGN_EPI) { if (wr == 0) PG8_BAR; }
        if constexpr (!Epi::AFTER_DRAIN) { E(acc, cur, wr, wc, fr, fq); S.done(cur); }
        if (!has_next) break;
#pragma unroll
        for (int a = 0; a < 2; ++a)
#pragma unroll
            for (int b = 0; b < 2; ++b)
#pragma unroll
                for (int m = 0; m < 4; ++m)
#pragma unroll
                    for (int n = 0; n < 2; ++n) acc[a][b][m][n] = (f32x4){0.f, 0.f, 0.f, 0.f};
        cur = nxt; cA = nA; cB = nB; ++ui;
        if constexpr (ALIGN_EPI) { if (wr == 1) PG8_BAR; }
    }
    PG8_WAIT_V(0);
    if constexpr (!ALIGN_EPI) { if (wr == 0) PG8_BAR; }
    PG8_BAR;
#undef PG8_SA
#undef PG8_SB
#undef PG8_STAGE
#undef PG8_LDA
#undef PG8_LDB
#undef PG8_MMA
#undef PG8_WAIT_V
#undef PG8_WAIT_L
#undef PG8_BAR
#undef PG8_SCHED
}
}
#include <hip/hip_bf16.h>
namespace attn_body {
using bf16=__hip_bfloat16;
using bf16x8=__attribute__((ext_vector_type(8)))short;
using s16x4=__attribute__((ext_vector_type(4)))short;
using f32x16=__attribute__((ext_vector_type(16)))float;
using u32x4=__attribute__((ext_vector_type(4)))unsigned;
constexpr int BATCH=8,SEQ=4096,D=64,DM=2048;
constexpr int NW=8,QBLK=32,QB=QBLK*NW,KVBLK=64,NQB=SEQ/QB;
constexpr int ATTN_PITCH=DM, ATTN_UNIT_ROWS=QB;
__device__ __forceinline__ int crow(int r,int hi){return (r&3)+8*(r>>2)+4*hi;}
#define SBAR() __builtin_amdgcn_sched_barrier(0)
__device__ __forceinline__ void cmask(f32x16&p0,f32x16&p1,int jb,int qrel,int hi){
  const float NEG=-INFINITY; int kb=64*jb+4*hi;
  #pragma unroll
  for(int r=0;r<16;++r){int kv=kb+(r&3)+8*(r>>2); if(kv>qrel)p0[r]=NEG; if(kv+32>qrel)p1[r]=NEG;}
}

constexpr int NSLOT=3, SLOTB=8192;
constexpr int LDS_K=0, LDS_V=NSLOT*SLOTB, LDS_WS=2*NSLOT*SLOTB, LDS_OST=LDS_WS+NW*64*4, LDS_BYTES=LDS_OST+NW*4096;
constexpr float C2=0.125f*1.4426950408889634f;
__device__ __forceinline__ void glds16(const void*gsrc,unsigned lds_dst){unsigned keep;
  asm volatile("s_mov_b32 %0, m0\n\ts_mov_b32 m0, %2\n\ts_nop 0\n\tglobal_load_lds_dwordx4 %1, off\n\ts_mov_b32 m0, %0":"=&s"(keep):"v"(gsrc),"s"(lds_dst):"memory");}
__device__ __forceinline__ float max3f(float a,float b,float c){float r;asm("v_max3_f32 %0, %1, %2, %3":"=v"(r):"v"(a),"v"(b),"v"(c));return r;}
__device__ __forceinline__ float max2f(float a,float b){float r;asm("v_max_f32_e32 %0, %1, %2":"=v"(r):"v"(a),"v"(b));return r;}
__device__ __forceinline__ float fadd_s(float a,float b){float r;asm("v_add_f32_e32 %0, %1, %2":"=v"(r):"v"(a),"v"(b));return r;}
__device__ __forceinline__ float fsub_s(float a,float b){float r;asm("v_sub_f32_e32 %0, %1, %2":"=v"(r):"v"(a),"v"(b));return r;}
typedef float f32x2_t __attribute__((ext_vector_type(2))); typedef __bf16 bf16x2_t __attribute__((ext_vector_type(2)));
__device__ __forceinline__ unsigned cvtpk_s(float lo,float hi){f32x2_t v={lo,hi};bf16x2_t b=__builtin_convertvector(v,bf16x2_t);return __builtin_bit_cast(unsigned,b);}
#define WAIT_BAR(N) asm volatile("s_waitcnt vmcnt(" #N ") lgkmcnt(0)\n\ts_barrier":::"memory")

__device__ __forceinline__ void qkt(f32x16&p0,f32x16&p1,const char*Kslot,const bf16x8*qr,const f32x16&negm,int r32,int hi){
  const char*kb=Kslot+hi*1024+r32*16;
  #pragma unroll
  for(int d0=0;d0<4;++d0){
    const bf16x8 b0=*reinterpret_cast<const bf16x8*>(kb+d0*2048);
    const bf16x8 b1=*reinterpret_cast<const bf16x8*>(kb+d0*2048+512);
    if(d0==0){p0=__builtin_amdgcn_mfma_f32_32x32x16_bf16(b0,qr[0],negm,0,0,0);p1=__builtin_amdgcn_mfma_f32_32x32x16_bf16(b1,qr[0],negm,0,0,0);}
    else{p0=__builtin_amdgcn_mfma_f32_32x32x16_bf16(b0,qr[d0],p0,0,0,0);p1=__builtin_amdgcn_mfma_f32_32x32x16_bf16(b1,qr[d0],p1,0,0,0);}}
}
typedef __attribute__((address_space(3))) const char* lds_cptr;
typedef short v4i16_t __attribute__((ext_vector_type(4)));
__device__ __forceinline__ void kload8(bf16x8*kf,lds_cptr kp){
  kf[0]=*(const __attribute__((address_space(3))) bf16x8*)(kp);      kf[1]=*(const __attribute__((address_space(3))) bf16x8*)(kp+512);
  kf[2]=*(const __attribute__((address_space(3))) bf16x8*)(kp+2048); kf[3]=*(const __attribute__((address_space(3))) bf16x8*)(kp+2560);
  kf[4]=*(const __attribute__((address_space(3))) bf16x8*)(kp+4096); kf[5]=*(const __attribute__((address_space(3))) bf16x8*)(kp+4608);
  kf[6]=*(const __attribute__((address_space(3))) bf16x8*)(kp+6144); kf[7]=*(const __attribute__((address_space(3))) bf16x8*)(kp+6656);
}
__device__ __forceinline__ void kload2(bf16x8*kf,lds_cptr kp,int j){ kf[2*j]=*(const __attribute__((address_space(3))) bf16x8*)(kp+j*2048); kf[2*j+1]=*(const __attribute__((address_space(3))) bf16x8*)(kp+j*2048+512); }
__device__ __forceinline__ s16x4 vtr(lds_cptr p){ return __builtin_bit_cast(s16x4,__builtin_amdgcn_ds_read_tr16_b64_v4i16((__attribute__((address_space(3))) v4i16_t*)p)); }
__device__ __forceinline__ float rowmax(const f32x16&p0,const f32x16&p1){
  float a=max3f(p0[0],p0[1],p1[0]),b=max3f(p0[2],p0[3],p1[1]);a=max3f(a,p1[2],p1[3]);
  #pragma unroll
  for(int r=4;r<16;r+=4){a=max3f(a,p0[r],p0[r+1]);b=max3f(b,p0[r+2],p0[r+3]);a=max3f(a,p1[r],p1[r+1]);b=max3f(b,p1[r+2],p1[r+3]);}
  const float m=max2f(a,b);
  auto rr=__builtin_amdgcn_permlane32_swap(__float_as_uint(m),__float_as_uint(m),false,false);
  return max2f(__uint_as_float(rr[0]),__uint_as_float(rr[1]));
}
__device__ __forceinline__ void pv(f32x16*o,int vb,bf16x8 pa0,bf16x8 pa1,bf16x8 pa2,bf16x8 pa3){
  #pragma unroll
  for(int d0=0;d0<2;++d0){s16x4 lo[4],hi[4];
    #pragma unroll
    for(int ks=0;ks<4;++ks){
      asm volatile("ds_read_b64_tr_b16 %0,%1 offset:%c2":"=&v"(lo[ks]):"v"(vb),"i"(d0*4096+ks*1024):"memory");
      asm volatile("ds_read_b64_tr_b16 %0,%1 offset:%c2":"=&v"(hi[ks]):"v"(vb),"i"(d0*4096+ks*1024+512):"memory");}
    asm volatile("s_waitcnt lgkmcnt(0)":::"memory");SBAR();
    #define PK(k) (bf16x8){lo[k][0],lo[k][1],lo[k][2],lo[k][3],hi[k][0],hi[k][1],hi[k][2],hi[k][3]}
    o[d0]=__builtin_amdgcn_mfma_f32_32x32x16_bf16(pa0,PK(0),o[d0],0,0,0);
    o[d0]=__builtin_amdgcn_mfma_f32_32x32x16_bf16(pa1,PK(1),o[d0],0,0,0);
    o[d0]=__builtin_amdgcn_mfma_f32_32x32x16_bf16(pa2,PK(2),o[d0],0,0,0);
    o[d0]=__builtin_amdgcn_mfma_f32_32x32x16_bf16(pa3,PK(3),o[d0],0,0,0);
    #undef PK
  }
}

#ifndef ATTN_STORE16
#define ATTN_STORE16(p,v) (*(u32x4*)(p)=(v))
#endif
template<int THRL> __device__ __forceinline__ void attn_unit(int b,int qkcol,int vcol,int ocol,int qb,const bf16*Q,const bf16*__restrict__ K,const bf16*__restrict__ V,bf16*O,char*shm){
  int tid_=threadIdx.x; asm volatile("":"+v"(tid_));
  const int tid=tid_,lane=tid&63,r32=lane&31,hi=lane>>5; const int wid=__builtin_amdgcn_readfirstlane(tid>>6);
  const long rowbase=(long)b*SEQ; const int q0=qb*QB;
  const bf16*Qw=Q+(rowbase+q0+wid*QBLK)*DM+qkcol;
  const bf16*Kh=K+rowbase*DM+qkcol,*Vh=V+rowbase*DM+vcol;
  const unsigned lds0=(unsigned)(uintptr_t)shm;
  float*wsf=(float*)(shm+LDS_WS)+wid*64;
  const bf16*ksrc=Kh+(long)lane*DM+wid*8;
  const bf16*vsrc=Vh+(long)(16*(wid&3)+(lane>>2))*DM+(wid>>2)*32+(lane&3)*8;
  const unsigned kdst=lds0+LDS_K+wid*1024, vdst=lds0+LDS_V+wid*1024;
  #define DMA_K(t,slot) glds16(ksrc+(long)(t)*KVBLK*DM,(unsigned)__builtin_amdgcn_readfirstlane(kdst+(slot)))
  #define DMA_V(t,slot) glds16(vsrc+(long)(t)*KVBLK*DM,(unsigned)__builtin_amdgcn_readfirstlane(vdst+(slot)))
  const int vb0=(int)(lds0+LDS_V)+((lane>>4)&1)*32+(lane&3)*8+(4*hi+((lane&15)>>2))*64;
  const char*Kbase=shm+LDS_K; bf16x8 kf[8];
  const lds_cptr shm3=(lds_cptr)shm; const lds_cptr kp0=shm3+LDS_K+hi*1024+r32*16; const lds_cptr vp0=shm3+LDS_V+((lane>>4)&1)*32+(lane&3)*8+(4*hi+((lane&15)>>2))*64;
  const int NT=(q0+QB)/KVBLK;
  DMA_K(0,0);DMA_V(0,0);DMA_K(1,SLOTB);
  bf16x8 qr[4];
  #pragma unroll
  for(int d0=0;d0<4;++d0)qr[d0]=*reinterpret_cast<const bf16x8*>(&Qw[(long)r32*DM+d0*16+hi*8]);
  float mhat=0.f,l_reg=0.f;f32x16 o[2];o[0]=f32x16{};o[1]=f32x16{};f32x16 negm=f32x16{};asm volatile("":"+v"(negm));
  const int qrel=wid*QBLK+r32;
  #define CMASK(P0,P1,t) do{int jb_=(t)-(NT-4); if(jb_>=0)cmask(P0,P1,jb_,qrel,hi);}while(0)
  bool resc=false;
  #define START(P0,P1) do{ const float rm=rowmax(P0,P1); resc=false; \
    { const float dl=rm; mhat=fadd_s(mhat,dl); \
      _Pragma("unroll") for(int r=0;r<16;++r){P0[r]=fsub_s(P0[r],dl);P1[r]=fsub_s(P1[r],dl);} \
      _Pragma("unroll") for(int r=0;r<16;++r)negm[r]=-mhat; asm volatile("":"+v"(negm)); } \
    _Pragma("unroll") for(int r=0;r<16;++r)P0[r]=__builtin_amdgcn_exp2f(P0[r]); }while(0)
  #define RESC() do{ if(resc){ asm volatile("s_waitcnt lgkmcnt(0)":::"memory"); \
      _Pragma("unroll") for(int d_=0;d_<2;++d_) _Pragma("unroll") for(int r=0;r<16;++r)o[d_][r]*=wsf[crow(r,hi)]; } }while(0)
  f32x16 pA0,pA1,pB0,pB1;
  int sl_prev=0,sl_cur=0,sl_next=SLOTB;
  #define ROT() do{sl_prev=sl_cur;sl_cur=sl_next;sl_next=(sl_next==(NSLOT-1)*SLOTB)?0:sl_next+SLOTB;}while(0)
  DMA_K(2,2*SLOTB);
  WAIT_BAR(3);
  qkt(pA0,pA1,Kbase,qr,negm,r32,hi);asm volatile("s_nop 15\n\ts_nop 7":"+v"(pA0),"+v"(pA1));CMASK(pA0,pA1,0);
  START(pA0,pA1);
  _Pragma("unroll") for(int r=0;r<16;++r)pA1[r]=__builtin_amdgcn_exp2f(pA1[r]);
  WAIT_BAR(0);
  DMA_K(3,0);DMA_V(1,SLOTB);
  ROT();
  kload8(kf,kp0+sl_cur);
  WAIT_BAR(2);
  s16x4 vlo[8],vhi[8]; u32x4 pw0,pw1,pw2,pw3;
  #define PKW(P,B) cvtpk_s(P[B],P[B+1])
  #define PAF(k) __builtin_bit_cast(bf16x8,pw##k)
  #define VFR(i) (bf16x8){vlo[i][0],vlo[i][1],vlo[i][2],vlo[i][3],vhi[i][0],vhi[i][1],vhi[i][2],vhi[i][3]}
  #define PIN(x) asm volatile("":"+v"(x))
  #define MX3(a,b,c) __builtin_fmaxf(__builtin_fmaxf((a),(b)),(c))
  #define GAPA(MF,A0,A1,A2,A3,W0,W1,PW) do{ MF; sacc+=A0; sacc+=A1; sacc+=A2; sacc+=A3; PIN(sacc); W0; W1; PIN(PW); SBAR(); }while(0)
  #define EX(v) __builtin_amdgcn_exp2f(v)
  #define GAPB(MF,X,B) do{ MF; X[B]=EX(X[B]); X[B+1]=EX(X[B+1]); X[B+2]=EX(X[B+2]); X[B+3]=EX(X[B+3]); PIN(X); SBAR(); }while(0)
  #define VRD(i) do{ vlo[i]=vtr(vp_+(((i)>>2)*4096+((i)&3)*1024)); vhi[i]=vtr(vp_+(((i)>>2)*4096+((i)&3)*1024+512)); }while(0)
  #define KRD(G,j) do{ if(G){ kload2(kf,kp0+sl_next,j); SBAR(); } }while(0)
  #define STEP(C0,C1,P0,P1,t,GK,GV,GL) do{ SBAR(); \
    const lds_cptr vp_=vp0+sl_prev; \
    VRD(0); SBAR(); float sacc=(P0[0]+P0[1]); \
    GAPA(C0=__builtin_amdgcn_mfma_f32_32x32x16_bf16(kf[0],qr[0],negm,0,0,0), P0[2],P0[3],P0[4],P0[5],     pw0[0]=PKW(P0,0), pw0[1]=PKW(P0,2), pw0); \
    VRD(4); SBAR(); GAPA(C1=__builtin_amdgcn_mfma_f32_32x32x16_bf16(kf[1],qr[0],negm,0,0,0), P0[6],P0[7],P0[8],P0[9],     pw0[2]=PKW(P0,4), pw0[3]=PKW(P0,6), pw0); \
    VRD(1); SBAR(); GAPA(C0=__builtin_amdgcn_mfma_f32_32x32x16_bf16(kf[2],qr[1],C0,0,0,0),   P0[10],P0[11],P0[12],P0[13], pw1[0]=PKW(P0,8), pw1[1]=PKW(P0,10), pw1); \
    VRD(5); SBAR(); GAPA(C1=__builtin_amdgcn_mfma_f32_32x32x16_bf16(kf[3],qr[1],C1,0,0,0),   P0[14],P0[15],P1[0],P1[1],   pw1[2]=PKW(P0,12),pw1[3]=PKW(P0,14), pw1); \
    VRD(2); SBAR(); GAPA(C0=__builtin_amdgcn_mfma_f32_32x32x16_bf16(kf[4],qr[2],C0,0,0,0),   P1[2],P1[3],P1[4],P1[5],     pw2[0]=PKW(P1,0), pw2[1]=PKW(P1,2), pw2); \
    VRD(6); SBAR(); GAPA(C1=__builtin_amdgcn_mfma_f32_32x32x16_bf16(kf[5],qr[2],C1,0,0,0),   P1[6],P1[7],P1[8],P1[9],     pw2[2]=PKW(P1,4), pw2[3]=PKW(P1,6), pw2); \
    VRD(3); SBAR(); GAPA(C0=__builtin_amdgcn_mfma_f32_32x32x16_bf16(kf[6],qr[3],C0,0,0,0),   P1[10],P1[11],P1[12],P1[13], pw3[0]=PKW(P1,8), pw3[1]=PKW(P1,10), pw3); \
    VRD(7); SBAR(); GAPA(C1=__builtin_amdgcn_mfma_f32_32x32x16_bf16(kf[7],qr[3],C1,0,0,0),   P1[14],P1[15],0.f,0.f,       pw3[2]=PKW(P1,12),pw3[3]=PKW(P1,14), pw3); \
    l_reg+=sacc; \
    if(GK){DMA_K((t)+3,sl_cur);} if(GV){DMA_V((t)+1,sl_next);} \
    CMASK(C0,C1,t); \
    { float a=MX3(C0[0],C0[1],C1[0]),b=MX3(C0[2],C0[3],C1[1]); a=MX3(a,C1[2],C1[3]); \
      _Pragma("unroll") for(int r=4;r<16;r+=4){a=MX3(a,C0[r],C0[r+1]);b=MX3(b,C0[r+2],C0[r+3]);a=MX3(a,C1[r],C1[r+1]);b=MX3(b,C1[r+2],C1[r+3]);} \
      float rm=__builtin_fmaxf(a,b); { auto rr=__builtin_amdgcn_permlane32_swap(__float_as_uint(rm),__float_as_uint(rm),false,false); rm=__builtin_fmaxf(__uint_as_float(rr[0]),__uint_as_float(rr[1])); } \
      resc=false; \
      if(__builtin_expect(__any(rm>(float)THRL),0)){ const float dl=__builtin_fmaxf(rm,0.f); mhat+=dl; \
        _Pragma("unroll") for(int r=0;r<16;++r){C0[r]-=dl;C1[r]-=dl;} \
        _Pragma("unroll") for(int r=0;r<16;++r)negm[r]=-mhat; asm volatile("":"+v"(negm)); \
        const float f=__builtin_amdgcn_exp2f(-dl); l_reg*=f; if(hi==0)wsf[r32]=f; resc=true; } } \
    SBAR(); \
    GAPB(o[0]=__builtin_amdgcn_mfma_f32_32x32x16_bf16(PAF(0),VFR(0),o[0],0,0,0), C0,0); \
    GAPB(o[1]=__builtin_amdgcn_mfma_f32_32x32x16_bf16(PAF(0),VFR(4),o[1],0,0,0), C0,4); \
    KRD(GL,0); GAPB(o[0]=__builtin_amdgcn_mfma_f32_32x32x16_bf16(PAF(1),VFR(1),o[0],0,0,0), C0,8); \
    KRD(GL,1); GAPB(o[1]=__builtin_amdgcn_mfma_f32_32x32x16_bf16(PAF(1),VFR(5),o[1],0,0,0), C0,12); \
    KRD(GL,2); GAPB(o[0]=__builtin_amdgcn_mfma_f32_32x32x16_bf16(PAF(2),VFR(2),o[0],0,0,0), C1,0); \
    KRD(GL,3); GAPB(o[1]=__builtin_amdgcn_mfma_f32_32x32x16_bf16(PAF(2),VFR(6),o[1],0,0,0), C1,4); \
    GAPB(o[0]=__builtin_amdgcn_mfma_f32_32x32x16_bf16(PAF(3),VFR(3),o[0],0,0,0), C1,8); \
    GAPB(o[1]=__builtin_amdgcn_mfma_f32_32x32x16_bf16(PAF(3),VFR(7),o[1],0,0,0), C1,12); \
    }while(0)
  int t=1;
  #undef CMASK
  #define CMASK(P0,P1,t) do{}while(0)
  for(;t+5<NT;t+=2){
    STEP(pB0,pB1,pA0,pA1,t,true,true,true);     WAIT_BAR(2); RESC(); ROT();
    STEP(pA0,pA1,pB0,pB1,t+1,true,true,true);   WAIT_BAR(2); RESC(); ROT();
  }
  #undef CMASK
  #define CMASK(P0,P1,t) do{int jb_=(t)-(NT-4); if(jb_>=0)cmask(P0,P1,jb_,qrel,hi);}while(0)
  #define ENDW(tt) do{ if((tt)+3<NT){WAIT_BAR(2);} else if((tt)+2<NT){WAIT_BAR(1);} else {WAIT_BAR(0);} }while(0)
  for(;t+1<NT;t+=2){
    STEP(pB0,pB1,pA0,pA1,t,(t+3<NT),(t+1<NT),(t+1<NT));       ENDW(t);   RESC(); ROT();
    STEP(pA0,pA1,pB0,pB1,t+1,(t+4<NT),(t+2<NT),(t+2<NT));     ENDW(t+1); RESC(); ROT();
  }
  STEP(pB0,pB1,pA0,pA1,NT-1,false,false,false); RESC();
  { float sacc=pB0[0]+pB0[1]; _Pragma("unroll") for(int r=2;r<16;++r)sacc+=pB0[r]; _Pragma("unroll") for(int r=0;r<16;++r)sacc+=pB1[r]; l_reg+=sacc;
    pw0=(u32x4){PKW(pB0,0),PKW(pB0,2),PKW(pB0,4),PKW(pB0,6)};pw1=(u32x4){PKW(pB0,8),PKW(pB0,10),PKW(pB0,12),PKW(pB0,14)};pw2=(u32x4){PKW(pB1,0),PKW(pB1,2),PKW(pB1,4),PKW(pB1,6)};pw3=(u32x4){PKW(pB1,8),PKW(pB1,10),PKW(pB1,12),PKW(pB1,14)};
    SBAR(); pv(o,vb0+sl_cur,PAF(0),PAF(1),PAF(2),PAF(3)); }
  #undef PKW
  #undef PAF
  #undef VFR
  #undef PIN
  #undef MX3
  #undef GAPA
  #undef GAPB
  #undef EX
  #undef VRD
  #undef KRD
  #undef STEP
  #undef ENDW
  {auto rr=__builtin_amdgcn_permlane32_swap(__float_as_uint(l_reg),__float_as_uint(l_reg),false,false);l_reg=__uint_as_float(rr[0])+__uint_as_float(rr[1]);}
  if(hi==0)wsf[32+r32]=l_reg;asm volatile("s_waitcnt lgkmcnt(0)":::"memory");
  float rli[16];
  #pragma unroll
  for(int r=0;r<16;++r)rli[r]=__builtin_amdgcn_rcpf(wsf[32+crow(r,hi)]);
  bf16*Ow=O+(rowbase+q0+wid*QBLK)*DM+ocol;
  { bf16*stg=(bf16*)(shm+LDS_OST)+wid*2048;
    #pragma unroll
    for(int r=0;r<16;++r){const int orow=crow(r,hi);
      #pragma unroll
      for(int d0=0;d0<2;++d0)stg[orow*64+d0*32+r32]=__float2bfloat16(o[d0][r]*rli[r]);}
    asm volatile("s_waitcnt lgkmcnt(0)":::"memory");
    #pragma unroll
    for(int i=0;i<4;++i){const int row=i*8+(lane>>3),ch=lane&7; const u32x4 v=*(const u32x4*)(stg+row*64+ch*8); ATTN_STORE16(Ow+(long)row*DM+ch*8,v);} }
  asm volatile("s_waitcnt lgkmcnt(0)\n\ts_barrier":::"memory");
  #undef DMA_K
  #undef DMA_V
  #undef CMASK
  #undef START
  #undef RESC
  #undef ROT
}
constexpr int ATTN_LDS_BYTES=LDS_BYTES;
struct AttnTensors { const bf16* Q; const bf16* K; const bf16* V; bf16* O0; bf16* O1; };
struct AttnUnit { int b, h, c, e, qb; };
struct StaticOrder {
  int vcu, G;
  __device__ __forceinline__ explicit StaticOrder(int grid,int block):vcu((grid%8==0)?(block%8)*(grid/8)+block/8:block),G(grid){}
  __device__ __forceinline__ bool next(int i,AttnUnit&u)const{ const int per=32; const int trip=vcu+(i/per)*G; if(trip>=BATCH*16*2)return false; const int j=i%per;
    u.b=trip>>5; u.h=(trip>>1)&15; u.c=trip&1; u.e=j>>4; u.qb=15-(j&15); return true; }
  __device__ __forceinline__ void a_ready(const AttnUnit&)const{}
  __device__ __forceinline__ void done(const AttnUnit&)const{}
};
template<class Sched,int THRL=8> __device__ __forceinline__ void attn_phase(char*lds,const AttnTensors&T,const Sched&S){
  AttnUnit u;
  for(int i=0;S.next(i,u);++i){ S.a_ready(u); attn_unit<THRL>(u.b,u.h*128+u.c*64,u.h*128+u.e*64,u.h*128+u.e*64,u.qb,T.Q,T.K,T.V,u.c?T.O1:T.O0,lds); S.done(u); }
}
#undef SBAR
#undef WAIT_BAR
}

constexpr int NWAVES = 8;
#ifndef MK_PER_PHASE
#define MK_PER_PHASE 0
#endif

constexpr int BATCH = 8, SEQ = 4096, DMODEL = 2048, MROWS = BATCH * SEQ, DFF = 8192, NHEADS = 16, HD = 128;
constexpr int GDN_PROJ = 8224, GDN_MAIN = 8192, CONVC = 6144, NCG = MROWS / 64;
constexpr float ALPHA_RES = 1.6817928305074292f;
constexpr float LN_EPS = 1e-5f, GDN_EPS = 1e-6f, SUBLN_EPS = 1e-5f;
constexpr int N_PHASES = 39;

constexpr size_t MiB = 1u << 20;
constexpr size_t WS_CTL = 0, CTL_ZERO_BYTES = 1 * MiB;
constexpr size_t WS_ONES = 1 * MiB, WS_ZEROS = WS_ONES + 8192, WS_MU = WS_ONES + 65536, WS_RSTD = WS_MU + 131072;
constexpr size_t WS_BETA = 2 * MiB, WS_G = 4 * MiB;
constexpr size_t WS_HALO = 9 * MiB;
constexpr size_t WS_WA = 27 * MiB, WS_WB = 60 * MiB;
constexpr size_t WS_ATTN = 27 * MiB;
constexpr size_t WS_XB = 92 * MiB;
constexpr size_t WS_Y = 220 * MiB;
constexpr size_t WS_R1 = 476 * MiB;
constexpr size_t WS_END = 988 * MiB;
constexpr size_t QTR = 128 * MiB;
constexpr int CW_TMO = 0;
constexpr int CW_BAR = 4096;

constexpr int RING_OFF = 0, RING_BYTES = 131072;
constexpr int LDSCTL_OFF = RING_BYTES, MISC_OFF = LDSCTL_OFF + 320;
constexpr int LDS_BYTES = 147456;
static_assert(MISC_OFF + 128 <= LDS_BYTES, "LDS map");

#define GAS __attribute__((address_space(1)))
#define LAS __attribute__((address_space(3)))
typedef unsigned short bf16;
typedef unsigned v4u __attribute__((ext_vector_type(4)));
typedef unsigned v2u __attribute__((ext_vector_type(2)));
typedef float f32x4 __attribute__((ext_vector_type(4)));
typedef float f32x16 __attribute__((ext_vector_type(16)));
typedef short bf16x8 __attribute__((ext_vector_type(8)));
typedef GAS unsigned gu32;
typedef GAS unsigned long long gu64;
#define RLX_AGENT __ATOMIC_RELAXED, __HIP_MEMORY_SCOPE_AGENT
#define LDS_WAIT() asm volatile("s_waitcnt lgkmcnt(0)" ::: "memory")
#define VM_WAIT() asm volatile("s_waitcnt vmcnt(0)" ::: "memory")
#define WG_BAR() asm volatile("s_waitcnt lgkmcnt(0)\n\ts_barrier" ::: "memory")
__device__ __forceinline__ unsigned f2bf(float f) { unsigned u = __builtin_bit_cast(unsigned, f); return (u + 0x7fffu + ((u >> 16) & 1u)) >> 16; }
__device__ __forceinline__ unsigned pk2(float lo, float hi) { return f2bf(lo) | (f2bf(hi) << 16); }
__device__ __forceinline__ float bflo(unsigned w) { return __builtin_bit_cast(float, w << 16); }
__device__ __forceinline__ float bfhi(unsigned w) { return __builtin_bit_cast(float, w & 0xffff0000u); }
__device__ __forceinline__ float bf2f(bf16 h) { return __builtin_bit_cast(float, (unsigned)h << 16); }
__device__ __forceinline__ float fast_exp(float x) { return __builtin_amdgcn_exp2f(x * 1.4426950408889634f); }
__device__ __forceinline__ float silu_f(float x) { return x * __builtin_amdgcn_rcpf(1.f + __expf(-x)); }

#define XB_TMO      128
#define XB_XCNT(j)  (256  + 64 * (j))
#define XB_XSUB(j)  (1280 + 64 * (j))
#define XB_XGEN(j)  (2304 + 64 * (j))
#define XB_TOP      3328
#define XB_TOPGEN   3392
#define XCD_BAR_WORDS 3456
#define XB_SPIN_CAP (1u << 18)

__device__ __forceinline__ unsigned xb_ld(unsigned* p)              { return __hip_atomic_load(p, __ATOMIC_RELAXED, __HIP_MEMORY_SCOPE_AGENT); }
__device__ __forceinline__ unsigned xb_add(unsigned* p, unsigned v) { return __hip_atomic_fetch_add(p, v, __ATOMIC_RELAXED, __HIP_MEMORY_SCOPE_AGENT); }
__device__ __forceinline__ unsigned xb_xcc_id() { return (unsigned)__builtin_amdgcn_s_getreg((3 << 11) | 20) & 0xFu; }
#define XB_SPIN(cond, bar) do { unsigned _sp = 0; while (cond) { __builtin_amdgcn_s_sleep(1); \
    if ((++_sp & 255u) == 0u) { if (xb_ld(&(bar)[XB_TMO])) break; if (_sp > XB_SPIN_CAP) { atomicAdd(&(bar)[XB_TMO], 1u); break; } } } } while (0)

struct XcdBarrier {
    unsigned* bar; unsigned x;
    volatile LAS unsigned* st;
};
__device__ __forceinline__ XcdBarrier xcd_barrier_post(unsigned* bar, volatile LAS unsigned* st) {
    XcdBarrier b; b.bar = bar; b.x = xb_xcc_id(); b.st = st;
    if (threadIdx.x == 0) (void)xb_add(&bar[XB_XCNT(b.x)], 1u);
    return b;
}
__device__ __forceinline__ void xcd_barrier_complete(unsigned* bar, unsigned x, unsigned& nloc, unsigned& nx) {
    const unsigned G = gridDim.x * gridDim.y * gridDim.z;
    unsigned sum, cnt, mine, sp = 0u;
    for (;;) {
        sum = 0u; cnt = 0u; mine = 0u;
#pragma unroll
        for (unsigned j = 0; j < 16; ++j) { const unsigned c = xb_ld(&bar[XB_XCNT(j)]); sum += c; cnt += (c > 0u) ? 1u : 0u; mine = (j == x) ? c : mine; }
        if (sum == G) break;
        __builtin_amdgcn_s_sleep(1);
        if ((++sp & 255u) == 0u) { if (xb_ld(&bar[XB_TMO])) break; if (sp > XB_SPIN_CAP) { atomicAdd(&bar[XB_TMO], 1u); break; } }
    }
    nloc = mine > 0u ? mine : 1u; nx = cnt > 0u ? cnt : 1u;
}
__device__ __forceinline__ void xcd_barrier(const XcdBarrier& b) {
    asm volatile("s_waitcnt vmcnt(0)" ::: "memory");
    __syncthreads();
    if (threadIdx.x == 0) {
        unsigned* bar = b.bar;
        __builtin_amdgcn_s_waitcnt(0);
        unsigned nloc = b.st[0], nx = b.st[1];
        if (nloc == 0u) { xcd_barrier_complete(bar, b.x, nloc, nx); b.st[0] = nloc; b.st[1] = nx; }
        const unsigned old = xb_add(&bar[XB_XSUB(b.x)], 1u);
        const unsigned gen = old / nloc;
        if (old + 1u == (gen + 1u) * nloc) {
            __builtin_amdgcn_fence(__ATOMIC_RELEASE, "agent");
            asm volatile("s_waitcnt vmcnt(0)" ::: "memory");
            const unsigned og = xb_add(&bar[XB_TOP], 1u);
            const unsigned tg = og / nx;
            if (og + 1u == (tg + 1u) * nx) xb_add(&bar[XB_TOPGEN], 1u);
            else XB_SPIN(xb_ld(&bar[XB_TOPGEN]) == tg, bar);
            __builtin_amdgcn_fence(__ATOMIC_ACQUIRE, "agent");
            xb_add(&bar[XB_XGEN(b.x)], 1u);
            asm volatile("s_waitcnt vmcnt(0)" ::: "memory");
        } else {
            XB_SPIN(xb_ld(&bar[XB_XGEN(b.x)]) == gen, bar);
            __builtin_amdgcn_fence(__ATOMIC_ACQUIRE, "agent");
            asm volatile("s_waitcnt vmcnt(0)" ::: "memory");
        }
    }
    __syncthreads();
}

__device__ __forceinline__ float wave_sum(float v) {
#pragma unroll
    for (int o = 1; o < 64; o <<= 1) v += __shfl_xor(v, o);
    return v;
}
__device__ __forceinline__ float sum16(float v) {
    v += __shfl_xor(v, 1); v += __shfl_xor(v, 2); v += __shfl_xor(v, 4); v += __shfl_xor(v, 8); return v;
}
__device__ __forceinline__ void transpose_item(const float* W, int K, int ldw, int n_begin, int nblk, bf16* WT, int row_off, LAS float* scr, int item, int lane) {
    const int kb = item / nblk, nb = item % nblk, k0 = 64 * kb, n0 = 32 * nb;
#pragma unroll 8
    for (int i = 0; i < 32; ++i) { const int kk = 2 * i + (lane >> 5); scr[kk * 33 + (lane & 31)] = W[(size_t)(k0 + kk) * ldw + n_begin + n0 + (lane & 31)]; }
    LDS_WAIT(); asm volatile("" ::: "memory");
    const int c = lane & 7;
#pragma unroll
    for (int j = 0; j < 4; ++j) { const int n = (lane >> 3) + 8 * j; const LAS float* s = scr + (8 * c) * 33 + n;
        v4u o; o.x = pk2(s[0 * 33], s[1 * 33]); o.y = pk2(s[2 * 33], s[3 * 33]); o.z = pk2(s[4 * 33], s[5 * 33]); o.w = pk2(s[6 * 33], s[7 * 33]);
        *(GAS v4u*)(WT + (size_t)(row_off + n0 + n) * K + k0 + 8 * c) = o; }
    LDS_WAIT(); asm volatile("" ::: "memory");
}
__device__ __forceinline__ void convert_w(LAS unsigned char* lds, int gw, int NGW, int wave, int lane, const float* W, int K, int ldw, int n_begin, int ncols, bf16* WT, int row_off) {
    LAS float* scr = (LAS float*)(lds + RING_OFF + wave * 16384);
    const int nblk = ncols / 32, nitems = (K / 64) * nblk;
    for (int it = gw; it < nitems; it += NGW) transpose_item(W, K, ldw, n_begin, nblk, WT, row_off, scr, it, lane);
}
__device__ __forceinline__ void row_to_bf16(const float* xrow, bf16* orow, int lane) {
    const GAS f32x4* xr = (const GAS f32x4*)xrow + lane; GAS v2u* o8 = (GAS v2u*)orow + lane;
#pragma unroll
    for (int j = 0; j < 8; ++j) { const f32x4 v = xr[64 * j]; v2u w; w.x = pk2(v.x, v.y); w.y = pk2(v.z, v.w); o8[64 * j] = w; }
}
__device__ __forceinline__ void ln_row(const float* yrow, const float* g, const float* b, float* mu, float* rstd, bf16* xbrow, float* outrow, int lane) {
    const GAS f32x4* yr = (const GAS f32x4*)yrow + lane;
    f32x4 v[8]; float s = 0.f;
#pragma unroll
    for (int j = 0; j < 8; ++j) { v[j] = yr[64 * j]; s += (v[j].x + v[j].y) + (v[j].z + v[j].w); }
    const float mean = wave_sum(s) * (1.f / DMODEL); float s2 = 0.f;
#pragma unroll
    for (int j = 0; j < 8; ++j) { v[j] = v[j] - mean; s2 += (v[j].x * v[j].x + v[j].y * v[j].y) + (v[j].z * v[j].z + v[j].w * v[j].w); }
    const float rs = 1.f / sqrtf(wave_sum(s2) * (1.f / DMODEL) + LN_EPS);
    if (lane == 0) { *mu = mean; *rstd = rs; }
    const GAS f32x4* gr = (const GAS f32x4*)g + lane; const GAS f32x4* br = (const GAS f32x4*)b + lane;
#pragma unroll
    for (int j = 0; j < 8; ++j) { const f32x4 o = (v[j] * rs) * gr[64 * j] + br[64 * j];
        if (xbrow) { v2u w; w.x = pk2(o.x, o.y); w.y = pk2(o.z, o.w); ((GAS v2u*)xbrow + lane)[64 * j] = w; }
        if (outrow) ((GAS f32x4*)outrow + lane)[64 * j] = o; }
}
#define MFMA32(a, b, c) __builtin_amdgcn_mfma_f32_32x32x16_bf16((a), (b), (c), 0, 0, 0)

__device__ __forceinline__ void ba_proj(const bf16* xb, const bf16* wt  , const float* a_log, const float* dt_bias, float* beta, float* g, int gw, int NGW, int lane) {
    const int r32 = lane & 31, hi = lane >> 5;
    for (int wu = gw; wu < MROWS / 32; wu += NGW) {
        const bf16* ap = xb + (size_t)(wu * 32 + r32) * DMODEL + 8 * hi; const bf16* bp = wt + (size_t)(GDN_MAIN + r32) * DMODEL + 8 * hi;
        f32x16 acc = {};
#pragma unroll 1
        for (int s0 = 0; s0 < DMODEL / 16; s0 += 8) {
            bf16x8 a[8], b[8];
#pragma unroll
            for (int s = 0; s < 8; ++s) { a[s] = *(const bf16x8*)(ap + (s0 + s) * 16); b[s] = *(const bf16x8*)(bp + (s0 + s) * 16); }
#pragma unroll
            for (int s = 0; s < 8; ++s) acc = MFMA32(a[s], b[s], acc);
        }
        const int j = r32 & 15; const float al = -__expf(a_log[j]), db = dt_bias[j];
#pragma unroll
        for (int r = 0; r < 16; ++r) { const int t = wu * 32 + (r & 3) + 8 * (r >> 2) + 4 * hi; const float v = acc[r];
            if (r32 < 16) beta[(size_t)t * 16 + j] = __builtin_amdgcn_rcpf(1.f + __expf(-v));
            else { const float z = v + db; const float sp = z > 20.f ? z : log1pf(__expf(z)); g[(size_t)t * 16 + j] = al * sp; } }
    }
}

constexpr int G2_TS = 136;
constexpr int G2_AS = 68, G2_A = 0, G2_GC = G2_A + 64 * G2_AS * 4, G2_BT = G2_GC + 256, G2_Q = G2_BT + 256, G2_K = G2_Q + 64 * G2_TS * 2, G2_V = G2_K + 64 * G2_TS * 2, G2_END = G2_V + 64 * G2_TS * 2;
static_assert(G2_END <= RING_BYTES, "G2 LDS");
__device__ __forceinline__ void gdn_chunk_phase(LAS unsigned char* lds, bf16* p, const bf16* halo, const float* beta, float* g, bf16* wbuf, bf16* attn, const float* conv_w, int vcu, int G) {
    int tid_ = threadIdx.x; asm volatile("" : "+v"(tid_));
    const int tid = tid_, lane = tid & 63, wid = __builtin_amdgcn_readfirstlane(tid >> 6), r32 = lane & 31, hi = lane >> 5;
    LAS bf16* Qs = (LAS bf16*)(lds + G2_Q); LAS bf16* Ks = (LAS bf16*)(lds + G2_K); LAS bf16* Vs = (LAS bf16*)(lds + G2_V);
    LAS float* As = (LAS float*)(lds + G2_A); LAS float* gcs = (LAS float*)(lds + G2_GC); LAS float* bts = (LAS float*)(lds + G2_BT);
    asm volatile("" : "+v"(Qs), "+v"(Ks), "+v"(Vs), "+v"(As), "+v"(gcs), "+v"(bts));
    for (int u = vcu; u < NCG * NHEADS; u += G) {
        const int cg = u >> 4, h = u & 15, n = cg & 63; const size_t row0 = (size_t)cg * 64;
        {
            const int cgp = lane & 15, sub = lane >> 4, tA = 8 * wid + 2 * sub;
#pragma unroll
            for (int X = 0; X < 3; ++X) {
                const int col = X * 2048 + h * HD + 8 * cgp;
                float raw[5][8];
#pragma unroll
                for (int rr = 0; rr < 5; ++rr) { const int rel = tA - 3 + rr; v4u v = {0u, 0u, 0u, 0u};
                    if (rel >= 0) v = *(const v4u*)(p + (row0 + rel) * GDN_MAIN + col);
                    else if (n > 0) v = *(const v4u*)(halo + ((size_t)(cg - 1) * 3 + (rel + 3)) * CONVC + col);
                    raw[rr][0] = bflo(v.x); raw[rr][1] = bfhi(v.x); raw[rr][2] = bflo(v.y); raw[rr][3] = bfhi(v.y); raw[rr][4] = bflo(v.z); raw[rr][5] = bfhi(v.z); raw[rr][6] = bflo(v.w); raw[rr][7] = bfhi(v.w); }
                float o0[8], o1[8];
#pragma unroll
                for (int c = 0; c < 8; ++c) { o0[c] = 0.f; o1[c] = 0.f; }
#pragma unroll
                for (int j = 0; j < 4; ++j) { const f32x4 wa = *(const f32x4*)(conv_w + (size_t)j * CONVC + col), wb = *(const f32x4*)(conv_w + (size_t)j * CONVC + col + 4);
#pragma unroll
                    for (int c = 0; c < 8; ++c) { const float w = c < 4 ? wa[c] : wb[c - 4]; o0[c] += w * raw[j][c]; o1[c] += w * raw[j + 1][c]; } }
                float s0 = 0.f, s1 = 0.f;
#pragma unroll
                for (int c = 0; c < 8; ++c) { o0[c] = silu_f(o0[c]); o1[c] = silu_f(o1[c]); s0 += o0[c] * o0[c]; s1 += o1[c] * o1[c]; }
                if (X < 2) { s0 = sum16(s0); s1 = sum16(s1); const float sc = X == 0 ? 0.08838834764831845f : 1.f; const float f0 = sc * __builtin_amdgcn_rsqf(s0 + GDN_EPS), f1 = sc * __builtin_amdgcn_rsqf(s1 + GDN_EPS);
#pragma unroll
                    for (int c = 0; c < 8; ++c) { o0[c] *= f0; o1[c] *= f1; } }
                LAS bf16* T = X == 0 ? Qs : (X == 1 ? Ks : Vs);
                v4u w0, w1; w0.x = pk2(o0[0], o0[1]); w0.y = pk2(o0[2], o0[3]); w0.z = pk2(o0[4], o0[5]); w0.w = pk2(o0[6], o0[7]);
                w1.x = pk2(o1[0], o1[1]); w1.y = pk2(o1[2], o1[3]); w1.z = pk2(o1[4], o1[5]); w1.w = pk2(o1[6], o1[7]);
                *(LAS v4u*)(T + tA * G2_TS + 8 * cgp) = w0; *(LAS v4u*)(T + (tA + 1) * G2_TS + 8 * cgp) = w1;
            }
            if (wid == 0) {
                float gv = g[(row0 + lane) * 16 + h];
#pragma unroll
                for (int o = 1; o < 64; o <<= 1) { const float t = __shfl_up(gv, o); if (lane >= o) gv += t; }
                gcs[lane] = gv; bts[lane] = beta[(row0 + lane) * 16 + h]; g[(row0 + lane) * 16 + h] = gv;
            }
        }
        __syncthreads();
        {
            const int rb = (wid >> 1) & 1, cb = wid & 1; const bool isA = wid < 4;
            f32x16 acc = {};
            if (!(rb == 0 && cb == 1)) {
                const LAS bf16* Ar = (isA ? Ks : Qs) + (32 * rb + r32) * G2_TS + 8 * hi; const LAS bf16* Br = Ks + (32 * cb + r32) * G2_TS + 8 * hi;
#pragma unroll
                for (int s = 0; s < 8; ++s) acc = MFMA32(*(const LAS bf16x8*)(Ar + 16 * s), *(const LAS bf16x8*)(Br + 16 * s), acc);
            }
            const int j = 32 * cb + r32; const float gj = gcs[j];
            bf16* at = attn + (size_t)u * 4096;
#pragma unroll
            for (int r = 0; r < 16; ++r) { const int i = 32 * rb + (r & 3) + 8 * (r >> 2) + 4 * hi; const float gi = gcs[i];
                if (isA) { const float d = (i > j) ? __expf(gi - gj) : 0.f; As[i * G2_AS + j] = (i > j) ? bts[i] * acc[r] * d : 0.f; }
                else { const float d = (i >= j) ? __expf(gi - gj) : 0.f; at[i * 64 + j] = (bf16)f2bf((i >= j) ? acc[r] * d : 0.f); } }
        }
        __syncthreads();
        if (wid < 4) {
            const int c = tid; float x[64]; const bool isK = c >= 128;
            const LAS bf16* src = isK ? Ks + (c - 128) : Vs + c;
#pragma unroll
            for (int i = 0; i < 64; ++i) { x[i] = bts[i] * bf2f(src[i * G2_TS]); if ((i & 7) == 7) asm volatile("" ::: "memory"); }
            if (isK) {
#pragma unroll
                for (int i = 0; i < 64; ++i) { x[i] *= __expf(gcs[i]); if ((i & 7) == 7) asm volatile("" ::: "memory"); }
            }
#pragma unroll
            for (int i = 1; i < 64; ++i) {
                float xi = x[i];
#pragma unroll
                for (int j4 = 0; j4 < (i + 3) / 4; ++j4) { const f32x4 a = *(const LAS f32x4*)(As + i * G2_AS + 4 * j4);
#pragma unroll
                    for (int k = 0; k < 4; ++k) if (4 * j4 + k < i) xi -= a[k] * x[4 * j4 + k]; }
                x[i] = xi;
                asm volatile("" ::: "memory");
            }
            if (c < 128) {
                bf16* dst = p + (row0 + (c & 63)) * GDN_MAIN + 4096 + h * HD + (c >> 6) * 64;
#pragma unroll
                for (int q = 0; q < 8; ++q) { v4u w; w.x = pk2(x[8 * q], x[8 * q + 1]); w.y = pk2(x[8 * q + 2], x[8 * q + 3]); w.z = pk2(x[8 * q + 4], x[8 * q + 5]); w.w = pk2(x[8 * q + 6], x[8 * q + 7]); *(v4u*)(dst + 8 * q) = w; }
            } else {
                bf16* dst = wbuf + row0 * DMODEL + h * HD + (c - 128);
#pragma unroll
                for (int i = 0; i < 64; ++i) dst[(size_t)i * DMODEL] = (bf16)f2bf(x[i]);
            }
        } else {
            const int tt = tid - 256;
            {
                const int cgp = tt & 15, r0 = tt >> 4;
#pragma unroll
                for (int r = 0; r < 4; ++r) { const int i = r0 + 16 * r; const float e = __expf(gcs[i]); const v4u v = *(const LAS v4u*)(Qs + i * G2_TS + 8 * cgp); v4u w;
                    w.x = pk2(bflo(v.x) * e, bfhi(v.x) * e); w.y = pk2(bflo(v.y) * e, bfhi(v.y) * e); w.z = pk2(bflo(v.z) * e, bfhi(v.z) * e); w.w = pk2(bflo(v.w) * e, bfhi(v.w) * e);
                    *(v4u*)(p + (row0 + i) * GDN_MAIN + h * HD + 8 * cgp) = w; }
            }
            {
                const int dk = tt & 127, th = tt >> 7; const float gl = gcs[63];
                bf16* dst = p + (row0 + (dk >> 1)) * GDN_MAIN + 2048 + h * HD + (dk & 1) * 64 + 32 * th;
#pragma unroll
                for (int q = 0; q < 4; ++q) { float v[8];
#pragma unroll
                    for (int k = 0; k < 8; ++k) { const int tk = 32 * th + 8 * q + k; v[k] = bf2f(Ks[tk * G2_TS + dk]) * __expf(gl - gcs[tk]); }
                    v4u w; w.x = pk2(v[0], v[1]); w.y = pk2(v[2], v[3]); w.z = pk2(v[4], v[5]); w.w = pk2(v[6], v[7]); *(v4u*)(dst + 8 * q) = w; }
            }
        }
        __syncthreads();
    }
}

constexpr int G3_STS = 136, G3_VTS = 72;
constexpr int G3_ST = 0, G3_VT = 64 * G3_STS * 2, G3_END = G3_VT + 64 * G3_VTS * 2;
__device__ __forceinline__ void gdn_scan_phase(LAS unsigned char* lds, bf16* p, const bf16* wbuf, const bf16* attn, const float* g, int vcu, int G) {
    int tid_ = threadIdx.x; asm volatile("" : "+v"(tid_));
    const int tid = tid_, lane = tid & 63, wid = __builtin_amdgcn_readfirstlane(tid >> 6), r32 = lane & 31, hi = lane >> 5;
    const int role = wid >> 2, a = (wid >> 1) & 1, bb = wid & 1, r = wid >> 1;
    LAS bf16* ST = (LAS bf16*)(lds + G3_ST); LAS bf16* VT = (LAS bf16*)(lds + G3_VT);
    for (int unit = vcu; unit < BATCH * NHEADS * 2; unit += G) {
        const int bh = unit >> 1, e = unit & 1, b = bh >> 4, h = bh & 15;
        for (int i = tid; i < G3_VT / 4; i += NWAVES * 64) ((LAS unsigned*)lds)[i] = 0u;
        f32x16 Sacc = {};
        __syncthreads();
        const bf16* aBase = role == 0 ? wbuf + (size_t)(32 * a + r32) * DMODEL + h * HD + 8 * hi : p + (size_t)(32 * a + r32) * GDN_MAIN + h * HD + 8 * hi;
        const size_t aPitch = role == 0 ? DMODEL : GDN_MAIN;
        const int dkr = 32 * r + r32;
        const bf16* kBase = p + (size_t)(dkr >> 1) * GDN_MAIN + 2048 + h * HD + (dkr & 1) * 64 + 8 * hi;
        const bf16* uBase = p + (size_t)(32 * bb + r32) * GDN_MAIN + 4096 + h * HD + e * 64 + 32 * a + 4 * hi;
        const bf16* pBase = attn + (size_t)(32 * a + r32) * 64 + 8 * hi;
        bf16* oBase = p + 4096 + h * HD + e * 64 + 32 * bb + r32;
        const LAS bf16* sRd = ST + (32 * bb + r32) * G3_STS + 8 * hi; const LAS bf16* vRd = VT + (32 * bb + r32) * G3_VTS + 8 * hi;
        LAS bf16* vWr = VT + (32 * bb + r32) * G3_VTS + 32 * a + 4 * hi; LAS bf16* sWr = ST + (32 * bb + r32) * G3_STS + 32 * r + 4 * hi;
#define G3_LOAD_A(nn) do { const size_t row0_ = (size_t)b * SEQ + (size_t)(nn) * 64; \
            _Pragma("unroll") for (int s = 0; s < 8; ++s) Af[s] = *(const bf16x8*)(aBase + row0_ * aPitch + 16 * s); } while (0)
#define G3_LOAD_U(nn) do { const size_t row0_ = (size_t)b * SEQ + (size_t)(nn) * 64; \
            _Pragma("unroll") for (int q = 0; q < 4; ++q) Uf[q] = *(const v2u*)(uBase + row0_ * GDN_MAIN + 8 * q); } while (0)
#define G3_LOAD_PK(nn) do { const size_t row0_ = (size_t)b * SEQ + (size_t)(nn) * 64; \
            if (role == 1) { const bf16* pp_ = pBase + ((size_t)(b * 64 + (nn)) * 16 + h) * 4096; _Pragma("unroll") for (int s = 0; s < 4; ++s) Pf[s] = *(const bf16x8*)(pp_ + 16 * s); } \
            _Pragma("unroll") for (int s = 0; s < 4; ++s) Kf[s] = *(const bf16x8*)(kBase + row0_ * GDN_MAIN + 16 * s); \
            dd = __expf(g[(row0_ + 63) * 16 + h]); } while (0)
        bf16x8 Af[8], Kf[4], Pf[4]; v2u Uf[4]; float dd;
#pragma unroll
        for (int s = 0; s < 4; ++s) { Pf[s] = (bf16x8){0, 0, 0, 0, 0, 0, 0, 0}; Uf[s] = (v2u){0u, 0u}; }
        G3_LOAD_A(0); if (role == 0) G3_LOAD_U(0); G3_LOAD_PK(0);
#pragma unroll 1
        for (int n = 0; n < 64; ++n) {
            const size_t row0_ = (size_t)b * SEQ + (size_t)n * 64; const int nn = (n + 1 < 64) ? n + 1 : n;
            f32x16 acc_ = {};
#pragma unroll
            for (int s = 0; s < 8; ++s) acc_ = MFMA32(Af[s], *(const LAS bf16x8*)(sRd + 16 * s), acc_);
            G3_LOAD_A(nn);
            if (role == 0) {
#pragma unroll
                for (int q = 0; q < 4; ++q) { v2u w_;
                    w_.x = pk2(bflo(Uf[q].x) - acc_[4 * q], bfhi(Uf[q].x) - acc_[4 * q + 1]); w_.y = pk2(bflo(Uf[q].y) - acc_[4 * q + 2], bfhi(Uf[q].y) - acc_[4 * q + 3]);
                    *(LAS v2u*)(vWr + 8 * q) = w_; }
                G3_LOAD_U(nn);
            }
            WG_BAR();
            bf16x8 Vf_[4];
#pragma unroll
            for (int s = 0; s < 4; ++s) Vf_[s] = *(const LAS bf16x8*)(vRd + 16 * s);
            if (role == 1) {
#pragma unroll
                for (int s = 0; s < 4; ++s) acc_ = MFMA32(Pf[s], Vf_[s], acc_);
#pragma unroll
                for (int rr = 0; rr < 16; ++rr) oBase[(row0_ + 32 * a + (rr & 3) + 8 * (rr >> 2) + 4 * hi) * GDN_MAIN] = (bf16)f2bf(acc_[rr]);
            }
            Sacc = Sacc * dd;
#pragma unroll
            for (int s = 0; s < 4; ++s) Sacc = MFMA32(Kf[s], Vf_[s], Sacc);
            G3_LOAD_PK(nn);
#pragma unroll
            for (int q = 0; q < 4; ++q) { v2u w_; w_.x = pk2(Sacc[4 * q], Sacc[4 * q + 1]); w_.y = pk2(Sacc[4 * q + 2], Sacc[4 * q + 3]); *(LAS v2u*)(sWr + 8 * q) = w_; }
            WG_BAR();
        }
#undef G3_LOAD_A
#undef G3_LOAD_U
#undef G3_LOAD_PK
        VM_WAIT(); __syncthreads();
    }
}

__device__ __forceinline__ void gdn_gate_phase(bf16* p, const float* norm_w, int gw, int NGW, int lane) {
    for (int m = gw; m < MROWS; m += NGW) {
        bf16* orow = p + (size_t)m * GDN_MAIN + 4096; const bf16* zrow = p + (size_t)m * GDN_MAIN + 6144;
#pragma unroll
        for (int it = 0; it < 4; ++it) { const int col = it * 512 + lane * 8;
            const v4u ov = *(const v4u*)(orow + col), zv = *(const v4u*)(zrow + col);
            float o[8] = {bflo(ov.x), bfhi(ov.x), bflo(ov.y), bfhi(ov.y), bflo(ov.z), bfhi(ov.z), bflo(ov.w), bfhi(ov.w)};
            float z[8] = {bflo(zv.x), bfhi(zv.x), bflo(zv.y), bfhi(zv.y), bflo(zv.z), bfhi(zv.z), bflo(zv.w), bfhi(zv.w)};
            float s = 0.f;
#pragma unroll
            for (int c = 0; c < 8; ++c) s += o[c] * o[c];
            s = sum16(s); const float rs = __builtin_amdgcn_rsqf(s * (1.f / HD) + GDN_EPS);
            const f32x4 wa = *(const f32x4*)(norm_w + (col & 127)), wb = *(const f32x4*)(norm_w + (col & 127) + 4);
#pragma unroll
            for (int c = 0; c < 8; ++c) o[c] = o[c] * rs * (c < 4 ? wa[c] : wb[c - 4]) * silu_f(z[c]);
            v4u w; w.x = pk2(o[0], o[1]); w.y = pk2(o[2], o[3]); w.z = pk2(o[4], o[5]); w.w = pk2(o[6], o[7]); *(v4u*)(orow + col) = w; }
    }
}

__device__ __forceinline__ void diff_combine_phase(const bf16* o0, const bf16* o1, bf16* og, const float* lam_params  , const float* subln_w, float lambda_init, int gw, int NGW, int lane) {
    const float e1 = wave_sum(lam_params[lane] * lam_params[64 + lane]), e2 = wave_sum(lam_params[128 + lane] * lam_params[192 + lane]);
    const float lam = __expf(e1) - __expf(e2) + lambda_init, post = 1.f - lambda_init;
    for (int m = gw; m < MROWS; m += NGW) {
#pragma unroll
        for (int it = 0; it < 4; ++it) { const int col = it * 512 + lane * 8; const size_t off = (size_t)m * DMODEL + col;
            const v4u av = *(const v4u*)(o0 + off), bv = *(const v4u*)(o1 + off);
            float d[8] = {bflo(av.x) - lam * bflo(bv.x), bfhi(av.x) - lam * bfhi(bv.x), bflo(av.y) - lam * bflo(bv.y), bfhi(av.y) - lam * bfhi(bv.y),
                          bflo(av.z) - lam * bflo(bv.z), bfhi(av.z) - lam * bfhi(bv.z), bflo(av.w) - lam * bflo(bv.w), bfhi(av.w) - lam * bfhi(bv.w)};
            float s = 0.f;
#pragma unroll
            for (int c = 0; c < 8; ++c) s += d[c] * d[c];
            s = sum16(s); const float rs = post * __builtin_amdgcn_rsqf(s * (1.f / HD) + SUBLN_EPS);
            const f32x4 wa = *(const f32x4*)(subln_w + (col & 127)), wb = *(const f32x4*)(subln_w + (col & 127) + 4);
#pragma unroll
            for (int c = 0; c < 8; ++c) d[c] = d[c] * rs * (c < 4 ? wa[c] : wb[c - 4]);
            v4u w; w.x = pk2(d[0], d[1]); w.y = pk2(d[2], d[3]); w.z = pk2(d[4], d[5]); w.w = pk2(d[6], d[7]); *(v4u*)(og + off) = w; }
    }
}
#ifndef PG8_SP2
#define PG8_SP2 true
#endif
#ifndef PG8_ALIGN
#define PG8_ALIGN true
#endif
#ifndef EN_P0
#define EN_P0 1
#endif
#ifndef EN_G1
#define EN_G1 1
#endif
#ifndef EN_G2
#define EN_G2 1
#endif
#ifndef EN_G3
#define EN_G3 1
#endif
#ifndef EN_G4
#define EN_G4 1
#endif
#ifndef EN_G5
#define EN_G5 1
#endif
#ifndef EN_G6
#define EN_G6 1
#endif
#ifndef EN_G7
#define EN_G7 1
#endif
#ifndef EN_G8
#define EN_G8 1
#endif
#ifndef EN_G9
#define EN_G9 1
#endif
#ifndef EN_D1
#define EN_D1 1
#endif
#ifndef EN_D2
#define EN_D2 1
#endif
#ifndef EN_D3
#define EN_D3 1
#endif
#ifndef EN_D4
#define EN_D4 1
#endif
#ifndef EN_D5
#define EN_D5 1
#endif
#ifndef EN_D6U
#define EN_D6U 1
#endif
#ifndef EN_D6D
#define EN_D6D 1
#endif
#ifndef EN_D7
#define EN_D7 1
#endif
struct Args { const float* in[16]; float* out; unsigned char* ws; int ph_lo, ph_hi; };
__global__ void __launch_bounds__(NWAVES * 64, 2) yoco_fwd(Args args) {
    extern __shared__ __attribute__((aligned(16))) unsigned char lds_raw[];
    LAS unsigned char* lds = (LAS unsigned char*)lds_raw;
    volatile LAS unsigned* MISC = (volatile LAS unsigned*)(lds + MISC_OFF);
    const int tid = threadIdx.x, lane = tid & 63, wave = __builtin_amdgcn_readfirstlane(tid >> 6);
    const int G = gridDim.x, bx = blockIdx.x, vcu = (G % 8 == 0) ? (bx % 8) * (G / 8) + bx / 8 : bx;
    const int gw = vcu * NWAVES + wave, NGW = G * NWAVES, gtid = vcu * NWAVES * 64 + tid, NGT = G * NWAVES * 64;
    const float* ln_g = args.in[14]; const float* ln_b = args.in[15];
    for (int u = tid; u < (LDS_BYTES - LDSCTL_OFF) / 4; u += NWAVES * 64) ((LAS unsigned*)(lds + LDSCTL_OFF))[u] = 0u;
    __syncthreads();
    XcdBarrier bar; bar.bar = (unsigned*)(args.ws + WS_CTL) + CW_BAR; bar.x = 0; bar.st = nullptr;
    if (!MK_PER_PHASE) bar = xcd_barrier_post((unsigned*)(args.ws + WS_CTL) + CW_BAR, MISC + 8);
    const int lo = args.ph_lo, hi = args.ph_hi;
#define IN(k) (lo <= (k) && (k) < hi)
#define FRESH_LANE() int ln_ = lane; asm volatile("" : "+v"(ln_)); unsigned char* ws_ = args.ws; asm volatile("" : "+s"(ws_)); int gw_ = gw, vcu_ = vcu, bx_ = bx; asm volatile("" : "+s"(gw_), "+s"(vcu_), "+s"(bx_))
#define x_in         (args.in[0])
#define gdn_w_in     (args.in[1])
#define gdn_conv_w   (args.in[2])
#define gdn_a_log    (args.in[3])
#define gdn_dt_bias  (args.in[4])
#define gdn_norm_w   (args.in[5])
#define gdn_w_out    (args.in[6])
#define diff_w_q     (args.in[7])
#define diff_lambda  (args.in[8])
#define diff_subln_w (args.in[9])
#define diff_w_o     (args.in[10])
#define shared_w_kv  (args.in[11])
#define mlp_w_up     (args.in[12])
#define mlp_w_down   (args.in[13])
#define ones  ((float*)(ws_ + WS_ONES))
#define zeros ((float*)(ws_ + WS_ZEROS))
#define mu    ((float*)(ws_ + WS_MU))
#define rstd  ((float*)(ws_ + WS_RSTD))
#define beta  ((float*)(ws_ + WS_BETA))
#define gdec  ((float*)(ws_ + WS_G))
#define halo  ((bf16*)(ws_ + WS_HALO))
#define WA    ((bf16*)(ws_ + WS_WA))
#define WB    ((bf16*)(ws_ + WS_WB))
#define attnb ((bf16*)(ws_ + WS_ATTN))
#define XB    ((bf16*)(ws_ + WS_XB))
#define Y     ((float*)(ws_ + WS_Y))
#define R1    ((bf16*)(ws_ + WS_R1))
#define Kb    (R1)
#define Vb    (R1 + QTR / 2)
#define Qb    (R1 + 2 * (QTR / 2))
#define O0    (R1 + 3 * (QTR / 2))
#define O1    (XB)
#define HID   (Qb)
#define SEAM(k) do { if (!MK_PER_PHASE && (k) + 1 < hi) xcd_barrier(bar); } while (0)

    if (EN_P0 && IN(0)) { FRESH_LANE();
        for (int i = gtid; i < DMODEL; i += NGT) { ones[i] = 1.f; zeros[i] = 0.f; }
        for (int i = gtid; i < MROWS; i += NGT) { mu[i] = 0.f; rstd[i] = 1.f; }
        for (int m = gw_; m < MROWS; m += NGW) row_to_bf16(x_in + (size_t)m * DMODEL, XB + (size_t)m * DMODEL, ln_);
        convert_w(lds, gw_, NGW, wave, ln_, gdn_w_in, DMODEL, GDN_PROJ, 0, GDN_PROJ, WA, 0);
        SEAM(0);
    }
    for (int l = 0; l < 2; ++l) {
        const int pb = 1 + 9 * l;
        if (EN_G1 && IN(pb + 0)) { FRESH_LANE();
            pg8::Gemm g{XB, WA, MROWS, GDN_MAIN, DMODEL, DMODEL}; pg8::StaticOrder S; S.init(MROWS, GDN_MAIN, G, bx_);
            pg8::EpiStore<0> E{R1, GDN_MAIN, 0, 0, -1, 1.f, halo};
            pg8::gemm_phase<pg8::EpiStore<0>, pg8::StaticOrder, PG8_ALIGN, PG8_SP2>(lds + RING_OFF, g, S, E);
            ba_proj(XB, WA, gdn_a_log + l * 16, gdn_dt_bias + l * 16, beta, gdec, gw_, NGW, ln_);
            SEAM(pb + 0);
        }
        if (EN_G2 && IN(pb + 1)) { FRESH_LANE(); gdn_chunk_phase(lds, R1, halo, beta, gdec, XB, attnb, gdn_conv_w + (size_t)l * 4 * CONVC, vcu_, G); SEAM(pb + 1); }
        if (EN_G3 && IN(pb + 2)) { FRESH_LANE(); gdn_scan_phase(lds, R1, XB, attnb, gdec, vcu_, G); SEAM(pb + 2); }
        if (EN_G4 && IN(pb + 3)) { FRESH_LANE();
            gdn_gate_phase(R1, gdn_norm_w + l * HD, gw_, NGW, ln_);
            convert_w(lds, gw_, NGW, wave, ln_, gdn_w_out + (size_t)l * DMODEL * DMODEL, DMODEL, DMODEL, 0, DMODEL, WA, 0);
            convert_w(lds, gw_, NGW, wave, ln_, mlp_w_up + (size_t)l * DMODEL * DFF, DMODEL, DFF, 0, DFF, WB, 0);
            SEAM(pb + 3);
        }
        if (EN_G5 && IN(pb + 4)) { FRESH_LANE();
            pg8::Gemm g{R1 + 4096, WA, MROWS, DMODEL, DMODEL, GDN_MAIN}; pg8::StaticOrder S; S.init(MROWS, DMODEL, G, bx_);
            const float* yin = (l == 0) ? x_in : Y; const float* xg = (l == 0) ? ones : ln_g + (size_t)((l - 1) * 2 + 1) * DMODEL; const float* xbt = (l == 0) ? zeros : ln_b + (size_t)((l - 1) * 2 + 1) * DMODEL;
            pg8::EpiResid E{yin, Y, mu, rstd, xg, xbt, DMODEL, ALPHA_RES};
            pg8::gemm_phase<pg8::EpiResid, pg8::StaticOrder, PG8_ALIGN, PG8_SP2>(lds + RING_OFF, g, S, E);
            SEAM(pb + 4);
        }
        const float* g1 = ln_g + (size_t)(l * 2) * DMODEL; const float* b1 = ln_b + (size_t)(l * 2) * DMODEL;
        if (EN_G6 && IN(pb + 5)) { FRESH_LANE();
            for (int m = gw_; m < MROWS; m += NGW) ln_row(Y + (size_t)m * DMODEL, g1, b1, mu + m, rstd + m, XB + (size_t)m * DMODEL, nullptr, ln_);
            convert_w(lds, gw_, NGW, wave, ln_, mlp_w_down + (size_t)l * DFF * DMODEL, DFF, DMODEL, 0, DMODEL, WA, 0);
            SEAM(pb + 5);
        }
        if (EN_G7 && IN(pb + 6)) { FRESH_LANE();
            pg8::Gemm g{XB, WB, MROWS, DFF, DMODEL, DMODEL}; pg8::StaticOrder S; S.init(MROWS, DFF, G, bx_);
            pg8::EpiStore<1> E{R1, DFF, 0, 0, -1, 1.f, nullptr};
            pg8::gemm_phase<pg8::EpiStore<1>, pg8::StaticOrder, PG8_ALIGN, PG8_SP2>(lds + RING_OFF, g, S, E);
            SEAM(pb + 6);
        }
        if (EN_G8 && IN(pb + 7)) { FRESH_LANE();
            pg8::Gemm g{R1, WA, MROWS, DMODEL, DFF, DFF}; pg8::StaticOrder S; S.init(MROWS, DMODEL, G, bx_);
            pg8::EpiResid E{Y, Y, mu, rstd, g1, b1, DMODEL, ALPHA_RES};
            pg8::gemm_phase<pg8::EpiResid, pg8::StaticOrder, PG8_ALIGN, PG8_SP2>(lds + RING_OFF, g, S, E);
            SEAM(pb + 7);
        }
        if (EN_G9 && IN(pb + 8)) { FRESH_LANE();
            const float* g2 = ln_g + (size_t)(l * 2 + 1) * DMODEL; const float* b2 = ln_b + (size_t)(l * 2 + 1) * DMODEL;
            for (int m = gw_; m < MROWS; m += NGW) ln_row(Y + (size_t)m * DMODEL, g2, b2, mu + m, rstd + m, XB + (size_t)m * DMODEL, nullptr, ln_);
            if (l == 0) convert_w(lds, gw_, NGW, wave, ln_, gdn_w_in + (size_t)DMODEL * GDN_PROJ, DMODEL, GDN_PROJ, 0, GDN_PROJ, WA, 0);
            else { convert_w(lds, gw_, NGW, wave, ln_, shared_w_kv, DMODEL, 2 * DMODEL, 0, 2 * DMODEL, WA, 0);
                   convert_w(lds, gw_, NGW, wave, ln_, diff_w_q, DMODEL, DMODEL, 0, DMODEL, WA, 2 * DMODEL); }
            SEAM(pb + 8);
        }
    }
    for (int j = 0; j < 2; ++j) {
        const int pb = 19 + 10 * j, L = 2 + j;
        const float* xg = ln_g + (size_t)((L - 1) * 2 + 1) * DMODEL; const float* xbt = ln_b + (size_t)((L - 1) * 2 + 1) * DMODEL;
        if (EN_D1 && IN(pb + 0)) { FRESH_LANE();
            const int N = (j == 0) ? 3 * DMODEL : DMODEL;
            pg8::Gemm g{XB, WA, MROWS, N, DMODEL, DMODEL}; pg8::StaticOrder S; S.init(MROWS, N, G, bx_);
            pg8::EpiStore<0> E{(j == 0) ? Kb : Qb, DMODEL, (j == 0) ? DMODEL : 0, QTR / 2, (j == 0) ? 2 : 0, attn_body::C2, nullptr};
            pg8::gemm_phase<pg8::EpiStore<0>, pg8::StaticOrder, PG8_ALIGN, PG8_SP2>(lds + RING_OFF, g, S, E);
            SEAM(pb + 0);
        }
        if (EN_D2 && IN(pb + 1)) { FRESH_LANE();
            const attn_body::AttnTensors AT{(const attn_body::bf16*)Qb, (const attn_body::bf16*)Kb, (const attn_body::bf16*)Vb, (attn_body::bf16*)O0, (attn_body::bf16*)O1};
            const attn_body::StaticOrder S(G, bx_);
            attn_body::attn_phase<attn_body::StaticOrder>((char*)lds_raw + RING_OFF, AT, S);
            SEAM(pb + 1);
        }
        if (EN_D3 && IN(pb + 2)) { FRESH_LANE();
            const float lambda_init = 0.8f - 0.6f * expf(-0.3f * (float)L);
            diff_combine_phase(O0, O1, Qb, diff_lambda + (size_t)j * 256, diff_subln_w + j * HD, lambda_init, gw_, NGW, ln_);
            convert_w(lds, gw_, NGW, wave, ln_, diff_w_o + (size_t)j * DMODEL * DMODEL, DMODEL, DMODEL, 0, DMODEL, WB, 0);
            convert_w(lds, gw_, NGW, wave, ln_, mlp_w_up + (size_t)L * DMODEL * DFF, DMODEL, DFF, 0, DFF, WA, 0);
            SEAM(pb + 2);
        }
        if (EN_D4 && IN(pb + 3)) { FRESH_LANE();
            pg8::Gemm g{Qb, WB, MROWS, DMODEL, DMODEL, DMODEL}; pg8::StaticOrder S; S.init(MROWS, DMODEL, G, bx_);
            pg8::EpiResid E{Y, Y, mu, rstd, xg, xbt, DMODEL, ALPHA_RES};
            pg8::gemm_phase<pg8::EpiResid, pg8::StaticOrder, PG8_ALIGN, PG8_SP2>(lds + RING_OFF, g, S, E);
            SEAM(pb + 3);
        }
        const float* g1 = ln_g + (size_t)(L * 2) * DMODEL; const float* b1 = ln_b + (size_t)(L * 2) * DMODEL;
        if (EN_D5 && IN(pb + 4)) { FRESH_LANE();
            for (int m = gw_; m < MROWS; m += NGW) ln_row(Y + (size_t)m * DMODEL, g1, b1, mu + m, rstd + m, XB + (size_t)m * DMODEL, nullptr, ln_);
            convert_w(lds, gw_, NGW, wave, ln_, mlp_w_down + (size_t)L * DFF * DMODEL, DFF, DMODEL, 0, DMODEL, WB, 0);
            SEAM(pb + 4);
        }
        for (int hf = 0; hf < 2; ++hf) {
            const size_t roff = (size_t)hf * (MROWS / 2);
            if (EN_D6U && IN(pb + 5 + 2 * hf)) { FRESH_LANE();
                pg8::Gemm g{XB + roff * DMODEL, WA, MROWS / 2, DFF, DMODEL, DMODEL}; pg8::StaticOrder S; S.init(MROWS / 2, DFF, G, bx_);
                pg8::EpiStore<1> E{HID, DFF, 0, 0, -1, 1.f, nullptr};
                pg8::gemm_phase<pg8::EpiStore<1>, pg8::StaticOrder, PG8_ALIGN, PG8_SP2>(lds + RING_OFF, g, S, E);
                SEAM(pb + 5 + 2 * hf);
            }
            if (EN_D6D && IN(pb + 6 + 2 * hf)) { FRESH_LANE();
                pg8::Gemm g{HID, WB, MROWS / 2, DMODEL, DFF, DFF}; pg8::StaticOrder S; S.init(MROWS / 2, DMODEL, G, bx_);
                pg8::EpiResid E{Y + roff * DMODEL, Y + roff * DMODEL, mu + roff, rstd + roff, g1, b1, DMODEL, ALPHA_RES};
                pg8::gemm_phase<pg8::EpiResid, pg8::StaticOrder, PG8_ALIGN, PG8_SP2>(lds + RING_OFF, g, S, E);
                SEAM(pb + 6 + 2 * hf);
            }
        }
        if (EN_D7 && IN(pb + 9)) { FRESH_LANE();
            const float* g2 = ln_g + (size_t)(L * 2 + 1) * DMODEL; const float* b2 = ln_b + (size_t)(L * 2 + 1) * DMODEL;
            if (j == 0) { for (int m = gw_; m < MROWS; m += NGW) ln_row(Y + (size_t)m * DMODEL, g2, b2, mu + m, rstd + m, XB + (size_t)m * DMODEL, nullptr, ln_);
                          convert_w(lds, gw_, NGW, wave, ln_, diff_w_q + (size_t)DMODEL * DMODEL, DMODEL, DMODEL, 0, DMODEL, WA, 0); }
            else { for (int m = gw_; m < MROWS; m += NGW) ln_row(Y + (size_t)m * DMODEL, g2, b2, mu + m, rstd + m, nullptr, args.out + (size_t)m * DMODEL, ln_); }
            SEAM(pb + 9);
        }
    }
#undef IN
#undef SEAM
}

extern "C" void kernel_launch(void* const* d_in, const int* in_sizes, int n_in, void* d_out, int out_size, void* d_ws, size_t ws_size, hipStream_t stream) {
    static int grid = 0;
    if (grid == 0) {
        if (n_in != 16 || in_sizes[0] != MROWS * DMODEL || out_size != MROWS * DMODEL || ws_size < WS_END) { fprintf(stderr, "kernel_launch: unexpected shapes / workspace (n_in %d, ws %zu < %zu); nothing launched\n", n_in, ws_size, (size_t)WS_END); grid = -1; return; }
        int dev = 0, cus = 0, per_cu = 0;
        if (hipGetDevice(&dev) != hipSuccess || hipDeviceGetAttribute(&cus, hipDeviceAttributeMultiprocessorCount, dev) != hipSuccess) { grid = -1; return; }
        if (hipFuncSetAttribute((const void*)yoco_fwd, hipFuncAttributeMaxDynamicSharedMemorySize, LDS_BYTES) != hipSuccess) { fprintf(stderr, "kernel_launch: hipFuncSetAttribute failed\n"); grid = -1; return; }
        if (hipOccupancyMaxActiveBlocksPerMultiprocessor(&per_cu, (const void*)yoco_fwd, NWAVES * 64, LDS_BYTES) != hipSuccess || per_cu < 1)
            fprintf(stderr, "kernel_launch: note: occupancy query reports %d workgroups per CU\n", per_cu);
        (void)hipGetLastError();
        grid = cus;
    }
    if (grid < 0) return;
    if (hipMemsetAsync((char*)d_ws + WS_CTL, 0, CTL_ZERO_BYTES, stream) != hipSuccess) return;
    Args a{};
    for (int i = 0; i < 16; ++i) a.in[i] = (const float*)d_in[i];
    a.out = (float*)d_out; a.ws = (unsigned char*)d_ws;
#if MK_PER_PHASE
    for (int k = 0; k < N_PHASES; ++k) { a.ph_lo = k; a.ph_hi = k + 1; hipLaunchKernelGGL(yoco_fwd, dim3(grid), dim3(NWAVES * 64), LDS_BYTES, stream, a); }
#else
    a.ph_lo = 0; a.ph_hi = N_PHASES;
    hipLaunchKernelGGL(yoco_fwd, dim3(grid), dim3(NWAVES * 64), LDS_BYTES, stream, a);
#endif
    const hipError_t le = hipPeekAtLastError();
    if (le != hipSuccess) fprintf(stderr, "kernel_launch: launch failed: %s\n", hipGetErrorName(le));
}
```

```cpp
#include <hip/hip_runtime.h>
#include <hip/hip_bf16.h>
#include <cstdio>
#include <cstdint>
#include <cmath>

namespace pg8 {
#define PG8_LAS __attribute__((address_space(3)))
typedef unsigned short bf16_t;
typedef short bf16x8 __attribute__((ext_vector_type(8)));
typedef float f32x4 __attribute__((ext_vector_type(4)));
typedef unsigned u32x4 __attribute__((ext_vector_type(4)));
constexpr int BM = 256, BK = 64, HALF = 128, HTB = HALF * BK * 2  , STAGE_BYTES = 8 * HTB, NXCD = 8, WGM = 8;

__host__ __device__ __forceinline__ int lds_byte(int r, int c) { const int st = (r >> 4) * 2 + (c >> 5), rr = r & 15, cc = c & 31, ob = rr * 64 + cc * 2; return st * 1024 + (ob ^ (((ob >> 9) & 1) << 5)); }
__host__ __device__ __forceinline__ void stage_rc(int b, int& R, int& C) { const int st = b / 1024, sb = b % 1024, swz = sb ^ (((sb >> 9) & 1) << 5); R = (st >> 1) * 16 + swz / 64; C = (st & 1) * 32 + (swz % 64) / 2; }
__host__ __device__ __forceinline__ int perm32(int rho) { const int n = rho >> 4, i = rho & 15; return 8 * (i >> 2) + 4 * n + (i & 3); }

struct Unit { int pm, pn; };
struct Gemm { const bf16_t* A; const bf16_t* Bt; int M, N, K, lda; };

struct StaticOrder {
    int nM, nN, nwg, G, c;
    __host__ __device__ void init(int M, int N, int G_, int c_) { nM = M / BM; nN = N / BM; nwg = nM * nN; G = G_; c = c_; }
    __host__ __device__ bool next(int i, Unit& u) const {
        const long L = (long)i * G + c; if (L >= nwg) return false;
        int wgid = (int)L; { const int q = nwg / NXCD, r = nwg % NXCD, xcd = wgid % NXCD, off = wgid / NXCD; wgid = (xcd < r ? xcd * (q + 1) : r * (q + 1) + (xcd - r) * q) + off; }
        const int nig = WGM * nN, gid = wgid / nig, fm = gid * WGM, gsz = (nM - fm) < WGM ? (nM - fm) : WGM;
        u.pm = fm + ((wgid % nig) % gsz); u.pn = (wgid % nig) / gsz; return true;
    }
    __device__ __forceinline__ void a_ready(const Unit&) const {}
    __device__ __forceinline__ void done(const Unit&) const {}
};

__device__ __forceinline__ unsigned cvt_pk_bf16(float lo, float hi) { unsigned r; asm volatile("v_cvt_pk_bf16_f32 %0, %1, %2" : "=v"(r) : "v"(lo), "v"(hi)); return r; }

template <int ACT> struct EpiStore {
    static constexpr bool PERM = true, AFTER_DRAIN = false;
    bf16_t* O; int ldc; int split_cols; size_t split_stride; int scale_tile; float scale0; bf16_t* halo;
    __device__ __forceinline__ void operator()(const f32x4 (&acc)[2][2][4][2], const Unit& u, int wr, int wc, int fr, int fq) const {
        const int row0 = u.pm * BM + wr * 64 + fr; int colt = u.pn * BM; bf16_t* base = O;
        int t = 0; if (split_cols) { t = colt / split_cols; base += (size_t)t * split_stride; colt -= t * split_cols; }
        const float sc = (t == scale_tile) ? scale0 : 1.f;
        const int col0 = colt + wc * 32 + 8 * fq;
#pragma unroll
        for (int ai = 0; ai < 2; ++ai)
#pragma unroll
            for (int m = 0; m < 4; ++m) { const int row = row0 + ai * HALF + m * 16; bf16_t* rowp = base + (size_t)row * ldc + col0;
#pragma unroll
                for (int bj = 0; bj < 2; ++bj) { f32x4 v0 = acc[ai][bj][m][0], v1 = acc[ai][bj][m][1];
                    if (ACT == 1) {
#pragma unroll
                        for (int e = 0; e < 4; ++e) { const float a = fmaxf(v0[e], 0.f), b = fmaxf(v1[e], 0.f); v0[e] = a * a; v1[e] = b * b; } }
                    v0 = v0 * sc; v1 = v1 * sc; u32x4 w; w.x = cvt_pk_bf16(v0[0], v0[1]); w.y = cvt_pk_bf16(v0[2], v0[3]); w.z = cvt_pk_bf16(v1[0], v1[1]); w.w = cvt_pk_bf16(v1[2], v1[3]);
                    if (O != nullptr) *(u32x4*)(rowp + bj * HALF) = w; else asm volatile("" :: "v"(w));
                    if (halo != nullptr && m == 3 && fr >= 13) { const int c = col0 + bj * HALF; if (c < 6144) *(u32x4*)(halo + ((size_t)(row >> 6) * 3 + (fr - 13)) * 6144 + c) = w; }
                } }
    }
};
struct EpiResid {
    static constexpr bool PERM = false, AFTER_DRAIN = false;
    const float* yin; float* yout; const float* mu; const float* rstd; const float* g; const float* b; int ldc; float alpha;
    __device__ __forceinline__ void operator()(const f32x4 (&acc)[2][2][4][2], const Unit& u, int wr, int wc, int fr, int fq) const {
        const int row0 = u.pm * BM + wr * 64 + fr; const int col0 = u.pn * BM + wc * 32 + 4 * fq;
#pragma unroll
        for (int ai = 0; ai < 2; ++ai)
#pragma unroll
            for (int m = 0; m < 4; ++m) { const int row = row0 + ai * HALF + m * 16; const float mr = mu[row], rs = rstd[row]; const size_t off = (size_t)row * ldc + col0;
#pragma unroll
                for (int bj = 0; bj < 2; ++bj)
#pragma unroll
                    for (int n = 0; n < 2; ++n) { const f32x4 yv = *(const f32x4*)(yin + off + bj * HALF + n * 16);
                        const f32x4 gv = *(const f32x4*)(g + col0 + bj * HALF + n * 16), bv = *(const f32x4*)(b + col0 + bj * HALF + n * 16);
                        const f32x4 xv = ((yv - mr) * rs) * gv + bv;
                        *(f32x4*)(yout + off + bj * HALF + n * 16) = xv * alpha + acc[ai][bj][m][n]; }
                if (m & 1) asm volatile("" ::: "memory"); }
    }
};

template <class Epi, class Sched, bool ALIGN_EPI = false, bool SP2 = false>
__device__ __forceinline__ void gemm_phase(PG8_LAS unsigned char* lds, const Gemm g, const Sched& S, const Epi& E) {
    int tid_ = threadIdx.x; asm volatile("" : "+v"(tid_));
    const int tid = tid_, wid = __builtin_amdgcn_readfirstlane(tid >> 6), lane = tid & 63, wr = wid >> 2, wc = wid & 3, fr = lane & 15, fq = lane >> 4;
    const int K = g.K, nt = K / BK, lda = g.lda;
    unsigned voffA[2], voffB[2];
#pragma unroll
    for (int i = 0; i < 2; ++i) { int R, C; stage_rc(tid * 16 + i * 8192, R, C); const int Rb = Epi::PERM ? ((R & ~31) + perm32(R & 31)) : R;
        voffA[i] = (unsigned)(R * lda + C) * 2u; voffB[i] = (unsigned)(Rb * K + C) * 2u; }
    const size_t kstep = (size_t)(BK * 2);
    const size_t hA = (size_t)HALF * lda * 2, hB = (size_t)HALF * K * 2;
    const size_t tA = 2 * hA, tB = 2 * hB;
    const unsigned ldsw = (unsigned)wid * 1024u;
    const int aoff = lds_byte(wr * 64 + fr, fq * 8), boff = lds_byte(wc * 32 + fr, fq * 8);
#define PG8_SA(b, h) (((b) * 2 + (h)) * HTB)
#define PG8_SB(b, h) ((4 + (b) * 2 + (h)) * HTB)
#define PG8_STAGE(bufoff, gbase, voff) do { _Pragma("unroll") for (int _i = 0; _i < 2; ++_i) \
        __builtin_amdgcn_global_load_lds((const unsigned*)((const char*)(gbase) + (voff)[_i]), (PG8_LAS unsigned*)(lds + (bufoff) + ldsw + _i * 8192), 16, 0, 0); } while (0)
#define PG8_LDA(dst, b, h) do { _Pragma("unroll") for (int m = 0; m < 4; ++m) _Pragma("unroll") for (int k = 0; k < 2; ++k) dst[m][k] = *(const PG8_LAS bf16x8*)(lds + PG8_SA(b, h) + aoff + m * 2048 + k * 1024); } while (0)
#define PG8_LDB(dst, b, h) do { _Pragma("unroll") for (int n = 0; n < 2; ++n) _Pragma("unroll") for (int k = 0; k < 2; ++k) dst[n][k] = *(const PG8_LAS bf16x8*)(lds + PG8_SB(b, h) + boff + n * 2048 + k * 1024); } while (0)
#define PG8_MMA(ai, bj, At, Bt) do { __builtin_amdgcn_s_setprio(1); _Pragma("unroll") for (int m = 0; m < 4; ++m) _Pragma("unroll") for (int n = 0; n < 2; ++n) _Pragma("unroll") for (int k = 0; k < 2; ++k) \
        acc[ai][bj][m][n] = __builtin_amdgcn_mfma_f32_16x16x32_bf16(Bt[n][k], At[m][k], acc[ai][bj][m][n], 0, 0, 0); __builtin_amdgcn_s_setprio(0); } while (0)
#define PG8_WAIT_V(n) asm volatile("s_waitcnt vmcnt(" #n ")" ::: "memory")
#define PG8_WAIT_L(n) asm volatile("s_waitcnt lgkmcnt(" #n ")" ::: "memory")
#define PG8_BAR __builtin_amdgcn_s_barrier()
#define PG8_SCHED __builtin_amdgcn_sched_barrier(0)
    Unit cur, nxt; int ui = 0;
    if (!S.next(0, cur)) return;
    f32x4 acc[2][2][4][2];
#pragma unroll
    for (int a = 0; a < 2; ++a)
#pragma unroll
        for (int b = 0; b < 2; ++b)
#pragma unroll
            for (int m = 0; m < 4; ++m)
#pragma unroll
                for (int n = 0; n < 2; ++n) acc[a][b][m][n] = (f32x4){0.f, 0.f, 0.f, 0.f};
    bf16x8 At[4][2], B0[2][2], B1[2][2];
    const char* cA = (const char*)g.A + (size_t)cur.pm * tA; const char* cB = (const char*)g.Bt + (size_t)cur.pn * tB;
    S.a_ready(cur);
    if constexpr (SP2) {
        PG8_STAGE(PG8_SB(0, 0), cB, voffB); PG8_STAGE(PG8_SB(0, 1), cB + hB, voffB); PG8_STAGE(PG8_SA(0, 0), cA, voffA); PG8_STAGE(PG8_SA(0, 1), cA + hA, voffA);
        if (wr == 1) PG8_BAR;
        PG8_WAIT_V(2); PG8_BAR;
        PG8_STAGE(PG8_SB(1, 0), cB + kstep, voffB); PG8_STAGE(PG8_SA(1, 0), cA + kstep, voffA); PG8_STAGE(PG8_SB(1, 1), cB + hB + kstep, voffB);
        PG8_WAIT_V(6); PG8_BAR;
    } else {
        PG8_STAGE(PG8_SB(0, 0), cB, voffB); PG8_STAGE(PG8_SA(0, 0), cA, voffA); PG8_STAGE(PG8_SB(0, 1), cB + hB, voffB); PG8_STAGE(PG8_SA(0, 1), cA + hA, voffA);
        if (wr == 1) PG8_BAR;
        PG8_WAIT_V(4); PG8_BAR;
        PG8_STAGE(PG8_SB(1, 0), cB + kstep, voffB); PG8_STAGE(PG8_SA(1, 0), cA + kstep, voffA); PG8_STAGE(PG8_SB(1, 1), cB + hB + kstep, voffB);
        PG8_WAIT_V(6); PG8_BAR;
    }
    for (;;) {
        const bool has_next = S.next(ui + 1, nxt);
        const char* nA = has_next ? (const char*)g.A + (size_t)nxt.pm * tA : cA; const char* nB = has_next ? (const char*)g.Bt + (size_t)nxt.pn * tB : cB;
        for (int t = 0; t < nt; t += 2) {
            const bool last = (t == nt - 2);
            const char* a1 = cA + (size_t)(t + 1) * kstep;
            const char* a2 = last ? nA : cA + (size_t)(t + 2) * kstep; const char* b2 = last ? nB : cB + (size_t)(t + 2) * kstep;
            const char* a3 = a2 + kstep; const char* b3 = b2 + kstep;
            if (last && has_next) S.a_ready(nxt);
            if constexpr (SP2) {
            PG8_LDB(B0, 0, 0); PG8_LDB(B1, 0, 1); PG8_SCHED; PG8_LDA(At, 0, 0); PG8_STAGE(PG8_SA(1, 1), a1 + hA, voffA);
            PG8_WAIT_V(8); PG8_WAIT_L(0); PG8_BAR; PG8_MMA(0, 0, At, B0); PG8_MMA(0, 1, At, B1); PG8_BAR; PG8_SCHED;
            PG8_LDA(At, 0, 1); PG8_STAGE(PG8_SB(0, 0), b2, voffB); PG8_STAGE(PG8_SB(0, 1), b2 + hB, voffB); PG8_STAGE(PG8_SA(0, 0), a2, voffA);
            PG8_WAIT_V(8); PG8_WAIT_L(0); PG8_BAR; PG8_MMA(1, 0, At, B0); PG8_MMA(1, 1, At, B1); PG8_BAR; PG8_SCHED;
            PG8_LDB(B0, 1, 0); PG8_LDB(B1, 1, 1); PG8_SCHED; PG8_LDA(At, 1, 0); PG8_STAGE(PG8_SA(0, 1), a2 + hA, voffA);
            PG8_WAIT_V(8); PG8_WAIT_L(0); PG8_BAR; PG8_MMA(0, 0, At, B0); PG8_MMA(0, 1, At, B1); PG8_BAR; PG8_SCHED;
            PG8_LDA(At, 1, 1); PG8_STAGE(PG8_SB(1, 0), b3, voffB); PG8_STAGE(PG8_SB(1, 1), b3 + hB, voffB); PG8_STAGE(PG8_SA(1, 0), a3, voffA);
            PG8_WAIT_V(8); PG8_WAIT_L(0); PG8_BAR; PG8_MMA(1, 0, At, B0); PG8_MMA(1, 1, At, B1); PG8_BAR; PG8_SCHED;
            } else {
            PG8_LDB(B0, 0, 0); PG8_SCHED; PG8_LDA(At, 0, 0); PG8_STAGE(PG8_SA(1, 1), a1 + hA, voffA);
            PG8_WAIT_L(8); PG8_BAR; PG8_WAIT_L(0); PG8_MMA(0, 0, At, B0); PG8_BAR; PG8_SCHED;
            PG8_LDB(B1, 0, 1); PG8_STAGE(PG8_SB(0, 0), b2, voffB);
            PG8_BAR; PG8_WAIT_L(0); PG8_MMA(0, 1, At, B1); PG8_BAR;
            PG8_LDA(At, 0, 1); PG8_STAGE(PG8_SA(0, 0), a2, voffA);
            PG8_BAR; PG8_WAIT_L(0); PG8_MMA(1, 0, At, B0); PG8_BAR; PG8_SCHED;
            PG8_STAGE(PG8_SB(0, 1), b2 + hB, voffB);
            PG8_WAIT_V(6); PG8_BAR; PG8_MMA(1, 1, At, B1); PG8_BAR;
            PG8_LDB(B0, 1, 0); PG8_SCHED; PG8_LDA(At, 1, 0); PG8_STAGE(PG8_SA(0, 1), a2 + hA, voffA);
            PG8_WAIT_L(8); PG8_BAR; PG8_WAIT_L(0); PG8_MMA(0, 0, At, B0); PG8_BAR; PG8_SCHED;
            PG8_LDB(B1, 1, 1); PG8_STAGE(PG8_SB(1, 0), b3, voffB);
            PG8_BAR; PG8_WAIT_L(0); PG8_MMA(0, 1, At, B1); PG8_BAR;
            PG8_LDA(At, 1, 1); PG8_STAGE(PG8_SA(1, 0), a3, voffA);
            PG8_BAR; PG8_WAIT_L(0); PG8_MMA(1, 0, At, B0); PG8_BAR; PG8_SCHED;
            PG8_STAGE(PG8_SB(1, 1), b3 + hB, voffB);
            PG8_WAIT_V(6); PG8_BAR; PG8_MMA(1, 1, At, B1); PG8_BAR;
            }
        }
        if constexpr (ALIGN_EPI) { if (wr == 0) PG8_BAR; }
        if constexpr (!Epi::AFTER_DRAIN) { E(acc, cur, wr, wc, fr, fq); S.done(cur); }
        if (!has_next) break;
#pragma unroll
        for (int a = 0; a < 2; ++a)
#pragma unroll
            for (int b = 0; b < 2; ++b)
#pragma unroll
                for (int m = 0; m < 4; ++m)
#pragma unroll
                    for (int n = 0; n < 2; ++n) acc[a][b][m][n] = (f32x4){0.f, 0.f, 0.f, 0.f};
        cur = nxt; cA = nA; cB = nB; ++ui;
        if constexpr (ALIGN_EPI) { if (wr == 1) PG8_BAR; }
    }
    PG8_WAIT_V(0);
    if constexpr (!ALIGN_EPI) { if (wr == 0) PG8_BAR; }
    PG8_BAR;
#undef PG8_SA
#undef PG8_SB
#undef PG8_STAGE
#undef PG8_LDA
#undef PG8_LDB
#undef PG8_MMA
#undef PG8_WAIT_V
#undef PG8_WAIT_L
#undef PG8_BAR
#undef PG8_SCHED
}
}
#include <hip/hip_bf16.h>
namespace attn_body {
using bf16=__hip_bfloat16;
using bf16x8=__attribute__((ext_vector_type(8)))short;
using s16x4=__attribute__((ext_vector_type(4)))short;
using f32x16=__attribute__((ext_vector_type(16)))float;
using u32x4=__attribute__((ext_vector_type(4)))unsigned;
constexpr int BATCH=8,SEQ=4096,D=64,DM=2048;
constexpr int NW=8,QBLK=32,QB=QBLK*NW,KVBLK=64,NQB=SEQ/QB;
constexpr int ATTN_PITCH=DM, ATTN_UNIT_ROWS=QB;
__device__ __forceinline__ int crow(int r,int hi){return (r&3)+8*(r>>2)+4*hi;}
#define SBAR() __builtin_amdgcn_sched_barrier(0)
__device__ __forceinline__ void cmask(f32x16&p0,f32x16&p1,int jb,int qrel,int hi){
  const float NEG=-INFINITY; int kb=64*jb+4*hi;
  #pragma unroll
  for(int r=0;r<16;++r){int kv=kb+(r&3)+8*(r>>2); if(kv>qrel)p0[r]=NEG; if(kv+32>qrel)p1[r]=NEG;}
}

constexpr int NSLOT=3, SLOTB=8192;
constexpr int LDS_K=0, LDS_V=NSLOT*SLOTB, LDS_WS=2*NSLOT*SLOTB, LDS_OST=LDS_WS+NW*64*4, LDS_BYTES=LDS_OST+NW*4096;
constexpr float C2=0.125f*1.4426950408889634f;
__device__ __forceinline__ void glds16(const void*gsrc,unsigned lds_dst){unsigned keep;
  asm volatile("s_mov_b32 %0, m0\n\ts_mov_b32 m0, %2\n\ts_nop 0\n\tglobal_load_lds_dwordx4 %1, off\n\ts_mov_b32 m0, %0":"=&s"(keep):"v"(gsrc),"s"(lds_dst):"memory");}
__device__ __forceinline__ float max3f(float a,float b,float c){float r;asm("v_max3_f32 %0, %1, %2, %3":"=v"(r):"v"(a),"v"(b),"v"(c));return r;}
__device__ __forceinline__ float max2f(float a,float b){float r;asm("v_max_f32_e32 %0, %1, %2":"=v"(r):"v"(a),"v"(b));return r;}
__device__ __forceinline__ float fadd_s(float a,float b){float r;asm("v_add_f32_e32 %0, %1, %2":"=v"(r):"v"(a),"v"(b));return r;}
__device__ __forceinline__ float fsub_s(float a,float b){float r;asm("v_sub_f32_e32 %0, %1, %2":"=v"(r):"v"(a),"v"(b));return r;}
typedef float f32x2_t __attribute__((ext_vector_type(2))); typedef __bf16 bf16x2_t __attribute__((ext_vector_type(2)));
__device__ __forceinline__ unsigned cvtpk_s(float lo,float hi){f32x2_t v={lo,hi};bf16x2_t b=__builtin_convertvector(v,bf16x2_t);return __builtin_bit_cast(unsigned,b);}
#define WAIT_BAR(N) asm volatile("s_waitcnt vmcnt(" #N ") lgkmcnt(0)\n\ts_barrier":::"memory")

__device__ __forceinline__ void qkt(f32x16&p0,f32x16&p1,const char*Kslot,const bf16x8*qr,const f32x16&negm,int r32,int hi){
  const char*kb=Kslot+hi*1024+r32*16;
  #pragma unroll
  for(int d0=0;d0<4;++d0){
    const bf16x8 b0=*reinterpret_cast<const bf16x8*>(kb+d0*2048);
    const bf16x8 b1=*reinterpret_cast<const bf16x8*>(kb+d0*2048+512);
    if(d0==0){p0=__builtin_amdgcn_mfma_f32_32x32x16_bf16(b0,qr[0],negm,0,0,0);p1=__builtin_amdgcn_mfma_f32_32x32x16_bf16(b1,qr[0],negm,0,0,0);}
    else{p0=__builtin_amdgcn_mfma_f32_32x32x16_bf16(b0,qr[d0],p0,0,0,0);p1=__builtin_amdgcn_mfma_f32_32x32x16_bf16(b1,qr[d0],p1,0,0,0);}}
}
typedef __attribute__((address_space(3))) const char* lds_cptr;
typedef short v4i16_t __attribute__((ext_vector_type(4)));
__device__ __forceinline__ void kload8(bf16x8*kf,lds_cptr kp){
  kf[0]=*(const __attribute__((address_space(3))) bf16x8*)(kp);      kf[1]=*(const __attribute__((address_space(3))) bf16x8*)(kp+512);
  kf[2]=*(const __attribute__((address_space(3))) bf16x8*)(kp+2048); kf[3]=*(const __attribute__((address_space(3))) bf16x8*)(kp+2560);
  kf[4]=*(const __attribute__((address_space(3))) bf16x8*)(kp+4096); kf[5]=*(const __attribute__((address_space(3))) bf16x8*)(kp+4608);
  kf[6]=*(const __attribute__((address_space(3))) bf16x8*)(kp+6144); kf[7]=*(const __attribute__((address_space(3))) bf16x8*)(kp+6656);
}
__device__ __forceinline__ void kload2(bf16x8*kf,lds_cptr kp,int j){ kf[2*j]=*(const __attribute__((address_space(3))) bf16x8*)(kp+j*2048); kf[2*j+1]=*(const __attribute__((address_space(3))) bf16x8*)(kp+j*2048+512); }
__device__ __forceinline__ s16x4 vtr(lds_cptr p){ return __builtin_bit_cast(s16x4,__builtin_amdgcn_ds_read_tr16_b64_v4i16((__attribute__((address_space(3))) v4i16_t*)p)); }
__device__ __forceinline__ float rowmax(const f32x16&p0,const f32x16&p1){
  float a=max3f(p0[0],p0[1],p1[0]),b=max3f(p0[2],p0[3],p1[1]);a=max3f(a,p1[2],p1[3]);
  #pragma unroll
  for(int r=4;r<16;r+=4){a=max3f(a,p0[r],p0[r+1]);b=max3f(b,p0[r+2],p0[r+3]);a=max3f(a,p1[r],p1[r+1]);b=max3f(b,p1[r+2],p1[r+3]);}
  const float m=max2f(a,b);
  auto rr=__builtin_amdgcn_permlane32_swap(__float_as_uint(m),__float_as_uint(m),false,false);
  return max2f(__uint_as_float(rr[0]),__uint_as_float(rr[1]));
}
__device__ __forceinline__ void pv(f32x16*o,int vb,bf16x8 pa0,bf16x8 pa1,bf16x8 pa2,bf16x8 pa3){
  #pragma unroll
  for(int d0=0;d0<2;++d0){s16x4 lo[4],hi[4];
    #pragma unroll
    for(int ks=0;ks<4;++ks){
      asm volatile("ds_read_b64_tr_b16 %0,%1 offset:%c2":"=&v"(lo[ks]):"v"(vb),"i"(d0*4096+ks*1024):"memory");
      asm volatile("ds_read_b64_tr_b16 %0,%1 offset:%c2":"=&v"(hi[ks]):"v"(vb),"i"(d0*4096+ks*1024+512):"memory");}
    asm volatile("s_waitcnt lgkmcnt(0)":::"memory");SBAR();
    #define PK(k) (bf16x8){lo[k][0],lo[k][1],lo[k][2],lo[k][3],hi[k][0],hi[k][1],hi[k][2],hi[k][3]}
    o[d0]=__builtin_amdgcn_mfma_f32_32x32x16_bf16(pa0,PK(0),o[d0],0,0,0);
    o[d0]=__builtin_amdgcn_mfma_f32_32x32x16_bf16(pa1,PK(1),o[d0],0,0,0);
    o[d0]=__builtin_amdgcn_mfma_f32_32x32x16_bf16(pa2,PK(2),o[d0],0,0,0);
    o[d0]=__builtin_amdgcn_mfma_f32_32x32x16_bf16(pa3,PK(3),o[d0],0,0,0);
    #undef PK
  }
}

#ifndef ATTN_STORE16
#define ATTN_STORE16(p,v) (*(u32x4*)(p)=(v))
#endif
template<int THRL> __device__ __forceinline__ void attn_unit(int b,int qkcol,int vcol,int ocol,int qb,const bf16*Q,const bf16*__restrict__ K,const bf16*__restrict__ V,bf16*O,char*shm){
  int tid_=threadIdx.x; asm volatile("":"+v"(tid_));
  const int tid=tid_,lane=tid&63,r32=lane&31,hi=lane>>5; const int wid=__builtin_amdgcn_readfirstlane(tid>>6);
  const long rowbase=(long)b*SEQ; const int q0=qb*QB;
  const bf16*Qw=Q+(rowbase+q0+wid*QBLK)*DM+qkcol;
  const bf16*Kh=K+rowbase*DM+qkcol,*Vh=V+rowbase*DM+vcol;
  const unsigned lds0=(unsigned)(uintptr_t)shm;
  float*wsf=(float*)(shm+LDS_WS)+wid*64;
  const bf16*ksrc=Kh+(long)lane*DM+wid*8;
  const bf16*vsrc=Vh+(long)(16*(wid&3)+(lane>>2))*DM+(wid>>2)*32+(lane&3)*8;
  const unsigned kdst=lds0+LDS_K+wid*1024, vdst=lds0+LDS_V+wid*1024;
  #define DMA_K(t,slot) glds16(ksrc+(long)(t)*KVBLK*DM,(unsigned)__builtin_amdgcn_readfirstlane(kdst+(slot)))
  #define DMA_V(t,slot) glds16(vsrc+(long)(t)*KVBLK*DM,(unsigned)__builtin_amdgcn_readfirstlane(vdst+(slot)))
  const int vb0=(int)(lds0+LDS_V)+((lane>>4)&1)*32+(lane&3)*8+(4*hi+((lane&15)>>2))*64;
  const char*Kbase=shm+LDS_K; bf16x8 kf[8];
  const lds_cptr shm3=(lds_cptr)shm; const lds_cptr kp0=shm3+LDS_K+hi*1024+r32*16; const lds_cptr vp0=shm3+LDS_V+((lane>>4)&1)*32+(lane&3)*8+(4*hi+((lane&15)>>2))*64;
  const int NT=(q0+QB)/KVBLK;
  DMA_K(0,0);DMA_V(0,0);DMA_K(1,SLOTB);
  bf16x8 qr[4];
  #pragma unroll
  for(int d0=0;d0<4;++d0)qr[d0]=*reinterpret_cast<const bf16x8*>(&Qw[(long)r32*DM+d0*16+hi*8]);
  float mhat=0.f,l_reg=0.f;f32x16 o[2];o[0]=f32x16{};o[1]=f32x16{};f32x16 negm=f32x16{};asm volatile("":"+v"(negm));
  const int qrel=wid*QBLK+r32;
  #define CMASK(P0,P1,t) do{int jb_=(t)-(NT-4); if(jb_>=0)cmask(P0,P1,jb_,qrel,hi);}while(0)
  bool resc=false;
  #define START(P0,P1) do{ const float rm=rowmax(P0,P1); resc=false; \
    { const float dl=rm; mhat=fadd_s(mhat,dl); \
      _Pragma("unroll") for(int r=0;r<16;++r){P0[r]=fsub_s(P0[r],dl);P1[r]=fsub_s(P1[r],dl);} \
      _Pragma("unroll") for(int r=0;r<16;++r)negm[r]=-mhat; asm volatile("":"+v"(negm)); } \
    _Pragma("unroll") for(int r=0;r<16;++r)P0[r]=__builtin_amdgcn_exp2f(P0[r]); }while(0)
  #define RESC() do{ if(resc){ asm volatile("s_waitcnt lgkmcnt(0)":::"memory"); \
      _Pragma("unroll") for(int d_=0;d_<2;++d_) _Pragma("unroll") for(int r=0;r<16;++r)o[d_][r]*=wsf[crow(r,hi)]; } }while(0)
  f32x16 pA0,pA1,pB0,pB1;
  int sl_prev=0,sl_cur=0,sl_next=SLOTB;
  #define ROT() do{sl_prev=sl_cur;sl_cur=sl_next;sl_next=(sl_next==(NSLOT-1)*SLOTB)?0:sl_next+SLOTB;}while(0)
  DMA_K(2,2*SLOTB);
  WAIT_BAR(3);
  qkt(pA0,pA1,Kbase,qr,negm,r32,hi);asm volatile("s_nop 15\n\ts_nop 7":"+v"(pA0),"+v"(pA1));CMASK(pA0,pA1,0);
  START(pA0,pA1);
  _Pragma("unroll") for(int r=0;r<16;++r)pA1[r]=__builtin_amdgcn_exp2f(pA1[r]);
  WAIT_BAR(0);
  DMA_K(3,0);DMA_V(1,SLOTB);
  ROT();
  kload8(kf,kp0+sl_cur);
  WAIT_BAR(2);
  s16x4 vlo[8],vhi[8]; u32x4 pw0,pw1,pw2,pw3;
  #define PKW(P,B) cvtpk_s(P[B],P[B+1])
  #define PAF(k) __builtin_bit_cast(bf16x8,pw##k)
  #define VFR(i) (bf16x8){vlo[i][0],vlo[i][1],vlo[i][2],vlo[i][3],vhi[i][0],vhi[i][1],vhi[i][2],vhi[i][3]}
  #define PIN(x) asm volatile("":"+v"(x))
  #define MX3(a,b,c) __builtin_fmaxf(__builtin_fmaxf((a),(b)),(c))
  #define GAPA(MF,A0,A1,A2,A3,W0,W1,PW) do{ MF; sacc+=A0; sacc+=A1; sacc+=A2; sacc+=A3; PIN(sacc); W0; W1; PIN(PW); SBAR(); }while(0)
  #define EX(v) __builtin_amdgcn_exp2f(v)
  #define GAPB(MF,X,B) do{ MF; X[B]=EX(X[B]); X[B+1]=EX(X[B+1]); X[B+2]=EX(X[B+2]); X[B+3]=EX(X[B+3]); PIN(X); SBAR(); }while(0)
  #define VRD(i) do{ vlo[i]=vtr(vp_+(((i)>>2)*4096+((i)&3)*1024)); vhi[i]=vtr(vp_+(((i)>>2)*4096+((i)&3)*1024+512)); }while(0)
  #define KRD(G,j) do{ if(G){ kload2(kf,kp0+sl_next,j); SBAR(); } }while(0)
  #define STEP(C0,C1,P0,P1,t,GK,GV,GL) do{ SBAR(); \
    const lds_cptr vp_=vp0+sl_prev; \
    VRD(0); SBAR(); float sacc=(P0[0]+P0[1]); \
    GAPA(C0=__builtin_amdgcn_mfma_f32_32x32x16_bf16(kf[0],qr[0],negm,0,0,0), P0[2],P0[3],P0[4],P0[5],     pw0[0]=PKW(P0,0), pw0[1]=PKW(P0,2), pw0); \
    VRD(4); SBAR(); GAPA(C1=__builtin_amdgcn_mfma_f32_32x32x16_bf16(kf[1],qr[0],negm,0,0,0), P0[6],P0[7],P0[8],P0[9],     pw0[2]=PKW(P0,4), pw0[3]=PKW(P0,6), pw0); \
    VRD(1); SBAR(); GAPA(C0=__builtin_amdgcn_mfma_f32_32x32x16_bf16(kf[2],qr[1],C0,0,0,0),   P0[10],P0[11],P0[12],P0[13], pw1[0]=PKW(P0,8), pw1[1]=PKW(P0,10), pw1); \
    VRD(5); SBAR(); GAPA(C1=__builtin_amdgcn_mfma_f32_32x32x16_bf16(kf[3],qr[1],C1,0,0,0),   P0[14],P0[15],P1[0],P1[1],   pw1[2]=PKW(P0,12),pw1[3]=PKW(P0,14), pw1); \
    VRD(2); SBAR(); GAPA(C0=__builtin_amdgcn_mfma_f32_32x32x16_bf16(kf[4],qr[2],C0,0,0,0),   P1[2],P1[3],P1[4],P1[5],     pw2[0]=PKW(P1,0), pw2[1]=PKW(P1,2), pw2); \
    VRD(6); SBAR(); GAPA(C1=__builtin_amdgcn_mfma_f32_32x32x16_bf16(kf[5],qr[2],C1,0,0,0),   P1[6],P1[7],P1[8],P1[9],     pw2[2]=PKW(P1,4), pw2[3]=PKW(P1,6), pw2); \
    VRD(3); SBAR(); GAPA(C0=__builtin_amdgcn_mfma_f32_32x32x16_bf16(kf[6],qr[3],C0,0,0,0),   P1[10],P1[11],P1[12],P1[13], pw3[0]=PKW(P1,8), pw3[1]=PKW(P1,10), pw3); \
    VRD(7); SBAR(); GAPA(C1=__builtin_amdgcn_mfma_f32_32x32x16_bf16(kf[7],qr[3],C1,0,0,0),   P1[14],P1[15],0.f,0.f,       pw3[2]=PKW(P1,12),pw3[3]=PKW(P1,14), pw3); \
    l_reg+=sacc; \
    if(GK){DMA_K((t)+3,sl_cur);} if(GV){DMA_V((t)+1,sl_next);} \
    CMASK(C0,C1,t); \
    { float a=MX3(C0[0],C0[1],C1[0]),b=MX3(C0[2],C0[3],C1[1]); a=MX3(a,C1[2],C1[3]); \
      _Pragma("unroll") for(int r=4;r<16;r+=4){a=MX3(a,C0[r],C0[r+1]);b=MX3(b,C0[r+2],C0[r+3]);a=MX3(a,C1[r],C1[r+1]);b=MX3(b,C1[r+2],C1[r+3]);} \
      float rm=__builtin_fmaxf(a,b); { auto rr=__builtin_amdgcn_permlane32_swap(__float_as_uint(rm),__float_as_uint(rm),false,false); rm=__builtin_fmaxf(__uint_as_float(rr[0]),__uint_as_float(rr[1])); } \
      resc=false; \
      if(__builtin_expect(__any(rm>(float)THRL),0)){ const float dl=__builtin_fmaxf(rm,0.f); mhat+=dl; \
        _Pragma("unroll") for(int r=0;r<16;++r){C0[r]-=dl;C1[r]-=dl;} \
        _Pragma("unroll") for(int r=0;r<16;++r)negm[r]=-mhat; asm volatile("":"+v"(negm)); \
        const float f=__builtin_amdgcn_exp2f(-dl); l_reg*=f; if(hi==0)wsf[r32]=f; resc=true; } } \
    SBAR(); \
    GAPB(o[0]=__builtin_amdgcn_mfma_f32_32x32x16_bf16(PAF(0),VFR(0),o[0],0,0,0), C0,0); \
    GAPB(o[1]=__builtin_amdgcn_mfma_f32_32x32x16_bf16(PAF(0),VFR(4),o[1],0,0,0), C0,4); \
    KRD(GL,0); GAPB(o[0]=__builtin_amdgcn_mfma_f32_32x32x16_bf16(PAF(1),VFR(1),o[0],0,0,0), C0,8); \
    KRD(GL,1); GAPB(o[1]=__builtin_amdgcn_mfma_f32_32x32x16_bf16(PAF(1),VFR(5),o[1],0,0,0), C0,12); \
    KRD(GL,2); GAPB(o[0]=__builtin_amdgcn_mfma_f32_32x32x16_bf16(PAF(2),VFR(2),o[0],0,0,0), C1,0); \
    KRD(GL,3); GAPB(o[1]=__builtin_amdgcn_mfma_f32_32x32x16_bf16(PAF(2),VFR(6),o[1],0,0,0), C1,4); \
    GAPB(o[0]=__builtin_amdgcn_mfma_f32_32x32x16_bf16(PAF(3),VFR(3),o[0],0,0,0), C1,8); \
    GAPB(o[1]=__builtin_amdgcn_mfma_f32_32x32x16_bf16(PAF(3),VFR(7),o[1],0,0,0), C1,12); \
    }while(0)
  int t=1;
  #undef CMASK
  #define CMASK(P0,P1,t) do{}while(0)
  for(;t+5<NT;t+=2){
    STEP(pB0,pB1,pA0,pA1,t,true,true,true);     WAIT_BAR(2); RESC(); ROT();
    STEP(pA0,pA1,pB0,pB1,t+1,true,true,true);   WAIT_BAR(2); RESC(); ROT();
  }
  #undef CMASK
  #define CMASK(P0,P1,t) do{int jb_=(t)-(NT-4); if(jb_>=0)cmask(P0,P1,jb_,qrel,hi);}while(0)
  #define ENDW(tt) do{ if((tt)+3<NT){WAIT_BAR(2);} else if((tt)+2<NT){WAIT_BAR(1);} else {WAIT_BAR(0);} }while(0)
  for(;t+1<NT;t+=2){
    STEP(pB0,pB1,pA0,pA1,t,(t+3<NT),(t+1<NT),(t+1<NT));       ENDW(t);   RESC(); ROT();
    STEP(pA0,pA1,pB0,pB1,t+1,(t+4<NT),(t+2<NT),(t+2<NT));     ENDW(t+1); RESC(); ROT();
  }
  STEP(pB0,pB1,pA0,pA1,NT-1,false,false,false); RESC();
  { float sacc=pB0[0]+pB0[1]; _Pragma("unroll") for(int r=2;r<16;++r)sacc+=pB0[r]; _Pragma("unroll") for(int r=0;r<16;++r)sacc+=pB1[r]; l_reg+=sacc;
    pw0=(u32x4){PKW(pB0,0),PKW(pB0,2),PKW(pB0,4),PKW(pB0,6)};pw1=(u32x4){PKW(pB0,8),PKW(pB0,10),PKW(pB0,12),PKW(pB0,14)};pw2=(u32x4){PKW(pB1,0),PKW(pB1,2),PKW(pB1,4),PKW(pB1,6)};pw3=(u32x4){PKW(pB1,8),PKW(pB1,10),PKW(pB1,12),PKW(pB1,14)};
    SBAR(); pv(o,vb0+sl_cur,PAF(0),PAF(1),PAF(2),PAF(3)); }
  #undef PKW
  #undef PAF
  #undef VFR
  #undef PIN
  #undef MX3
  #undef GAPA
  #undef GAPB
  #undef EX
  #undef VRD
  #undef KRD
  #undef STEP
  #undef ENDW
  {auto rr=__builtin_amdgcn_permlane32_swap(__float_as_uint(l_reg),__float_as_uint(l_reg),false,false);l_reg=__uint_as_float(rr[0])+__uint_as_float(rr[1]);}
  if(hi==0)wsf[32+r32]=l_reg;asm volatile("s_waitcnt lgkmcnt(0)":::"memory");
  float rli[16];
  #pragma unroll
  for(int r=0;r<16;++r)rli[r]=__builtin_amdgcn_rcpf(wsf[32+crow(r,hi)]);
  bf16*Ow=O+(rowbase+q0+wid*QBLK)*DM+ocol;
  { bf16*stg=(bf16*)(shm+LDS_OST)+wid*2048;
    #pragma unroll
    for(int r=0;r<16;++r){const int orow=crow(r,hi);
      #pragma unroll
      for(int d0=0;d0<2;++d0)stg[orow*64+d0*32+r32]=__float2bfloat16(o[d0][r]*rli[r]);}
    asm volatile("s_waitcnt lgkmcnt(0)":::"memory");
    #pragma unroll
    for(int i=0;i<4;++i){const int row=i*8+(lane>>3),ch=lane&7; const u32x4 v=*(const u32x4*)(stg+row*64+ch*8); ATTN_STORE16(Ow+(long)row*DM+ch*8,v);} }
  asm volatile("s_waitcnt lgkmcnt(0)\n\ts_barrier":::"memory");
  #undef DMA_K
  #undef DMA_V
  #undef CMASK
  #undef START
  #undef RESC
  #undef ROT
}
constexpr int ATTN_LDS_BYTES=LDS_BYTES;
struct AttnTensors { const bf16* Q; const bf16* K; const bf16* V; bf16* O0; bf16* O1; };
struct AttnUnit { int b, h, c, e, qb; };
struct StaticOrder {
  int vcu, G;
  __device__ __forceinline__ explicit StaticOrder(int grid,int block):vcu((grid%8==0)?(block%8)*(grid/8)+block/8:block),G(grid){}
  __device__ __forceinline__ bool next(int i,AttnUnit&u)const{ const int per=32; const int trip=vcu+(i/per)*G; if(trip>=BATCH*16*2)return false; const int j=i%per;
    u.b=trip>>5; u.h=(trip>>1)&15; u.c=trip&1; u.e=j>>4; u.qb=15-(j&15); return true; }
  __device__ __forceinline__ void a_ready(const AttnUnit&)const{}
  __device__ __forceinline__ void done(const AttnUnit&)const{}
};
template<class Sched,int THRL=8> __device__ __forceinline__ void attn_phase(char*lds,const AttnTensors&T,const Sched&S){
  AttnUnit u;
  for(int i=0;S.next(i,u);++i){ S.a_ready(u); attn_unit<THRL>(u.b,u.h*128+u.c*64,u.h*128+u.e*64,u.h*128+u.e*64,u.qb,T.Q,T.K,T.V,u.c?T.O1:T.O0,lds); S.done(u); }
}
#undef SBAR
#undef WAIT_BAR
}

constexpr int NWAVES = 8;
#ifndef MK_PER_PHASE
#define MK_PER_PHASE 0
#endif

constexpr int BATCH = 8, SEQ = 4096, DMODEL = 2048, MROWS = BATCH * SEQ, DFF = 8192, NHEADS = 16, HD = 128;
constexpr int GDN_PROJ = 8224, GDN_MAIN = 8192, CONVC = 6144, NCG = MROWS / 64;
constexpr float ALPHA_RES = 1.6817928305074292f;
constexpr float LN_EPS = 1e-5f, GDN_EPS = 1e-6f, SUBLN_EPS = 1e-5f;
constexpr int N_PHASES = 39;

constexpr size_t MiB = 1u << 20;
constexpr size_t WS_CTL = 0, CTL_ZERO_BYTES = 1 * MiB;
constexpr size_t WS_ONES = 1 * MiB, WS_ZEROS = WS_ONES + 8192, WS_MU = WS_ONES + 65536, WS_RSTD = WS_MU + 131072;
constexpr size_t WS_BETA = 2 * MiB, WS_G = 4 * MiB;
constexpr size_t WS_HALO = 9 * MiB;
constexpr size_t WS_WA = 27 * MiB, WS_WB = 60 * MiB;
constexpr size_t WS_ATTN = 27 * MiB;
constexpr size_t WS_XB = 92 * MiB;
constexpr size_t WS_Y = 220 * MiB;
constexpr size_t WS_R1 = 476 * MiB;
constexpr size_t WS_END = 988 * MiB;
constexpr size_t QTR = 128 * MiB;
constexpr int CW_TMO = 0;
constexpr int CW_BAR = 4096;

constexpr int RING_OFF = 0, RING_BYTES = 131072;
constexpr int LDSCTL_OFF = RING_BYTES, MISC_OFF = LDSCTL_OFF + 320;
constexpr int LDS_BYTES = 147456;
static_assert(MISC_OFF + 128 <= LDS_BYTES, "LDS map");

#define GAS __attribute__((address_space(1)))
#define LAS __attribute__((address_space(3)))
typedef unsigned short bf16;
typedef unsigned v4u __attribute__((ext_vector_type(4)));
typedef unsigned v2u __attribute__((ext_vector_type(2)));
typedef float f32x4 __attribute__((ext_vector_type(4)));
typedef float f32x16 __attribute__((ext_vector_type(16)));
typedef short bf16x8 __attribute__((ext_vector_type(8)));
typedef GAS unsigned gu32;
typedef GAS unsigned long long gu64;
#define RLX_AGENT __ATOMIC_RELAXED, __HIP_MEMORY_SCOPE_AGENT
#define LDS_WAIT() asm volatile("s_waitcnt lgkmcnt(0)" ::: "memory")
#define VM_WAIT() asm volatile("s_waitcnt vmcnt(0)" ::: "memory")
#define WG_BAR() asm volatile("s_waitcnt lgkmcnt(0)\n\ts_barrier" ::: "memory")
typedef float f32x2_t_ __attribute__((ext_vector_type(2))); typedef __bf16 bf16x2_t_ __attribute__((ext_vector_type(2)));
__device__ __forceinline__ unsigned pk2(float lo, float hi) { f32x2_t_ v = {lo, hi}; bf16x2_t_ b = __builtin_convertvector(v, bf16x2_t_); return __builtin_bit_cast(unsigned, b); }
__device__ __forceinline__ unsigned f2bf(float f) { return pk2(f, 0.f) & 0xffffu; }
__device__ __forceinline__ float bflo(unsigned w) { return __builtin_bit_cast(float, w << 16); }
__device__ __forceinline__ float bfhi(unsigned w) { return __builtin_bit_cast(float, w & 0xffff0000u); }
__device__ __forceinline__ float bf2f(bf16 h) { return __builtin_bit_cast(float, (unsigned)h << 16); }
__device__ __forceinline__ float fast_exp(float x) { return __builtin_amdgcn_exp2f(x * 1.4426950408889634f); }
__device__ __forceinline__ float silu_f(float x) { return x * __builtin_amdgcn_rcpf(1.f + __expf(-x)); }

#define XB_TMO      128
#define XB_XCNT(j)  (256  + 64 * (j))
#define XB_XSUB(j)  (1280 + 64 * (j))
#define XB_XGEN(j)  (2304 + 64 * (j))
#define XB_TOP      3328
#define XB_TOPGEN   3392
#define XCD_BAR_WORDS 3456
#define XB_SPIN_CAP (1u << 18)

__device__ __forceinline__ unsigned xb_ld(unsigned* p)              { return __hip_atomic_load(p, __ATOMIC_RELAXED, __HIP_MEMORY_SCOPE_AGENT); }
__device__ __forceinline__ unsigned xb_add(unsigned* p, unsigned v) { return __hip_atomic_fetch_add(p, v, __ATOMIC_RELAXED, __HIP_MEMORY_SCOPE_AGENT); }
__device__ __forceinline__ unsigned xb_xcc_id() { return (unsigned)__builtin_amdgcn_s_getreg((3 << 11) | 20) & 0xFu; }
#define XB_SPIN(cond, bar) do { unsigned _sp = 0; while (cond) { __builtin_amdgcn_s_sleep(1); \
    if ((++_sp & 255u) == 0u) { if (xb_ld(&(bar)[XB_TMO])) break; if (_sp > XB_SPIN_CAP) { atomicAdd(&(bar)[XB_TMO], 1u); break; } } } } while (0)

struct XcdBarrier {
    unsigned* bar; unsigned x;
    volatile LAS unsigned* st;
};
__device__ __forceinline__ XcdBarrier xcd_barrier_post(unsigned* bar, volatile LAS unsigned* st) {
    XcdBarrier b; b.bar = bar; b.x = xb_xcc_id(); b.st = st;
    if (threadIdx.x == 0) (void)xb_add(&bar[XB_XCNT(b.x)], 1u);
    return b;
}
__device__ __forceinline__ void xcd_barrier_complete(unsigned* bar, unsigned x, unsigned& nloc, unsigned& nx) {
    const unsigned G = gridDim.x * gridDim.y * gridDim.z;
    unsigned sum, cnt, mine, sp = 0u;
    for (;;) {
        sum = 0u; cnt = 0u; mine = 0u;
#pragma unroll
        for (unsigned j = 0; j < 16; ++j) { const unsigned c = xb_ld(&bar[XB_XCNT(j)]); sum += c; cnt += (c > 0u) ? 1u : 0u; mine = (j == x) ? c : mine; }
        if (sum == G) break;
        __builtin_amdgcn_s_sleep(1);
        if ((++sp & 255u) == 0u) { if (xb_ld(&bar[XB_TMO])) break; if (sp > XB_SPIN_CAP) { atomicAdd(&bar[XB_TMO], 1u); break; } }
    }
    nloc = mine > 0u ? mine : 1u; nx = cnt > 0u ? cnt : 1u;
}
__device__ __forceinline__ void xcd_barrier(const XcdBarrier& b) {
    asm volatile("s_waitcnt vmcnt(0)" ::: "memory");
    __syncthreads();
    if (threadIdx.x == 0) {
        unsigned* bar = b.bar;
        __builtin_amdgcn_s_waitcnt(0);
        unsigned nloc = b.st[0], nx = b.st[1];
        if (nloc == 0u) { xcd_barrier_complete(bar, b.x, nloc, nx); b.st[0] = nloc; b.st[1] = nx; }
        const unsigned old = xb_add(&bar[XB_XSUB(b.x)], 1u);
        const unsigned gen = old / nloc;
        if (old + 1u == (gen + 1u) * nloc) {
            __builtin_amdgcn_fence(__ATOMIC_RELEASE, "agent");
            asm volatile("s_waitcnt vmcnt(0)" ::: "memory");
            const unsigned og = xb_add(&bar[XB_TOP], 1u);
            const unsigned tg = og / nx;
            if (og + 1u == (tg + 1u) * nx) xb_add(&bar[XB_TOPGEN], 1u);
            else XB_SPIN(xb_ld(&bar[XB_TOPGEN]) == tg, bar);
            __builtin_amdgcn_fence(__ATOMIC_ACQUIRE, "agent");
            xb_add(&bar[XB_XGEN(b.x)], 1u);
            asm volatile("s_waitcnt vmcnt(0)" ::: "memory");
        } else {
            XB_SPIN(xb_ld(&bar[XB_XGEN(b.x)]) == gen, bar);
            __builtin_amdgcn_fence(__ATOMIC_ACQUIRE, "agent");
            asm volatile("s_waitcnt vmcnt(0)" ::: "memory");
        }
    }
    __syncthreads();
}

__device__ __forceinline__ float wave_sum(float v) {
#pragma unroll
    for (int o = 1; o < 64; o <<= 1) v += __shfl_xor(v, o);
    return v;
}
__device__ __forceinline__ float sum16(float v) {
    v += __shfl_xor(v, 1); v += __shfl_xor(v, 2); v += __shfl_xor(v, 4); v += __shfl_xor(v, 8); return v;
}
__device__ __forceinline__ void transpose_item(const float* W, int K, int ldw, int n_begin, int nblk, bf16* WT, int row_off, LAS float* scr, int item, int lane) {
    const int kb = item / nblk, nb = item % nblk, k0 = 64 * kb, n0 = 32 * nb;
    float wv[32];
#pragma unroll
    for (int i = 0; i < 32; ++i) wv[i] = W[(size_t)(k0 + 2 * i + (lane >> 5)) * ldw + n_begin + n0 + (lane & 31)];
#pragma unroll
    for (int i = 0; i < 32; ++i) scr[(2 * i + (lane >> 5)) * 33 + (lane & 31)] = wv[i];
    LDS_WAIT(); asm volatile("" ::: "memory");
    const int c = lane & 7;
#pragma unroll
    for (int j = 0; j < 4; ++j) { const int n = (lane >> 3) + 8 * j; const LAS float* s = scr + (8 * c) * 33 + n;
        v4u o; o.x = pk2(s[0 * 33], s[1 * 33]); o.y = pk2(s[2 * 33], s[3 * 33]); o.z = pk2(s[4 * 33], s[5 * 33]); o.w = pk2(s[6 * 33], s[7 * 33]);
        *(GAS v4u*)(WT + (size_t)(row_off + n0 + n) * K + k0 + 8 * c) = o; }
    LDS_WAIT(); asm volatile("" ::: "memory");
}
__device__ __forceinline__ void convert_w(LAS unsigned char* lds, int gw, int NGW, int wave, int lane, const float* W, int K, int ldw, int n_begin, int ncols, bf16* WT, int row_off) {
    LAS float* scr = (LAS float*)(lds + RING_OFF + wave * 16384);
    const int nblk = ncols / 32, nitems = (K / 64) * nblk;
    for (int it = gw; it < nitems; it += NGW) transpose_item(W, K, ldw, n_begin, nblk, WT, row_off, scr, it, lane);
}
__device__ __forceinline__ void row_to_bf16(const float* xrow, bf16* orow, int lane) {
    const GAS f32x4* xr = (const GAS f32x4*)xrow + lane; GAS v2u* o8 = (GAS v2u*)orow + lane;
#pragma unroll
    for (int j = 0; j < 8; ++j) { const f32x4 v = xr[64 * j]; v2u w; w.x = pk2(v.x, v.y); w.y = pk2(v.z, v.w); o8[64 * j] = w; }
}
__device__ __forceinline__ void ln_row(const float* yrow, const float* g, const float* b, float* mu, float* rstd, bf16* xbrow, float* outrow, int lane) {
    const GAS f32x4* yr = (const GAS f32x4*)yrow + lane;
    f32x4 v[8]; float s = 0.f;
#pragma unroll
    for (int j = 0; j < 8; ++j) { v[j] = yr[64 * j]; s += (v[j].x + v[j].y) + (v[j].z + v[j].w); }
    const float mean = wave_sum(s) * (1.f / DMODEL); float s2 = 0.f;
#pragma unroll
    for (int j = 0; j < 8; ++j) { v[j] = v[j] - mean; s2 += (v[j].x * v[j].x + v[j].y * v[j].y) + (v[j].z * v[j].z + v[j].w * v[j].w); }
    const float rs = 1.f / sqrtf(wave_sum(s2) * (1.f / DMODEL) + LN_EPS);
    if (lane == 0) { *mu = mean; *rstd = rs; }
    const GAS f32x4* gr = (const GAS f32x4*)g + lane; const GAS f32x4* br = (const GAS f32x4*)b + lane;
#pragma unroll
    for (int j = 0; j < 8; ++j) { const f32x4 o = (v[j] * rs) * gr[64 * j] + br[64 * j];
        if (xbrow) { v2u w; w.x = pk2(o.x, o.y); w.y = pk2(o.z, o.w); ((GAS v2u*)xbrow + lane)[64 * j] = w; }
        if (outrow) ((GAS f32x4*)outrow + lane)[64 * j] = o; }
}

__device__ __forceinline__ void ln_pass(const float* y, const float* g, const float* b, float* mu, float* rstd, bf16* xb, float* outf, int gw, int NGW, int lane) {
    for (int m = gw; m < MROWS; m += 2 * NGW) {
        const int m1 = m + NGW;
        if (m1 >= MROWS) { ln_row(y + (size_t)m * DMODEL, g, b, mu + m, rstd + m, xb ? xb + (size_t)m * DMODEL : nullptr, outf ? outf + (size_t)m * DMODEL : nullptr, lane); continue; }
        const GAS f32x4* y0 = (const GAS f32x4*)(y + (size_t)m * DMODEL) + lane; const GAS f32x4* y1 = (const GAS f32x4*)(y + (size_t)m1 * DMODEL) + lane;
        f32x4 v0[8], v1[8]; float s0 = 0.f, s1 = 0.f;
#pragma unroll
        for (int j = 0; j < 8; ++j) { v0[j] = y0[64 * j]; v1[j] = y1[64 * j]; }
#pragma unroll
        for (int j = 0; j < 8; ++j) { s0 += (v0[j].x + v0[j].y) + (v0[j].z + v0[j].w); s1 += (v1[j].x + v1[j].y) + (v1[j].z + v1[j].w); }
#pragma unroll
        for (int o = 1; o < 64; o <<= 1) { s0 += __shfl_xor(s0, o); s1 += __shfl_xor(s1, o); }
        const float mean0 = s0 * (1.f / DMODEL), mean1 = s1 * (1.f / DMODEL); float q0 = 0.f, q1 = 0.f;
#pragma unroll
        for (int j = 0; j < 8; ++j) { v0[j] = v0[j] - mean0; v1[j] = v1[j] - mean1;
            q0 += (v0[j].x * v0[j].x + v0[j].y * v0[j].y) + (v0[j].z * v0[j].z + v0[j].w * v0[j].w); q1 += (v1[j].x * v1[j].x + v1[j].y * v1[j].y) + (v1[j].z * v1[j].z + v1[j].w * v1[j].w); }
#pragma unroll
        for (int o = 1; o < 64; o <<= 1) { q0 += __shfl_xor(q0, o); q1 += __shfl_xor(q1, o); }
        const float rs0 = 1.f / sqrtf(q0 * (1.f / DMODEL) + LN_EPS), rs1 = 1.f / sqrtf(q1 * (1.f / DMODEL) + LN_EPS);
        if (lane == 0) { mu[m] = mean0; rstd[m] = rs0; mu[m1] = mean1; rstd[m1] = rs1; }
        const GAS f32x4* gr = (const GAS f32x4*)g + lane; const GAS f32x4* br = (const GAS f32x4*)b + lane;
#pragma unroll
        for (int j = 0; j < 8; ++j) { const f32x4 gg = gr[64 * j], bb = br[64 * j]; const f32x4 o0 = (v0[j] * rs0) * gg + bb, o1 = (v1[j] * rs1) * gg + bb;
            if (xb) { v2u w0, w1; w0.x = pk2(o0.x, o0.y); w0.y = pk2(o0.z, o0.w); w1.x = pk2(o1.x, o1.y); w1.y = pk2(o1.z, o1.w);
                ((GAS v2u*)(xb + (size_t)m * DMODEL) + lane)[64 * j] = w0; ((GAS v2u*)(xb + (size_t)m1 * DMODEL) + lane)[64 * j] = w1; }
            if (outf) { ((GAS f32x4*)(outf + (size_t)m * DMODEL) + lane)[64 * j] = o0; ((GAS f32x4*)(outf + (size_t)m1 * DMODEL) + lane)[64 * j] = o1; } }
    }
}
#define MFMA32(a, b, c) __builtin_amdgcn_mfma_f32_32x32x16_bf16((a), (b), (c), 0, 0, 0)

__device__ __forceinline__ void ba_proj(const bf16* xb, const bf16* wt  , const float* a_log, const float* dt_bias, float* beta, float* g, int gw, int NGW, int lane) {
    const int r32 = lane & 31, hi = lane >> 5;
    for (int wu = gw; wu < MROWS / 32; wu += NGW) {
        const bf16* ap = xb + (size_t)(wu * 32 + r32) * DMODEL + 8 * hi; const bf16* bp = wt + (size_t)(GDN_MAIN + r32) * DMODEL + 8 * hi;
        f32x16 acc = {};
#pragma unroll 1
        for (int s0 = 0; s0 < DMODEL / 16; s0 += 8) {
            bf16x8 a[8], b[8];
#pragma unroll
            for (int s = 0; s < 8; ++s) { a[s] = *(const bf16x8*)(ap + (s0 + s) * 16); b[s] = *(const bf16x8*)(bp + (s0 + s) * 16); }
#pragma unroll
            for (int s = 0; s < 8; ++s) acc = MFMA32(a[s], b[s], acc);
        }
        const int j = r32 & 15; const float al = -__expf(a_log[j]), db = dt_bias[j];
#pragma unroll
        for (int r = 0; r < 16; ++r) { const int t = wu * 32 + (r & 3) + 8 * (r >> 2) + 4 * hi; const float v = acc[r];
            if (r32 < 16) beta[(size_t)t * 16 + j] = __builtin_amdgcn_rcpf(1.f + __expf(-v));
            else { const float z = v + db; const float sp = z > 20.f ? z : log1pf(__expf(z)); g[(size_t)t * 16 + j] = al * sp; } }
    }
}

typedef short bf16x4 __attribute__((ext_vector_type(4)));
#define MFMA16K16(a, b, c) __builtin_amdgcn_mfma_f32_16x16x16bf16_1k((a), (b), (c), 0, 0, 0)
constexpr int G2_TS = 136;
constexpr int G2_AS = 68, G2_ANS = 72;
constexpr int G2_A = 0, G2_GC = G2_A + 64 * G2_AS * 4, G2_BT = G2_GC + 256, G2_AN = G2_BT + 256, G2_TB = G2_AN + 64 * G2_ANS * 2, G2_Q = G2_TB + 2048, G2_K = G2_Q + 64 * G2_TS * 2, G2_V = G2_K + 64 * G2_TS * 2,
              G2_W = G2_V + 64 * G2_TS * 2, G2_END = G2_W + 64 * G2_TS * 2;
static_assert(G2_END <= RING_BYTES, "G2 LDS");
__device__ __forceinline__ bf16x4 pack4(f32x4 v) { v2u w; w.x = pk2(v[0], v[1]); w.y = pk2(v[2], v[3]); return __builtin_bit_cast(bf16x4, w); }
__device__ __forceinline__ void gdn_chunk_phase(LAS unsigned char* lds, bf16* p, const bf16* halo, const float* beta, float* g, bf16* wbuf, bf16* attn, const float* conv_w, int vcu, int G, bf16* palt = nullptr) {
#define G2_ST(off) ((palt ? palt + ((size_t)(off) & 0x7ffffffull) : p + (size_t)(off)))
    int tid_ = threadIdx.x; asm volatile("" : "+v"(tid_));
    const int tid0 = tid_, lane0 = tid0 & 63, wid0 = __builtin_amdgcn_readfirstlane(tid0 >> 6);
    LAS bf16* Qs = (LAS bf16*)(lds + G2_Q); LAS bf16* Ks = (LAS bf16*)(lds + G2_K); LAS bf16* Vs = (LAS bf16*)(lds + G2_V); LAS bf16* Ws = (LAS bf16*)(lds + G2_W);
    LAS float* As = (LAS float*)(lds + G2_A); LAS float* gcs = (LAS float*)(lds + G2_GC); LAS float* bts = (LAS float*)(lds + G2_BT);
    LAS bf16* An = (LAS bf16*)(lds + G2_AN); LAS bf16* Tb = (LAS bf16*)(lds + G2_TB);
    asm volatile("" : "+v"(Qs), "+v"(Ks), "+v"(Vs), "+v"(Ws), "+v"(As), "+v"(gcs), "+v"(bts), "+v"(An), "+v"(Tb));
    v4u rawv[3][5]; float gpre = 0.f, bpre = 0.f;
#define G2_LOAD_RAW(uu, LN, WD) do { const int cg_ = (uu) >> 4, h_ = (uu) & 15, n_ = cg_ & 63; const size_t r0_ = (size_t)cg_ * 64; const int cgp_l = (LN) & 15, tA_l = 8 * (WD) + 2 * ((LN) >> 4); \
        _Pragma("unroll") for (int X = 0; X < 3; ++X) { const int col_ = X * 2048 + h_ * HD + 8 * cgp_l; \
            _Pragma("unroll") for (int rr = 0; rr < 5; ++rr) { const int rel = tA_l - 3 + rr; v4u v = {0u, 0u, 0u, 0u}; \
                if (rel >= 0) v = *(const v4u*)(p + (r0_ + rel) * GDN_MAIN + col_); \
                else if (n_ > 0) v = *(const v4u*)(halo + ((size_t)(cg_ - 1) * 3 + (rel + 3)) * CONVC + col_); \
                rawv[X][rr] = v; } } \
        if ((WD) == 0) { gpre = g[(r0_ + (LN)) * 16 + h_]; bpre = beta[(r0_ + (LN)) * 16 + h_]; } } while (0)
    if (vcu < NCG * NHEADS) G2_LOAD_RAW(vcu, lane0, wid0);
    for (int u = vcu; u < NCG * NHEADS; u += G) {
        const int cg = u >> 4, h = u & 15; const size_t row0 = (size_t)cg * 64;
        int tl_ = tid0; asm volatile("" : "+v"(tl_));
        const int tid = tl_, lane = tid & 63, wid = __builtin_amdgcn_readfirstlane(tid >> 6), r32 = lane & 31, hi = lane >> 5;
        {
            const int cgp = lane & 15, sub = lane >> 4, tA = 8 * wid + 2 * sub;
#pragma unroll
            for (int X = 0; X < 3; ++X) {
                const int col = X * 2048 + h * HD + 8 * cgp;
                float raw[5][8];
                asm volatile("" : "+v"(rawv[X][0]), "+v"(rawv[X][1]), "+v"(rawv[X][2]), "+v"(rawv[X][3]), "+v"(rawv[X][4]));
#pragma unroll
                for (int rr = 0; rr < 5; ++rr) { const v4u v = rawv[X][rr];
                    raw[rr][0] = bflo(v.x); raw[rr][1] = bfhi(v.x); raw[rr][2] = bflo(v.y); raw[rr][3] = bfhi(v.y); raw[rr][4] = bflo(v.z); raw[rr][5] = bfhi(v.z); raw[rr][6] = bflo(v.w); raw[rr][7] = bfhi(v.w); }
                float o0[8], o1[8];
#pragma unroll
                for (int c = 0; c < 8; ++c) { o0[c] = 0.f; o1[c] = 0.f; }
#pragma unroll
                for (int j = 0; j < 4; ++j) { const f32x4 wa = *(const f32x4*)(conv_w + (size_t)j * CONVC + col), wb = *(const f32x4*)(conv_w + (size_t)j * CONVC + col + 4);
#pragma unroll
                    for (int c = 0; c < 8; ++c) { const float w = c < 4 ? wa[c] : wb[c - 4]; o0[c] += w * raw[j][c]; o1[c] += w * raw[j + 1][c]; } }
                float s0 = 0.f, s1 = 0.f;
#pragma unroll
                for (int c = 0; c < 8; ++c) { o0[c] = silu_f(o0[c]); o1[c] = silu_f(o1[c]); s0 += o0[c] * o0[c]; s1 += o1[c] * o1[c]; }
                if (X < 2) { s0 = sum16(s0); s1 = sum16(s1); const float sc = X == 0 ? 0.08838834764831845f : 1.f; const float f0 = sc * __builtin_amdgcn_rsqf(s0 + GDN_EPS), f1 = sc * __builtin_amdgcn_rsqf(s1 + GDN_EPS);
#pragma unroll
                    for (int c = 0; c < 8; ++c) { o0[c] *= f0; o1[c] *= f1; } }
                LAS bf16* T = X == 0 ? Qs : (X == 1 ? Ks : Vs);
                v4u w0, w1; w0.x = pk2(o0[0], o0[1]); w0.y = pk2(o0[2], o0[3]); w0.z = pk2(o0[4], o0[5]); w0.w = pk2(o0[6], o0[7]);
                w1.x = pk2(o1[0], o1[1]); w1.y = pk2(o1[2], o1[3]); w1.z = pk2(o1[4], o1[5]); w1.w = pk2(o1[6], o1[7]);
                *(LAS v4u*)(T + tA * G2_TS + 8 * cgp) = w0; *(LAS v4u*)(T + (tA + 1) * G2_TS + 8 * cgp) = w1;
                asm volatile("" ::: "memory");
            }
            if (wid == 0) {
                float gv = gpre;
#pragma unroll
                for (int o = 1; o < 64; o <<= 1) { const float t = __shfl_up(gv, o); if (lane >= o) gv += t; }
                gcs[lane] = gv; bts[lane] = bpre; if (!palt) g[(row0 + lane) * 16 + h] = gv;
            }
        }
        __syncthreads();
        if (u + G < NCG * NHEADS) G2_LOAD_RAW(u + G, lane, wid);
        {
            const int rb = (wid >> 1) & 1, cb = wid & 1; const bool isA = wid < 4;
            f32x16 acc = {};
            if (!(rb == 0 && cb == 1)) {
                const LAS bf16* Ar = (isA ? Ks : Qs) + (32 * rb + r32) * G2_TS + 8 * hi; const LAS bf16* Br = Ks + (32 * cb + r32) * G2_TS + 8 * hi;
#pragma unroll
                for (int s = 0; s < 8; ++s) acc = MFMA32(*(const LAS bf16x8*)(Ar + 16 * s), *(const LAS bf16x8*)(Br + 16 * s), acc);
            }
            const int j = 32 * cb + r32; const float gj = gcs[j];
            bf16* at = palt ? palt + (((size_t)u * 4096 + 0x4000000ull) & 0x7ffffffull) : attn + (size_t)u * 4096;
#pragma unroll
            for (int r = 0; r < 16; ++r) { const int i = 32 * rb + (r & 3) + 8 * (r >> 2) + 4 * hi; const float gi = gcs[i];
                if (isA) { const float d = (i > j) ? __expf(gi - gj) : 0.f; const float a = (i > j) ? bts[i] * acc[r] * d : 0.f; As[i * G2_AS + j] = a; An[i * G2_ANS + j] = (bf16)f2bf(-a); }
                else { const float d = (i >= j) ? __expf(gi - gj) : 0.f; at[i * 64 + j] = (bf16)f2bf((i >= j) ? acc[r] * d : 0.f); } }
        }
        __syncthreads();
        if (wid == 0) {
            const int b = lane >> 4, c = lane & 15; float t[16];
            const LAS float* Ab = As + (16 * b) * G2_AS + 16 * b;
#pragma unroll
            for (int i = 0; i < 16; ++i) {
                float ti = (i == c) ? 1.f : 0.f;
#pragma unroll
                for (int j4 = 0; j4 < (i + 3) / 4; ++j4) { const f32x4 a = *(const LAS f32x4*)(Ab + i * G2_AS + 4 * j4);
#pragma unroll
                    for (int k = 0; k < 4; ++k) if (4 * j4 + k < i) ti -= a[k] * t[4 * j4 + k]; }
                t[i] = ti;
            }
#pragma unroll
            for (int i = 0; i < 16; ++i) Tb[b * 256 + i * 16 + c] = (bf16)f2bf(t[i]);
        } else if (wid < 5) {
            const int tt = tid - 64, cgp = tt & 15, r0 = tt >> 4;
#pragma unroll
            for (int r = 0; r < 4; ++r) { const int i = r0 + 16 * r; const float e = __expf(gcs[i]); const v4u v = *(const LAS v4u*)(Qs + i * G2_TS + 8 * cgp); v4u w;
                w.x = pk2(bflo(v.x) * e, bfhi(v.x) * e); w.y = pk2(bflo(v.y) * e, bfhi(v.y) * e); w.z = pk2(bflo(v.z) * e, bfhi(v.z) * e); w.w = pk2(bflo(v.w) * e, bfhi(v.w) * e);
                *(v4u*)G2_ST((row0 + i) * GDN_MAIN + h * HD + 8 * cgp) = w; }
        } else {
            const float gl = gcs[63];
            for (int task = tid - 320; task < 256; task += 192) { const int dk = task & 127, th = task >> 7;
                bf16* dst = G2_ST((row0 + (dk >> 1)) * GDN_MAIN + 2048 + h * HD + (dk & 1) * 64 + 32 * th);
#pragma unroll
                for (int q = 0; q < 4; ++q) { float v[8];
#pragma unroll
                    for (int k = 0; k < 8; ++k) { const int tk = 32 * th + 8 * q + k; v[k] = bf2f(Ks[tk * G2_TS + dk]) * __expf(gl - gcs[tk]); }
                    v4u w; w.x = pk2(v[0], v[1]); w.y = pk2(v[2], v[3]); w.z = pk2(v[4], v[5]); w.w = pk2(v[6], v[7]); *(v4u*)(dst + 8 * q) = w; } }
        }
        __syncthreads();
        {
            const int nl = lane & 15, q = lane >> 4; const bool isK = wid >= 4;
            float rsc[16];
#pragma unroll
            for (int b = 0; b < 4; ++b)
#pragma unroll
                for (int r = 0; r < 4; ++r) { const int row = 16 * b + 4 * q + r; rsc[4 * b + r] = isK ? bts[row] * __expf(gcs[row]) : bts[row]; }
            bf16x4 Tq[4], Aq[6];
#pragma unroll
            for (int b = 0; b < 4; ++b) Tq[b] = *(const LAS bf16x4*)(Tb + b * 256 + nl * 16 + 4 * q);
            Aq[0] = *(const LAS bf16x4*)(An + (16 + nl) * G2_ANS + 4 * q);
            Aq[1] = *(const LAS bf16x4*)(An + (32 + nl) * G2_ANS + 4 * q);      Aq[2] = *(const LAS bf16x4*)(An + (32 + nl) * G2_ANS + 16 + 4 * q);
            Aq[3] = *(const LAS bf16x4*)(An + (48 + nl) * G2_ANS + 4 * q);      Aq[4] = *(const LAS bf16x4*)(An + (48 + nl) * G2_ANS + 16 + 4 * q);   Aq[5] = *(const LAS bf16x4*)(An + (48 + nl) * G2_ANS + 32 + 4 * q);
#pragma unroll
            for (int t = 0; t < 2; ++t) {
                const int cc = 32 * (wid & 3) + 16 * t + nl;
                const LAS bf16* src = (isK ? Ks : Vs) + cc;
                f32x4 R[4];
#pragma unroll
                for (int b = 0; b < 4; ++b)
#pragma unroll
                    for (int r = 0; r < 4; ++r) R[b][r] = rsc[4 * b + r] * bf2f(src[(16 * b + 4 * q + r) * G2_TS]);
                const f32x4 z4 = {0.f, 0.f, 0.f, 0.f};
                const f32x4 y0 = MFMA16K16(Tq[0], pack4(R[0]), z4); const bf16x4 y0b = pack4(y0);
                f32x4 c1 = MFMA16K16(Aq[0], y0b, R[1]);
                const f32x4 y1 = MFMA16K16(Tq[1], pack4(c1), z4); const bf16x4 y1b = pack4(y1);
                f32x4 c2 = MFMA16K16(Aq[1], y0b, R[2]); c2 = MFMA16K16(Aq[2], y1b, c2);
                const f32x4 y2 = MFMA16K16(Tq[2], pack4(c2), z4); const bf16x4 y2b = pack4(y2);
                f32x4 c3 = MFMA16K16(Aq[3], y0b, R[3]); c3 = MFMA16K16(Aq[4], y1b, c3); c3 = MFMA16K16(Aq[5], y2b, c3);
                const f32x4 y3 = MFMA16K16(Tq[3], pack4(c3), z4); const bf16x4 y3b = pack4(y3);
                if (!isK) {
                    bf16* dst = G2_ST((row0 + (cc & 63)) * GDN_MAIN + 4096 + h * HD + (cc >> 6) * 64 + 4 * q);
                    *(bf16x4*)(dst) = y0b; *(bf16x4*)(dst + 16) = y1b; *(bf16x4*)(dst + 32) = y2b; *(bf16x4*)(dst + 48) = y3b;
                } else {
#pragma unroll
                    for (int r = 0; r < 4; ++r) { Ws[(4 * q + r) * G2_TS + cc] = (bf16)y0b[r]; Ws[(16 + 4 * q + r) * G2_TS + cc] = (bf16)y1b[r]; Ws[(32 + 4 * q + r) * G2_TS + cc] = (bf16)y2b[r]; Ws[(48 + 4 * q + r) * G2_TS + cc] = (bf16)y3b[r]; }
                }
            }
        }
        __syncthreads();
#pragma unroll
        for (int k = 0; k < 2; ++k) { const int ch = tid + 512 * k, i = ch >> 4, c8 = ch & 15; *(v4u*)((palt ? palt + (((row0 + i) * DMODEL + h * HD + 8 * c8) & 0x7ffffffull) : wbuf + (row0 + i) * DMODEL + h * HD + 8 * c8)) = *(const LAS v4u*)(Ws + i * G2_TS + 8 * c8); }
    }
#undef G2_ST
#undef G2_LOAD_RAW
}

constexpr int G3_STS = 136, G3_VTS = 72;
constexpr int G3_ST = 0, G3_VT = 64 * G3_STS * 2, G3_END = G3_VT + 64 * G3_VTS * 2;
__device__ __forceinline__ void gdn_scan_phase(LAS unsigned char* lds, bf16* p, const bf16* wbuf, const bf16* attn, const float* g, int vcu, int G, bf16* oalt = nullptr) {
    int tid_ = threadIdx.x; asm volatile("" : "+v"(tid_));
    const int tid = tid_, lane = tid & 63, wid = __builtin_amdgcn_readfirstlane(tid >> 6), r32 = lane & 31, hi = lane >> 5;
    const int role = wid >> 2, a = (wid >> 1) & 1, bb = wid & 1, r = wid >> 1;
    LAS bf16* ST = (LAS bf16*)(lds + G3_ST); LAS bf16* VT = (LAS bf16*)(lds + G3_VT);
    for (int unit = vcu; unit < BATCH * NHEADS * 2; unit += G) {
        const int bh = unit >> 1, e = unit & 1, b = bh >> 4, h = bh & 15;
        for (int i = tid; i < G3_VT / 4; i += NWAVES * 64) ((LAS unsigned*)lds)[i] = 0u;
        f32x16 Sacc = {};
        __syncthreads();
        const bf16* aBase = role == 0 ? wbuf + (size_t)(32 * a + r32) * DMODEL + h * HD + 8 * hi : p + (size_t)(32 * a + r32) * GDN_MAIN + h * HD + 8 * hi;
        const size_t aPitch = role == 0 ? DMODEL : GDN_MAIN;
        const int dkr = 32 * r + r32;
        const bf16* kBase = p + (size_t)(dkr >> 1) * GDN_MAIN + 2048 + h * HD + (dkr & 1) * 64 + 8 * hi;
        const bf16* uBase = p + (size_t)(32 * bb + r32) * GDN_MAIN + 4096 + h * HD + e * 64 + 32 * a + 4 * hi;
        const bf16* pBase = attn + (size_t)(32 * a + r32) * 64 + 8 * hi;
        bf16* oBase = (oalt ? oalt : p + 4096) + h * HD + e * 64 + 32 * bb + r32; const size_t oPitch = oalt ? DMODEL : GDN_MAIN;
        const LAS bf16* sRd = ST + (32 * bb + r32) * G3_STS + 8 * hi; const LAS bf16* vRd = VT + (32 * bb + r32) * G3_VTS + 8 * hi;
        LAS bf16* vWr = VT + (32 * bb + r32) * G3_VTS + 32 * a + 4 * hi; LAS bf16* sWr = ST + (32 * bb + r32) * G3_STS + 32 * r + 4 * hi;
#define G3_LOAD_A(nn) do { const size_t row0_ = (size_t)b * SEQ + (size_t)(nn) * 64; \
            _Pragma("unroll") for (int s = 0; s < 8; ++s) Af[s] = *(const bf16x8*)(aBase + row0_ * aPitch + 16 * s); } while (0)
#define G3_LOAD_U(nn) do { const size_t row0_ = (size_t)b * SEQ + (size_t)(nn) * 64; \
            _Pragma("unroll") for (int q = 0; q < 4; ++q) Uf[q] = *(const v2u*)(uBase + row0_ * GDN_MAIN + 8 * q); } while (0)
#define G3_LOAD_PK(nn) do { const size_t row0_ = (size_t)b * SEQ + (size_t)(nn) * 64; \
            if (role == 1) { const bf16* pp_ = pBase + ((size_t)(b * 64 + (nn)) * 16 + h) * 4096; _Pragma("unroll") for (int s = 0; s < 4; ++s) Pf[s] = *(const bf16x8*)(pp_ + 16 * s); } \
            _Pragma("unroll") for (int s = 0; s < 4; ++s) Kf[s] = *(const bf16x8*)(kBase + row0_ * GDN_MAIN + 16 * s); \
            dd = __expf(g[(row0_ + 63) * 16 + h]); } while (0)
        bf16x8 Af[8], Kf[4], Pf[4]; v2u Uf[4]; float dd;
#pragma unroll
        for (int s = 0; s < 4; ++s) { Pf[s] = (bf16x8){0, 0, 0, 0, 0, 0, 0, 0}; Uf[s] = (v2u){0u, 0u}; }
        G3_LOAD_A(0); if (role == 0) G3_LOAD_U(0); G3_LOAD_PK(0);
#pragma unroll 1
        for (int n = 0; n < 64; ++n) {
            const size_t row0_ = (size_t)b * SEQ + (size_t)n * 64; const int nn = (n + 1 < 64) ? n + 1 : n;
            f32x16 acc_ = {};
#pragma unroll
            for (int s = 0; s < 8; ++s) acc_ = MFMA32(Af[s], *(const LAS bf16x8*)(sRd + 16 * s), acc_);
            G3_LOAD_A(nn);
            if (role == 0) {
#pragma unroll
                for (int q = 0; q < 4; ++q) { v2u w_;
                    w_.x = pk2(bflo(Uf[q].x) - acc_[4 * q], bfhi(Uf[q].x) - acc_[4 * q + 1]); w_.y = pk2(bflo(Uf[q].y) - acc_[4 * q + 2], bfhi(Uf[q].y) - acc_[4 * q + 3]);
                    *(LAS v2u*)(vWr + 8 * q) = w_; }
                G3_LOAD_U(nn);
            }
            WG_BAR();
            bf16x8 Vf_[4];
#pragma unroll
            for (int s = 0; s < 4; ++s) Vf_[s] = *(const LAS bf16x8*)(vRd + 16 * s);
            if (role == 1) {
#pragma unroll
                for (int s = 0; s < 4; ++s) acc_ = MFMA32(Pf[s], Vf_[s], acc_);
#pragma unroll
                for (int rr = 0; rr < 16; ++rr) oBase[(row0_ + 32 * a + (rr & 3) + 8 * (rr >> 2) + 4 * hi) * oPitch] = (bf16)f2bf(acc_[rr]);
            }
            Sacc = Sacc * dd;
#pragma unroll
            for (int s = 0; s < 4; ++s) Sacc = MFMA32(Kf[s], Vf_[s], Sacc);
            G3_LOAD_PK(nn);
#pragma unroll
            for (int q = 0; q < 4; ++q) { v2u w_; w_.x = pk2(Sacc[4 * q], Sacc[4 * q + 1]); w_.y = pk2(Sacc[4 * q + 2], Sacc[4 * q + 3]); *(LAS v2u*)(sWr + 8 * q) = w_; }
            WG_BAR();
        }
#undef G3_LOAD_A
#undef G3_LOAD_U
#undef G3_LOAD_PK
        VM_WAIT(); __syncthreads();
    }
}

__device__ __forceinline__ void gdn_gate_phase(bf16* p, const float* norm_w, int gw, int NGW, int lane, bf16* oalt = nullptr) {
    for (int m = gw; m < MROWS; m += NGW) {
        bf16* orow = p + (size_t)m * GDN_MAIN + 4096; const bf16* zrow = p + (size_t)m * GDN_MAIN + 6144;
#pragma unroll
        for (int it = 0; it < 4; ++it) { const int col = it * 512 + lane * 8;
            const v4u ov = *(const v4u*)(orow + col), zv = *(const v4u*)(zrow + col);
            float o[8] = {bflo(ov.x), bfhi(ov.x), bflo(ov.y), bfhi(ov.y), bflo(ov.z), bfhi(ov.z), bflo(ov.w), bfhi(ov.w)};
            float z[8] = {bflo(zv.x), bfhi(zv.x), bflo(zv.y), bfhi(zv.y), bflo(zv.z), bfhi(zv.z), bflo(zv.w), bfhi(zv.w)};
            float s = 0.f;
#pragma unroll
            for (int c = 0; c < 8; ++c) s += o[c] * o[c];
            s = sum16(s); const float rs = __builtin_amdgcn_rsqf(s * (1.f / HD) + GDN_EPS);
            const f32x4 wa = *(const f32x4*)(norm_w + (col & 127)), wb = *(const f32x4*)(norm_w + (col & 127) + 4);
#pragma unroll
            for (int c = 0; c < 8; ++c) o[c] = o[c] * rs * (c < 4 ? wa[c] : wb[c - 4]) * silu_f(z[c]);
            v4u w; w.x = pk2(o[0], o[1]); w.y = pk2(o[2], o[3]); w.z = pk2(o[4], o[5]); w.w = pk2(o[6], o[7]); *(v4u*)((oalt ? oalt + (size_t)m * DMODEL : orow) + col) = w; }
    }
}

__device__ __forceinline__ void diff_combine_phase(const bf16* o0, const bf16* o1, bf16* og, const float* lam_params  , const float* subln_w, float lambda_init, int gw, int NGW, int lane) {
    const float e1 = wave_sum(lam_params[lane] * lam_params[64 + lane]), e2 = wave_sum(lam_params[128 + lane] * lam_params[192 + lane]);
    const float lam = __expf(e1) - __expf(e2) + lambda_init, post = 1.f - lambda_init;
    for (int m = gw; m < MROWS; m += NGW) {
#pragma unroll
        for (int it = 0; it < 4; ++it) { const int col = it * 512 + lane * 8; const size_t off = (size_t)m * DMODEL + col;
            const v4u av = *(const v4u*)(o0 + off), bv = *(const v4u*)(o1 + off);
            float d[8] = {bflo(av.x) - lam * bflo(bv.x), bfhi(av.x) - lam * bfhi(bv.x), bflo(av.y) - lam * bflo(bv.y), bfhi(av.y) - lam * bfhi(bv.y),
                          bflo(av.z) - lam * bflo(bv.z), bfhi(av.z) - lam * bfhi(bv.z), bflo(av.w) - lam * bflo(bv.w), bfhi(av.w) - lam * bfhi(bv.w)};
            float s = 0.f;
#pragma unroll
            for (int c = 0; c < 8; ++c) s += d[c] * d[c];
            s = sum16(s); const float rs = post * __builtin_amdgcn_rsqf(s * (1.f / HD) + SUBLN_EPS);
            const f32x4 wa = *(const f32x4*)(subln_w + (col & 127)), wb = *(const f32x4*)(subln_w + (col & 127) + 4);
#pragma unroll
            for (int c = 0; c < 8; ++c) d[c] = d[c] * rs * (c < 4 ? wa[c] : wb[c - 4]);
            v4u w; w.x = pk2(d[0], d[1]); w.y = pk2(d[2], d[3]); w.z = pk2(d[4], d[5]); w.w = pk2(d[6], d[7]); *(v4u*)(og + off) = w; }
    }
}
#ifndef PG8_SP2
#define PG8_SP2 true
#endif
#ifndef PG8_ALIGN
#define PG8_ALIGN true
#endif
#ifndef EN_P0
#define EN_P0 1
#endif
#ifndef EN_G1
#define EN_G1 1
#endif
#ifndef EN_G2
#define EN_G2 1
#endif
#ifndef EN_G3
#define EN_G3 1
#endif
#ifndef EN_G4
#define EN_G4 1
#endif
#ifndef EN_G5
#define EN_G5 1
#endif
#ifndef EN_G6
#define EN_G6 1
#endif
#ifndef EN_G7
#define EN_G7 1
#endif
#ifndef EN_G8
#define EN_G8 1
#endif
#ifndef EN_G9
#define EN_G9 1
#endif
#ifndef EN_D1
#define EN_D1 1
#endif
#ifndef EN_D2
#define EN_D2 1
#endif
#ifndef EN_D3
#define EN_D3 1
#endif
#ifndef EN_D4
#define EN_D4 1
#endif
#ifndef EN_D5
#define EN_D5 1
#endif
#ifndef EN_D6U
#define EN_D6U 1
#endif
#ifndef EN_D6D
#define EN_D6D 1
#endif
#ifndef EN_D7
#define EN_D7 1
#endif
#ifndef REP_P0
#define REP_P0 1
#endif
#ifndef REP_G1
#define REP_G1 1
#endif
#ifndef REP_G2
#define REP_G2 1
#endif
#ifndef REP_G3
#define REP_G3 1
#endif
#ifndef REP_G4
#define REP_G4 1
#endif
#ifndef REP_G5
#define REP_G5 1
#endif
#ifndef REP_G6
#define REP_G6 1
#endif
#ifndef REP_G7
#define REP_G7 1
#endif
#ifndef REP_G8
#define REP_G8 1
#endif
#ifndef REP_G9
#define REP_G9 1
#endif
#ifndef REP_D1
#define REP_D1 1
#endif
#ifndef REP_D2
#define REP_D2 1
#endif
#ifndef REP_D3
#define REP_D3 1
#endif
#ifndef REP_D4
#define REP_D4 1
#endif
#ifndef REP_D5
#define REP_D5 1
#endif
#ifndef REP_D6U
#define REP_D6U 1
#endif
#ifndef REP_D6D
#define REP_D6D 1
#endif
#ifndef REP_D7
#define REP_D7 1
#endif
#ifndef PROBE_NOSTORE
#define PROBE_NOSTORE 0
#endif
struct Args { const float* in[16]; float* out; unsigned char* ws; int ph_lo, ph_hi; };
__global__ void __launch_bounds__(NWAVES * 64, 2) yoco_fwd(Args args) {
    extern __shared__ __attribute__((aligned(16))) unsigned char lds_raw[];
    LAS unsigned char* lds = (LAS unsigned char*)lds_raw;
    volatile LAS unsigned* MISC = (volatile LAS unsigned*)(lds + MISC_OFF);
    const int tid = threadIdx.x, lane = tid & 63, wave = __builtin_amdgcn_readfirstlane(tid >> 6);
    const int G = gridDim.x, bx = blockIdx.x, vcu = (G % 8 == 0) ? (bx % 8) * (G / 8) + bx / 8 : bx;
    const int gw = vcu * NWAVES + wave, NGW = G * NWAVES, gtid = vcu * NWAVES * 64 + tid, NGT = G * NWAVES * 64;
    const float* ln_g = args.in[14]; const float* ln_b = args.in[15];
    for (int u = tid; u < (LDS_BYTES - LDSCTL_OFF) / 4; u += NWAVES * 64) ((LAS unsigned*)(lds + LDSCTL_OFF))[u] = 0u;
    __syncthreads();
    XcdBarrier bar; bar.bar = (unsigned*)(args.ws + WS_CTL) + CW_BAR; bar.x = 0; bar.st = nullptr;
    if (!MK_PER_PHASE) bar = xcd_barrier_post((unsigned*)(args.ws + WS_CTL) + CW_BAR, MISC + 8);
    const int lo = args.ph_lo, hi = args.ph_hi;
#define IN(k) (lo <= (k) && (k) < hi)
#define FRESH_LANE() int ln_ = lane; asm volatile("" : "+v"(ln_)); unsigned char* ws_ = args.ws; asm volatile("" : "+s"(ws_)); int gw_ = gw, vcu_ = vcu, bx_ = bx; asm volatile("" : "+s"(gw_), "+s"(vcu_), "+s"(bx_))
#define x_in         (args.in[0])
#define gdn_w_in     (args.in[1])
#define gdn_conv_w   (args.in[2])
#define gdn_a_log    (args.in[3])
#define gdn_dt_bias  (args.in[4])
#define gdn_norm_w   (args.in[5])
#define gdn_w_out    (args.in[6])
#define diff_w_q     (args.in[7])
#define diff_lambda  (args.in[8])
#define diff_subln_w (args.in[9])
#define diff_w_o     (args.in[10])
#define shared_w_kv  (args.in[11])
#define mlp_w_up     (args.in[12])
#define mlp_w_down   (args.in[13])
#define ones  ((float*)(ws_ + WS_ONES))
#define zeros ((float*)(ws_ + WS_ZEROS))
#define mu    ((float*)(ws_ + WS_MU))
#define rstd  ((float*)(ws_ + WS_RSTD))
#define beta  ((float*)(ws_ + WS_BETA))
#define gdec  ((float*)(ws_ + WS_G))
#define halo  ((bf16*)(ws_ + WS_HALO))
#define WA    ((bf16*)(ws_ + WS_WA))
#define WB    ((bf16*)(ws_ + WS_WB))
#define attnb ((bf16*)(ws_ + WS_ATTN))
#define XB    ((bf16*)(ws_ + WS_XB))
#define Y     ((float*)(ws_ + WS_Y))
#define R1    ((bf16*)(ws_ + WS_R1))
#define Kb    (R1)
#define Vb    (R1 + QTR / 2)
#define Qb    (R1 + 2 * (QTR / 2))
#define O0    (R1 + 3 * (QTR / 2))
#define O1    (XB)
#define HID   (Qb)
#define SEAM(k) do { if (!MK_PER_PHASE && (k) + 1 < hi) xcd_barrier(bar); } while (0)

    for (int rep_ = 0; rep_ < REP_P0; ++rep_) if (EN_P0 && IN(0)) { FRESH_LANE();
        for (int i = gtid; i < DMODEL; i += NGT) { ones[i] = 1.f; zeros[i] = 0.f; }
        for (int i = gtid; i < MROWS; i += NGT) { mu[i] = 0.f; rstd[i] = 1.f; }
        for (int m = gw_; m < MROWS; m += NGW) row_to_bf16(x_in + (size_t)m * DMODEL, XB + (size_t)m * DMODEL, ln_);
        convert_w(lds, gw_, NGW, wave, ln_, gdn_w_in, DMODEL, GDN_PROJ, 0, GDN_PROJ, WA, 0);
        SEAM(0);
    }
    for (int l = 0; l < 2; ++l) {
        const int pb = 1 + 9 * l;
        for (int rep_ = 0; rep_ < REP_G1; ++rep_) if (EN_G1 && IN(pb + 0)) { FRESH_LANE();
            pg8::Gemm g{XB, WA, MROWS, GDN_MAIN, DMODEL, DMODEL}; pg8::StaticOrder S; S.init(MROWS, GDN_MAIN, G, bx_);
            pg8::EpiStore<0> E{R1, GDN_MAIN, 0, 0, -1, 1.f, halo};
            pg8::gemm_phase<pg8::EpiStore<0>, pg8::StaticOrder, PG8_ALIGN, PG8_SP2>(lds + RING_OFF, g, S, E);
            ba_proj(XB, WA, gdn_a_log + l * 16, gdn_dt_bias + l * 16, beta, gdec, gw_, NGW, ln_);
            SEAM(pb + 0);
        }
        for (int rep_ = 0; rep_ < REP_G2; ++rep_) if (EN_G2 && IN(pb + 1)) { FRESH_LANE(); gdn_chunk_phase(lds, R1, halo, beta, gdec, XB, attnb, gdn_conv_w + (size_t)l * 4 * CONVC, vcu_, G, (rep_ + 1 < REP_G2) ? (bf16*)args.out : nullptr); SEAM(pb + 1); }
        for (int rep_ = 0; rep_ < REP_G3; ++rep_) if (EN_G3 && IN(pb + 2)) { FRESH_LANE(); gdn_scan_phase(lds, R1, XB, attnb, gdec, vcu_, G, (rep_ + 1 < REP_G3) ? (bf16*)args.out : nullptr); SEAM(pb + 2); }
        for (int rep_ = 0; rep_ < REP_G4; ++rep_) if (EN_G4 && IN(pb + 3)) { FRESH_LANE();
            gdn_gate_phase(R1, gdn_norm_w + l * HD, gw_, NGW, ln_, (rep_ + 1 < REP_G4) ? (bf16*)args.out : nullptr);
            convert_w(lds, gw_, NGW, wave, ln_, gdn_w_out + (size_t)l * DMODEL * DMODEL, DMODEL, DMODEL, 0, DMODEL, WA, 0);
            convert_w(lds, gw_, NGW, wave, ln_, mlp_w_up + (size_t)l * DMODEL * DFF, DMODEL, DFF, 0, DFF, WB, 0);
            SEAM(pb + 3);
        }
        for (int rep_ = 0; rep_ < REP_G5; ++rep_) if (EN_G5 && IN(pb + 4)) { FRESH_LANE();
            pg8::Gemm g{R1 + 4096, WA, MROWS, DMODEL, DMODEL, GDN_MAIN}; pg8::StaticOrder S; S.init(MROWS, DMODEL, G, bx_);
            const float* yin = (l == 0) ? x_in : Y; const float* xg = (l == 0) ? ones : ln_g + (size_t)((l - 1) * 2 + 1) * DMODEL; const float* xbt = (l == 0) ? zeros : ln_b + (size_t)((l - 1) * 2 + 1) * DMODEL;
            pg8::EpiResid E{yin, (rep_ + 1 < REP_G5) ? args.out : Y, mu, rstd, xg, xbt, DMODEL, ALPHA_RES};
            pg8::gemm_phase<pg8::EpiResid, pg8::StaticOrder, PG8_ALIGN, PG8_SP2>(lds + RING_OFF, g, S, E);
            SEAM(pb + 4);
        }
        const float* g1 = ln_g + (size_t)(l * 2) * DMODEL; const float* b1 = ln_b + (size_t)(l * 2) * DMODEL;
        for (int rep_ = 0; rep_ < REP_G6; ++rep_) if (EN_G6 && IN(pb + 5)) { FRESH_LANE();
            ln_pass(Y, g1, b1, mu, rstd, XB, nullptr, gw_, NGW, ln_);
            convert_w(lds, gw_, NGW, wave, ln_, mlp_w_down + (size_t)l * DFF * DMODEL, DFF, DMODEL, 0, DMODEL, WA, 0);
            SEAM(pb + 5);
        }
        for (int rep_ = 0; rep_ < REP_G7; ++rep_) if (EN_G7 && IN(pb + 6)) { FRESH_LANE();
            pg8::Gemm g{XB, WB, MROWS, DFF, DMODEL, DMODEL}; pg8::StaticOrder S; S.init(MROWS, DFF, G, bx_);
            pg8::EpiStore<1> E{R1, DFF, 0, 0, -1, 1.f, nullptr};
            pg8::gemm_phase<pg8::EpiStore<1>, pg8::StaticOrder, PG8_ALIGN, PG8_SP2>(lds + RING_OFF, g, S, E);
            SEAM(pb + 6);
        }
        for (int rep_ = 0; rep_ < REP_G8; ++rep_) if (EN_G8 && IN(pb + 7)) { FRESH_LANE();
            pg8::Gemm g{R1, WA, MROWS, DMODEL, DFF, DFF}; pg8::StaticOrder S; S.init(MROWS, DMODEL, G, bx_);
            pg8::EpiResid E{Y, (rep_ + 1 < REP_G8) ? args.out : Y, mu, rstd, g1, b1, DMODEL, ALPHA_RES};
            pg8::gemm_phase<pg8::EpiResid, pg8::StaticOrder, PG8_ALIGN, PG8_SP2>(lds + RING_OFF, g, S, E);
            SEAM(pb + 7);
        }
        for (int rep_ = 0; rep_ < REP_G9; ++rep_) if (EN_G9 && IN(pb + 8)) { FRESH_LANE();
            const float* g2 = ln_g + (size_t)(l * 2 + 1) * DMODEL; const float* b2 = ln_b + (size_t)(l * 2 + 1) * DMODEL;
            ln_pass(Y, g2, b2, mu, rstd, XB, nullptr, gw_, NGW, ln_);
            if (l == 0) convert_w(lds, gw_, NGW, wave, ln_, gdn_w_in + (size_t)DMODEL * GDN_PROJ, DMODEL, GDN_PROJ, 0, GDN_PROJ, WA, 0);
            else { convert_w(lds, gw_, NGW, wave, ln_, shared_w_kv, DMODEL, 2 * DMODEL, 0, 2 * DMODEL, WA, 0);
                   convert_w(lds, gw_, NGW, wave, ln_, diff_w_q, DMODEL, DMODEL, 0, DMODEL, WA, 2 * DMODEL); }
            SEAM(pb + 8);
        }
    }
    for (int j = 0; j < 2; ++j) {
        const int pb = 19 + 10 * j, L = 2 + j;
        const float* xg = ln_g + (size_t)((L - 1) * 2 + 1) * DMODEL; const float* xbt = ln_b + (size_t)((L - 1) * 2 + 1) * DMODEL;
        for (int rep_ = 0; rep_ < REP_D1; ++rep_) if (EN_D1 && IN(pb + 0)) { FRESH_LANE();
            const int N = (j == 0) ? 3 * DMODEL : DMODEL;
            pg8::Gemm g{XB, WA, MROWS, N, DMODEL, DMODEL}; pg8::StaticOrder S; S.init(MROWS, N, G, bx_);
            pg8::EpiStore<0> E{(j == 0) ? Kb : Qb, DMODEL, (j == 0) ? DMODEL : 0, QTR / 2, (j == 0) ? 2 : 0, attn_body::C2, nullptr};
            pg8::gemm_phase<pg8::EpiStore<0>, pg8::StaticOrder, PG8_ALIGN, PG8_SP2>(lds + RING_OFF, g, S, E);
            SEAM(pb + 0);
        }
        for (int rep_ = 0; rep_ < REP_D2; ++rep_) if (EN_D2 && IN(pb + 1)) { FRESH_LANE();
            const attn_body::AttnTensors AT{(const attn_body::bf16*)Qb, (const attn_body::bf16*)Kb, (const attn_body::bf16*)Vb, (attn_body::bf16*)O0, (attn_body::bf16*)O1};
            const attn_body::StaticOrder S(G, bx_);
            attn_body::attn_phase<attn_body::StaticOrder>((char*)lds_raw + RING_OFF, AT, S);
            SEAM(pb + 1);
        }
        for (int rep_ = 0; rep_ < REP_D3; ++rep_) if (EN_D3 && IN(pb + 2)) { FRESH_LANE();
            const float lambda_init = 0.8f - 0.6f * expf(-0.3f * (float)L);
            diff_combine_phase(O0, O1, Qb, diff_lambda + (size_t)j * 256, diff_subln_w + j * HD, lambda_init, gw_, NGW, ln_);
            convert_w(lds, gw_, NGW, wave, ln_, diff_w_o + (size_t)j * DMODEL * DMODEL, DMODEL, DMODEL, 0, DMODEL, WB, 0);
            convert_w(lds, gw_, NGW, wave, ln_, mlp_w_up + (size_t)L * DMODEL * DFF, DMODEL, DFF, 0, DFF, WA, 0);
            SEAM(pb + 2);
        }
        for (int rep_ = 0; rep_ < REP_D4; ++rep_) if (EN_D4 && IN(pb + 3)) { FRESH_LANE();
            pg8::Gemm g{Qb, WB, MROWS, DMODEL, DMODEL, DMODEL}; pg8::StaticOrder S; S.init(MROWS, DMODEL, G, bx_);
            pg8::EpiResid E{Y, (rep_ + 1 < REP_D4) ? args.out : Y, mu, rstd, xg, xbt, DMODEL, ALPHA_RES};
            pg8::gemm_phase<pg8::EpiResid, pg8::StaticOrder, PG8_ALIGN, PG8_SP2>(lds + RING_OFF, g, S, E);
            SEAM(pb + 3);
        }
        const float* g1 = ln_g + (size_t)(L * 2) * DMODEL; const float* b1 = ln_b + (size_t)(L * 2) * DMODEL;
        for (int rep_ = 0; rep_ < REP_D5; ++rep_) if (EN_D5 && IN(pb + 4)) { FRESH_LANE();
            ln_pass(Y, g1, b1, mu, rstd, XB, nullptr, gw_, NGW, ln_);
            convert_w(lds, gw_, NGW, wave, ln_, mlp_w_down + (size_t)L * DFF * DMODEL, DFF, DMODEL, 0, DMODEL, WB, 0);
            SEAM(pb + 4);
        }
        for (int hf = 0; hf < 2; ++hf) {
            const size_t roff = (size_t)hf * (MROWS / 2);
            for (int rep_ = 0; rep_ < REP_D6U; ++rep_) if (EN_D6U && IN(pb + 5 + 2 * hf)) { FRESH_LANE();
                pg8::Gemm g{XB + roff * DMODEL, WA, MROWS / 2, DFF, DMODEL, DMODEL}; pg8::StaticOrder S; S.init(MROWS / 2, DFF, G, bx_);
                pg8::EpiStore<1> E{(PROBE_NOSTORE && rep_ + 1 < REP_D6U) ? (bf16*)nullptr : HID, DFF, 0, 0, -1, 1.f, nullptr};
                pg8::gemm_phase<pg8::EpiStore<1>, pg8::StaticOrder, PG8_ALIGN, PG8_SP2>(lds + RING_OFF, g, S, E);
                SEAM(pb + 5 + 2 * hf);
            }
            for (int rep_ = 0; rep_ < REP_D6D; ++rep_) if (EN_D6D && IN(pb + 6 + 2 * hf)) { FRESH_LANE();
                pg8::Gemm g{HID, WB, MROWS / 2, DMODEL, DFF, DFF}; pg8::StaticOrder S; S.init(MROWS / 2, DMODEL, G, bx_);
                pg8::EpiResid E{Y + roff * DMODEL, ((rep_ + 1 < REP_D6D) ? args.out : Y) + roff * DMODEL, mu + roff, rstd + roff, g1, b1, DMODEL, ALPHA_RES};
                pg8::gemm_phase<pg8::EpiResid, pg8::StaticOrder, PG8_ALIGN, PG8_SP2>(lds + RING_OFF, g, S, E);
                SEAM(pb + 6 + 2 * hf);
            }
        }
        for (int rep_ = 0; rep_ < REP_D7; ++rep_) if (EN_D7 && IN(pb + 9)) { FRESH_LANE();
            const float* g2 = ln_g + (size_t)(L * 2 + 1) * DMODEL; const float* b2 = ln_b + (size_t)(L * 2 + 1) * DMODEL;
            if (j == 0) { ln_pass(Y, g2, b2, mu, rstd, XB, nullptr, gw_, NGW, ln_);
                          convert_w(lds, gw_, NGW, wave, ln_, diff_w_q + (size_t)DMODEL * DMODEL, DMODEL, DMODEL, 0, DMODEL, WA, 0); }
            else { ln_pass(Y, g2, b2, mu, rstd, nullptr, args.out, gw_, NGW, ln_); }
            SEAM(pb + 9);
        }
    }
#undef IN
#undef SEAM
}

extern "C" void kernel_launch(void* const* d_in, const int* in_sizes, int n_in, void* d_out, int out_size, void* d_ws, size_t ws_size, hipStream_t stream) {
    static int grid = 0;
    if (grid == 0) {
        if (n_in != 16 || in_sizes[0] != MROWS * DMODEL || out_size != MROWS * DMODEL || ws_size < WS_END) { fprintf(stderr, "kernel_launch: unexpected shapes / workspace (n_in %d, ws %zu < %zu); nothing launched\n", n_in, ws_size, (size_t)WS_END); grid = -1; return; }
        int dev = 0, cus = 0, per_cu = 0;
        if (hipGetDevice(&dev) != hipSuccess || hipDeviceGetAttribute(&cus, hipDeviceAttributeMultiprocessorCount, dev) != hipSuccess) { grid = -1; return; }
        if (hipFuncSetAttribute((const void*)yoco_fwd, hipFuncAttributeMaxDynamicSharedMemorySize, LDS_BYTES) != hipSuccess) { fprintf(stderr, "kernel_launch: hipFuncSetAttribute failed\n"); grid = -1; return; }
        if (hipOccupancyMaxActiveBlocksPerMultiprocessor(&per_cu, (const void*)yoco_fwd, NWAVES * 64, LDS_BYTES) != hipSuccess || per_cu < 1)
            fprintf(stderr, "kernel_launch: note: occupancy query reports %d workgroups per CU\n", per_cu);
        (void)hipGetLastError();
        grid = cus;
    }
    if (grid < 0) return;
    if (hipMemsetAsync((char*)d_ws + WS_CTL, 0, CTL_ZERO_BYTES, stream) != hipSuccess) return;
    Args a{};
    for (int i = 0; i < 16; ++i) a.in[i] = (const float*)d_in[i];
    a.out = (float*)d_out; a.ws = (unsigned char*)d_ws;
#if MK_PER_PHASE
    for (int k = 0; k < N_PHASES; ++k) { a.ph_lo = k; a.ph_hi = k + 1; hipLaunchKernelGGL(yoco_fwd, dim3(grid), dim3(NWAVES * 64), LDS_BYTES, stream, a); }
#else
    a.ph_lo = 0; a.ph_hi = N_PHASES;
    hipLaunchKernelGGL(yoco_fwd, dim3(grid), dim3(NWAVES * 64), LDS_BYTES, stream, a);
#endif
    const hipError_t le = hipPeekAtLastError();
    if (le != hipSuccess) fprintf(stderr, "kernel_launch: launch failed: %s\n", hipGetErrorName(le));
}
```

```cpp
#include <hip/hip_runtime.h>
#include <hip/hip_bf16.h>
#include <cstdio>
#include <cstdint>
#include <cmath>

namespace pg8 {
#define PG8_LAS __attribute__((address_space(3)))
typedef unsigned short bf16_t;
typedef short bf16x8 __attribute__((ext_vector_type(8)));
typedef float f32x4 __attribute__((ext_vector_type(4)));
typedef unsigned u32x4 __attribute__((ext_vector_type(4)));
constexpr int BM = 256, BK = 64, HALF = 128, HTB = HALF * BK * 2  , STAGE_BYTES = 8 * HTB, NXCD = 8, WGM = 8;

__host__ __device__ __forceinline__ int lds_byte(int r, int c) { const int st = (r >> 4) * 2 + (c >> 5), rr = r & 15, cc = c & 31, ob = rr * 64 + cc * 2; return st * 1024 + (ob ^ (((ob >> 9) & 1) << 5)); }
__host__ __device__ __forceinline__ void stage_rc(int b, int& R, int& C) { const int st = b / 1024, sb = b % 1024, swz = sb ^ (((sb >> 9) & 1) << 5); R = (st >> 1) * 16 + swz / 64; C = (st & 1) * 32 + (swz % 64) / 2; }
__host__ __device__ __forceinline__ int perm32(int rho) { const int n = rho >> 4, i = rho & 15; return 8 * (i >> 2) + 4 * n + (i & 3); }

struct Unit { int pm, pn; };
struct Gemm { const bf16_t* A; const bf16_t* Bt; int M, N, K, lda; };

struct StaticOrder {
    int nM, nN, nwg, G, c;
    __host__ __device__ void init(int M, int N, int G_, int c_) { nM = M / BM; nN = N / BM; nwg = nM * nN; G = G_; c = c_; }
    __host__ __device__ bool next(int i, Unit& u) const {
        const long L = (long)i * G + c; if (L >= nwg) return false;
        int wgid = (int)L; { const int q = nwg / NXCD, r = nwg % NXCD, xcd = wgid % NXCD, off = wgid / NXCD; wgid = (xcd < r ? xcd * (q + 1) : r * (q + 1) + (xcd - r) * q) + off; }
        const int nig = WGM * nN, gid = wgid / nig, fm = gid * WGM, gsz = (nM - fm) < WGM ? (nM - fm) : WGM;
        u.pm = fm + ((wgid % nig) % gsz); u.pn = (wgid % nig) / gsz; return true;
    }
    __device__ __forceinline__ void a_ready(const Unit&) const {}
    __device__ __forceinline__ void done(const Unit&) const {}
};

__device__ __forceinline__ unsigned cvt_pk_bf16(float lo, float hi) { unsigned r; asm volatile("v_cvt_pk_bf16_f32 %0, %1, %2" : "=v"(r) : "v"(lo), "v"(hi)); return r; }

template <int ACT> struct EpiStore {
    static constexpr bool PERM = true, AFTER_DRAIN = false;
    bf16_t* O; int ldc; int split_cols; size_t split_stride; int scale_tile; float scale0; bf16_t* halo;
    __device__ __forceinline__ void operator()(const f32x4 (&acc)[2][2][4][2], const Unit& u, int wr, int wc, int fr, int fq) const {
        const int row0 = u.pm * BM + wr * 64 + fr; int colt = u.pn * BM; bf16_t* base = O;
        int t = 0; if (split_cols) { t = colt / split_cols; base += (size_t)t * split_stride; colt -= t * split_cols; }
        const float sc = (t == scale_tile) ? scale0 : 1.f;
        const int col0 = colt + wc * 32 + 8 * fq;
#pragma unroll
        for (int ai = 0; ai < 2; ++ai)
#pragma unroll
            for (int m = 0; m < 4; ++m) { const int row = row0 + ai * HALF + m * 16; bf16_t* rowp = base + (size_t)row * ldc + col0;
#pragma unroll
                for (int bj = 0; bj < 2; ++bj) { f32x4 v0 = acc[ai][bj][m][0], v1 = acc[ai][bj][m][1];
                    if (ACT == 1) {
#pragma unroll
                        for (int e = 0; e < 4; ++e) { const float a = fmaxf(v0[e], 0.f), b = fmaxf(v1[e], 0.f); v0[e] = a * a; v1[e] = b * b; } }
                    v0 = v0 * sc; v1 = v1 * sc; u32x4 w; w.x = cvt_pk_bf16(v0[0], v0[1]); w.y = cvt_pk_bf16(v0[2], v0[3]); w.z = cvt_pk_bf16(v1[0], v1[1]); w.w = cvt_pk_bf16(v1[2], v1[3]);
                    if (O != nullptr) *(u32x4*)(rowp + bj * HALF) = w; else asm volatile("" :: "v"(w));
                    if (halo != nullptr && m == 3 && fr >= 13) { const int c = col0 + bj * HALF; if (c < 6144) *(u32x4*)(halo + ((size_t)(row >> 6) * 3 + (fr - 13)) * 6144 + c) = w; }
                } }
    }
};
struct EpiResid {
    static constexpr bool PERM = false, AFTER_DRAIN = false;
    const float* yin; float* yout; const float* mu; const float* rstd; const float* g; const float* b; int ldc; float alpha;
    __device__ __forceinline__ void operator()(const f32x4 (&acc)[2][2][4][2], const Unit& u, int wr, int wc, int fr, int fq) const {
        const int row0 = u.pm * BM + wr * 64 + fr; const int col0 = u.pn * BM + wc * 32 + 4 * fq;
#pragma unroll
        for (int ai = 0; ai < 2; ++ai)
#pragma unroll
            for (int m = 0; m < 4; ++m) { const int row = row0 + ai * HALF + m * 16; const float mr = mu[row], rs = rstd[row]; const size_t off = (size_t)row * ldc + col0;
#pragma unroll
                for (int bj = 0; bj < 2; ++bj)
#pragma unroll
                    for (int n = 0; n < 2; ++n) { const f32x4 yv = *(const f32x4*)(yin + off + bj * HALF + n * 16);
                        const f32x4 gv = *(const f32x4*)(g + col0 + bj * HALF + n * 16), bv = *(const f32x4*)(b + col0 + bj * HALF + n * 16);
                        const f32x4 xv = ((yv - mr) * rs) * gv + bv;
                        *(f32x4*)(yout + off + bj * HALF + n * 16) = xv * alpha + acc[ai][bj][m][n]; }
                if (m & 1) asm volatile("" ::: "memory"); }
    }
};

template <class Epi, class Sched, bool ALIGN_EPI = false, bool SP2 = false>
__device__ __forceinline__ void gemm_phase(PG8_LAS unsigned char* lds, const Gemm g, const Sched& S, const Epi& E) {
    int tid_ = threadIdx.x; asm volatile("" : "+v"(tid_));
    const int tid = tid_, wid = __builtin_amdgcn_readfirstlane(tid >> 6), lane = tid & 63, wr = wid >> 2, wc = wid & 3, fr = lane & 15, fq = lane >> 4;
    const int K = g.K, nt = K / BK, lda = g.lda;
    unsigned voffA[2], voffB[2];
#pragma unroll
    for (int i = 0; i < 2; ++i) { int R, C; stage_rc(tid * 16 + i * 8192, R, C); const int Rb = Epi::PERM ? ((R & ~31) + perm32(R & 31)) : R;
        voffA[i] = (unsigned)(R * lda + C) * 2u; voffB[i] = (unsigned)(Rb * K + C) * 2u; }
    const size_t kstep = (size_t)(BK * 2);
    const size_t hA = (size_t)HALF * lda * 2, hB = (size_t)HALF * K * 2;
    const size_t tA = 2 * hA, tB = 2 * hB;
    const unsigned ldsw = (unsigned)wid * 1024u;
    const int aoff = lds_byte(wr * 64 + fr, fq * 8), boff = lds_byte(wc * 32 + fr, fq * 8);
#define PG8_SA(b, h) (((b) * 2 + (h)) * HTB)
#define PG8_SB(b, h) ((4 + (b) * 2 + (h)) * HTB)
#define PG8_STAGE(bufoff, gbase, voff) do { _Pragma("unroll") for (int _i = 0; _i < 2; ++_i) \
        __builtin_amdgcn_global_load_lds((const unsigned*)((const char*)(gbase) + (voff)[_i]), (PG8_LAS unsigned*)(lds + (bufoff) + ldsw + _i * 8192), 16, 0, 0); } while (0)
#define PG8_LDA(dst, b, h) do { _Pragma("unroll") for (int m = 0; m < 4; ++m) _Pragma("unroll") for (int k = 0; k < 2; ++k) dst[m][k] = *(const PG8_LAS bf16x8*)(lds + PG8_SA(b, h) + aoff + m * 2048 + k * 1024); } while (0)
#define PG8_LDB(dst, b, h) do { _Pragma("unroll") for (int n = 0; n < 2; ++n) _Pragma("unroll") for (int k = 0; k < 2; ++k) dst[n][k] = *(const PG8_LAS bf16x8*)(lds + PG8_SB(b, h) + boff + n * 2048 + k * 1024); } while (0)
#define PG8_MMA(ai, bj, At, Bt) do { __builtin_amdgcn_s_setprio(1); _Pragma("unroll") for (int m = 0; m < 4; ++m) _Pragma("unroll") for (int n = 0; n < 2; ++n) _Pragma("unroll") for (int k = 0; k < 2; ++k) \
        acc[ai][bj][m][n] = __builtin_amdgcn_mfma_f32_16x16x32_bf16(Bt[n][k], At[m][k], acc[ai][bj][m][n], 0, 0, 0); __builtin_amdgcn_s_setprio(0); } while (0)
#define PG8_WAIT_V(n) asm volatile("s_waitcnt vmcnt(" #n ")" ::: "memory")
#define PG8_WAIT_L(n) asm volatile("s_waitcnt lgkmcnt(" #n ")" ::: "memory")
#define PG8_BAR __builtin_amdgcn_s_barrier()
#define PG8_SCHED __builtin_amdgcn_sched_barrier(0)
    Unit cur, nxt; int ui = 0;
    if (!S.next(0, cur)) return;
    f32x4 acc[2][2][4][2];
#pragma unroll
    for (int a = 0; a < 2; ++a)
#pragma unroll
        for (int b = 0; b < 2; ++b)
#pragma unroll
            for (int m = 0; m < 4; ++m)
#pragma unroll
                for (int n = 0; n < 2; ++n) acc[a][b][m][n] = (f32x4){0.f, 0.f, 0.f, 0.f};
    bf16x8 At[4][2], B0[2][2], B1[2][2];
    const char* cA = (const char*)g.A + (size_t)cur.pm * tA; const char* cB = (const char*)g.Bt + (size_t)cur.pn * tB;
    S.a_ready(cur);
    if constexpr (SP2) {
        PG8_STAGE(PG8_SB(0, 0), cB, voffB); PG8_STAGE(PG8_SB(0, 1), cB + hB, voffB); PG8_STAGE(PG8_SA(0, 0), cA, voffA); PG8_STAGE(PG8_SA(0, 1), cA + hA, voffA);
        if (wr == 1) PG8_BAR;
        PG8_WAIT_V(2); PG8_BAR;
        PG8_STAGE(PG8_SB(1, 0), cB + kstep, voffB); PG8_STAGE(PG8_SA(1, 0), cA + kstep, voffA); PG8_STAGE(PG8_SB(1, 1), cB + hB + kstep, voffB);
        PG8_WAIT_V(6); PG8_BAR;
    } else {
        PG8_STAGE(PG8_SB(0, 0), cB, voffB); PG8_STAGE(PG8_SA(0, 0), cA, voffA); PG8_STAGE(PG8_SB(0, 1), cB + hB, voffB); PG8_STAGE(PG8_SA(0, 1), cA + hA, voffA);
        if (wr == 1) PG8_BAR;
        PG8_WAIT_V(4); PG8_BAR;
        PG8_STAGE(PG8_SB(1, 0), cB + kstep, voffB); PG8_STAGE(PG8_SA(1, 0), cA + kstep, voffA); PG8_STAGE(PG8_SB(1, 1), cB + hB + kstep, voffB);
        PG8_WAIT_V(6); PG8_BAR;
    }
    for (;;) {
        const bool has_next = S.next(ui + 1, nxt);
        const char* nA = has_next ? (const char*)g.A + (size_t)nxt.pm * tA : cA; const char* nB = has_next ? (const char*)g.Bt + (size_t)nxt.pn * tB : cB;
        for (int t = 0; t < nt; t += 2) {
            const bool last = (t == nt - 2);
            const char* a1 = cA + (size_t)(t + 1) * kstep;
            const char* a2 = last ? nA : cA + (size_t)(t + 2) * kstep; const char* b2 = last ? nB : cB + (size_t)(t + 2) * kstep;
            const char* a3 = a2 + kstep; const char* b3 = b2 + kstep;
            if (last && has_next) S.a_ready(nxt);
            if constexpr (SP2) {
            PG8_LDB(B0, 0, 0); PG8_LDB(B1, 0, 1); PG8_SCHED; PG8_LDA(At, 0, 0); PG8_STAGE(PG8_SA(1, 1), a1 + hA, voffA);
            PG8_WAIT_V(8); PG8_WAIT_L(0); PG8_BAR; PG8_MMA(0, 0, At, B0); PG8_MMA(0, 1, At, B1); PG8_BAR; PG8_SCHED;
            PG8_LDA(At, 0, 1); PG8_STAGE(PG8_SB(0, 0), b2, voffB); PG8_STAGE(PG8_SB(0, 1), b2 + hB, voffB); PG8_STAGE(PG8_SA(0, 0), a2, voffA);
            PG8_WAIT_V(8); PG8_WAIT_L(0); PG8_BAR; PG8_MMA(1, 0, At, B0); PG8_MMA(1, 1, At, B1); PG8_BAR; PG8_SCHED;
            PG8_LDB(B0, 1, 0); PG8_LDB(B1, 1, 1); PG8_SCHED; PG8_LDA(At, 1, 0); PG8_STAGE(PG8_SA(0, 1), a2 + hA, voffA);
            PG8_WAIT_V(8); PG8_WAIT_L(0); PG8_BAR; PG8_MMA(0, 0, At, B0); PG8_MMA(0, 1, At, B1); PG8_BAR; PG8_SCHED;
            PG8_LDA(At, 1, 1); PG8_STAGE(PG8_SB(1, 0), b3, voffB); PG8_STAGE(PG8_SB(1, 1), b3 + hB, voffB); PG8_STAGE(PG8_SA(1, 0), a3, voffA);
            PG8_WAIT_V(8); PG8_WAIT_L(0); PG8_BAR; PG8_MMA(1, 0, At, B0); PG8_MMA(1, 1, At, B1); PG8_BAR; PG8_SCHED;
            } else {
            PG8_LDB(B0, 0, 0); PG8_SCHED; PG8_LDA(At, 0, 0); PG8_STAGE(PG8_SA(1, 1), a1 + hA, voffA);
            PG8_WAIT_L(8); PG8_BAR; PG8_WAIT_L(0); PG8_MMA(0, 0, At, B0); PG8_BAR; PG8_SCHED;
            PG8_LDB(B1, 0, 1); PG8_STAGE(PG8_SB(0, 0), b2, voffB);
            PG8_BAR; PG8_WAIT_L(0); PG8_MMA(0, 1, At, B1); PG8_BAR;
            PG8_LDA(At, 0, 1); PG8_STAGE(PG8_SA(0, 0), a2, voffA);
            PG8_BAR; PG8_WAIT_L(0); PG8_MMA(1, 0, At, B0); PG8_BAR; PG8_SCHED;
            PG8_STAGE(PG8_SB(0, 1), b2 + hB, voffB);
            PG8_WAIT_V(6); PG8_BAR; PG8_MMA(1, 1, At, B1); PG8_BAR;
            PG8_LDB(B0, 1, 0); PG8_SCHED; PG8_LDA(At, 1, 0); PG8_STAGE(PG8_SA(0, 1), a2 + hA, voffA);
            PG8_WAIT_L(8); PG8_BAR; PG8_WAIT_L(0); PG8_MMA(0, 0, At, B0); PG8_BAR; PG8_SCHED;
            PG8_LDB(B1, 1, 1); PG8_STAGE(PG8_SB(1, 0), b3, voffB);
            PG8_BAR; PG8_WAIT_L(0); PG8_MMA(0, 1, At, B1); PG8_BAR;
            PG8_LDA(At, 1, 1); PG8_STAGE(PG8_SA(1, 0), a3, voffA);
            PG8_BAR; PG8_WAIT_L(0); PG8_MMA(1, 0, At, B0); PG8_BAR; PG8_SCHED;
            PG8_STAGE(PG8_SB(1, 1), b3 + hB, voffB);
            PG8_WAIT_V(6); PG8_BAR; PG8_MMA(1, 1, At, B1); PG8_BAR;
            }
        }
        if constexpr (ALIGN_EPI) { if (wr == 0) PG8_BAR; }
        if constexpr (!Epi::AFTER_DRAIN) { E(acc, cur, wr, wc, fr, fq); S.done(cur); }
        if (!has_next) break;
#pragma unroll
        for (int a = 0; a < 2; ++a)
#pragma unroll
            for (int b = 0; b < 2; ++b)
#pragma unroll
                for (int m = 0; m < 4; ++m)
#pragma unroll
                    for (int n = 0; n < 2; ++n) acc[a][b][m][n] = (f32x4){0.f, 0.f, 0.f, 0.f};
        cur = nxt; cA = nA; cB = nB; ++ui;
        if constexpr (ALIGN_EPI) { if (wr == 1) PG8_BAR; }
    }
    PG8_WAIT_V(0);
    if constexpr (!ALIGN_EPI) { if (wr == 0) PG8_BAR; }
    PG8_BAR;
#undef PG8_SA
#undef PG8_SB
#undef PG8_STAGE
#undef PG8_LDA
#undef PG8_LDB
#undef PG8_MMA
#undef PG8_WAIT_V
#undef PG8_WAIT_L
#undef PG8_BAR
#undef PG8_SCHED
}
}
namespace dattn {
using bf16=__hip_bfloat16;
using bf16x8=__attribute__((ext_vector_type(8)))short;
using s16x4=__attribute__((ext_vector_type(4)))short;
using f32x16=__attribute__((ext_vector_type(16)))float;
using u32x4=__attribute__((ext_vector_type(4)))unsigned;
constexpr int SEQ=4096,DM=2048,HDV=128;
constexpr int NW=8,QBLK=32,QB=128,KVBLK=64,NQB=SEQ/QB;
__device__ __forceinline__ int crow(int r,int hi){return (r&3)+8*(r>>2)+4*hi;}
#define SBAR() __builtin_amdgcn_sched_barrier(0)
__device__ __forceinline__ void cmask(f32x16&p0,f32x16&p1,int jb,int qrel,int hi){
  const float NEG=-INFINITY; int kb=64*jb+4*hi;
  #pragma unroll
  for(int r=0;r<16;++r){int kv=kb+(r&3)+8*(r>>2); if(kv>qrel)p0[r]=NEG; if(kv+32>qrel)p1[r]=NEG;}
}
constexpr float C2=0.125f*1.4426950408889634f;
constexpr int NSLOT=3, SLOTB=16384;
constexpr int LDS_K=0, LDS_V=NSLOT*SLOTB, LDS_WS=2*NSLOT*SLOTB, LDS_BYTES=LDS_WS+NW*64*4;
__device__ __forceinline__ void glds16(const void*gsrc,unsigned lds_dst){unsigned keep;
  asm volatile("s_mov_b32 %0, m0\n\ts_mov_b32 m0, %2\n\ts_nop 0\n\tglobal_load_lds_dwordx4 %1, off\n\ts_mov_b32 m0, %0":"=&s"(keep):"v"(gsrc),"s"(lds_dst):"memory");}
__device__ __forceinline__ float max3f(float a,float b,float c){float r;asm("v_max3_f32 %0, %1, %2, %3":"=v"(r):"v"(a),"v"(b),"v"(c));return r;}
__device__ __forceinline__ float max2f(float a,float b){float r;asm("v_max_f32_e32 %0, %1, %2":"=v"(r):"v"(a),"v"(b));return r;}
__device__ __forceinline__ float fadd_s(float a,float b){float r;asm("v_add_f32_e32 %0, %1, %2":"=v"(r):"v"(a),"v"(b));return r;}
__device__ __forceinline__ float fsub_s(float a,float b){float r;asm("v_sub_f32_e32 %0, %1, %2":"=v"(r):"v"(a),"v"(b));return r;}
typedef float f32x2_t __attribute__((ext_vector_type(2))); typedef __bf16 bf16x2_t __attribute__((ext_vector_type(2)));
__device__ __forceinline__ unsigned cvtpk_s(float lo,float hi){f32x2_t v={lo,hi};bf16x2_t b=__builtin_convertvector(v,bf16x2_t);return __builtin_bit_cast(unsigned,b);}
#define WAIT_BAR(N) asm volatile("s_waitcnt vmcnt(" #N ") lgkmcnt(0)\n\ts_barrier":::"memory")
typedef __attribute__((address_space(3))) const char* lds_cptr;
typedef short v4i16_t __attribute__((ext_vector_type(4)));
__device__ __forceinline__ void qkt(f32x16&p0,f32x16&p1,const char*kb,const bf16x8*qr){ const f32x16 negm=f32x16{};
  #pragma unroll
  for(int d0=0;d0<4;++d0){
    const bf16x8 b0=*reinterpret_cast<const bf16x8*>(kb+d0*2048);
    const bf16x8 b1=*reinterpret_cast<const bf16x8*>(kb+d0*2048+512);
    if(d0==0){p0=__builtin_amdgcn_mfma_f32_32x32x16_bf16(b0,qr[0],negm,0,0,0);p1=__builtin_amdgcn_mfma_f32_32x32x16_bf16(b1,qr[0],negm,0,0,0);}
    else{p0=__builtin_amdgcn_mfma_f32_32x32x16_bf16(b0,qr[d0],p0,0,0,0);p1=__builtin_amdgcn_mfma_f32_32x32x16_bf16(b1,qr[d0],p1,0,0,0);}}
}
__device__ __forceinline__ void kload8(bf16x8*kf,lds_cptr kp){
  kf[0]=*(const __attribute__((address_space(3))) bf16x8*)(kp);      kf[1]=*(const __attribute__((address_space(3))) bf16x8*)(kp+512);
  kf[2]=*(const __attribute__((address_space(3))) bf16x8*)(kp+2048); kf[3]=*(const __attribute__((address_space(3))) bf16x8*)(kp+2560);
  kf[4]=*(const __attribute__((address_space(3))) bf16x8*)(kp+4096); kf[5]=*(const __attribute__((address_space(3))) bf16x8*)(kp+4608);
  kf[6]=*(const __attribute__((address_space(3))) bf16x8*)(kp+6144); kf[7]=*(const __attribute__((address_space(3))) bf16x8*)(kp+6656);
}
__device__ __forceinline__ void kload2(bf16x8*kf,lds_cptr kp,int j){ kf[2*j]=*(const __attribute__((address_space(3))) bf16x8*)(kp+j*2048); kf[2*j+1]=*(const __attribute__((address_space(3))) bf16x8*)(kp+j*2048+512); }
__device__ __forceinline__ s16x4 vtr(lds_cptr p){ return __builtin_bit_cast(s16x4,__builtin_amdgcn_ds_read_tr16_b64_v4i16((__attribute__((address_space(3))) v4i16_t*)p)); }
__device__ __forceinline__ float rowmax(const f32x16&p0,const f32x16&p1){
  float a=max3f(p0[0],p0[1],p1[0]),b=max3f(p0[2],p0[3],p1[1]);a=max3f(a,p1[2],p1[3]);
  #pragma unroll
  for(int r=4;r<16;r+=4){a=max3f(a,p0[r],p0[r+1]);b=max3f(b,p0[r+2],p0[r+3]);a=max3f(a,p1[r],p1[r+1]);b=max3f(b,p1[r+2],p1[r+3]);}
  const float m=max2f(a,b);
  auto rr=__builtin_amdgcn_permlane32_swap(__float_as_uint(m),__float_as_uint(m),false,false);
  return max2f(__uint_as_float(rr[0]),__uint_as_float(rr[1]));
}
__device__ __forceinline__ void pv(f32x16*o,int vb,bf16x8 pa0,bf16x8 pa1,bf16x8 pa2,bf16x8 pa3){
  #pragma unroll
  for(int d0=0;d0<4;++d0){s16x4 lo[4],hi[4];
    #pragma unroll
    for(int ks=0;ks<4;++ks){
      asm volatile("ds_read_b64_tr_b16 %0,%1 offset:%c2":"=&v"(lo[ks]):"v"(vb),"i"(d0*4096+ks*1024):"memory");
      asm volatile("ds_read_b64_tr_b16 %0,%1 offset:%c2":"=&v"(hi[ks]):"v"(vb),"i"(d0*4096+ks*1024+512):"memory");}
    asm volatile("s_waitcnt lgkmcnt(0)":::"memory");SBAR();
    #define PK(k) (bf16x8){lo[k][0],lo[k][1],lo[k][2],lo[k][3],hi[k][0],hi[k][1],hi[k][2],hi[k][3]}
    o[d0]=__builtin_amdgcn_mfma_f32_32x32x16_bf16(pa0,PK(0),o[d0],0,0,0);
    o[d0]=__builtin_amdgcn_mfma_f32_32x32x16_bf16(pa1,PK(1),o[d0],0,0,0);
    o[d0]=__builtin_amdgcn_mfma_f32_32x32x16_bf16(pa2,PK(2),o[d0],0,0,0);
    o[d0]=__builtin_amdgcn_mfma_f32_32x32x16_bf16(pa3,PK(3),o[d0],0,0,0);
    #undef PK
  }
}

struct Params { const bf16* Q; const bf16* K; const bf16* V; bf16* O; const float* subln_w; float lam, post; };
template<int THRL> __device__ __forceinline__ void unit(int b,int h,int qb,const Params&P,char*shm){
  int tid_=threadIdx.x; asm volatile("":"+v"(tid_));
  const int tid=tid_,lane=tid&63,r32=lane&31,hi=lane>>5; const int wid=__builtin_amdgcn_readfirstlane(tid>>6);
  const int cmp=wid&1,rbk=wid>>1;
  const long rowbase=(long)b*SEQ; const int q0=qb*QB;
  const bf16*Qw=P.Q+(rowbase+q0+rbk*QBLK)*DM+h*HDV+cmp*64;
  const bf16*Kh=P.K+rowbase*DM+h*HDV,*Vh=P.V+rowbase*DM+h*HDV;
  const unsigned lds0=(unsigned)(uintptr_t)shm;
  float*wsf=(float*)(shm+LDS_WS)+wid*64;
  const bf16*ksrc=Kh+(long)lane*DM+wid*8;
  const bf16*vsrc=Vh+(long)(16*(wid&3)+(lane>>2))*DM+(wid>>2)*32+(lane&3)*8;
  const unsigned kdst=lds0+LDS_K+wid*1024, vdst=lds0+LDS_V+wid*1024;
  #define DMA_K(t,slot) do{ glds16(ksrc+(long)(t)*KVBLK*DM,(unsigned)__builtin_amdgcn_readfirstlane(kdst+(slot))); glds16(ksrc+(long)(t)*KVBLK*DM+64,(unsigned)__builtin_amdgcn_readfirstlane(kdst+(slot)+8192)); }while(0)
  #define DMA_V(t,slot) do{ glds16(vsrc+(long)(t)*KVBLK*DM,(unsigned)__builtin_amdgcn_readfirstlane(vdst+(slot))); glds16(vsrc+(long)(t)*KVBLK*DM+64,(unsigned)__builtin_amdgcn_readfirstlane(vdst+(slot)+8192)); }while(0)
  const int vb0=(int)(lds0+LDS_V)+((lane>>4)&1)*32+(lane&3)*8+(4*hi+((lane&15)>>2))*64;
  bf16x8 kf[8];
  const lds_cptr shm3=(lds_cptr)shm; const lds_cptr kp0=shm3+LDS_K+(cmp*8+hi)*1024+r32*16; const lds_cptr vp0=shm3+LDS_V+((lane>>4)&1)*32+(lane&3)*8+(4*hi+((lane&15)>>2))*64;
  const char*Kbase=shm+LDS_K+(cmp*8+hi)*1024+r32*16;
  const int NT=(q0+QB)/KVBLK;
  DMA_K(0,0);DMA_V(0,0);DMA_K(1,SLOTB);
  bf16x8 qr[4];
  #pragma unroll
  for(int d0=0;d0<4;++d0)qr[d0]=*reinterpret_cast<const bf16x8*>(&Qw[(long)r32*DM+d0*16+hi*8]);
  float mhat=0.f,l_reg=0.f;f32x16 o[4];o[0]=f32x16{};o[1]=f32x16{};o[2]=f32x16{};o[3]=f32x16{};const f32x16 zero16=f32x16{};
  const int qrel=rbk*QBLK+r32;
  #define CMASK(P0,P1,t) do{int jb_=(t)-(NT-2); if(jb_>=0)cmask(P0,P1,jb_,qrel,hi);}while(0)
  bool resc=false;
  #define START(P0,P1) do{ const float rm=rowmax(P0,P1); resc=false; \
    { const float dl=rm; mhat=fadd_s(mhat,dl); \
      _Pragma("unroll") for(int r=0;r<16;++r){P0[r]=fsub_s(P0[r],dl);P1[r]=fsub_s(P1[r],dl);} } \
    _Pragma("unroll") for(int r=0;r<16;++r)P0[r]=__builtin_amdgcn_exp2f(P0[r]); }while(0)
  #define RESC() do{ if(resc){ asm volatile("s_waitcnt lgkmcnt(0)":::"memory"); \
      _Pragma("unroll") for(int d_=0;d_<4;++d_) _Pragma("unroll") for(int r=0;r<16;++r)o[d_][r]*=wsf[crow(r,hi)]; } }while(0)
  f32x16 pA0,pA1,pB0,pB1;
  int sl_prev=0,sl_cur=0,sl_next=SLOTB;
  #define ROT() do{sl_prev=sl_cur;sl_cur=sl_next;sl_next=(sl_next==(NSLOT-1)*SLOTB)?0:sl_next+SLOTB;}while(0)
  DMA_K(2,2*SLOTB);
  WAIT_BAR(6);
  qkt(pA0,pA1,Kbase,qr);asm volatile("s_nop 15\n\ts_nop 7":"+v"(pA0),"+v"(pA1));CMASK(pA0,pA1,0);
  START(pA0,pA1);
  _Pragma("unroll") for(int r=0;r<16;++r)pA1[r]=__builtin_amdgcn_exp2f(pA1[r]);
  WAIT_BAR(0);
  DMA_K(3,0);DMA_V(1,SLOTB);
  ROT();
  kload8(kf,kp0+sl_cur);
  if(NT>2){WAIT_BAR(4);}else{WAIT_BAR(0);}
  s16x4 vlo[4],vhi[4]; u32x4 pw0,pw1,pw2,pw3;
  #define PKW(P,B) cvtpk_s(P[B],P[B+1])
  #define PAF(k) __builtin_bit_cast(bf16x8,pw##k)
  #define VFR(i) (bf16x8){vlo[i][0],vlo[i][1],vlo[i][2],vlo[i][3],vhi[i][0],vhi[i][1],vhi[i][2],vhi[i][3]}
  #define PIN(x) asm volatile("":"+v"(x))
  #define MX3(a,b,c) __builtin_fmaxf(__builtin_fmaxf((a),(b)),(c))
  #define GAPA(MF,A0,A1,A2,A3,W0,W1,PW) do{ MF; sacc+=A0; sacc+=A1; sacc+=A2; sacc+=A3; PIN(sacc); W0; W1; PIN(PW); SBAR(); }while(0)
  #define EX(v) __builtin_amdgcn_exp2f((v)-mhat)
  #define VOFF(f) ((((f)&3)*4096)+(((f)>>2)*1024))
  #define VRD(i,f) do{ vlo[i]=vtr(vp_+VOFF(f)); vhi[i]=vtr(vp_+VOFF(f)+512); }while(0)
  #define GAPB(MF,X,B) do{ MF; X[B]=EX(X[B]); X[B+1]=EX(X[B+1]); PIN(X); SBAR(); }while(0)
  #define GAPBV(MF,X,B,i,f) do{ MF; X[B]=EX(X[B]); X[B+1]=EX(X[B+1]); PIN(X); VRD(i,f); SBAR(); }while(0)
  #define KRD(G,j) do{ if(G){ kload2(kf,kp0+sl_next,j); SBAR(); } }while(0)
  #define PVM(d,k,i) o[d]=__builtin_amdgcn_mfma_f32_32x32x16_bf16(PAF(k),VFR(i),o[d],0,0,0)
  #define STEP(C0,C1,P0,P1,t,GK,GV,GL) do{ SBAR(); \
    const lds_cptr vp_=vp0+sl_prev; \
    float sacc=(P0[0]+P0[1]); \
    GAPA(C0=__builtin_amdgcn_mfma_f32_32x32x16_bf16(kf[0],qr[0],zero16,0,0,0), P0[2],P0[3],P0[4],P0[5],     pw0[0]=PKW(P0,0), pw0[1]=PKW(P0,2), pw0); \
    GAPA(C1=__builtin_amdgcn_mfma_f32_32x32x16_bf16(kf[1],qr[0],zero16,0,0,0), P0[6],P0[7],P0[8],P0[9],     pw0[2]=PKW(P0,4), pw0[3]=PKW(P0,6), pw0); \
    GAPA(C0=__builtin_amdgcn_mfma_f32_32x32x16_bf16(kf[2],qr[1],C0,0,0,0),   P0[10],P0[11],P0[12],P0[13], pw1[0]=PKW(P0,8), pw1[1]=PKW(P0,10), pw1); \
    GAPA(C1=__builtin_amdgcn_mfma_f32_32x32x16_bf16(kf[3],qr[1],C1,0,0,0),   P0[14],P0[15],P1[0],P1[1],   pw1[2]=PKW(P0,12),pw1[3]=PKW(P0,14), pw1); \
    VRD(0,0); SBAR(); GAPA(C0=__builtin_amdgcn_mfma_f32_32x32x16_bf16(kf[4],qr[2],C0,0,0,0),   P1[2],P1[3],P1[4],P1[5],     pw2[0]=PKW(P1,0), pw2[1]=PKW(P1,2), pw2); \
    VRD(1,1); SBAR(); GAPA(C1=__builtin_amdgcn_mfma_f32_32x32x16_bf16(kf[5],qr[2],C1,0,0,0),   P1[6],P1[7],P1[8],P1[9],     pw2[2]=PKW(P1,4), pw2[3]=PKW(P1,6), pw2); \
    VRD(2,2); SBAR(); GAPA(C0=__builtin_amdgcn_mfma_f32_32x32x16_bf16(kf[6],qr[3],C0,0,0,0),   P1[10],P1[11],P1[12],P1[13], pw3[0]=PKW(P1,8), pw3[1]=PKW(P1,10), pw3); \
    VRD(3,3); SBAR(); GAPA(C1=__builtin_amdgcn_mfma_f32_32x32x16_bf16(kf[7],qr[3],C1,0,0,0),   P1[14],P1[15],0.f,0.f,       pw3[2]=PKW(P1,12),pw3[3]=PKW(P1,14), pw3); \
    l_reg+=sacc; \
    if(GK){DMA_K((t)+3,sl_cur);} if(GV){DMA_V((t)+1,sl_next);} \
    CMASK(C0,C1,t); \
    { float a=MX3(C0[0],C0[1],C1[0]),b=MX3(C0[2],C0[3],C1[1]); a=MX3(a,C1[2],C1[3]); \
      _Pragma("unroll") for(int r=4;r<16;r+=4){a=MX3(a,C0[r],C0[r+1]);b=MX3(b,C0[r+2],C0[r+3]);a=MX3(a,C1[r],C1[r+1]);b=MX3(b,C1[r+2],C1[r+3]);} \
      float rm=__builtin_fmaxf(a,b); { auto rr=__builtin_amdgcn_permlane32_swap(__float_as_uint(rm),__float_as_uint(rm),false,false); rm=__builtin_fmaxf(__uint_as_float(rr[0]),__uint_as_float(rr[1])); } \
      rm-=mhat; resc=false; \
      if(__builtin_expect(__any(rm>(float)THRL),0)){ const float dl=__builtin_fmaxf(rm,0.f); mhat+=dl; \
        const float f=__builtin_amdgcn_exp2f(-dl); l_reg*=f; if(hi==0)wsf[r32]=f; resc=true; } } \
    SBAR(); \
    GAPBV(PVM(0,0,0),C0,0, 0,4);  GAPBV(PVM(1,0,1),C0,2, 1,5);  GAPBV(PVM(2,0,2),C0,4, 2,6);  GAPBV(PVM(3,0,3),C0,6, 3,7); \
    GAPBV(PVM(0,1,0),C0,8, 0,8);  GAPBV(PVM(1,1,1),C0,10,1,9);  GAPBV(PVM(2,1,2),C0,12,2,10); GAPBV(PVM(3,1,3),C0,14,3,11); \
    KRD(GL,0); GAPBV(PVM(0,2,0),C1,0, 0,12); KRD(GL,1); GAPBV(PVM(1,2,1),C1,2, 1,13); KRD(GL,2); GAPBV(PVM(2,2,2),C1,4, 2,14); KRD(GL,3); GAPBV(PVM(3,2,3),C1,6, 3,15); \
    GAPB(PVM(0,3,0),C1,8); GAPB(PVM(1,3,1),C1,10); GAPB(PVM(2,3,2),C1,12); GAPB(PVM(3,3,3),C1,14); \
    }while(0)
  int t=1;
  #undef CMASK
  #define CMASK(P0,P1,t) do{}while(0)
  for(;t+3<NT;t+=2){
    STEP(pB0,pB1,pA0,pA1,t,true,true,true);     WAIT_BAR(4); RESC(); ROT();
    STEP(pA0,pA1,pB0,pB1,t+1,true,true,true);   WAIT_BAR(4); RESC(); ROT();
  }
  #undef CMASK
  #define CMASK(P0,P1,t) do{int jb_=(t)-(NT-2); if(jb_>=0)cmask(P0,P1,jb_,qrel,hi);}while(0)
  #define ENDW(tt) do{ if((tt)+3<NT){WAIT_BAR(4);} else if((tt)+2<NT){WAIT_BAR(2);} else {WAIT_BAR(0);} }while(0)
  for(;t+1<NT;t+=2){
    STEP(pB0,pB1,pA0,pA1,t,(t+3<NT),(t+1<NT),(t+1<NT));       ENDW(t);   RESC(); ROT();
    STEP(pA0,pA1,pB0,pB1,t+1,(t+4<NT),(t+2<NT),(t+2<NT));     ENDW(t+1); RESC(); ROT();
  }
  STEP(pB0,pB1,pA0,pA1,NT-1,false,false,false); RESC();
  { float sacc=pB0[0]+pB0[1]; _Pragma("unroll") for(int r=2;r<16;++r)sacc+=pB0[r]; _Pragma("unroll") for(int r=0;r<16;++r)sacc+=pB1[r]; l_reg+=sacc;
    pw0=(u32x4){PKW(pB0,0),PKW(pB0,2),PKW(pB0,4),PKW(pB0,6)};pw1=(u32x4){PKW(pB0,8),PKW(pB0,10),PKW(pB0,12),PKW(pB0,14)};pw2=(u32x4){PKW(pB1,0),PKW(pB1,2),PKW(pB1,4),PKW(pB1,6)};pw3=(u32x4){PKW(pB1,8),PKW(pB1,10),PKW(pB1,12),PKW(pB1,14)};
    SBAR(); pv(o,vb0+sl_cur,PAF(0),PAF(1),PAF(2),PAF(3)); }
  #undef PKW
  #undef PAF
  #undef VFR
  #undef PIN
  #undef MX3
  #undef GAPA
  #undef GAPB
  #undef GAPBV
  #undef EX
  #undef VOFF
  #undef VRD
  #undef KRD
  #undef PVM
  #undef STEP
  #undef ENDW
  {auto rr=__builtin_amdgcn_permlane32_swap(__float_as_uint(l_reg),__float_as_uint(l_reg),false,false);l_reg=__uint_as_float(rr[0])+__uint_as_float(rr[1]);}
  if(hi==0)wsf[32+r32]=l_reg;asm volatile("s_waitcnt lgkmcnt(0)":::"memory");
  float rli[16];
  #pragma unroll
  for(int r=0;r<16;++r)rli[r]=__builtin_amdgcn_rcpf(wsf[32+crow(r,hi)]);
  asm volatile("s_waitcnt lgkmcnt(0)\n\ts_barrier":::"memory");
  { bf16*stg=(bf16*)(shm)+wid*4096;
    #pragma unroll
    for(int r=0;r<16;++r){const int orow=crow(r,hi);
      #pragma unroll
      for(int d0=0;d0<4;++d0)stg[orow*128+d0*32+r32]=__float2bfloat16(o[d0][r]*rli[r]);} }
  asm volatile("s_waitcnt lgkmcnt(0)\n\ts_barrier":::"memory");
  { const bf16*s0=(const bf16*)(shm)+(wid&~1)*4096; const bf16*s1=s0+4096;
    bf16*Ow=P.O+(rowbase+q0+rbk*QBLK)*DM+h*HDV; const int ch=lane&15;
    const float4 wa=*(const float4*)(P.subln_w+ch*8), wb=*(const float4*)(P.subln_w+ch*8+4);
    #pragma unroll
    for(int i=0;i<4;++i){ const int row=16*cmp+4*i+(lane>>4);
      const u32x4 a=*(const u32x4*)(s0+row*128+ch*8), bq=*(const u32x4*)(s1+row*128+ch*8);
      float d[8];
      #pragma unroll
      for(int k=0;k<4;++k){ const unsigned ua=a[k],ub=bq[k];
        d[2*k]=__uint_as_float(ua<<16)-P.lam*__uint_as_float(ub<<16); d[2*k+1]=__uint_as_float(ua&0xffff0000u)-P.lam*__uint_as_float(ub&0xffff0000u); }
      float s=0.f;
      #pragma unroll
      for(int k=0;k<8;++k)s+=d[k]*d[k];
      s+=__shfl_xor(s,1);s+=__shfl_xor(s,2);s+=__shfl_xor(s,4);s+=__shfl_xor(s,8);
      const float rs=P.post*__builtin_amdgcn_rsqf(s*(1.f/128.f)+1e-5f);
      u32x4 w; w[0]=cvtpk_s(d[0]*rs*wa.x,d[1]*rs*wa.y); w[1]=cvtpk_s(d[2]*rs*wa.z,d[3]*rs*wa.w); w[2]=cvtpk_s(d[4]*rs*wb.x,d[5]*rs*wb.y); w[3]=cvtpk_s(d[6]*rs*wb.z,d[7]*rs*wb.w);
      *(u32x4*)(Ow+(long)row*DM+ch*8)=w; } }
  asm volatile("s_waitcnt lgkmcnt(0)\n\ts_barrier":::"memory");
  #undef DMA_K
  #undef DMA_V
  #undef CMASK
  #undef START
  #undef RESC
  #undef ROT
}
constexpr int ATTN_LDS_BYTES=LDS_BYTES;
template<int THRL=8> __device__ __forceinline__ void phase(char*lds,const Params&P,int grid,int block){
  const int vcu=(grid%8==0)?(block%8)*(grid/8)+block/8:block;
  for(int v=vcu;v<256;v+=grid){ const int bh=v>>1,p=v&1;
    for(int i=0;i<16;++i){ const int s=2*(i>>1)+p; const int qb=(i&1)?31-s:s; unit<THRL>(bh>>4,bh&15,qb,P,lds); } }
}
#undef SBAR
#undef WAIT_BAR
}
constexpr int NWAVES = 8;
#ifndef MK_PER_PHASE
#define MK_PER_PHASE 0
#endif

constexpr int BATCH = 8, SEQ = 4096, DMODEL = 2048, MROWS = BATCH * SEQ, DFF = 8192, NHEADS = 16, HD = 128;
constexpr int GDN_PROJ = 8224, GDN_MAIN = 8192, CONVC = 6144, NCG = MROWS / 64;
constexpr float ALPHA_RES = 1.6817928305074292f;
constexpr float LN_EPS = 1e-5f, GDN_EPS = 1e-6f, SUBLN_EPS = 1e-5f;
constexpr int N_PHASES = 39;

constexpr size_t MiB = 1u << 20;
constexpr size_t WS_CTL = 0, CTL_ZERO_BYTES = 1 * MiB;
constexpr size_t WS_ONES = 1 * MiB, WS_ZEROS = WS_ONES + 8192, WS_MU = WS_ONES + 65536, WS_RSTD = WS_MU + 131072;
constexpr size_t WS_BETA = 2 * MiB, WS_G = 4 * MiB;
constexpr size_t WS_HALO = 9 * MiB;
constexpr size_t WS_WA = 27 * MiB, WS_WB = 60 * MiB;
constexpr size_t WS_ATTN = 27 * MiB;
constexpr size_t WS_XB = 92 * MiB;
constexpr size_t WS_Y = 220 * MiB;
constexpr size_t WS_R1 = 476 * MiB;
constexpr size_t WS_END = 988 * MiB;
constexpr size_t QTR = 128 * MiB;
constexpr int CW_TMO = 0;
constexpr int CW_BAR = 4096;

constexpr int RING_OFF = 0, RING_BYTES = 131072;
constexpr int LDSCTL_OFF = RING_BYTES, MISC_OFF = LDSCTL_OFF + 320;
constexpr int LDS_BYTES = 147456;
static_assert(MISC_OFF + 128 <= LDS_BYTES, "LDS map");

#define GAS __attribute__((address_space(1)))
#define LAS __attribute__((address_space(3)))
typedef unsigned short bf16;
typedef unsigned v4u __attribute__((ext_vector_type(4)));
typedef unsigned v2u __attribute__((ext_vector_type(2)));
typedef float f32x4 __attribute__((ext_vector_type(4)));
typedef float f32x16 __attribute__((ext_vector_type(16)));
typedef short bf16x8 __attribute__((ext_vector_type(8)));
typedef GAS unsigned gu32;
typedef GAS unsigned long long gu64;
#define RLX_AGENT __ATOMIC_RELAXED, __HIP_MEMORY_SCOPE_AGENT
#define LDS_WAIT() asm volatile("s_waitcnt lgkmcnt(0)" ::: "memory")
#define VM_WAIT() asm volatile("s_waitcnt vmcnt(0)" ::: "memory")
#define WG_BAR() asm volatile("s_waitcnt lgkmcnt(0)\n\ts_barrier" ::: "memory")
typedef float f32x2_t_ __attribute__((ext_vector_type(2))); typedef __bf16 bf16x2_t_ __attribute__((ext_vector_type(2)));
__device__ __forceinline__ unsigned pk2(float lo, float hi) { f32x2_t_ v = {lo, hi}; bf16x2_t_ b = __builtin_convertvector(v, bf16x2_t_); return __builtin_bit_cast(unsigned, b); }
__device__ __forceinline__ unsigned f2bf(float f) { return pk2(f, 0.f) & 0xffffu; }
__device__ __forceinline__ float bflo(unsigned w) { return __builtin_bit_cast(float, w << 16); }
__device__ __forceinline__ float bfhi(unsigned w) { return __builtin_bit_cast(float, w & 0xffff0000u); }
__device__ __forceinline__ float bf2f(bf16 h) { return __builtin_bit_cast(float, (unsigned)h << 16); }
__device__ __forceinline__ float fast_exp(float x) { return __builtin_amdgcn_exp2f(x * 1.4426950408889634f); }
__device__ __forceinline__ float silu_f(float x) { return x * __builtin_amdgcn_rcpf(1.f + __expf(-x)); }

#define XB_TMO      128
#define XB_XCNT(j)  (256  + 64 * (j))
#define XB_XSUB(j)  (1280 + 64 * (j))
#define XB_XGEN(j)  (2304 + 64 * (j))
#define XB_TOP      3328
#define XB_TOPGEN   3392
#define XCD_BAR_WORDS 3456
#define XB_SPIN_CAP (1u << 18)

__device__ __forceinline__ unsigned xb_ld(unsigned* p)              { return __hip_atomic_load(p, __ATOMIC_RELAXED, __HIP_MEMORY_SCOPE_AGENT); }
__device__ __forceinline__ unsigned xb_add(unsigned* p, unsigned v) { return __hip_atomic_fetch_add(p, v, __ATOMIC_RELAXED, __HIP_MEMORY_SCOPE_AGENT); }
__device__ __forceinline__ unsigned xb_xcc_id() { return (unsigned)__builtin_amdgcn_s_getreg((3 << 11) | 20) & 0xFu; }
#define XB_SPIN(cond, bar) do { unsigned _sp = 0; while (cond) { __builtin_amdgcn_s_sleep(1); \
    if ((++_sp & 255u) == 0u) { if (xb_ld(&(bar)[XB_TMO])) break; if (_sp > XB_SPIN_CAP) { atomicAdd(&(bar)[XB_TMO], 1u); break; } } } } while (0)

struct XcdBarrier {
    unsigned* bar; unsigned x;
    volatile LAS unsigned* st;
};
__device__ __forceinline__ XcdBarrier xcd_barrier_post(unsigned* bar, volatile LAS unsigned* st) {
    XcdBarrier b; b.bar = bar; b.x = xb_xcc_id(); b.st = st;
    if (threadIdx.x == 0) (void)xb_add(&bar[XB_XCNT(b.x)], 1u);
    return b;
}
__device__ __forceinline__ void xcd_barrier_complete(unsigned* bar, unsigned x, unsigned& nloc, unsigned& nx) {
    const unsigned G = gridDim.x * gridDim.y * gridDim.z;
    unsigned sum, cnt, mine, sp = 0u;
    for (;;) {
        sum = 0u; cnt = 0u; mine = 0u;
#pragma unroll
        for (unsigned j = 0; j < 16; ++j) { const unsigned c = xb_ld(&bar[XB_XCNT(j)]); sum += c; cnt += (c > 0u) ? 1u : 0u; mine = (j == x) ? c : mine; }
        if (sum == G) break;
        __builtin_amdgcn_s_sleep(1);
        if ((++sp & 255u) == 0u) { if (xb_ld(&bar[XB_TMO])) break; if (sp > XB_SPIN_CAP) { atomicAdd(&bar[XB_TMO], 1u); break; } }
    }
    nloc = mine > 0u ? mine : 1u; nx = cnt > 0u ? cnt : 1u;
}
__device__ __forceinline__ void xcd_barrier(const XcdBarrier& b) {
    asm volatile("s_waitcnt vmcnt(0)" ::: "memory");
    __syncthreads();
    if (threadIdx.x == 0) {
        unsigned* bar = b.bar;
        __builtin_amdgcn_s_waitcnt(0);
        unsigned nloc = b.st[0], nx = b.st[1];
        if (nloc == 0u) { xcd_barrier_complete(bar, b.x, nloc, nx); b.st[0] = nloc; b.st[1] = nx; }
        const unsigned old = xb_add(&bar[XB_XSUB(b.x)], 1u);
        const unsigned gen = old / nloc;
        if (old + 1u == (gen + 1u) * nloc) {
            __builtin_amdgcn_fence(__ATOMIC_RELEASE, "agent");
            asm volatile("s_waitcnt vmcnt(0)" ::: "memory");
            const unsigned og = xb_add(&bar[XB_TOP], 1u);
            const unsigned tg = og / nx;
            if (og + 1u == (tg + 1u) * nx) xb_add(&bar[XB_TOPGEN], 1u);
            else XB_SPIN(xb_ld(&bar[XB_TOPGEN]) == tg, bar);
            __builtin_amdgcn_fence(__ATOMIC_ACQUIRE, "agent");
            xb_add(&bar[XB_XGEN(b.x)], 1u);
            asm volatile("s_waitcnt vmcnt(0)" ::: "memory");
        } else {
            XB_SPIN(xb_ld(&bar[XB_XGEN(b.x)]) == gen, bar);
            __builtin_amdgcn_fence(__ATOMIC_ACQUIRE, "agent");
            asm volatile("s_waitcnt vmcnt(0)" ::: "memory");
        }
    }
    __syncthreads();
}

__device__ __forceinline__ float wave_sum(float v) {
#pragma unroll
    for (int o = 1; o < 64; o <<= 1) v += __shfl_xor(v, o);
    return v;
}
__device__ __forceinline__ float sum16(float v) {
    v += __shfl_xor(v, 1); v += __shfl_xor(v, 2); v += __shfl_xor(v, 4); v += __shfl_xor(v, 8); return v;
}
__device__ __forceinline__ void transpose_item(const float* W, int K, int ldw, int n_begin, int nblk, bf16* WT, int row_off, LAS float* scr, int item, int lane) {
    const int kb = item / nblk, nb = item % nblk, k0 = 64 * kb, n0 = 32 * nb;
    float wv[32];
#pragma unroll
    for (int i = 0; i < 32; ++i) wv[i] = W[(size_t)(k0 + 2 * i + (lane >> 5)) * ldw + n_begin + n0 + (lane & 31)];
#pragma unroll
    for (int i = 0; i < 32; ++i) scr[(2 * i + (lane >> 5)) * 33 + (lane & 31)] = wv[i];
    LDS_WAIT(); asm volatile("" ::: "memory");
    const int c = lane & 7;
#pragma unroll
    for (int j = 0; j < 4; ++j) { const int n = (lane >> 3) + 8 * j; const LAS float* s = scr + (8 * c) * 33 + n;
        v4u o; o.x = pk2(s[0 * 33], s[1 * 33]); o.y = pk2(s[2 * 33], s[3 * 33]); o.z = pk2(s[4 * 33], s[5 * 33]); o.w = pk2(s[6 * 33], s[7 * 33]);
        *(GAS v4u*)(WT + (size_t)(row_off + n0 + n) * K + k0 + 8 * c) = o; }
    LDS_WAIT(); asm volatile("" ::: "memory");
}
__device__ __forceinline__ void convert_w(LAS unsigned char* lds, int gw, int NGW, int wave, int lane, const float* W, int K, int ldw, int n_begin, int ncols, bf16* WT, int row_off) {
    LAS float* scr = (LAS float*)(lds + RING_OFF + wave * 16384);
    const int nblk = ncols / 32, nitems = (K / 64) * nblk;
    for (int it = gw; it < nitems; it += NGW) transpose_item(W, K, ldw, n_begin, nblk, WT, row_off, scr, it, lane);
}
__device__ __forceinline__ void row_to_bf16(const float* xrow, bf16* orow, int lane) {
    const GAS f32x4* xr = (const GAS f32x4*)xrow + lane; GAS v2u* o8 = (GAS v2u*)orow + lane;
#pragma unroll
    for (int j = 0; j < 8; ++j) { const f32x4 v = xr[64 * j]; v2u w; w.x = pk2(v.x, v.y); w.y = pk2(v.z, v.w); o8[64 * j] = w; }
}
__device__ __forceinline__ void ln_row(const float* yrow, const float* g, const float* b, float* mu, float* rstd, bf16* xbrow, float* outrow, int lane) {
    const GAS f32x4* yr = (const GAS f32x4*)yrow + lane;
    f32x4 v[8]; float s = 0.f;
#pragma unroll
    for (int j = 0; j < 8; ++j) { v[j] = yr[64 * j]; s += (v[j].x + v[j].y) + (v[j].z + v[j].w); }
    const float mean = wave_sum(s) * (1.f / DMODEL); float s2 = 0.f;
#pragma unroll
    for (int j = 0; j < 8; ++j) { v[j] = v[j] - mean; s2 += (v[j].x * v[j].x + v[j].y * v[j].y) + (v[j].z * v[j].z + v[j].w * v[j].w); }
    const float rs = 1.f / sqrtf(wave_sum(s2) * (1.f / DMODEL) + LN_EPS);
    if (lane == 0) { *mu = mean; *rstd = rs; }
    const GAS f32x4* gr = (const GAS f32x4*)g + lane; const GAS f32x4* br = (const GAS f32x4*)b + lane;
#pragma unroll
    for (int j = 0; j < 8; ++j) { const f32x4 o = (v[j] * rs) * gr[64 * j] + br[64 * j];
        if (xbrow) { v2u w; w.x = pk2(o.x, o.y); w.y = pk2(o.z, o.w); ((GAS v2u*)xbrow + lane)[64 * j] = w; }
        if (outrow) ((GAS f32x4*)outrow + lane)[64 * j] = o; }
}

__device__ __forceinline__ void ln_pass(const float* y, const float* g, const float* b, float* mu, float* rstd, bf16* xb, float* outf, int gw, int NGW, int lane) {
    for (int m = gw; m < MROWS; m += 2 * NGW) {
        const int m1 = m + NGW;
        if (m1 >= MROWS) { ln_row(y + (size_t)m * DMODEL, g, b, mu + m, rstd + m, xb ? xb + (size_t)m * DMODEL : nullptr, outf ? outf + (size_t)m * DMODEL : nullptr, lane); continue; }
        const GAS f32x4* y0 = (const GAS f32x4*)(y + (size_t)m * DMODEL) + lane; const GAS f32x4* y1 = (const GAS f32x4*)(y + (size_t)m1 * DMODEL) + lane;
        f32x4 v0[8], v1[8]; float s0 = 0.f, s1 = 0.f;
#pragma unroll
        for (int j = 0; j < 8; ++j) { v0[j] = y0[64 * j]; v1[j] = y1[64 * j]; }
#pragma unroll
        for (int j = 0; j < 8; ++j) { s0 += (v0[j].x + v0[j].y) + (v0[j].z + v0[j].w); s1 += (v1[j].x + v1[j].y) + (v1[j].z + v1[j].w); }
#pragma unroll
        for (int o = 1; o < 64; o <<= 1) { s0 += __shfl_xor(s0, o); s1 += __shfl_xor(s1, o); }
        const float mean0 = s0 * (1.f / DMODEL), mean1 = s1 * (1.f / DMODEL); float q0 = 0.f, q1 = 0.f;
#pragma unroll
        for (int j = 0; j < 8; ++j) { v0[j] = v0[j] - mean0; v1[j] = v1[j] - mean1;
            q0 += (v0[j].x * v0[j].x + v0[j].y * v0[j].y) + (v0[j].z * v0[j].z + v0[j].w * v0[j].w); q1 += (v1[j].x * v1[j].x + v1[j].y * v1[j].y) + (v1[j].z * v1[j].z + v1[j].w * v1[j].w); }
#pragma unroll
        for (int o = 1; o < 64; o <<= 1) { q0 += __shfl_xor(q0, o); q1 += __shfl_xor(q1, o); }
        const float rs0 = 1.f / sqrtf(q0 * (1.f / DMODEL) + LN_EPS), rs1 = 1.f / sqrtf(q1 * (1.f / DMODEL) + LN_EPS);
        if (lane == 0) { mu[m] = mean0; rstd[m] = rs0; mu[m1] = mean1; rstd[m1] = rs1; }
        const GAS f32x4* gr = (const GAS f32x4*)g + lane; const GAS f32x4* br = (const GAS f32x4*)b + lane;
#pragma unroll
        for (int j = 0; j < 8; ++j) { const f32x4 gg = gr[64 * j], bb = br[64 * j]; const f32x4 o0 = (v0[j] * rs0) * gg + bb, o1 = (v1[j] * rs1) * gg + bb;
            if (xb) { v2u w0, w1; w0.x = pk2(o0.x, o0.y); w0.y = pk2(o0.z, o0.w); w1.x = pk2(o1.x, o1.y); w1.y = pk2(o1.z, o1.w);
                ((GAS v2u*)(xb + (size_t)m * DMODEL) + lane)[64 * j] = w0; ((GAS v2u*)(xb + (size_t)m1 * DMODEL) + lane)[64 * j] = w1; }
            if (outf) { ((GAS f32x4*)(outf + (size_t)m * DMODEL) + lane)[64 * j] = o0; ((GAS f32x4*)(outf + (size_t)m1 * DMODEL) + lane)[64 * j] = o1; } }
    }
}
#define MFMA32(a, b, c) __builtin_amdgcn_mfma_f32_32x32x16_bf16((a), (b), (c), 0, 0, 0)

__device__ __forceinline__ void ba_proj(const bf16* xb, const bf16* wt  , const float* a_log, const float* dt_bias, float* beta, float* g, int gw, int NGW, int lane) {
    const int r32 = lane & 31, hi = lane >> 5;
    for (int wu = gw; wu < MROWS / 32; wu += NGW) {
        const bf16* ap = xb + (size_t)(wu * 32 + r32) * DMODEL + 8 * hi; const bf16* bp = wt + (size_t)(GDN_MAIN + r32) * DMODEL + 8 * hi;
        f32x16 acc = {};
#pragma unroll 1
        for (int s0 = 0; s0 < DMODEL / 16; s0 += 8) {
            bf16x8 a[8], b[8];
#pragma unroll
            for (int s = 0; s < 8; ++s) { a[s] = *(const bf16x8*)(ap + (s0 + s) * 16); b[s] = *(const bf16x8*)(bp + (s0 + s) * 16); }
#pragma unroll
            for (int s = 0; s < 8; ++s) acc = MFMA32(a[s], b[s], acc);
        }
        const int j = r32 & 15; const float al = -__expf(a_log[j]), db = dt_bias[j];
#pragma unroll
        for (int r = 0; r < 16; ++r) { const int t = wu * 32 + (r & 3) + 8 * (r >> 2) + 4 * hi; const float v = acc[r];
            if (r32 < 16) beta[(size_t)t * 16 + j] = __builtin_amdgcn_rcpf(1.f + __expf(-v));
            else { const float z = v + db; const float sp = z > 20.f ? z : log1pf(__expf(z)); g[(size_t)t * 16 + j] = al * sp; } }
    }
}

#ifndef PROBE_G2_NOSCAT
#define PROBE_G2_NOSCAT 0
#endif
typedef short bf16x4 __attribute__((ext_vector_type(4)));
#define MFMA16K16(a, b, c) __builtin_amdgcn_mfma_f32_16x16x16bf16_1k((a), (b), (c), 0, 0, 0)
constexpr int G2_TS = 136;
constexpr int G2_AS = 68, G2_ANS = 72;
constexpr int G2_A = 0, G2_GC = G2_A + 64 * G2_AS * 4, G2_BT = G2_GC + 256, G2_AN = G2_BT + 256, G2_TB = G2_AN + 64 * G2_ANS * 2, G2_Q = G2_TB + 2048, G2_K = G2_Q + 64 * G2_TS * 2, G2_V = G2_K + 64 * G2_TS * 2,
              G2_W = G2_V + 64 * G2_TS * 2, G2_END = G2_W + 64 * G2_TS * 2;
static_assert(G2_END <= RING_BYTES, "G2 LDS");
__device__ __forceinline__ bf16x4 pack4(f32x4 v) { v2u w; w.x = pk2(v[0], v[1]); w.y = pk2(v[2], v[3]); return __builtin_bit_cast(bf16x4, w); }
__device__ __forceinline__ void gdn_chunk_phase(LAS unsigned char* lds, bf16* p, const bf16* halo, const float* beta, float* g, bf16* wbuf, bf16* attn, const float* conv_w, int vcu, int G, bf16* palt = nullptr) {
#define G2_ST(off) ((palt ? palt + ((size_t)(off) & 0x7ffffffull) : p + (size_t)(off)))
    int tid_ = threadIdx.x; asm volatile("" : "+v"(tid_));
    const int tid0 = tid_, lane0 = tid0 & 63, wid0 = __builtin_amdgcn_readfirstlane(tid0 >> 6);
    LAS bf16* Qs = (LAS bf16*)(lds + G2_Q); LAS bf16* Ks = (LAS bf16*)(lds + G2_K); LAS bf16* Vs = (LAS bf16*)(lds + G2_V); LAS bf16* Ws = (LAS bf16*)(lds + G2_W);
    LAS float* As = (LAS float*)(lds + G2_A); LAS float* gcs = (LAS float*)(lds + G2_GC); LAS float* bts = (LAS float*)(lds + G2_BT);
    LAS bf16* An = (LAS bf16*)(lds + G2_AN); LAS bf16* Tb = (LAS bf16*)(lds + G2_TB);
    asm volatile("" : "+v"(Qs), "+v"(Ks), "+v"(Vs), "+v"(Ws), "+v"(As), "+v"(gcs), "+v"(bts), "+v"(An), "+v"(Tb));
    v4u rawv[3][5]; float gpre = 0.f, bpre = 0.f;
#define G2_LOAD_RAW(uu, LN, WD) do { const int cg_ = (uu) >> 4, h_ = (uu) & 15, n_ = cg_ & 63; const size_t r0_ = (size_t)cg_ * 64; const int cgp_l = (LN) & 15, tA_l = 8 * (WD) + 2 * ((LN) >> 4); \
        _Pragma("unroll") for (int X = 0; X < 3; ++X) { const int col_ = X * 2048 + h_ * HD + 8 * cgp_l; \
            _Pragma("unroll") for (int rr = 0; rr < 5; ++rr) { const int rel = tA_l - 3 + rr; v4u v = {0u, 0u, 0u, 0u}; \
                if (rel >= 0) v = *(const v4u*)(p + (r0_ + rel) * GDN_MAIN + col_); \
                else if (n_ > 0) v = *(const v4u*)(halo + ((size_t)(cg_ - 1) * 3 + (rel + 3)) * CONVC + col_); \
                rawv[X][rr] = v; } } \
        if ((WD) == 0) { gpre = g[(r0_ + (LN)) * 16 + h_]; bpre = beta[(r0_ + (LN)) * 16 + h_]; } } while (0)
    if (vcu < NCG * NHEADS) G2_LOAD_RAW(vcu, lane0, wid0);
    for (int u = vcu; u < NCG * NHEADS; u += G) {
        const int cg = u >> 4, h = u & 15; const size_t row0 = (size_t)cg * 64;
        int tl_ = tid0; asm volatile("" : "+v"(tl_));
        const int tid = tl_, lane = tid & 63, wid = __builtin_amdgcn_readfirstlane(tid >> 6), r32 = lane & 31, hi = lane >> 5;
        {
            const int cgp = lane & 15, sub = lane >> 4, tA = 8 * wid + 2 * sub;
#pragma unroll
            for (int X = 0; X < 3; ++X) {
                const int col = X * 2048 + h * HD + 8 * cgp;
                float raw[5][8];
                asm volatile("" : "+v"(rawv[X][0]), "+v"(rawv[X][1]), "+v"(rawv[X][2]), "+v"(rawv[X][3]), "+v"(rawv[X][4]));
#pragma unroll
                for (int rr = 0; rr < 5; ++rr) { const v4u v = rawv[X][rr];
                    raw[rr][0] = bflo(v.x); raw[rr][1] = bfhi(v.x); raw[rr][2] = bflo(v.y); raw[rr][3] = bfhi(v.y); raw[rr][4] = bflo(v.z); raw[rr][5] = bfhi(v.z); raw[rr][6] = bflo(v.w); raw[rr][7] = bfhi(v.w); }
                float o0[8], o1[8];
#pragma unroll
                for (int c = 0; c < 8; ++c) { o0[c] = 0.f; o1[c] = 0.f; }
#pragma unroll
                for (int j = 0; j < 4; ++j) { const f32x4 wa = *(const f32x4*)(conv_w + (size_t)j * CONVC + col), wb = *(const f32x4*)(conv_w + (size_t)j * CONVC + col + 4);
#pragma unroll
                    for (int c = 0; c < 8; ++c) { const float w = c < 4 ? wa[c] : wb[c - 4]; o0[c] += w * raw[j][c]; o1[c] += w * raw[j + 1][c]; } }
                float s0 = 0.f, s1 = 0.f;
#pragma unroll
                for (int c = 0; c < 8; ++c) { o0[c] = silu_f(o0[c]); o1[c] = silu_f(o1[c]); s0 += o0[c] * o0[c]; s1 += o1[c] * o1[c]; }
                if (X < 2) { s0 = sum16(s0); s1 = sum16(s1); const float sc = X == 0 ? 0.08838834764831845f : 1.f; const float f0 = sc * __builtin_amdgcn_rsqf(s0 + GDN_EPS), f1 = sc * __builtin_amdgcn_rsqf(s1 + GDN_EPS);
#pragma unroll
                    for (int c = 0; c < 8; ++c) { o0[c] *= f0; o1[c] *= f1; } }
                LAS bf16* T = X == 0 ? Qs : (X == 1 ? Ks : Vs);
                v4u w0, w1; w0.x = pk2(o0[0], o0[1]); w0.y = pk2(o0[2], o0[3]); w0.z = pk2(o0[4], o0[5]); w0.w = pk2(o0[6], o0[7]);
                w1.x = pk2(o1[0], o1[1]); w1.y = pk2(o1[2], o1[3]); w1.z = pk2(o1[4], o1[5]); w1.w = pk2(o1[6], o1[7]);
                *(LAS v4u*)(T + tA * G2_TS + 8 * cgp) = w0; *(LAS v4u*)(T + (tA + 1) * G2_TS + 8 * cgp) = w1;
                asm volatile("" ::: "memory");
            }
            if (wid == 0) {
                float gv = gpre;
#pragma unroll
                for (int o = 1; o < 64; o <<= 1) { const float t = __shfl_up(gv, o); if (lane >= o) gv += t; }
                gcs[lane] = gv; bts[lane] = bpre; if (!palt) g[(row0 + lane) * 16 + h] = gv;
            }
        }
        __syncthreads();
        if (u + G < NCG * NHEADS) G2_LOAD_RAW(u + G, lane, wid);
        {
            const int rb = (wid >> 1) & 1, cb = wid & 1; const bool isA = wid < 4;
            f32x16 acc = {};
            if (!(rb == 0 && cb == 1)) {
                const LAS bf16* Ar = (isA ? Ks : Qs) + (32 * rb + r32) * G2_TS + 8 * hi; const LAS bf16* Br = Ks + (32 * cb + r32) * G2_TS + 8 * hi;
#pragma unroll
                for (int s = 0; s < 8; ++s) acc = MFMA32(*(const LAS bf16x8*)(Ar + 16 * s), *(const LAS bf16x8*)(Br + 16 * s), acc);
            }
            const int j = 32 * cb + r32; const float gj = gcs[j];
            bf16* at = palt ? palt + (((size_t)u * 4096 + 0x4000000ull) & 0x7ffffffull) : attn + (size_t)u * 4096;
#pragma unroll
            for (int r = 0; r < 16; ++r) { const int i = 32 * rb + (r & 3) + 8 * (r >> 2) + 4 * hi; const float gi = gcs[i];
                if (isA) { const float d = (i > j) ? __expf(gi - gj) : 0.f; const float a = (i > j) ? bts[i] * acc[r] * d : 0.f; As[i * G2_AS + j] = a; An[i * G2_ANS + j] = (bf16)f2bf(-a); }
                else { const float d = (i >= j) ? __expf(gi - gj) : 0.f; const bf16 av = (bf16)f2bf((i >= j) ? acc[r] * d : 0.f); if (!(PROBE_G2_NOSCAT && palt)) at[i * 64 + j] = av; else asm volatile("" :: "v"(av)); } }
        }
        __syncthreads();
        if (wid == 0) {
            const int b = lane >> 4, c = lane & 15; float t[16];
            const LAS float* Ab = As + (16 * b) * G2_AS + 16 * b;
#pragma unroll
            for (int i = 0; i < 16; ++i) {
                float ti = (i == c) ? 1.f : 0.f;
#pragma unroll
                for (int j4 = 0; j4 < (i + 3) / 4; ++j4) { const f32x4 a = *(const LAS f32x4*)(Ab + i * G2_AS + 4 * j4);
#pragma unroll
                    for (int k = 0; k < 4; ++k) if (4 * j4 + k < i) ti -= a[k] * t[4 * j4 + k]; }
                t[i] = ti;
            }
#pragma unroll
            for (int i = 0; i < 16; ++i) Tb[b * 256 + i * 16 + c] = (bf16)f2bf(t[i]);
        } else if (wid < 5) {
            const int tt = tid - 64, cgp = tt & 15, r0 = tt >> 4;
#pragma unroll
            for (int r = 0; r < 4; ++r) { const int i = r0 + 16 * r; const float e = __expf(gcs[i]); const v4u v = *(const LAS v4u*)(Qs + i * G2_TS + 8 * cgp); v4u w;
                w.x = pk2(bflo(v.x) * e, bfhi(v.x) * e); w.y = pk2(bflo(v.y) * e, bfhi(v.y) * e); w.z = pk2(bflo(v.z) * e, bfhi(v.z) * e); w.w = pk2(bflo(v.w) * e, bfhi(v.w) * e);
                *(v4u*)G2_ST((row0 + i) * GDN_MAIN + h * HD + 8 * cgp) = w; }
        } else {
            const float gl = gcs[63];
            for (int task = tid - 320; task < 256; task += 192) { const int dk = task & 127, th = task >> 7;
                bf16* dst = G2_ST((row0 + (dk >> 1)) * GDN_MAIN + 2048 + h * HD + (dk & 1) * 64 + 32 * th);
#pragma unroll
                for (int q = 0; q < 4; ++q) { float v[8];
#pragma unroll
                    for (int k = 0; k < 8; ++k) { const int tk = 32 * th + 8 * q + k; v[k] = bf2f(Ks[tk * G2_TS + dk]) * __expf(gl - gcs[tk]); }
                    v4u w; w.x = pk2(v[0], v[1]); w.y = pk2(v[2], v[3]); w.z = pk2(v[4], v[5]); w.w = pk2(v[6], v[7]); if (!(PROBE_G2_NOSCAT && palt)) *(v4u*)(dst + 8 * q) = w; else asm volatile("" :: "v"(w)); } }
        }
        __syncthreads();
        {
            const int nl = lane & 15, q = lane >> 4; const bool isK = wid >= 4;
            float rsc[16];
#pragma unroll
            for (int b = 0; b < 4; ++b)
#pragma unroll
                for (int r = 0; r < 4; ++r) { const int row = 16 * b + 4 * q + r; rsc[4 * b + r] = isK ? bts[row] * __expf(gcs[row]) : bts[row]; }
            bf16x4 Tq[4], Aq[6];
#pragma unroll
            for (int b = 0; b < 4; ++b) Tq[b] = *(const LAS bf16x4*)(Tb + b * 256 + nl * 16 + 4 * q);
            Aq[0] = *(const LAS bf16x4*)(An + (16 + nl) * G2_ANS + 4 * q);
            Aq[1] = *(const LAS bf16x4*)(An + (32 + nl) * G2_ANS + 4 * q);      Aq[2] = *(const LAS bf16x4*)(An + (32 + nl) * G2_ANS + 16 + 4 * q);
            Aq[3] = *(const LAS bf16x4*)(An + (48 + nl) * G2_ANS + 4 * q);      Aq[4] = *(const LAS bf16x4*)(An + (48 + nl) * G2_ANS + 16 + 4 * q);   Aq[5] = *(const LAS bf16x4*)(An + (48 + nl) * G2_ANS + 32 + 4 * q);
#pragma unroll
            for (int t = 0; t < 2; ++t) {
                const int cc = 32 * (wid & 3) + 16 * t + nl;
                const LAS bf16* src = (isK ? Ks : Vs) + cc;
                f32x4 R[4];
#pragma unroll
                for (int b = 0; b < 4; ++b)
#pragma unroll
                    for (int r = 0; r < 4; ++r) R[b][r] = rsc[4 * b + r] * bf2f(src[(16 * b + 4 * q + r) * G2_TS]);
                const f32x4 z4 = {0.f, 0.f, 0.f, 0.f};
                const f32x4 y0 = MFMA16K16(Tq[0], pack4(R[0]), z4); const bf16x4 y0b = pack4(y0);
                f32x4 c1 = MFMA16K16(Aq[0], y0b, R[1]);
                const f32x4 y1 = MFMA16K16(Tq[1], pack4(c1), z4); const bf16x4 y1b = pack4(y1);
                f32x4 c2 = MFMA16K16(Aq[1], y0b, R[2]); c2 = MFMA16K16(Aq[2], y1b, c2);
                const f32x4 y2 = MFMA16K16(Tq[2], pack4(c2), z4); const bf16x4 y2b = pack4(y2);
                f32x4 c3 = MFMA16K16(Aq[3], y0b, R[3]); c3 = MFMA16K16(Aq[4], y1b, c3); c3 = MFMA16K16(Aq[5], y2b, c3);
                const f32x4 y3 = MFMA16K16(Tq[3], pack4(c3), z4); const bf16x4 y3b = pack4(y3);
                if (!isK) {
                    bf16* dst = G2_ST((row0 + (cc & 63)) * GDN_MAIN + 4096 + h * HD + (cc >> 6) * 64 + 4 * q);
                    if (!(PROBE_G2_NOSCAT && palt)) { *(bf16x4*)(dst) = y0b; *(bf16x4*)(dst + 16) = y1b; *(bf16x4*)(dst + 32) = y2b; *(bf16x4*)(dst + 48) = y3b; } else asm volatile("" :: "v"(y0b), "v"(y1b), "v"(y2b), "v"(y3b));
                } else {
#pragma unroll
                    for (int r = 0; r < 4; ++r) { Ws[(4 * q + r) * G2_TS + cc] = (bf16)y0b[r]; Ws[(16 + 4 * q + r) * G2_TS + cc] = (bf16)y1b[r]; Ws[(32 + 4 * q + r) * G2_TS + cc] = (bf16)y2b[r]; Ws[(48 + 4 * q + r) * G2_TS + cc] = (bf16)y3b[r]; }
                }
            }
        }
        __syncthreads();
#pragma unroll
        for (int k = 0; k < 2; ++k) { const int ch = tid + 512 * k, i = ch >> 4, c8 = ch & 15; *(v4u*)((palt ? palt + (((row0 + i) * DMODEL + h * HD + 8 * c8) & 0x7ffffffull) : wbuf + (row0 + i) * DMODEL + h * HD + 8 * c8)) = *(const LAS v4u*)(Ws + i * G2_TS + 8 * c8); }
    }
#undef G2_ST
#undef G2_LOAD_RAW
}

constexpr int G3_STS = 136, G3_VTS = 72;
constexpr int G3_ST = 0, G3_VT = 64 * G3_STS * 2, G3_END = G3_VT + 64 * G3_VTS * 2;
__device__ __forceinline__ void gdn_scan_phase(LAS unsigned char* lds, bf16* p, const bf16* wbuf, const bf16* attn, const float* g, int vcu, int G, bf16* oalt = nullptr) {
    int tid_ = threadIdx.x; asm volatile("" : "+v"(tid_));
    const int tid = tid_, lane = tid & 63, wid = __builtin_amdgcn_readfirstlane(tid >> 6), r32 = lane & 31, hi = lane >> 5;
    const int role = wid >> 2, a = (wid >> 1) & 1, bb = wid & 1, r = wid >> 1;
    LAS bf16* ST = (LAS bf16*)(lds + G3_ST); LAS bf16* VT = (LAS bf16*)(lds + G3_VT);
    for (int unit = vcu; unit < BATCH * NHEADS * 2; unit += G) {
        const int bh = unit >> 1, e = unit & 1, b = bh >> 4, h = bh & 15;
        for (int i = tid; i < G3_VT / 4; i += NWAVES * 64) ((LAS unsigned*)lds)[i] = 0u;
        f32x16 Sacc = {};
        __syncthreads();
        const bf16* aBase = role == 0 ? wbuf + (size_t)(32 * a + r32) * DMODEL + h * HD + 8 * hi : p + (size_t)(32 * a + r32) * GDN_MAIN + h * HD + 8 * hi;
        const size_t aPitch = role == 0 ? DMODEL : GDN_MAIN;
        const int dkr = 32 * r + r32;
        const bf16* kBase = p + (size_t)(dkr >> 1) * GDN_MAIN + 2048 + h * HD + (dkr & 1) * 64 + 8 * hi;
        const bf16* uBase = p + (size_t)(32 * bb + r32) * GDN_MAIN + 4096 + h * HD + e * 64 + 32 * a + 4 * hi;
        const bf16* pBase = attn + (size_t)(32 * a + r32) * 64 + 8 * hi;
        bf16* oBase = (oalt ? oalt : p + 4096) + h * HD + e * 64 + 32 * bb + r32; const size_t oPitch = oalt ? DMODEL : GDN_MAIN;
        const LAS bf16* sRd = ST + (32 * bb + r32) * G3_STS + 8 * hi; const LAS bf16* vRd = VT + (32 * bb + r32) * G3_VTS + 8 * hi;
        LAS bf16* vWr = VT + (32 * bb + r32) * G3_VTS + 32 * a + 4 * hi; LAS bf16* sWr = ST + (32 * bb + r32) * G3_STS + 32 * r + 4 * hi;
#define G3_LOAD_A(nn) do { const size_t row0_ = (size_t)b * SEQ + (size_t)(nn) * 64; \
            _Pragma("unroll") for (int s = 0; s < 8; ++s) Af[s] = *(const bf16x8*)(aBase + row0_ * aPitch + 16 * s); } while (0)
#define G3_LOAD_U(nn) do { const size_t row0_ = (size_t)b * SEQ + (size_t)(nn) * 64; \
            _Pragma("unroll") for (int q = 0; q < 4; ++q) Uf[q] = *(const v2u*)(uBase + row0_ * GDN_MAIN + 8 * q); } while (0)
#define G3_LOAD_PK(nn) do { const size_t row0_ = (size_t)b * SEQ + (size_t)(nn) * 64; \
            if (role == 1) { const bf16* pp_ = pBase + ((size_t)(b * 64 + (nn)) * 16 + h) * 4096; _Pragma("unroll") for (int s = 0; s < 4; ++s) Pf[s] = *(const bf16x8*)(pp_ + 16 * s); } \
            _Pragma("unroll") for (int s = 0; s < 4; ++s) Kf[s] = *(const bf16x8*)(kBase + row0_ * GDN_MAIN + 16 * s); \
            dd = __expf(g[(row0_ + 63) * 16 + h]); } while (0)
        bf16x8 Af[8], Kf[4], Pf[4]; v2u Uf[4]; float dd;
#pragma unroll
        for (int s = 0; s < 4; ++s) { Pf[s] = (bf16x8){0, 0, 0, 0, 0, 0, 0, 0}; Uf[s] = (v2u){0u, 0u}; }
        G3_LOAD_A(0); if (role == 0) G3_LOAD_U(0); G3_LOAD_PK(0);
#pragma unroll 1
        for (int n = 0; n < 64; ++n) {
            const size_t row0_ = (size_t)b * SEQ + (size_t)n * 64; const int nn = (n + 1 < 64) ? n + 1 : n;
            f32x16 acc_ = {};
#pragma unroll
            for (int s = 0; s < 8; ++s) acc_ = MFMA32(Af[s], *(const LAS bf16x8*)(sRd + 16 * s), acc_);
            G3_LOAD_A(nn);
            if (role == 0) {
#pragma unroll
                for (int q = 0; q < 4; ++q) { v2u w_;
                    w_.x = pk2(bflo(Uf[q].x) - acc_[4 * q], bfhi(Uf[q].x) - acc_[4 * q + 1]); w_.y = pk2(bflo(Uf[q].y) - acc_[4 * q + 2], bfhi(Uf[q].y) - acc_[4 * q + 3]);
                    *(LAS v2u*)(vWr + 8 * q) = w_; }
                G3_LOAD_U(nn);
            }
            WG_BAR();
            bf16x8 Vf_[4];
#pragma unroll
            for (int s = 0; s < 4; ++s) Vf_[s] = *(const LAS bf16x8*)(vRd + 16 * s);
            if (role == 1) {
#pragma unroll
                for (int s = 0; s < 4; ++s) acc_ = MFMA32(Pf[s], Vf_[s], acc_);
#pragma unroll
                for (int rr = 0; rr < 16; ++rr) oBase[(row0_ + 32 * a + (rr & 3) + 8 * (rr >> 2) + 4 * hi) * oPitch] = (bf16)f2bf(acc_[rr]);
            }
            Sacc = Sacc * dd;
#pragma unroll
            for (int s = 0; s < 4; ++s) Sacc = MFMA32(Kf[s], Vf_[s], Sacc);
            G3_LOAD_PK(nn);
#pragma unroll
            for (int q = 0; q < 4; ++q) { v2u w_; w_.x = pk2(Sacc[4 * q], Sacc[4 * q + 1]); w_.y = pk2(Sacc[4 * q + 2], Sacc[4 * q + 3]); *(LAS v2u*)(sWr + 8 * q) = w_; }
            WG_BAR();
        }
#undef G3_LOAD_A
#undef G3_LOAD_U
#undef G3_LOAD_PK
        VM_WAIT(); __syncthreads();
    }
}

__device__ __forceinline__ void gdn_gate_phase(bf16* p, const float* norm_w, int gw, int NGW, int lane, bf16* oalt = nullptr) {
    for (int m = gw; m < MROWS; m += NGW) {
        bf16* orow = p + (size_t)m * GDN_MAIN + 4096; const bf16* zrow = p + (size_t)m * GDN_MAIN + 6144;
#pragma unroll
        for (int it = 0; it < 4; ++it) { const int col = it * 512 + lane * 8;
            const v4u ov = *(const v4u*)(orow + col), zv = *(const v4u*)(zrow + col);
            float o[8] = {bflo(ov.x), bfhi(ov.x), bflo(ov.y), bfhi(ov.y), bflo(ov.z), bfhi(ov.z), bflo(ov.w), bfhi(ov.w)};
            float z[8] = {bflo(zv.x), bfhi(zv.x), bflo(zv.y), bfhi(zv.y), bflo(zv.z), bfhi(zv.z), bflo(zv.w), bfhi(zv.w)};
            float s = 0.f;
#pragma unroll
            for (int c = 0; c < 8; ++c) s += o[c] * o[c];
            s = sum16(s); const float rs = __builtin_amdgcn_rsqf(s * (1.f / HD) + GDN_EPS);
            const f32x4 wa = *(const f32x4*)(norm_w + (col & 127)), wb = *(const f32x4*)(norm_w + (col & 127) + 4);
#pragma unroll
            for (int c = 0; c < 8; ++c) o[c] = o[c] * rs * (c < 4 ? wa[c] : wb[c - 4]) * silu_f(z[c]);
            v4u w; w.x = pk2(o[0], o[1]); w.y = pk2(o[2], o[3]); w.z = pk2(o[4], o[5]); w.w = pk2(o[6], o[7]); *(v4u*)((oalt ? oalt + (size_t)m * DMODEL : orow) + col) = w; }
    }
}

__device__ __forceinline__ void diff_combine_phase(const bf16* o0, const bf16* o1, bf16* og, const float* lam_params  , const float* subln_w, float lambda_init, int gw, int NGW, int lane) {
    const float e1 = wave_sum(lam_params[lane] * lam_params[64 + lane]), e2 = wave_sum(lam_params[128 + lane] * lam_params[192 + lane]);
    const float lam = __expf(e1) - __expf(e2) + lambda_init, post = 1.f - lambda_init;
    for (int m = gw; m < MROWS; m += NGW) {
#pragma unroll
        for (int it = 0; it < 4; ++it) { const int col = it * 512 + lane * 8; const size_t off = (size_t)m * DMODEL + col;
            const v4u av = *(const v4u*)(o0 + off), bv = *(const v4u*)(o1 + off);
            float d[8] = {bflo(av.x) - lam * bflo(bv.x), bfhi(av.x) - lam * bfhi(bv.x), bflo(av.y) - lam * bflo(bv.y), bfhi(av.y) - lam * bfhi(bv.y),
                          bflo(av.z) - lam * bflo(bv.z), bfhi(av.z) - lam * bfhi(bv.z), bflo(av.w) - lam * bflo(bv.w), bfhi(av.w) - lam * bfhi(bv.w)};
            float s = 0.f;
#pragma unroll
            for (int c = 0; c < 8; ++c) s += d[c] * d[c];
            s = sum16(s); const float rs = post * __builtin_amdgcn_rsqf(s * (1.f / HD) + SUBLN_EPS);
            const f32x4 wa = *(const f32x4*)(subln_w + (col & 127)), wb = *(const f32x4*)(subln_w + (col & 127) + 4);
#pragma unroll
            for (int c = 0; c < 8; ++c) d[c] = d[c] * rs * (c < 4 ? wa[c] : wb[c - 4]);
            v4u w; w.x = pk2(d[0], d[1]); w.y = pk2(d[2], d[3]); w.z = pk2(d[4], d[5]); w.w = pk2(d[6], d[7]); *(v4u*)(og + off) = w; }
    }
}
#ifndef PG8_SP2
#define PG8_SP2 true
#endif
#ifndef PG8_ALIGN
#define PG8_ALIGN true
#endif
#ifndef EN_P0
#define EN_P0 1
#endif
#ifndef EN_G1
#define EN_G1 1
#endif
#ifndef EN_G2
#define EN_G2 1
#endif
#ifndef EN_G3
#define EN_G3 1
#endif
#ifndef EN_G4
#define EN_G4 1
#endif
#ifndef EN_G5
#define EN_G5 1
#endif
#ifndef EN_G6
#define EN_G6 1
#endif
#ifndef EN_G7
#define EN_G7 1
#endif
#ifndef EN_G8
#define EN_G8 1
#endif
#ifndef EN_G9
#define EN_G9 1
#endif
#ifndef EN_D1
#define EN_D1 1
#endif
#ifndef EN_D2
#define EN_D2 1
#endif
#ifndef EN_D3
#define EN_D3 1
#endif
#ifndef EN_D4
#define EN_D4 1
#endif
#ifndef EN_D5
#define EN_D5 1
#endif
#ifndef EN_D6U
#define EN_D6U 1
#endif
#ifndef EN_D6D
#define EN_D6D 1
#endif
#ifndef EN_D7
#define EN_D7 1
#endif
#ifndef REP_P0
#define REP_P0 1
#endif
#ifndef REP_G1
#define REP_G1 1
#endif
#ifndef REP_G2
#define REP_G2 1
#endif
#ifndef REP_G3
#define REP_G3 1
#endif
#ifndef REP_G4
#define REP_G4 1
#endif
#ifndef REP_G5
#define REP_G5 1
#endif
#ifndef REP_G6
#define REP_G6 1
#endif
#ifndef REP_G7
#define REP_G7 1
#endif
#ifndef REP_G8
#define REP_G8 1
#endif
#ifndef REP_G9
#define REP_G9 1
#endif
#ifndef REP_D1
#define REP_D1 1
#endif
#ifndef REP_D2
#define REP_D2 1
#endif
#ifndef REP_D3
#define REP_D3 1
#endif
#ifndef REP_D4
#define REP_D4 1
#endif
#ifndef REP_D5
#define REP_D5 1
#endif
#ifndef REP_D6U
#define REP_D6U 1
#endif
#ifndef REP_D6D
#define REP_D6D 1
#endif
#ifndef REP_D7
#define REP_D7 1
#endif
#ifndef PROBE_NOSTORE
#define PROBE_NOSTORE 0
#endif
struct Args { const float* in[16]; float* out; unsigned char* ws; int ph_lo, ph_hi; };
__global__ void __launch_bounds__(NWAVES * 64, 2) yoco_fwd(Args args) {
    extern __shared__ __attribute__((aligned(16))) unsigned char lds_raw[];
    LAS unsigned char* lds = (LAS unsigned char*)lds_raw;
    volatile LAS unsigned* MISC = (volatile LAS unsigned*)(lds + MISC_OFF);
    const int tid = threadIdx.x, lane = tid & 63, wave = __builtin_amdgcn_readfirstlane(tid >> 6);
    const int G = gridDim.x, bx = blockIdx.x, vcu = (G % 8 == 0) ? (bx % 8) * (G / 8) + bx / 8 : bx;
    const int gw = vcu * NWAVES + wave, NGW = G * NWAVES, gtid = vcu * NWAVES * 64 + tid, NGT = G * NWAVES * 64;
    const float* ln_g = args.in[14]; const float* ln_b = args.in[15];
    for (int u = tid; u < (LDS_BYTES - LDSCTL_OFF) / 4; u += NWAVES * 64) ((LAS unsigned*)(lds + LDSCTL_OFF))[u] = 0u;
    __syncthreads();
    XcdBarrier bar; bar.bar = (unsigned*)(args.ws + WS_CTL) + CW_BAR; bar.x = 0; bar.st = nullptr;
    if (!MK_PER_PHASE) bar = xcd_barrier_post((unsigned*)(args.ws + WS_CTL) + CW_BAR, MISC + 8);
    const int lo = args.ph_lo, hi = args.ph_hi;
#define IN(k) (lo <= (k) && (k) < hi)
#define FRESH_LANE() int ln_ = lane; asm volatile("" : "+v"(ln_)); unsigned char* ws_ = args.ws; asm volatile("" : "+s"(ws_)); int gw_ = gw, vcu_ = vcu, bx_ = bx; asm volatile("" : "+s"(gw_), "+s"(vcu_), "+s"(bx_))
#define x_in         (args.in[0])
#define gdn_w_in     (args.in[1])
#define gdn_conv_w   (args.in[2])
#define gdn_a_log    (args.in[3])
#define gdn_dt_bias  (args.in[4])
#define gdn_norm_w   (args.in[5])
#define gdn_w_out    (args.in[6])
#define diff_w_q     (args.in[7])
#define diff_lambda  (args.in[8])
#define diff_subln_w (args.in[9])
#define diff_w_o     (args.in[10])
#define shared_w_kv  (args.in[11])
#define mlp_w_up     (args.in[12])
#define mlp_w_down   (args.in[13])
#define ones  ((float*)(ws_ + WS_ONES))
#define zeros ((float*)(ws_ + WS_ZEROS))
#define mu    ((float*)(ws_ + WS_MU))
#define rstd  ((float*)(ws_ + WS_RSTD))
#define beta  ((float*)(ws_ + WS_BETA))
#define gdec  ((float*)(ws_ + WS_G))
#define halo  ((bf16*)(ws_ + WS_HALO))
#define WA    ((bf16*)(ws_ + WS_WA))
#define WB    ((bf16*)(ws_ + WS_WB))
#define attnb ((bf16*)(ws_ + WS_ATTN))
#define XB    ((bf16*)(ws_ + WS_XB))
#define Y     ((float*)(ws_ + WS_Y))
#define R1    ((bf16*)(ws_ + WS_R1))
#define Kb    (R1)
#define Vb    (R1 + QTR / 2)
#define Qb    (R1 + 2 * (QTR / 2))
#define O0    (R1 + 3 * (QTR / 2))
#define O1    (XB)
#define HID   (Qb)
#define SEAM(k) do { if (!MK_PER_PHASE && (k) + 1 < hi) xcd_barrier(bar); } while (0)

    for (int rep_ = 0; rep_ < REP_P0; ++rep_) if (EN_P0 && IN(0)) { FRESH_LANE();
        for (int i = gtid; i < DMODEL; i += NGT) { ones[i] = 1.f; zeros[i] = 0.f; }
        for (int i = gtid; i < MROWS; i += NGT) { mu[i] = 0.f; rstd[i] = 1.f; }
        for (int m = gw_; m < MROWS; m += NGW) row_to_bf16(x_in + (size_t)m * DMODEL, XB + (size_t)m * DMODEL, ln_);
        convert_w(lds, gw_, NGW, wave, ln_, gdn_w_in, DMODEL, GDN_PROJ, 0, GDN_PROJ, WA, 0);
        SEAM(0);
    }
    for (int l = 0; l < 2; ++l) {
        const int pb = 1 + 9 * l;
        for (int rep_ = 0; rep_ < REP_G1; ++rep_) if (EN_G1 && IN(pb + 0)) { FRESH_LANE();
            pg8::Gemm g{XB, WA, MROWS, GDN_MAIN, DMODEL, DMODEL}; pg8::StaticOrder S; S.init(MROWS, GDN_MAIN, G, bx_);
            pg8::EpiStore<0> E{R1, GDN_MAIN, 0, 0, -1, 1.f, halo};
            pg8::gemm_phase<pg8::EpiStore<0>, pg8::StaticOrder, PG8_ALIGN, PG8_SP2>(lds + RING_OFF, g, S, E);
            ba_proj(XB, WA, gdn_a_log + l * 16, gdn_dt_bias + l * 16, beta, gdec, gw_, NGW, ln_);
            SEAM(pb + 0);
        }
        for (int rep_ = 0; rep_ < REP_G2; ++rep_) if (EN_G2 && IN(pb + 1)) { FRESH_LANE(); gdn_chunk_phase(lds, R1, halo, beta, gdec, XB, attnb, gdn_conv_w + (size_t)l * 4 * CONVC, vcu_, G, (rep_ + 1 < REP_G2) ? (bf16*)args.out : nullptr); SEAM(pb + 1); }
        for (int rep_ = 0; rep_ < REP_G3; ++rep_) if (EN_G3 && IN(pb + 2)) { FRESH_LANE(); gdn_scan_phase(lds, R1, XB, attnb, gdec, vcu_, G, (rep_ + 1 < REP_G3) ? (bf16*)args.out : nullptr); SEAM(pb + 2); }
        for (int rep_ = 0; rep_ < REP_G4; ++rep_) if (EN_G4 && IN(pb + 3)) { FRESH_LANE();
            gdn_gate_phase(R1, gdn_norm_w + l * HD, gw_, NGW, ln_, (rep_ + 1 < REP_G4) ? (bf16*)args.out : nullptr);
            convert_w(lds, gw_, NGW, wave, ln_, gdn_w_out + (size_t)l * DMODEL * DMODEL, DMODEL, DMODEL, 0, DMODEL, WA, 0);
            convert_w(lds, gw_, NGW, wave, ln_, mlp_w_up + (size_t)l * DMODEL * DFF, DMODEL, DFF, 0, DFF, WB, 0);
            SEAM(pb + 3);
        }
        for (int rep_ = 0; rep_ < REP_G5; ++rep_) if (EN_G5 && IN(pb + 4)) { FRESH_LANE();
            pg8::Gemm g{R1 + 4096, WA, MROWS, DMODEL, DMODEL, GDN_MAIN}; pg8::StaticOrder S; S.init(MROWS, DMODEL, G, bx_);
            const float* yin = (l == 0) ? x_in : Y; const float* xg = (l == 0) ? ones : ln_g + (size_t)((l - 1) * 2 + 1) * DMODEL; const float* xbt = (l == 0) ? zeros : ln_b + (size_t)((l - 1) * 2 + 1) * DMODEL;
            pg8::EpiResid E{yin, (rep_ + 1 < REP_G5) ? args.out : Y, mu, rstd, xg, xbt, DMODEL, ALPHA_RES};
            pg8::gemm_phase<pg8::EpiResid, pg8::StaticOrder, PG8_ALIGN, PG8_SP2>(lds + RING_OFF, g, S, E);
            SEAM(pb + 4);
        }
        const float* g1 = ln_g + (size_t)(l * 2) * DMODEL; const float* b1 = ln_b + (size_t)(l * 2) * DMODEL;
        for (int rep_ = 0; rep_ < REP_G6; ++rep_) if (EN_G6 && IN(pb + 5)) { FRESH_LANE();
            ln_pass(Y, g1, b1, mu, rstd, XB, nullptr, gw_, NGW, ln_);
            convert_w(lds, gw_, NGW, wave, ln_, mlp_w_down + (size_t)l * DFF * DMODEL, DFF, DMODEL, 0, DMODEL, WA, 0);
            SEAM(pb + 5);
        }
        for (int rep_ = 0; rep_ < REP_G7; ++rep_) if (EN_G7 && IN(pb + 6)) { FRESH_LANE();
            pg8::Gemm g{XB, WB, MROWS, DFF, DMODEL, DMODEL}; pg8::StaticOrder S; S.init(MROWS, DFF, G, bx_);
            pg8::EpiStore<1> E{R1, DFF, 0, 0, -1, 1.f, nullptr};
            pg8::gemm_phase<pg8::EpiStore<1>, pg8::StaticOrder, PG8_ALIGN, PG8_SP2>(lds + RING_OFF, g, S, E);
            SEAM(pb + 6);
        }
        for (int rep_ = 0; rep_ < REP_G8; ++rep_) if (EN_G8 && IN(pb + 7)) { FRESH_LANE();
            pg8::Gemm g{R1, WA, MROWS, DMODEL, DFF, DFF}; pg8::StaticOrder S; S.init(MROWS, DMODEL, G, bx_);
            pg8::EpiResid E{Y, (rep_ + 1 < REP_G8) ? args.out : Y, mu, rstd, g1, b1, DMODEL, ALPHA_RES};
            pg8::gemm_phase<pg8::EpiResid, pg8::StaticOrder, PG8_ALIGN, PG8_SP2>(lds + RING_OFF, g, S, E);
            SEAM(pb + 7);
        }
        for (int rep_ = 0; rep_ < REP_G9; ++rep_) if (EN_G9 && IN(pb + 8)) { FRESH_LANE();
            const float* g2 = ln_g + (size_t)(l * 2 + 1) * DMODEL; const float* b2 = ln_b + (size_t)(l * 2 + 1) * DMODEL;
            ln_pass(Y, g2, b2, mu, rstd, XB, nullptr, gw_, NGW, ln_);
            if (l == 0) convert_w(lds, gw_, NGW, wave, ln_, gdn_w_in + (size_t)DMODEL * GDN_PROJ, DMODEL, GDN_PROJ, 0, GDN_PROJ, WA, 0);
            else { convert_w(lds, gw_, NGW, wave, ln_, shared_w_kv, DMODEL, 2 * DMODEL, 0, 2 * DMODEL, WA, 0);
                   convert_w(lds, gw_, NGW, wave, ln_, diff_w_q, DMODEL, DMODEL, 0, DMODEL, WA, 2 * DMODEL); }
            SEAM(pb + 8);
        }
    }
    for (int j = 0; j < 2; ++j) {
        const int pb = 19 + 10 * j, L = 2 + j;
        const float* xg = ln_g + (size_t)((L - 1) * 2 + 1) * DMODEL; const float* xbt = ln_b + (size_t)((L - 1) * 2 + 1) * DMODEL;
        for (int rep_ = 0; rep_ < REP_D1; ++rep_) if (EN_D1 && IN(pb + 0)) { FRESH_LANE();
            const int N = (j == 0) ? 3 * DMODEL : DMODEL;
            pg8::Gemm g{XB, WA, MROWS, N, DMODEL, DMODEL}; pg8::StaticOrder S; S.init(MROWS, N, G, bx_);
            pg8::EpiStore<0> E{(j == 0) ? Kb : Qb, DMODEL, (j == 0) ? DMODEL : 0, QTR / 2, (j == 0) ? 2 : 0, dattn::C2, nullptr};
            pg8::gemm_phase<pg8::EpiStore<0>, pg8::StaticOrder, PG8_ALIGN, PG8_SP2>(lds + RING_OFF, g, S, E);
            SEAM(pb + 0);
        }
        for (int rep_ = 0; rep_ < REP_D2; ++rep_) if (EN_D2 && IN(pb + 1)) { FRESH_LANE();
            const float lambda_init = 0.8f - 0.6f * expf(-0.3f * (float)L);
            const float* lp = diff_lambda + (size_t)j * 256;
            const float e1 = wave_sum(lp[ln_] * lp[64 + ln_]), e2 = wave_sum(lp[128 + ln_] * lp[192 + ln_]);
            const dattn::Params AP{(const dattn::bf16*)Qb, (const dattn::bf16*)Kb, (const dattn::bf16*)Vb, (dattn::bf16*)Qb, diff_subln_w + j * HD, __expf(e1) - __expf(e2) + lambda_init, 1.f - lambda_init};
            dattn::phase<8>((char*)lds_raw + RING_OFF, AP, G, bx_);
            convert_w(lds, gw_, NGW, wave, ln_, diff_w_o + (size_t)j * DMODEL * DMODEL, DMODEL, DMODEL, 0, DMODEL, WB, 0);
            convert_w(lds, gw_, NGW, wave, ln_, mlp_w_up + (size_t)L * DMODEL * DFF, DMODEL, DFF, 0, DFF, WA, 0);
            SEAM(pb + 1);
        }
        for (int rep_ = 0; rep_ < REP_D4; ++rep_) if (EN_D4 && IN(pb + 3)) { FRESH_LANE();
            pg8::Gemm g{Qb, WB, MROWS, DMODEL, DMODEL, DMODEL}; pg8::StaticOrder S; S.init(MROWS, DMODEL, G, bx_);
            pg8::EpiResid E{Y, (rep_ + 1 < REP_D4) ? args.out : Y, mu, rstd, xg, xbt, DMODEL, ALPHA_RES};
            pg8::gemm_phase<pg8::EpiResid, pg8::StaticOrder, PG8_ALIGN, PG8_SP2>(lds + RING_OFF, g, S, E);
            SEAM(pb + 3);
        }
        const float* g1 = ln_g + (size_t)(L * 2) * DMODEL; const float* b1 = ln_b + (size_t)(L * 2) * DMODEL;
        for (int rep_ = 0; rep_ < REP_D5; ++rep_) if (EN_D5 && IN(pb + 4)) { FRESH_LANE();
            ln_pass(Y, g1, b1, mu, rstd, XB, nullptr, gw_, NGW, ln_);
            convert_w(lds, gw_, NGW, wave, ln_, mlp_w_down + (size_t)L * DFF * DMODEL, DFF, DMODEL, 0, DMODEL, WB, 0);
            SEAM(pb + 4);
        }
        for (int hf = 0; hf < 2; ++hf) {
            const size_t roff = (size_t)hf * (MROWS / 2);
            for (int rep_ = 0; rep_ < REP_D6U; ++rep_) if (EN_D6U && IN(pb + 5 + 2 * hf)) { FRESH_LANE();
                pg8::Gemm g{XB + roff * DMODEL, WA, MROWS / 2, DFF, DMODEL, DMODEL}; pg8::StaticOrder S; S.init(MROWS / 2, DFF, G, bx_);
                pg8::EpiStore<1> E{(PROBE_NOSTORE && rep_ + 1 < REP_D6U) ? (bf16*)nullptr : HID, DFF, 0, 0, -1, 1.f, nullptr};
                pg8::gemm_phase<pg8::EpiStore<1>, pg8::StaticOrder, PG8_ALIGN, PG8_SP2>(lds + RING_OFF, g, S, E);
                SEAM(pb + 5 + 2 * hf);
            }
            for (int rep_ = 0; rep_ < REP_D6D; ++rep_) if (EN_D6D && IN(pb + 6 + 2 * hf)) { FRESH_LANE();
                pg8::Gemm g{HID, WB, MROWS / 2, DMODEL, DFF, DFF}; pg8::StaticOrder S; S.init(MROWS / 2, DMODEL, G, bx_);
                pg8::EpiResid E{Y + roff * DMODEL, ((rep_ + 1 < REP_D6D) ? args.out : Y) + roff * DMODEL, mu + roff, rstd + roff, g1, b1, DMODEL, ALPHA_RES};
                pg8::gemm_phase<pg8::EpiResid, pg8::StaticOrder, PG8_ALIGN, PG8_SP2>(lds + RING_OFF, g, S, E);
                SEAM(pb + 6 + 2 * hf);
            }
        }
        for (int rep_ = 0; rep_ < REP_D7; ++rep_) if (EN_D7 && IN(pb + 9)) { FRESH_LANE();
            const float* g2 = ln_g + (size_t)(L * 2 + 1) * DMODEL; const float* b2 = ln_b + (size_t)(L * 2 + 1) * DMODEL;
            if (j == 0) { ln_pass(Y, g2, b2, mu, rstd, XB, nullptr, gw_, NGW, ln_);
                          convert_w(lds, gw_, NGW, wave, ln_, diff_w_q + (size_t)DMODEL * DMODEL, DMODEL, DMODEL, 0, DMODEL, WA, 0); }
            else { ln_pass(Y, g2, b2, mu, rstd, nullptr, args.out, gw_, NGW, ln_); }
            SEAM(pb + 9);
        }
    }
#undef IN
#undef SEAM
}

extern "C" void kernel_launch(void* const* d_in, const int* in_sizes, int n_in, void* d_out, int out_size, void* d_ws, size_t ws_size, hipStream_t stream) {
    static int grid = 0;
    if (grid == 0) {
        if (n_in != 16 || in_sizes[0] != MROWS * DMODEL || out_size != MROWS * DMODEL || ws_size < WS_END) { fprintf(stderr, "kernel_launch: unexpected shapes / workspace (n_in %d, ws %zu < %zu); nothing launched\n", n_in, ws_size, (size_t)WS_END); grid = -1; return; }
        int dev = 0, cus = 0, per_cu = 0;
        if (hipGetDevice(&dev) != hipSuccess || hipDeviceGetAttribute(&cus, hipDeviceAttributeMultiprocessorCount, dev) != hipSuccess) { grid = -1; return; }
        if (hipFuncSetAttribute((const void*)yoco_fwd, hipFuncAttributeMaxDynamicSharedMemorySize, LDS_BYTES) != hipSuccess) { fprintf(stderr, "kernel_launch: hipFuncSetAttribute failed\n"); grid = -1; return; }
        if (hipOccupancyMaxActiveBlocksPerMultiprocessor(&per_cu, (const void*)yoco_fwd, NWAVES * 64, LDS_BYTES) != hipSuccess || per_cu < 1)
            fprintf(stderr, "kernel_launch: note: occupancy query reports %d workgroups per CU\n", per_cu);
        (void)hipGetLastError();
        grid = cus;
    }
    if (grid < 0) return;
    if (hipMemsetAsync((char*)d_ws + WS_CTL, 0, CTL_ZERO_BYTES, stream) != hipSuccess) return;
    Args a{};
    for (int i = 0; i < 16; ++i) a.in[i] = (const float*)d_in[i];
    a.out = (float*)d_out; a.ws = (unsigned char*)d_ws;
#if MK_PER_PHASE
    for (int k = 0; k < N_PHASES; ++k) { a.ph_lo = k; a.ph_hi = k + 1; hipLaunchKernelGGL(yoco_fwd, dim3(grid), dim3(NWAVES * 64), LDS_BYTES, stream, a); }
#else
    a.ph_lo = 0; a.ph_hi = N_PHASES;
    hipLaunchKernelGGL(yoco_fwd, dim3(grid), dim3(NWAVES * 64), LDS_BYTES, stream, a);
#endif
    const hipError_t le = hipPeekAtLastError();
    if (le != hipSuccess) fprintf(stderr, "kernel_launch: launch failed: %s\n", hipGetErrorName(le));
}
```

```cpp
#define PG8_STORE_SC1 1
#include <hip/hip_runtime.h>
#include <hip/hip_bf16.h>
#include <cstdio>
#include <cstdint>
#include <cmath>

namespace pg8 {
#define PG8_LAS __attribute__((address_space(3)))
typedef unsigned short bf16_t;
typedef short bf16x8 __attribute__((ext_vector_type(8)));
typedef float f32x4 __attribute__((ext_vector_type(4)));
typedef unsigned u32x4 __attribute__((ext_vector_type(4)));
#define PG8_GAS __attribute__((address_space(1)))
#ifndef PG8_STORE_SC1
#define PG8_STORE_SC1 0
#endif
constexpr int BM = 256, BK = 64, HALF = 128, HTB = HALF * BK * 2  , STAGE_BYTES = 8 * HTB, NXCD = 8, WGM = 8;

__host__ __device__ __forceinline__ int lds_byte(int r, int c) { const int st = (r >> 4) * 2 + (c >> 5), rr = r & 15, cc = c & 31, ob = rr * 64 + cc * 2; return st * 1024 + (ob ^ (((ob >> 9) & 1) << 5)); }
__host__ __device__ __forceinline__ void stage_rc(int b, int& R, int& C) { const int st = b / 1024, sb = b % 1024, swz = sb ^ (((sb >> 9) & 1) << 5); R = (st >> 1) * 16 + swz / 64; C = (st & 1) * 32 + (swz % 64) / 2; }
__host__ __device__ __forceinline__ int perm32(int rho) { const int n = rho >> 4, i = rho & 15; return 8 * (i >> 2) + 4 * n + (i & 3); }

struct Unit { int pm, pn; };
struct Gemm { const bf16_t* A; const bf16_t* Bt; int M, N, K, lda; };

struct StaticOrder {
    int nM, nN, nwg, G, c;
    __host__ __device__ void init(int M, int N, int G_, int c_) { nM = M / BM; nN = N / BM; nwg = nM * nN; G = G_; c = c_; }
    __host__ __device__ bool next(int i, Unit& u) const {
        const long L = (long)i * G + c; if (L >= nwg) return false;
        int wgid = (int)L; { const int q = nwg / NXCD, r = nwg % NXCD, xcd = wgid % NXCD, off = wgid / NXCD; wgid = (xcd < r ? xcd * (q + 1) : r * (q + 1) + (xcd - r) * q) + off; }
        const int nig = WGM * nN, gid = wgid / nig, fm = gid * WGM, gsz = (nM - fm) < WGM ? (nM - fm) : WGM;
        u.pm = fm + ((wgid % nig) % gsz); u.pn = (wgid % nig) / gsz; return true;
    }
    __device__ __forceinline__ void a_ready(const Unit&) const {}
    __device__ __forceinline__ void done(const Unit&) const {}
};

__device__ __forceinline__ unsigned cvt_pk_bf16(float lo, float hi) { unsigned r; asm volatile("v_cvt_pk_bf16_f32 %0, %1, %2" : "=v"(r) : "v"(lo), "v"(hi)); return r; }

template <int ACT> struct EpiStore {
    static constexpr bool PERM = true, AFTER_DRAIN = false;
    bf16_t* O; int ldc; int split_cols; size_t split_stride; int scale_tile; float scale0; bf16_t* halo;
    __device__ __forceinline__ void operator()(const f32x4 (&acc)[2][2][4][2], const Unit& u, int wr, int wc, int fr, int fq) const {
        const int row0 = u.pm * BM + wr * 64 + fr; int colt = u.pn * BM; PG8_GAS bf16_t* base = (PG8_GAS bf16_t*)O; PG8_GAS bf16_t* hal = (PG8_GAS bf16_t*)halo;
        int t = 0; if (split_cols) { t = colt / split_cols; base += (size_t)t * split_stride; colt -= t * split_cols; }
        const float sc = (t == scale_tile) ? scale0 : 1.f;
        const int col0 = colt + wc * 32 + 8 * fq;
#pragma unroll
        for (int ai = 0; ai < 2; ++ai)
#pragma unroll
            for (int m = 0; m < 4; ++m) { const int row = row0 + ai * HALF + m * 16; PG8_GAS bf16_t* rowp = base + (size_t)row * ldc + col0;
#pragma unroll
                for (int bj = 0; bj < 2; ++bj) { f32x4 v0 = acc[ai][bj][m][0], v1 = acc[ai][bj][m][1];
                    if (ACT == 1) {
#pragma unroll
                        for (int e = 0; e < 4; ++e) { const float a = fmaxf(v0[e], 0.f), b = fmaxf(v1[e], 0.f); v0[e] = a * a; v1[e] = b * b; } }
                    if (sc != 1.f) { v0 = v0 * sc; v1 = v1 * sc; }
                    u32x4 w; w.x = cvt_pk_bf16(v0[0], v0[1]); w.y = cvt_pk_bf16(v0[2], v0[3]); w.z = cvt_pk_bf16(v1[0], v1[1]); w.w = cvt_pk_bf16(v1[2], v1[3]);
#if PG8_STORE_SC1
                    if (O != nullptr) asm volatile("global_store_dwordx4 %0, %1, off sc1\n\ts_nop 1" :: "v"(rowp + bj * HALF), "v"(w) : "memory"); else asm volatile("" :: "v"(w));
#else
                    if (O != nullptr) *(PG8_GAS u32x4*)(rowp + bj * HALF) = w; else asm volatile("" :: "v"(w));
#endif
                    if (halo != nullptr && m == 3 && fr >= 13) { const int c = col0 + bj * HALF; if (c < 6144) *(PG8_GAS u32x4*)(hal + ((size_t)(row >> 6) * 3 + (fr - 13)) * 6144 + c) = w; }
                } }
    }
};
template <class Epi, class Sched, bool ALIGN_EPI = false, bool SP2 = false>
__device__ __forceinline__ void gemm_phase(PG8_LAS unsigned char* lds, const Gemm g, const Sched& S, const Epi& E) {
    int tid_ = threadIdx.x; asm volatile("" : "+v"(tid_));
    const int tid = tid_, wid = __builtin_amdgcn_readfirstlane(tid >> 6), lane = tid & 63, wr = wid >> 2, wc = wid & 3, fr = lane & 15, fq = lane >> 4;
    const int K = g.K, nt = K / BK, lda = g.lda;
    unsigned voffA[2], voffB[2];
#pragma unroll
    for (int i = 0; i < 2; ++i) { int R, C; stage_rc(tid * 16 + i * 8192, R, C); const int Rb = Epi::PERM ? ((R & ~31) + perm32(R & 31)) : R;
        voffA[i] = (unsigned)(R * lda + C) * 2u; voffB[i] = (unsigned)(Rb * K + C) * 2u; }
    const size_t kstep = (size_t)(BK * 2);
    const size_t hA = (size_t)HALF * lda * 2, hB = (size_t)HALF * K * 2;
    const size_t tA = 2 * hA, tB = 2 * hB;
    const unsigned ldsw = (unsigned)wid * 1024u;
    const int aoff = lds_byte(wr * 64 + fr, fq * 8), boff = lds_byte(wc * 32 + fr, fq * 8);
#define PG8_SA(b, h) (((b) * 2 + (h)) * HTB)
#define PG8_SB(b, h) ((4 + (b) * 2 + (h)) * HTB)
#define PG8_STAGE(bufoff, gbase, voff) do { _Pragma("unroll") for (int _i = 0; _i < 2; ++_i) \
        __builtin_amdgcn_global_load_lds((const unsigned*)((const char*)(gbase) + (voff)[_i]), (PG8_LAS unsigned*)(lds + (bufoff) + ldsw + _i * 8192), 16, 0, 0); } while (0)
#define PG8_LDA(dst, b, h) do { _Pragma("unroll") for (int m = 0; m < 4; ++m) _Pragma("unroll") for (int k = 0; k < 2; ++k) dst[m][k] = *(const PG8_LAS bf16x8*)(lds + PG8_SA(b, h) + aoff + m * 2048 + k * 1024); } while (0)
#define PG8_LDB(dst, b, h) do { _Pragma("unroll") for (int n = 0; n < 2; ++n) _Pragma("unroll") for (int k = 0; k < 2; ++k) dst[n][k] = *(const PG8_LAS bf16x8*)(lds + PG8_SB(b, h) + boff + n * 2048 + k * 1024); } while (0)
#define PG8_MMA(ai, bj, At, Bt) do { __builtin_amdgcn_s_setprio(1); _Pragma("unroll") for (int m = 0; m < 4; ++m) _Pragma("unroll") for (int n = 0; n < 2; ++n) _Pragma("unroll") for (int k = 0; k < 2; ++k) \
        acc[ai][bj][m][n] = __builtin_amdgcn_mfma_f32_16x16x32_bf16(Bt[n][k], At[m][k], acc[ai][bj][m][n], 0, 0, 0); __builtin_amdgcn_s_setprio(0); } while (0)
#define PG8_WAIT_V(n) asm volatile("s_waitcnt vmcnt(" #n ")" ::: "memory")
#define PG8_WAIT_L(n) asm volatile("s_waitcnt lgkmcnt(" #n ")" ::: "memory")
#define PG8_BAR __builtin_amdgcn_s_barrier()
#define PG8_SCHED __builtin_amdgcn_sched_barrier(0)
    Unit cur, nxt; int ui = 0;
    if (!S.next(0, cur)) return;
    f32x4 acc[2][2][4][2];
#pragma unroll
    for (int a = 0; a < 2; ++a)
#pragma unroll
        for (int b = 0; b < 2; ++b)
#pragma unroll
            for (int m = 0; m < 4; ++m)
#pragma unroll
                for (int n = 0; n < 2; ++n) acc[a][b][m][n] = (f32x4){0.f, 0.f, 0.f, 0.f};
    bf16x8 At[4][2], B0[2][2], B1[2][2];
    const char* cA = (const char*)g.A + (size_t)cur.pm * tA; const char* cB = (const char*)g.Bt + (size_t)cur.pn * tB;
    S.a_ready(cur);
    if constexpr (SP2) {
        PG8_STAGE(PG8_SB(0, 0), cB, voffB); PG8_STAGE(PG8_SB(0, 1), cB + hB, voffB); PG8_STAGE(PG8_SA(0, 0), cA, voffA); PG8_STAGE(PG8_SA(0, 1), cA + hA, voffA);
        if (wr == 1) PG8_BAR;
        PG8_WAIT_V(2); PG8_BAR;
        PG8_STAGE(PG8_SB(1, 0), cB + kstep, voffB); PG8_STAGE(PG8_SA(1, 0), cA + kstep, voffA); PG8_STAGE(PG8_SB(1, 1), cB + hB + kstep, voffB);
        PG8_WAIT_V(6); PG8_BAR;
    } else {
        PG8_STAGE(PG8_SB(0, 0), cB, voffB); PG8_STAGE(PG8_SA(0, 0), cA, voffA); PG8_STAGE(PG8_SB(0, 1), cB + hB, voffB); PG8_STAGE(PG8_SA(0, 1), cA + hA, voffA);
        if (wr == 1) PG8_BAR;
        PG8_WAIT_V(4); PG8_BAR;
        PG8_STAGE(PG8_SB(1, 0), cB + kstep, voffB); PG8_STAGE(PG8_SA(1, 0), cA + kstep, voffA); PG8_STAGE(PG8_SB(1, 1), cB + hB + kstep, voffB);
        PG8_WAIT_V(6); PG8_BAR;
    }
    for (;;) {
        const bool has_next = S.next(ui + 1, nxt);
        const char* nA = has_next ? (const char*)g.A + (size_t)nxt.pm * tA : cA; const char* nB = has_next ? (const char*)g.Bt + (size_t)nxt.pn * tB : cB;
        for (int t = 0; t < nt; t += 2) {
            const bool last = (t == nt - 2);
            const char* a1 = cA + (size_t)(t + 1) * kstep;
            const char* a2 = last ? nA : cA + (size_t)(t + 2) * kstep; const char* b2 = last ? nB : cB + (size_t)(t + 2) * kstep;
            const char* a3 = a2 + kstep; const char* b3 = b2 + kstep;
            if (last && has_next) S.a_ready(nxt);
            if constexpr (SP2) {
            PG8_LDB(B0, 0, 0); PG8_LDB(B1, 0, 1); PG8_SCHED; PG8_LDA(At, 0, 0); PG8_STAGE(PG8_SA(1, 1), a1 + hA, voffA);
            PG8_WAIT_V(8); PG8_WAIT_L(0); PG8_BAR; PG8_MMA(0, 0, At, B0); PG8_MMA(0, 1, At, B1); PG8_BAR; PG8_SCHED;
            PG8_LDA(At, 0, 1); PG8_STAGE(PG8_SB(0, 0), b2, voffB); PG8_STAGE(PG8_SB(0, 1), b2 + hB, voffB); PG8_STAGE(PG8_SA(0, 0), a2, voffA);
            PG8_WAIT_V(8); PG8_WAIT_L(0); PG8_BAR; PG8_MMA(1, 0, At, B0); PG8_MMA(1, 1, At, B1); PG8_BAR; PG8_SCHED;
            PG8_LDB(B0, 1, 0); PG8_LDB(B1, 1, 1); PG8_SCHED; PG8_LDA(At, 1, 0); PG8_STAGE(PG8_SA(0, 1), a2 + hA, voffA);
            PG8_WAIT_V(8); PG8_WAIT_L(0); PG8_BAR; PG8_MMA(0, 0, At, B0); PG8_MMA(0, 1, At, B1); PG8_BAR; PG8_SCHED;
            PG8_LDA(At, 1, 1); PG8_STAGE(PG8_SB(1, 0), b3, voffB); PG8_STAGE(PG8_SB(1, 1), b3 + hB, voffB); PG8_STAGE(PG8_SA(1, 0), a3, voffA);
            PG8_WAIT_V(8); PG8_WAIT_L(0); PG8_BAR; PG8_MMA(1, 0, At, B0); PG8_MMA(1, 1, At, B1); PG8_BAR; PG8_SCHED;
            } else {
            PG8_LDB(B0, 0, 0); PG8_SCHED; PG8_LDA(At, 0, 0); PG8_STAGE(PG8_SA(1, 1), a1 + hA, voffA);
            PG8_WAIT_L(8); PG8_BAR; PG8_WAIT_L(0); PG8_MMA(0, 0, At, B0); PG8_BAR; PG8_SCHED;
            PG8_LDB(B1, 0, 1); PG8_STAGE(PG8_SB(0, 0), b2, voffB);
            PG8_BAR; PG8_WAIT_L(0); PG8_MMA(0, 1, At, B1); PG8_BAR;
            PG8_LDA(At, 0, 1); PG8_STAGE(PG8_SA(0, 0), a2, voffA);
            PG8_BAR; PG8_WAIT_L(0); PG8_MMA(1, 0, At, B0); PG8_BAR; PG8_SCHED;
            PG8_STAGE(PG8_SB(0, 1), b2 + hB, voffB);
            PG8_WAIT_V(6); PG8_BAR; PG8_MMA(1, 1, At, B1); PG8_BAR;
            PG8_LDB(B0, 1, 0); PG8_SCHED; PG8_LDA(At, 1, 0); PG8_STAGE(PG8_SA(0, 1), a2 + hA, voffA);
            PG8_WAIT_L(8); PG8_BAR; PG8_WAIT_L(0); PG8_MMA(0, 0, At, B0); PG8_BAR; PG8_SCHED;
            PG8_LDB(B1, 1, 1); PG8_STAGE(PG8_SB(1, 0), b3, voffB);
            PG8_BAR; PG8_WAIT_L(0); PG8_MMA(0, 1, At, B1); PG8_BAR;
            PG8_LDA(At, 1, 1); PG8_STAGE(PG8_SA(1, 0), a3, voffA);
            PG8_BAR; PG8_WAIT_L(0); PG8_MMA(1, 0, At, B0); PG8_BAR; PG8_SCHED;
            PG8_STAGE(PG8_SB(1, 1), b3 + hB, voffB);
            PG8_WAIT_V(6); PG8_BAR; PG8_MMA(1, 1, At, B1); PG8_BAR;
            }
        }
        if constexpr (ALIGN_EPI) { if (wr == 0) PG8_BAR; }
        if constexpr (!Epi::AFTER_DRAIN) { E(acc, cur, wr, wc, fr, fq); S.done(cur); }
        if (!has_next) break;
#pragma unroll
        for (int a = 0; a < 2; ++a)
#pragma unroll
            for (int b = 0; b < 2; ++b)
#pragma unroll
                for (int m = 0; m < 4; ++m)
#pragma unroll
                    for (int n = 0; n < 2; ++n) acc[a][b][m][n] = (f32x4){0.f, 0.f, 0.f, 0.f};
        cur = nxt; cA = nA; cB = nB; ++ui;
        if constexpr (ALIGN_EPI) { if (wr == 1) PG8_BAR; }
    }
    PG8_WAIT_V(0);
    if constexpr (!ALIGN_EPI) { if (wr == 0) PG8_BAR; }
    PG8_BAR;
#undef PG8_SA
#undef PG8_SB
#undef PG8_STAGE
#undef PG8_LDA
#undef PG8_LDB
#undef PG8_MMA
#undef PG8_WAIT_V
#undef PG8_WAIT_L
#undef PG8_BAR
#undef PG8_SCHED
}
}
#ifndef ATTN_PRIO
#define ATTN_PRIO 0
#endif
namespace dattn {
using bf16=__hip_bfloat16;
using bf16x8=__attribute__((ext_vector_type(8)))short;
using s16x4=__attribute__((ext_vector_type(4)))short;
using f32x16=__attribute__((ext_vector_type(16)))float;
using u32x4=__attribute__((ext_vector_type(4)))unsigned;
constexpr int SEQ=4096,DM=2048,HDV=128;
constexpr int NW=8,QBLK=32,QB=128,KVBLK=64,NQB=SEQ/QB;
__device__ __forceinline__ int crow(int r,int hi){return (r&3)+8*(r>>2)+4*hi;}
#define SBAR() __builtin_amdgcn_sched_barrier(0)
__device__ __forceinline__ void cmask(f32x16&p0,f32x16&p1,int jb,int qrel,int hi){
  const float NEG=-INFINITY; int kb=64*jb+4*hi;
  #pragma unroll
  for(int r=0;r<16;++r){int kv=kb+(r&3)+8*(r>>2); if(kv>qrel)p0[r]=NEG; if(kv+32>qrel)p1[r]=NEG;}
}
constexpr float C2=0.125f*1.4426950408889634f;
constexpr int NSLOT=3, SLOTB=16384;
constexpr int LDS_K=0, LDS_V=NSLOT*SLOTB, LDS_WS=2*NSLOT*SLOTB, LDS_BYTES=LDS_WS+NW*64*4;
__device__ __forceinline__ void glds16(const void*gsrc,unsigned lds_dst){unsigned keep;
  asm volatile("s_mov_b32 %0, m0\n\ts_mov_b32 m0, %2\n\ts_nop 0\n\tglobal_load_lds_dwordx4 %1, off\n\ts_mov_b32 m0, %0":"=&s"(keep):"v"(gsrc),"s"(lds_dst):"memory");}
__device__ __forceinline__ float max3f(float a,float b,float c){float r;asm("v_max3_f32 %0, %1, %2, %3":"=v"(r):"v"(a),"v"(b),"v"(c));return r;}
__device__ __forceinline__ float max2f(float a,float b){float r;asm("v_max_f32_e32 %0, %1, %2":"=v"(r):"v"(a),"v"(b));return r;}
__device__ __forceinline__ float fadd_s(float a,float b){float r;asm("v_add_f32_e32 %0, %1, %2":"=v"(r):"v"(a),"v"(b));return r;}
__device__ __forceinline__ float fsub_s(float a,float b){float r;asm("v_sub_f32_e32 %0, %1, %2":"=v"(r):"v"(a),"v"(b));return r;}
typedef float f32x2_t __attribute__((ext_vector_type(2))); typedef __bf16 bf16x2_t __attribute__((ext_vector_type(2)));
__device__ __forceinline__ unsigned cvtpk_s(float lo,float hi){f32x2_t v={lo,hi};bf16x2_t b=__builtin_convertvector(v,bf16x2_t);return __builtin_bit_cast(unsigned,b);}
#define WAIT_BAR(N) asm volatile("s_waitcnt vmcnt(" #N ") lgkmcnt(0)\n\ts_barrier":::"memory")
typedef __attribute__((address_space(3))) const char* lds_cptr;
typedef short v4i16_t __attribute__((ext_vector_type(4)));
__device__ __forceinline__ void qkt(f32x16&p0,f32x16&p1,const char*kb,const bf16x8*qr){ const f32x16 negm=f32x16{};
  #pragma unroll
  for(int d0=0;d0<4;++d0){
    const bf16x8 b0=*reinterpret_cast<const bf16x8*>(kb+d0*2048);
    const bf16x8 b1=*reinterpret_cast<const bf16x8*>(kb+d0*2048+512);
    if(d0==0){p0=__builtin_amdgcn_mfma_f32_32x32x16_bf16(b0,qr[0],negm,0,0,0);p1=__builtin_amdgcn_mfma_f32_32x32x16_bf16(b1,qr[0],negm,0,0,0);}
    else{p0=__builtin_amdgcn_mfma_f32_32x32x16_bf16(b0,qr[d0],p0,0,0,0);p1=__builtin_amdgcn_mfma_f32_32x32x16_bf16(b1,qr[d0],p1,0,0,0);}}
}
__device__ __forceinline__ void kload8(bf16x8*kf,lds_cptr kp){
  kf[0]=*(const __attribute__((address_space(3))) bf16x8*)(kp);      kf[1]=*(const __attribute__((address_space(3))) bf16x8*)(kp+512);
  kf[2]=*(const __attribute__((address_space(3))) bf16x8*)(kp+2048); kf[3]=*(const __attribute__((address_space(3))) bf16x8*)(kp+2560);
  kf[4]=*(const __attribute__((address_space(3))) bf16x8*)(kp+4096); kf[5]=*(const __attribute__((address_space(3))) bf16x8*)(kp+4608);
  kf[6]=*(const __attribute__((address_space(3))) bf16x8*)(kp+6144); kf[7]=*(const __attribute__((address_space(3))) bf16x8*)(kp+6656);
}
__device__ __forceinline__ void kload2(bf16x8*kf,lds_cptr kp,int j){ kf[2*j]=*(const __attribute__((address_space(3))) bf16x8*)(kp+j*2048); kf[2*j+1]=*(const __attribute__((address_space(3))) bf16x8*)(kp+j*2048+512); }
__device__ __forceinline__ s16x4 vtr(lds_cptr p){ return __builtin_bit_cast(s16x4,__builtin_amdgcn_ds_read_tr16_b64_v4i16((__attribute__((address_space(3))) v4i16_t*)p)); }
__device__ __forceinline__ float rowmax(const f32x16&p0,const f32x16&p1){
  float a=max3f(p0[0],p0[1],p1[0]),b=max3f(p0[2],p0[3],p1[1]);a=max3f(a,p1[2],p1[3]);
  #pragma unroll
  for(int r=4;r<16;r+=4){a=max3f(a,p0[r],p0[r+1]);b=max3f(b,p0[r+2],p0[r+3]);a=max3f(a,p1[r],p1[r+1]);b=max3f(b,p1[r+2],p1[r+3]);}
  const float m=max2f(a,b);
  auto rr=__builtin_amdgcn_permlane32_swap(__float_as_uint(m),__float_as_uint(m),false,false);
  return max2f(__uint_as_float(rr[0]),__uint_as_float(rr[1]));
}
__device__ __forceinline__ void pv(f32x16*o,int vb,bf16x8 pa0,bf16x8 pa1,bf16x8 pa2,bf16x8 pa3){
  #pragma unroll
  for(int d0=0;d0<4;++d0){s16x4 lo[4],hi[4];
    #pragma unroll
    for(int ks=0;ks<4;++ks){
      asm volatile("ds_read_b64_tr_b16 %0,%1 offset:%c2":"=&v"(lo[ks]):"v"(vb),"i"(d0*4096+ks*1024):"memory");
      asm volatile("ds_read_b64_tr_b16 %0,%1 offset:%c2":"=&v"(hi[ks]):"v"(vb),"i"(d0*4096+ks*1024+512):"memory");}
    asm volatile("s_waitcnt lgkmcnt(0)":::"memory");SBAR();
    #define PK(k) (bf16x8){lo[k][0],lo[k][1],lo[k][2],lo[k][3],hi[k][0],hi[k][1],hi[k][2],hi[k][3]}
    o[d0]=__builtin_amdgcn_mfma_f32_32x32x16_bf16(pa0,PK(0),o[d0],0,0,0);
    o[d0]=__builtin_amdgcn_mfma_f32_32x32x16_bf16(pa1,PK(1),o[d0],0,0,0);
    o[d0]=__builtin_amdgcn_mfma_f32_32x32x16_bf16(pa2,PK(2),o[d0],0,0,0);
    o[d0]=__builtin_amdgcn_mfma_f32_32x32x16_bf16(pa3,PK(3),o[d0],0,0,0);
    #undef PK
  }
}

struct Params { const bf16* Q; const bf16* K; const bf16* V; bf16* O; const float* subln_w; float lam, post; };
template<int THRL> __device__ __forceinline__ void unit(int b,int h,int qb,const Params&P,char*shm){
  int tid_=threadIdx.x; asm volatile("":"+v"(tid_));
  const int tid=tid_,lane=tid&63,r32=lane&31,hi=lane>>5; const int wid=__builtin_amdgcn_readfirstlane(tid>>6);
  const int cmp=wid&1,rbk=wid>>1;
  if(ATTN_PRIO&&wid>=4)__builtin_amdgcn_s_setprio(1);
  const long rowbase=(long)b*SEQ; const int q0=qb*QB;
  const bf16*Qw=P.Q+(rowbase+q0+rbk*QBLK)*DM+h*HDV+cmp*64;
  const bf16*Kh=P.K+rowbase*DM+h*HDV,*Vh=P.V+rowbase*DM+h*HDV;
  const unsigned lds0=(unsigned)(uintptr_t)shm;
  float*wsf=(float*)(shm+LDS_WS)+wid*64;
  const bf16*ksrc=Kh+(long)lane*DM+wid*8;
  const bf16*vsrc=Vh+(long)(16*(wid&3)+(lane>>2))*DM+(wid>>2)*32+(lane&3)*8;
  const unsigned kdst=lds0+LDS_K+wid*1024, vdst=lds0+LDS_V+wid*1024;
  #define DMA_K(t,slot) do{ glds16(ksrc+(long)(t)*KVBLK*DM,(unsigned)__builtin_amdgcn_readfirstlane(kdst+(slot))); glds16(ksrc+(long)(t)*KVBLK*DM+64,(unsigned)__builtin_amdgcn_readfirstlane(kdst+(slot)+8192)); }while(0)
  #define DMA_V(t,slot) do{ glds16(vsrc+(long)(t)*KVBLK*DM,(unsigned)__builtin_amdgcn_readfirstlane(vdst+(slot))); glds16(vsrc+(long)(t)*KVBLK*DM+64,(unsigned)__builtin_amdgcn_readfirstlane(vdst+(slot)+8192)); }while(0)
  const int vb0=(int)(lds0+LDS_V)+((lane>>4)&1)*32+(lane&3)*8+(4*hi+((lane&15)>>2))*64;
  bf16x8 kf[8];
  const lds_cptr shm3=(lds_cptr)shm; const lds_cptr kp0=shm3+LDS_K+(cmp*8+hi)*1024+r32*16; const lds_cptr vp0=shm3+LDS_V+((lane>>4)&1)*32+(lane&3)*8+(4*hi+((lane&15)>>2))*64;
  const char*Kbase=shm+LDS_K+(cmp*8+hi)*1024+r32*16;
  const int NT=(q0+QB)/KVBLK;
  DMA_K(0,0);DMA_V(0,0);DMA_K(1,SLOTB);
  bf16x8 qr[4];
  #pragma unroll
  for(int d0=0;d0<4;++d0)qr[d0]=*(const __attribute__((address_space(1))) bf16x8*)(&Qw[(long)r32*DM+d0*16+hi*8]);
  float mhat=0.f,l_reg=0.f;f32x16 o[4];o[0]=f32x16{};o[1]=f32x16{};o[2]=f32x16{};o[3]=f32x16{};const f32x16 zero16=f32x16{};
  const int qrel=rbk*QBLK+r32;
  #define CMASK(P0,P1,t) do{int jb_=(t)-(NT-2); if(jb_>=0)cmask(P0,P1,jb_,qrel,hi);}while(0)
  bool resc=false;
  #define START(P0,P1) do{ const float rm=rowmax(P0,P1); resc=false; \
    { const float dl=rm; mhat=fadd_s(mhat,dl); \
      _Pragma("unroll") for(int r=0;r<16;++r){P0[r]=fsub_s(P0[r],dl);P1[r]=fsub_s(P1[r],dl);} } \
    _Pragma("unroll") for(int r=0;r<16;++r)P0[r]=__builtin_amdgcn_exp2f(P0[r]); }while(0)
  #define RESC() do{ if(resc){ asm volatile("s_waitcnt lgkmcnt(0)":::"memory"); \
      _Pragma("unroll") for(int d_=0;d_<4;++d_) _Pragma("unroll") for(int r=0;r<16;++r)o[d_][r]*=wsf[crow(r,hi)]; } }while(0)
  f32x16 pA0,pA1,pB0,pB1;
  int sl_prev=0,sl_cur=0,sl_next=SLOTB;
  #define ROT() do{sl_prev=sl_cur;sl_cur=sl_next;sl_next=(sl_next==(NSLOT-1)*SLOTB)?0:sl_next+SLOTB;}while(0)
  DMA_K(2,2*SLOTB);
  WAIT_BAR(6);
  qkt(pA0,pA1,Kbase,qr);asm volatile("s_nop 15\n\ts_nop 7":"+v"(pA0),"+v"(pA1));CMASK(pA0,pA1,0);
  START(pA0,pA1);
  _Pragma("unroll") for(int r=0;r<16;++r)pA1[r]=__builtin_amdgcn_exp2f(pA1[r]);
  WAIT_BAR(0);
  DMA_K(3,0);DMA_V(1,SLOTB);
  ROT();
  kload8(kf,kp0+sl_cur);
  if(NT>2){WAIT_BAR(4);}else{WAIT_BAR(0);}
  s16x4 vlo[4],vhi[4]; u32x4 pw0,pw1,pw2,pw3;
  #define PKW(P,B) cvtpk_s(P[B],P[B+1])
  #define PAF(k) __builtin_bit_cast(bf16x8,pw##k)
  #define VFR(i) (bf16x8){vlo[i][0],vlo[i][1],vlo[i][2],vlo[i][3],vhi[i][0],vhi[i][1],vhi[i][2],vhi[i][3]}
  #define PIN(x) asm volatile("":"+v"(x))
  #define MX3(a,b,c) __builtin_fmaxf(__builtin_fmaxf((a),(b)),(c))
  #define GAPA(MF,A0,A1,A2,A3,W0,W1,PW) do{ MF; sacc+=A0; sacc+=A1; sacc+=A2; sacc+=A3; PIN(sacc); W0; W1; PIN(PW); SBAR(); }while(0)
  #define EX(v) __builtin_amdgcn_exp2f((v)-mhat)
  #define VOFF(f) ((((f)&3)*4096)+(((f)>>2)*1024))
  #define VRD(i,f) do{ vlo[i]=vtr(vp_+VOFF(f)); vhi[i]=vtr(vp_+VOFF(f)+512); }while(0)
  #define GAPB(MF,X,B) do{ MF; X[B]=EX(X[B]); X[B+1]=EX(X[B+1]); PIN(X); SBAR(); }while(0)
  #define GAPBV(MF,X,B,i,f) do{ MF; X[B]=EX(X[B]); X[B+1]=EX(X[B+1]); PIN(X); VRD(i,f); SBAR(); }while(0)
  #define KRD(G,j) do{ if(G){ kload2(kf,kp0+sl_next,j); SBAR(); } }while(0)
  #define PVM(d,k,i) o[d]=__builtin_amdgcn_mfma_f32_32x32x16_bf16(PAF(k),VFR(i),o[d],0,0,0)
  #define STEP(C0,C1,P0,P1,t,GK,GV,GL) do{ SBAR(); \
    const lds_cptr vp_=vp0+sl_prev; \
    float sacc=(P0[0]+P0[1]); \
    GAPA(C0=__builtin_amdgcn_mfma_f32_32x32x16_bf16(kf[0],qr[0],zero16,0,0,0), P0[2],P0[3],P0[4],P0[5],     pw0[0]=PKW(P0,0), pw0[1]=PKW(P0,2), pw0); \
    GAPA(C1=__builtin_amdgcn_mfma_f32_32x32x16_bf16(kf[1],qr[0],zero16,0,0,0), P0[6],P0[7],P0[8],P0[9],     pw0[2]=PKW(P0,4), pw0[3]=PKW(P0,6), pw0); \
    GAPA(C0=__builtin_amdgcn_mfma_f32_32x32x16_bf16(kf[2],qr[1],C0,0,0,0),   P0[10],P0[11],P0[12],P0[13], pw1[0]=PKW(P0,8), pw1[1]=PKW(P0,10), pw1); \
    GAPA(C1=__builtin_amdgcn_mfma_f32_32x32x16_bf16(kf[3],qr[1],C1,0,0,0),   P0[14],P0[15],P1[0],P1[1],   pw1[2]=PKW(P0,12),pw1[3]=PKW(P0,14), pw1); \
    VRD(0,0); SBAR(); GAPA(C0=__builtin_amdgcn_mfma_f32_32x32x16_bf16(kf[4],qr[2],C0,0,0,0),   P1[2],P1[3],P1[4],P1[5],     pw2[0]=PKW(P1,0), pw2[1]=PKW(P1,2), pw2); \
    VRD(1,1); SBAR(); GAPA(C1=__builtin_amdgcn_mfma_f32_32x32x16_bf16(kf[5],qr[2],C1,0,0,0),   P1[6],P1[7],P1[8],P1[9],     pw2[2]=PKW(P1,4), pw2[3]=PKW(P1,6), pw2); \
    VRD(2,2); SBAR(); GAPA(C0=__builtin_amdgcn_mfma_f32_32x32x16_bf16(kf[6],qr[3],C0,0,0,0),   P1[10],P1[11],P1[12],P1[13], pw3[0]=PKW(P1,8), pw3[1]=PKW(P1,10), pw3); \
    VRD(3,3); SBAR(); GAPA(C1=__builtin_amdgcn_mfma_f32_32x32x16_bf16(kf[7],qr[3],C1,0,0,0),   P1[14],P1[15],0.f,0.f,       pw3[2]=PKW(P1,12),pw3[3]=PKW(P1,14), pw3); \
    l_reg+=sacc; \
    if(GK){DMA_K((t)+3,sl_cur);} if(GV){DMA_V((t)+1,sl_next);} \
    CMASK(C0,C1,t); \
    { float a=MX3(C0[0],C0[1],C1[0]),b=MX3(C0[2],C0[3],C1[1]); a=MX3(a,C1[2],C1[3]); \
      _Pragma("unroll") for(int r=4;r<16;r+=4){a=MX3(a,C0[r],C0[r+1]);b=MX3(b,C0[r+2],C0[r+3]);a=MX3(a,C1[r],C1[r+1]);b=MX3(b,C1[r+2],C1[r+3]);} \
      float rm=__builtin_fmaxf(a,b); { auto rr=__builtin_amdgcn_permlane32_swap(__float_as_uint(rm),__float_as_uint(rm),false,false); rm=__builtin_fmaxf(__uint_as_float(rr[0]),__uint_as_float(rr[1])); } \
      rm-=mhat; resc=false; \
      if(__builtin_expect(__any(rm>(float)THRL),0)){ const float dl=__builtin_fmaxf(rm,0.f); mhat+=dl; \
        const float f=__builtin_amdgcn_exp2f(-dl); l_reg*=f; if(hi==0)wsf[r32]=f; resc=true; } } \
    SBAR(); \
    GAPBV(PVM(0,0,0),C0,0, 0,4);  GAPBV(PVM(1,0,1),C0,2, 1,5);  GAPBV(PVM(2,0,2),C0,4, 2,6);  GAPBV(PVM(3,0,3),C0,6, 3,7); \
    GAPBV(PVM(0,1,0),C0,8, 0,8);  GAPBV(PVM(1,1,1),C0,10,1,9);  GAPBV(PVM(2,1,2),C0,12,2,10); GAPBV(PVM(3,1,3),C0,14,3,11); \
    KRD(GL,0); GAPBV(PVM(0,2,0),C1,0, 0,12); KRD(GL,1); GAPBV(PVM(1,2,1),C1,2, 1,13); KRD(GL,2); GAPBV(PVM(2,2,2),C1,4, 2,14); KRD(GL,3); GAPBV(PVM(3,2,3),C1,6, 3,15); \
    GAPB(PVM(0,3,0),C1,8); GAPB(PVM(1,3,1),C1,10); GAPB(PVM(2,3,2),C1,12); GAPB(PVM(3,3,3),C1,14); \
    }while(0)
  int t=1;
  #undef CMASK
  #define CMASK(P0,P1,t) do{}while(0)
  for(;t+3<NT;t+=2){
    STEP(pB0,pB1,pA0,pA1,t,true,true,true);     WAIT_BAR(4); RESC(); ROT();
    STEP(pA0,pA1,pB0,pB1,t+1,true,true,true);   WAIT_BAR(4); RESC(); ROT();
  }
  #undef CMASK
  #define CMASK(P0,P1,t) do{int jb_=(t)-(NT-2); if(jb_>=0)cmask(P0,P1,jb_,qrel,hi);}while(0)
  #define ENDW(tt) do{ if((tt)+3<NT){WAIT_BAR(4);} else if((tt)+2<NT){WAIT_BAR(2);} else {WAIT_BAR(0);} }while(0)
  for(;t+1<NT;t+=2){
    STEP(pB0,pB1,pA0,pA1,t,(t+3<NT),(t+1<NT),(t+1<NT));       ENDW(t);   RESC(); ROT();
    STEP(pA0,pA1,pB0,pB1,t+1,(t+4<NT),(t+2<NT),(t+2<NT));     ENDW(t+1); RESC(); ROT();
  }
  STEP(pB0,pB1,pA0,pA1,NT-1,false,false,false); RESC();
  { float sacc=pB0[0]+pB0[1]; _Pragma("unroll") for(int r=2;r<16;++r)sacc+=pB0[r]; _Pragma("unroll") for(int r=0;r<16;++r)sacc+=pB1[r]; l_reg+=sacc;
    pw0=(u32x4){PKW(pB0,0),PKW(pB0,2),PKW(pB0,4),PKW(pB0,6)};pw1=(u32x4){PKW(pB0,8),PKW(pB0,10),PKW(pB0,12),PKW(pB0,14)};pw2=(u32x4){PKW(pB1,0),PKW(pB1,2),PKW(pB1,4),PKW(pB1,6)};pw3=(u32x4){PKW(pB1,8),PKW(pB1,10),PKW(pB1,12),PKW(pB1,14)};
    SBAR(); pv(o,vb0+sl_cur,PAF(0),PAF(1),PAF(2),PAF(3)); }
  #undef PKW
  #undef PAF
  #undef VFR
  #undef PIN
  #undef MX3
  #undef GAPA
  #undef GAPB
  #undef GAPBV
  #undef EX
  #undef VOFF
  #undef VRD
  #undef KRD
  #undef PVM
  #undef STEP
  #undef ENDW
  {auto rr=__builtin_amdgcn_permlane32_swap(__float_as_uint(l_reg),__float_as_uint(l_reg),false,false);l_reg=__uint_as_float(rr[0])+__uint_as_float(rr[1]);}
  if(hi==0)wsf[32+r32]=l_reg;asm volatile("s_waitcnt lgkmcnt(0)":::"memory");
  float rli[16];
  #pragma unroll
  for(int r=0;r<16;++r)rli[r]=__builtin_amdgcn_rcpf(wsf[32+crow(r,hi)]);
  asm volatile("s_waitcnt lgkmcnt(0)\n\ts_barrier":::"memory");
  { bf16*stg=(bf16*)(shm)+wid*4096;
    #pragma unroll
    for(int r=0;r<16;++r){const int orow=crow(r,hi);
      #pragma unroll
      for(int d0=0;d0<4;++d0)stg[orow*128+d0*32+r32]=__float2bfloat16(o[d0][r]*rli[r]);} }
  asm volatile("s_waitcnt lgkmcnt(0)\n\ts_barrier":::"memory");
  { const bf16*s0=(const bf16*)(shm)+(wid&~1)*4096; const bf16*s1=s0+4096;
    bf16*Ow=P.O+(rowbase+q0+rbk*QBLK)*DM+h*HDV; const int ch=lane&15;
    typedef float f32x4_t __attribute__((ext_vector_type(4)));
    const f32x4_t wa=*(const __attribute__((address_space(1))) f32x4_t*)(P.subln_w+ch*8), wb=*(const __attribute__((address_space(1))) f32x4_t*)(P.subln_w+ch*8+4);
    #pragma unroll
    for(int i=0;i<4;++i){ const int row=16*cmp+4*i+(lane>>4);
      const u32x4 a=*(const u32x4*)(s0+row*128+ch*8), bq=*(const u32x4*)(s1+row*128+ch*8);
      float d[8];
      #pragma unroll
      for(int k=0;k<4;++k){ const unsigned ua=a[k],ub=bq[k];
        d[2*k]=__uint_as_float(ua<<16)-P.lam*__uint_as_float(ub<<16); d[2*k+1]=__uint_as_float(ua&0xffff0000u)-P.lam*__uint_as_float(ub&0xffff0000u); }
      float s=0.f;
      #pragma unroll
      for(int k=0;k<8;++k)s+=d[k]*d[k];
      s+=__shfl_xor(s,1);s+=__shfl_xor(s,2);s+=__shfl_xor(s,4);s+=__shfl_xor(s,8);
      const float rs=P.post*__builtin_amdgcn_rsqf(s*(1.f/128.f)+1e-5f);
      u32x4 w; w[0]=cvtpk_s(d[0]*rs*wa[0],d[1]*rs*wa[1]); w[1]=cvtpk_s(d[2]*rs*wa[2],d[3]*rs*wa[3]); w[2]=cvtpk_s(d[4]*rs*wb[0],d[5]*rs*wb[1]); w[3]=cvtpk_s(d[6]*rs*wb[2],d[7]*rs*wb[3]);
      *(__attribute__((address_space(1))) u32x4*)(Ow+(long)row*DM+ch*8)=w; } }
  asm volatile("s_waitcnt lgkmcnt(0)\n\ts_barrier":::"memory");
  if(ATTN_PRIO&&wid>=4)__builtin_amdgcn_s_setprio(0);
  #undef DMA_K
  #undef DMA_V
  #undef CMASK
  #undef START
  #undef RESC
  #undef ROT
}
constexpr int ATTN_LDS_BYTES=LDS_BYTES;
template<int THRL=8> __device__ __forceinline__ void phase(char*lds,const Params&P,int grid,int block){
  const int vcu=(grid%8==0)?(block%8)*(grid/8)+block/8:block;
  for(int v=vcu;v<256;v+=grid){ const int bh=v>>1,p=v&1;
    for(int i=0;i<16;++i){ const int s=2*(i>>1)+p; const int qb=(i&1)?31-s:s; unit<THRL>(bh>>4,bh&15,qb,P,lds); } }
}
#undef SBAR
#undef WAIT_BAR
}
constexpr int NWAVES = 8;
#ifndef MK_PER_PHASE
#define MK_PER_PHASE 0
#endif

constexpr int BATCH = 8, SEQ = 4096, DMODEL = 2048, MROWS = BATCH * SEQ, DFF = 8192, NHEADS = 16, HD = 128;
constexpr int GDN_PROJ = 8224, GDN_MAIN = 8192, CONVC = 6144, NCG = MROWS / 64;
constexpr float ALPHA_RES = 1.6817928305074292f;
constexpr float LN_EPS = 1e-5f, GDN_EPS = 1e-6f, SUBLN_EPS = 1e-5f;
constexpr int N_PHASES = 39;

constexpr size_t MiB = 1u << 20;
constexpr size_t WS_CTL = 0, CTL_ZERO_BYTES = 1 * MiB;
constexpr size_t WS_ONES = 1 * MiB, WS_ZEROS = WS_ONES + 8192, WS_MU = WS_ONES + 65536, WS_RSTD = WS_MU + 131072;
constexpr size_t WS_BETA = 2 * MiB, WS_G = 4 * MiB;
constexpr size_t WS_HALO = 9 * MiB;
constexpr size_t WS_WA = 27 * MiB, WS_WB = 60 * MiB;
constexpr size_t WS_ATTN = 27 * MiB;
constexpr size_t WS_XB = 92 * MiB;
constexpr size_t WS_Y = 220 * MiB;
constexpr size_t WS_R1 = 476 * MiB;
constexpr size_t WS_END = 988 * MiB;
constexpr size_t QTR = 128 * MiB;
constexpr int CW_TMO = 0;
constexpr int CW_BAR = 4096;

constexpr int RING_OFF = 0, RING_BYTES = 131072;
constexpr int LDSCTL_OFF = RING_BYTES, MISC_OFF = LDSCTL_OFF + 320;
constexpr int LDS_BYTES = 147456;
static_assert(MISC_OFF + 128 <= LDS_BYTES, "LDS map");

#define GAS __attribute__((address_space(1)))
#define LAS __attribute__((address_space(3)))
typedef unsigned short bf16;
typedef unsigned v4u __attribute__((ext_vector_type(4)));
typedef unsigned v2u __attribute__((ext_vector_type(2)));
typedef float f32x4 __attribute__((ext_vector_type(4)));
typedef float f32x16 __attribute__((ext_vector_type(16)));
typedef short bf16x8 __attribute__((ext_vector_type(8)));
typedef GAS unsigned gu32;
typedef GAS unsigned long long gu64;
#define RLX_AGENT __ATOMIC_RELAXED, __HIP_MEMORY_SCOPE_AGENT
#define LDS_WAIT() asm volatile("s_waitcnt lgkmcnt(0)" ::: "memory")
#define VM_WAIT() asm volatile("s_waitcnt vmcnt(0)" ::: "memory")
#define WG_BAR() asm volatile("s_waitcnt lgkmcnt(0)\n\ts_barrier" ::: "memory")
typedef float f32x2_t_ __attribute__((ext_vector_type(2))); typedef __bf16 bf16x2_t_ __attribute__((ext_vector_type(2)));
__device__ __forceinline__ unsigned pk2(float lo, float hi) { f32x2_t_ v = {lo, hi}; bf16x2_t_ b = __builtin_convertvector(v, bf16x2_t_); return __builtin_bit_cast(unsigned, b); }
__device__ __forceinline__ unsigned f2bf(float f) { return pk2(f, 0.f) & 0xffffu; }
__device__ __forceinline__ float bflo(unsigned w) { return __builtin_bit_cast(float, w << 16); }
__device__ __forceinline__ float bfhi(unsigned w) { return __builtin_bit_cast(float, w & 0xffff0000u); }
__device__ __forceinline__ float bf2f(bf16 h) { return __builtin_bit_cast(float, (unsigned)h << 16); }
__device__ __forceinline__ float fast_exp(float x) { return __builtin_amdgcn_exp2f(x * 1.4426950408889634f); }
__device__ __forceinline__ float silu_f(float x) { return x * __builtin_amdgcn_rcpf(1.f + __expf(-x)); }

#define XB_TMO      128
#define XB_XCNT(j)  (256  + 64 * (j))
#define XB_XSUB(j)  (1280 + 64 * (j))
#define XB_XGEN(j)  (2304 + 64 * (j))
#define XB_TOP      3328
#define XB_TOPGEN   3392
#define XCD_BAR_WORDS 3456
#define XB_SPIN_CAP (1u << 18)

__device__ __forceinline__ unsigned xb_ld(unsigned* p)              { return __hip_atomic_load(p, __ATOMIC_RELAXED, __HIP_MEMORY_SCOPE_AGENT); }
__device__ __forceinline__ unsigned xb_add(unsigned* p, unsigned v) { return __hip_atomic_fetch_add(p, v, __ATOMIC_RELAXED, __HIP_MEMORY_SCOPE_AGENT); }
__device__ __forceinline__ unsigned xb_xcc_id() { return (unsigned)__builtin_amdgcn_s_getreg((3 << 11) | 20) & 0xFu; }
#define XB_SPIN(cond, bar) do { unsigned _sp = 0; while (cond) { __builtin_amdgcn_s_sleep(1); \
    if ((++_sp & 255u) == 0u) { if (xb_ld(&(bar)[XB_TMO])) break; if (_sp > XB_SPIN_CAP) { atomicAdd(&(bar)[XB_TMO], 1u); break; } } } } while (0)

struct XcdBarrier {
    unsigned* bar; unsigned x;
    volatile LAS unsigned* st;
};
__device__ __forceinline__ XcdBarrier xcd_barrier_post(unsigned* bar, volatile LAS unsigned* st) {
    XcdBarrier b; b.bar = bar; b.x = xb_xcc_id(); b.st = st;
    if (threadIdx.x == 0) (void)xb_add(&bar[XB_XCNT(b.x)], 1u);
    return b;
}
__device__ __forceinline__ void xcd_barrier_complete(unsigned* bar, unsigned x, unsigned& nloc, unsigned& nx) {
    const unsigned G = gridDim.x * gridDim.y * gridDim.z;
    unsigned sum, cnt, mine, sp = 0u;
    for (;;) {
        sum = 0u; cnt = 0u; mine = 0u;
#pragma unroll
        for (unsigned j = 0; j < 16; ++j) { const unsigned c = xb_ld(&bar[XB_XCNT(j)]); sum += c; cnt += (c > 0u) ? 1u : 0u; mine = (j == x) ? c : mine; }
        if (sum == G) break;
        __builtin_amdgcn_s_sleep(1);
        if ((++sp & 255u) == 0u) { if (xb_ld(&bar[XB_TMO])) break; if (sp > XB_SPIN_CAP) { atomicAdd(&bar[XB_TMO], 1u); break; } }
    }
    nloc = mine > 0u ? mine : 1u; nx = cnt > 0u ? cnt : 1u;
}
__device__ __forceinline__ void xcd_barrier(const XcdBarrier& b) {
    asm volatile("s_waitcnt vmcnt(0)" ::: "memory");
    __syncthreads();
    if (threadIdx.x == 0) {
        unsigned* bar = b.bar;
        __builtin_amdgcn_s_waitcnt(0);
        unsigned nloc = b.st[0], nx = b.st[1];
        if (nloc == 0u) { xcd_barrier_complete(bar, b.x, nloc, nx); b.st[0] = nloc; b.st[1] = nx; }
        const unsigned old = xb_add(&bar[XB_XSUB(b.x)], 1u);
        const unsigned gen = old / nloc;
        if (old + 1u == (gen + 1u) * nloc) {
            __builtin_amdgcn_fence(__ATOMIC_RELEASE, "agent");
            asm volatile("s_waitcnt vmcnt(0)" ::: "memory");
            const unsigned og = xb_add(&bar[XB_TOP], 1u);
            const unsigned tg = og / nx;
            if (og + 1u == (tg + 1u) * nx) xb_add(&bar[XB_TOPGEN], 1u);
            else XB_SPIN(xb_ld(&bar[XB_TOPGEN]) == tg, bar);
            __builtin_amdgcn_fence(__ATOMIC_ACQUIRE, "agent");
            xb_add(&bar[XB_XGEN(b.x)], 1u);
            asm volatile("s_waitcnt vmcnt(0)" ::: "memory");
        } else {
            XB_SPIN(xb_ld(&bar[XB_XGEN(b.x)]) == gen, bar);
            __builtin_amdgcn_fence(__ATOMIC_ACQUIRE, "agent");
            asm volatile("s_waitcnt vmcnt(0)" ::: "memory");
        }
    }
    __syncthreads();
}

__device__ __forceinline__ float wave_sum(float v) {
#pragma unroll
    for (int o = 1; o < 64; o <<= 1) v += __shfl_xor(v, o);
    return v;
}
__device__ __forceinline__ float sum16(float v) {
    v += __shfl_xor(v, 1); v += __shfl_xor(v, 2); v += __shfl_xor(v, 4); v += __shfl_xor(v, 8); return v;
}
__device__ __forceinline__ void transpose_item(const float* W, int K, int ldw, int n_begin, int nblk, bf16* WT, int row_off, LAS float* scr, int item, int lane) {
    const int kb = item / nblk, nb = item % nblk, k0 = 64 * kb, n0 = 32 * nb;
    float wv[32];
#pragma unroll
    for (int i = 0; i < 32; ++i) wv[i] = ((const GAS float*)W)[(size_t)(k0 + 2 * i + (lane >> 5)) * ldw + n_begin + n0 + (lane & 31)];
#pragma unroll
    for (int i = 0; i < 32; ++i) scr[(2 * i + (lane >> 5)) * 33 + (lane & 31)] = wv[i];
    LDS_WAIT(); asm volatile("" ::: "memory");
    const int c = lane & 7;
#pragma unroll
    for (int j = 0; j < 4; ++j) { const int n = (lane >> 3) + 8 * j; const LAS float* s = scr + (8 * c) * 33 + n;
        v4u o; o.x = pk2(s[0 * 33], s[1 * 33]); o.y = pk2(s[2 * 33], s[3 * 33]); o.z = pk2(s[4 * 33], s[5 * 33]); o.w = pk2(s[6 * 33], s[7 * 33]);
        *(GAS v4u*)(WT + (size_t)(row_off + n0 + n) * K + k0 + 8 * c) = o; }
    LDS_WAIT(); asm volatile("" ::: "memory");
}
__device__ __forceinline__ void convert_w(LAS unsigned char* lds, int gw, int NGW, int wave, int lane, const float* W, int K, int ldw, int n_begin, int ncols, bf16* WT, int row_off) {
    LAS float* scr = (LAS float*)(lds + RING_OFF + wave * 16384);
    const int nblk = ncols / 32, nitems = (K / 64) * nblk;
    for (int it = gw; it < nitems; it += NGW) transpose_item(W, K, ldw, n_begin, nblk, WT, row_off, scr, it, lane);
}
__device__ __forceinline__ void row_to_bf16(const float* xrow, bf16* orow, int lane) {
    const GAS f32x4* xr = (const GAS f32x4*)xrow + lane; GAS v2u* o8 = (GAS v2u*)orow + lane;
#pragma unroll
    for (int j = 0; j < 8; ++j) { const f32x4 v = xr[64 * j]; v2u w; w.x = pk2(v.x, v.y); w.y = pk2(v.z, v.w); o8[64 * j] = w; }
}
__device__ __forceinline__ void ln_pass_b(const bf16* xb_in, const bf16* hb, const float* g, const float* b, bf16* xb_out, float* outf, float alpha, int gw, int NGW, int lane) {
    const GAS f32x4* gr = (const GAS f32x4*)g + 2 * lane; const GAS f32x4* br = (const GAS f32x4*)b + 2 * lane;
    for (int m = gw; m < MROWS; m += 2 * NGW) {
        const int m1 = (m + NGW < MROWS) ? m + NGW : m;
        const GAS v4u* x0 = (const GAS v4u*)(xb_in + (size_t)m * DMODEL) + lane; const GAS v4u* x1 = (const GAS v4u*)(xb_in + (size_t)m1 * DMODEL) + lane;
        const GAS v4u* h0 = (const GAS v4u*)(hb + (size_t)m * DMODEL) + lane;   const GAS v4u* h1 = (const GAS v4u*)(hb + (size_t)m1 * DMODEL) + lane;
        v4u xa[4], xc[4], ha[4], hc[4];
#pragma unroll
        for (int j = 0; j < 4; ++j) { xa[j] = x0[64 * j]; xc[j] = x1[64 * j]; ha[j] = h0[64 * j]; hc[j] = h1[64 * j]; }
        float y0[32], y1[32]; float s0 = 0.f, s1 = 0.f;
#pragma unroll
        for (int j = 0; j < 4; ++j)
#pragma unroll
            for (int k = 0; k < 4; ++k) { y0[8 * j + 2 * k] = alpha * bflo(xa[j][k]) + bflo(ha[j][k]); y0[8 * j + 2 * k + 1] = alpha * bfhi(xa[j][k]) + bfhi(ha[j][k]);
                                          y1[8 * j + 2 * k] = alpha * bflo(xc[j][k]) + bflo(hc[j][k]); y1[8 * j + 2 * k + 1] = alpha * bfhi(xc[j][k]) + bfhi(hc[j][k]); }
#pragma unroll
        for (int k = 0; k < 32; ++k) { s0 += y0[k]; s1 += y1[k]; }
#pragma unroll
        for (int o = 1; o < 64; o <<= 1) { s0 += __shfl_xor(s0, o); s1 += __shfl_xor(s1, o); }
        const float mean0 = s0 * (1.f / DMODEL), mean1 = s1 * (1.f / DMODEL); float q0 = 0.f, q1 = 0.f;
#pragma unroll
        for (int k = 0; k < 32; ++k) { y0[k] -= mean0; y1[k] -= mean1; q0 += y0[k] * y0[k]; q1 += y1[k] * y1[k]; }
#pragma unroll
        for (int o = 1; o < 64; o <<= 1) { q0 += __shfl_xor(q0, o); q1 += __shfl_xor(q1, o); }
        const float rs0 = 1.f / sqrtf(q0 * (1.f / DMODEL) + LN_EPS), rs1 = 1.f / sqrtf(q1 * (1.f / DMODEL) + LN_EPS);
#pragma unroll
        for (int j = 0; j < 4; ++j) { const f32x4 ga = gr[128 * j], gb = gr[128 * j + 1], ba = br[128 * j], bb = br[128 * j + 1];
            float o0[8], o1[8];
#pragma unroll
            for (int k = 0; k < 8; ++k) { const float gg = k < 4 ? ga[k] : gb[k - 4], bv = k < 4 ? ba[k] : bb[k - 4]; o0[k] = y0[8 * j + k] * rs0 * gg + bv; o1[k] = y1[8 * j + k] * rs1 * gg + bv; }
            if (xb_out) { v4u w0, w1; w0.x = pk2(o0[0], o0[1]); w0.y = pk2(o0[2], o0[3]); w0.z = pk2(o0[4], o0[5]); w0.w = pk2(o0[6], o0[7]); w1.x = pk2(o1[0], o1[1]); w1.y = pk2(o1[2], o1[3]); w1.z = pk2(o1[4], o1[5]); w1.w = pk2(o1[6], o1[7]);
                ((GAS v4u*)(xb_out + (size_t)m * DMODEL) + lane)[64 * j] = w0; ((GAS v4u*)(xb_out + (size_t)m1 * DMODEL) + lane)[64 * j] = w1; }
            if (outf) { GAS f32x4* p0 = (GAS f32x4*)(outf + (size_t)m * DMODEL) + 2 * lane + 128 * j; GAS f32x4* p1 = (GAS f32x4*)(outf + (size_t)m1 * DMODEL) + 2 * lane + 128 * j;
                p0[0] = (f32x4){o0[0], o0[1], o0[2], o0[3]}; p0[1] = (f32x4){o0[4], o0[5], o0[6], o0[7]}; p1[0] = (f32x4){o1[0], o1[1], o1[2], o1[3]}; p1[1] = (f32x4){o1[4], o1[5], o1[6], o1[7]}; } }
    }
}
#define MFMA32(a, b, c) __builtin_amdgcn_mfma_f32_32x32x16_bf16((a), (b), (c), 0, 0, 0)

__device__ __forceinline__ void ba_proj(const bf16* xb, const bf16* wt  , const float* a_log, const float* dt_bias, float* beta, float* g, int gw, int NGW, int lane) {
    const int r32 = lane & 31, hi = lane >> 5;
    for (int wu = gw; wu < MROWS / 32; wu += NGW) {
        const GAS bf16* ap = (const GAS bf16*)xb + (size_t)(wu * 32 + r32) * DMODEL + 8 * hi; const GAS bf16* bp = (const GAS bf16*)wt + (size_t)(GDN_MAIN + r32) * DMODEL + 8 * hi;
        f32x16 acc = {};
#pragma unroll 1
        for (int s0 = 0; s0 < DMODEL / 16; s0 += 8) {
            bf16x8 a[8], b[8];
#pragma unroll
            for (int s = 0; s < 8; ++s) { a[s] = *(const GAS bf16x8*)(ap + (s0 + s) * 16); b[s] = *(const GAS bf16x8*)(bp + (s0 + s) * 16); }
#pragma unroll
            for (int s = 0; s < 8; ++s) acc = MFMA32(a[s], b[s], acc);
        }
        const int j = r32 & 15; const float al = -__expf(((const GAS float*)a_log)[j]), db = ((const GAS float*)dt_bias)[j]; GAS float* betag = (GAS float*)beta; GAS float* gg_ = (GAS float*)g;
#pragma unroll
        for (int r = 0; r < 16; ++r) { const int t = wu * 32 + (r & 3) + 8 * (r >> 2) + 4 * hi; const float v = acc[r];
            if (r32 < 16) betag[(size_t)t * 16 + j] = __builtin_amdgcn_rcpf(1.f + __expf(-v));
            else { const float z = v + db; const float sp = z > 20.f ? z : log1pf(__expf(z)); gg_[(size_t)t * 16 + j] = al * sp; } }
    }
}

#ifndef G2_SKIP
#define G2_SKIP 0
#endif
#ifndef PROBE_G2_NOSCAT
#define PROBE_G2_NOSCAT 0
#endif
typedef short bf16x4 __attribute__((ext_vector_type(4)));
#define MFMA16K16(a, b, c) __builtin_amdgcn_mfma_f32_16x16x16bf16_1k((a), (b), (c), 0, 0, 0)
constexpr int G2_TS = 136;
constexpr int G2_AS = 68, G2_ANS = 72, G2_US = 68;
constexpr int G2_A = 0, G2_GC = G2_A + 64 * G2_AS * 4, G2_BT = G2_GC + 256, G2_AN = G2_BT + 256, G2_TB = G2_AN + 64 * G2_ANS * 2, G2_Q = G2_TB + 2048, G2_K = G2_Q + 64 * G2_TS * 2, G2_V = G2_K + 64 * G2_TS * 2,
              G2_W = G2_V + 64 * G2_TS * 2, G2_END = G2_W + 64 * G2_TS * 2;
static_assert(G2_END <= RING_BYTES, "G2 LDS");
__device__ __forceinline__ bf16x4 pack4(f32x4 v) { v2u w; w.x = pk2(v[0], v[1]); w.y = pk2(v[2], v[3]); return __builtin_bit_cast(bf16x4, w); }
__device__ __forceinline__ void gdn_chunk_phase(LAS unsigned char* lds, bf16* p_, const bf16* halo_, const float* beta_, float* g_, bf16* wbuf_, bf16* attn_, const float* conv_w_, int vcu, int G, bf16* palt_ = nullptr) {
#define G2_ST(off) ((palt ? palt + ((size_t)(off) & 0x7ffffffull) : p + (size_t)(off)))
    int tid_ = threadIdx.x; asm volatile("" : "+v"(tid_));
    const int tid0 = tid_, lane0 = tid0 & 63, wid0 = __builtin_amdgcn_readfirstlane(tid0 >> 6);
    GAS bf16* const p = (GAS bf16*)p_; const GAS bf16* const halo = (const GAS bf16*)halo_; const GAS float* const beta = (const GAS float*)beta_; GAS float* const g = (GAS float*)g_;
    GAS bf16* const wbuf = (GAS bf16*)wbuf_; GAS bf16* const attn = (GAS bf16*)attn_; const GAS float* const conv_w = (const GAS float*)conv_w_; GAS bf16* const palt = (GAS bf16*)palt_;
    LAS bf16* Qs = (LAS bf16*)(lds + G2_Q); LAS bf16* Ks = (LAS bf16*)(lds + G2_K); LAS bf16* Vs = (LAS bf16*)(lds + G2_V); LAS bf16* Ws = (LAS bf16*)(lds + G2_W);
    LAS float* As = (LAS float*)(lds + G2_A); LAS float* gcs = (LAS float*)(lds + G2_GC); LAS float* bts = (LAS float*)(lds + G2_BT);
    LAS bf16* An = (LAS bf16*)(lds + G2_AN); LAS bf16* Tb = (LAS bf16*)(lds + G2_TB); LAS bf16* Us = (LAS bf16*)(lds + G2_A);
    asm volatile("" : "+v"(Qs), "+v"(Ks), "+v"(Vs), "+v"(Ws), "+v"(As), "+v"(gcs), "+v"(bts), "+v"(An), "+v"(Tb), "+v"(Us));
    v4u rawv[3][5]; float gpre = 0.f, bpre = 0.f;
#define G2_LOAD_RAW(uu, LN, WD) do { const int cg_ = (uu) >> 4, h_ = (uu) & 15, n_ = cg_ & 63; const size_t r0_ = (size_t)cg_ * 64; const int cgp_l = (LN) & 15, tA_l = 8 * (WD) + 2 * ((LN) >> 4); \
        _Pragma("unroll") for (int X = 0; X < 3; ++X) { const int col_ = X * 2048 + h_ * HD + 8 * cgp_l; \
            _Pragma("unroll") for (int rr = 0; rr < 5; ++rr) { const int rel = tA_l - 3 + rr; v4u v = {0u, 0u, 0u, 0u}; \
                if (rel >= 0) v = *(const GAS v4u*)(p + (r0_ + rel) * GDN_MAIN + col_); \
                else if (n_ > 0) v = *(const GAS v4u*)(halo + ((size_t)(cg_ - 1) * 3 + (rel + 3)) * CONVC + col_); \
                rawv[X][rr] = v; } } \
        if ((WD) == 0) { gpre = g[(r0_ + (LN)) * 16 + h_]; bpre = beta[(r0_ + (LN)) * 16 + h_]; } } while (0)
    if (vcu < NCG * NHEADS) G2_LOAD_RAW(vcu, lane0, wid0);
    for (int u = vcu; u < NCG * NHEADS; u += G) {
        const int cg = u >> 4, h = u & 15; const size_t row0 = (size_t)cg * 64;
        int tl_ = tid0; asm volatile("" : "+v"(tl_));
        const int tid = tl_, lane = tid & 63, wid = __builtin_amdgcn_readfirstlane(tid >> 6), r32 = lane & 31, hi = lane >> 5;
        {
            const int cgp = lane & 15, sub = lane >> 4, tA = 8 * wid + 2 * sub;
#pragma unroll
            for (int X = 0; X < 3; ++X) {
                const int col = X * 2048 + h * HD + 8 * cgp;
                float raw[5][8];
                asm volatile("" : "+v"(rawv[X][0]), "+v"(rawv[X][1]), "+v"(rawv[X][2]), "+v"(rawv[X][3]), "+v"(rawv[X][4]));
#pragma unroll
                for (int rr = 0; rr < 5; ++rr) { const v4u v = rawv[X][rr];
                    raw[rr][0] = bflo(v.x); raw[rr][1] = bfhi(v.x); raw[rr][2] = bflo(v.y); raw[rr][3] = bfhi(v.y); raw[rr][4] = bflo(v.z); raw[rr][5] = bfhi(v.z); raw[rr][6] = bflo(v.w); raw[rr][7] = bfhi(v.w); }
                float o0[8], o1[8];
#pragma unroll
                for (int c = 0; c < 8; ++c) { o0[c] = 0.f; o1[c] = 0.f; }
#pragma unroll
                for (int j = 0; j < 4; ++j) { const f32x4 wa = *(const GAS f32x4*)(conv_w + (size_t)j * CONVC + col), wb = *(const GAS f32x4*)(conv_w + (size_t)j * CONVC + col + 4);
#pragma unroll
                    for (int c = 0; c < 8; ++c) { const float w = c < 4 ? wa[c] : wb[c - 4]; o0[c] += w * raw[j][c]; o1[c] += w * raw[j + 1][c]; } }
                float s0 = 0.f, s1 = 0.f;
#pragma unroll
                for (int c = 0; c < 8; ++c) { o0[c] = silu_f(o0[c]); o1[c] = silu_f(o1[c]); s0 += o0[c] * o0[c]; s1 += o1[c] * o1[c]; }
                if (X < 2) { s0 = sum16(s0); s1 = sum16(s1); const float sc = X == 0 ? 0.08838834764831845f : 1.f; const float f0 = sc * __builtin_amdgcn_rsqf(s0 + GDN_EPS), f1 = sc * __builtin_amdgcn_rsqf(s1 + GDN_EPS);
#pragma unroll
                    for (int c = 0; c < 8; ++c) { o0[c] *= f0; o1[c] *= f1; } }
                LAS bf16* T = X == 0 ? Qs : (X == 1 ? Ks : Vs);
                v4u w0, w1; w0.x = pk2(o0[0], o0[1]); w0.y = pk2(o0[2], o0[3]); w0.z = pk2(o0[4], o0[5]); w0.w = pk2(o0[6], o0[7]);
                w1.x = pk2(o1[0], o1[1]); w1.y = pk2(o1[2], o1[3]); w1.z = pk2(o1[4], o1[5]); w1.w = pk2(o1[6], o1[7]);
                *(LAS v4u*)(T + tA * G2_TS + 8 * cgp) = w0; *(LAS v4u*)(T + (tA + 1) * G2_TS + 8 * cgp) = w1;
                asm volatile("" ::: "memory");
            }
            if (wid == 0) {
                float gv = gpre;
#pragma unroll
                for (int o = 1; o < 64; o <<= 1) { const float t = __shfl_up(gv, o); if (lane >= o) gv += t; }
                gcs[lane] = gv; bts[lane] = bpre; if (!palt) g[(row0 + lane) * 16 + h] = gv;
            }
        }
        __syncthreads();
        if (u + G < NCG * NHEADS) G2_LOAD_RAW(u + G, lane, wid);
        if (!((G2_SKIP & 4) && palt)) {
            const int rb = (wid >> 1) & 1, cb = wid & 1; const bool isA = wid < 4;
            f32x16 acc = {};
            if (!(rb == 0 && cb == 1)) {
                const LAS bf16* Ar = (isA ? Ks : Qs) + (32 * rb + r32) * G2_TS + 8 * hi; const LAS bf16* Br = Ks + (32 * cb + r32) * G2_TS + 8 * hi;
#pragma unroll
                for (int s = 0; s < 8; ++s) acc = MFMA32(*(const LAS bf16x8*)(Ar + 16 * s), *(const LAS bf16x8*)(Br + 16 * s), acc);
            }
            const int j = 32 * cb + r32; const float gj = gcs[j];
#pragma unroll
            for (int r = 0; r < 16; ++r) { const int i = 32 * rb + (r & 3) + 8 * (r >> 2) + 4 * hi; const float gi = gcs[i];
                if (isA) { const float d = (i > j) ? __expf(gi - gj) : 0.f; const float a = (i > j) ? bts[i] * acc[r] * d : 0.f; As[i * G2_AS + j] = a; An[i * G2_ANS + j] = (bf16)f2bf(-a); }
                else { const float d = (i >= j) ? __expf(gi - gj) : 0.f; Ws[i * G2_TS + j] = (bf16)f2bf((i >= j) ? acc[r] * d : 0.f); } }
        }
        __syncthreads();
        if (wid == 0 && !((G2_SKIP & 2) && palt)) {
            const int b = lane >> 4, c = lane & 15; float t[16];
            const LAS float* Ab = As + (16 * b) * G2_AS + 16 * b;
#pragma unroll
            for (int i = 0; i < 16; ++i) {
                float ti = (i == c) ? 1.f : 0.f;
#pragma unroll
                for (int j4 = 0; j4 < (i + 3) / 4; ++j4) { const f32x4 a = *(const LAS f32x4*)(Ab + i * G2_AS + 4 * j4);
#pragma unroll
                    for (int k = 0; k < 4; ++k) if (4 * j4 + k < i) ti -= a[k] * t[4 * j4 + k]; }
                t[i] = ti;
            }
#pragma unroll
            for (int i = 0; i < 16; ++i) Tb[b * 256 + i * 16 + c] = (bf16)f2bf(t[i]);
        } else if (wid < 5) {
            const int tt = tid - 64, cgp = tt & 15, r0 = tt >> 4;
            { GAS bf16* at = palt ? palt + (((size_t)u * 4096 + 0x4000000ull) & 0x7ffffffull) : attn + (size_t)u * 4096;
#pragma unroll
              for (int k = 0; k < 2; ++k) { const int pc = tt + 256 * k, i = pc >> 3, c8 = pc & 7; *(GAS v4u*)(at + i * 64 + 8 * c8) = *(const LAS v4u*)(Ws + i * G2_TS + 8 * c8); } }
#pragma unroll
            for (int r = 0; r < 4; ++r) { const int i = r0 + 16 * r; const float e = __expf(gcs[i]); const v4u v = *(const LAS v4u*)(Qs + i * G2_TS + 8 * cgp); v4u w;
                w.x = pk2(bflo(v.x) * e, bfhi(v.x) * e); w.y = pk2(bflo(v.y) * e, bfhi(v.y) * e); w.z = pk2(bflo(v.z) * e, bfhi(v.z) * e); w.w = pk2(bflo(v.w) * e, bfhi(v.w) * e);
                *(GAS v4u*)G2_ST((row0 + i) * GDN_MAIN + h * HD + 8 * cgp) = w; }
        } else {
            const float gl = gcs[63];
            for (int task = tid - 320; task < 256; task += 192) { const int dk = task & 127, th = task >> 7;
                GAS bf16* dst = G2_ST((row0 + (dk >> 1)) * GDN_MAIN + 2048 + h * HD + (dk & 1) * 64 + 32 * th);
#pragma unroll
                for (int q = 0; q < 4; ++q) { float v[8];
#pragma unroll
                    for (int k = 0; k < 8; ++k) { const int tk = 32 * th + 8 * q + k; v[k] = bf2f(Ks[tk * G2_TS + dk]) * __expf(gl - gcs[tk]); }
                    v4u w; w.x = pk2(v[0], v[1]); w.y = pk2(v[2], v[3]); w.z = pk2(v[4], v[5]); w.w = pk2(v[6], v[7]); if (!(PROBE_G2_NOSCAT && palt)) *(GAS v4u*)(dst + 8 * q) = w; else asm volatile("" :: "v"(w)); } }
        }
        __syncthreads();
        if (!((G2_SKIP & 1) && palt)) {
            const int nl = lane & 15, q = lane >> 4; const bool isK = wid >= 4;
            float rsc[16];
#pragma unroll
            for (int b = 0; b < 4; ++b)
#pragma unroll
                for (int r = 0; r < 4; ++r) { const int row = 16 * b + 4 * q + r; rsc[4 * b + r] = isK ? bts[row] * __expf(gcs[row]) : bts[row]; }
            bf16x4 Tq[4], Aq[6];
#pragma unroll
            for (int b = 0; b < 4; ++b) Tq[b] = *(const LAS bf16x4*)(Tb + b * 256 + nl * 16 + 4 * q);
            Aq[0] = *(const LAS bf16x4*)(An + (16 + nl) * G2_ANS + 4 * q);
            Aq[1] = *(const LAS bf16x4*)(An + (32 + nl) * G2_ANS + 4 * q);      Aq[2] = *(const LAS bf16x4*)(An + (32 + nl) * G2_ANS + 16 + 4 * q);
            Aq[3] = *(const LAS bf16x4*)(An + (48 + nl) * G2_ANS + 4 * q);      Aq[4] = *(const LAS bf16x4*)(An + (48 + nl) * G2_ANS + 16 + 4 * q);   Aq[5] = *(const LAS bf16x4*)(An + (48 + nl) * G2_ANS + 32 + 4 * q);
#pragma unroll
            for (int t = 0; t < 2; ++t) {
                const int cc = 32 * (wid & 3) + 16 * t + nl;
                const LAS bf16* src = (isK ? Ks : Vs) + cc;
                f32x4 R[4];
#pragma unroll
                for (int b = 0; b < 4; ++b)
#pragma unroll
                    for (int r = 0; r < 4; ++r) R[b][r] = rsc[4 * b + r] * bf2f(src[(16 * b + 4 * q + r) * G2_TS]);
                const f32x4 z4 = {0.f, 0.f, 0.f, 0.f};
                const f32x4 y0 = MFMA16K16(Tq[0], pack4(R[0]), z4); const bf16x4 y0b = pack4(y0);
                f32x4 c1 = MFMA16K16(Aq[0], y0b, R[1]);
                const f32x4 y1 = MFMA16K16(Tq[1], pack4(c1), z4); const bf16x4 y1b = pack4(y1);
                f32x4 c2 = MFMA16K16(Aq[1], y0b, R[2]); c2 = MFMA16K16(Aq[2], y1b, c2);
                const f32x4 y2 = MFMA16K16(Tq[2], pack4(c2), z4); const bf16x4 y2b = pack4(y2);
                f32x4 c3 = MFMA16K16(Aq[3], y0b, R[3]); c3 = MFMA16K16(Aq[4], y1b, c3); c3 = MFMA16K16(Aq[5], y2b, c3);
                const f32x4 y3 = MFMA16K16(Tq[3], pack4(c3), z4); const bf16x4 y3b = pack4(y3);
                if (!isK) {
                    LAS bf16* dst = Us + cc * G2_US + 4 * q;
                    *(LAS bf16x4*)(dst) = y0b; *(LAS bf16x4*)(dst + 16) = y1b; *(LAS bf16x4*)(dst + 32) = y2b; *(LAS bf16x4*)(dst + 48) = y3b;
                } else {
#pragma unroll
                    for (int r = 0; r < 4; ++r) { Ws[(4 * q + r) * G2_TS + cc] = (bf16)y0b[r]; Ws[(16 + 4 * q + r) * G2_TS + cc] = (bf16)y1b[r]; Ws[(32 + 4 * q + r) * G2_TS + cc] = (bf16)y2b[r]; Ws[(48 + 4 * q + r) * G2_TS + cc] = (bf16)y3b[r]; }
                }
            }
        }
        __syncthreads();
#pragma unroll
        for (int k = 0; k < 2; ++k) { const int pc = tid + 512 * k, dv = pc >> 3, c8 = pc & 7;
            const v2u lo = *(const LAS v2u*)(Us + dv * G2_US + 8 * c8), hi2 = *(const LAS v2u*)(Us + dv * G2_US + 8 * c8 + 4);
            *(GAS v4u*)G2_ST((row0 + (dv & 63)) * GDN_MAIN + 4096 + h * HD + (dv >> 6) * 64 + 8 * c8) = (v4u){lo.x, lo.y, hi2.x, hi2.y}; }
#pragma unroll
        for (int k = 0; k < 2; ++k) { const int ch = tid + 512 * k, i = ch >> 4, c8 = ch & 15; *(GAS v4u*)((palt ? palt + (((row0 + i) * DMODEL + h * HD + 8 * c8) & 0x7ffffffull) : wbuf + (row0 + i) * DMODEL + h * HD + 8 * c8)) = *(const LAS v4u*)(Ws + i * G2_TS + 8 * c8); }
    }
#undef G2_ST
#undef G2_LOAD_RAW
}

constexpr int G3_STS = 136, G3_VTS = 72;
constexpr int G3_ST = 0, G3_VT = G3_ST + 64 * G3_STS * 2, G3_OT = G3_VT + 64 * G3_VTS * 2, G3_WT = G3_OT + 64 * G3_VTS * 2, G3_QT = G3_WT + 64 * G3_STS * 2, G3_KT = G3_QT + 64 * G3_STS * 2,
              G3_PT = G3_KT + 128 * G3_VTS * 2, G3_UT = G3_PT + 64 * G3_VTS * 2, G3_END = G3_UT + 64 * G3_VTS * 2;
static_assert(G3_END <= RING_BYTES, "G3 LDS");
__device__ __forceinline__ void gdn_scan_phase(LAS unsigned char* lds, bf16* p_, const bf16* wbuf_, const bf16* attn_, const float* g_, int vcu, int G, bf16* oalt_ = nullptr) {
    GAS bf16* const p = (GAS bf16*)p_; const GAS bf16* const wbuf = (const GAS bf16*)wbuf_; const GAS bf16* const attn = (const GAS bf16*)attn_; const GAS float* const g = (const GAS float*)g_; GAS bf16* const oalt = (GAS bf16*)oalt_;
    int tid_ = threadIdx.x; asm volatile("" : "+v"(tid_));
    const int tid = tid_, lane = tid & 63, wid = __builtin_amdgcn_readfirstlane(tid >> 6), r32 = lane & 31, hi = lane >> 5;
    const int role = wid >> 2, a = (wid >> 1) & 1, bb = wid & 1, r = wid >> 1;
    LAS bf16* ST = (LAS bf16*)(lds + G3_ST); LAS bf16* VT = (LAS bf16*)(lds + G3_VT); LAS bf16* OT = (LAS bf16*)(lds + G3_OT);
    LAS bf16* WT = (LAS bf16*)(lds + G3_WT); LAS bf16* QT = (LAS bf16*)(lds + G3_QT); LAS bf16* KT = (LAS bf16*)(lds + G3_KT); LAS bf16* PT = (LAS bf16*)(lds + G3_PT); LAS bf16* UT = (LAS bf16*)(lds + G3_UT);
    for (int unit = vcu; unit < BATCH * NHEADS * 2; unit += G) {
        const int bh = unit >> 1, e = unit & 1, b = bh >> 4, h = bh & 15;
        for (int i = tid; i < G3_VT / 4; i += NWAVES * 64) ((LAS unsigned*)lds)[i] = 0u;
        f32x16 Sacc = {};
        const int r16a = tid >> 4, c16 = tid & 15, r8 = tid >> 3, c8 = tid & 7;
        const GAS bf16* gW = wbuf + (size_t)r16a * DMODEL + h * HD + 8 * c16;
        const GAS bf16* gQ = p + (size_t)r16a * GDN_MAIN + h * HD + 8 * c16;
        const GAS bf16* gK = p + (size_t)r16a * GDN_MAIN + 2048 + h * HD + 8 * c16;
        const GAS bf16* gP = attn + (size_t)r8 * 64 + 8 * c8;
        const GAS bf16* gU = p + (size_t)r8 * GDN_MAIN + 4096 + h * HD + e * 64 + 8 * c8;
        LAS bf16* sW = WT + r16a * G3_STS + 8 * c16; LAS bf16* sQ = QT + r16a * G3_STS + 8 * c16;
        LAS bf16* sK = KT + (2 * r16a + (c16 >> 3)) * G3_VTS + 8 * (c16 & 7);
        LAS bf16* sP = PT + r8 * G3_VTS + 8 * c8; LAS bf16* sU = UT + r8 * G3_VTS + 8 * c8;
        GAS bf16* oRow = (oalt ? oalt : p + 4096) + h * HD + e * 64; const size_t oPitch = oalt ? DMODEL : GDN_MAIN;
        const LAS bf16* aRd = (role == 0 ? WT : QT) + (32 * a + r32) * G3_STS + 8 * hi;
        const LAS bf16* sRd = ST + (32 * bb + r32) * G3_STS + 8 * hi; const LAS bf16* vRd = VT + (32 * bb + r32) * G3_VTS + 8 * hi;
        const LAS bf16* uRd = UT + (32 * bb + r32) * G3_VTS + 32 * a + 4 * hi; const LAS bf16* pRd = PT + (32 * a + r32) * G3_VTS + 8 * hi; const LAS bf16* kRd = KT + (32 * r + r32) * G3_VTS + 8 * hi;
        LAS bf16* vWr = VT + (32 * bb + r32) * G3_VTS + 32 * a + 4 * hi; LAS bf16* sWr = ST + (32 * bb + r32) * G3_STS + 32 * r + 4 * hi;
        v4u gw0, gw1, gq0, gq1, gk0, gk1, gp0, gu0; float dd;
#define G3_LOAD(nn) do { const size_t row0_ = (size_t)b * SEQ + (size_t)(nn) * 64; \
            gw0 = *(const GAS v4u*)(gW + row0_ * DMODEL); gw1 = *(const GAS v4u*)(gW + (row0_ + 32) * DMODEL); \
            gq0 = *(const GAS v4u*)(gQ + row0_ * GDN_MAIN); gq1 = *(const GAS v4u*)(gQ + (row0_ + 32) * GDN_MAIN); \
            gk0 = *(const GAS v4u*)(gK + row0_ * GDN_MAIN); gk1 = *(const GAS v4u*)(gK + (row0_ + 32) * GDN_MAIN); \
            gp0 = *(const GAS v4u*)(gP + ((size_t)(b * 64 + (nn)) * 16 + h) * 4096); gu0 = *(const GAS v4u*)(gU + row0_ * GDN_MAIN); \
            dd = __expf(g[(row0_ + 63) * 16 + h]); } while (0)
        G3_LOAD(0);
        __syncthreads();
#pragma unroll 1
        for (int n = 0; n < 64; ++n) {
            const size_t row0_ = (size_t)b * SEQ + (size_t)n * 64; const int nn = (n + 1 < 64) ? n + 1 : n;
            *(LAS v4u*)(sW) = gw0; *(LAS v4u*)(sW + 32 * G3_STS) = gw1; *(LAS v4u*)(sQ) = gq0; *(LAS v4u*)(sQ + 32 * G3_STS) = gq1;
            *(LAS v4u*)(sK) = gk0; *(LAS v4u*)(sK + 64 * G3_VTS) = gk1; *(LAS v4u*)(sP) = gp0; *(LAS v4u*)(sU) = gu0;
            const float dcur = dd;
            WG_BAR();
            G3_LOAD(nn);
            f32x16 acc_ = {};
#pragma unroll
            for (int s = 0; s < 8; ++s) acc_ = MFMA32(*(const LAS bf16x8*)(aRd + 16 * s), *(const LAS bf16x8*)(sRd + 16 * s), acc_);
            if (role == 0) {
#pragma unroll
                for (int q = 0; q < 4; ++q) { const v2u uu = *(const LAS v2u*)(uRd + 8 * q); v2u w_;
                    w_.x = pk2(bflo(uu.x) - acc_[4 * q], bfhi(uu.x) - acc_[4 * q + 1]); w_.y = pk2(bflo(uu.y) - acc_[4 * q + 2], bfhi(uu.y) - acc_[4 * q + 3]);
                    *(LAS v2u*)(vWr + 8 * q) = w_; }
            }
            WG_BAR();
            bf16x8 Vf_[4];
#pragma unroll
            for (int s = 0; s < 4; ++s) Vf_[s] = *(const LAS bf16x8*)(vRd + 16 * s);
            if (role == 1) {
#pragma unroll
                for (int s = 0; s < 4; ++s) acc_ = MFMA32(*(const LAS bf16x8*)(pRd + 16 * s), Vf_[s], acc_);
#pragma unroll
                for (int rr = 0; rr < 16; ++rr) OT[(32 * a + (rr & 3) + 8 * (rr >> 2) + 4 * hi) * G3_VTS + 32 * bb + r32] = (bf16)f2bf(acc_[rr]);
            }
            Sacc = Sacc * dcur;
#pragma unroll
            for (int s = 0; s < 4; ++s) Sacc = MFMA32(*(const LAS bf16x8*)(kRd + 16 * s), Vf_[s], Sacc);
#pragma unroll
            for (int q = 0; q < 4; ++q) { v2u w_; w_.x = pk2(Sacc[4 * q], Sacc[4 * q + 1]); w_.y = pk2(Sacc[4 * q + 2], Sacc[4 * q + 3]); *(LAS v2u*)(sWr + 8 * q) = w_; }
            WG_BAR();
            *(GAS v4u*)(oRow + (row0_ + r8) * oPitch + 8 * c8) = *(const LAS v4u*)(OT + r8 * G3_VTS + 8 * c8);
        }
#undef G3_LOAD
        VM_WAIT(); __syncthreads();
    }
}

__device__ __forceinline__ void gdn_gate_phase(bf16* p, const float* norm_w, int gw, int NGW, int lane, bf16* oalt = nullptr) {
    for (int m = gw; m < MROWS; m += NGW) {
        GAS bf16* orow = (GAS bf16*)p + (size_t)m * GDN_MAIN + 4096; const GAS bf16* zrow = (const GAS bf16*)p + (size_t)m * GDN_MAIN + 6144;
#pragma unroll
        for (int it = 0; it < 4; ++it) { const int col = it * 512 + lane * 8;
            const v4u ov = *(const GAS v4u*)(orow + col), zv = *(const GAS v4u*)(zrow + col);
            float o[8] = {bflo(ov.x), bfhi(ov.x), bflo(ov.y), bfhi(ov.y), bflo(ov.z), bfhi(ov.z), bflo(ov.w), bfhi(ov.w)};
            float z[8] = {bflo(zv.x), bfhi(zv.x), bflo(zv.y), bfhi(zv.y), bflo(zv.z), bfhi(zv.z), bflo(zv.w), bfhi(zv.w)};
            float s = 0.f;
#pragma unroll
            for (int c = 0; c < 8; ++c) s += o[c] * o[c];
            s = sum16(s); const float rs = __builtin_amdgcn_rsqf(s * (1.f / HD) + GDN_EPS);
            const f32x4 wa = *(const GAS f32x4*)((const GAS float*)norm_w + (col & 127)), wb = *(const GAS f32x4*)((const GAS float*)norm_w + (col & 127) + 4);
#pragma unroll
            for (int c = 0; c < 8; ++c) o[c] = o[c] * rs * (c < 4 ? wa[c] : wb[c - 4]) * silu_f(z[c]);
            v4u w; w.x = pk2(o[0], o[1]); w.y = pk2(o[2], o[3]); w.z = pk2(o[4], o[5]); w.w = pk2(o[6], o[7]); *(GAS v4u*)((oalt ? (GAS bf16*)oalt + (size_t)m * DMODEL : orow) + col) = w; }
    }
}

#ifndef PG8_SP2
#define PG8_SP2 true
#endif
#ifndef PG8_ALIGN
#define PG8_ALIGN true
#endif
#ifndef EN_P0
#define EN_P0 1
#endif
#ifndef EN_G1
#define EN_G1 1
#endif
#ifndef EN_G2
#define EN_G2 1
#endif
#ifndef EN_G3
#define EN_G3 1
#endif
#ifndef EN_G4
#define EN_G4 1
#endif
#ifndef EN_G5
#define EN_G5 1
#endif
#ifndef EN_G6
#define EN_G6 1
#endif
#ifndef EN_G7
#define EN_G7 1
#endif
#ifndef EN_G8
#define EN_G8 1
#endif
#ifndef EN_G9
#define EN_G9 1
#endif
#ifndef EN_D1
#define EN_D1 1
#endif
#ifndef EN_D2
#define EN_D2 1
#endif
#ifndef EN_D3
#define EN_D3 1
#endif
#ifndef EN_D4
#define EN_D4 1
#endif
#ifndef EN_D5
#define EN_D5 1
#endif
#ifndef EN_D6U
#define EN_D6U 1
#endif
#ifndef EN_D6D
#define EN_D6D 1
#endif
#ifndef EN_D7
#define EN_D7 1
#endif
#ifndef REP_P0
#define REP_P0 1
#endif
#ifndef REP_G1
#define REP_G1 1
#endif
#ifndef REP_G2
#define REP_G2 1
#endif
#ifndef REP_G3
#define REP_G3 1
#endif
#ifndef REP_G4
#define REP_G4 1
#endif
#ifndef REP_G5
#define REP_G5 1
#endif
#ifndef REP_G6
#define REP_G6 1
#endif
#ifndef REP_G7
#define REP_G7 1
#endif
#ifndef REP_G8
#define REP_G8 1
#endif
#ifndef REP_G9
#define REP_G9 1
#endif
#ifndef REP_D1
#define REP_D1 1
#endif
#ifndef REP_D2
#define REP_D2 1
#endif
#ifndef REP_D3
#define REP_D3 1
#endif
#ifndef REP_D4
#define REP_D4 1
#endif
#ifndef REP_D5
#define REP_D5 1
#endif
#ifndef REP_D6U
#define REP_D6U 1
#endif
#ifndef REP_D6D
#define REP_D6D 1
#endif
#ifndef REP_D7
#define REP_D7 1
#endif
#ifndef REP_BA
#define REP_BA 1
#endif
#ifndef PROBE_NOSTORE
#define PROBE_NOSTORE 0
#endif
struct Args { const float* in[16]; float* out; unsigned char* ws; int ph_lo, ph_hi; };
__global__ void __launch_bounds__(NWAVES * 64, 2) yoco_fwd(Args args) {
    extern __shared__ __attribute__((aligned(16))) unsigned char lds_raw[];
    LAS unsigned char* lds = (LAS unsigned char*)lds_raw;
    volatile LAS unsigned* MISC = (volatile LAS unsigned*)(lds + MISC_OFF);
    const int tid = threadIdx.x, lane = tid & 63, wave = __builtin_amdgcn_readfirstlane(tid >> 6);
    const int G = gridDim.x, bx = blockIdx.x, vcu = (G % 8 == 0) ? (bx % 8) * (G / 8) + bx / 8 : bx;
    const int gw = vcu * NWAVES + wave, NGW = G * NWAVES, gtid = vcu * NWAVES * 64 + tid, NGT = G * NWAVES * 64;
    const float* ln_g = args.in[14]; const float* ln_b = args.in[15];
    for (int u = tid; u < (LDS_BYTES - LDSCTL_OFF) / 4; u += NWAVES * 64) ((LAS unsigned*)(lds + LDSCTL_OFF))[u] = 0u;
    __syncthreads();
    XcdBarrier bar; bar.bar = (unsigned*)(args.ws + WS_CTL) + CW_BAR; bar.x = 0; bar.st = nullptr;
    if (!MK_PER_PHASE) bar = xcd_barrier_post((unsigned*)(args.ws + WS_CTL) + CW_BAR, MISC + 8);
    const int lo = args.ph_lo, hi = args.ph_hi;
#define IN(k) (lo <= (k) && (k) < hi)
#define FRESH_LANE() int ln_ = lane; asm volatile("" : "+v"(ln_)); unsigned char* ws_ = args.ws; asm volatile("" : "+s"(ws_)); int gw_ = gw, vcu_ = vcu, bx_ = bx; asm volatile("" : "+s"(gw_), "+s"(vcu_), "+s"(bx_))
#define x_in         (args.in[0])
#define gdn_w_in     (args.in[1])
#define gdn_conv_w   (args.in[2])
#define gdn_a_log    (args.in[3])
#define gdn_dt_bias  (args.in[4])
#define gdn_norm_w   (args.in[5])
#define gdn_w_out    (args.in[6])
#define diff_w_q     (args.in[7])
#define diff_lambda  (args.in[8])
#define diff_subln_w (args.in[9])
#define diff_w_o     (args.in[10])
#define shared_w_kv  (args.in[11])
#define mlp_w_up     (args.in[12])
#define mlp_w_down   (args.in[13])
#define beta  ((float*)(ws_ + WS_BETA))
#define gdec  ((float*)(ws_ + WS_G))
#define halo  ((bf16*)(ws_ + WS_HALO))
#define WA    ((bf16*)(ws_ + WS_WA))
#define WB    ((bf16*)(ws_ + WS_WB))
#define attnb ((bf16*)(ws_ + WS_ATTN))
#define XB    ((bf16*)(ws_ + WS_XB))
#define HB    ((bf16*)(ws_ + WS_Y))
#define WBUF  ((bf16*)(ws_ + WS_Y + QTR))
#define R1    ((bf16*)(ws_ + WS_R1))
#define Kb    (R1)
#define Vb    (R1 + QTR / 2)
#define Qb    (R1 + 2 * (QTR / 2))
#define HID   (Qb)
#define SEAM(k) do { if (!MK_PER_PHASE && (k) + 1 < hi) xcd_barrier(bar); } while (0)

    for (int rep_ = 0; rep_ < REP_P0; ++rep_) if (EN_P0 && IN(0)) { FRESH_LANE();
        for (int m = gw_; m < MROWS; m += NGW) row_to_bf16(x_in + (size_t)m * DMODEL, XB + (size_t)m * DMODEL, ln_);
        convert_w(lds, gw_, NGW, wave, ln_, gdn_w_in, DMODEL, GDN_PROJ, 0, GDN_PROJ, WA, 0);
        SEAM(0);
    }
    for (int l = 0; l < 2; ++l) {
        const int pb = 1 + 9 * l;
        for (int rep_ = 0; rep_ < REP_G1; ++rep_) if (EN_G1 && IN(pb + 0)) { FRESH_LANE();
            pg8::Gemm g{XB, WA, MROWS, GDN_MAIN, DMODEL, DMODEL}; pg8::StaticOrder S; S.init(MROWS, GDN_MAIN, G, bx_);
            pg8::EpiStore<0> E{R1, GDN_MAIN, 0, 0, -1, 1.f, halo};
            pg8::gemm_phase<pg8::EpiStore<0>, pg8::StaticOrder, PG8_ALIGN, PG8_SP2>(lds + RING_OFF, g, S, E);
            { int ln2_ = lane; asm volatile("" : "+v"(ln2_));
              for (int rb_ = 0; rb_ < REP_BA; ++rb_) ba_proj(XB, WA, gdn_a_log + l * 16, gdn_dt_bias + l * 16, beta, gdec, gw_, NGW, ln2_); }
            SEAM(pb + 0);
        }
        for (int rep_ = 0; rep_ < REP_G2; ++rep_) if (EN_G2 && IN(pb + 1)) { FRESH_LANE(); gdn_chunk_phase(lds, R1, halo, beta, gdec, WBUF, attnb, gdn_conv_w + (size_t)l * 4 * CONVC, vcu_, G, (rep_ + 1 < REP_G2) ? (bf16*)args.out : nullptr); SEAM(pb + 1); }
        for (int rep_ = 0; rep_ < REP_G3; ++rep_) if (EN_G3 && IN(pb + 2)) { FRESH_LANE(); gdn_scan_phase(lds, R1, WBUF, attnb, gdec, vcu_, G, (rep_ + 1 < REP_G3) ? (bf16*)args.out : nullptr); SEAM(pb + 2); }
        for (int rep_ = 0; rep_ < REP_G4; ++rep_) if (EN_G4 && IN(pb + 3)) { FRESH_LANE();
            gdn_gate_phase(R1, gdn_norm_w + l * HD, gw_, NGW, ln_, (rep_ + 1 < REP_G4) ? (bf16*)args.out : nullptr);
            convert_w(lds, gw_, NGW, wave, ln_, gdn_w_out + (size_t)l * DMODEL * DMODEL, DMODEL, DMODEL, 0, DMODEL, WA, 0);
            convert_w(lds, gw_, NGW, wave, ln_, mlp_w_up + (size_t)l * DMODEL * DFF, DMODEL, DFF, 0, DFF, WB, 0);
            SEAM(pb + 3);
        }
        for (int rep_ = 0; rep_ < REP_G5; ++rep_) if (EN_G5 && IN(pb + 4)) { FRESH_LANE();
            pg8::Gemm g{R1 + 4096, WA, MROWS, DMODEL, DMODEL, GDN_MAIN}; pg8::StaticOrder S; S.init(MROWS, DMODEL, G, bx_);
            pg8::EpiStore<0> E{(rep_ + 1 < REP_G5) ? (bf16*)args.out : HB, DMODEL, 0, 0, -1, 1.f, nullptr};
            pg8::gemm_phase<pg8::EpiStore<0>, pg8::StaticOrder, PG8_ALIGN, PG8_SP2>(lds + RING_OFF, g, S, E);
            SEAM(pb + 4);
        }
        const float* g1 = ln_g + (size_t)(l * 2) * DMODEL; const float* b1 = ln_b + (size_t)(l * 2) * DMODEL;
        for (int rep_ = 0; rep_ < REP_G6; ++rep_) if (EN_G6 && IN(pb + 5)) { FRESH_LANE();
            ln_pass_b(XB, HB, g1, b1, XB, nullptr, ALPHA_RES, gw_, NGW, ln_);
            convert_w(lds, gw_, NGW, wave, ln_, mlp_w_down + (size_t)l * DFF * DMODEL, DFF, DMODEL, 0, DMODEL, WA, 0);
            SEAM(pb + 5);
        }
        for (int rep_ = 0; rep_ < REP_G7; ++rep_) if (EN_G7 && IN(pb + 6)) { FRESH_LANE();
            pg8::Gemm g{XB, WB, MROWS, DFF, DMODEL, DMODEL}; pg8::StaticOrder S; S.init(MROWS, DFF, G, bx_);
            pg8::EpiStore<1> E{R1, DFF, 0, 0, -1, 1.f, nullptr};
            pg8::gemm_phase<pg8::EpiStore<1>, pg8::StaticOrder, PG8_ALIGN, PG8_SP2>(lds + RING_OFF, g, S, E);
            SEAM(pb + 6);
        }
        for (int rep_ = 0; rep_ < REP_G8; ++rep_) if (EN_G8 && IN(pb + 7)) { FRESH_LANE();
            pg8::Gemm g{R1, WA, MROWS, DMODEL, DFF, DFF}; pg8::StaticOrder S; S.init(MROWS, DMODEL, G, bx_);
            pg8::EpiStore<0> E{(rep_ + 1 < REP_G8) ? (bf16*)args.out : HB, DMODEL, 0, 0, -1, 1.f, nullptr};
            pg8::gemm_phase<pg8::EpiStore<0>, pg8::StaticOrder, PG8_ALIGN, PG8_SP2>(lds + RING_OFF, g, S, E);
            SEAM(pb + 7);
        }
        for (int rep_ = 0; rep_ < REP_G9; ++rep_) if (EN_G9 && IN(pb + 8)) { FRESH_LANE();
            const float* g2 = ln_g + (size_t)(l * 2 + 1) * DMODEL; const float* b2 = ln_b + (size_t)(l * 2 + 1) * DMODEL;
            ln_pass_b(XB, HB, g2, b2, XB, nullptr, ALPHA_RES, gw_, NGW, ln_);
            if (l == 0) convert_w(lds, gw_, NGW, wave, ln_, gdn_w_in + (size_t)DMODEL * GDN_PROJ, DMODEL, GDN_PROJ, 0, GDN_PROJ, WA, 0);
            else { convert_w(lds, gw_, NGW, wave, ln_, shared_w_kv, DMODEL, 2 * DMODEL, 0, 2 * DMODEL, WA, 0);
                   convert_w(lds, gw_, NGW, wave, ln_, diff_w_q, DMODEL, DMODEL, 0, DMODEL, WA, 2 * DMODEL); }
            SEAM(pb + 8);
        }
    }
    for (int j = 0; j < 2; ++j) {
        const int pb = 19 + 10 * j, L = 2 + j;
        for (int rep_ = 0; rep_ < REP_D1; ++rep_) if (EN_D1 && IN(pb + 0)) { FRESH_LANE();
            const int N = (j == 0) ? 3 * DMODEL : DMODEL;
            pg8::Gemm g{XB, WA, MROWS, N, DMODEL, DMODEL}; pg8::StaticOrder S; S.init(MROWS, N, G, bx_);
            pg8::EpiStore<0> E{(j == 0) ? Kb : Qb, DMODEL, (j == 0) ? DMODEL : 0, QTR / 2, (j == 0) ? 2 : 0, dattn::C2, nullptr};
            pg8::gemm_phase<pg8::EpiStore<0>, pg8::StaticOrder, PG8_ALIGN, PG8_SP2>(lds + RING_OFF, g, S, E);
            SEAM(pb + 0);
        }
        for (int rep_ = 0; rep_ < REP_D2; ++rep_) if (EN_D2 && IN(pb + 1)) { FRESH_LANE();
            const float lambda_init = 0.8f - 0.6f * expf(-0.3f * (float)L);
            const float* lp = diff_lambda + (size_t)j * 256;
            const float e1 = wave_sum(lp[ln_] * lp[64 + ln_]), e2 = wave_sum(lp[128 + ln_] * lp[192 + ln_]);
            const dattn::Params AP{(const dattn::bf16*)Qb, (const dattn::bf16*)Kb, (const dattn::bf16*)Vb, (rep_ + 1 < REP_D2) ? (dattn::bf16*)args.out : (dattn::bf16*)Qb, diff_subln_w + j * HD, __expf(e1) - __expf(e2) + lambda_init, 1.f - lambda_init};
            dattn::phase<8>((char*)lds_raw + RING_OFF, AP, G, bx_);
            { int ln2_ = lane; asm volatile("" : "+v"(ln2_));
              convert_w(lds, gw_, NGW, wave, ln2_, diff_w_o + (size_t)j * DMODEL * DMODEL, DMODEL, DMODEL, 0, DMODEL, WB, 0);
              convert_w(lds, gw_, NGW, wave, ln2_, mlp_w_up + (size_t)L * DMODEL * DFF, DMODEL, DFF, 0, DFF, WA, 0); }
            SEAM(pb + 1);
        }
        for (int rep_ = 0; rep_ < REP_D4; ++rep_) if (EN_D4 && IN(pb + 3)) { FRESH_LANE();
            pg8::Gemm g{Qb, WB, MROWS, DMODEL, DMODEL, DMODEL}; pg8::StaticOrder S; S.init(MROWS, DMODEL, G, bx_);
            pg8::EpiStore<0> E{(rep_ + 1 < REP_D4) ? (bf16*)args.out : HB, DMODEL, 0, 0, -1, 1.f, nullptr};
            pg8::gemm_phase<pg8::EpiStore<0>, pg8::StaticOrder, PG8_ALIGN, PG8_SP2>(lds + RING_OFF, g, S, E);
            SEAM(pb + 3);
        }
        const float* g1 = ln_g + (size_t)(L * 2) * DMODEL; const float* b1 = ln_b + (size_t)(L * 2) * DMODEL;
        for (int rep_ = 0; rep_ < REP_D5; ++rep_) if (EN_D5 && IN(pb + 4)) { FRESH_LANE();
            ln_pass_b(XB, HB, g1, b1, XB, nullptr, ALPHA_RES, gw_, NGW, ln_);
            convert_w(lds, gw_, NGW, wave, ln_, mlp_w_down + (size_t)L * DFF * DMODEL, DFF, DMODEL, 0, DMODEL, WB, 0);
            SEAM(pb + 4);
        }
        for (int hf = 0; hf < 2; ++hf) {
            const size_t roff = (size_t)hf * (MROWS / 2);
            for (int rep_ = 0; rep_ < REP_D6U; ++rep_) if (EN_D6U && IN(pb + 5 + 2 * hf)) { FRESH_LANE();
                pg8::Gemm g{XB + roff * DMODEL, WA, MROWS / 2, DFF, DMODEL, DMODEL}; pg8::StaticOrder S; S.init(MROWS / 2, DFF, G, bx_);
                pg8::EpiStore<1> E{(PROBE_NOSTORE && rep_ + 1 < REP_D6U) ? (bf16*)nullptr : HID, DFF, 0, 0, -1, 1.f, nullptr};
                pg8::gemm_phase<pg8::EpiStore<1>, pg8::StaticOrder, PG8_ALIGN, PG8_SP2>(lds + RING_OFF, g, S, E);
                SEAM(pb + 5 + 2 * hf);
            }
            for (int rep_ = 0; rep_ < REP_D6D; ++rep_) if (EN_D6D && IN(pb + 6 + 2 * hf)) { FRESH_LANE();
                pg8::Gemm g{HID, WB, MROWS / 2, DMODEL, DFF, DFF}; pg8::StaticOrder S; S.init(MROWS / 2, DMODEL, G, bx_);
                pg8::EpiStore<0> E{((rep_ + 1 < REP_D6D) ? (bf16*)args.out : HB) + roff * DMODEL, DMODEL, 0, 0, -1, 1.f, nullptr};
                pg8::gemm_phase<pg8::EpiStore<0>, pg8::StaticOrder, PG8_ALIGN, PG8_SP2>(lds + RING_OFF, g, S, E);
                SEAM(pb + 6 + 2 * hf);
            }
        }
        for (int rep_ = 0; rep_ < REP_D7; ++rep_) if (EN_D7 && IN(pb + 9)) { FRESH_LANE();
            const float* g2 = ln_g + (size_t)(L * 2 + 1) * DMODEL; const float* b2 = ln_b + (size_t)(L * 2 + 1) * DMODEL;
            if (j == 0) { ln_pass_b(XB, HB, g2, b2, XB, nullptr, ALPHA_RES, gw_, NGW, ln_);
                          convert_w(lds, gw_, NGW, wave, ln_, diff_w_q + (size_t)DMODEL * DMODEL, DMODEL, DMODEL, 0, DMODEL, WA, 0); }
            else { ln_pass_b(XB, HB, g2, b2, nullptr, args.out, ALPHA_RES, gw_, NGW, ln_); }
            SEAM(pb + 9);
        }
    }
#undef IN
#undef SEAM
}

extern "C" void kernel_launch(void* const* d_in, const int* in_sizes, int n_in, void* d_out, int out_size, void* d_ws, size_t ws_size, hipStream_t stream) {
    static int grid = 0;
    if (grid == 0) {
        if (n_in != 16 || in_sizes[0] != MROWS * DMODEL || out_size != MROWS * DMODEL || ws_size < WS_END) { fprintf(stderr, "kernel_launch: unexpected shapes / workspace (n_in %d, ws %zu < %zu); nothing launched\n", n_in, ws_size, (size_t)WS_END); grid = -1; return; }
        int dev = 0, cus = 0, per_cu = 0;
        if (hipGetDevice(&dev) != hipSuccess || hipDeviceGetAttribute(&cus, hipDeviceAttributeMultiprocessorCount, dev) != hipSuccess) { grid = -1; return; }
        if (hipFuncSetAttribute((const void*)yoco_fwd, hipFuncAttributeMaxDynamicSharedMemorySize, LDS_BYTES) != hipSuccess) { fprintf(stderr, "kernel_launch: hipFuncSetAttribute failed\n"); grid = -1; return; }
        if (hipOccupancyMaxActiveBlocksPerMultiprocessor(&per_cu, (const void*)yoco_fwd, NWAVES * 64, LDS_BYTES) != hipSuccess || per_cu < 1)
            fprintf(stderr, "kernel_launch: note: occupancy query reports %d workgroups per CU\n", per_cu);
        (void)hipGetLastError();
        grid = cus;
    }
    if (grid < 0) return;
    if (hipMemsetAsync((char*)d_ws + WS_CTL, 0, CTL_ZERO_BYTES, stream) != hipSuccess) return;
    Args a{};
    for (int i = 0; i < 16; ++i) a.in[i] = (const float*)d_in[i];
    a.out = (float*)d_out; a.ws = (unsigned char*)d_ws;
#if MK_PER_PHASE
    for (int k = 0; k < N_PHASES; ++k) { a.ph_lo = k; a.ph_hi = k + 1; hipLaunchKernelGGL(yoco_fwd, dim3(grid), dim3(NWAVES * 64), LDS_BYTES, stream, a); }
#else
    a.ph_lo = 0; a.ph_hi = N_PHASES;
    hipLaunchKernelGGL(yoco_fwd, dim3(grid), dim3(NWAVES * 64), LDS_BYTES, stream, a);
#endif
    const hipError_t le = hipPeekAtLastError();
    if (le != hipSuccess) fprintf(stderr, "kernel_launch: launch failed: %s\n", hipGetErrorName(le));
}
```

```cpp
#include <hip/hip_runtime.h>
#include <hip/hip_bf16.h>
#include <cstdio>
#include <cstdint>
#include <cmath>

namespace pg8 {
#define PG8_LAS __attribute__((address_space(3)))
typedef unsigned short bf16_t;
typedef short bf16x8 __attribute__((ext_vector_type(8)));
typedef float f32x4 __attribute__((ext_vector_type(4)));
typedef unsigned u32x4 __attribute__((ext_vector_type(4)));
#define PG8_GAS __attribute__((address_space(1)))
#ifndef PG8_STORE_SC1
#define PG8_STORE_SC1 0
#endif
constexpr int BM = 256, BK = 64, HALF = 128, HTB = HALF * BK * 2  , STAGE_BYTES = 8 * HTB, NXCD = 8, WGM = 8;

__host__ __device__ __forceinline__ int lds_byte(int r, int c) { const int st = (r >> 4) * 2 + (c >> 5), rr = r & 15, cc = c & 31, ob = rr * 64 + cc * 2; return st * 1024 + (ob ^ (((ob >> 9) & 1) << 5)); }
__host__ __device__ __forceinline__ void stage_rc(int b, int& R, int& C) { const int st = b / 1024, sb = b % 1024, swz = sb ^ (((sb >> 9) & 1) << 5); R = (st >> 1) * 16 + swz / 64; C = (st & 1) * 32 + (swz % 64) / 2; }
__host__ __device__ __forceinline__ int perm32(int rho) { const int n = rho >> 4, i = rho & 15; return 8 * (i >> 2) + 4 * n + (i & 3); }

struct Unit { int pm, pn; };
struct Gemm { const bf16_t* A; const bf16_t* Bt; int M, N, K, lda; };

struct StaticOrder {
    int nM, nN, nwg, G, c;
    __host__ __device__ void init(int M, int N, int G_, int c_) { nM = M / BM; nN = N / BM; nwg = nM * nN; G = G_; c = c_; }
    __host__ __device__ bool next(int i, Unit& u) const {
        const long L = (long)i * G + c; if (L >= nwg) return false;
        int wgid = (int)L; { const int q = nwg / NXCD, r = nwg % NXCD, xcd = wgid % NXCD, off = wgid / NXCD; wgid = (xcd < r ? xcd * (q + 1) : r * (q + 1) + (xcd - r) * q) + off; }
        const int nig = WGM * nN, gid = wgid / nig, fm = gid * WGM, gsz = (nM - fm) < WGM ? (nM - fm) : WGM;
        u.pm = fm + ((wgid % nig) % gsz); u.pn = (wgid % nig) / gsz; return true;
    }
    __device__ __forceinline__ void a_ready(const Unit&) const {}
    __device__ __forceinline__ void done(const Unit&) const {}
};

__device__ __forceinline__ unsigned cvt_pk_bf16(float lo, float hi) { unsigned r; asm volatile("v_cvt_pk_bf16_f32 %0, %1, %2" : "=v"(r) : "v"(lo), "v"(hi)); return r; }

template <int ACT> struct EpiStore {
    static constexpr bool PERM = true, AFTER_DRAIN = false;
    bf16_t* O; int ldc; int split_cols; size_t split_stride; int scale_tile; float scale0; bf16_t* halo;
    __device__ __forceinline__ void operator()(const f32x4 (&acc)[2][2][4][2], const Unit& u, int wr, int wc, int fr, int fq) const {
        const int row0 = u.pm * BM + wr * 64 + fr; int colt = u.pn * BM; PG8_GAS bf16_t* base = (PG8_GAS bf16_t*)O; PG8_GAS bf16_t* hal = (PG8_GAS bf16_t*)halo;
        int t = 0; if (split_cols) { t = colt / split_cols; base += (size_t)t * split_stride; colt -= t * split_cols; }
        const float sc = (t == scale_tile) ? scale0 : 1.f;
        const int col0 = colt + wc * 32 + 8 * fq;
#pragma unroll
        for (int ai = 0; ai < 2; ++ai)
#pragma unroll
            for (int m = 0; m < 4; ++m) { const int row = row0 + ai * HALF + m * 16; PG8_GAS bf16_t* rowp = base + (size_t)row * ldc + col0;
#pragma unroll
                for (int bj = 0; bj < 2; ++bj) { f32x4 v0 = acc[ai][bj][m][0], v1 = acc[ai][bj][m][1];
                    if (ACT == 1) {
#pragma unroll
                        for (int e = 0; e < 4; ++e) { const float a = fmaxf(v0[e], 0.f), b = fmaxf(v1[e], 0.f); v0[e] = a * a; v1[e] = b * b; } }
                    if (sc != 1.f) { v0 = v0 * sc; v1 = v1 * sc; }
                    u32x4 w; w.x = cvt_pk_bf16(v0[0], v0[1]); w.y = cvt_pk_bf16(v0[2], v0[3]); w.z = cvt_pk_bf16(v1[0], v1[1]); w.w = cvt_pk_bf16(v1[2], v1[3]);
#if PG8_STORE_SC1
                    if (O != nullptr) asm volatile("global_store_dwordx4 %0, %1, off sc1\n\ts_nop 1" :: "v"(rowp + bj * HALF), "v"(w) : "memory"); else asm volatile("" :: "v"(w));
#else
                    if (O != nullptr) *(PG8_GAS u32x4*)(rowp + bj * HALF) = w; else asm volatile("" :: "v"(w));
#endif
                    if (halo != nullptr && m == 3 && fr >= 13) { const int c = col0 + bj * HALF; if (c < 6144) *(PG8_GAS u32x4*)(hal + ((size_t)(row >> 6) * 3 + (fr - 13)) * 6144 + c) = w; }
                } }
    }
};
template <class Epi, class Sched, bool ALIGN_EPI = false, bool SP2 = false>
__device__ __forceinline__ void gemm_phase(PG8_LAS unsigned char* lds, const Gemm g, const Sched& S, const Epi& E) {
    int tid_ = threadIdx.x; asm volatile("" : "+v"(tid_));
    const int tid = tid_, wid = __builtin_amdgcn_readfirstlane(tid >> 6), lane = tid & 63, wr = wid >> 2, wc = wid & 3, fr = lane & 15, fq = lane >> 4;
    const int K = g.K, nt = K / BK, lda = g.lda;
    unsigned voffA[2], voffB[2];
#pragma unroll
    for (int i = 0; i < 2; ++i) { int R, C; stage_rc(tid * 16 + i * 8192, R, C); const int Rb = Epi::PERM ? ((R & ~31) + perm32(R & 31)) : R;
        voffA[i] = (unsigned)(R * lda + C) * 2u; voffB[i] = (unsigned)(Rb * K + C) * 2u; }
    const size_t kstep = (size_t)(BK * 2);
    const size_t hA = (size_t)HALF * lda * 2, hB = (size_t)HALF * K * 2;
    const size_t tA = 2 * hA, tB = 2 * hB;
    const unsigned ldsw = (unsigned)wid * 1024u;
    const int aoff = lds_byte(wr * 64 + fr, fq * 8), boff = lds_byte(wc * 32 + fr, fq * 8);
#define PG8_SA(b, h) (((b) * 2 + (h)) * HTB)
#define PG8_SB(b, h) ((4 + (b) * 2 + (h)) * HTB)
#define PG8_STAGE(bufoff, gbase, voff) do { _Pragma("unroll") for (int _i = 0; _i < 2; ++_i) \
        __builtin_amdgcn_global_load_lds((const unsigned*)((const char*)(gbase) + (voff)[_i]), (PG8_LAS unsigned*)(lds + (bufoff) + ldsw + _i * 8192), 16, 0, 0); } while (0)
#define PG8_LDA(dst, b, h) do { _Pragma("unroll") for (int m = 0; m < 4; ++m) _Pragma("unroll") for (int k = 0; k < 2; ++k) dst[m][k] = *(const PG8_LAS bf16x8*)(lds + PG8_SA(b, h) + aoff + m * 2048 + k * 1024); } while (0)
#define PG8_LDB(dst, b, h) do { _Pragma("unroll") for (int n = 0; n < 2; ++n) _Pragma("unroll") for (int k = 0; k < 2; ++k) dst[n][k] = *(const PG8_LAS bf16x8*)(lds + PG8_SB(b, h) + boff + n * 2048 + k * 1024); } while (0)
#define PG8_MMA(ai, bj, At, Bt) do { __builtin_amdgcn_s_setprio(1); _Pragma("unroll") for (int m = 0; m < 4; ++m) _Pragma("unroll") for (int n = 0; n < 2; ++n) _Pragma("unroll") for (int k = 0; k < 2; ++k) \
        acc[ai][bj][m][n] = __builtin_amdgcn_mfma_f32_16x16x32_bf16(Bt[n][k], At[m][k], acc[ai][bj][m][n], 0, 0, 0); __builtin_amdgcn_s_setprio(0); } while (0)
#define PG8_WAIT_V(n) asm volatile("s_waitcnt vmcnt(" #n ")" ::: "memory")
#define PG8_WAIT_L(n) asm volatile("s_waitcnt lgkmcnt(" #n ")" ::: "memory")
#define PG8_BAR __builtin_amdgcn_s_barrier()
#define PG8_SCHED __builtin_amdgcn_sched_barrier(0)
    Unit cur, nxt; int ui = 0;
    if (!S.next(0, cur)) return;
    f32x4 acc[2][2][4][2];
#pragma unroll
    for (int a = 0; a < 2; ++a)
#pragma unroll
        for (int b = 0; b < 2; ++b)
#pragma unroll
            for (int m = 0; m < 4; ++m)
#pragma unroll
                for (int n = 0; n < 2; ++n) acc[a][b][m][n] = (f32x4){0.f, 0.f, 0.f, 0.f};
    bf16x8 At[4][2], B0[2][2], B1[2][2];
    const char* cA = (const char*)g.A + (size_t)cur.pm * tA; const char* cB = (const char*)g.Bt + (size_t)cur.pn * tB;
    S.a_ready(cur);
    if constexpr (SP2) {
        PG8_STAGE(PG8_SB(0, 0), cB, voffB); PG8_STAGE(PG8_SB(0, 1), cB + hB, voffB); PG8_STAGE(PG8_SA(0, 0), cA, voffA); PG8_STAGE(PG8_SA(0, 1), cA + hA, voffA);
        if (wr == 1) PG8_BAR;
        PG8_WAIT_V(2); PG8_BAR;
        PG8_STAGE(PG8_SB(1, 0), cB + kstep, voffB); PG8_STAGE(PG8_SA(1, 0), cA + kstep, voffA); PG8_STAGE(PG8_SB(1, 1), cB + hB + kstep, voffB);
        PG8_WAIT_V(6); PG8_BAR;
    } else {
        PG8_STAGE(PG8_SB(0, 0), cB, voffB); PG8_STAGE(PG8_SA(0, 0), cA, voffA); PG8_STAGE(PG8_SB(0, 1), cB + hB, voffB); PG8_STAGE(PG8_SA(0, 1), cA + hA, voffA);
        if (wr == 1) PG8_BAR;
        PG8_WAIT_V(4); PG8_BAR;
        PG8_STAGE(PG8_SB(1, 0), cB + kstep, voffB); PG8_STAGE(PG8_SA(1, 0), cA + kstep, voffA); PG8_STAGE(PG8_SB(1, 1), cB + hB + kstep, voffB);
        PG8_WAIT_V(6); PG8_BAR;
    }
    for (;;) {
        const bool has_next = S.next(ui + 1, nxt);
        const char* nA = has_next ? (const char*)g.A + (size_t)nxt.pm * tA : cA; const char* nB = has_next ? (const char*)g.Bt + (size_t)nxt.pn * tB : cB;
        for (int t = 0; t < nt; t += 2) {
            const bool last = (t == nt - 2);
            const char* a1 = cA + (size_t)(t + 1) * kstep;
            const char* a2 = last ? nA : cA + (size_t)(t + 2) * kstep; const char* b2 = last ? nB : cB + (size_t)(t + 2) * kstep;
            const char* a3 = a2 + kstep; const char* b3 = b2 + kstep;
            if (last && has_next) S.a_ready(nxt);
            if constexpr (SP2) {
            PG8_LDB(B0, 0, 0); PG8_LDB(B1, 0, 1); PG8_SCHED; PG8_LDA(At, 0, 0); PG8_STAGE(PG8_SA(1, 1), a1 + hA, voffA);
            PG8_WAIT_V(8); PG8_WAIT_L(0); PG8_BAR; PG8_MMA(0, 0, At, B0); PG8_MMA(0, 1, At, B1); PG8_BAR; PG8_SCHED;
            PG8_LDA(At, 0, 1); PG8_STAGE(PG8_SB(0, 0), b2, voffB); PG8_STAGE(PG8_SB(0, 1), b2 + hB, voffB); PG8_STAGE(PG8_SA(0, 0), a2, voffA);
            PG8_WAIT_V(8); PG8_WAIT_L(0); PG8_BAR; PG8_MMA(1, 0, At, B0); PG8_MMA(1, 1, At, B1); PG8_BAR; PG8_SCHED;
            PG8_LDB(B0, 1, 0); PG8_LDB(B1, 1, 1); PG8_SCHED; PG8_LDA(At, 1, 0); PG8_STAGE(PG8_SA(0, 1), a2 + hA, voffA);
            PG8_WAIT_V(8); PG8_WAIT_L(0); PG8_BAR; PG8_MMA(0, 0, At, B0); PG8_MMA(0, 1, At, B1); PG8_BAR; PG8_SCHED;
            PG8_LDA(At, 1, 1); PG8_STAGE(PG8_SB(1, 0), b3, voffB); PG8_STAGE(PG8_SB(1, 1), b3 + hB, voffB); PG8_STAGE(PG8_SA(1, 0), a3, voffA);
            PG8_WAIT_V(8); PG8_WAIT_L(0); PG8_BAR; PG8_MMA(1, 0, At, B0); PG8_MMA(1, 1, At, B1); PG8_BAR; PG8_SCHED;
            } else {
            PG8_LDB(B0, 0, 0); PG8_SCHED; PG8_LDA(At, 0, 0); PG8_STAGE(PG8_SA(1, 1), a1 + hA, voffA);
            PG8_WAIT_L(8); PG8_BAR; PG8_WAIT_L(0); PG8_MMA(0, 0, At, B0); PG8_BAR; PG8_SCHED;
            PG8_LDB(B1, 0, 1); PG8_STAGE(PG8_SB(0, 0), b2, voffB);
            PG8_BAR; PG8_WAIT_L(0); PG8_MMA(0, 1, At, B1); PG8_BAR;
            PG8_LDA(At, 0, 1); PG8_STAGE(PG8_SA(0, 0), a2, voffA);
            PG8_BAR; PG8_WAIT_L(0); PG8_MMA(1, 0, At, B0); PG8_BAR; PG8_SCHED;
            PG8_STAGE(PG8_SB(0, 1), b2 + hB, voffB);
            PG8_WAIT_V(6); PG8_BAR; PG8_MMA(1, 1, At, B1); PG8_BAR;
            PG8_LDB(B0, 1, 0); PG8_SCHED; PG8_LDA(At, 1, 0); PG8_STAGE(PG8_SA(0, 1), a2 + hA, voffA);
            PG8_WAIT_L(8); PG8_BAR; PG8_WAIT_L(0); PG8_MMA(0, 0, At, B0); PG8_BAR; PG8_SCHED;
            PG8_LDB(B1, 1, 1); PG8_STAGE(PG8_SB(1, 0), b3, voffB);
            PG8_BAR; PG8_WAIT_L(0); PG8_MMA(0, 1, At, B1); PG8_BAR;
            PG8_LDA(At, 1, 1); PG8_STAGE(PG8_SA(1, 0), a3, voffA);
            PG8_BAR; PG8_WAIT_L(0); PG8_MMA(1, 0, At, B0); PG8_BAR; PG8_SCHED;
            PG8_STAGE(PG8_SB(1, 1), b3 + hB, voffB);
            PG8_WAIT_V(6); PG8_BAR; PG8_MMA(1, 1, At, B1); PG8_BAR;
            }
        }
        if constexpr (ALIGN_EPI) { if (wr == 0) PG8_BAR; }
        if constexpr (!Epi::AFTER_DRAIN) { E(acc, cur, wr, wc, fr, fq); S.done(cur); }
        if (!has_next) break;
#pragma unroll
        for (int a = 0; a < 2; ++a)
#pragma unroll
            for (int b = 0; b < 2; ++b)
#pragma unroll
                for (int m = 0; m < 4; ++m)
#pragma unroll
                    for (int n = 0; n < 2; ++n) acc[a][b][m][n] = (f32x4){0.f, 0.f, 0.f, 0.f};
        cur = nxt; cA = nA; cB = nB; ++ui;
        if constexpr (ALIGN_EPI) { if (wr == 1) PG8_BAR; }
    }
    PG8_WAIT_V(0);
    if constexpr (!ALIGN_EPI) { if (wr == 0) PG8_BAR; }
    PG8_BAR;
#undef PG8_SA
#undef PG8_SB
#undef PG8_STAGE
#undef PG8_LDA
#undef PG8_LDB
#undef PG8_MMA
#undef PG8_WAIT_V
#undef PG8_WAIT_L
#undef PG8_BAR
#undef PG8_SCHED
}
}
#ifndef ATTN_PRIO
#define ATTN_PRIO 0
#endif
namespace dattn {
using bf16=__hip_bfloat16;
using bf16x8=__attribute__((ext_vector_type(8)))short;
using s16x4=__attribute__((ext_vector_type(4)))short;
using f32x16=__attribute__((ext_vector_type(16)))float;
using u32x4=__attribute__((ext_vector_type(4)))unsigned;
constexpr int SEQ=4096,DM=2048,HDV=128;
constexpr int NW=8,QBLK=32,QB=128,KVBLK=64,NQB=SEQ/QB;
__device__ __forceinline__ int crow(int r,int hi){return (r&3)+8*(r>>2)+4*hi;}
#define SBAR() __builtin_amdgcn_sched_barrier(0)
__device__ __forceinline__ void cmask(f32x16&p0,f32x16&p1,int jb,int qrel,int hi){
  const float NEG=-INFINITY; int kb=64*jb+4*hi;
  #pragma unroll
  for(int r=0;r<16;++r){int kv=kb+(r&3)+8*(r>>2); if(kv>qrel)p0[r]=NEG; if(kv+32>qrel)p1[r]=NEG;}
}
constexpr float C2=0.125f*1.4426950408889634f;
constexpr int NSLOT=3, SLOTB=16384;
constexpr int LDS_K=0, LDS_V=NSLOT*SLOTB, LDS_WS=2*NSLOT*SLOTB, LDS_BYTES=LDS_WS+NW*64*4;
__device__ __forceinline__ void glds16(const void*gsrc,unsigned lds_dst){unsigned keep;
  asm volatile("s_mov_b32 %0, m0\n\ts_mov_b32 m0, %2\n\ts_nop 0\n\tglobal_load_lds_dwordx4 %1, off\n\ts_mov_b32 m0, %0":"=&s"(keep):"v"(gsrc),"s"(lds_dst):"memory");}
__device__ __forceinline__ float max3f(float a,float b,float c){float r;asm("v_max3_f32 %0, %1, %2, %3":"=v"(r):"v"(a),"v"(b),"v"(c));return r;}
__device__ __forceinline__ float max2f(float a,float b){float r;asm("v_max_f32_e32 %0, %1, %2":"=v"(r):"v"(a),"v"(b));return r;}
__device__ __forceinline__ float fadd_s(float a,float b){float r;asm("v_add_f32_e32 %0, %1, %2":"=v"(r):"v"(a),"v"(b));return r;}
__device__ __forceinline__ float fsub_s(float a,float b){float r;asm("v_sub_f32_e32 %0, %1, %2":"=v"(r):"v"(a),"v"(b));return r;}
typedef float f32x2_t __attribute__((ext_vector_type(2))); typedef __bf16 bf16x2_t __attribute__((ext_vector_type(2)));
__device__ __forceinline__ unsigned cvtpk_s(float lo,float hi){f32x2_t v={lo,hi};bf16x2_t b=__builtin_convertvector(v,bf16x2_t);return __builtin_bit_cast(unsigned,b);}
#define WAIT_BAR(N) asm volatile("s_waitcnt vmcnt(" #N ") lgkmcnt(0)\n\ts_barrier":::"memory")
typedef __attribute__((address_space(3))) const char* lds_cptr;
typedef short v4i16_t __attribute__((ext_vector_type(4)));
__device__ __forceinline__ void qkt(f32x16&p0,f32x16&p1,const char*kb,const bf16x8*qr){ const f32x16 negm=f32x16{};
  #pragma unroll
  for(int d0=0;d0<4;++d0){
    const bf16x8 b0=*reinterpret_cast<const bf16x8*>(kb+d0*2048);
    const bf16x8 b1=*reinterpret_cast<const bf16x8*>(kb+d0*2048+512);
    if(d0==0){p0=__builtin_amdgcn_mfma_f32_32x32x16_bf16(b0,qr[0],negm,0,0,0);p1=__builtin_amdgcn_mfma_f32_32x32x16_bf16(b1,qr[0],negm,0,0,0);}
    else{p0=__builtin_amdgcn_mfma_f32_32x32x16_bf16(b0,qr[d0],p0,0,0,0);p1=__builtin_amdgcn_mfma_f32_32x32x16_bf16(b1,qr[d0],p1,0,0,0);}}
}
__device__ __forceinline__ void kload8(bf16x8*kf,lds_cptr kp){
  kf[0]=*(const __attribute__((address_space(3))) bf16x8*)(kp);      kf[1]=*(const __attribute__((address_space(3))) bf16x8*)(kp+512);
  kf[2]=*(const __attribute__((address_space(3))) bf16x8*)(kp+2048); kf[3]=*(const __attribute__((address_space(3))) bf16x8*)(kp+2560);
  kf[4]=*(const __attribute__((address_space(3))) bf16x8*)(kp+4096); kf[5]=*(const __attribute__((address_space(3))) bf16x8*)(kp+4608);
  kf[6]=*(const __attribute__((address_space(3))) bf16x8*)(kp+6144); kf[7]=*(const __attribute__((address_space(3))) bf16x8*)(kp+6656);
}
__device__ __forceinline__ void kload2(bf16x8*kf,lds_cptr kp,int j){ kf[2*j]=*(const __attribute__((address_space(3))) bf16x8*)(kp+j*2048); kf[2*j+1]=*(const __attribute__((address_space(3))) bf16x8*)(kp+j*2048+512); }
__device__ __forceinline__ s16x4 vtr(lds_cptr p){ return __builtin_bit_cast(s16x4,__builtin_amdgcn_ds_read_tr16_b64_v4i16((__attribute__((address_space(3))) v4i16_t*)p)); }
__device__ __forceinline__ float rowmax(const f32x16&p0,const f32x16&p1){
  float a=max3f(p0[0],p0[1],p1[0]),b=max3f(p0[2],p0[3],p1[1]);a=max3f(a,p1[2],p1[3]);
  #pragma unroll
  for(int r=4;r<16;r+=4){a=max3f(a,p0[r],p0[r+1]);b=max3f(b,p0[r+2],p0[r+3]);a=max3f(a,p1[r],p1[r+1]);b=max3f(b,p1[r+2],p1[r+3]);}
  const float m=max2f(a,b);
  auto rr=__builtin_amdgcn_permlane32_swap(__float_as_uint(m),__float_as_uint(m),false,false);
  return max2f(__uint_as_float(rr[0]),__uint_as_float(rr[1]));
}
__device__ __forceinline__ void pv(f32x16*o,int vb,bf16x8 pa0,bf16x8 pa1,bf16x8 pa2,bf16x8 pa3){
  #pragma unroll
  for(int d0=0;d0<4;++d0){s16x4 lo[4],hi[4];
    #pragma unroll
    for(int ks=0;ks<4;++ks){
      asm volatile("ds_read_b64_tr_b16 %0,%1 offset:%c2":"=&v"(lo[ks]):"v"(vb),"i"(d0*4096+ks*1024):"memory");
      asm volatile("ds_read_b64_tr_b16 %0,%1 offset:%c2":"=&v"(hi[ks]):"v"(vb),"i"(d0*4096+ks*1024+512):"memory");}
    asm volatile("s_waitcnt lgkmcnt(0)":::"memory");SBAR();
    #define PK(k) (bf16x8){lo[k][0],lo[k][1],lo[k][2],lo[k][3],hi[k][0],hi[k][1],hi[k][2],hi[k][3]}
    o[d0]=__builtin_amdgcn_mfma_f32_32x32x16_bf16(pa0,PK(0),o[d0],0,0,0);
    o[d0]=__builtin_amdgcn_mfma_f32_32x32x16_bf16(pa1,PK(1),o[d0],0,0,0);
    o[d0]=__builtin_amdgcn_mfma_f32_32x32x16_bf16(pa2,PK(2),o[d0],0,0,0);
    o[d0]=__builtin_amdgcn_mfma_f32_32x32x16_bf16(pa3,PK(3),o[d0],0,0,0);
    #undef PK
  }
}

struct Params { const bf16* Q; const bf16* K; const bf16* V; bf16* O; const float* subln_w; float lam, post; };
template<int THRL> __device__ __forceinline__ void unit(int b,int h,int qb,const Params&P,char*shm){
  int tid_=threadIdx.x; asm volatile("":"+v"(tid_));
  const int tid=tid_,lane=tid&63,r32=lane&31,hi=lane>>5; const int wid=__builtin_amdgcn_readfirstlane(tid>>6);
  const int cmp=wid&1,rbk=wid>>1;
  if(ATTN_PRIO&&wid>=4)__builtin_amdgcn_s_setprio(1);
  const long rowbase=(long)b*SEQ; const int q0=qb*QB;
  const bf16*Qw=P.Q+(rowbase+q0+rbk*QBLK)*DM+h*HDV+cmp*64;
  const bf16*Kh=P.K+rowbase*DM+h*HDV,*Vh=P.V+rowbase*DM+h*HDV;
  const unsigned lds0=(unsigned)(uintptr_t)shm;
  float*wsf=(float*)(shm+LDS_WS)+wid*64;
  const bf16*ksrc=Kh+(long)lane*DM+wid*8;
  const bf16*vsrc=Vh+(long)(16*(wid&3)+(lane>>2))*DM+(wid>>2)*32+(lane&3)*8;
  const unsigned kdst=lds0+LDS_K+wid*1024, vdst=lds0+LDS_V+wid*1024;
  #define DMA_K(t,slot) do{ glds16(ksrc+(long)(t)*KVBLK*DM,(unsigned)__builtin_amdgcn_readfirstlane(kdst+(slot))); glds16(ksrc+(long)(t)*KVBLK*DM+64,(unsigned)__builtin_amdgcn_readfirstlane(kdst+(slot)+8192)); }while(0)
  #define DMA_V(t,slot) do{ glds16(vsrc+(long)(t)*KVBLK*DM,(unsigned)__builtin_amdgcn_readfirstlane(vdst+(slot))); glds16(vsrc+(long)(t)*KVBLK*DM+64,(unsigned)__builtin_amdgcn_readfirstlane(vdst+(slot)+8192)); }while(0)
  const int vb0=(int)(lds0+LDS_V)+((lane>>4)&1)*32+(lane&3)*8+(4*hi+((lane&15)>>2))*64;
  bf16x8 kf[8];
  const lds_cptr shm3=(lds_cptr)shm; const lds_cptr kp0=shm3+LDS_K+(cmp*8+hi)*1024+r32*16; const lds_cptr vp0=shm3+LDS_V+((lane>>4)&1)*32+(lane&3)*8+(4*hi+((lane&15)>>2))*64;
  const char*Kbase=shm+LDS_K+(cmp*8+hi)*1024+r32*16;
  const int NT=(q0+QB)/KVBLK;
  DMA_K(0,0);DMA_V(0,0);DMA_K(1,SLOTB);
  bf16x8 qr[4];
  #pragma unroll
  for(int d0=0;d0<4;++d0)qr[d0]=*(const __attribute__((address_space(1))) bf16x8*)(&Qw[(long)r32*DM+d0*16+hi*8]);
  float mhat=0.f,l_reg=0.f;f32x16 o[4];o[0]=f32x16{};o[1]=f32x16{};o[2]=f32x16{};o[3]=f32x16{};const f32x16 zero16=f32x16{};
  const int qrel=rbk*QBLK+r32;
  #define CMASK(P0,P1,t) do{int jb_=(t)-(NT-2); if(jb_>=0)cmask(P0,P1,jb_,qrel,hi);}while(0)
  bool resc=false;
  #define START(P0,P1) do{ const float rm=rowmax(P0,P1); resc=false; \
    { const float dl=rm; mhat=fadd_s(mhat,dl); \
      _Pragma("unroll") for(int r=0;r<16;++r){P0[r]=fsub_s(P0[r],dl);P1[r]=fsub_s(P1[r],dl);} } \
    _Pragma("unroll") for(int r=0;r<16;++r)P0[r]=__builtin_amdgcn_exp2f(P0[r]); }while(0)
  #define RESC() do{ if(resc){ asm volatile("s_waitcnt lgkmcnt(0)":::"memory"); \
      _Pragma("unroll") for(int d_=0;d_<4;++d_) _Pragma("unroll") for(int r=0;r<16;++r)o[d_][r]*=wsf[crow(r,hi)]; } }while(0)
  f32x16 pA0,pA1,pB0,pB1;
  int sl_prev=0,sl_cur=0,sl_next=SLOTB;
  #define ROT() do{sl_prev=sl_cur;sl_cur=sl_next;sl_next=(sl_next==(NSLOT-1)*SLOTB)?0:sl_next+SLOTB;}while(0)
  DMA_K(2,2*SLOTB);
  WAIT_BAR(6);
  qkt(pA0,pA1,Kbase,qr);asm volatile("s_nop 15\n\ts_nop 7":"+v"(pA0),"+v"(pA1));CMASK(pA0,pA1,0);
  START(pA0,pA1);
  _Pragma("unroll") for(int r=0;r<16;++r)pA1[r]=__builtin_amdgcn_exp2f(pA1[r]);
  WAIT_BAR(0);
  DMA_K(3,0);DMA_V(1,SLOTB);
  ROT();
  kload8(kf,kp0+sl_cur);
  if(NT>2){WAIT_BAR(4);}else{WAIT_BAR(0);}
  s16x4 vlo[4],vhi[4]; u32x4 pw0,pw1,pw2,pw3;
  #define PKW(P,B) cvtpk_s(P[B],P[B+1])
  #define PAF(k) __builtin_bit_cast(bf16x8,pw##k)
  #define VFR(i) (bf16x8){vlo[i][0],vlo[i][1],vlo[i][2],vlo[i][3],vhi[i][0],vhi[i][1],vhi[i][2],vhi[i][3]}
  #define PIN(x) asm volatile("":"+v"(x))
  #define MX3(a,b,c) __builtin_fmaxf(__builtin_fmaxf((a),(b)),(c))
  #define GAPA(MF,A0,A1,A2,A3,W0,W1,PW) do{ MF; sacc+=A0; sacc+=A1; sacc+=A2; sacc+=A3; PIN(sacc); W0; W1; PIN(PW); SBAR(); }while(0)
  #define EX(v) __builtin_amdgcn_exp2f((v)-mhat)
  #define VOFF(f) ((((f)&3)*4096)+(((f)>>2)*1024))
  #define VRD(i,f) do{ vlo[i]=vtr(vp_+VOFF(f)); vhi[i]=vtr(vp_+VOFF(f)+512); }while(0)
  #define GAPB(MF,X,B) do{ MF; X[B]=EX(X[B]); X[B+1]=EX(X[B+1]); PIN(X); SBAR(); }while(0)
  #define GAPBV(MF,X,B,i,f) do{ MF; X[B]=EX(X[B]); X[B+1]=EX(X[B+1]); PIN(X); VRD(i,f); SBAR(); }while(0)
  #define KRD(G,j) do{ if(G){ kload2(kf,kp0+sl_next,j); SBAR(); } }while(0)
  #define PVM(d,k,i) o[d]=__builtin_amdgcn_mfma_f32_32x32x16_bf16(PAF(k),VFR(i),o[d],0,0,0)
  #define STEP(C0,C1,P0,P1,t,GK,GV,GL) do{ SBAR(); \
    const lds_cptr vp_=vp0+sl_prev; \
    float sacc=(P0[0]+P0[1]); \
    GAPA(C0=__builtin_amdgcn_mfma_f32_32x32x16_bf16(kf[0],qr[0],zero16,0,0,0), P0[2],P0[3],P0[4],P0[5],     pw0[0]=PKW(P0,0), pw0[1]=PKW(P0,2), pw0); \
    GAPA(C1=__builtin_amdgcn_mfma_f32_32x32x16_bf16(kf[1],qr[0],zero16,0,0,0), P0[6],P0[7],P0[8],P0[9],     pw0[2]=PKW(P0,4), pw0[3]=PKW(P0,6), pw0); \
    GAPA(C0=__builtin_amdgcn_mfma_f32_32x32x16_bf16(kf[2],qr[1],C0,0,0,0),   P0[10],P0[11],P0[12],P0[13], pw1[0]=PKW(P0,8), pw1[1]=PKW(P0,10), pw1); \
    GAPA(C1=__builtin_amdgcn_mfma_f32_32x32x16_bf16(kf[3],qr[1],C1,0,0,0),   P0[14],P0[15],P1[0],P1[1],   pw1[2]=PKW(P0,12),pw1[3]=PKW(P0,14), pw1); \
    VRD(0,0); SBAR(); GAPA(C0=__builtin_amdgcn_mfma_f32_32x32x16_bf16(kf[4],qr[2],C0,0,0,0),   P1[2],P1[3],P1[4],P1[5],     pw2[0]=PKW(P1,0), pw2[1]=PKW(P1,2), pw2); \
    VRD(1,1); SBAR(); GAPA(C1=__builtin_amdgcn_mfma_f32_32x32x16_bf16(kf[5],qr[2],C1,0,0,0),   P1[6],P1[7],P1[8],P1[9],     pw2[2]=PKW(P1,4), pw2[3]=PKW(P1,6), pw2); \
    VRD(2,2); SBAR(); GAPA(C0=__builtin_amdgcn_mfma_f32_32x32x16_bf16(kf[6],qr[3],C0,0,0,0),   P1[10],P1[11],P1[12],P1[13], pw3[0]=PKW(P1,8), pw3[1]=PKW(P1,10), pw3); \
    VRD(3,3); SBAR(); GAPA(C1=__builtin_amdgcn_mfma_f32_32x32x16_bf16(kf[7],qr[3],C1,0,0,0),   P1[14],P1[15],0.f,0.f,       pw3[2]=PKW(P1,12),pw3[3]=PKW(P1,14), pw3); \
    l_reg+=sacc; \
    if(GK){DMA_K((t)+3,sl_cur);} if(GV){DMA_V((t)+1,sl_next);} \
    CMASK(C0,C1,t); \
    { float a=MX3(C0[0],C0[1],C1[0]),b=MX3(C0[2],C0[3],C1[1]); a=MX3(a,C1[2],C1[3]); \
      _Pragma("unroll") for(int r=4;r<16;r+=4){a=MX3(a,C0[r],C0[r+1]);b=MX3(b,C0[r+2],C0[r+3]);a=MX3(a,C1[r],C1[r+1]);b=MX3(b,C1[r+2],C1[r+3]);} \
      float rm=__builtin_fmaxf(a,b); { auto rr=__builtin_amdgcn_permlane32_swap(__float_as_uint(rm),__float_as_uint(rm),false,false); rm=__builtin_fmaxf(__uint_as_float(rr[0]),__uint_as_float(rr[1])); } \
      rm-=mhat; resc=false; \
      if(__builtin_expect(__any(rm>(float)THRL),0)){ const float dl=__builtin_fmaxf(rm,0.f); mhat+=dl; \
        const float f=__builtin_amdgcn_exp2f(-dl); l_reg*=f; if(hi==0)wsf[r32]=f; resc=true; } } \
    SBAR(); \
    GAPBV(PVM(0,0,0),C0,0, 0,4);  GAPBV(PVM(1,0,1),C0,2, 1,5);  GAPBV(PVM(2,0,2),C0,4, 2,6);  GAPBV(PVM(3,0,3),C0,6, 3,7); \
    GAPBV(PVM(0,1,0),C0,8, 0,8);  GAPBV(PVM(1,1,1),C0,10,1,9);  GAPBV(PVM(2,1,2),C0,12,2,10); GAPBV(PVM(3,1,3),C0,14,3,11); \
    KRD(GL,0); GAPBV(PVM(0,2,0),C1,0, 0,12); KRD(GL,1); GAPBV(PVM(1,2,1),C1,2, 1,13); KRD(GL,2); GAPBV(PVM(2,2,2),C1,4, 2,14); KRD(GL,3); GAPBV(PVM(3,2,3),C1,6, 3,15); \
    GAPB(PVM(0,3,0),C1,8); GAPB(PVM(1,3,1),C1,10); GAPB(PVM(2,3,2),C1,12); GAPB(PVM(3,3,3),C1,14); \
    }while(0)
  int t=1;
  #undef CMASK
  #define CMASK(P0,P1,t) do{}while(0)
  for(;t+3<NT;t+=2){
    STEP(pB0,pB1,pA0,pA1,t,true,true,true);     WAIT_BAR(4); RESC(); ROT();
    STEP(pA0,pA1,pB0,pB1,t+1,true,true,true);   WAIT_BAR(4); RESC(); ROT();
  }
  #undef CMASK
  #define CMASK(P0,P1,t) do{int jb_=(t)-(NT-2); if(jb_>=0)cmask(P0,P1,jb_,qrel,hi);}while(0)
  #define ENDW(tt) do{ if((tt)+3<NT){WAIT_BAR(4);} else if((tt)+2<NT){WAIT_BAR(2);} else {WAIT_BAR(0);} }while(0)
  for(;t+1<NT;t+=2){
    STEP(pB0,pB1,pA0,pA1,t,(t+3<NT),(t+1<NT),(t+1<NT));       ENDW(t);   RESC(); ROT();
    STEP(pA0,pA1,pB0,pB1,t+1,(t+4<NT),(t+2<NT),(t+2<NT));     ENDW(t+1); RESC(); ROT();
  }
  STEP(pB0,pB1,pA0,pA1,NT-1,false,false,false); RESC();
  { float sacc=pB0[0]+pB0[1]; _Pragma("unroll") for(int r=2;r<16;++r)sacc+=pB0[r]; _Pragma("unroll") for(int r=0;r<16;++r)sacc+=pB1[r]; l_reg+=sacc;
    pw0=(u32x4){PKW(pB0,0),PKW(pB0,2),PKW(pB0,4),PKW(pB0,6)};pw1=(u32x4){PKW(pB0,8),PKW(pB0,10),PKW(pB0,12),PKW(pB0,14)};pw2=(u32x4){PKW(pB1,0),PKW(pB1,2),PKW(pB1,4),PKW(pB1,6)};pw3=(u32x4){PKW(pB1,8),PKW(pB1,10),PKW(pB1,12),PKW(pB1,14)};
    SBAR(); pv(o,vb0+sl_cur,PAF(0),PAF(1),PAF(2),PAF(3)); }
  #undef PKW
  #undef PAF
  #undef VFR
  #undef PIN
  #undef MX3
  #undef GAPA
  #undef GAPB
  #undef GAPBV
  #undef EX
  #undef VOFF
  #undef VRD
  #undef KRD
  #undef PVM
  #undef STEP
  #undef ENDW
  {auto rr=__builtin_amdgcn_permlane32_swap(__float_as_uint(l_reg),__float_as_uint(l_reg),false,false);l_reg=__uint_as_float(rr[0])+__uint_as_float(rr[1]);}
  if(hi==0)wsf[32+r32]=l_reg;asm volatile("s_waitcnt lgkmcnt(0)":::"memory");
  float rli[16];
  #pragma unroll
  for(int r=0;r<16;++r)rli[r]=__builtin_amdgcn_rcpf(wsf[32+crow(r,hi)]);
  asm volatile("s_waitcnt lgkmcnt(0)\n\ts_barrier":::"memory");
  { bf16*stg=(bf16*)(shm)+wid*4096;
    #pragma unroll
    for(int r=0;r<16;++r){const int orow=crow(r,hi);
      #pragma unroll
      for(int d0=0;d0<4;++d0)stg[orow*128+d0*32+r32]=__float2bfloat16(o[d0][r]*rli[r]);} }
  asm volatile("s_waitcnt lgkmcnt(0)\n\ts_barrier":::"memory");
  { const bf16*s0=(const bf16*)(shm)+(wid&~1)*4096; const bf16*s1=s0+4096;
    bf16*Ow=P.O+(rowbase+q0+rbk*QBLK)*DM+h*HDV; const int ch=lane&15;
    typedef float f32x4_t __attribute__((ext_vector_type(4)));
    const f32x4_t wa=*(const __attribute__((address_space(1))) f32x4_t*)(P.subln_w+ch*8), wb=*(const __attribute__((address_space(1))) f32x4_t*)(P.subln_w+ch*8+4);
    #pragma unroll
    for(int i=0;i<4;++i){ const int row=16*cmp+4*i+(lane>>4);
      const u32x4 a=*(const u32x4*)(s0+row*128+ch*8), bq=*(const u32x4*)(s1+row*128+ch*8);
      float d[8];
      #pragma unroll
      for(int k=0;k<4;++k){ const unsigned ua=a[k],ub=bq[k];
        d[2*k]=__uint_as_float(ua<<16)-P.lam*__uint_as_float(ub<<16); d[2*k+1]=__uint_as_float(ua&0xffff0000u)-P.lam*__uint_as_float(ub&0xffff0000u); }
      float s=0.f;
      #pragma unroll
      for(int k=0;k<8;++k)s+=d[k]*d[k];
      s+=__shfl_xor(s,1);s+=__shfl_xor(s,2);s+=__shfl_xor(s,4);s+=__shfl_xor(s,8);
      const float rs=P.post*__builtin_amdgcn_rsqf(s*(1.f/128.f)+1e-5f);
      u32x4 w; w[0]=cvtpk_s(d[0]*rs*wa[0],d[1]*rs*wa[1]); w[1]=cvtpk_s(d[2]*rs*wa[2],d[3]*rs*wa[3]); w[2]=cvtpk_s(d[4]*rs*wb[0],d[5]*rs*wb[1]); w[3]=cvtpk_s(d[6]*rs*wb[2],d[7]*rs*wb[3]);
      *(__attribute__((address_space(1))) u32x4*)(Ow+(long)row*DM+ch*8)=w; } }
  asm volatile("s_waitcnt lgkmcnt(0)\n\ts_barrier":::"memory");
  if(ATTN_PRIO&&wid>=4)__builtin_amdgcn_s_setprio(0);
  #undef DMA_K
  #undef DMA_V
  #undef CMASK
  #undef START
  #undef RESC
  #undef ROT
}
constexpr int ATTN_LDS_BYTES=LDS_BYTES;
template<int THRL=8> __device__ __forceinline__ void phase(char*lds,const Params&P,int grid,int block){
  const int vcu=(grid%8==0)?(block%8)*(grid/8)+block/8:block;
  for(int v=vcu;v<256;v+=grid){ const int bh=v>>1,p=v&1;
    for(int i=0;i<16;++i){ const int s=2*(i>>1)+p; const int qb=(i&1)?31-s:s; unit<THRL>(bh>>4,bh&15,qb,P,lds); } }
}
#undef SBAR
#undef WAIT_BAR
}
constexpr int NWAVES = 8;
#ifndef MK_PER_PHASE
#define MK_PER_PHASE 0
#endif

constexpr int BATCH = 8, SEQ = 4096, DMODEL = 2048, MROWS = BATCH * SEQ, DFF = 8192, NHEADS = 16, HD = 128;
constexpr int GDN_PROJ = 8224, GDN_MAIN = 8192, CONVC = 6144, NCG = MROWS / 64;
constexpr float ALPHA_RES = 1.6817928305074292f;
constexpr float LN_EPS = 1e-5f, GDN_EPS = 1e-6f, SUBLN_EPS = 1e-5f;
constexpr int N_PHASES = 39;

constexpr size_t MiB = 1u << 20;
constexpr size_t WS_CTL = 0, CTL_ZERO_BYTES = 1 * MiB;
constexpr size_t WS_ONES = 1 * MiB, WS_ZEROS = WS_ONES + 8192, WS_MU = WS_ONES + 65536, WS_RSTD = WS_MU + 131072;
constexpr size_t WS_BETA = 2 * MiB, WS_G = 4 * MiB;
constexpr size_t WS_HALO = 9 * MiB;
constexpr size_t WS_WA = 27 * MiB, WS_WB = 60 * MiB;
constexpr size_t WS_ATTN = 27 * MiB;
constexpr size_t WS_XB = 92 * MiB;
constexpr size_t WS_Y = 220 * MiB;
constexpr size_t WS_R1 = 476 * MiB;
constexpr size_t WS_END = 988 * MiB;
constexpr size_t QTR = 128 * MiB;
constexpr int CW_TMO = 0;
constexpr int CW_BAR = 4096;

constexpr int RING_OFF = 0, RING_BYTES = 131072;
constexpr int LDSCTL_OFF = RING_BYTES, MISC_OFF = LDSCTL_OFF + 320;
constexpr int LDS_BYTES = 147456;
static_assert(MISC_OFF + 128 <= LDS_BYTES, "LDS map");

#define GAS __attribute__((address_space(1)))
#define LAS __attribute__((address_space(3)))
typedef unsigned short bf16;
typedef unsigned v4u __attribute__((ext_vector_type(4)));
typedef unsigned v2u __attribute__((ext_vector_type(2)));
typedef float f32x4 __attribute__((ext_vector_type(4)));
typedef float f32x16 __attribute__((ext_vector_type(16)));
typedef short bf16x8 __attribute__((ext_vector_type(8)));
typedef GAS unsigned gu32;
typedef GAS unsigned long long gu64;
#define RLX_AGENT __ATOMIC_RELAXED, __HIP_MEMORY_SCOPE_AGENT
#define LDS_WAIT() asm volatile("s_waitcnt lgkmcnt(0)" ::: "memory")
#define VM_WAIT() asm volatile("s_waitcnt vmcnt(0)" ::: "memory")
#define WG_BAR() asm volatile("s_waitcnt lgkmcnt(0)\n\ts_barrier" ::: "memory")
typedef float f32x2_t_ __attribute__((ext_vector_type(2))); typedef __bf16 bf16x2_t_ __attribute__((ext_vector_type(2)));
__device__ __forceinline__ unsigned pk2(float lo, float hi) { f32x2_t_ v = {lo, hi}; bf16x2_t_ b = __builtin_convertvector(v, bf16x2_t_); return __builtin_bit_cast(unsigned, b); }
__device__ __forceinline__ unsigned f2bf(float f) { return pk2(f, 0.f) & 0xffffu; }
__device__ __forceinline__ float bflo(unsigned w) { return __builtin_bit_cast(float, w << 16); }
__device__ __forceinline__ float bfhi(unsigned w) { return __builtin_bit_cast(float, w & 0xffff0000u); }
__device__ __forceinline__ float bf2f(bf16 h) { return __builtin_bit_cast(float, (unsigned)h << 16); }
__device__ __forceinline__ float fast_exp(float x) { return __builtin_amdgcn_exp2f(x * 1.4426950408889634f); }
__device__ __forceinline__ float silu_f(float x) { return x * __builtin_amdgcn_rcpf(1.f + __expf(-x)); }

#define XB_TMO      128
#define XB_XCNT(j)  (256  + 64 * (j))
#define XB_XSUB(j)  (1280 + 64 * (j))
#define XB_XGEN(j)  (2304 + 64 * (j))
#define XB_TOP      3328
#define XB_TOPGEN   3392
#define XCD_BAR_WORDS 3456
#define XB_SPIN_CAP (1u << 18)

__device__ __forceinline__ unsigned xb_ld(unsigned* p)              { return __hip_atomic_load(p, __ATOMIC_RELAXED, __HIP_MEMORY_SCOPE_AGENT); }
__device__ __forceinline__ unsigned xb_add(unsigned* p, unsigned v) { return __hip_atomic_fetch_add(p, v, __ATOMIC_RELAXED, __HIP_MEMORY_SCOPE_AGENT); }
__device__ __forceinline__ unsigned xb_xcc_id() { return (unsigned)__builtin_amdgcn_s_getreg((3 << 11) | 20) & 0xFu; }
#define XB_SPIN(cond, bar) do { unsigned _sp = 0; while (cond) { __builtin_amdgcn_s_sleep(1); \
    if ((++_sp & 255u) == 0u) { if (xb_ld(&(bar)[XB_TMO])) break; if (_sp > XB_SPIN_CAP) { atomicAdd(&(bar)[XB_TMO], 1u); break; } } } } while (0)

struct XcdBarrier {
    unsigned* bar; unsigned x;
    volatile LAS unsigned* st;
};
__device__ __forceinline__ XcdBarrier xcd_barrier_post(unsigned* bar, volatile LAS unsigned* st) {
    XcdBarrier b; b.bar = bar; b.x = xb_xcc_id(); b.st = st;
    if (threadIdx.x == 0) (void)xb_add(&bar[XB_XCNT(b.x)], 1u);
    return b;
}
__device__ __forceinline__ void xcd_barrier_complete(unsigned* bar, unsigned x, unsigned& nloc, unsigned& nx) {
    const unsigned G = gridDim.x * gridDim.y * gridDim.z;
    unsigned sum, cnt, mine, sp = 0u;
    for (;;) {
        sum = 0u; cnt = 0u; mine = 0u;
#pragma unroll
        for (unsigned j = 0; j < 16; ++j) { const unsigned c = xb_ld(&bar[XB_XCNT(j)]); sum += c; cnt += (c > 0u) ? 1u : 0u; mine = (j == x) ? c : mine; }
        if (sum == G) break;
        __builtin_amdgcn_s_sleep(1);
        if ((++sp & 255u) == 0u) { if (xb_ld(&bar[XB_TMO])) break; if (sp > XB_SPIN_CAP) { atomicAdd(&bar[XB_TMO], 1u); break; } }
    }
    nloc = mine > 0u ? mine : 1u; nx = cnt > 0u ? cnt : 1u;
}
__device__ __forceinline__ void xcd_barrier(const XcdBarrier& b) {
    asm volatile("s_waitcnt vmcnt(0)" ::: "memory");
    __syncthreads();
    if (threadIdx.x == 0) {
        unsigned* bar = b.bar;
        __builtin_amdgcn_s_waitcnt(0);
        unsigned nloc = b.st[0], nx = b.st[1];
        if (nloc == 0u) { xcd_barrier_complete(bar, b.x, nloc, nx); b.st[0] = nloc; b.st[1] = nx; }
        const unsigned old = xb_add(&bar[XB_XSUB(b.x)], 1u);
        const unsigned gen = old / nloc;
        if (old + 1u == (gen + 1u) * nloc) {
            __builtin_amdgcn_fence(__ATOMIC_RELEASE, "agent");
            asm volatile("s_waitcnt vmcnt(0)" ::: "memory");
            const unsigned og = xb_add(&bar[XB_TOP], 1u);
            const unsigned tg = og / nx;
            if (og + 1u == (tg + 1u) * nx) xb_add(&bar[XB_TOPGEN], 1u);
            else XB_SPIN(xb_ld(&bar[XB_TOPGEN]) == tg, bar);
            __builtin_amdgcn_fence(__ATOMIC_ACQUIRE, "agent");
            xb_add(&bar[XB_XGEN(b.x)], 1u);
            asm volatile("s_waitcnt vmcnt(0)" ::: "memory");
        } else {
            XB_SPIN(xb_ld(&bar[XB_XGEN(b.x)]) == gen, bar);
            __builtin_amdgcn_fence(__ATOMIC_ACQUIRE, "agent");
            asm volatile("s_waitcnt vmcnt(0)" ::: "memory");
        }
    }
    __syncthreads();
}

__device__ __forceinline__ float wave_sum(float v) {
#pragma unroll
    for (int o = 1; o < 64; o <<= 1) v += __shfl_xor(v, o);
    return v;
}
__device__ __forceinline__ float sum16(float v) {
    v += __shfl_xor(v, 1); v += __shfl_xor(v, 2); v += __shfl_xor(v, 4); v += __shfl_xor(v, 8); return v;
}
__device__ __forceinline__ void transpose_item(const float* W, int K, int ldw, int n_begin, int nblk, bf16* WT, int row_off, LAS float* scr, int item, int lane) {
    const int kb = item / nblk, nb = item % nblk, k0 = 64 * kb, n0 = 32 * nb;
    float wv[32];
#pragma unroll
    for (int i = 0; i < 32; ++i) wv[i] = ((const GAS float*)W)[(size_t)(k0 + 2 * i + (lane >> 5)) * ldw + n_begin + n0 + (lane & 31)];
#pragma unroll
    for (int i = 0; i < 32; ++i) scr[(2 * i + (lane >> 5)) * 33 + (lane & 31)] = wv[i];
    LDS_WAIT(); asm volatile("" ::: "memory");
    const int c = lane & 7;
#pragma unroll
    for (int j = 0; j < 4; ++j) { const int n = (lane >> 3) + 8 * j; const LAS float* s = scr + (8 * c) * 33 + n;
        v4u o; o.x = pk2(s[0 * 33], s[1 * 33]); o.y = pk2(s[2 * 33], s[3 * 33]); o.z = pk2(s[4 * 33], s[5 * 33]); o.w = pk2(s[6 * 33], s[7 * 33]);
        *(GAS v4u*)(WT + (size_t)(row_off + n0 + n) * K + k0 + 8 * c) = o; }
    LDS_WAIT(); asm volatile("" ::: "memory");
}
__device__ __forceinline__ void convert_w(LAS unsigned char* lds, int gw, int NGW, int wave, int lane, const float* W, int K, int ldw, int n_begin, int ncols, bf16* WT, int row_off) {
    LAS float* scr = (LAS float*)(lds + RING_OFF + wave * 16384);
    const int nblk = ncols / 32, nitems = (K / 64) * nblk;
    for (int it = gw; it < nitems; it += NGW) transpose_item(W, K, ldw, n_begin, nblk, WT, row_off, scr, it, lane);
}
__device__ __forceinline__ void row_to_bf16(const float* xrow, bf16* orow, int lane) {
    const GAS f32x4* xr = (const GAS f32x4*)xrow + lane; GAS v2u* o8 = (GAS v2u*)orow + lane;
#pragma unroll
    for (int j = 0; j < 8; ++j) { const f32x4 v = xr[64 * j]; v2u w; w.x = pk2(v.x, v.y); w.y = pk2(v.z, v.w); o8[64 * j] = w; }
}
__device__ __forceinline__ void ln_pass_b(const bf16* xb_in, const bf16* hb, const float* g, const float* b, bf16* xb_out, float* outf, float alpha, int gw, int NGW, int lane) {
    const GAS f32x4* gr = (const GAS f32x4*)g + 2 * lane; const GAS f32x4* br = (const GAS f32x4*)b + 2 * lane;
    for (int m = gw; m < MROWS; m += 2 * NGW) {
        const int m1 = (m + NGW < MROWS) ? m + NGW : m;
        const GAS v4u* x0 = (const GAS v4u*)(xb_in + (size_t)m * DMODEL) + lane; const GAS v4u* x1 = (const GAS v4u*)(xb_in + (size_t)m1 * DMODEL) + lane;
        const GAS v4u* h0 = (const GAS v4u*)(hb + (size_t)m * DMODEL) + lane;   const GAS v4u* h1 = (const GAS v4u*)(hb + (size_t)m1 * DMODEL) + lane;
        v4u xa[4], xc[4], ha[4], hc[4];
#pragma unroll
        for (int j = 0; j < 4; ++j) { xa[j] = x0[64 * j]; xc[j] = x1[64 * j]; ha[j] = h0[64 * j]; hc[j] = h1[64 * j]; }
        float y0[32], y1[32]; float s0 = 0.f, s1 = 0.f;
#pragma unroll
        for (int j = 0; j < 4; ++j)
#pragma unroll
            for (int k = 0; k < 4; ++k) { y0[8 * j + 2 * k] = alpha * bflo(xa[j][k]) + bflo(ha[j][k]); y0[8 * j + 2 * k + 1] = alpha * bfhi(xa[j][k]) + bfhi(ha[j][k]);
                                          y1[8 * j + 2 * k] = alpha * bflo(xc[j][k]) + bflo(hc[j][k]); y1[8 * j + 2 * k + 1] = alpha * bfhi(xc[j][k]) + bfhi(hc[j][k]); }
#pragma unroll
        for (int k = 0; k < 32; ++k) { s0 += y0[k]; s1 += y1[k]; }
#pragma unroll
        for (int o = 1; o < 64; o <<= 1) { s0 += __shfl_xor(s0, o); s1 += __shfl_xor(s1, o); }
        const float mean0 = s0 * (1.f / DMODEL), mean1 = s1 * (1.f / DMODEL); float q0 = 0.f, q1 = 0.f;
#pragma unroll
        for (int k = 0; k < 32; ++k) { y0[k] -= mean0; y1[k] -= mean1; q0 += y0[k] * y0[k]; q1 += y1[k] * y1[k]; }
#pragma unroll
        for (int o = 1; o < 64; o <<= 1) { q0 += __shfl_xor(q0, o); q1 += __shfl_xor(q1, o); }
        const float rs0 = 1.f / sqrtf(q0 * (1.f / DMODEL) + LN_EPS), rs1 = 1.f / sqrtf(q1 * (1.f / DMODEL) + LN_EPS);
#pragma unroll
        for (int j = 0; j < 4; ++j) { const f32x4 ga = gr[128 * j], gb = gr[128 * j + 1], ba = br[128 * j], bb = br[128 * j + 1];
            float o0[8], o1[8];
#pragma unroll
            for (int k = 0; k < 8; ++k) { const float gg = k < 4 ? ga[k] : gb[k - 4], bv = k < 4 ? ba[k] : bb[k - 4]; o0[k] = y0[8 * j + k] * rs0 * gg + bv; o1[k] = y1[8 * j + k] * rs1 * gg + bv; }
            if (xb_out) { v4u w0, w1; w0.x = pk2(o0[0], o0[1]); w0.y = pk2(o0[2], o0[3]); w0.z = pk2(o0[4], o0[5]); w0.w = pk2(o0[6], o0[7]); w1.x = pk2(o1[0], o1[1]); w1.y = pk2(o1[2], o1[3]); w1.z = pk2(o1[4], o1[5]); w1.w = pk2(o1[6], o1[7]);
                ((GAS v4u*)(xb_out + (size_t)m * DMODEL) + lane)[64 * j] = w0; ((GAS v4u*)(xb_out + (size_t)m1 * DMODEL) + lane)[64 * j] = w1; }
            if (outf) { GAS f32x4* p0 = (GAS f32x4*)(outf + (size_t)m * DMODEL) + 2 * lane + 128 * j; GAS f32x4* p1 = (GAS f32x4*)(outf + (size_t)m1 * DMODEL) + 2 * lane + 128 * j;
                p0[0] = (f32x4){o0[0], o0[1], o0[2], o0[3]}; p0[1] = (f32x4){o0[4], o0[5], o0[6], o0[7]}; p1[0] = (f32x4){o1[0], o1[1], o1[2], o1[3]}; p1[1] = (f32x4){o1[4], o1[5], o1[6], o1[7]}; } }
    }
}
#define MFMA32(a, b, c) __builtin_amdgcn_mfma_f32_32x32x16_bf16((a), (b), (c), 0, 0, 0)

__device__ __forceinline__ void ba_proj(const bf16* xb, const bf16* wt  , const float* a_log, const float* dt_bias, float* beta, float* g, int gw, int NGW, int lane) {
    const int r32 = lane & 31, hi = lane >> 5;
    for (int wu = gw; wu < MROWS / 32; wu += NGW) {
        const GAS bf16* ap = (const GAS bf16*)xb + (size_t)(wu * 32 + r32) * DMODEL + 8 * hi; const GAS bf16* bp = (const GAS bf16*)wt + (size_t)(GDN_MAIN + r32) * DMODEL + 8 * hi;
        f32x16 acc = {};
#pragma unroll 1
        for (int s0 = 0; s0 < DMODEL / 16; s0 += 8) {
            bf16x8 a[8], b[8];
#pragma unroll
            for (int s = 0; s < 8; ++s) { a[s] = *(const GAS bf16x8*)(ap + (s0 + s) * 16); b[s] = *(const GAS bf16x8*)(bp + (s0 + s) * 16); }
#pragma unroll
            for (int s = 0; s < 8; ++s) acc = MFMA32(a[s], b[s], acc);
        }
        const int j = r32 & 15; const float al = -__expf(((const GAS float*)a_log)[j]), db = ((const GAS float*)dt_bias)[j]; GAS float* betag = (GAS float*)beta; GAS float* gg_ = (GAS float*)g;
#pragma unroll
        for (int r = 0; r < 16; ++r) { const int t = wu * 32 + (r & 3) + 8 * (r >> 2) + 4 * hi; const float v = acc[r];
            if (r32 < 16) betag[(size_t)t * 16 + j] = __builtin_amdgcn_rcpf(1.f + __expf(-v));
            else { const float z = v + db; const float sp = z > 20.f ? z : log1pf(__expf(z)); gg_[(size_t)t * 16 + j] = al * sp; } }
    }
}

#ifndef G2_SKIP
#define G2_SKIP 0
#endif
#ifndef PROBE_G2_NOSCAT
#define PROBE_G2_NOSCAT 0
#endif
typedef short bf16x4 __attribute__((ext_vector_type(4)));
#define MFMA16K16(a, b, c) __builtin_amdgcn_mfma_f32_16x16x16bf16_1k((a), (b), (c), 0, 0, 0)
constexpr int G2_TS = 136;
constexpr int G2_AS = 68, G2_ANS = 72, G2_US = 68;
constexpr int G2_A = 0, G2_GC = G2_A + 64 * G2_AS * 4, G2_BT = G2_GC + 256, G2_AN = G2_BT + 256, G2_TB = G2_AN + 64 * G2_ANS * 2, G2_Q = G2_TB + 2048, G2_K = G2_Q + 64 * G2_TS * 2, G2_V = G2_K + 64 * G2_TS * 2,
              G2_W = G2_V + 64 * G2_TS * 2, G2_END = G2_W + 64 * G2_TS * 2;
static_assert(G2_END <= RING_BYTES, "G2 LDS");
__device__ __forceinline__ bf16x4 pack4(f32x4 v) { v2u w; w.x = pk2(v[0], v[1]); w.y = pk2(v[2], v[3]); return __builtin_bit_cast(bf16x4, w); }
__device__ __forceinline__ void gdn_chunk_phase(LAS unsigned char* lds, bf16* p_, const bf16* halo_, const float* beta_, float* g_, bf16* wbuf_, bf16* attn_, const float* conv_w_, int vcu, int G, bf16* palt_ = nullptr) {
#define G2_ST(off) ((palt ? palt + ((size_t)(off) & 0x7ffffffull) : p + (size_t)(off)))
    int tid_ = threadIdx.x; asm volatile("" : "+v"(tid_));
    const int tid0 = tid_, lane0 = tid0 & 63, wid0 = __builtin_amdgcn_readfirstlane(tid0 >> 6);
    GAS bf16* const p = (GAS bf16*)p_; const GAS bf16* const halo = (const GAS bf16*)halo_; const GAS float* const beta = (const GAS float*)beta_; GAS float* const g = (GAS float*)g_;
    GAS bf16* const wbuf = (GAS bf16*)wbuf_; GAS bf16* const attn = (GAS bf16*)attn_; const GAS float* const conv_w = (const GAS float*)conv_w_; GAS bf16* const palt = (GAS bf16*)palt_;
    LAS bf16* Qs = (LAS bf16*)(lds + G2_Q); LAS bf16* Ks = (LAS bf16*)(lds + G2_K); LAS bf16* Vs = (LAS bf16*)(lds + G2_V); LAS bf16* Ws = (LAS bf16*)(lds + G2_W);
    LAS float* As = (LAS float*)(lds + G2_A); LAS float* gcs = (LAS float*)(lds + G2_GC); LAS float* bts = (LAS float*)(lds + G2_BT);
    LAS bf16* An = (LAS bf16*)(lds + G2_AN); LAS bf16* Tb = (LAS bf16*)(lds + G2_TB); LAS bf16* Us = (LAS bf16*)(lds + G2_A);
    asm volatile("" : "+v"(Qs), "+v"(Ks), "+v"(Vs), "+v"(Ws), "+v"(As), "+v"(gcs), "+v"(bts), "+v"(An), "+v"(Tb), "+v"(Us));
    v4u rawv[3][5]; float gpre = 0.f, bpre = 0.f;
#define G2_LOAD_RAW(uu, LN, WD) do { const int cg_ = (uu) >> 4, h_ = (uu) & 15, n_ = cg_ & 63; const size_t r0_ = (size_t)cg_ * 64; const int cgp_l = (LN) & 15, tA_l = 8 * (WD) + 2 * ((LN) >> 4); \
        _Pragma("unroll") for (int X = 0; X < 3; ++X) { const int col_ = X * 2048 + h_ * HD + 8 * cgp_l; \
            _Pragma("unroll") for (int rr = 0; rr < 5; ++rr) { const int rel = tA_l - 3 + rr; v4u v = {0u, 0u, 0u, 0u}; \
                if (rel >= 0) v = *(const GAS v4u*)(p + (r0_ + rel) * GDN_MAIN + col_); \
                else if (n_ > 0) v = *(const GAS v4u*)(halo + ((size_t)(cg_ - 1) * 3 + (rel + 3)) * CONVC + col_); \
                rawv[X][rr] = v; } } \
        if ((WD) == 0) { gpre = g[(r0_ + (LN)) * 16 + h_]; bpre = beta[(r0_ + (LN)) * 16 + h_]; } } while (0)
    if (vcu < NCG * NHEADS) G2_LOAD_RAW(vcu, lane0, wid0);
    for (int u = vcu; u < NCG * NHEADS; u += G) {
        const int cg = u >> 4, h = u & 15; const size_t row0 = (size_t)cg * 64;
        int tl_ = tid0; asm volatile("" : "+v"(tl_));
        const int tid = tl_, lane = tid & 63, wid = __builtin_amdgcn_readfirstlane(tid >> 6), r32 = lane & 31, hi = lane >> 5;
        {
            const int cgp = lane & 15, sub = lane >> 4, tA = 8 * wid + 2 * sub;
#pragma unroll
            for (int X = 0; X < 3; ++X) {
                const int col = X * 2048 + h * HD + 8 * cgp;
                float raw[5][8];
                asm volatile("" : "+v"(rawv[X][0]), "+v"(rawv[X][1]), "+v"(rawv[X][2]), "+v"(rawv[X][3]), "+v"(rawv[X][4]));
#pragma unroll
                for (int rr = 0; rr < 5; ++rr) { const v4u v = rawv[X][rr];
                    raw[rr][0] = bflo(v.x); raw[rr][1] = bfhi(v.x); raw[rr][2] = bflo(v.y); raw[rr][3] = bfhi(v.y); raw[rr][4] = bflo(v.z); raw[rr][5] = bfhi(v.z); raw[rr][6] = bflo(v.w); raw[rr][7] = bfhi(v.w); }
                float o0[8], o1[8];
#pragma unroll
                for (int c = 0; c < 8; ++c) { o0[c] = 0.f; o1[c] = 0.f; }
#pragma unroll
                for (int j = 0; j < 4; ++j) { const f32x4 wa = *(const GAS f32x4*)(conv_w + (size_t)j * CONVC + col), wb = *(const GAS f32x4*)(conv_w + (size_t)j * CONVC + col + 4);
#pragma unroll
                    for (int c = 0; c < 8; ++c) { const float w = c < 4 ? wa[c] : wb[c - 4]; o0[c] += w * raw[j][c]; o1[c] += w * raw[j + 1][c]; } }
                float s0 = 0.f, s1 = 0.f;
#pragma unroll
                for (int c = 0; c < 8; ++c) { o0[c] = silu_f(o0[c]); o1[c] = silu_f(o1[c]); s0 += o0[c] * o0[c]; s1 += o1[c] * o1[c]; }
                if (X < 2) { s0 = sum16(s0); s1 = sum16(s1); const float sc = X == 0 ? 0.08838834764831845f : 1.f; const float f0 = sc * __builtin_amdgcn_rsqf(s0 + GDN_EPS), f1 = sc * __builtin_amdgcn_rsqf(s1 + GDN_EPS);
#pragma unroll
                    for (int c = 0; c < 8; ++c) { o0[c] *= f0; o1[c] *= f1; } }
                LAS bf16* T = X == 0 ? Qs : (X == 1 ? Ks : Vs);
                v4u w0, w1; w0.x = pk2(o0[0], o0[1]); w0.y = pk2(o0[2], o0[3]); w0.z = pk2(o0[4], o0[5]); w0.w = pk2(o0[6], o0[7]);
                w1.x = pk2(o1[0], o1[1]); w1.y = pk2(o1[2], o1[3]); w1.z = pk2(o1[4], o1[5]); w1.w = pk2(o1[6], o1[7]);
                *(LAS v4u*)(T + tA * G2_TS + 8 * cgp) = w0; *(LAS v4u*)(T + (tA + 1) * G2_TS + 8 * cgp) = w1;
                asm volatile("" ::: "memory");
            }
            if (wid == 0) {
                float gv = gpre;
#pragma unroll
                for (int o = 1; o < 64; o <<= 1) { const float t = __shfl_up(gv, o); if (lane >= o) gv += t; }
                gcs[lane] = gv; bts[lane] = bpre; if (!palt) g[(row0 + lane) * 16 + h] = gv;
            }
        }
        __syncthreads();
        if (u + G < NCG * NHEADS) G2_LOAD_RAW(u + G, lane, wid);
        if (!((G2_SKIP & 4) && palt)) {
            const int rb = (wid >> 1) & 1, cb = wid & 1; const bool isA = wid < 4;
            f32x16 acc = {};
            if (!(rb == 0 && cb == 1)) {
                const LAS bf16* Ar = (isA ? Ks : Qs) + (32 * rb + r32) * G2_TS + 8 * hi; const LAS bf16* Br = Ks + (32 * cb + r32) * G2_TS + 8 * hi;
#pragma unroll
                for (int s = 0; s < 8; ++s) acc = MFMA32(*(const LAS bf16x8*)(Ar + 16 * s), *(const LAS bf16x8*)(Br + 16 * s), acc);
            }
            const int j = 32 * cb + r32; const float gj = gcs[j];
#pragma unroll
            for (int r = 0; r < 16; ++r) { const int i = 32 * rb + (r & 3) + 8 * (r >> 2) + 4 * hi; const float gi = gcs[i];
                if (isA) { const float d = (i > j) ? __expf(gi - gj) : 0.f; const float a = (i > j) ? bts[i] * acc[r] * d : 0.f; As[i * G2_AS + j] = a; An[i * G2_ANS + j] = (bf16)f2bf(-a); }
                else { const float d = (i >= j) ? __expf(gi - gj) : 0.f; Ws[i * G2_TS + j] = (bf16)f2bf((i >= j) ? acc[r] * d : 0.f); } }
        }
        __syncthreads();
        if (wid == 0 && !((G2_SKIP & 2) && palt)) {
            const int b = lane >> 4, c = lane & 15; float t[16];
            const LAS float* Ab = As + (16 * b) * G2_AS + 16 * b;
#pragma unroll
            for (int i = 0; i < 16; ++i) {
                float ti = (i == c) ? 1.f : 0.f;
#pragma unroll
                for (int j4 = 0; j4 < (i + 3) / 4; ++j4) { const f32x4 a = *(const LAS f32x4*)(Ab + i * G2_AS + 4 * j4);
#pragma unroll
                    for (int k = 0; k < 4; ++k) if (4 * j4 + k < i) ti -= a[k] * t[4 * j4 + k]; }
                t[i] = ti;
            }
#pragma unroll
            for (int i = 0; i < 16; ++i) Tb[b * 256 + i * 16 + c] = (bf16)f2bf(t[i]);
        } else if (wid < 5) {
            const int tt = tid - 64, cgp = tt & 15, r0 = tt >> 4;
            { GAS bf16* at = palt ? palt + (((size_t)u * 4096 + 0x4000000ull) & 0x7ffffffull) : attn + (size_t)u * 4096;
#pragma unroll
              for (int k = 0; k < 2; ++k) { const int pc = tt + 256 * k, i = pc >> 3, c8 = pc & 7; *(GAS v4u*)(at + i * 64 + 8 * c8) = *(const LAS v4u*)(Ws + i * G2_TS + 8 * c8); } }
#pragma unroll
            for (int r = 0; r < 4; ++r) { const int i = r0 + 16 * r; const float e = __expf(gcs[i]); const v4u v = *(const LAS v4u*)(Qs + i * G2_TS + 8 * cgp); v4u w;
                w.x = pk2(bflo(v.x) * e, bfhi(v.x) * e); w.y = pk2(bflo(v.y) * e, bfhi(v.y) * e); w.z = pk2(bflo(v.z) * e, bfhi(v.z) * e); w.w = pk2(bflo(v.w) * e, bfhi(v.w) * e);
                *(GAS v4u*)G2_ST((row0 + i) * GDN_MAIN + h * HD + 8 * cgp) = w; }
        } else {
            const float gl = gcs[63];
            for (int task = tid - 320; task < 256; task += 192) { const int dk = task & 127, th = task >> 7;
                GAS bf16* dst = G2_ST((row0 + (dk >> 1)) * GDN_MAIN + 2048 + h * HD + (dk & 1) * 64 + 32 * th);
#pragma unroll
                for (int q = 0; q < 4; ++q) { float v[8];
#pragma unroll
                    for (int k = 0; k < 8; ++k) { const int tk = 32 * th + 8 * q + k; v[k] = bf2f(Ks[tk * G2_TS + dk]) * __expf(gl - gcs[tk]); }
                    v4u w; w.x = pk2(v[0], v[1]); w.y = pk2(v[2], v[3]); w.z = pk2(v[4], v[5]); w.w = pk2(v[6], v[7]); if (!(PROBE_G2_NOSCAT && palt)) *(GAS v4u*)(dst + 8 * q) = w; else asm volatile("" :: "v"(w)); } }
        }
        __syncthreads();
        if (!((G2_SKIP & 1) && palt)) {
            const int nl = lane & 15, q = lane >> 4; const bool isK = wid >= 4;
            float rsc[16];
#pragma unroll
            for (int b = 0; b < 4; ++b)
#pragma unroll
                for (int r = 0; r < 4; ++r) { const int row = 16 * b + 4 * q + r; rsc[4 * b + r] = isK ? bts[row] * __expf(gcs[row]) : bts[row]; }
            bf16x4 Tq[4], Aq[6];
#pragma unroll
            for (int b = 0; b < 4; ++b) Tq[b] = *(const LAS bf16x4*)(Tb + b * 256 + nl * 16 + 4 * q);
            Aq[0] = *(const LAS bf16x4*)(An + (16 + nl) * G2_ANS + 4 * q);
            Aq[1] = *(const LAS bf16x4*)(An + (32 + nl) * G2_ANS + 4 * q);      Aq[2] = *(const LAS bf16x4*)(An + (32 + nl) * G2_ANS + 16 + 4 * q);
            Aq[3] = *(const LAS bf16x4*)(An + (48 + nl) * G2_ANS + 4 * q);      Aq[4] = *(const LAS bf16x4*)(An + (48 + nl) * G2_ANS + 16 + 4 * q);   Aq[5] = *(const LAS bf16x4*)(An + (48 + nl) * G2_ANS + 32 + 4 * q);
#pragma unroll
            for (int t = 0; t < 2; ++t) {
                const int cc = 32 * (wid & 3) + 16 * t + nl;
                const LAS bf16* src = (isK ? Ks : Vs) + cc;
                f32x4 R[4];
#pragma unroll
                for (int b = 0; b < 4; ++b)
#pragma unroll
                    for (int r = 0; r < 4; ++r) R[b][r] = rsc[4 * b + r] * bf2f(src[(16 * b + 4 * q + r) * G2_TS]);
                const f32x4 z4 = {0.f, 0.f, 0.f, 0.f};
                const f32x4 y0 = MFMA16K16(Tq[0], pack4(R[0]), z4); const bf16x4 y0b = pack4(y0);
                f32x4 c1 = MFMA16K16(Aq[0], y0b, R[1]);
                const f32x4 y1 = MFMA16K16(Tq[1], pack4(c1), z4); const bf16x4 y1b = pack4(y1);
                f32x4 c2 = MFMA16K16(Aq[1], y0b, R[2]); c2 = MFMA16K16(Aq[2], y1b, c2);
                const f32x4 y2 = MFMA16K16(Tq[2], pack4(c2), z4); const bf16x4 y2b = pack4(y2);
                f32x4 c3 = MFMA16K16(Aq[3], y0b, R[3]); c3 = MFMA16K16(Aq[4], y1b, c3); c3 = MFMA16K16(Aq[5], y2b, c3);
                const f32x4 y3 = MFMA16K16(Tq[3], pack4(c3), z4); const bf16x4 y3b = pack4(y3);
                if (!isK) {
                    LAS bf16* dst = Us + cc * G2_US + 4 * q;
                    *(LAS bf16x4*)(dst) = y0b; *(LAS bf16x4*)(dst + 16) = y1b; *(LAS bf16x4*)(dst + 32) = y2b; *(LAS bf16x4*)(dst + 48) = y3b;
                } else {
#pragma unroll
                    for (int r = 0; r < 4; ++r) { Ws[(4 * q + r) * G2_TS + cc] = (bf16)y0b[r]; Ws[(16 + 4 * q + r) * G2_TS + cc] = (bf16)y1b[r]; Ws[(32 + 4 * q + r) * G2_TS + cc] = (bf16)y2b[r]; Ws[(48 + 4 * q + r) * G2_TS + cc] = (bf16)y3b[r]; }
                }
            }
        }
        __syncthreads();
#pragma unroll
        for (int k = 0; k < 2; ++k) { const int pc = tid + 512 * k, dv = pc >> 3, c8 = pc & 7;
            const v2u lo = *(const LAS v2u*)(Us + dv * G2_US + 8 * c8), hi2 = *(const LAS v2u*)(Us + dv * G2_US + 8 * c8 + 4);
            *(GAS v4u*)G2_ST((row0 + (dv & 63)) * GDN_MAIN + 4096 + h * HD + (dv >> 6) * 64 + 8 * c8) = (v4u){lo.x, lo.y, hi2.x, hi2.y}; }
#pragma unroll
        for (int k = 0; k < 2; ++k) { const int ch = tid + 512 * k, i = ch >> 4, c8 = ch & 15; *(GAS v4u*)((palt ? palt + (((row0 + i) * DMODEL + h * HD + 8 * c8) & 0x7ffffffull) : wbuf + (row0 + i) * DMODEL + h * HD + 8 * c8)) = *(const LAS v4u*)(Ws + i * G2_TS + 8 * c8); }
    }
#undef G2_ST
#undef G2_LOAD_RAW
}

constexpr int G3_STS = 136, G3_VTS = 72;
constexpr int G3_ST = 0, G3_VT = G3_ST + 64 * G3_STS * 2, G3_OT = G3_VT + 64 * G3_VTS * 2, G3_WT = G3_OT + 64 * G3_VTS * 2, G3_QT = G3_WT + 64 * G3_STS * 2, G3_KT = G3_QT + 64 * G3_STS * 2,
              G3_PT = G3_KT + 128 * G3_VTS * 2, G3_UT = G3_PT + 64 * G3_VTS * 2, G3_END = G3_UT + 64 * G3_VTS * 2;
static_assert(G3_END <= RING_BYTES, "G3 LDS");
__device__ __forceinline__ void gdn_scan_phase(LAS unsigned char* lds, bf16* p_, const bf16* wbuf_, const bf16* attn_, const float* g_, int vcu, int G, bf16* oalt_ = nullptr) {
    GAS bf16* const p = (GAS bf16*)p_; const GAS bf16* const wbuf = (const GAS bf16*)wbuf_; const GAS bf16* const attn = (const GAS bf16*)attn_; const GAS float* const g = (const GAS float*)g_; GAS bf16* const oalt = (GAS bf16*)oalt_;
    int tid_ = threadIdx.x; asm volatile("" : "+v"(tid_));
    const int tid = tid_, lane = tid & 63, wid = __builtin_amdgcn_readfirstlane(tid >> 6), r32 = lane & 31, hi = lane >> 5;
    const int role = wid >> 2, a = (wid >> 1) & 1, bb = wid & 1, r = wid >> 1;
    LAS bf16* ST = (LAS bf16*)(lds + G3_ST); LAS bf16* VT = (LAS bf16*)(lds + G3_VT); LAS bf16* OT = (LAS bf16*)(lds + G3_OT);
    LAS bf16* WT = (LAS bf16*)(lds + G3_WT); LAS bf16* QT = (LAS bf16*)(lds + G3_QT); LAS bf16* KT = (LAS bf16*)(lds + G3_KT); LAS bf16* PT = (LAS bf16*)(lds + G3_PT); LAS bf16* UT = (LAS bf16*)(lds + G3_UT);
    for (int unit = vcu; unit < BATCH * NHEADS * 2; unit += G) {
        const int bh = unit >> 1, e = unit & 1, b = bh >> 4, h = bh & 15;
        for (int i = tid; i < G3_VT / 4; i += NWAVES * 64) ((LAS unsigned*)lds)[i] = 0u;
        f32x16 Sacc = {};
        const int r16a = tid >> 4, c16 = tid & 15, r8 = tid >> 3, c8 = tid & 7;
        const GAS bf16* gW = wbuf + (size_t)r16a * DMODEL + h * HD + 8 * c16;
        const GAS bf16* gQ = p + (size_t)r16a * GDN_MAIN + h * HD + 8 * c16;
        const GAS bf16* gK = p + (size_t)r16a * GDN_MAIN + 2048 + h * HD + 8 * c16;
        const GAS bf16* gP = attn + (size_t)r8 * 64 + 8 * c8;
        const GAS bf16* gU = p + (size_t)r8 * GDN_MAIN + 4096 + h * HD + e * 64 + 8 * c8;
        LAS bf16* sW = WT + r16a * G3_STS + 8 * c16; LAS bf16* sQ = QT + r16a * G3_STS + 8 * c16;
        LAS bf16* sK = KT + (2 * r16a + (c16 >> 3)) * G3_VTS + 8 * (c16 & 7);
        LAS bf16* sP = PT + r8 * G3_VTS + 8 * c8; LAS bf16* sU = UT + r8 * G3_VTS + 8 * c8;
        GAS bf16* oRow = (oalt ? oalt : p + 4096) + h * HD + e * 64; const size_t oPitch = oalt ? DMODEL : GDN_MAIN;
        const LAS bf16* aRd = (role == 0 ? WT : QT) + (32 * a + r32) * G3_STS + 8 * hi;
        const LAS bf16* sRd = ST + (32 * bb + r32) * G3_STS + 8 * hi; const LAS bf16* vRd = VT + (32 * bb + r32) * G3_VTS + 8 * hi;
        const LAS bf16* uRd = UT + (32 * bb + r32) * G3_VTS + 32 * a + 4 * hi; const LAS bf16* pRd = PT + (32 * a + r32) * G3_VTS + 8 * hi; const LAS bf16* kRd = KT + (32 * r + r32) * G3_VTS + 8 * hi;
        LAS bf16* vWr = VT + (32 * bb + r32) * G3_VTS + 32 * a + 4 * hi; LAS bf16* sWr = ST + (32 * bb + r32) * G3_STS + 32 * r + 4 * hi;
        v4u gw0, gw1, gq0, gq1, gk0, gk1, gp0, gu0; float dd;
#define G3_LOAD(nn) do { const size_t row0_ = (size_t)b * SEQ + (size_t)(nn) * 64; \
            gw0 = *(const GAS v4u*)(gW + row0_ * DMODEL); gw1 = *(const GAS v4u*)(gW + (row0_ + 32) * DMODEL); \
            gq0 = *(const GAS v4u*)(gQ + row0_ * GDN_MAIN); gq1 = *(const GAS v4u*)(gQ + (row0_ + 32) * GDN_MAIN); \
            gk0 = *(const GAS v4u*)(gK + row0_ * GDN_MAIN); gk1 = *(const GAS v4u*)(gK + (row0_ + 32) * GDN_MAIN); \
            gp0 = *(const GAS v4u*)(gP + ((size_t)(b * 64 + (nn)) * 16 + h) * 4096); gu0 = *(const GAS v4u*)(gU + row0_ * GDN_MAIN); \
            dd = __expf(g[(row0_ + 63) * 16 + h]); } while (0)
        G3_LOAD(0);
        __syncthreads();
#pragma unroll 1
        for (int n = 0; n < 64; ++n) {
            const size_t row0_ = (size_t)b * SEQ + (size_t)n * 64; const int nn = (n + 1 < 64) ? n + 1 : n;
            *(LAS v4u*)(sW) = gw0; *(LAS v4u*)(sW + 32 * G3_STS) = gw1; *(LAS v4u*)(sQ) = gq0; *(LAS v4u*)(sQ + 32 * G3_STS) = gq1;
            *(LAS v4u*)(sK) = gk0; *(LAS v4u*)(sK + 64 * G3_VTS) = gk1; *(LAS v4u*)(sP) = gp0; *(LAS v4u*)(sU) = gu0;
            const float dcur = dd;
            WG_BAR();
            G3_LOAD(nn);
            f32x16 acc_ = {};
#pragma unroll
            for (int s = 0; s < 8; ++s) acc_ = MFMA32(*(const LAS bf16x8*)(aRd + 16 * s), *(const LAS bf16x8*)(sRd + 16 * s), acc_);
            if (role == 0) {
#pragma unroll
                for (int q = 0; q < 4; ++q) { const v2u uu = *(const LAS v2u*)(uRd + 8 * q); v2u w_;
                    w_.x = pk2(bflo(uu.x) - acc_[4 * q], bfhi(uu.x) - acc_[4 * q + 1]); w_.y = pk2(bflo(uu.y) - acc_[4 * q + 2], bfhi(uu.y) - acc_[4 * q + 3]);
                    *(LAS v2u*)(vWr + 8 * q) = w_; }
            }
            WG_BAR();
            bf16x8 Vf_[4];
#pragma unroll
            for (int s = 0; s < 4; ++s) Vf_[s] = *(const LAS bf16x8*)(vRd + 16 * s);
            if (role == 1) {
#pragma unroll
                for (int s = 0; s < 4; ++s) acc_ = MFMA32(*(const LAS bf16x8*)(pRd + 16 * s), Vf_[s], acc_);
#pragma unroll
                for (int rr = 0; rr < 16; ++rr) OT[(32 * a + (rr & 3) + 8 * (rr >> 2) + 4 * hi) * G3_VTS + 32 * bb + r32] = (bf16)f2bf(acc_[rr]);
            }
            Sacc = Sacc * dcur;
#pragma unroll
            for (int s = 0; s < 4; ++s) Sacc = MFMA32(*(const LAS bf16x8*)(kRd + 16 * s), Vf_[s], Sacc);
#pragma unroll
            for (int q = 0; q < 4; ++q) { v2u w_; w_.x = pk2(Sacc[4 * q], Sacc[4 * q + 1]); w_.y = pk2(Sacc[4 * q + 2], Sacc[4 * q + 3]); *(LAS v2u*)(sWr + 8 * q) = w_; }
            WG_BAR();
            *(GAS v4u*)(oRow + (row0_ + r8) * oPitch + 8 * c8) = *(const LAS v4u*)(OT + r8 * G3_VTS + 8 * c8);
        }
#undef G3_LOAD
        VM_WAIT(); __syncthreads();
    }
}

__device__ __forceinline__ void gdn_gate_phase(bf16* p, const float* norm_w, int gw, int NGW, int lane, bf16* oalt = nullptr) {
    for (int m = gw; m < MROWS; m += NGW) {
        GAS bf16* orow = (GAS bf16*)p + (size_t)m * GDN_MAIN + 4096; const GAS bf16* zrow = (const GAS bf16*)p + (size_t)m * GDN_MAIN + 6144;
#pragma unroll
        for (int it = 0; it < 4; ++it) { const int col = it * 512 + lane * 8;
            const v4u ov = *(const GAS v4u*)(orow + col), zv = *(const GAS v4u*)(zrow + col);
            float o[8] = {bflo(ov.x), bfhi(ov.x), bflo(ov.y), bfhi(ov.y), bflo(ov.z), bfhi(ov.z), bflo(ov.w), bfhi(ov.w)};
            float z[8] = {bflo(zv.x), bfhi(zv.x), bflo(zv.y), bfhi(zv.y), bflo(zv.z), bfhi(zv.z), bflo(zv.w), bfhi(zv.w)};
            float s = 0.f;
#pragma unroll
            for (int c = 0; c < 8; ++c) s += o[c] * o[c];
            s = sum16(s); const float rs = __builtin_amdgcn_rsqf(s * (1.f / HD) + GDN_EPS);
            const f32x4 wa = *(const GAS f32x4*)((const GAS float*)norm_w + (col & 127)), wb = *(const GAS f32x4*)((const GAS float*)norm_w + (col & 127) + 4);
#pragma unroll
            for (int c = 0; c < 8; ++c) o[c] = o[c] * rs * (c < 4 ? wa[c] : wb[c - 4]) * silu_f(z[c]);
            v4u w; w.x = pk2(o[0], o[1]); w.y = pk2(o[2], o[3]); w.z = pk2(o[4], o[5]); w.w = pk2(o[6], o[7]); *(GAS v4u*)((oalt ? (GAS bf16*)oalt + (size_t)m * DMODEL : orow) + col) = w; }
    }
}

#ifndef PG8_SP2
#define PG8_SP2 true
#endif
#ifndef PG8_ALIGN
#define PG8_ALIGN true
#endif
#ifndef EN_P0
#define EN_P0 1
#endif
#ifndef EN_G1
#define EN_G1 1
#endif
#ifndef EN_G2
#define EN_G2 1
#endif
#ifndef EN_G3
#define EN_G3 1
#endif
#ifndef EN_G4
#define EN_G4 1
#endif
#ifndef EN_G5
#define EN_G5 1
#endif
#ifndef EN_G6
#define EN_G6 1
#endif
#ifndef EN_G7
#define EN_G7 1
#endif
#ifndef EN_G8
#define EN_G8 1
#endif
#ifndef EN_G9
#define EN_G9 1
#endif
#ifndef EN_D1
#define EN_D1 1
#endif
#ifndef EN_D2
#define EN_D2 1
#endif
#ifndef EN_D3
#define EN_D3 1
#endif
#ifndef EN_D4
#define EN_D4 1
#endif
#ifndef EN_D5
#define EN_D5 1
#endif
#ifndef EN_D6U
#define EN_D6U 1
#endif
#ifndef EN_D6D
#define EN_D6D 1
#endif
#ifndef EN_D7
#define EN_D7 1
#endif
#ifndef REP_P0
#define REP_P0 1
#endif
#ifndef REP_G1
#define REP_G1 1
#endif
#ifndef REP_G2
#define REP_G2 1
#endif
#ifndef REP_G3
#define REP_G3 1
#endif
#ifndef REP_G4
#define REP_G4 1
#endif
#ifndef REP_G5
#define REP_G5 1
#endif
#ifndef REP_G6
#define REP_G6 1
#endif
#ifndef REP_G7
#define REP_G7 1
#endif
#ifndef REP_G8
#define REP_G8 1
#endif
#ifndef REP_G9
#define REP_G9 1
#endif
#ifndef REP_D1
#define REP_D1 1
#endif
#ifndef REP_D2
#define REP_D2 1
#endif
#ifndef REP_D3
#define REP_D3 1
#endif
#ifndef REP_D4
#define REP_D4 1
#endif
#ifndef REP_D5
#define REP_D5 1
#endif
#ifndef REP_D6U
#define REP_D6U 1
#endif
#ifndef REP_D6D
#define REP_D6D 1
#endif
#ifndef REP_D7
#define REP_D7 1
#endif
#ifndef REP_BA
#define REP_BA 1
#endif
#ifndef PROBE_NOSTORE
#define PROBE_NOSTORE 0
#endif
struct Args { const float* in[16]; float* out; unsigned char* ws; int ph_lo, ph_hi; };
__global__ void __launch_bounds__(NWAVES * 64, 2) yoco_fwd(Args args) {
    extern __shared__ __attribute__((aligned(16))) unsigned char lds_raw[];
    LAS unsigned char* lds = (LAS unsigned char*)lds_raw;
    volatile LAS unsigned* MISC = (volatile LAS unsigned*)(lds + MISC_OFF);
    const int tid = threadIdx.x, lane = tid & 63, wave = __builtin_amdgcn_readfirstlane(tid >> 6);
    const int G = gridDim.x, bx = blockIdx.x, vcu = (G % 8 == 0) ? (bx % 8) * (G / 8) + bx / 8 : bx;
    const int gw = vcu * NWAVES + wave, NGW = G * NWAVES, gtid = vcu * NWAVES * 64 + tid, NGT = G * NWAVES * 64;
    const float* ln_g = args.in[14]; const float* ln_b = args.in[15];
    for (int u = tid; u < (LDS_BYTES - LDSCTL_OFF) / 4; u += NWAVES * 64) ((LAS unsigned*)(lds + LDSCTL_OFF))[u] = 0u;
    __syncthreads();
    XcdBarrier bar; bar.bar = (unsigned*)(args.ws + WS_CTL) + CW_BAR; bar.x = 0; bar.st = nullptr;
    if (!MK_PER_PHASE) bar = xcd_barrier_post((unsigned*)(args.ws + WS_CTL) + CW_BAR, MISC + 8);
    const int lo = args.ph_lo, hi = args.ph_hi;
#define IN(k) (lo <= (k) && (k) < hi)
#define FRESH_LANE() int ln_ = lane; asm volatile("" : "+v"(ln_)); unsigned char* ws_ = args.ws; asm volatile("" : "+s"(ws_)); int gw_ = gw, vcu_ = vcu, bx_ = bx; asm volatile("" : "+s"(gw_), "+s"(vcu_), "+s"(bx_))
#define x_in         (args.in[0])
#define gdn_w_in     (args.in[1])
#define gdn_conv_w   (args.in[2])
#define gdn_a_log    (args.in[3])
#define gdn_dt_bias  (args.in[4])
#define gdn_norm_w   (args.in[5])
#define gdn_w_out    (args.in[6])
#define diff_w_q     (args.in[7])
#define diff_lambda  (args.in[8])
#define diff_subln_w (args.in[9])
#define diff_w_o     (args.in[10])
#define shared_w_kv  (args.in[11])
#define mlp_w_up     (args.in[12])
#define mlp_w_down   (args.in[13])
#define beta  ((float*)(ws_ + WS_BETA))
#define gdec  ((float*)(ws_ + WS_G))
#define halo  ((bf16*)(ws_ + WS_HALO))
#define WA    ((bf16*)(ws_ + WS_WA))
#define WB    ((bf16*)(ws_ + WS_WB))
#define attnb ((bf16*)(ws_ + WS_ATTN))
#define XB    ((bf16*)(ws_ + WS_XB))
#define HB    ((bf16*)(ws_ + WS_Y))
#define WBUF  ((bf16*)(ws_ + WS_Y + QTR))
#define R1    ((bf16*)(ws_ + WS_R1))
#define Kb    (R1)
#define Vb    (R1 + QTR / 2)
#define Qb    (R1 + 2 * (QTR / 2))
#define HID   (Qb)
#define SEAM(k) do { if (!MK_PER_PHASE && (k) + 1 < hi) xcd_barrier(bar); } while (0)

    for (int rep_ = 0; rep_ < REP_P0; ++rep_) if (EN_P0 && IN(0)) { FRESH_LANE();
        for (int m = gw_; m < MROWS; m += NGW) row_to_bf16(x_in + (size_t)m * DMODEL, XB + (size_t)m * DMODEL, ln_);
        convert_w(lds, gw_, NGW, wave, ln_, gdn_w_in, DMODEL, GDN_PROJ, 0, GDN_PROJ, WA, 0);
        SEAM(0);
    }
    for (int l = 0; l < 2; ++l) {
        const int pb = 1 + 9 * l;
        for (int rep_ = 0; rep_ < REP_G1; ++rep_) if (EN_G1 && IN(pb + 0)) { FRESH_LANE();
            pg8::Gemm g{XB, WA, MROWS, GDN_MAIN, DMODEL, DMODEL}; pg8::StaticOrder S; S.init(MROWS, GDN_MAIN, G, bx_);
            pg8::EpiStore<0> E{R1, GDN_MAIN, 0, 0, -1, 1.f, halo};
            pg8::gemm_phase<pg8::EpiStore<0>, pg8::StaticOrder, PG8_ALIGN, PG8_SP2>(lds + RING_OFF, g, S, E);
            { int ln2_ = lane; asm volatile("" : "+v"(ln2_));
              for (int rb_ = 0; rb_ < REP_BA; ++rb_) ba_proj(XB, WA, gdn_a_log + l * 16, gdn_dt_bias + l * 16, beta, gdec, gw_, NGW, ln2_); }
            SEAM(pb + 0);
        }
        for (int rep_ = 0; rep_ < REP_G2; ++rep_) if (EN_G2 && IN(pb + 1)) { FRESH_LANE(); gdn_chunk_phase(lds, R1, halo, beta, gdec, WBUF, attnb, gdn_conv_w + (size_t)l * 4 * CONVC, vcu_, G, (rep_ + 1 < REP_G2) ? (bf16*)args.out : nullptr); SEAM(pb + 1); }
        for (int rep_ = 0; rep_ < REP_G3; ++rep_) if (EN_G3 && IN(pb + 2)) { FRESH_LANE(); gdn_scan_phase(lds, R1, WBUF, attnb, gdec, vcu_, G, (rep_ + 1 < REP_G3) ? (bf16*)args.out : nullptr); SEAM(pb + 2); }
        for (int rep_ = 0; rep_ < REP_G4; ++rep_) if (EN_G4 && IN(pb + 3)) { FRESH_LANE();
            gdn_gate_phase(R1, gdn_norm_w + l * HD, gw_, NGW, ln_, (rep_ + 1 < REP_G4) ? (bf16*)args.out : nullptr);
            convert_w(lds, gw_, NGW, wave, ln_, gdn_w_out + (size_t)l * DMODEL * DMODEL, DMODEL, DMODEL, 0, DMODEL, WA, 0);
            convert_w(lds, gw_, NGW, wave, ln_, mlp_w_up + (size_t)l * DMODEL * DFF, DMODEL, DFF, 0, DFF, WB, 0);
            SEAM(pb + 3);
        }
        for (int rep_ = 0; rep_ < REP_G5; ++rep_) if (EN_G5 && IN(pb + 4)) { FRESH_LANE();
            pg8::Gemm g{R1 + 4096, WA, MROWS, DMODEL, DMODEL, GDN_MAIN}; pg8::StaticOrder S; S.init(MROWS, DMODEL, G, bx_);
            pg8::EpiStore<0> E{(rep_ + 1 < REP_G5) ? (bf16*)args.out : HB, DMODEL, 0, 0, -1, 1.f, nullptr};
            pg8::gemm_phase<pg8::EpiStore<0>, pg8::StaticOrder, PG8_ALIGN, PG8_SP2>(lds + RING_OFF, g, S, E);
            SEAM(pb + 4);
        }
        const float* g1 = ln_g + (size_t)(l * 2) * DMODEL; const float* b1 = ln_b + (size_t)(l * 2) * DMODEL;
        for (int rep_ = 0; rep_ < REP_G6; ++rep_) if (EN_G6 && IN(pb + 5)) { FRESH_LANE();
            ln_pass_b(XB, HB, g1, b1, XB, nullptr, ALPHA_RES, gw_, NGW, ln_);
            convert_w(lds, gw_, NGW, wave, ln_, mlp_w_down + (size_t)l * DFF * DMODEL, DFF, DMODEL, 0, DMODEL, WA, 0);
            SEAM(pb + 5);
        }
        for (int rep_ = 0; rep_ < REP_G7; ++rep_) if (EN_G7 && IN(pb + 6)) { FRESH_LANE();
            pg8::Gemm g{XB, WB, MROWS, DFF, DMODEL, DMODEL}; pg8::StaticOrder S; S.init(MROWS, DFF, G, bx_);
            pg8::EpiStore<1> E{R1, DFF, 0, 0, -1, 1.f, nullptr};
            pg8::gemm_phase<pg8::EpiStore<1>, pg8::StaticOrder, PG8_ALIGN, PG8_SP2>(lds + RING_OFF, g, S, E);
            SEAM(pb + 6);
        }
        for (int rep_ = 0; rep_ < REP_G8; ++rep_) if (EN_G8 && IN(pb + 7)) { FRESH_LANE();
            pg8::Gemm g{R1, WA, MROWS, DMODEL, DFF, DFF}; pg8::StaticOrder S; S.init(MROWS, DMODEL, G, bx_);
            pg8::EpiStore<0> E{(rep_ + 1 < REP_G8) ? (bf16*)args.out : HB, DMODEL, 0, 0, -1, 1.f, nullptr};
            pg8::gemm_phase<pg8::EpiStore<0>, pg8::StaticOrder, PG8_ALIGN, PG8_SP2>(lds + RING_OFF, g, S, E);
            SEAM(pb + 7);
        }
        for (int rep_ = 0; rep_ < REP_G9; ++rep_) if (EN_G9 && IN(pb + 8)) { FRESH_LANE();
            const float* g2 = ln_g + (size_t)(l * 2 + 1) * DMODEL; const float* b2 = ln_b + (size_t)(l * 2 + 1) * DMODEL;
            ln_pass_b(XB, HB, g2, b2, XB, nullptr, ALPHA_RES, gw_, NGW, ln_);
            if (l == 0) convert_w(lds, gw_, NGW, wave, ln_, gdn_w_in + (size_t)DMODEL * GDN_PROJ, DMODEL, GDN_PROJ, 0, GDN_PROJ, WA, 0);
            else { convert_w(lds, gw_, NGW, wave, ln_, shared_w_kv, DMODEL, 2 * DMODEL, 0, 2 * DMODEL, WA, 0);
                   convert_w(lds, gw_, NGW, wave, ln_, diff_w_q, DMODEL, DMODEL, 0, DMODEL, WA, 2 * DMODEL); }
            SEAM(pb + 8);
        }
    }
    for (int j = 0; j < 2; ++j) {
        const int pb = 19 + 10 * j, L = 2 + j;
        for (int rep_ = 0; rep_ < REP_D1; ++rep_) if (EN_D1 && IN(pb + 0)) { FRESH_LANE();
            const int N = (j == 0) ? 3 * DMODEL : DMODEL;
            pg8::Gemm g{XB, WA, MROWS, N, DMODEL, DMODEL}; pg8::StaticOrder S; S.init(MROWS, N, G, bx_);
            pg8::EpiStore<0> E{(j == 0) ? Kb : Qb, DMODEL, (j == 0) ? DMODEL : 0, QTR / 2, (j == 0) ? 2 : 0, dattn::C2, nullptr};
            pg8::gemm_phase<pg8::EpiStore<0>, pg8::StaticOrder, PG8_ALIGN, PG8_SP2>(lds + RING_OFF, g, S, E);
            SEAM(pb + 0);
        }
        for (int rep_ = 0; rep_ < REP_D2; ++rep_) if (EN_D2 && IN(pb + 1)) { FRESH_LANE();
            const float lambda_init = 0.8f - 0.6f * expf(-0.3f * (float)L);
            const float* lp = diff_lambda + (size_t)j * 256;
            const float e1 = wave_sum(lp[ln_] * lp[64 + ln_]), e2 = wave_sum(lp[128 + ln_] * lp[192 + ln_]);
            const dattn::Params AP{(const dattn::bf16*)Qb, (const dattn::bf16*)Kb, (const dattn::bf16*)Vb, (rep_ + 1 < REP_D2) ? (dattn::bf16*)args.out : (dattn::bf16*)Qb, diff_subln_w + j * HD, __expf(e1) - __expf(e2) + lambda_init, 1.f - lambda_init};
            dattn::phase<8>((char*)lds_raw + RING_OFF, AP, G, bx_);
            { int ln2_ = lane; asm volatile("" : "+v"(ln2_));
              convert_w(lds, gw_, NGW, wave, ln2_, diff_w_o + (size_t)j * DMODEL * DMODEL, DMODEL, DMODEL, 0, DMODEL, WB, 0);
              convert_w(lds, gw_, NGW, wave, ln2_, mlp_w_up + (size_t)L * DMODEL * DFF, DMODEL, DFF, 0, DFF, WA, 0); }
            SEAM(pb + 1);
        }
        for (int rep_ = 0; rep_ < REP_D4; ++rep_) if (EN_D4 && IN(pb + 3)) { FRESH_LANE();
            pg8::Gemm g{Qb, WB, MROWS, DMODEL, DMODEL, DMODEL}; pg8::StaticOrder S; S.init(MROWS, DMODEL, G, bx_);
            pg8::EpiStore<0> E{(rep_ + 1 < REP_D4) ? (bf16*)args.out : HB, DMODEL, 0, 0, -1, 1.f, nullptr};
            pg8::gemm_phase<pg8::EpiStore<0>, pg8::StaticOrder, PG8_ALIGN, PG8_SP2>(lds + RING_OFF, g, S, E);
            SEAM(pb + 3);
        }
        const float* g1 = ln_g + (size_t)(L * 2) * DMODEL; const float* b1 = ln_b + (size_t)(L * 2) * DMODEL;
        for (int rep_ = 0; rep_ < REP_D5; ++rep_) if (EN_D5 && IN(pb + 4)) { FRESH_LANE();
            ln_pass_b(XB, HB, g1, b1, XB, nullptr, ALPHA_RES, gw_, NGW, ln_);
            convert_w(lds, gw_, NGW, wave, ln_, mlp_w_down + (size_t)L * DFF * DMODEL, DFF, DMODEL, 0, DMODEL, WB, 0);
            SEAM(pb + 4);
        }
        for (int hf = 0; hf < 2; ++hf) {
            const size_t roff = (size_t)hf * (MROWS / 2);
            for (int rep_ = 0; rep_ < REP_D6U; ++rep_) if (EN_D6U && IN(pb + 5 + 2 * hf)) { FRESH_LANE();
                pg8::Gemm g{XB + roff * DMODEL, WA, MROWS / 2, DFF, DMODEL, DMODEL}; pg8::StaticOrder S; S.init(MROWS / 2, DFF, G, bx_);
                pg8::EpiStore<1> E{(PROBE_NOSTORE && rep_ + 1 < REP_D6U) ? (bf16*)nullptr : HID, DFF, 0, 0, -1, 1.f, nullptr};
                pg8::gemm_phase<pg8::EpiStore<1>, pg8::StaticOrder, PG8_ALIGN, PG8_SP2>(lds + RING_OFF, g, S, E);
                SEAM(pb + 5 + 2 * hf);
            }
            for (int rep_ = 0; rep_ < REP_D6D; ++rep_) if (EN_D6D && IN(pb + 6 + 2 * hf)) { FRESH_LANE();
                pg8::Gemm g{HID, WB, MROWS / 2, DMODEL, DFF, DFF}; pg8::StaticOrder S; S.init(MROWS / 2, DMODEL, G, bx_);
                pg8::EpiStore<0> E{((rep_ + 1 < REP_D6D) ? (bf16*)args.out : HB) + roff * DMODEL, DMODEL, 0, 0, -1, 1.f, nullptr};
                pg8::gemm_phase<pg8::EpiStore<0>, pg8::StaticOrder, PG8_ALIGN, PG8_SP2>(lds + RING_OFF, g, S, E);
                SEAM(pb + 6 + 2 * hf);
            }
        }
        for (int rep_ = 0; rep_ < REP_D7; ++rep_) if (EN_D7 && IN(pb + 9)) { FRESH_LANE();
            const float* g2 = ln_g + (size_t)(L * 2 + 1) * DMODEL; const float* b2 = ln_b + (size_t)(L * 2 + 1) * DMODEL;
            if (j == 0) { ln_pass_b(XB, HB, g2, b2, XB, nullptr, ALPHA_RES, gw_, NGW, ln_);
                          convert_w(lds, gw_, NGW, wave, ln_, diff_w_q + (size_t)DMODEL * DMODEL, DMODEL, DMODEL, 0, DMODEL, WA, 0); }
            else { ln_pass_b(XB, HB, g2, b2, nullptr, args.out, ALPHA_RES, gw_, NGW, ln_); }
            SEAM(pb + 9);
        }
    }
#undef IN
#undef SEAM
}

extern "C" void kernel_launch(void* const* d_in, const int* in_sizes, int n_in, void* d_out, int out_size, void* d_ws, size_t ws_size, hipStream_t stream) {
    static int grid = 0;
    if (grid == 0) {
        if (n_in != 16 || in_sizes[0] != MROWS * DMODEL || out_size != MROWS * DMODEL || ws_size < WS_END) { fprintf(stderr, "kernel_launch: unexpected shapes / workspace (n_in %d, ws %zu < %zu); nothing launched\n", n_in, ws_size, (size_t)WS_END); grid = -1; return; }
        int dev = 0, cus = 0, per_cu = 0;
        if (hipGetDevice(&dev) != hipSuccess || hipDeviceGetAttribute(&cus, hipDeviceAttributeMultiprocessorCount, dev) != hipSuccess) { grid = -1; return; }
        if (hipFuncSetAttribute((const void*)yoco_fwd, hipFuncAttributeMaxDynamicSharedMemorySize, LDS_BYTES) != hipSuccess) { fprintf(stderr, "kernel_launch: hipFuncSetAttribute failed\n"); grid = -1; return; }
        if (hipOccupancyMaxActiveBlocksPerMultiprocessor(&per_cu, (const void*)yoco_fwd, NWAVES * 64, LDS_BYTES) != hipSuccess || per_cu < 1)
            fprintf(stderr, "kernel_launch: note: occupancy query reports %d workgroups per CU\n", per_cu);
        (void)hipGetLastError();
        grid = cus;
    }
    if (grid < 0) return;
    if (hipMemsetAsync((char*)d_ws + WS_CTL, 0, CTL_ZERO_BYTES, stream) != hipSuccess) return;
    Args a{};
    for (int i = 0; i < 16; ++i) a.in[i] = (const float*)d_in[i];
    a.out = (float*)d_out; a.ws = (unsigned char*)d_ws;
#if MK_PER_PHASE
    for (int k = 0; k < N_PHASES; ++k) { a.ph_lo = k; a.ph_hi = k + 1; hipLaunchKernelGGL(yoco_fwd, dim3(grid), dim3(NWAVES * 64), LDS_BYTES, stream, a); }
#else
    a.ph_lo = 0; a.ph_hi = N_PHASES;
    hipLaunchKernelGGL(yoco_fwd, dim3(grid), dim3(NWAVES * 64), LDS_BYTES, stream, a);
#endif
    const hipError_t le = hipPeekAtLastError();
    if (le != hipSuccess) fprintf(stderr, "kernel_launch: launch failed: %s\n", hipGetErrorName(le));
}
```

```cpp
#include <hip/hip_runtime.h>
#include <hip/hip_bf16.h>
#include <cstdio>
#include <cstdint>
#include <cmath>

namespace pg8 {
#define PG8_LAS __attribute__((address_space(3)))
typedef unsigned short bf16_t;
typedef short bf16x8 __attribute__((ext_vector_type(8)));
typedef float f32x4 __attribute__((ext_vector_type(4)));
typedef unsigned u32x4 __attribute__((ext_vector_type(4)));
#define PG8_GAS __attribute__((address_space(1)))
#ifndef PG8_STORE_SC1
#define PG8_STORE_SC1 0
#endif
constexpr int BM = 256, BK = 64, HALF = 128, HTB = HALF * BK * 2  , STAGE_BYTES = 8 * HTB, NXCD = 8, WGM = 8;

__host__ __device__ __forceinline__ int lds_byte(int r, int c) { const int st = (r >> 4) * 2 + (c >> 5), rr = r & 15, cc = c & 31, ob = rr * 64 + cc * 2; return st * 1024 + (ob ^ (((ob >> 9) & 1) << 5)); }
__host__ __device__ __forceinline__ void stage_rc(int b, int& R, int& C) { const int st = b / 1024, sb = b % 1024, swz = sb ^ (((sb >> 9) & 1) << 5); R = (st >> 1) * 16 + swz / 64; C = (st & 1) * 32 + (swz % 64) / 2; }
__host__ __device__ __forceinline__ int perm32(int rho) { const int n = rho >> 4, i = rho & 15; return 8 * (i >> 2) + 4 * n + (i & 3); }

struct Unit { int pm, pn; };
struct Gemm { const bf16_t* A; const bf16_t* Bt; int M, N, K, lda; };

struct StaticOrder {
    int nM, nN, nwg, G, c;
    __host__ __device__ void init(int M, int N, int G_, int c_) { nM = M / BM; nN = N / BM; nwg = nM * nN; G = G_; c = c_; }
    __host__ __device__ bool next(int i, Unit& u) const {
        const long L = (long)i * G + c; if (L >= nwg) return false;
        int wgid = (int)L; { const int q = nwg / NXCD, r = nwg % NXCD, xcd = wgid % NXCD, off = wgid / NXCD; wgid = (xcd < r ? xcd * (q + 1) : r * (q + 1) + (xcd - r) * q) + off; }
        const int nig = WGM * nN, gid = wgid / nig, fm = gid * WGM, gsz = (nM - fm) < WGM ? (nM - fm) : WGM;
        u.pm = fm + ((wgid % nig) % gsz); u.pn = (wgid % nig) / gsz; return true;
    }
    __device__ __forceinline__ void a_ready(const Unit&) const {}
    __device__ __forceinline__ void done(const Unit&) const {}
};

__device__ __forceinline__ unsigned cvt_pk_bf16(float lo, float hi) { unsigned r; asm volatile("v_cvt_pk_bf16_f32 %0, %1, %2" : "=v"(r) : "v"(lo), "v"(hi)); return r; }

template <int ACT> struct EpiStore {
    static constexpr bool PERM = true, AFTER_DRAIN = false;
    bf16_t* O; int ldc; int split_cols; size_t split_stride; int scale_tile; float scale0; bf16_t* halo;
    __device__ __forceinline__ void operator()(const f32x4 (&acc)[2][2][4][2], const Unit& u, int wr, int wc, int fr, int fq) const {
        const int row0 = u.pm * BM + wr * 64 + fr; int colt = u.pn * BM; PG8_GAS bf16_t* base = (PG8_GAS bf16_t*)O; PG8_GAS bf16_t* hal = (PG8_GAS bf16_t*)halo;
        int t = 0; if (split_cols) { t = colt / split_cols; base += (size_t)t * split_stride; colt -= t * split_cols; }
        const float sc = (t == scale_tile) ? scale0 : 1.f;
        const int col0 = colt + wc * 32 + 8 * fq;
#pragma unroll
        for (int ai = 0; ai < 2; ++ai)
#pragma unroll
            for (int m = 0; m < 4; ++m) { const int row = row0 + ai * HALF + m * 16; PG8_GAS bf16_t* rowp = base + (size_t)row * ldc + col0;
#pragma unroll
                for (int bj = 0; bj < 2; ++bj) { f32x4 v0 = acc[ai][bj][m][0], v1 = acc[ai][bj][m][1];
                    if (ACT == 1) {
#pragma unroll
                        for (int e = 0; e < 4; ++e) { const float a = fmaxf(v0[e], 0.f), b = fmaxf(v1[e], 0.f); v0[e] = a * a; v1[e] = b * b; } }
                    if (sc != 1.f) { v0 = v0 * sc; v1 = v1 * sc; }
                    u32x4 w; w.x = cvt_pk_bf16(v0[0], v0[1]); w.y = cvt_pk_bf16(v0[2], v0[3]); w.z = cvt_pk_bf16(v1[0], v1[1]); w.w = cvt_pk_bf16(v1[2], v1[3]);
#if PG8_STORE_SC1
                    if (O != nullptr) asm volatile("global_store_dwordx4 %0, %1, off sc1\n\ts_nop 1" :: "v"(rowp + bj * HALF), "v"(w) : "memory"); else asm volatile("" :: "v"(w));
#else
                    if (O != nullptr) *(PG8_GAS u32x4*)(rowp + bj * HALF) = w; else asm volatile("" :: "v"(w));
#endif
                    if (halo != nullptr && m == 3 && fr >= 13) { const int c = col0 + bj * HALF; if (c < 6144) *(PG8_GAS u32x4*)(hal + ((size_t)(row >> 6) * 3 + (fr - 13)) * 6144 + c) = w; }
                } }
    }
};
template <class Epi, class Sched, bool ALIGN_EPI = false, bool SP2 = false>
__device__ __forceinline__ void gemm_phase(PG8_LAS unsigned char* lds, const Gemm g, const Sched& S, const Epi& E) {
    int tid_ = threadIdx.x; asm volatile("" : "+v"(tid_));
    const int tid = tid_, wid = __builtin_amdgcn_readfirstlane(tid >> 6), lane = tid & 63, wr = wid >> 2, wc = wid & 3, fr = lane & 15, fq = lane >> 4;
    const int K = g.K, nt = K / BK, lda = g.lda;
    unsigned voffA[2], voffB[2];
#pragma unroll
    for (int i = 0; i < 2; ++i) { int R, C; stage_rc(tid * 16 + i * 8192, R, C); const int Rb = Epi::PERM ? ((R & ~31) + perm32(R & 31)) : R;
        voffA[i] = (unsigned)(R * lda + C) * 2u; voffB[i] = (unsigned)(Rb * K + C) * 2u; }
    const size_t kstep = (size_t)(BK * 2);
    const size_t hA = (size_t)HALF * lda * 2, hB = (size_t)HALF * K * 2;
    const size_t tA = 2 * hA, tB = 2 * hB;
    const unsigned ldsw = (unsigned)wid * 1024u;
    const int aoff = lds_byte(wr * 64 + fr, fq * 8), boff = lds_byte(wc * 32 + fr, fq * 8);
#define PG8_SA(b, h) (((b) * 2 + (h)) * HTB)
#define PG8_SB(b, h) ((4 + (b) * 2 + (h)) * HTB)
#define PG8_STAGE(bufoff, gbase, voff) do { _Pragma("unroll") for (int _i = 0; _i < 2; ++_i) \
        __builtin_amdgcn_global_load_lds((const unsigned*)((const char*)(gbase) + (voff)[_i]), (PG8_LAS unsigned*)(lds + (bufoff) + ldsw + _i * 8192), 16, 0, 0); } while (0)
#define PG8_LDA(dst, b, h) do { _Pragma("unroll") for (int m = 0; m < 4; ++m) _Pragma("unroll") for (int k = 0; k < 2; ++k) dst[m][k] = *(const PG8_LAS bf16x8*)(lds + PG8_SA(b, h) + aoff + m * 2048 + k * 1024); } while (0)
#define PG8_LDB(dst, b, h) do { _Pragma("unroll") for (int n = 0; n < 2; ++n) _Pragma("unroll") for (int k = 0; k < 2; ++k) dst[n][k] = *(const PG8_LAS bf16x8*)(lds + PG8_SB(b, h) + boff + n * 2048 + k * 1024); } while (0)
#define PG8_MMA(ai, bj, At, Bt) do { __builtin_amdgcn_s_setprio(1); _Pragma("unroll") for (int m = 0; m < 4; ++m) _Pragma("unroll") for (int n = 0; n < 2; ++n) _Pragma("unroll") for (int k = 0; k < 2; ++k) \
        acc[ai][bj][m][n] = __builtin_amdgcn_mfma_f32_16x16x32_bf16(Bt[n][k], At[m][k], acc[ai][bj][m][n], 0, 0, 0); __builtin_amdgcn_s_setprio(0); } while (0)
#define PG8_WAIT_V(n) asm volatile("s_waitcnt vmcnt(" #n ")" ::: "memory")
#define PG8_WAIT_L(n) asm volatile("s_waitcnt lgkmcnt(" #n ")" ::: "memory")
#define PG8_BAR __builtin_amdgcn_s_barrier()
#define PG8_SCHED __builtin_amdgcn_sched_barrier(0)
    Unit cur, nxt; int ui = 0;
    if (!S.next(0, cur)) return;
    f32x4 acc[2][2][4][2];
#pragma unroll
    for (int a = 0; a < 2; ++a)
#pragma unroll
        for (int b = 0; b < 2; ++b)
#pragma unroll
            for (int m = 0; m < 4; ++m)
#pragma unroll
                for (int n = 0; n < 2; ++n) acc[a][b][m][n] = (f32x4){0.f, 0.f, 0.f, 0.f};
    bf16x8 At[4][2], B0[2][2], B1[2][2];
    const char* cA = (const char*)g.A + (size_t)cur.pm * tA; const char* cB = (const char*)g.Bt + (size_t)cur.pn * tB;
    S.a_ready(cur);
    if constexpr (SP2) {
        PG8_STAGE(PG8_SB(0, 0), cB, voffB); PG8_STAGE(PG8_SB(0, 1), cB + hB, voffB); PG8_STAGE(PG8_SA(0, 0), cA, voffA); PG8_STAGE(PG8_SA(0, 1), cA + hA, voffA);
        if (wr == 1) PG8_BAR;
        PG8_WAIT_V(2); PG8_BAR;
        PG8_STAGE(PG8_SB(1, 0), cB + kstep, voffB); PG8_STAGE(PG8_SA(1, 0), cA + kstep, voffA); PG8_STAGE(PG8_SB(1, 1), cB + hB + kstep, voffB);
        PG8_WAIT_V(6); PG8_BAR;
    } else {
        PG8_STAGE(PG8_SB(0, 0), cB, voffB); PG8_STAGE(PG8_SA(0, 0), cA, voffA); PG8_STAGE(PG8_SB(0, 1), cB + hB, voffB); PG8_STAGE(PG8_SA(0, 1), cA + hA, voffA);
        if (wr == 1) PG8_BAR;
        PG8_WAIT_V(4); PG8_BAR;
        PG8_STAGE(PG8_SB(1, 0), cB + kstep, voffB); PG8_STAGE(PG8_SA(1, 0), cA + kstep, voffA); PG8_STAGE(PG8_SB(1, 1), cB + hB + kstep, voffB);
        PG8_WAIT_V(6); PG8_BAR;
    }
    for (;;) {
        const bool has_next = S.next(ui + 1, nxt);
        const char* nA = has_next ? (const char*)g.A + (size_t)nxt.pm * tA : cA; const char* nB = has_next ? (const char*)g.Bt + (size_t)nxt.pn * tB : cB;
        for (int t = 0; t < nt; t += 2) {
            const bool last = (t == nt - 2);
            const char* a1 = cA + (size_t)(t + 1) * kstep;
            const char* a2 = last ? nA : cA + (size_t)(t + 2) * kstep; const char* b2 = last ? nB : cB + (size_t)(t + 2) * kstep;
            const char* a3 = a2 + kstep; const char* b3 = b2 + kstep;
            if (last && has_next) S.a_ready(nxt);
            if constexpr (SP2) {
            PG8_LDB(B0, 0, 0); PG8_LDB(B1, 0, 1); PG8_SCHED; PG8_LDA(At, 0, 0); PG8_STAGE(PG8_SA(1, 1), a1 + hA, voffA);
            PG8_WAIT_V(8); PG8_WAIT_L(0); PG8_BAR; PG8_MMA(0, 0, At, B0); PG8_MMA(0, 1, At, B1); PG8_BAR; PG8_SCHED;
            PG8_LDA(At, 0, 1); PG8_STAGE(PG8_SB(0, 0), b2, voffB); PG8_STAGE(PG8_SB(0, 1), b2 + hB, voffB); PG8_STAGE(PG8_SA(0, 0), a2, voffA);
            PG8_WAIT_V(8); PG8_WAIT_L(0); PG8_BAR; PG8_MMA(1, 0, At, B0); PG8_MMA(1, 1, At, B1); PG8_BAR; PG8_SCHED;
            PG8_LDB(B0, 1, 0); PG8_LDB(B1, 1, 1); PG8_SCHED; PG8_LDA(At, 1, 0); PG8_STAGE(PG8_SA(0, 1), a2 + hA, voffA);
            PG8_WAIT_V(8); PG8_WAIT_L(0); PG8_BAR; PG8_MMA(0, 0, At, B0); PG8_MMA(0, 1, At, B1); PG8_BAR; PG8_SCHED;
            PG8_LDA(At, 1, 1); PG8_STAGE(PG8_SB(1, 0), b3, voffB); PG8_STAGE(PG8_SB(1, 1), b3 + hB, voffB); PG8_STAGE(PG8_SA(1, 0), a3, voffA);
            PG8_WAIT_V(8); PG8_WAIT_L(0); PG8_BAR; PG8_MMA(1, 0, At, B0); PG8_MMA(1, 1, At, B1); PG8_BAR; PG8_SCHED;
            } else {
            PG8_LDB(B0, 0, 0); PG8_SCHED; PG8_LDA(At, 0, 0); PG8_STAGE(PG8_SA(1, 1), a1 + hA, voffA);
            PG8_WAIT_L(8); PG8_BAR; PG8_WAIT_L(0); PG8_MMA(0, 0, At, B0); PG8_BAR; PG8_SCHED;
            PG8_LDB(B1, 0, 1); PG8_STAGE(PG8_SB(0, 0), b2, voffB);
            PG8_BAR; PG8_WAIT_L(0); PG8_MMA(0, 1, At, B1); PG8_BAR;
            PG8_LDA(At, 0, 1); PG8_STAGE(PG8_SA(0, 0), a2, voffA);
            PG8_BAR; PG8_WAIT_L(0); PG8_MMA(1, 0, At, B0); PG8_BAR; PG8_SCHED;
            PG8_STAGE(PG8_SB(0, 1), b2 + hB, voffB);
            PG8_WAIT_V(6); PG8_BAR; PG8_MMA(1, 1, At, B1); PG8_BAR;
            PG8_LDB(B0, 1, 0); PG8_SCHED; PG8_LDA(At, 1, 0); PG8_STAGE(PG8_SA(0, 1), a2 + hA, voffA);
            PG8_WAIT_L(8); PG8_BAR; PG8_WAIT_L(0); PG8_MMA(0, 0, At, B0); PG8_BAR; PG8_SCHED;
            PG8_LDB(B1, 1, 1); PG8_STAGE(PG8_SB(1, 0), b3, voffB);
            PG8_BAR; PG8_WAIT_L(0); PG8_MMA(0, 1, At, B1); PG8_BAR;
            PG8_LDA(At, 1, 1); PG8_STAGE(PG8_SA(1, 0), a3, voffA);
            PG8_BAR; PG8_WAIT_L(0); PG8_MMA(1, 0, At, B0); PG8_BAR; PG8_SCHED;
            PG8_STAGE(PG8_SB(1, 1), b3 + hB, voffB);
            PG8_WAIT_V(6); PG8_BAR; PG8_MMA(1, 1, At, B1); PG8_BAR;
            }
        }
        if constexpr (ALIGN_EPI) { if (wr == 0) PG8_BAR; }
        if constexpr (!Epi::AFTER_DRAIN) { E(acc, cur, wr, wc, fr, fq); S.done(cur); }
        if (!has_next) break;
#pragma unroll
        for (int a = 0; a < 2; ++a)
#pragma unroll
            for (int b = 0; b < 2; ++b)
#pragma unroll
                for (int m = 0; m < 4; ++m)
#pragma unroll
                    for (int n = 0; n < 2; ++n) acc[a][b][m][n] = (f32x4){0.f, 0.f, 0.f, 0.f};
        cur = nxt; cA = nA; cB = nB; ++ui;
        if constexpr (ALIGN_EPI) { if (wr == 1) PG8_BAR; }
    }
    PG8_WAIT_V(0);
    if constexpr (!ALIGN_EPI) { if (wr == 0) PG8_BAR; }
    PG8_BAR;
#undef PG8_SA
#undef PG8_SB
#undef PG8_STAGE
#undef PG8_LDA
#undef PG8_LDB
#undef PG8_MMA
#undef PG8_WAIT_V
#undef PG8_WAIT_L
#undef PG8_BAR
#undef PG8_SCHED
}
}
#ifndef ATTN_PRIO
#define ATTN_PRIO 0
#endif
namespace dattn {
using bf16=__hip_bfloat16;
using bf16x8=__attribute__((ext_vector_type(8)))short;
using s16x4=__attribute__((ext_vector_type(4)))short;
using f32x16=__attribute__((ext_vector_type(16)))float;
using u32x4=__attribute__((ext_vector_type(4)))unsigned;
constexpr int SEQ=4096,DM=2048,HDV=128;
constexpr int NW=8,QBLK=32,QB=128,KVBLK=64,NQB=SEQ/QB;
__device__ __forceinline__ int crow(int r,int hi){return (r&3)+8*(r>>2)+4*hi;}
#define SBAR() __builtin_amdgcn_sched_barrier(0)
__device__ __forceinline__ void cmask(f32x16&p0,f32x16&p1,int jb,int qrel,int hi){
  const float NEG=-INFINITY; int kb=64*jb+4*hi;
  #pragma unroll
  for(int r=0;r<16;++r){int kv=kb+(r&3)+8*(r>>2); if(kv>qrel)p0[r]=NEG; if(kv+32>qrel)p1[r]=NEG;}
}
constexpr float C2=0.125f*1.4426950408889634f;
constexpr int NSLOT=3, SLOTB=16384;
constexpr int LDS_K=0, LDS_V=NSLOT*SLOTB, LDS_WS=2*NSLOT*SLOTB, LDS_BYTES=LDS_WS+NW*64*4;
__device__ __forceinline__ void glds16(const void*gsrc,unsigned lds_dst){unsigned keep;
  asm volatile("s_mov_b32 %0, m0\n\ts_mov_b32 m0, %2\n\ts_nop 0\n\tglobal_load_lds_dwordx4 %1, off\n\ts_mov_b32 m0, %0":"=&s"(keep):"v"(gsrc),"s"(lds_dst):"memory");}
__device__ __forceinline__ float max3f(float a,float b,float c){float r;asm("v_max3_f32 %0, %1, %2, %3":"=v"(r):"v"(a),"v"(b),"v"(c));return r;}
__device__ __forceinline__ float max2f(float a,float b){float r;asm("v_max_f32_e32 %0, %1, %2":"=v"(r):"v"(a),"v"(b));return r;}
__device__ __forceinline__ float fadd_s(float a,float b){float r;asm("v_add_f32_e32 %0, %1, %2":"=v"(r):"v"(a),"v"(b));return r;}
__device__ __forceinline__ float fsub_s(float a,float b){float r;asm("v_sub_f32_e32 %0, %1, %2":"=v"(r):"v"(a),"v"(b));return r;}
typedef float f32x2_t __attribute__((ext_vector_type(2))); typedef __bf16 bf16x2_t __attribute__((ext_vector_type(2)));
__device__ __forceinline__ unsigned cvtpk_s(float lo,float hi){f32x2_t v={lo,hi};bf16x2_t b=__builtin_convertvector(v,bf16x2_t);return __builtin_bit_cast(unsigned,b);}
#define WAIT_BAR(N) asm volatile("s_waitcnt vmcnt(" #N ") lgkmcnt(0)\n\ts_barrier":::"memory")
typedef __attribute__((address_space(3))) const char* lds_cptr;
typedef short v4i16_t __attribute__((ext_vector_type(4)));
__device__ __forceinline__ void qkt(f32x16&p0,f32x16&p1,const char*kb,const bf16x8*qr){ const f32x16 negm=f32x16{};
  #pragma unroll
  for(int d0=0;d0<4;++d0){
    const bf16x8 b0=*reinterpret_cast<const bf16x8*>(kb+d0*2048);
    const bf16x8 b1=*reinterpret_cast<const bf16x8*>(kb+d0*2048+512);
    if(d0==0){p0=__builtin_amdgcn_mfma_f32_32x32x16_bf16(b0,qr[0],negm,0,0,0);p1=__builtin_amdgcn_mfma_f32_32x32x16_bf16(b1,qr[0],negm,0,0,0);}
    else{p0=__builtin_amdgcn_mfma_f32_32x32x16_bf16(b0,qr[d0],p0,0,0,0);p1=__builtin_amdgcn_mfma_f32_32x32x16_bf16(b1,qr[d0],p1,0,0,0);}}
}
__device__ __forceinline__ void kload8(bf16x8*kf,lds_cptr kp){
  kf[0]=*(const __attribute__((address_space(3))) bf16x8*)(kp);      kf[1]=*(const __attribute__((address_space(3))) bf16x8*)(kp+512);
  kf[2]=*(const __attribute__((address_space(3))) bf16x8*)(kp+2048); kf[3]=*(const __attribute__((address_space(3))) bf16x8*)(kp+2560);
  kf[4]=*(const __attribute__((address_space(3))) bf16x8*)(kp+4096); kf[5]=*(const __attribute__((address_space(3))) bf16x8*)(kp+4608);
  kf[6]=*(const __attribute__((address_space(3))) bf16x8*)(kp+6144); kf[7]=*(const __attribute__((address_space(3))) bf16x8*)(kp+6656);
}
__device__ __forceinline__ void kload2(bf16x8*kf,lds_cptr kp,int j){ kf[2*j]=*(const __attribute__((address_space(3))) bf16x8*)(kp+j*2048); kf[2*j+1]=*(const __attribute__((address_space(3))) bf16x8*)(kp+j*2048+512); }
__device__ __forceinline__ s16x4 vtr(lds_cptr p){ return __builtin_bit_cast(s16x4,__builtin_amdgcn_ds_read_tr16_b64_v4i16((__attribute__((address_space(3))) v4i16_t*)p)); }
__device__ __forceinline__ float rowmax(const f32x16&p0,const f32x16&p1){
  float a=max3f(p0[0],p0[1],p1[0]),b=max3f(p0[2],p0[3],p1[1]);a=max3f(a,p1[2],p1[3]);
  #pragma unroll
  for(int r=4;r<16;r+=4){a=max3f(a,p0[r],p0[r+1]);b=max3f(b,p0[r+2],p0[r+3]);a=max3f(a,p1[r],p1[r+1]);b=max3f(b,p1[r+2],p1[r+3]);}
  const float m=max2f(a,b);
  auto rr=__builtin_amdgcn_permlane32_swap(__float_as_uint(m),__float_as_uint(m),false,false);
  return max2f(__uint_as_float(rr[0]),__uint_as_float(rr[1]));
}
__device__ __forceinline__ void pv(f32x16*o,int vb,bf16x8 pa0,bf16x8 pa1,bf16x8 pa2,bf16x8 pa3){
  #pragma unroll
  for(int d0=0;d0<4;++d0){s16x4 lo[4],hi[4];
    #pragma unroll
    for(int ks=0;ks<4;++ks){
      asm volatile("ds_read_b64_tr_b16 %0,%1 offset:%c2":"=&v"(lo[ks]):"v"(vb),"i"(d0*4096+ks*1024):"memory");
      asm volatile("ds_read_b64_tr_b16 %0,%1 offset:%c2":"=&v"(hi[ks]):"v"(vb),"i"(d0*4096+ks*1024+512):"memory");}
    asm volatile("s_waitcnt lgkmcnt(0)":::"memory");SBAR();
    #define PK(k) (bf16x8){lo[k][0],lo[k][1],lo[k][2],lo[k][3],hi[k][0],hi[k][1],hi[k][2],hi[k][3]}
    o[d0]=__builtin_amdgcn_mfma_f32_32x32x16_bf16(pa0,PK(0),o[d0],0,0,0);
    o[d0]=__builtin_amdgcn_mfma_f32_32x32x16_bf16(pa1,PK(1),o[d0],0,0,0);
    o[d0]=__builtin_amdgcn_mfma_f32_32x32x16_bf16(pa2,PK(2),o[d0],0,0,0);
    o[d0]=__builtin_amdgcn_mfma_f32_32x32x16_bf16(pa3,PK(3),o[d0],0,0,0);
    #undef PK
  }
}

struct Params { const bf16* Q; const bf16* K; const bf16* V; bf16* O; const float* subln_w; float lam, post; };
template<int THRL> __device__ __forceinline__ void unit(int b,int h,int qb,const Params&P,char*shm){
  int tid_=threadIdx.x; asm volatile("":"+v"(tid_));
  const int tid=tid_,lane=tid&63,r32=lane&31,hi=lane>>5; const int wid=__builtin_amdgcn_readfirstlane(tid>>6);
  const int cmp=wid&1,rbk=wid>>1;
  if(ATTN_PRIO&&wid>=4)__builtin_amdgcn_s_setprio(1);
  const long rowbase=(long)b*SEQ; const int q0=qb*QB;
  const bf16*Qw=P.Q+(rowbase+q0+rbk*QBLK)*DM+h*HDV+cmp*64;
  const bf16*Kh=P.K+rowbase*DM+h*HDV,*Vh=P.V+rowbase*DM+h*HDV;
  const unsigned lds0=(unsigned)(uintptr_t)shm;
  float*wsf=(float*)(shm+LDS_WS)+wid*64;
  const bf16*ksrc=Kh+(long)lane*DM+wid*8;
  const bf16*vsrc=Vh+(long)(16*(wid&3)+(lane>>2))*DM+(wid>>2)*32+(lane&3)*8;
  const unsigned kdst=lds0+LDS_K+wid*1024, vdst=lds0+LDS_V+wid*1024;
  #define DMA_K(t,slot) do{ glds16(ksrc+(long)(t)*KVBLK*DM,(unsigned)__builtin_amdgcn_readfirstlane(kdst+(slot))); glds16(ksrc+(long)(t)*KVBLK*DM+64,(unsigned)__builtin_amdgcn_readfirstlane(kdst+(slot)+8192)); }while(0)
  #define DMA_V(t,slot) do{ glds16(vsrc+(long)(t)*KVBLK*DM,(unsigned)__builtin_amdgcn_readfirstlane(vdst+(slot))); glds16(vsrc+(long)(t)*KVBLK*DM+64,(unsigned)__builtin_amdgcn_readfirstlane(vdst+(slot)+8192)); }while(0)
  const int vb0=(int)(lds0+LDS_V)+((lane>>4)&1)*32+(lane&3)*8+(4*hi+((lane&15)>>2))*64;
  bf16x8 kf[8];
  const lds_cptr shm3=(lds_cptr)shm; const lds_cptr kp0=shm3+LDS_K+(cmp*8+hi)*1024+r32*16; const lds_cptr vp0=shm3+LDS_V+((lane>>4)&1)*32+(lane&3)*8+(4*hi+((lane&15)>>2))*64;
  const char*Kbase=shm+LDS_K+(cmp*8+hi)*1024+r32*16;
  const int NT=(q0+QB)/KVBLK;
  DMA_K(0,0);DMA_V(0,0);DMA_K(1,SLOTB);
  bf16x8 qr[4];
  #pragma unroll
  for(int d0=0;d0<4;++d0)qr[d0]=*(const __attribute__((address_space(1))) bf16x8*)(&Qw[(long)r32*DM+d0*16+hi*8]);
  float mhat=0.f,l_reg=0.f;f32x16 o[4];o[0]=f32x16{};o[1]=f32x16{};o[2]=f32x16{};o[3]=f32x16{};const f32x16 zero16=f32x16{};
  const int qrel=rbk*QBLK+r32;
  #define CMASK(P0,P1,t) do{int jb_=(t)-(NT-2); if(jb_>=0)cmask(P0,P1,jb_,qrel,hi);}while(0)
  bool resc=false;
  #define START(P0,P1) do{ const float rm=rowmax(P0,P1); resc=false; \
    { const float dl=rm; mhat=fadd_s(mhat,dl); \
      _Pragma("unroll") for(int r=0;r<16;++r){P0[r]=fsub_s(P0[r],dl);P1[r]=fsub_s(P1[r],dl);} } \
    _Pragma("unroll") for(int r=0;r<16;++r)P0[r]=__builtin_amdgcn_exp2f(P0[r]); }while(0)
  #define RESC() do{ if(resc){ asm volatile("s_waitcnt lgkmcnt(0)":::"memory"); \
      _Pragma("unroll") for(int d_=0;d_<4;++d_) _Pragma("unroll") for(int r=0;r<16;++r)o[d_][r]*=wsf[crow(r,hi)]; } }while(0)
  f32x16 pA0,pA1,pB0,pB1;
  int sl_prev=0,sl_cur=0,sl_next=SLOTB;
  #define ROT() do{sl_prev=sl_cur;sl_cur=sl_next;sl_next=(sl_next==(NSLOT-1)*SLOTB)?0:sl_next+SLOTB;}while(0)
  DMA_K(2,2*SLOTB);
  WAIT_BAR(6);
  qkt(pA0,pA1,Kbase,qr);asm volatile("s_nop 15\n\ts_nop 7":"+v"(pA0),"+v"(pA1));CMASK(pA0,pA1,0);
  START(pA0,pA1);
  _Pragma("unroll") for(int r=0;r<16;++r)pA1[r]=__builtin_amdgcn_exp2f(pA1[r]);
  WAIT_BAR(0);
  DMA_K(3,0);DMA_V(1,SLOTB);
  ROT();
  kload8(kf,kp0+sl_cur);
  if(NT>2){WAIT_BAR(4);}else{WAIT_BAR(0);}
  s16x4 vlo[4],vhi[4]; u32x4 pw0,pw1,pw2,pw3;
  #define PKW(P,B) cvtpk_s(P[B],P[B+1])
  #define PAF(k) __builtin_bit_cast(bf16x8,pw##k)
  #define VFR(i) (bf16x8){vlo[i][0],vlo[i][1],vlo[i][2],vlo[i][3],vhi[i][0],vhi[i][1],vhi[i][2],vhi[i][3]}
  #define PIN(x) asm volatile("":"+v"(x))
  #define MX3(a,b,c) __builtin_fmaxf(__builtin_fmaxf((a),(b)),(c))
  #define GAPA(MF,A0,A1,A2,A3,W0,W1,PW) do{ MF; sacc+=A0; sacc+=A1; sacc+=A2; sacc+=A3; PIN(sacc); W0; W1; PIN(PW); SBAR(); }while(0)
  #define EX(v) __builtin_amdgcn_exp2f((v)-mhat)
  #define VOFF(f) ((((f)&3)*4096)+(((f)>>2)*1024))
  #define VRD(i,f) do{ vlo[i]=vtr(vp_+VOFF(f)); vhi[i]=vtr(vp_+VOFF(f)+512); }while(0)
  #define GAPB(MF,X,B) do{ MF; X[B]=EX(X[B]); X[B+1]=EX(X[B+1]); PIN(X); SBAR(); }while(0)
  #define GAPBV(MF,X,B,i,f) do{ MF; X[B]=EX(X[B]); X[B+1]=EX(X[B+1]); PIN(X); VRD(i,f); SBAR(); }while(0)
  #define KRD(G,j) do{ if(G){ kload2(kf,kp0+sl_next,j); SBAR(); } }while(0)
  #define PVM(d,k,i) o[d]=__builtin_amdgcn_mfma_f32_32x32x16_bf16(PAF(k),VFR(i),o[d],0,0,0)
  #define STEP(C0,C1,P0,P1,t,GK,GV,GL) do{ SBAR(); \
    const lds_cptr vp_=vp0+sl_prev; \
    float sacc=(P0[0]+P0[1]); \
    GAPA(C0=__builtin_amdgcn_mfma_f32_32x32x16_bf16(kf[0],qr[0],zero16,0,0,0), P0[2],P0[3],P0[4],P0[5],     pw0[0]=PKW(P0,0), pw0[1]=PKW(P0,2), pw0); \
    GAPA(C1=__builtin_amdgcn_mfma_f32_32x32x16_bf16(kf[1],qr[0],zero16,0,0,0), P0[6],P0[7],P0[8],P0[9],     pw0[2]=PKW(P0,4), pw0[3]=PKW(P0,6), pw0); \
    GAPA(C0=__builtin_amdgcn_mfma_f32_32x32x16_bf16(kf[2],qr[1],C0,0,0,0),   P0[10],P0[11],P0[12],P0[13], pw1[0]=PKW(P0,8), pw1[1]=PKW(P0,10), pw1); \
    GAPA(C1=__builtin_amdgcn_mfma_f32_32x32x16_bf16(kf[3],qr[1],C1,0,0,0),   P0[14],P0[15],P1[0],P1[1],   pw1[2]=PKW(P0,12),pw1[3]=PKW(P0,14), pw1); \
    VRD(0,0); SBAR(); GAPA(C0=__builtin_amdgcn_mfma_f32_32x32x16_bf16(kf[4],qr[2],C0,0,0,0),   P1[2],P1[3],P1[4],P1[5],     pw2[0]=PKW(P1,0), pw2[1]=PKW(P1,2), pw2); \
    VRD(1,1); SBAR(); GAPA(C1=__builtin_amdgcn_mfma_f32_32x32x16_bf16(kf[5],qr[2],C1,0,0,0),   P1[6],P1[7],P1[8],P1[9],     pw2[2]=PKW(P1,4), pw2[3]=PKW(P1,6), pw2); \
    VRD(2,2); SBAR(); GAPA(C0=__builtin_amdgcn_mfma_f32_32x32x16_bf16(kf[6],qr[3],C0,0,0,0),   P1[10],P1[11],P1[12],P1[13], pw3[0]=PKW(P1,8), pw3[1]=PKW(P1,10), pw3); \
    VRD(3,3); SBAR(); GAPA(C1=__builtin_amdgcn_mfma_f32_32x32x16_bf16(kf[7],qr[3],C1,0,0,0),   P1[14],P1[15],0.f,0.f,       pw3[2]=PKW(P1,12),pw3[3]=PKW(P1,14), pw3); \
    l_reg+=sacc; \
    if(GK){DMA_K((t)+3,sl_cur);} if(GV){DMA_V((t)+1,sl_next);} \
    CMASK(C0,C1,t); \
    { float a=MX3(C0[0],C0[1],C1[0]),b=MX3(C0[2],C0[3],C1[1]); a=MX3(a,C1[2],C1[3]); \
      _Pragma("unroll") for(int r=4;r<16;r+=4){a=MX3(a,C0[r],C0[r+1]);b=MX3(b,C0[r+2],C0[r+3]);a=MX3(a,C1[r],C1[r+1]);b=MX3(b,C1[r+2],C1[r+3]);} \
      float rm=__builtin_fmaxf(a,b); { auto rr=__builtin_amdgcn_permlane32_swap(__float_as_uint(rm),__float_as_uint(rm),false,false); rm=__builtin_fmaxf(__uint_as_float(rr[0]),__uint_as_float(rr[1])); } \
      rm-=mhat; resc=false; \
      if(__builtin_expect(__any(rm>(float)THRL),0)){ const float dl=__builtin_fmaxf(rm,0.f); mhat+=dl; \
        const float f=__builtin_amdgcn_exp2f(-dl); l_reg*=f; if(hi==0)wsf[r32]=f; resc=true; } } \
    SBAR(); \
    GAPBV(PVM(0,0,0),C0,0, 0,4);  GAPBV(PVM(1,0,1),C0,2, 1,5);  GAPBV(PVM(2,0,2),C0,4, 2,6);  GAPBV(PVM(3,0,3),C0,6, 3,7); \
    GAPBV(PVM(0,1,0),C0,8, 0,8);  GAPBV(PVM(1,1,1),C0,10,1,9);  GAPBV(PVM(2,1,2),C0,12,2,10); GAPBV(PVM(3,1,3),C0,14,3,11); \
    KRD(GL,0); GAPBV(PVM(0,2,0),C1,0, 0,12); KRD(GL,1); GAPBV(PVM(1,2,1),C1,2, 1,13); KRD(GL,2); GAPBV(PVM(2,2,2),C1,4, 2,14); KRD(GL,3); GAPBV(PVM(3,2,3),C1,6, 3,15); \
    GAPB(PVM(0,3,0),C1,8); GAPB(PVM(1,3,1),C1,10); GAPB(PVM(2,3,2),C1,12); GAPB(PVM(3,3,3),C1,14); \
    }while(0)
  int t=1;
  #undef CMASK
  #define CMASK(P0,P1,t) do{}while(0)
  for(;t+3<NT;t+=2){
    STEP(pB0,pB1,pA0,pA1,t,true,true,true);     WAIT_BAR(4); RESC(); ROT();
    STEP(pA0,pA1,pB0,pB1,t+1,true,true,true);   WAIT_BAR(4); RESC(); ROT();
  }
  #undef CMASK
  #define CMASK(P0,P1,t) do{int jb_=(t)-(NT-2); if(jb_>=0)cmask(P0,P1,jb_,qrel,hi);}while(0)
  #define ENDW(tt) do{ if((tt)+3<NT){WAIT_BAR(4);} else if((tt)+2<NT){WAIT_BAR(2);} else {WAIT_BAR(0);} }while(0)
  for(;t+1<NT;t+=2){
    STEP(pB0,pB1,pA0,pA1,t,(t+3<NT),(t+1<NT),(t+1<NT));       ENDW(t);   RESC(); ROT();
    STEP(pA0,pA1,pB0,pB1,t+1,(t+4<NT),(t+2<NT),(t+2<NT));     ENDW(t+1); RESC(); ROT();
  }
  STEP(pB0,pB1,pA0,pA1,NT-1,false,false,false); RESC();
  { float sacc=pB0[0]+pB0[1]; _Pragma("unroll") for(int r=2;r<16;++r)sacc+=pB0[r]; _Pragma("unroll") for(int r=0;r<16;++r)sacc+=pB1[r]; l_reg+=sacc;
    pw0=(u32x4){PKW(pB0,0),PKW(pB0,2),PKW(pB0,4),PKW(pB0,6)};pw1=(u32x4){PKW(pB0,8),PKW(pB0,10),PKW(pB0,12),PKW(pB0,14)};pw2=(u32x4){PKW(pB1,0),PKW(pB1,2),PKW(pB1,4),PKW(pB1,6)};pw3=(u32x4){PKW(pB1,8),PKW(pB1,10),PKW(pB1,12),PKW(pB1,14)};
    SBAR(); pv(o,vb0+sl_cur,PAF(0),PAF(1),PAF(2),PAF(3)); }
  #undef PKW
  #undef PAF
  #undef VFR
  #undef PIN
  #undef MX3
  #undef GAPA
  #undef GAPB
  #undef GAPBV
  #undef EX
  #undef VOFF
  #undef VRD
  #undef KRD
  #undef PVM
  #undef STEP
  #undef ENDW
  {auto rr=__builtin_amdgcn_permlane32_swap(__float_as_uint(l_reg),__float_as_uint(l_reg),false,false);l_reg=__uint_as_float(rr[0])+__uint_as_float(rr[1]);}
  if(hi==0)wsf[32+r32]=l_reg;asm volatile("s_waitcnt lgkmcnt(0)":::"memory");
  float rli[16];
  #pragma unroll
  for(int r=0;r<16;++r)rli[r]=__builtin_amdgcn_rcpf(wsf[32+crow(r,hi)]);
  asm volatile("s_waitcnt lgkmcnt(0)\n\ts_barrier":::"memory");
  { bf16*stg=(bf16*)(shm)+wid*4096;
    #pragma unroll
    for(int r=0;r<16;++r){const int orow=crow(r,hi);
      #pragma unroll
      for(int d0=0;d0<4;++d0)stg[orow*128+d0*32+r32]=__float2bfloat16(o[d0][r]*rli[r]);} }
  asm volatile("s_waitcnt lgkmcnt(0)\n\ts_barrier":::"memory");
  { const bf16*s0=(const bf16*)(shm)+(wid&~1)*4096; const bf16*s1=s0+4096;
    bf16*Ow=P.O+(rowbase+q0+rbk*QBLK)*DM+h*HDV; const int ch=lane&15;
    typedef float f32x4_t __attribute__((ext_vector_type(4)));
    const f32x4_t wa=*(const __attribute__((address_space(1))) f32x4_t*)(P.subln_w+ch*8), wb=*(const __attribute__((address_space(1))) f32x4_t*)(P.subln_w+ch*8+4);
    #pragma unroll
    for(int i=0;i<4;++i){ const int row=16*cmp+4*i+(lane>>4);
      const u32x4 a=*(const u32x4*)(s0+row*128+ch*8), bq=*(const u32x4*)(s1+row*128+ch*8);
      float d[8];
      #pragma unroll
      for(int k=0;k<4;++k){ const unsigned ua=a[k],ub=bq[k];
        d[2*k]=__uint_as_float(ua<<16)-P.lam*__uint_as_float(ub<<16); d[2*k+1]=__uint_as_float(ua&0xffff0000u)-P.lam*__uint_as_float(ub&0xffff0000u); }
      float s=0.f;
      #pragma unroll
      for(int k=0;k<8;++k)s+=d[k]*d[k];
      s+=__shfl_xor(s,1);s+=__shfl_xor(s,2);s+=__shfl_xor(s,4);s+=__shfl_xor(s,8);
      const float rs=P.post*__builtin_amdgcn_rsqf(s*(1.f/128.f)+1e-5f);
      u32x4 w; w[0]=cvtpk_s(d[0]*rs*wa[0],d[1]*rs*wa[1]); w[1]=cvtpk_s(d[2]*rs*wa[2],d[3]*rs*wa[3]); w[2]=cvtpk_s(d[4]*rs*wb[0],d[5]*rs*wb[1]); w[3]=cvtpk_s(d[6]*rs*wb[2],d[7]*rs*wb[3]);
      *(__attribute__((address_space(1))) u32x4*)(Ow+(long)row*DM+ch*8)=w; } }
  asm volatile("s_waitcnt lgkmcnt(0)\n\ts_barrier":::"memory");
  if(ATTN_PRIO&&wid>=4)__builtin_amdgcn_s_setprio(0);
  #undef DMA_K
  #undef DMA_V
  #undef CMASK
  #undef START
  #undef RESC
  #undef ROT
}
constexpr int ATTN_LDS_BYTES=LDS_BYTES;
template<int THRL=8> __device__ __forceinline__ void phase(char*lds,const Params&P,int grid,int block){
  const int vcu=(grid%8==0)?(block%8)*(grid/8)+block/8:block;
  for(int v=vcu;v<256;v+=grid){ const int bh=v>>1,p=v&1;
    for(int i=0;i<16;++i){ const int s=2*(i>>1)+p; const int qb=(i&1)?31-s:s; unit<THRL>(bh>>4,bh&15,qb,P,lds); } }
}
#undef SBAR
#undef WAIT_BAR
}
constexpr int NWAVES = 8;
#ifndef MK_PER_PHASE
#define MK_PER_PHASE 0
#endif

constexpr int BATCH = 8, SEQ = 4096, DMODEL = 2048, MROWS = BATCH * SEQ, DFF = 8192, NHEADS = 16, HD = 128;
constexpr int GDN_PROJ = 8224, GDN_MAIN = 8192, CONVC = 6144, NCG = MROWS / 64;
constexpr float ALPHA_RES = 1.6817928305074292f;
constexpr float LN_EPS = 1e-5f, GDN_EPS = 1e-6f, SUBLN_EPS = 1e-5f;
constexpr int N_PHASES = 39;

constexpr size_t MiB = 1u << 20;
constexpr size_t WS_CTL = 0, CTL_ZERO_BYTES = 1 * MiB;
constexpr size_t WS_ONES = 1 * MiB, WS_ZEROS = WS_ONES + 8192, WS_MU = WS_ONES + 65536, WS_RSTD = WS_MU + 131072;
constexpr size_t WS_BETA = 2 * MiB, WS_G = 4 * MiB;
constexpr size_t WS_HALO = 9 * MiB;
constexpr size_t WS_WA = 27 * MiB, WS_WB = 60 * MiB;
constexpr size_t WS_ATTN = 27 * MiB;
constexpr size_t WS_XB = 92 * MiB;
constexpr size_t WS_Y = 220 * MiB;
constexpr size_t WS_R1 = 476 * MiB;
constexpr size_t WS_END = 988 * MiB;
constexpr size_t QTR = 128 * MiB;
constexpr int CW_TMO = 0;
constexpr int CW_BAR = 4096;

constexpr int LDS_BYTES_C = 147456;
constexpr int RING_OFF = 0, RING_BYTES = 131072;
constexpr int LDSCTL_OFF = LDS_BYTES_C - 512, MISC_OFF = LDSCTL_OFF + 320;
constexpr int LDS_BYTES = LDS_BYTES_C;
static_assert(MISC_OFF + 128 <= LDS_BYTES, "LDS map");

#define GAS __attribute__((address_space(1)))
#define LAS __attribute__((address_space(3)))
typedef unsigned short bf16;
typedef unsigned v4u __attribute__((ext_vector_type(4)));
typedef unsigned v2u __attribute__((ext_vector_type(2)));
typedef float f32x4 __attribute__((ext_vector_type(4)));
typedef float f32x16 __attribute__((ext_vector_type(16)));
typedef short bf16x8 __attribute__((ext_vector_type(8)));
typedef GAS unsigned gu32;
typedef GAS unsigned long long gu64;
#define RLX_AGENT __ATOMIC_RELAXED, __HIP_MEMORY_SCOPE_AGENT
#define LDS_WAIT() asm volatile("s_waitcnt lgkmcnt(0)" ::: "memory")
#define VM_WAIT() asm volatile("s_waitcnt vmcnt(0)" ::: "memory")
#define WG_BAR() asm volatile("s_waitcnt lgkmcnt(0)\n\ts_barrier" ::: "memory")
typedef float f32x2_t_ __attribute__((ext_vector_type(2))); typedef __bf16 bf16x2_t_ __attribute__((ext_vector_type(2)));
__device__ __forceinline__ unsigned pk2(float lo, float hi) { f32x2_t_ v = {lo, hi}; bf16x2_t_ b = __builtin_convertvector(v, bf16x2_t_); return __builtin_bit_cast(unsigned, b); }
__device__ __forceinline__ unsigned f2bf(float f) { return pk2(f, 0.f) & 0xffffu; }
__device__ __forceinline__ float bflo(unsigned w) { return __builtin_bit_cast(float, w << 16); }
__device__ __forceinline__ float bfhi(unsigned w) { return __builtin_bit_cast(float, w & 0xffff0000u); }
__device__ __forceinline__ float bf2f(bf16 h) { return __builtin_bit_cast(float, (unsigned)h << 16); }
__device__ __forceinline__ float fast_exp(float x) { return __builtin_amdgcn_exp2f(x * 1.4426950408889634f); }
__device__ __forceinline__ float silu_f(float x) { return x * __builtin_amdgcn_rcpf(1.f + __expf(-x)); }

#define XB_TMO      128
#define XB_XCNT(j)  (256  + 64 * (j))
#define XB_XSUB(j)  (1280 + 64 * (j))
#define XB_XGEN(j)  (2304 + 64 * (j))
#define XB_TOP      3328
#define XB_TOPGEN   3392
#define XCD_BAR_WORDS 3456
#define XB_SPIN_CAP (1u << 18)

__device__ __forceinline__ unsigned xb_ld(unsigned* p)              { return __hip_atomic_load(p, __ATOMIC_RELAXED, __HIP_MEMORY_SCOPE_AGENT); }
__device__ __forceinline__ unsigned xb_add(unsigned* p, unsigned v) { return __hip_atomic_fetch_add(p, v, __ATOMIC_RELAXED, __HIP_MEMORY_SCOPE_AGENT); }
__device__ __forceinline__ unsigned xb_xcc_id() { return (unsigned)__builtin_amdgcn_s_getreg((3 << 11) | 20) & 0xFu; }
#define XB_SPIN(cond, bar) do { unsigned _sp = 0; while (cond) { __builtin_amdgcn_s_sleep(1); \
    if ((++_sp & 255u) == 0u) { if (xb_ld(&(bar)[XB_TMO])) break; if (_sp > XB_SPIN_CAP) { atomicAdd(&(bar)[XB_TMO], 1u); break; } } } } while (0)

struct XcdBarrier {
    unsigned* bar; unsigned x;
    volatile LAS unsigned* st;
};
__device__ __forceinline__ XcdBarrier xcd_barrier_post(unsigned* bar, volatile LAS unsigned* st) {
    XcdBarrier b; b.bar = bar; b.x = xb_xcc_id(); b.st = st;
    if (threadIdx.x == 0) (void)xb_add(&bar[XB_XCNT(b.x)], 1u);
    return b;
}
__device__ __forceinline__ void xcd_barrier_complete(unsigned* bar, unsigned x, unsigned& nloc, unsigned& nx) {
    const unsigned G = gridDim.x * gridDim.y * gridDim.z;
    unsigned sum, cnt, mine, sp = 0u;
    for (;;) {
        sum = 0u; cnt = 0u; mine = 0u;
#pragma unroll
        for (unsigned j = 0; j < 16; ++j) { const unsigned c = xb_ld(&bar[XB_XCNT(j)]); sum += c; cnt += (c > 0u) ? 1u : 0u; mine = (j == x) ? c : mine; }
        if (sum == G) break;
        __builtin_amdgcn_s_sleep(1);
        if ((++sp & 255u) == 0u) { if (xb_ld(&bar[XB_TMO])) break; if (sp > XB_SPIN_CAP) { atomicAdd(&bar[XB_TMO], 1u); break; } }
    }
    nloc = mine > 0u ? mine : 1u; nx = cnt > 0u ? cnt : 1u;
}
__device__ __forceinline__ void xcd_barrier(const XcdBarrier& b) {
    asm volatile("s_waitcnt vmcnt(0)" ::: "memory");
    __syncthreads();
    if (threadIdx.x == 0) {
        unsigned* bar = b.bar;
        __builtin_amdgcn_s_waitcnt(0);
        unsigned nloc = b.st[0], nx = b.st[1];
        if (nloc == 0u) { xcd_barrier_complete(bar, b.x, nloc, nx); b.st[0] = nloc; b.st[1] = nx; }
        const unsigned old = xb_add(&bar[XB_XSUB(b.x)], 1u);
        const unsigned gen = old / nloc;
        if (old + 1u == (gen + 1u) * nloc) {
            __builtin_amdgcn_fence(__ATOMIC_RELEASE, "agent");
            asm volatile("s_waitcnt vmcnt(0)" ::: "memory");
            const unsigned og = xb_add(&bar[XB_TOP], 1u);
            const unsigned tg = og / nx;
            if (og + 1u == (tg + 1u) * nx) xb_add(&bar[XB_TOPGEN], 1u);
            else XB_SPIN(xb_ld(&bar[XB_TOPGEN]) == tg, bar);
            __builtin_amdgcn_fence(__ATOMIC_ACQUIRE, "agent");
            xb_add(&bar[XB_XGEN(b.x)], 1u);
            asm volatile("s_waitcnt vmcnt(0)" ::: "memory");
        } else {
            XB_SPIN(xb_ld(&bar[XB_XGEN(b.x)]) == gen, bar);
            __builtin_amdgcn_fence(__ATOMIC_ACQUIRE, "agent");
            asm volatile("s_waitcnt vmcnt(0)" ::: "memory");
        }
    }
    __syncthreads();
}

__device__ __forceinline__ float wave_sum(float v) {
#pragma unroll
    for (int o = 1; o < 64; o <<= 1) v += __shfl_xor(v, o);
    return v;
}
__device__ __forceinline__ float sum16(float v) {
    v += __shfl_xor(v, 1); v += __shfl_xor(v, 2); v += __shfl_xor(v, 4); v += __shfl_xor(v, 8); return v;
}
__device__ __forceinline__ void transpose_item(const float* W, int K, int ldw, int n_begin, int nblk, bf16* WT, int row_off, LAS float* scr, int item, int lane) {
    const int kb = item / nblk, nb = item % nblk, k0 = 64 * kb, n0 = 32 * nb;
    float wv[32];
#pragma unroll
    for (int i = 0; i < 32; ++i) wv[i] = ((const GAS float*)W)[(size_t)(k0 + 2 * i + (lane >> 5)) * ldw + n_begin + n0 + (lane & 31)];
#pragma unroll
    for (int i = 0; i < 32; ++i) scr[(2 * i + (lane >> 5)) * 33 + (lane & 31)] = wv[i];
    LDS_WAIT(); asm volatile("" ::: "memory");
    const int c = lane & 7;
#pragma unroll
    for (int j = 0; j < 4; ++j) { const int n = (lane >> 3) + 8 * j; const LAS float* s = scr + (8 * c) * 33 + n;
        v4u o; o.x = pk2(s[0 * 33], s[1 * 33]); o.y = pk2(s[2 * 33], s[3 * 33]); o.z = pk2(s[4 * 33], s[5 * 33]); o.w = pk2(s[6 * 33], s[7 * 33]);
        *(GAS v4u*)(WT + (size_t)(row_off + n0 + n) * K + k0 + 8 * c) = o; }
    LDS_WAIT(); asm volatile("" ::: "memory");
}
__device__ __forceinline__ void convert_w(LAS unsigned char* lds, int gw, int NGW, int wave, int lane, const float* W, int K, int ldw, int n_begin, int ncols, bf16* WT, int row_off) {
    LAS float* scr = (LAS float*)(lds + RING_OFF + wave * 16384);
    const int nblk = ncols / 32, nitems = (K / 64) * nblk;
    for (int it = gw; it < nitems; it += NGW) transpose_item(W, K, ldw, n_begin, nblk, WT, row_off, scr, it, lane);
}
__device__ __forceinline__ void row_to_bf16(const float* xrow, bf16* orow, int lane) {
    const GAS f32x4* xr = (const GAS f32x4*)xrow + lane; GAS v2u* o8 = (GAS v2u*)orow + lane;
#pragma unroll
    for (int j = 0; j < 8; ++j) { const f32x4 v = xr[64 * j]; v2u w; w.x = pk2(v.x, v.y); w.y = pk2(v.z, v.w); o8[64 * j] = w; }
}
__device__ __forceinline__ void ln_pass_b(const bf16* xb_in, const bf16* hb, const float* g, const float* b, bf16* xb_out, float* outf, float alpha, int gw, int NGW, int lane) {
    const GAS f32x4* gr = (const GAS f32x4*)g + 2 * lane; const GAS f32x4* br = (const GAS f32x4*)b + 2 * lane;
    for (int m = gw; m < MROWS; m += 2 * NGW) {
        const int m1 = (m + NGW < MROWS) ? m + NGW : m;
        const GAS v4u* x0 = (const GAS v4u*)(xb_in + (size_t)m * DMODEL) + lane; const GAS v4u* x1 = (const GAS v4u*)(xb_in + (size_t)m1 * DMODEL) + lane;
        const GAS v4u* h0 = (const GAS v4u*)(hb + (size_t)m * DMODEL) + lane;   const GAS v4u* h1 = (const GAS v4u*)(hb + (size_t)m1 * DMODEL) + lane;
        v4u xa[4], xc[4], ha[4], hc[4];
#pragma unroll
        for (int j = 0; j < 4; ++j) { xa[j] = x0[64 * j]; xc[j] = x1[64 * j]; ha[j] = h0[64 * j]; hc[j] = h1[64 * j]; }
        float y0[32], y1[32]; float s0 = 0.f, s1 = 0.f;
#pragma unroll
        for (int j = 0; j < 4; ++j)
#pragma unroll
            for (int k = 0; k < 4; ++k) { y0[8 * j + 2 * k] = alpha * bflo(xa[j][k]) + bflo(ha[j][k]); y0[8 * j + 2 * k + 1] = alpha * bfhi(xa[j][k]) + bfhi(ha[j][k]);
                                          y1[8 * j + 2 * k] = alpha * bflo(xc[j][k]) + bflo(hc[j][k]); y1[8 * j + 2 * k + 1] = alpha * bfhi(xc[j][k]) + bfhi(hc[j][k]); }
#pragma unroll
        for (int k = 0; k < 32; ++k) { s0 += y0[k]; s1 += y1[k]; }
#pragma unroll
        for (int o = 1; o < 64; o <<= 1) { s0 += __shfl_xor(s0, o); s1 += __shfl_xor(s1, o); }
        const float mean0 = s0 * (1.f / DMODEL), mean1 = s1 * (1.f / DMODEL); float q0 = 0.f, q1 = 0.f;
#pragma unroll
        for (int k = 0; k < 32; ++k) { y0[k] -= mean0; y1[k] -= mean1; q0 += y0[k] * y0[k]; q1 += y1[k] * y1[k]; }
#pragma unroll
        for (int o = 1; o < 64; o <<= 1) { q0 += __shfl_xor(q0, o); q1 += __shfl_xor(q1, o); }
        const float rs0 = 1.f / sqrtf(q0 * (1.f / DMODEL) + LN_EPS), rs1 = 1.f / sqrtf(q1 * (1.f / DMODEL) + LN_EPS);
#pragma unroll
        for (int j = 0; j < 4; ++j) { const f32x4 ga = gr[128 * j], gb = gr[128 * j + 1], ba = br[128 * j], bb = br[128 * j + 1];
            float o0[8], o1[8];
#pragma unroll
            for (int k = 0; k < 8; ++k) { const float gg = k < 4 ? ga[k] : gb[k - 4], bv = k < 4 ? ba[k] : bb[k - 4]; o0[k] = y0[8 * j + k] * rs0 * gg + bv; o1[k] = y1[8 * j + k] * rs1 * gg + bv; }
            if (xb_out) { v4u w0, w1; w0.x = pk2(o0[0], o0[1]); w0.y = pk2(o0[2], o0[3]); w0.z = pk2(o0[4], o0[5]); w0.w = pk2(o0[6], o0[7]); w1.x = pk2(o1[0], o1[1]); w1.y = pk2(o1[2], o1[3]); w1.z = pk2(o1[4], o1[5]); w1.w = pk2(o1[6], o1[7]);
                ((GAS v4u*)(xb_out + (size_t)m * DMODEL) + lane)[64 * j] = w0; ((GAS v4u*)(xb_out + (size_t)m1 * DMODEL) + lane)[64 * j] = w1; }
            if (outf) { GAS f32x4* p0 = (GAS f32x4*)(outf + (size_t)m * DMODEL) + 2 * lane + 128 * j; GAS f32x4* p1 = (GAS f32x4*)(outf + (size_t)m1 * DMODEL) + 2 * lane + 128 * j;
                p0[0] = (f32x4){o0[0], o0[1], o0[2], o0[3]}; p0[1] = (f32x4){o0[4], o0[5], o0[6], o0[7]}; p1[0] = (f32x4){o1[0], o1[1], o1[2], o1[3]}; p1[1] = (f32x4){o1[4], o1[5], o1[6], o1[7]}; } }
    }
}
#define MFMA32(a, b, c) __builtin_amdgcn_mfma_f32_32x32x16_bf16((a), (b), (c), 0, 0, 0)

__device__ __forceinline__ void ba_proj(const bf16* xb, const bf16* wt  , const float* a_log, const float* dt_bias, float* beta, float* g, int gw, int NGW, int lane) {
    const int r32 = lane & 31, hi = lane >> 5;
    for (int wu = gw; wu < MROWS / 32; wu += NGW) {
        const GAS bf16* ap = (const GAS bf16*)xb + (size_t)(wu * 32 + r32) * DMODEL + 8 * hi; const GAS bf16* bp = (const GAS bf16*)wt + (size_t)(GDN_MAIN + r32) * DMODEL + 8 * hi;
        f32x16 acc = {};
#pragma unroll 1
        for (int s0 = 0; s0 < DMODEL / 16; s0 += 8) {
            bf16x8 a[8], b[8];
#pragma unroll
            for (int s = 0; s < 8; ++s) { a[s] = *(const GAS bf16x8*)(ap + (s0 + s) * 16); b[s] = *(const GAS bf16x8*)(bp + (s0 + s) * 16); }
#pragma unroll
            for (int s = 0; s < 8; ++s) acc = MFMA32(a[s], b[s], acc);
        }
        const int j = r32 & 15; const float al = -__expf(((const GAS float*)a_log)[j]), db = ((const GAS float*)dt_bias)[j]; GAS float* betag = (GAS float*)beta; GAS float* gg_ = (GAS float*)g;
#pragma unroll
        for (int r = 0; r < 16; ++r) { const int t = wu * 32 + (r & 3) + 8 * (r >> 2) + 4 * hi; const float v = acc[r];
            if (r32 < 16) betag[(size_t)t * 16 + j] = __builtin_amdgcn_rcpf(1.f + __expf(-v));
            else { const float z = v + db; const float sp = z > 20.f ? z : log1pf(__expf(z)); gg_[(size_t)t * 16 + j] = al * sp; } }
    }
}

#ifndef G2_SKIP
#define G2_SKIP 0
#endif
#ifndef PROBE_G2_NOSCAT
#define PROBE_G2_NOSCAT 0
#endif
typedef short bf16x4 __attribute__((ext_vector_type(4)));
#define MFMA16K16(a, b, c) __builtin_amdgcn_mfma_f32_16x16x16bf16_1k((a), (b), (c), 0, 0, 0)
constexpr int G2_TS = 136;
constexpr int G2_AS = 68, G2_ANS = 72, G2_US = 68;
constexpr int G2_A = 0, G2_GC = G2_A + 64 * G2_AS * 4, G2_BT = G2_GC + 256, G2_AN = G2_BT + 256, G2_TB = G2_AN + 64 * G2_ANS * 2, G2_Q = G2_TB + 2048, G2_K = G2_Q + 64 * G2_TS * 2, G2_V = G2_K + 64 * G2_TS * 2,
              G2_W = G2_V + 64 * G2_TS * 2, G2_END = G2_W + 64 * G2_TS * 2;
static_assert(G2_END <= RING_BYTES, "G2 LDS");
__device__ __forceinline__ bf16x4 pack4(f32x4 v) { v2u w; w.x = pk2(v[0], v[1]); w.y = pk2(v[2], v[3]); return __builtin_bit_cast(bf16x4, w); }
__device__ __forceinline__ void gdn_chunk_phase(LAS unsigned char* lds, bf16* p_, const bf16* halo_, const float* beta_, float* g_, bf16* wbuf_, bf16* attn_, const float* conv_w_, int vcu, int G, bf16* palt_ = nullptr) {
#define G2_ST(off) ((palt ? palt + ((size_t)(off) & 0x7ffffffull) : p + (size_t)(off)))
    int tid_ = threadIdx.x; asm volatile("" : "+v"(tid_));
    const int tid0 = tid_, lane0 = tid0 & 63, wid0 = __builtin_amdgcn_readfirstlane(tid0 >> 6);
    GAS bf16* const p = (GAS bf16*)p_; const GAS bf16* const halo = (const GAS bf16*)halo_; const GAS float* const beta = (const GAS float*)beta_; GAS float* const g = (GAS float*)g_;
    GAS bf16* const wbuf = (GAS bf16*)wbuf_; GAS bf16* const attn = (GAS bf16*)attn_; const GAS float* const conv_w = (const GAS float*)conv_w_; GAS bf16* const palt = (GAS bf16*)palt_;
    LAS bf16* Qs = (LAS bf16*)(lds + G2_Q); LAS bf16* Ks = (LAS bf16*)(lds + G2_K); LAS bf16* Vs = (LAS bf16*)(lds + G2_V); LAS bf16* Ws = (LAS bf16*)(lds + G2_W);
    LAS float* As = (LAS float*)(lds + G2_A); LAS float* gcs = (LAS float*)(lds + G2_GC); LAS float* bts = (LAS float*)(lds + G2_BT);
    LAS bf16* An = (LAS bf16*)(lds + G2_AN); LAS bf16* Tb = (LAS bf16*)(lds + G2_TB); LAS bf16* Us = (LAS bf16*)(lds + G2_A);
    asm volatile("" : "+v"(Qs), "+v"(Ks), "+v"(Vs), "+v"(Ws), "+v"(As), "+v"(gcs), "+v"(bts), "+v"(An), "+v"(Tb), "+v"(Us));
    v4u rawv[3][5]; float gpre = 0.f, bpre = 0.f;
#define G2_LOAD_RAW(uu, LN, WD) do { const int cg_ = (uu) >> 4, h_ = (uu) & 15, n_ = cg_ & 63; const size_t r0_ = (size_t)cg_ * 64; const int cgp_l = (LN) & 15, tA_l = 8 * (WD) + 2 * ((LN) >> 4); \
        _Pragma("unroll") for (int X = 0; X < 3; ++X) { const int col_ = X * 2048 + h_ * HD + 8 * cgp_l; \
            _Pragma("unroll") for (int rr = 0; rr < 5; ++rr) { const int rel = tA_l - 3 + rr; v4u v = {0u, 0u, 0u, 0u}; \
                if (rel >= 0) v = *(const GAS v4u*)(p + (r0_ + rel) * GDN_MAIN + col_); \
                else if (n_ > 0) v = *(const GAS v4u*)(halo + ((size_t)(cg_ - 1) * 3 + (rel + 3)) * CONVC + col_); \
                rawv[X][rr] = v; } } \
        if ((WD) == 0) { gpre = g[(r0_ + (LN)) * 16 + h_]; bpre = beta[(r0_ + (LN)) * 16 + h_]; } } while (0)
    if (vcu < NCG * NHEADS) G2_LOAD_RAW(vcu, lane0, wid0);
    for (int u = vcu; u < NCG * NHEADS; u += G) {
        const int cg = u >> 4, h = u & 15; const size_t row0 = (size_t)cg * 64;
        int tl_ = tid0; asm volatile("" : "+v"(tl_));
        const int tid = tl_, lane = tid & 63, wid = __builtin_amdgcn_readfirstlane(tid >> 6), r32 = lane & 31, hi = lane >> 5;
        {
            const int cgp = lane & 15, sub = lane >> 4, tA = 8 * wid + 2 * sub;
#pragma unroll
            for (int X = 0; X < 3; ++X) {
                const int col = X * 2048 + h * HD + 8 * cgp;
                float raw[5][8];
                asm volatile("" : "+v"(rawv[X][0]), "+v"(rawv[X][1]), "+v"(rawv[X][2]), "+v"(rawv[X][3]), "+v"(rawv[X][4]));
#pragma unroll
                for (int rr = 0; rr < 5; ++rr) { const v4u v = rawv[X][rr];
                    raw[rr][0] = bflo(v.x); raw[rr][1] = bfhi(v.x); raw[rr][2] = bflo(v.y); raw[rr][3] = bfhi(v.y); raw[rr][4] = bflo(v.z); raw[rr][5] = bfhi(v.z); raw[rr][6] = bflo(v.w); raw[rr][7] = bfhi(v.w); }
                float o0[8], o1[8];
#pragma unroll
                for (int c = 0; c < 8; ++c) { o0[c] = 0.f; o1[c] = 0.f; }
#pragma unroll
                for (int j = 0; j < 4; ++j) { const f32x4 wa = *(const GAS f32x4*)(conv_w + (size_t)j * CONVC + col), wb = *(const GAS f32x4*)(conv_w + (size_t)j * CONVC + col + 4);
#pragma unroll
                    for (int c = 0; c < 8; ++c) { const float w = c < 4 ? wa[c] : wb[c - 4]; o0[c] += w * raw[j][c]; o1[c] += w * raw[j + 1][c]; } }
                float s0 = 0.f, s1 = 0.f;
#pragma unroll
                for (int c = 0; c < 8; ++c) { o0[c] = silu_f(o0[c]); o1[c] = silu_f(o1[c]); s0 += o0[c] * o0[c]; s1 += o1[c] * o1[c]; }
                if (X < 2) { s0 = sum16(s0); s1 = sum16(s1); const float sc = X == 0 ? 0.08838834764831845f : 1.f; const float f0 = sc * __builtin_amdgcn_rsqf(s0 + GDN_EPS), f1 = sc * __builtin_amdgcn_rsqf(s1 + GDN_EPS);
#pragma unroll
                    for (int c = 0; c < 8; ++c) { o0[c] *= f0; o1[c] *= f1; } }
                LAS bf16* T = X == 0 ? Qs : (X == 1 ? Ks : Vs);
                v4u w0, w1; w0.x = pk2(o0[0], o0[1]); w0.y = pk2(o0[2], o0[3]); w0.z = pk2(o0[4], o0[5]); w0.w = pk2(o0[6], o0[7]);
                w1.x = pk2(o1[0], o1[1]); w1.y = pk2(o1[2], o1[3]); w1.z = pk2(o1[4], o1[5]); w1.w = pk2(o1[6], o1[7]);
                *(LAS v4u*)(T + tA * G2_TS + 8 * cgp) = w0; *(LAS v4u*)(T + (tA + 1) * G2_TS + 8 * cgp) = w1;
                asm volatile("" ::: "memory");
            }
            if (wid == 0) {
                float gv = gpre;
#pragma unroll
                for (int o = 1; o < 64; o <<= 1) { const float t = __shfl_up(gv, o); if (lane >= o) gv += t; }
                gcs[lane] = gv; bts[lane] = bpre; if (!palt) g[(row0 + lane) * 16 + h] = gv;
            }
        }
        __syncthreads();
        if (u + G < NCG * NHEADS) G2_LOAD_RAW(u + G, lane, wid);
        if (!((G2_SKIP & 4) && palt)) {
            const int rb = (wid >> 1) & 1, cb = wid & 1; const bool isA = wid < 4;
            f32x16 acc = {};
            if (!(rb == 0 && cb == 1)) {
                const LAS bf16* Ar = (isA ? Ks : Qs) + (32 * rb + r32) * G2_TS + 8 * hi; const LAS bf16* Br = Ks + (32 * cb + r32) * G2_TS + 8 * hi;
#pragma unroll
                for (int s = 0; s < 8; ++s) acc = MFMA32(*(const LAS bf16x8*)(Ar + 16 * s), *(const LAS bf16x8*)(Br + 16 * s), acc);
            }
            const int j = 32 * cb + r32; const float gj = gcs[j];
#pragma unroll
            for (int r = 0; r < 16; ++r) { const int i = 32 * rb + (r & 3) + 8 * (r >> 2) + 4 * hi; const float gi = gcs[i];
                if (isA) { const float d = (i > j) ? __expf(gi - gj) : 0.f; const float a = (i > j) ? bts[i] * acc[r] * d : 0.f; As[i * G2_AS + j] = a; An[i * G2_ANS + j] = (bf16)f2bf(-a); }
                else { const float d = (i >= j) ? __expf(gi - gj) : 0.f; Ws[i * G2_TS + j] = (bf16)f2bf((i >= j) ? acc[r] * d : 0.f); } }
        }
        __syncthreads();
        if (wid == 0 && !((G2_SKIP & 2) && palt)) {
            const int b = lane >> 4, c = lane & 15; float t[16];
            const LAS float* Ab = As + (16 * b) * G2_AS + 16 * b;
#pragma unroll
            for (int i = 0; i < 16; ++i) {
                float ti = (i == c) ? 1.f : 0.f;
#pragma unroll
                for (int j4 = 0; j4 < (i + 3) / 4; ++j4) { const f32x4 a = *(const LAS f32x4*)(Ab + i * G2_AS + 4 * j4);
#pragma unroll
                    for (int k = 0; k < 4; ++k) if (4 * j4 + k < i) ti -= a[k] * t[4 * j4 + k]; }
                t[i] = ti;
            }
#pragma unroll
            for (int i = 0; i < 16; ++i) Tb[b * 256 + i * 16 + c] = (bf16)f2bf(t[i]);
        } else if (wid < 5) {
            const int tt = tid - 64, cgp = tt & 15, r0 = tt >> 4;
            { GAS bf16* at = palt ? palt + (((size_t)u * 4096 + 0x4000000ull) & 0x7ffffffull) : attn + (size_t)u * 4096;
#pragma unroll
              for (int k = 0; k < 2; ++k) { const int pc = tt + 256 * k, i = pc >> 3, c8 = pc & 7; *(GAS v4u*)(at + i * 64 + 8 * c8) = *(const LAS v4u*)(Ws + i * G2_TS + 8 * c8); } }
#pragma unroll
            for (int r = 0; r < 4; ++r) { const int i = r0 + 16 * r; const float e = __expf(gcs[i]); const v4u v = *(const LAS v4u*)(Qs + i * G2_TS + 8 * cgp); v4u w;
                w.x = pk2(bflo(v.x) * e, bfhi(v.x) * e); w.y = pk2(bflo(v.y) * e, bfhi(v.y) * e); w.z = pk2(bflo(v.z) * e, bfhi(v.z) * e); w.w = pk2(bflo(v.w) * e, bfhi(v.w) * e);
                *(GAS v4u*)G2_ST((row0 + i) * GDN_MAIN + h * HD + 8 * cgp) = w; }
        } else {
            const float gl = gcs[63];
            for (int task = tid - 320; task < 256; task += 192) { const int dk = task & 127, th = task >> 7;
                GAS bf16* dst = G2_ST((row0 + (dk >> 1)) * GDN_MAIN + 2048 + h * HD + (dk & 1) * 64 + 32 * th);
#pragma unroll
                for (int q = 0; q < 4; ++q) { float v[8];
#pragma unroll
                    for (int k = 0; k < 8; ++k) { const int tk = 32 * th + 8 * q + k; v[k] = bf2f(Ks[tk * G2_TS + dk]) * __expf(gl - gcs[tk]); }
                    v4u w; w.x = pk2(v[0], v[1]); w.y = pk2(v[2], v[3]); w.z = pk2(v[4], v[5]); w.w = pk2(v[6], v[7]); if (!(PROBE_G2_NOSCAT && palt)) *(GAS v4u*)(dst + 8 * q) = w; else asm volatile("" :: "v"(w)); } }
        }
        __syncthreads();
        if (!((G2_SKIP & 1) && palt)) {
            const int nl = lane & 15, q = lane >> 4; const bool isK = wid >= 4;
            float rsc[16];
#pragma unroll
            for (int b = 0; b < 4; ++b)
#pragma unroll
                for (int r = 0; r < 4; ++r) { const int row = 16 * b + 4 * q + r; rsc[4 * b + r] = isK ? bts[row] * __expf(gcs[row]) : bts[row]; }
            bf16x4 Tq[4], Aq[6];
#pragma unroll
            for (int b = 0; b < 4; ++b) Tq[b] = *(const LAS bf16x4*)(Tb + b * 256 + nl * 16 + 4 * q);
            Aq[0] = *(const LAS bf16x4*)(An + (16 + nl) * G2_ANS + 4 * q);
            Aq[1] = *(const LAS bf16x4*)(An + (32 + nl) * G2_ANS + 4 * q);      Aq[2] = *(const LAS bf16x4*)(An + (32 + nl) * G2_ANS + 16 + 4 * q);
            Aq[3] = *(const LAS bf16x4*)(An + (48 + nl) * G2_ANS + 4 * q);      Aq[4] = *(const LAS bf16x4*)(An + (48 + nl) * G2_ANS + 16 + 4 * q);   Aq[5] = *(const LAS bf16x4*)(An + (48 + nl) * G2_ANS + 32 + 4 * q);
#pragma unroll
            for (int t = 0; t < 2; ++t) {
                const int cc = 32 * (wid & 3) + 16 * t + nl;
                const LAS bf16* src = (isK ? Ks : Vs) + cc;
                f32x4 R[4];
#pragma unroll
                for (int b = 0; b < 4; ++b)
#pragma unroll
                    for (int r = 0; r < 4; ++r) R[b][r] = rsc[4 * b + r] * bf2f(src[(16 * b + 4 * q + r) * G2_TS]);
                const f32x4 z4 = {0.f, 0.f, 0.f, 0.f};
                const f32x4 y0 = MFMA16K16(Tq[0], pack4(R[0]), z4); const bf16x4 y0b = pack4(y0);
                f32x4 c1 = MFMA16K16(Aq[0], y0b, R[1]);
                const f32x4 y1 = MFMA16K16(Tq[1], pack4(c1), z4); const bf16x4 y1b = pack4(y1);
                f32x4 c2 = MFMA16K16(Aq[1], y0b, R[2]); c2 = MFMA16K16(Aq[2], y1b, c2);
                const f32x4 y2 = MFMA16K16(Tq[2], pack4(c2), z4); const bf16x4 y2b = pack4(y2);
                f32x4 c3 = MFMA16K16(Aq[3], y0b, R[3]); c3 = MFMA16K16(Aq[4], y1b, c3); c3 = MFMA16K16(Aq[5], y2b, c3);
                const f32x4 y3 = MFMA16K16(Tq[3], pack4(c3), z4); const bf16x4 y3b = pack4(y3);
                if (!isK) {
                    LAS bf16* dst = Us + cc * G2_US + 4 * q;
                    *(LAS bf16x4*)(dst) = y0b; *(LAS bf16x4*)(dst + 16) = y1b; *(LAS bf16x4*)(dst + 32) = y2b; *(LAS bf16x4*)(dst + 48) = y3b;
                } else {
#pragma unroll
                    for (int r = 0; r < 4; ++r) { Ws[(4 * q + r) * G2_TS + cc] = (bf16)y0b[r]; Ws[(16 + 4 * q + r) * G2_TS + cc] = (bf16)y1b[r]; Ws[(32 + 4 * q + r) * G2_TS + cc] = (bf16)y2b[r]; Ws[(48 + 4 * q + r) * G2_TS + cc] = (bf16)y3b[r]; }
                }
            }
        }
        __syncthreads();
#pragma unroll
        for (int k = 0; k < 2; ++k) { const int pc = tid + 512 * k, dv = pc >> 3, c8 = pc & 7;
            const v2u lo = *(const LAS v2u*)(Us + dv * G2_US + 8 * c8), hi2 = *(const LAS v2u*)(Us + dv * G2_US + 8 * c8 + 4);
            *(GAS v4u*)G2_ST((row0 + (dv & 63)) * GDN_MAIN + 4096 + h * HD + (dv >> 6) * 64 + 8 * c8) = (v4u){lo.x, lo.y, hi2.x, hi2.y}; }
#pragma unroll
        for (int k = 0; k < 2; ++k) { const int ch = tid + 512 * k, i = ch >> 4, c8 = ch & 15; *(GAS v4u*)((palt ? palt + (((row0 + i) * DMODEL + h * HD + 8 * c8) & 0x7ffffffull) : wbuf + (row0 + i) * DMODEL + h * HD + 8 * c8)) = *(const LAS v4u*)(Ws + i * G2_TS + 8 * c8); }
    }
#undef G2_ST
#undef G2_LOAD_RAW
}

constexpr int H2_AD = 0, H2_GC = 4096, H2_BT = 4352, H2_AN = 4608, H2_TB = H2_AN + 64 * G2_ANS * 2, H2_Q = H2_TB + 2048, H2_K = H2_Q + 64 * G2_TS * 2, H2_V = H2_K + 64 * G2_TS * 2, H2_GSZ = H2_V + 64 * G2_TS * 2;
static_assert(2 * H2_GSZ <= LDSCTL_OFF && H2_GSZ % 16 == 0, "G2 (two groups) LDS");
__device__ __forceinline__ void grp_bar(LAS unsigned* cnt, unsigned& tgt, int lane) {
    asm volatile("s_waitcnt lgkmcnt(0)" ::: "memory");
    if (lane == 0) __hip_atomic_fetch_add(cnt, 1u, __ATOMIC_RELAXED, __HIP_MEMORY_SCOPE_WORKGROUP);
    tgt += 4u;
    while (*(volatile LAS unsigned*)cnt < tgt) __builtin_amdgcn_s_sleep(1);
    asm volatile("" ::: "memory");
}
__device__ __forceinline__ void gdn_chunk_phase2(LAS unsigned char* lds, bf16* p_, const bf16* halo_, const float* beta_, float* g_, bf16* wbuf_, bf16* attn_, const float* conv_w_, int vcu, int G, bf16* palt_ = nullptr) {
#define G2_ST(off) ((palt ? palt + ((size_t)(off) & 0x7ffffffull) : p + (size_t)(off)))
    int tid_ = threadIdx.x; asm volatile("" : "+v"(tid_));
    const int tid0 = tid_;
    GAS bf16* const p = (GAS bf16*)p_; const GAS bf16* const halo = (const GAS bf16*)halo_; const GAS float* const beta = (const GAS float*)beta_; GAS float* const g = (GAS float*)g_;
    GAS bf16* const wbuf = (GAS bf16*)wbuf_; GAS bf16* const attn = (GAS bf16*)attn_; const GAS float* const conv_w = (const GAS float*)conv_w_; GAS bf16* const palt = (GAS bf16*)palt_;
    const int grp = __builtin_amdgcn_readfirstlane(tid0 >> 8);
    LAS unsigned* cnt = (LAS unsigned*)(lds + LDSCTL_OFF + 128 + 64 * grp);
    __syncthreads(); if (tid0 == 0) { *(LAS unsigned*)(lds + LDSCTL_OFF + 128) = 0u; *(LAS unsigned*)(lds + LDSCTL_OFF + 192) = 0u; } __syncthreads();
    unsigned tgt = 0u;
    LAS unsigned char* gb = lds + grp * H2_GSZ;
    LAS bf16* Qs = (LAS bf16*)(gb + H2_Q); LAS bf16* Ks = (LAS bf16*)(gb + H2_K); LAS bf16* Vs = (LAS bf16*)(gb + H2_V);
    LAS float* Ad = (LAS float*)(gb + H2_AD); LAS float* gcs = (LAS float*)(gb + H2_GC); LAS float* bts = (LAS float*)(gb + H2_BT);
    LAS bf16* An = (LAS bf16*)(gb + H2_AN); LAS bf16* Tb = (LAS bf16*)(gb + H2_TB);
    asm volatile("" : "+v"(Qs), "+v"(Ks), "+v"(Vs), "+v"(Ad), "+v"(gcs), "+v"(bts), "+v"(An), "+v"(Tb));
    v4u rawv[3][7]; float gpre = 0.f, bpre = 0.f;
#define H2_LOAD_RAW(uu, LN, W4) do { const int cg_ = (uu) >> 4, h_ = (uu) & 15, n_ = cg_ & 63; const size_t r0_ = (size_t)cg_ * 64; const int cgp_l = (LN) & 15, tA_l = 16 * (W4) + 4 * ((LN) >> 4); \
        _Pragma("unroll") for (int X = 0; X < 3; ++X) { const int col_ = X * 2048 + h_ * HD + 8 * cgp_l; \
            _Pragma("unroll") for (int rr = 0; rr < 7; ++rr) { const int rel = tA_l - 3 + rr; v4u v = {0u, 0u, 0u, 0u}; \
                if (rel >= 0) v = *(const GAS v4u*)(p + (r0_ + rel) * GDN_MAIN + col_); \
                else if (n_ > 0) v = *(const GAS v4u*)(halo + ((size_t)(cg_ - 1) * 3 + (rel + 3)) * CONVC + col_); \
                rawv[X][rr] = v; } } \
        if ((W4) == 0) { gpre = g[(r0_ + (LN)) * 16 + h_]; bpre = beta[(r0_ + (LN)) * 16 + h_]; } } while (0)
    const int u0 = 2 * vcu + grp, ustep = 2 * G;
    if (u0 < NCG * NHEADS) H2_LOAD_RAW(u0, (tid0 & 63), __builtin_amdgcn_readfirstlane((tid0 >> 6) & 3));
    for (int u = u0; u < NCG * NHEADS; u += ustep) {
        const int cg = u >> 4, h = u & 15; const size_t row0 = (size_t)cg * 64;
        int tl_ = tid0; asm volatile("" : "+v"(tl_));
        const int tid = tl_, lane = tid & 63, w4 = __builtin_amdgcn_readfirstlane((tid >> 6) & 3), gt = tid & 255, r32 = lane & 31, hi = lane >> 5;
        {
            const int cgp = lane & 15, sub = lane >> 4, tA = 16 * w4 + 4 * sub;
#pragma unroll
            for (int X = 0; X < 3; ++X) {
                const int col = X * 2048 + h * HD + 8 * cgp;
                asm volatile("" : "+v"(rawv[X][0]), "+v"(rawv[X][1]), "+v"(rawv[X][2]), "+v"(rawv[X][3]), "+v"(rawv[X][4]), "+v"(rawv[X][5]), "+v"(rawv[X][6]));
                float wj[4][8];
#pragma unroll
                for (int j = 0; j < 4; ++j) { const f32x4 wa = *(const GAS f32x4*)(conv_w + (size_t)j * CONVC + col), wb = *(const GAS f32x4*)(conv_w + (size_t)j * CONVC + col + 4);
#pragma unroll
                    for (int c = 0; c < 4; ++c) { wj[j][c] = wa[c]; wj[j][4 + c] = wb[c]; } }
                float o[4][8];
#pragma unroll
                for (int t = 0; t < 4; ++t)
#pragma unroll
                    for (int c = 0; c < 8; ++c) o[t][c] = 0.f;
#pragma unroll
                for (int rr = 0; rr < 7; ++rr) { const v4u v = rawv[X][rr]; const float rw[8] = {bflo(v.x), bfhi(v.x), bflo(v.y), bfhi(v.y), bflo(v.z), bfhi(v.z), bflo(v.w), bfhi(v.w)};
#pragma unroll
                    for (int t = 0; t < 4; ++t) { const int j = rr - t; if (j >= 0 && j < 4) {
#pragma unroll
                            for (int c = 0; c < 8; ++c) o[t][c] += wj[j][c] * rw[c]; } } }
                LAS bf16* T = X == 0 ? Qs : (X == 1 ? Ks : Vs);
#pragma unroll
                for (int t = 0; t < 4; ++t) { float s = 0.f;
#pragma unroll
                    for (int c = 0; c < 8; ++c) { o[t][c] = silu_f(o[t][c]); s += o[t][c] * o[t][c]; }
                    if (X < 2) { s = sum16(s); const float f = (X == 0 ? 0.08838834764831845f : 1.f) * __builtin_amdgcn_rsqf(s + GDN_EPS);
#pragma unroll
                        for (int c = 0; c < 8; ++c) o[t][c] *= f; }
                    v4u w0; w0.x = pk2(o[t][0], o[t][1]); w0.y = pk2(o[t][2], o[t][3]); w0.z = pk2(o[t][4], o[t][5]); w0.w = pk2(o[t][6], o[t][7]);
                    *(LAS v4u*)(T + (tA + t) * G2_TS + 8 * cgp) = w0; }
                asm volatile("" ::: "memory");
            }
            if (w4 == 0) {
                float gv = gpre;
#pragma unroll
                for (int o_ = 1; o_ < 64; o_ <<= 1) { const float t = __shfl_up(gv, o_); if (lane >= o_) gv += t; }
                gcs[lane] = gv; bts[lane] = bpre; if (!palt) g[(row0 + lane) * 16 + h] = gv;
            }
        }
        grp_bar(cnt, tgt, lane);
        if (u + ustep < NCG * NHEADS) H2_LOAD_RAW(u + ustep, lane, w4);
        {
            const int rb = w4 >> 1, cb = w4 & 1; const int j = 32 * cb + r32; const float gj = gcs[j];
            GAS bf16* at = palt ? palt + (((size_t)u * 4096 + 0x4000000ull) & 0x7ffffffull) : attn + (size_t)u * 4096;
#pragma unroll
            for (int pass = 0; pass < 2; ++pass) {
                f32x16 acc = {};
                if (!(rb == 0 && cb == 1)) {
                    const LAS bf16* Ar = (pass == 0 ? Ks : Qs) + (32 * rb + r32) * G2_TS + 8 * hi; const LAS bf16* Br = Ks + (32 * cb + r32) * G2_TS + 8 * hi;
#pragma unroll
                    for (int s = 0; s < 8; ++s) acc = MFMA32(*(const LAS bf16x8*)(Ar + 16 * s), *(const LAS bf16x8*)(Br + 16 * s), acc);
                }
#pragma unroll
                for (int r = 0; r < 16; ++r) { const int i = 32 * rb + (r & 3) + 8 * (r >> 2) + 4 * hi; const float gi = gcs[i];
                    if (pass == 0) { const float d = (i > j) ? __expf(gi - gj) : 0.f; const float a = (i > j) ? bts[i] * acc[r] * d : 0.f; An[i * G2_ANS + j] = (bf16)f2bf(-a);
                        if ((i >> 4) == (j >> 4)) Ad[(i >> 4) * 256 + (i & 15) * 16 + (j & 15)] = a; }
                    else { const float d = (i >= j) ? __expf(gi - gj) : 0.f; at[i * 64 + j] = (bf16)f2bf((i >= j) ? acc[r] * d : 0.f); } }
            }
        }
        grp_bar(cnt, tgt, lane);
        if (w4 == 0) {
            const int b = lane >> 4, c = lane & 15; float t[16];
            const LAS float* Ab = Ad + b * 256;
#pragma unroll
            for (int i = 0; i < 16; ++i) {
                float ti = (i == c) ? 1.f : 0.f;
#pragma unroll
                for (int j4 = 0; j4 < (i + 3) / 4; ++j4) { const f32x4 a = *(const LAS f32x4*)(Ab + i * 16 + 4 * j4);
#pragma unroll
                    for (int k = 0; k < 4; ++k) if (4 * j4 + k < i) ti -= a[k] * t[4 * j4 + k]; }
                t[i] = ti;
            }
#pragma unroll
            for (int i = 0; i < 16; ++i) Tb[b * 256 + i * 16 + c] = (bf16)f2bf(t[i]);
        } else {
            const int tt = gt - 64;
            for (int pc = tt; pc < 1024; pc += 192) { const int i = pc >> 4, cgp = pc & 15; const float e = __expf(gcs[i]); const v4u v = *(const LAS v4u*)(Qs + i * G2_TS + 8 * cgp); v4u w;
                w.x = pk2(bflo(v.x) * e, bfhi(v.x) * e); w.y = pk2(bflo(v.y) * e, bfhi(v.y) * e); w.z = pk2(bflo(v.z) * e, bfhi(v.z) * e); w.w = pk2(bflo(v.w) * e, bfhi(v.w) * e);
                *(GAS v4u*)G2_ST((row0 + i) * GDN_MAIN + h * HD + 8 * cgp) = w; }
            const float gl = gcs[63];
            for (int task = tt; task < 256; task += 192) { const int dk = task & 127, th = task >> 7;
                GAS bf16* dst = G2_ST((row0 + (dk >> 1)) * GDN_MAIN + 2048 + h * HD + (dk & 1) * 64 + 32 * th);
#pragma unroll
                for (int q = 0; q < 4; ++q) { float v[8];
#pragma unroll
                    for (int k = 0; k < 8; ++k) { const int tk = 32 * th + 8 * q + k; v[k] = bf2f(Ks[tk * G2_TS + dk]) * __expf(gl - gcs[tk]); }
                    v4u w; w.x = pk2(v[0], v[1]); w.y = pk2(v[2], v[3]); w.z = pk2(v[4], v[5]); w.w = pk2(v[6], v[7]); *(GAS v4u*)(dst + 8 * q) = w; } }
        }
        grp_bar(cnt, tgt, lane);
        {
            const int nl = lane & 15, q = lane >> 4; const bool isK = w4 >= 2;
            float rsc[16];
#pragma unroll
            for (int b = 0; b < 4; ++b)
#pragma unroll
                for (int r = 0; r < 4; ++r) { const int row = 16 * b + 4 * q + r; rsc[4 * b + r] = isK ? bts[row] * __expf(gcs[row]) : bts[row]; }
            bf16x4 Tq[4], Aq[6];
#pragma unroll
            for (int b = 0; b < 4; ++b) Tq[b] = *(const LAS bf16x4*)(Tb + b * 256 + nl * 16 + 4 * q);
            Aq[0] = *(const LAS bf16x4*)(An + (16 + nl) * G2_ANS + 4 * q);
            Aq[1] = *(const LAS bf16x4*)(An + (32 + nl) * G2_ANS + 4 * q);      Aq[2] = *(const LAS bf16x4*)(An + (32 + nl) * G2_ANS + 16 + 4 * q);
            Aq[3] = *(const LAS bf16x4*)(An + (48 + nl) * G2_ANS + 4 * q);      Aq[4] = *(const LAS bf16x4*)(An + (48 + nl) * G2_ANS + 16 + 4 * q);   Aq[5] = *(const LAS bf16x4*)(An + (48 + nl) * G2_ANS + 32 + 4 * q);
#pragma unroll
            for (int t = 0; t < 4; ++t) {
                const int cc = 64 * (w4 & 1) + 16 * t + nl;
                const LAS bf16* src = (isK ? Ks : Vs) + cc;
                f32x4 R[4];
#pragma unroll
                for (int b = 0; b < 4; ++b)
#pragma unroll
                    for (int r = 0; r < 4; ++r) R[b][r] = rsc[4 * b + r] * bf2f(src[(16 * b + 4 * q + r) * G2_TS]);
                const f32x4 z4 = {0.f, 0.f, 0.f, 0.f};
                const f32x4 y0 = MFMA16K16(Tq[0], pack4(R[0]), z4); const bf16x4 y0b = pack4(y0);
                f32x4 c1 = MFMA16K16(Aq[0], y0b, R[1]);
                const f32x4 y1 = MFMA16K16(Tq[1], pack4(c1), z4); const bf16x4 y1b = pack4(y1);
                f32x4 c2 = MFMA16K16(Aq[1], y0b, R[2]); c2 = MFMA16K16(Aq[2], y1b, c2);
                const f32x4 y2 = MFMA16K16(Tq[2], pack4(c2), z4); const bf16x4 y2b = pack4(y2);
                f32x4 c3 = MFMA16K16(Aq[3], y0b, R[3]); c3 = MFMA16K16(Aq[4], y1b, c3); c3 = MFMA16K16(Aq[5], y2b, c3);
                const f32x4 y3 = MFMA16K16(Tq[3], pack4(c3), z4); const bf16x4 y3b = pack4(y3);
                if (!isK) {
                    GAS bf16* dst = G2_ST((row0 + (cc & 63)) * GDN_MAIN + 4096 + h * HD + (cc >> 6) * 64 + 4 * q);
                    *(GAS bf16x4*)(dst) = y0b; *(GAS bf16x4*)(dst + 16) = y1b; *(GAS bf16x4*)(dst + 32) = y2b; *(GAS bf16x4*)(dst + 48) = y3b;
                } else {
                    GAS bf16* dst = palt ? palt + (((row0 + 4 * q) * DMODEL + h * HD + cc) & 0x7ffffffull) : wbuf + (row0 + 4 * q) * DMODEL + h * HD + cc;
#pragma unroll
                    for (int r = 0; r < 4; ++r) { dst[(size_t)r * DMODEL] = (bf16)y0b[r]; dst[(size_t)(16 + r) * DMODEL] = (bf16)y1b[r]; dst[(size_t)(32 + r) * DMODEL] = (bf16)y2b[r]; dst[(size_t)(48 + r) * DMODEL] = (bf16)y3b[r]; }
                }
            }
        }
        grp_bar(cnt, tgt, lane);
    }
#undef H2_LOAD_RAW
#undef G2_ST
    __syncthreads();
}

constexpr int G3_STS = 136, G3_VTS = 72;
constexpr int G3_ST = 0, G3_VT = G3_ST + 64 * G3_STS * 2, G3_OT = G3_VT + 64 * G3_VTS * 2, G3_WT = G3_OT + 64 * G3_VTS * 2, G3_QT = G3_WT + 64 * G3_STS * 2, G3_KT = G3_QT + 64 * G3_STS * 2,
              G3_PT = G3_KT + 128 * G3_VTS * 2, G3_UT = G3_PT + 64 * G3_VTS * 2, G3_END = G3_UT + 64 * G3_VTS * 2;
static_assert(G3_END <= RING_BYTES, "G3 LDS");
__device__ __forceinline__ void gdn_scan_phase(LAS unsigned char* lds, bf16* p_, const bf16* wbuf_, const bf16* attn_, const float* g_, int vcu, int G, bf16* oalt_ = nullptr) {
    GAS bf16* const p = (GAS bf16*)p_; const GAS bf16* const wbuf = (const GAS bf16*)wbuf_; const GAS bf16* const attn = (const GAS bf16*)attn_; const GAS float* const g = (const GAS float*)g_; GAS bf16* const oalt = (GAS bf16*)oalt_;
    int tid_ = threadIdx.x; asm volatile("" : "+v"(tid_));
    const int tid = tid_, lane = tid & 63, wid = __builtin_amdgcn_readfirstlane(tid >> 6), r32 = lane & 31, hi = lane >> 5;
    const int role = wid >> 2, a = (wid >> 1) & 1, bb = wid & 1, r = wid >> 1;
    LAS bf16* ST = (LAS bf16*)(lds + G3_ST); LAS bf16* VT = (LAS bf16*)(lds + G3_VT); LAS bf16* OT = (LAS bf16*)(lds + G3_OT);
    LAS bf16* WT = (LAS bf16*)(lds + G3_WT); LAS bf16* QT = (LAS bf16*)(lds + G3_QT); LAS bf16* KT = (LAS bf16*)(lds + G3_KT); LAS bf16* PT = (LAS bf16*)(lds + G3_PT); LAS bf16* UT = (LAS bf16*)(lds + G3_UT);
    for (int unit = vcu; unit < BATCH * NHEADS * 2; unit += G) {
        const int bh = unit >> 1, e = unit & 1, b = bh >> 4, h = bh & 15;
        for (int i = tid; i < G3_VT / 4; i += NWAVES * 64) ((LAS unsigned*)lds)[i] = 0u;
        f32x16 Sacc = {};
        const int r16a = tid >> 4, c16 = tid & 15, r8 = tid >> 3, c8 = tid & 7;
        const GAS bf16* gW = wbuf + (size_t)r16a * DMODEL + h * HD + 8 * c16;
        const GAS bf16* gQ = p + (size_t)r16a * GDN_MAIN + h * HD + 8 * c16;
        const GAS bf16* gK = p + (size_t)r16a * GDN_MAIN + 2048 + h * HD + 8 * c16;
        const GAS bf16* gP = attn + (size_t)r8 * 64 + 8 * c8;
        const GAS bf16* gU = p + (size_t)r8 * GDN_MAIN + 4096 + h * HD + e * 64 + 8 * c8;
        LAS bf16* sW = WT + r16a * G3_STS + 8 * c16; LAS bf16* sQ = QT + r16a * G3_STS + 8 * c16;
        LAS bf16* sK = KT + (2 * r16a + (c16 >> 3)) * G3_VTS + 8 * (c16 & 7);
        LAS bf16* sP = PT + r8 * G3_VTS + 8 * c8; LAS bf16* sU = UT + r8 * G3_VTS + 8 * c8;
        GAS bf16* oRow = (oalt ? oalt : p + 4096) + h * HD + e * 64; const size_t oPitch = oalt ? DMODEL : GDN_MAIN;
        const LAS bf16* aRd = (role == 0 ? WT : QT) + (32 * a + r32) * G3_STS + 8 * hi;
        const LAS bf16* sRd = ST + (32 * bb + r32) * G3_STS + 8 * hi; const LAS bf16* vRd = VT + (32 * bb + r32) * G3_VTS + 8 * hi;
        const LAS bf16* uRd = UT + (32 * bb + r32) * G3_VTS + 32 * a + 4 * hi; const LAS bf16* pRd = PT + (32 * a + r32) * G3_VTS + 8 * hi; const LAS bf16* kRd = KT + (32 * r + r32) * G3_VTS + 8 * hi;
        LAS bf16* vWr = VT + (32 * bb + r32) * G3_VTS + 32 * a + 4 * hi; LAS bf16* sWr = ST + (32 * bb + r32) * G3_STS + 32 * r + 4 * hi;
        v4u gw0, gw1, gq0, gq1, gk0, gk1, gp0, gu0; float dd;
#define G3_LOAD(nn) do { const size_t row0_ = (size_t)b * SEQ + (size_t)(nn) * 64; \
            gw0 = *(const GAS v4u*)(gW + row0_ * DMODEL); gw1 = *(const GAS v4u*)(gW + (row0_ + 32) * DMODEL); \
            gq0 = *(const GAS v4u*)(gQ + row0_ * GDN_MAIN); gq1 = *(const GAS v4u*)(gQ + (row0_ + 32) * GDN_MAIN); \
            gk0 = *(const GAS v4u*)(gK + row0_ * GDN_MAIN); gk1 = *(const GAS v4u*)(gK + (row0_ + 32) * GDN_MAIN); \
            gp0 = *(const GAS v4u*)(gP + ((size_t)(b * 64 + (nn)) * 16 + h) * 4096); gu0 = *(const GAS v4u*)(gU + row0_ * GDN_MAIN); \
            dd = __expf(g[(row0_ + 63) * 16 + h]); } while (0)
        G3_LOAD(0);
        __syncthreads();
#pragma unroll 1
        for (int n = 0; n < 64; ++n) {
            const size_t row0_ = (size_t)b * SEQ + (size_t)n * 64; const int nn = (n + 1 < 64) ? n + 1 : n;
            *(LAS v4u*)(sW) = gw0; *(LAS v4u*)(sW + 32 * G3_STS) = gw1; *(LAS v4u*)(sQ) = gq0; *(LAS v4u*)(sQ + 32 * G3_STS) = gq1;
            *(LAS v4u*)(sK) = gk0; *(LAS v4u*)(sK + 64 * G3_VTS) = gk1; *(LAS v4u*)(sP) = gp0; *(LAS v4u*)(sU) = gu0;
            const float dcur = dd;
            WG_BAR();
            G3_LOAD(nn);
            f32x16 acc_ = {};
#pragma unroll
            for (int s = 0; s < 8; ++s) acc_ = MFMA32(*(const LAS bf16x8*)(aRd + 16 * s), *(const LAS bf16x8*)(sRd + 16 * s), acc_);
            if (role == 0) {
#pragma unroll
                for (int q = 0; q < 4; ++q) { const v2u uu = *(const LAS v2u*)(uRd + 8 * q); v2u w_;
                    w_.x = pk2(bflo(uu.x) - acc_[4 * q], bfhi(uu.x) - acc_[4 * q + 1]); w_.y = pk2(bflo(uu.y) - acc_[4 * q + 2], bfhi(uu.y) - acc_[4 * q + 3]);
                    *(LAS v2u*)(vWr + 8 * q) = w_; }
            }
            WG_BAR();
            bf16x8 Vf_[4];
#pragma unroll
            for (int s = 0; s < 4; ++s) Vf_[s] = *(const LAS bf16x8*)(vRd + 16 * s);
            if (role == 1) {
#pragma unroll
                for (int s = 0; s < 4; ++s) acc_ = MFMA32(*(const LAS bf16x8*)(pRd + 16 * s), Vf_[s], acc_);
#pragma unroll
                for (int rr = 0; rr < 16; ++rr) OT[(32 * a + (rr & 3) + 8 * (rr >> 2) + 4 * hi) * G3_VTS + 32 * bb + r32] = (bf16)f2bf(acc_[rr]);
            }
            Sacc = Sacc * dcur;
#pragma unroll
            for (int s = 0; s < 4; ++s) Sacc = MFMA32(*(const LAS bf16x8*)(kRd + 16 * s), Vf_[s], Sacc);
#pragma unroll
            for (int q = 0; q < 4; ++q) { v2u w_; w_.x = pk2(Sacc[4 * q], Sacc[4 * q + 1]); w_.y = pk2(Sacc[4 * q + 2], Sacc[4 * q + 3]); *(LAS v2u*)(sWr + 8 * q) = w_; }
            WG_BAR();
            *(GAS v4u*)(oRow + (row0_ + r8) * oPitch + 8 * c8) = *(const LAS v4u*)(OT + r8 * G3_VTS + 8 * c8);
        }
#undef G3_LOAD
        VM_WAIT(); __syncthreads();
    }
}

__device__ __forceinline__ void gdn_gate_phase(bf16* p, const float* norm_w, int gw, int NGW, int lane, bf16* oalt = nullptr) {
    for (int m = gw; m < MROWS; m += NGW) {
        GAS bf16* orow = (GAS bf16*)p + (size_t)m * GDN_MAIN + 4096; const GAS bf16* zrow = (const GAS bf16*)p + (size_t)m * GDN_MAIN + 6144;
#pragma unroll
        for (int it = 0; it < 4; ++it) { const int col = it * 512 + lane * 8;
            const v4u ov = *(const GAS v4u*)(orow + col), zv = *(const GAS v4u*)(zrow + col);
            float o[8] = {bflo(ov.x), bfhi(ov.x), bflo(ov.y), bfhi(ov.y), bflo(ov.z), bfhi(ov.z), bflo(ov.w), bfhi(ov.w)};
            float z[8] = {bflo(zv.x), bfhi(zv.x), bflo(zv.y), bfhi(zv.y), bflo(zv.z), bfhi(zv.z), bflo(zv.w), bfhi(zv.w)};
            float s = 0.f;
#pragma unroll
            for (int c = 0; c < 8; ++c) s += o[c] * o[c];
            s = sum16(s); const float rs = __builtin_amdgcn_rsqf(s * (1.f / HD) + GDN_EPS);
            const f32x4 wa = *(const GAS f32x4*)((const GAS float*)norm_w + (col & 127)), wb = *(const GAS f32x4*)((const GAS float*)norm_w + (col & 127) + 4);
#pragma unroll
            for (int c = 0; c < 8; ++c) o[c] = o[c] * rs * (c < 4 ? wa[c] : wb[c - 4]) * silu_f(z[c]);
            v4u w; w.x = pk2(o[0], o[1]); w.y = pk2(o[2], o[3]); w.z = pk2(o[4], o[5]); w.w = pk2(o[6], o[7]); *(GAS v4u*)((oalt ? (GAS bf16*)oalt + (size_t)m * DMODEL : orow) + col) = w; }
    }
}

#ifndef PG8_SP2
#define PG8_SP2 true
#endif
#ifndef PG8_ALIGN
#define PG8_ALIGN true
#endif
#ifndef EN_P0
#define EN_P0 1
#endif
#ifndef EN_G1
#define EN_G1 1
#endif
#ifndef EN_G2
#define EN_G2 1
#endif
#ifndef EN_G3
#define EN_G3 1
#endif
#ifndef EN_G4
#define EN_G4 1
#endif
#ifndef EN_G5
#define EN_G5 1
#endif
#ifndef EN_G6
#define EN_G6 1
#endif
#ifndef EN_G7
#define EN_G7 1
#endif
#ifndef EN_G8
#define EN_G8 1
#endif
#ifndef EN_G9
#define EN_G9 1
#endif
#ifndef EN_D1
#define EN_D1 1
#endif
#ifndef EN_D2
#define EN_D2 1
#endif
#ifndef EN_D3
#define EN_D3 1
#endif
#ifndef EN_D4
#define EN_D4 1
#endif
#ifndef EN_D5
#define EN_D5 1
#endif
#ifndef EN_D6U
#define EN_D6U 1
#endif
#ifndef EN_D6D
#define EN_D6D 1
#endif
#ifndef EN_D7
#define EN_D7 1
#endif
#ifndef REP_P0
#define REP_P0 1
#endif
#ifndef REP_G1
#define REP_G1 1
#endif
#ifndef REP_G2
#define REP_G2 1
#endif
#ifndef REP_G3
#define REP_G3 1
#endif
#ifndef REP_G4
#define REP_G4 1
#endif
#ifndef REP_G5
#define REP_G5 1
#endif
#ifndef REP_G6
#define REP_G6 1
#endif
#ifndef REP_G7
#define REP_G7 1
#endif
#ifndef REP_G8
#define REP_G8 1
#endif
#ifndef REP_G9
#define REP_G9 1
#endif
#ifndef REP_D1
#define REP_D1 1
#endif
#ifndef REP_D2
#define REP_D2 1
#endif
#ifndef REP_D3
#define REP_D3 1
#endif
#ifndef REP_D4
#define REP_D4 1
#endif
#ifndef REP_D5
#define REP_D5 1
#endif
#ifndef REP_D6U
#define REP_D6U 1
#endif
#ifndef REP_D6D
#define REP_D6D 1
#endif
#ifndef REP_D7
#define REP_D7 1
#endif
#ifndef G2_VER
#define G2_VER 2
#endif
#if G2_VER == 2
#define G2_FN gdn_chunk_phase2
#else
#define G2_FN gdn_chunk_phase
#endif
#ifndef REP_BA
#define REP_BA 1
#endif
#ifndef PROBE_NOSTORE
#define PROBE_NOSTORE 0
#endif
struct Args { const float* in[16]; float* out; unsigned char* ws; int ph_lo, ph_hi; };
__global__ void __launch_bounds__(NWAVES * 64, 2) yoco_fwd(Args args) {
    extern __shared__ __attribute__((aligned(16))) unsigned char lds_raw[];
    LAS unsigned char* lds = (LAS unsigned char*)lds_raw;
    volatile LAS unsigned* MISC = (volatile LAS unsigned*)(lds + MISC_OFF);
    const int tid = threadIdx.x, lane = tid & 63, wave = __builtin_amdgcn_readfirstlane(tid >> 6);
    const int G = gridDim.x, bx = blockIdx.x, vcu = (G % 8 == 0) ? (bx % 8) * (G / 8) + bx / 8 : bx;
    const int gw = vcu * NWAVES + wave, NGW = G * NWAVES, gtid = vcu * NWAVES * 64 + tid, NGT = G * NWAVES * 64;
    const float* ln_g = args.in[14]; const float* ln_b = args.in[15];
    for (int u = tid; u < (LDS_BYTES - LDSCTL_OFF) / 4; u += NWAVES * 64) ((LAS unsigned*)(lds + LDSCTL_OFF))[u] = 0u;
    __syncthreads();
    XcdBarrier bar; bar.bar = (unsigned*)(args.ws + WS_CTL) + CW_BAR; bar.x = 0; bar.st = nullptr;
    if (!MK_PER_PHASE) bar = xcd_barrier_post((unsigned*)(args.ws + WS_CTL) + CW_BAR, MISC + 8);
    const int lo = args.ph_lo, hi = args.ph_hi;
#define IN(k) (lo <= (k) && (k) < hi)
#define FRESH_LANE() int ln_ = lane; asm volatile("" : "+v"(ln_)); unsigned char* ws_ = args.ws; asm volatile("" : "+s"(ws_)); int gw_ = gw, vcu_ = vcu, bx_ = bx; asm volatile("" : "+s"(gw_), "+s"(vcu_), "+s"(bx_))
#define x_in         (args.in[0])
#define gdn_w_in     (args.in[1])
#define gdn_conv_w   (args.in[2])
#define gdn_a_log    (args.in[3])
#define gdn_dt_bias  (args.in[4])
#define gdn_norm_w   (args.in[5])
#define gdn_w_out    (args.in[6])
#define diff_w_q     (args.in[7])
#define diff_lambda  (args.in[8])
#define diff_subln_w (args.in[9])
#define diff_w_o     (args.in[10])
#define shared_w_kv  (args.in[11])
#define mlp_w_up     (args.in[12])
#define mlp_w_down   (args.in[13])
#define beta  ((float*)(ws_ + WS_BETA))
#define gdec  ((float*)(ws_ + WS_G))
#define halo  ((bf16*)(ws_ + WS_HALO))
#define WA    ((bf16*)(ws_ + WS_WA))
#define WB    ((bf16*)(ws_ + WS_WB))
#define attnb ((bf16*)(ws_ + WS_ATTN))
#define XB    ((bf16*)(ws_ + WS_XB))
#define HB    ((bf16*)(ws_ + WS_Y))
#define WBUF  ((bf16*)(ws_ + WS_Y + QTR))
#define R1    ((bf16*)(ws_ + WS_R1))
#define Kb    (R1)
#define Vb    (R1 + QTR / 2)
#define Qb    (R1 + 2 * (QTR / 2))
#define HID   (Qb)
#define SEAM(k) do { if (!MK_PER_PHASE && (k) + 1 < hi) xcd_barrier(bar); } while (0)

    for (int rep_ = 0; rep_ < REP_P0; ++rep_) if (EN_P0 && IN(0)) { FRESH_LANE();
        for (int m = gw_; m < MROWS; m += NGW) row_to_bf16(x_in + (size_t)m * DMODEL, XB + (size_t)m * DMODEL, ln_);
        convert_w(lds, gw_, NGW, wave, ln_, gdn_w_in, DMODEL, GDN_PROJ, 0, GDN_PROJ, WA, 0);
        SEAM(0);
    }
    for (int l = 0; l < 2; ++l) {
        const int pb = 1 + 9 * l;
        for (int rep_ = 0; rep_ < REP_G1; ++rep_) if (EN_G1 && IN(pb + 0)) { FRESH_LANE();
            pg8::Gemm g{XB, WA, MROWS, GDN_MAIN, DMODEL, DMODEL}; pg8::StaticOrder S; S.init(MROWS, GDN_MAIN, G, bx_);
            pg8::EpiStore<0> E{R1, GDN_MAIN, 0, 0, -1, 1.f, halo};
            pg8::gemm_phase<pg8::EpiStore<0>, pg8::StaticOrder, PG8_ALIGN, PG8_SP2>(lds + RING_OFF, g, S, E);
            { int ln2_ = lane; asm volatile("" : "+v"(ln2_));
              for (int rb_ = 0; rb_ < REP_BA; ++rb_) ba_proj(XB, WA, gdn_a_log + l * 16, gdn_dt_bias + l * 16, beta, gdec, gw_, NGW, ln2_); }
            SEAM(pb + 0);
        }
        for (int rep_ = 0; rep_ < REP_G2; ++rep_) if (EN_G2 && IN(pb + 1)) { FRESH_LANE(); G2_FN(lds, R1, halo, beta, gdec, WBUF, attnb, gdn_conv_w + (size_t)l * 4 * CONVC, vcu_, G, (rep_ + 1 < REP_G2) ? (bf16*)args.out : nullptr); SEAM(pb + 1); }
        for (int rep_ = 0; rep_ < REP_G3; ++rep_) if (EN_G3 && IN(pb + 2)) { FRESH_LANE(); gdn_scan_phase(lds, R1, WBUF, attnb, gdec, vcu_, G, (rep_ + 1 < REP_G3) ? (bf16*)args.out : nullptr); SEAM(pb + 2); }
        for (int rep_ = 0; rep_ < REP_G4; ++rep_) if (EN_G4 && IN(pb + 3)) { FRESH_LANE();
            gdn_gate_phase(R1, gdn_norm_w + l * HD, gw_, NGW, ln_, (rep_ + 1 < REP_G4) ? (bf16*)args.out : nullptr);
            convert_w(lds, gw_, NGW, wave, ln_, gdn_w_out + (size_t)l * DMODEL * DMODEL, DMODEL, DMODEL, 0, DMODEL, WA, 0);
            convert_w(lds, gw_, NGW, wave, ln_, mlp_w_up + (size_t)l * DMODEL * DFF, DMODEL, DFF, 0, DFF, WB, 0);
            SEAM(pb + 3);
        }
        for (int rep_ = 0; rep_ < REP_G5; ++rep_) if (EN_G5 && IN(pb + 4)) { FRESH_LANE();
            pg8::Gemm g{R1 + 4096, WA, MROWS, DMODEL, DMODEL, GDN_MAIN}; pg8::StaticOrder S; S.init(MROWS, DMODEL, G, bx_);
            pg8::EpiStore<0> E{(rep_ + 1 < REP_G5) ? (bf16*)args.out : HB, DMODEL, 0, 0, -1, 1.f, nullptr};
            pg8::gemm_phase<pg8::EpiStore<0>, pg8::StaticOrder, PG8_ALIGN, PG8_SP2>(lds + RING_OFF, g, S, E);
            SEAM(pb + 4);
        }
        const float* g1 = ln_g + (size_t)(l * 2) * DMODEL; const float* b1 = ln_b + (size_t)(l * 2) * DMODEL;
        for (int rep_ = 0; rep_ < REP_G6; ++rep_) if (EN_G6 && IN(pb + 5)) { FRESH_LANE();
            ln_pass_b(XB, HB, g1, b1, XB, nullptr, ALPHA_RES, gw_, NGW, ln_);
            convert_w(lds, gw_, NGW, wave, ln_, mlp_w_down + (size_t)l * DFF * DMODEL, DFF, DMODEL, 0, DMODEL, WA, 0);
            SEAM(pb + 5);
        }
        for (int rep_ = 0; rep_ < REP_G7; ++rep_) if (EN_G7 && IN(pb + 6)) { FRESH_LANE();
            pg8::Gemm g{XB, WB, MROWS, DFF, DMODEL, DMODEL}; pg8::StaticOrder S; S.init(MROWS, DFF, G, bx_);
            pg8::EpiStore<1> E{R1, DFF, 0, 0, -1, 1.f, nullptr};
            pg8::gemm_phase<pg8::EpiStore<1>, pg8::StaticOrder, PG8_ALIGN, PG8_SP2>(lds + RING_OFF, g, S, E);
            SEAM(pb + 6);
        }
        for (int rep_ = 0; rep_ < REP_G8; ++rep_) if (EN_G8 && IN(pb + 7)) { FRESH_LANE();
            pg8::Gemm g{R1, WA, MROWS, DMODEL, DFF, DFF}; pg8::StaticOrder S; S.init(MROWS, DMODEL, G, bx_);
            pg8::EpiStore<0> E{(rep_ + 1 < REP_G8) ? (bf16*)args.out : HB, DMODEL, 0, 0, -1, 1.f, nullptr};
            pg8::gemm_phase<pg8::EpiStore<0>, pg8::StaticOrder, PG8_ALIGN, PG8_SP2>(lds + RING_OFF, g, S, E);
            SEAM(pb + 7);
        }
        for (int rep_ = 0; rep_ < REP_G9; ++rep_) if (EN_G9 && IN(pb + 8)) { FRESH_LANE();
            const float* g2 = ln_g + (size_t)(l * 2 + 1) * DMODEL; const float* b2 = ln_b + (size_t)(l * 2 + 1) * DMODEL;
            ln_pass_b(XB, HB, g2, b2, XB, nullptr, ALPHA_RES, gw_, NGW, ln_);
            if (l == 0) convert_w(lds, gw_, NGW, wave, ln_, gdn_w_in + (size_t)DMODEL * GDN_PROJ, DMODEL, GDN_PROJ, 0, GDN_PROJ, WA, 0);
            else { convert_w(lds, gw_, NGW, wave, ln_, shared_w_kv, DMODEL, 2 * DMODEL, 0, 2 * DMODEL, WA, 0);
                   convert_w(lds, gw_, NGW, wave, ln_, diff_w_q, DMODEL, DMODEL, 0, DMODEL, WA, 2 * DMODEL); }
            SEAM(pb + 8);
        }
    }
    for (int j = 0; j < 2; ++j) {
        const int pb = 19 + 10 * j, L = 2 + j;
        for (int rep_ = 0; rep_ < REP_D1; ++rep_) if (EN_D1 && IN(pb + 0)) { FRESH_LANE();
            const int N = (j == 0) ? 3 * DMODEL : DMODEL;
            pg8::Gemm g{XB, WA, MROWS, N, DMODEL, DMODEL}; pg8::StaticOrder S; S.init(MROWS, N, G, bx_);
            pg8::EpiStore<0> E{(j == 0) ? Kb : Qb, DMODEL, (j == 0) ? DMODEL : 0, QTR / 2, (j == 0) ? 2 : 0, dattn::C2, nullptr};
            pg8::gemm_phase<pg8::EpiStore<0>, pg8::StaticOrder, PG8_ALIGN, PG8_SP2>(lds + RING_OFF, g, S, E);
            SEAM(pb + 0);
        }
        for (int rep_ = 0; rep_ < REP_D2; ++rep_) if (EN_D2 && IN(pb + 1)) { FRESH_LANE();
            const float lambda_init = 0.8f - 0.6f * expf(-0.3f * (float)L);
            const float* lp = diff_lambda + (size_t)j * 256;
            const float e1 = wave_sum(lp[ln_] * lp[64 + ln_]), e2 = wave_sum(lp[128 + ln_] * lp[192 + ln_]);
            const dattn::Params AP{(const dattn::bf16*)Qb, (const dattn::bf16*)Kb, (const dattn::bf16*)Vb, (rep_ + 1 < REP_D2) ? (dattn::bf16*)args.out : (dattn::bf16*)Qb, diff_subln_w + j * HD, __expf(e1) - __expf(e2) + lambda_init, 1.f - lambda_init};
            dattn::phase<8>((char*)lds_raw + RING_OFF, AP, G, bx_);
            { int ln2_ = lane; asm volatile("" : "+v"(ln2_));
              convert_w(lds, gw_, NGW, wave, ln2_, diff_w_o + (size_t)j * DMODEL * DMODEL, DMODEL, DMODEL, 0, DMODEL, WB, 0);
              convert_w(lds, gw_, NGW, wave, ln2_, mlp_w_up + (size_t)L * DMODEL * DFF, DMODEL, DFF, 0, DFF, WA, 0); }
            SEAM(pb + 1);
        }
        for (int rep_ = 0; rep_ < REP_D4; ++rep_) if (EN_D4 && IN(pb + 3)) { FRESH_LANE();
            pg8::Gemm g{Qb, WB, MROWS, DMODEL, DMODEL, DMODEL}; pg8::StaticOrder S; S.init(MROWS, DMODEL, G, bx_);
            pg8::EpiStore<0> E{(rep_ + 1 < REP_D4) ? (bf16*)args.out : HB, DMODEL, 0, 0, -1, 1.f, nullptr};
            pg8::gemm_phase<pg8::EpiStore<0>, pg8::StaticOrder, PG8_ALIGN, PG8_SP2>(lds + RING_OFF, g, S, E);
            SEAM(pb + 3);
        }
        const float* g1 = ln_g + (size_t)(L * 2) * DMODEL; const float* b1 = ln_b + (size_t)(L * 2) * DMODEL;
        for (int rep_ = 0; rep_ < REP_D5; ++rep_) if (EN_D5 && IN(pb + 4)) { FRESH_LANE();
            ln_pass_b(XB, HB, g1, b1, XB, nullptr, ALPHA_RES, gw_, NGW, ln_);
            convert_w(lds, gw_, NGW, wave, ln_, mlp_w_down + (size_t)L * DFF * DMODEL, DFF, DMODEL, 0, DMODEL, WB, 0);
            SEAM(pb + 4);
        }
        for (int hf = 0; hf < 2; ++hf) {
            const size_t roff = (size_t)hf * (MROWS / 2);
            for (int rep_ = 0; rep_ < REP_D6U; ++rep_) if (EN_D6U && IN(pb + 5 + 2 * hf)) { FRESH_LANE();
                pg8::Gemm g{XB + roff * DMODEL, WA, MROWS / 2, DFF, DMODEL, DMODEL}; pg8::StaticOrder S; S.init(MROWS / 2, DFF, G, bx_);
                pg8::EpiStore<1> E{(PROBE_NOSTORE && rep_ + 1 < REP_D6U) ? (bf16*)nullptr : HID, DFF, 0, 0, -1, 1.f, nullptr};
                pg8::gemm_phase<pg8::EpiStore<1>, pg8::StaticOrder, PG8_ALIGN, PG8_SP2>(lds + RING_OFF, g, S, E);
                SEAM(pb + 5 + 2 * hf);
            }
            for (int rep_ = 0; rep_ < REP_D6D; ++rep_) if (EN_D6D && IN(pb + 6 + 2 * hf)) { FRESH_LANE();
                pg8::Gemm g{HID, WB, MROWS / 2, DMODEL, DFF, DFF}; pg8::StaticOrder S; S.init(MROWS / 2, DMODEL, G, bx_);
                pg8::EpiStore<0> E{((rep_ + 1 < REP_D6D) ? (bf16*)args.out : HB) + roff * DMODEL, DMODEL, 0, 0, -1, 1.f, nullptr};
                pg8::gemm_phase<pg8::EpiStore<0>, pg8::StaticOrder, PG8_ALIGN, PG8_SP2>(lds + RING_OFF, g, S, E);
                SEAM(pb + 6 + 2 * hf);
            }
        }
        for (int rep_ = 0; rep_ < REP_D7; ++rep_) if (EN_D7 && IN(pb + 9)) { FRESH_LANE();
            const float* g2 = ln_g + (size_t)(L * 2 + 1) * DMODEL; const float* b2 = ln_b + (size_t)(L * 2 + 1) * DMODEL;
            if (j == 0) { ln_pass_b(XB, HB, g2, b2, XB, nullptr, ALPHA_RES, gw_, NGW, ln_);
                          convert_w(lds, gw_, NGW, wave, ln_, diff_w_q + (size_t)DMODEL * DMODEL, DMODEL, DMODEL, 0, DMODEL, WA, 0); }
            else { ln_pass_b(XB, HB, g2, b2, nullptr, args.out, ALPHA_RES, gw_, NGW, ln_); }
            SEAM(pb + 9);
        }
    }
#undef IN
#undef SEAM
}

extern "C" void kernel_launch(void* const* d_in, const int* in_sizes, int n_in, void* d_out, int out_size, void* d_ws, size_t ws_size, hipStream_t stream) {
    static int grid = 0;
    if (grid == 0) {
        if (n_in != 16 || in_sizes[0] != MROWS * DMODEL || out_size != MROWS * DMODEL || ws_size < WS_END) { fprintf(stderr, "kernel_launch: unexpected shapes / workspace (n_in %d, ws %zu < %zu); nothing launched\n", n_in, ws_size, (size_t)WS_END); grid = -1; return; }
        int dev = 0, cus = 0, per_cu = 0;
        if (hipGetDevice(&dev) != hipSuccess || hipDeviceGetAttribute(&cus, hipDeviceAttributeMultiprocessorCount, dev) != hipSuccess) { grid = -1; return; }
        if (hipFuncSetAttribute((const void*)yoco_fwd, hipFuncAttributeMaxDynamicSharedMemorySize, LDS_BYTES) != hipSuccess) { fprintf(stderr, "kernel_launch: hipFuncSetAttribute failed\n"); grid = -1; return; }
        if (hipOccupancyMaxActiveBlocksPerMultiprocessor(&per_cu, (const void*)yoco_fwd, NWAVES * 64, LDS_BYTES) != hipSuccess || per_cu < 1)
            fprintf(stderr, "kernel_launch: note: occupancy query reports %d workgroups per CU\n", per_cu);
        (void)hipGetLastError();
        grid = cus;
    }
    if (grid < 0) return;
    if (hipMemsetAsync((char*)d_ws + WS_CTL, 0, CTL_ZERO_BYTES, stream) != hipSuccess) return;
    Args a{};
    for (int i = 0; i < 16; ++i) a.in[i] = (const float*)d_in[i];
    a.out = (float*)d_out; a.ws = (unsigned char*)d_ws;
#if MK_PER_PHASE
    for (int k = 0; k < N_PHASES; ++k) { a.ph_lo = k; a.ph_hi = k + 1; hipLaunchKernelGGL(yoco_fwd, dim3(grid), dim3(NWAVES * 64), LDS_BYTES, stream, a); }
#else
    a.ph_lo = 0; a.ph_hi = N_PHASES;
    hipLaunchKernelGGL(yoco_fwd, dim3(grid), dim3(NWAVES * 64), LDS_BYTES, stream, a);
#endif
    const hipError_t le = hipPeekAtLastError();
    if (le != hipSuccess) fprintf(stderr, "kernel_launch: launch failed: %s\n", hipGetErrorName(le));
}
```

```cpp
#include <hip/hip_runtime.h>
#include <hip/hip_bf16.h>
#include <cstdio>
#include <cstdint>
#include <cmath>

namespace pg8 {
#define PG8_LAS __attribute__((address_space(3)))
typedef unsigned short bf16_t;
typedef short bf16x8 __attribute__((ext_vector_type(8)));
typedef float f32x4 __attribute__((ext_vector_type(4)));
typedef unsigned u32x4 __attribute__((ext_vector_type(4)));
#define PG8_GAS __attribute__((address_space(1)))
#ifndef PG8_STORE_SC1
#define PG8_STORE_SC1 0
#endif
constexpr int BM = 256, BK = 64, HALF = 128, HTB = HALF * BK * 2  , STAGE_BYTES = 8 * HTB, NXCD = 8, WGM = 8;

__host__ __device__ __forceinline__ int lds_byte(int r, int c) { const int st = (r >> 4) * 2 + (c >> 5), rr = r & 15, cc = c & 31, ob = rr * 64 + cc * 2; return st * 1024 + (ob ^ (((ob >> 9) & 1) << 5)); }
__host__ __device__ __forceinline__ void stage_rc(int b, int& R, int& C) { const int st = b / 1024, sb = b % 1024, swz = sb ^ (((sb >> 9) & 1) << 5); R = (st >> 1) * 16 + swz / 64; C = (st & 1) * 32 + (swz % 64) / 2; }
__host__ __device__ __forceinline__ int perm32(int rho) { const int n = rho >> 4, i = rho & 15; return 8 * (i >> 2) + 4 * n + (i & 3); }

struct Unit { int pm, pn; };
struct Gemm { const bf16_t* A; const bf16_t* Bt; int M, N, K, lda; };

struct StaticOrder {
    int nM, nN, nwg, G, c;
    __host__ __device__ void init(int M, int N, int G_, int c_) { nM = M / BM; nN = N / BM; nwg = nM * nN; G = G_; c = c_; }
    __host__ __device__ bool next(int i, Unit& u) const {
        const long L = (long)i * G + c; if (L >= nwg) return false;
        int wgid = (int)L; { const int q = nwg / NXCD, r = nwg % NXCD, xcd = wgid % NXCD, off = wgid / NXCD; wgid = (xcd < r ? xcd * (q + 1) : r * (q + 1) + (xcd - r) * q) + off; }
        const int nig = WGM * nN, gid = wgid / nig, fm = gid * WGM, gsz = (nM - fm) < WGM ? (nM - fm) : WGM;
        u.pm = fm + ((wgid % nig) % gsz); u.pn = (wgid % nig) / gsz; return true;
    }
    __device__ __forceinline__ void a_ready(const Unit&) const {}
    __device__ __forceinline__ void done(const Unit&) const {}
};

__device__ __forceinline__ unsigned cvt_pk_bf16(float lo, float hi) { unsigned r; asm volatile("v_cvt_pk_bf16_f32 %0, %1, %2" : "=v"(r) : "v"(lo), "v"(hi)); return r; }

template <int ACT> struct EpiStore {
    static constexpr bool PERM = true, AFTER_DRAIN = false;
    bf16_t* O; int ldc; int split_cols; size_t split_stride; int scale_tile; float scale0; bf16_t* halo;
    __device__ __forceinline__ void operator()(const f32x4 (&acc)[2][2][4][2], const Unit& u, int wr, int wc, int fr, int fq) const {
        const int row0 = u.pm * BM + wr * 64 + fr; int colt = u.pn * BM; PG8_GAS bf16_t* base = (PG8_GAS bf16_t*)O; PG8_GAS bf16_t* hal = (PG8_GAS bf16_t*)halo;
        int t = 0; if (split_cols) { t = colt / split_cols; base += (size_t)t * split_stride; colt -= t * split_cols; }
        const float sc = (t == scale_tile) ? scale0 : 1.f;
        const int col0 = colt + wc * 32 + 8 * fq;
#pragma unroll
        for (int ai = 0; ai < 2; ++ai)
#pragma unroll
            for (int m = 0; m < 4; ++m) { const int row = row0 + ai * HALF + m * 16; PG8_GAS bf16_t* rowp = base + (size_t)row * ldc + col0;
#pragma unroll
                for (int bj = 0; bj < 2; ++bj) { f32x4 v0 = acc[ai][bj][m][0], v1 = acc[ai][bj][m][1];
                    if (ACT == 1) {
#pragma unroll
                        for (int e = 0; e < 4; ++e) { const float a = fmaxf(v0[e], 0.f), b = fmaxf(v1[e], 0.f); v0[e] = a * a; v1[e] = b * b; } }
                    if (sc != 1.f) { v0 = v0 * sc; v1 = v1 * sc; }
                    u32x4 w; w.x = cvt_pk_bf16(v0[0], v0[1]); w.y = cvt_pk_bf16(v0[2], v0[3]); w.z = cvt_pk_bf16(v1[0], v1[1]); w.w = cvt_pk_bf16(v1[2], v1[3]);
#if PG8_STORE_SC1
                    if (O != nullptr) asm volatile("global_store_dwordx4 %0, %1, off sc1\n\ts_nop 1" :: "v"(rowp + bj * HALF), "v"(w) : "memory"); else asm volatile("" :: "v"(w));
#else
                    if (O != nullptr) *(PG8_GAS u32x4*)(rowp + bj * HALF) = w; else asm volatile("" :: "v"(w));
#endif
                    if (halo != nullptr && m == 3 && fr >= 13) { const int c = col0 + bj * HALF; if (c < 6144) *(PG8_GAS u32x4*)(hal + ((size_t)(row >> 6) * 3 + (fr - 13)) * 6144 + c) = w; }
                } }
    }
};
template <class Epi, class Sched, bool ALIGN_EPI = false, bool SP2 = false>
__device__ __forceinline__ void gemm_phase(PG8_LAS unsigned char* lds, const Gemm g, const Sched& S, const Epi& E) {
    int tid_ = threadIdx.x; asm volatile("" : "+v"(tid_));
    const int tid = tid_, wid = __builtin_amdgcn_readfirstlane(tid >> 6), lane = tid & 63, wr = wid >> 2, wc = wid & 3, fr = lane & 15, fq = lane >> 4;
    const int K = g.K, nt = K / BK, lda = g.lda;
    unsigned voffA[2], voffB[2];
#pragma unroll
    for (int i = 0; i < 2; ++i) { int R, C; stage_rc(tid * 16 + i * 8192, R, C); const int Rb = Epi::PERM ? ((R & ~31) + perm32(R & 31)) : R;
        voffA[i] = (unsigned)(R * lda + C) * 2u; voffB[i] = (unsigned)(Rb * K + C) * 2u; }
    const size_t kstep = (size_t)(BK * 2);
    const size_t hA = (size_t)HALF * lda * 2, hB = (size_t)HALF * K * 2;
    const size_t tA = 2 * hA, tB = 2 * hB;
    const unsigned ldsw = (unsigned)wid * 1024u;
    const int aoff = lds_byte(wr * 64 + fr, fq * 8), boff = lds_byte(wc * 32 + fr, fq * 8);
#define PG8_SA(b, h) (((b) * 2 + (h)) * HTB)
#define PG8_SB(b, h) ((4 + (b) * 2 + (h)) * HTB)
#define PG8_STAGE(bufoff, gbase, voff) do { _Pragma("unroll") for (int _i = 0; _i < 2; ++_i) \
        __builtin_amdgcn_global_load_lds((const unsigned*)((const char*)(gbase) + (voff)[_i]), (PG8_LAS unsigned*)(lds + (bufoff) + ldsw + _i * 8192), 16, 0, 0); } while (0)
#define PG8_LDA(dst, b, h) do { _Pragma("unroll") for (int m = 0; m < 4; ++m) _Pragma("unroll") for (int k = 0; k < 2; ++k) dst[m][k] = *(const PG8_LAS bf16x8*)(lds + PG8_SA(b, h) + aoff + m * 2048 + k * 1024); } while (0)
#define PG8_LDB(dst, b, h) do { _Pragma("unroll") for (int n = 0; n < 2; ++n) _Pragma("unroll") for (int k = 0; k < 2; ++k) dst[n][k] = *(const PG8_LAS bf16x8*)(lds + PG8_SB(b, h) + boff + n * 2048 + k * 1024); } while (0)
#define PG8_MMA(ai, bj, At, Bt) do { __builtin_amdgcn_s_setprio(1); _Pragma("unroll") for (int m = 0; m < 4; ++m) _Pragma("unroll") for (int n = 0; n < 2; ++n) _Pragma("unroll") for (int k = 0; k < 2; ++k) \
        acc[ai][bj][m][n] = __builtin_amdgcn_mfma_f32_16x16x32_bf16(Bt[n][k], At[m][k], acc[ai][bj][m][n], 0, 0, 0); __builtin_amdgcn_s_setprio(0); } while (0)
#define PG8_WAIT_V(n) asm volatile("s_waitcnt vmcnt(" #n ")" ::: "memory")
#define PG8_WAIT_L(n) asm volatile("s_waitcnt lgkmcnt(" #n ")" ::: "memory")
#define PG8_BAR __builtin_amdgcn_s_barrier()
#define PG8_SCHED __builtin_amdgcn_sched_barrier(0)
    Unit cur, nxt; int ui = 0;
    if (!S.next(0, cur)) return;
    f32x4 acc[2][2][4][2];
#pragma unroll
    for (int a = 0; a < 2; ++a)
#pragma unroll
        for (int b = 0; b < 2; ++b)
#pragma unroll
            for (int m = 0; m < 4; ++m)
#pragma unroll
                for (int n = 0; n < 2; ++n) acc[a][b][m][n] = (f32x4){0.f, 0.f, 0.f, 0.f};
    bf16x8 At[4][2], B0[2][2], B1[2][2];
    const char* cA = (const char*)g.A + (size_t)cur.pm * tA; const char* cB = (const char*)g.Bt + (size_t)cur.pn * tB;
    S.a_ready(cur);
    if constexpr (SP2) {
        PG8_STAGE(PG8_SB(0, 0), cB, voffB); PG8_STAGE(PG8_SB(0, 1), cB + hB, voffB); PG8_STAGE(PG8_SA(0, 0), cA, voffA); PG8_STAGE(PG8_SA(0, 1), cA + hA, voffA);
        if (wr == 1) PG8_BAR;
        PG8_WAIT_V(2); PG8_BAR;
        PG8_STAGE(PG8_SB(1, 0), cB + kstep, voffB); PG8_STAGE(PG8_SA(1, 0), cA + kstep, voffA); PG8_STAGE(PG8_SB(1, 1), cB + hB + kstep, voffB);
        PG8_WAIT_V(6); PG8_BAR;
    } else {
        PG8_STAGE(PG8_SB(0, 0), cB, voffB); PG8_STAGE(PG8_SA(0, 0), cA, voffA); PG8_STAGE(PG8_SB(0, 1), cB + hB, voffB); PG8_STAGE(PG8_SA(0, 1), cA + hA, voffA);
        if (wr == 1) PG8_BAR;
        PG8_WAIT_V(4); PG8_BAR;
        PG8_STAGE(PG8_SB(1, 0), cB + kstep, voffB); PG8_STAGE(PG8_SA(1, 0), cA + kstep, voffA); PG8_STAGE(PG8_SB(1, 1), cB + hB + kstep, voffB);
        PG8_WAIT_V(6); PG8_BAR;
    }
    for (;;) {
        const bool has_next = S.next(ui + 1, nxt);
        const char* nA = has_next ? (const char*)g.A + (size_t)nxt.pm * tA : cA; const char* nB = has_next ? (const char*)g.Bt + (size_t)nxt.pn * tB : cB;
        for (int t = 0; t < nt; t += 2) {
            const bool last = (t == nt - 2);
            const char* a1 = cA + (size_t)(t + 1) * kstep;
            const char* a2 = last ? nA : cA + (size_t)(t + 2) * kstep; const char* b2 = last ? nB : cB + (size_t)(t + 2) * kstep;
            const char* a3 = a2 + kstep; const char* b3 = b2 + kstep;
            if (last && has_next) S.a_ready(nxt);
            if constexpr (SP2) {
            PG8_LDB(B0, 0, 0); PG8_LDB(B1, 0, 1); PG8_SCHED; PG8_LDA(At, 0, 0); PG8_STAGE(PG8_SA(1, 1), a1 + hA, voffA);
            PG8_WAIT_V(8); PG8_WAIT_L(0); PG8_BAR; PG8_MMA(0, 0, At, B0); PG8_MMA(0, 1, At, B1); PG8_BAR; PG8_SCHED;
            PG8_LDA(At, 0, 1); PG8_STAGE(PG8_SB(0, 0), b2, voffB); PG8_STAGE(PG8_SB(0, 1), b2 + hB, voffB); PG8_STAGE(PG8_SA(0, 0), a2, voffA);
            PG8_WAIT_V(8); PG8_WAIT_L(0); PG8_BAR; PG8_MMA(1, 0, At, B0); PG8_MMA(1, 1, At, B1); PG8_BAR; PG8_SCHED;
            PG8_LDB(B0, 1, 0); PG8_LDB(B1, 1, 1); PG8_SCHED; PG8_LDA(At, 1, 0); PG8_STAGE(PG8_SA(0, 1), a2 + hA, voffA);
            PG8_WAIT_V(8); PG8_WAIT_L(0); PG8_BAR; PG8_MMA(0, 0, At, B0); PG8_MMA(0, 1, At, B1); PG8_BAR; PG8_SCHED;
            PG8_LDA(At, 1, 1); PG8_STAGE(PG8_SB(1, 0), b3, voffB); PG8_STAGE(PG8_SB(1, 1), b3 + hB, voffB); PG8_STAGE(PG8_SA(1, 0), a3, voffA);
            PG8_WAIT_V(8); PG8_WAIT_L(0); PG8_BAR; PG8_MMA(1, 0, At, B0); PG8_MMA(1, 1, At, B1); PG8_BAR; PG8_SCHED;
            } else {
            PG8_LDB(B0, 0, 0); PG8_SCHED; PG8_LDA(At, 0, 0); PG8_STAGE(PG8_SA(1, 1), a1 + hA, voffA);
            PG8_WAIT_L(8); PG8_BAR; PG8_WAIT_L(0); PG8_MMA(0, 0, At, B0); PG8_BAR; PG8_SCHED;
            PG8_LDB(B1, 0, 1); PG8_STAGE(PG8_SB(0, 0), b2, voffB);
            PG8_BAR; PG8_WAIT_L(0); PG8_MMA(0, 1, At, B1); PG8_BAR;
            PG8_LDA(At, 0, 1); PG8_STAGE(PG8_SA(0, 0), a2, voffA);
            PG8_BAR; PG8_WAIT_L(0); PG8_MMA(1, 0, At, B0); PG8_BAR; PG8_SCHED;
            PG8_STAGE(PG8_SB(0, 1), b2 + hB, voffB);
            PG8_WAIT_V(6); PG8_BAR; PG8_MMA(1, 1, At, B1); PG8_BAR;
            PG8_LDB(B0, 1, 0); PG8_SCHED; PG8_LDA(At, 1, 0); PG8_STAGE(PG8_SA(0, 1), a2 + hA, voffA);
            PG8_WAIT_L(8); PG8_BAR; PG8_WAIT_L(0); PG8_MMA(0, 0, At, B0); PG8_BAR; PG8_SCHED;
            PG8_LDB(B1, 1, 1); PG8_STAGE(PG8_SB(1, 0), b3, voffB);
            PG8_BAR; PG8_WAIT_L(0); PG8_MMA(0, 1, At, B1); PG8_BAR;
            PG8_LDA(At, 1, 1); PG8_STAGE(PG8_SA(1, 0), a3, voffA);
            PG8_BAR; PG8_WAIT_L(0); PG8_MMA(1, 0, At, B0); PG8_BAR; PG8_SCHED;
            PG8_STAGE(PG8_SB(1, 1), b3 + hB, voffB);
            PG8_WAIT_V(6); PG8_BAR; PG8_MMA(1, 1, At, B1); PG8_BAR;
            }
        }
        if constexpr (ALIGN_EPI) { if (wr == 0) PG8_BAR; }
        if constexpr (!Epi::AFTER_DRAIN) { E(acc, cur, wr, wc, fr, fq); S.done(cur); }
        if (!has_next) break;
#pragma unroll
        for (int a = 0; a < 2; ++a)
#pragma unroll
            for (int b = 0; b < 2; ++b)
#pragma unroll
                for (int m = 0; m < 4; ++m)
#pragma unroll
                    for (int n = 0; n < 2; ++n) acc[a][b][m][n] = (f32x4){0.f, 0.f, 0.f, 0.f};
        cur = nxt; cA = nA; cB = nB; ++ui;
        if constexpr (ALIGN_EPI) { if (wr == 1) PG8_BAR; }
    }
    PG8_WAIT_V(0);
    if constexpr (!ALIGN_EPI) { if (wr == 0) PG8_BAR; }
    PG8_BAR;
#undef PG8_SA
#undef PG8_SB
#undef PG8_STAGE
#undef PG8_LDA
#undef PG8_LDB
#undef PG8_MMA
#undef PG8_WAIT_V
#undef PG8_WAIT_L
#undef PG8_BAR
#undef PG8_SCHED
}
}
#ifndef ATTN_PRIO
#define ATTN_PRIO 0
#endif
namespace dattn {
using bf16=__hip_bfloat16;
using bf16x8=__attribute__((ext_vector_type(8)))short;
using s16x4=__attribute__((ext_vector_type(4)))short;
using f32x16=__attribute__((ext_vector_type(16)))float;
using u32x4=__attribute__((ext_vector_type(4)))unsigned;
constexpr int SEQ=4096,DM=2048,HDV=128;
constexpr int NW=8,QBLK=32,QB=128,KVBLK=64,NQB=SEQ/QB;
__device__ __forceinline__ int crow(int r,int hi){return (r&3)+8*(r>>2)+4*hi;}
#define SBAR() __builtin_amdgcn_sched_barrier(0)
__device__ __forceinline__ void cmask(f32x16&p0,f32x16&p1,int jb,int qrel,int hi){
  const float NEG=-INFINITY; int kb=64*jb+4*hi;
  #pragma unroll
  for(int r=0;r<16;++r){int kv=kb+(r&3)+8*(r>>2); if(kv>qrel)p0[r]=NEG; if(kv+32>qrel)p1[r]=NEG;}
}
constexpr float C2=0.125f*1.4426950408889634f;
constexpr int NSLOT=3, SLOTB=16384;
constexpr int LDS_K=0, LDS_V=NSLOT*SLOTB, LDS_WS=2*NSLOT*SLOTB, LDS_BYTES=LDS_WS+NW*64*4;
__device__ __forceinline__ void glds16(const void*gsrc,unsigned lds_dst){unsigned keep;
  asm volatile("s_mov_b32 %0, m0\n\ts_mov_b32 m0, %2\n\ts_nop 0\n\tglobal_load_lds_dwordx4 %1, off\n\ts_mov_b32 m0, %0":"=&s"(keep):"v"(gsrc),"s"(lds_dst):"memory");}
__device__ __forceinline__ float max3f(float a,float b,float c){float r;asm("v_max3_f32 %0, %1, %2, %3":"=v"(r):"v"(a),"v"(b),"v"(c));return r;}
__device__ __forceinline__ float max2f(float a,float b){float r;asm("v_max_f32_e32 %0, %1, %2":"=v"(r):"v"(a),"v"(b));return r;}
__device__ __forceinline__ float fadd_s(float a,float b){float r;asm("v_add_f32_e32 %0, %1, %2":"=v"(r):"v"(a),"v"(b));return r;}
__device__ __forceinline__ float fsub_s(float a,float b){float r;asm("v_sub_f32_e32 %0, %1, %2":"=v"(r):"v"(a),"v"(b));return r;}
typedef float f32x2_t __attribute__((ext_vector_type(2))); typedef __bf16 bf16x2_t __attribute__((ext_vector_type(2)));
__device__ __forceinline__ unsigned cvtpk_s(float lo,float hi){f32x2_t v={lo,hi};bf16x2_t b=__builtin_convertvector(v,bf16x2_t);return __builtin_bit_cast(unsigned,b);}
#define WAIT_BAR(N) asm volatile("s_waitcnt vmcnt(" #N ") lgkmcnt(0)\n\ts_barrier":::"memory")
typedef __attribute__((address_space(3))) const char* lds_cptr;
typedef short v4i16_t __attribute__((ext_vector_type(4)));
__device__ __forceinline__ void qkt(f32x16&p0,f32x16&p1,const char*kb,const bf16x8*qr){ const f32x16 negm=f32x16{};
  #pragma unroll
  for(int d0=0;d0<4;++d0){
    const bf16x8 b0=*reinterpret_cast<const bf16x8*>(kb+d0*2048);
    const bf16x8 b1=*reinterpret_cast<const bf16x8*>(kb+d0*2048+512);
    if(d0==0){p0=__builtin_amdgcn_mfma_f32_32x32x16_bf16(b0,qr[0],negm,0,0,0);p1=__builtin_amdgcn_mfma_f32_32x32x16_bf16(b1,qr[0],negm,0,0,0);}
    else{p0=__builtin_amdgcn_mfma_f32_32x32x16_bf16(b0,qr[d0],p0,0,0,0);p1=__builtin_amdgcn_mfma_f32_32x32x16_bf16(b1,qr[d0],p1,0,0,0);}}
}
__device__ __forceinline__ void kload8(bf16x8*kf,lds_cptr kp){
  kf[0]=*(const __attribute__((address_space(3))) bf16x8*)(kp);      kf[1]=*(const __attribute__((address_space(3))) bf16x8*)(kp+512);
  kf[2]=*(const __attribute__((address_space(3))) bf16x8*)(kp+2048); kf[3]=*(const __attribute__((address_space(3))) bf16x8*)(kp+2560);
  kf[4]=*(const __attribute__((address_space(3))) bf16x8*)(kp+4096); kf[5]=*(const __attribute__((address_space(3))) bf16x8*)(kp+4608);
  kf[6]=*(const __attribute__((address_space(3))) bf16x8*)(kp+6144); kf[7]=*(const __attribute__((address_space(3))) bf16x8*)(kp+6656);
}
__device__ __forceinline__ void kload2(bf16x8*kf,lds_cptr kp,int j){ kf[2*j]=*(const __attribute__((address_space(3))) bf16x8*)(kp+j*2048); kf[2*j+1]=*(const __attribute__((address_space(3))) bf16x8*)(kp+j*2048+512); }
__device__ __forceinline__ s16x4 vtr(lds_cptr p){ return __builtin_bit_cast(s16x4,__builtin_amdgcn_ds_read_tr16_b64_v4i16((__attribute__((address_space(3))) v4i16_t*)p)); }
__device__ __forceinline__ float rowmax(const f32x16&p0,const f32x16&p1){
  float a=max3f(p0[0],p0[1],p1[0]),b=max3f(p0[2],p0[3],p1[1]);a=max3f(a,p1[2],p1[3]);
  #pragma unroll
  for(int r=4;r<16;r+=4){a=max3f(a,p0[r],p0[r+1]);b=max3f(b,p0[r+2],p0[r+3]);a=max3f(a,p1[r],p1[r+1]);b=max3f(b,p1[r+2],p1[r+3]);}
  const float m=max2f(a,b);
  auto rr=__builtin_amdgcn_permlane32_swap(__float_as_uint(m),__float_as_uint(m),false,false);
  return max2f(__uint_as_float(rr[0]),__uint_as_float(rr[1]));
}
__device__ __forceinline__ void pv(f32x16*o,int vb,bf16x8 pa0,bf16x8 pa1,bf16x8 pa2,bf16x8 pa3){
  #pragma unroll
  for(int d0=0;d0<4;++d0){s16x4 lo[4],hi[4];
    #pragma unroll
    for(int ks=0;ks<4;++ks){
      asm volatile("ds_read_b64_tr_b16 %0,%1 offset:%c2":"=&v"(lo[ks]):"v"(vb),"i"(d0*4096+ks*1024):"memory");
      asm volatile("ds_read_b64_tr_b16 %0,%1 offset:%c2":"=&v"(hi[ks]):"v"(vb),"i"(d0*4096+ks*1024+512):"memory");}
    asm volatile("s_waitcnt lgkmcnt(0)":::"memory");SBAR();
    #define PK(k) (bf16x8){lo[k][0],lo[k][1],lo[k][2],lo[k][3],hi[k][0],hi[k][1],hi[k][2],hi[k][3]}
    o[d0]=__builtin_amdgcn_mfma_f32_32x32x16_bf16(pa0,PK(0),o[d0],0,0,0);
    o[d0]=__builtin_amdgcn_mfma_f32_32x32x16_bf16(pa1,PK(1),o[d0],0,0,0);
    o[d0]=__builtin_amdgcn_mfma_f32_32x32x16_bf16(pa2,PK(2),o[d0],0,0,0);
    o[d0]=__builtin_amdgcn_mfma_f32_32x32x16_bf16(pa3,PK(3),o[d0],0,0,0);
    #undef PK
  }
}

struct Params { const bf16* Q; const bf16* K; const bf16* V; bf16* O; const float* subln_w; float lam, post; };
template<int THRL> __device__ __forceinline__ void unit(int b,int h,int qb,const Params&P,char*shm){
  int tid_=threadIdx.x; asm volatile("":"+v"(tid_));
  const int tid=tid_,lane=tid&63,r32=lane&31,hi=lane>>5; const int wid=__builtin_amdgcn_readfirstlane(tid>>6);
  const int cmp=wid&1,rbk=wid>>1;
  if(ATTN_PRIO&&wid>=4)__builtin_amdgcn_s_setprio(1);
  const long rowbase=(long)b*SEQ; const int q0=qb*QB;
  const bf16*Qw=P.Q+(rowbase+q0+rbk*QBLK)*DM+h*HDV+cmp*64;
  const bf16*Kh=P.K+rowbase*DM+h*HDV,*Vh=P.V+rowbase*DM+h*HDV;
  const unsigned lds0=(unsigned)(uintptr_t)shm;
  float*wsf=(float*)(shm+LDS_WS)+wid*64;
  const bf16*ksrc=Kh+(long)lane*DM+wid*8;
  const bf16*vsrc=Vh+(long)(16*(wid&3)+(lane>>2))*DM+(wid>>2)*32+(lane&3)*8;
  const unsigned kdst=lds0+LDS_K+wid*1024, vdst=lds0+LDS_V+wid*1024;
  #define DMA_K(t,slot) do{ glds16(ksrc+(long)(t)*KVBLK*DM,(unsigned)__builtin_amdgcn_readfirstlane(kdst+(slot))); glds16(ksrc+(long)(t)*KVBLK*DM+64,(unsigned)__builtin_amdgcn_readfirstlane(kdst+(slot)+8192)); }while(0)
  #define DMA_V(t,slot) do{ glds16(vsrc+(long)(t)*KVBLK*DM,(unsigned)__builtin_amdgcn_readfirstlane(vdst+(slot))); glds16(vsrc+(long)(t)*KVBLK*DM+64,(unsigned)__builtin_amdgcn_readfirstlane(vdst+(slot)+8192)); }while(0)
  const int vb0=(int)(lds0+LDS_V)+((lane>>4)&1)*32+(lane&3)*8+(4*hi+((lane&15)>>2))*64;
  bf16x8 kf[8];
  const lds_cptr shm3=(lds_cptr)shm; const lds_cptr kp0=shm3+LDS_K+(cmp*8+hi)*1024+r32*16; const lds_cptr vp0=shm3+LDS_V+((lane>>4)&1)*32+(lane&3)*8+(4*hi+((lane&15)>>2))*64;
  const char*Kbase=shm+LDS_K+(cmp*8+hi)*1024+r32*16;
  const int NT=(q0+QB)/KVBLK;
  DMA_K(0,0);DMA_V(0,0);DMA_K(1,SLOTB);
  bf16x8 qr[4];
  #pragma unroll
  for(int d0=0;d0<4;++d0)qr[d0]=*(const __attribute__((address_space(1))) bf16x8*)(&Qw[(long)r32*DM+d0*16+hi*8]);
  float mhat=0.f,l_reg=0.f;f32x16 o[4];o[0]=f32x16{};o[1]=f32x16{};o[2]=f32x16{};o[3]=f32x16{};const f32x16 zero16=f32x16{};
  const int qrel=rbk*QBLK+r32;
  #define CMASK(P0,P1,t) do{int jb_=(t)-(NT-2); if(jb_>=0)cmask(P0,P1,jb_,qrel,hi);}while(0)
  bool resc=false;
  #define START(P0,P1) do{ const float rm=rowmax(P0,P1); resc=false; \
    { const float dl=rm; mhat=fadd_s(mhat,dl); \
      _Pragma("unroll") for(int r=0;r<16;++r){P0[r]=fsub_s(P0[r],dl);P1[r]=fsub_s(P1[r],dl);} } \
    _Pragma("unroll") for(int r=0;r<16;++r)P0[r]=__builtin_amdgcn_exp2f(P0[r]); }while(0)
  #define RESC() do{ if(resc){ asm volatile("s_waitcnt lgkmcnt(0)":::"memory"); \
      _Pragma("unroll") for(int d_=0;d_<4;++d_) _Pragma("unroll") for(int r=0;r<16;++r)o[d_][r]*=wsf[crow(r,hi)]; } }while(0)
  f32x16 pA0,pA1,pB0,pB1;
  int sl_prev=0,sl_cur=0,sl_next=SLOTB;
  #define ROT() do{sl_prev=sl_cur;sl_cur=sl_next;sl_next=(sl_next==(NSLOT-1)*SLOTB)?0:sl_next+SLOTB;}while(0)
  DMA_K(2,2*SLOTB);
  WAIT_BAR(6);
  qkt(pA0,pA1,Kbase,qr);asm volatile("s_nop 15\n\ts_nop 7":"+v"(pA0),"+v"(pA1));CMASK(pA0,pA1,0);
  START(pA0,pA1);
  _Pragma("unroll") for(int r=0;r<16;++r)pA1[r]=__builtin_amdgcn_exp2f(pA1[r]);
  WAIT_BAR(0);
  DMA_K(3,0);DMA_V(1,SLOTB);
  ROT();
  kload8(kf,kp0+sl_cur);
  if(NT>2){WAIT_BAR(4);}else{WAIT_BAR(0);}
  s16x4 vlo[4],vhi[4]; u32x4 pw0,pw1,pw2,pw3;
  #define PKW(P,B) cvtpk_s(P[B],P[B+1])
  #define PAF(k) __builtin_bit_cast(bf16x8,pw##k)
  #define VFR(i) (bf16x8){vlo[i][0],vlo[i][1],vlo[i][2],vlo[i][3],vhi[i][0],vhi[i][1],vhi[i][2],vhi[i][3]}
  #define PIN(x) asm volatile("":"+v"(x))
  #define MX3(a,b,c) __builtin_fmaxf(__builtin_fmaxf((a),(b)),(c))
  #define GAPA(MF,A0,A1,A2,A3,W0,W1,PW) do{ MF; sacc+=A0; sacc+=A1; sacc+=A2; sacc+=A3; PIN(sacc); W0; W1; PIN(PW); SBAR(); }while(0)
  #define EX(v) __builtin_amdgcn_exp2f((v)-mhat)
  #define VOFF(f) ((((f)&3)*4096)+(((f)>>2)*1024))
  #define VRD(i,f) do{ vlo[i]=vtr(vp_+VOFF(f)); vhi[i]=vtr(vp_+VOFF(f)+512); }while(0)
  #define GAPB(MF,X,B) do{ MF; X[B]=EX(X[B]); X[B+1]=EX(X[B+1]); PIN(X); SBAR(); }while(0)
  #define GAPBV(MF,X,B,i,f) do{ MF; X[B]=EX(X[B]); X[B+1]=EX(X[B+1]); PIN(X); VRD(i,f); SBAR(); }while(0)
  #define KRD(G,j) do{ if(G){ kload2(kf,kp0+sl_next,j); SBAR(); } }while(0)
  #define PVM(d,k,i) o[d]=__builtin_amdgcn_mfma_f32_32x32x16_bf16(PAF(k),VFR(i),o[d],0,0,0)
  #define STEP(C0,C1,P0,P1,t,GK,GV,GL) do{ SBAR(); \
    const lds_cptr vp_=vp0+sl_prev; \
    float sacc=(P0[0]+P0[1]); \
    GAPA(C0=__builtin_amdgcn_mfma_f32_32x32x16_bf16(kf[0],qr[0],zero16,0,0,0), P0[2],P0[3],P0[4],P0[5],     pw0[0]=PKW(P0,0), pw0[1]=PKW(P0,2), pw0); \
    GAPA(C1=__builtin_amdgcn_mfma_f32_32x32x16_bf16(kf[1],qr[0],zero16,0,0,0), P0[6],P0[7],P0[8],P0[9],     pw0[2]=PKW(P0,4), pw0[3]=PKW(P0,6), pw0); \
    GAPA(C0=__builtin_amdgcn_mfma_f32_32x32x16_bf16(kf[2],qr[1],C0,0,0,0),   P0[10],P0[11],P0[12],P0[13], pw1[0]=PKW(P0,8), pw1[1]=PKW(P0,10), pw1); \
    GAPA(C1=__builtin_amdgcn_mfma_f32_32x32x16_bf16(kf[3],qr[1],C1,0,0,0),   P0[14],P0[15],P1[0],P1[1],   pw1[2]=PKW(P0,12),pw1[3]=PKW(P0,14), pw1); \
    VRD(0,0); SBAR(); GAPA(C0=__builtin_amdgcn_mfma_f32_32x32x16_bf16(kf[4],qr[2],C0,0,0,0),   P1[2],P1[3],P1[4],P1[5],     pw2[0]=PKW(P1,0), pw2[1]=PKW(P1,2), pw2); \
    VRD(1,1); SBAR(); GAPA(C1=__builtin_amdgcn_mfma_f32_32x32x16_bf16(kf[5],qr[2],C1,0,0,0),   P1[6],P1[7],P1[8],P1[9],     pw2[2]=PKW(P1,4), pw2[3]=PKW(P1,6), pw2); \
    VRD(2,2); SBAR(); GAPA(C0=__builtin_amdgcn_mfma_f32_32x32x16_bf16(kf[6],qr[3],C0,0,0,0),   P1[10],P1[11],P1[12],P1[13], pw3[0]=PKW(P1,8), pw3[1]=PKW(P1,10), pw3); \
    VRD(3,3); SBAR(); GAPA(C1=__builtin_amdgcn_mfma_f32_32x32x16_bf16(kf[7],qr[3],C1,0,0,0),   P1[14],P1[15],0.f,0.f,       pw3[2]=PKW(P1,12),pw3[3]=PKW(P1,14), pw3); \
    l_reg+=sacc; \
    if(GK){DMA_K((t)+3,sl_cur);} if(GV){DMA_V((t)+1,sl_next);} \
    CMASK(C0,C1,t); \
    { float a=MX3(C0[0],C0[1],C1[0]),b=MX3(C0[2],C0[3],C1[1]); a=MX3(a,C1[2],C1[3]); \
      _Pragma("unroll") for(int r=4;r<16;r+=4){a=MX3(a,C0[r],C0[r+1]);b=MX3(b,C0[r+2],C0[r+3]);a=MX3(a,C1[r],C1[r+1]);b=MX3(b,C1[r+2],C1[r+3]);} \
      float rm=__builtin_fmaxf(a,b); { auto rr=__builtin_amdgcn_permlane32_swap(__float_as_uint(rm),__float_as_uint(rm),false,false); rm=__builtin_fmaxf(__uint_as_float(rr[0]),__uint_as_float(rr[1])); } \
      rm-=mhat; resc=false; \
      if(__builtin_expect(__any(rm>(float)THRL),0)){ const float dl=__builtin_fmaxf(rm,0.f); mhat+=dl; \
        const float f=__builtin_amdgcn_exp2f(-dl); l_reg*=f; if(hi==0)wsf[r32]=f; resc=true; } } \
    SBAR(); \
    GAPBV(PVM(0,0,0),C0,0, 0,4);  GAPBV(PVM(1,0,1),C0,2, 1,5);  GAPBV(PVM(2,0,2),C0,4, 2,6);  GAPBV(PVM(3,0,3),C0,6, 3,7); \
    GAPBV(PVM(0,1,0),C0,8, 0,8);  GAPBV(PVM(1,1,1),C0,10,1,9);  GAPBV(PVM(2,1,2),C0,12,2,10); GAPBV(PVM(3,1,3),C0,14,3,11); \
    KRD(GL,0); GAPBV(PVM(0,2,0),C1,0, 0,12); KRD(GL,1); GAPBV(PVM(1,2,1),C1,2, 1,13); KRD(GL,2); GAPBV(PVM(2,2,2),C1,4, 2,14); KRD(GL,3); GAPBV(PVM(3,2,3),C1,6, 3,15); \
    GAPB(PVM(0,3,0),C1,8); GAPB(PVM(1,3,1),C1,10); GAPB(PVM(2,3,2),C1,12); GAPB(PVM(3,3,3),C1,14); \
    }while(0)
  int t=1;
  #undef CMASK
  #define CMASK(P0,P1,t) do{}while(0)
  for(;t+3<NT;t+=2){
    STEP(pB0,pB1,pA0,pA1,t,true,true,true);     WAIT_BAR(4); RESC(); ROT();
    STEP(pA0,pA1,pB0,pB1,t+1,true,true,true);   WAIT_BAR(4); RESC(); ROT();
  }
  #undef CMASK
  #define CMASK(P0,P1,t) do{int jb_=(t)-(NT-2); if(jb_>=0)cmask(P0,P1,jb_,qrel,hi);}while(0)
  #define ENDW(tt) do{ if((tt)+3<NT){WAIT_BAR(4);} else if((tt)+2<NT){WAIT_BAR(2);} else {WAIT_BAR(0);} }while(0)
  for(;t+1<NT;t+=2){
    STEP(pB0,pB1,pA0,pA1,t,(t+3<NT),(t+1<NT),(t+1<NT));       ENDW(t);   RESC(); ROT();
    STEP(pA0,pA1,pB0,pB1,t+1,(t+4<NT),(t+2<NT),(t+2<NT));     ENDW(t+1); RESC(); ROT();
  }
  STEP(pB0,pB1,pA0,pA1,NT-1,false,false,false); RESC();
  { float sacc=pB0[0]+pB0[1]; _Pragma("unroll") for(int r=2;r<16;++r)sacc+=pB0[r]; _Pragma("unroll") for(int r=0;r<16;++r)sacc+=pB1[r]; l_reg+=sacc;
    pw0=(u32x4){PKW(pB0,0),PKW(pB0,2),PKW(pB0,4),PKW(pB0,6)};pw1=(u32x4){PKW(pB0,8),PKW(pB0,10),PKW(pB0,12),PKW(pB0,14)};pw2=(u32x4){PKW(pB1,0),PKW(pB1,2),PKW(pB1,4),PKW(pB1,6)};pw3=(u32x4){PKW(pB1,8),PKW(pB1,10),PKW(pB1,12),PKW(pB1,14)};
    SBAR(); pv(o,vb0+sl_cur,PAF(0),PAF(1),PAF(2),PAF(3)); }
  #undef PKW
  #undef PAF
  #undef VFR
  #undef PIN
  #undef MX3
  #undef GAPA
  #undef GAPB
  #undef GAPBV
  #undef EX
  #undef VOFF
  #undef VRD
  #undef KRD
  #undef PVM
  #undef STEP
  #undef ENDW
  {auto rr=__builtin_amdgcn_permlane32_swap(__float_as_uint(l_reg),__float_as_uint(l_reg),false,false);l_reg=__uint_as_float(rr[0])+__uint_as_float(rr[1]);}
  if(hi==0)wsf[32+r32]=l_reg;asm volatile("s_waitcnt lgkmcnt(0)":::"memory");
  float rli[16];
  #pragma unroll
  for(int r=0;r<16;++r)rli[r]=__builtin_amdgcn_rcpf(wsf[32+crow(r,hi)]);
  asm volatile("s_waitcnt lgkmcnt(0)\n\ts_barrier":::"memory");
  { bf16*stg=(bf16*)(shm)+wid*4096;
    #pragma unroll
    for(int r=0;r<16;++r){const int orow=crow(r,hi);
      #pragma unroll
      for(int d0=0;d0<4;++d0)stg[orow*128+d0*32+r32]=__float2bfloat16(o[d0][r]*rli[r]);} }
  asm volatile("s_waitcnt lgkmcnt(0)\n\ts_barrier":::"memory");
  { const bf16*s0=(const bf16*)(shm)+(wid&~1)*4096; const bf16*s1=s0+4096;
    bf16*Ow=P.O+(rowbase+q0+rbk*QBLK)*DM+h*HDV; const int ch=lane&15;
    typedef float f32x4_t __attribute__((ext_vector_type(4)));
    const f32x4_t wa=*(const __attribute__((address_space(1))) f32x4_t*)(P.subln_w+ch*8), wb=*(const __attribute__((address_space(1))) f32x4_t*)(P.subln_w+ch*8+4);
    #pragma unroll
    for(int i=0;i<4;++i){ const int row=16*cmp+4*i+(lane>>4);
      const u32x4 a=*(const u32x4*)(s0+row*128+ch*8), bq=*(const u32x4*)(s1+row*128+ch*8);
      float d[8];
      #pragma unroll
      for(int k=0;k<4;++k){ const unsigned ua=a[k],ub=bq[k];
        d[2*k]=__uint_as_float(ua<<16)-P.lam*__uint_as_float(ub<<16); d[2*k+1]=__uint_as_float(ua&0xffff0000u)-P.lam*__uint_as_float(ub&0xffff0000u); }
      float s=0.f;
      #pragma unroll
      for(int k=0;k<8;++k)s+=d[k]*d[k];
      s+=__shfl_xor(s,1);s+=__shfl_xor(s,2);s+=__shfl_xor(s,4);s+=__shfl_xor(s,8);
      const float rs=P.post*__builtin_amdgcn_rsqf(s*(1.f/128.f)+1e-5f);
      u32x4 w; w[0]=cvtpk_s(d[0]*rs*wa[0],d[1]*rs*wa[1]); w[1]=cvtpk_s(d[2]*rs*wa[2],d[3]*rs*wa[3]); w[2]=cvtpk_s(d[4]*rs*wb[0],d[5]*rs*wb[1]); w[3]=cvtpk_s(d[6]*rs*wb[2],d[7]*rs*wb[3]);
      *(__attribute__((address_space(1))) u32x4*)(Ow+(long)row*DM+ch*8)=w; } }
  asm volatile("s_waitcnt lgkmcnt(0)\n\ts_barrier":::"memory");
  if(ATTN_PRIO&&wid>=4)__builtin_amdgcn_s_setprio(0);
  #undef DMA_K
  #undef DMA_V
  #undef CMASK
  #undef START
  #undef RESC
  #undef ROT
}
constexpr int ATTN_LDS_BYTES=LDS_BYTES;
template<int THRL=8> __device__ __forceinline__ void phase(char*lds,const Params&P,int grid,int block){
  const int vcu=(grid%8==0)?(block%8)*(grid/8)+block/8:block;
  for(int v=vcu;v<256;v+=grid){ const int bh=v>>1,p=v&1;
    for(int i=0;i<16;++i){ const int s=2*(i>>1)+p; const int qb=(i&1)?31-s:s; unit<THRL>(bh>>4,bh&15,qb,P,lds); } }
}
#undef SBAR
#undef WAIT_BAR
}
constexpr int NWAVES = 8;
#ifndef MK_PER_PHASE
#define MK_PER_PHASE 0
#endif

constexpr int BATCH = 8, SEQ = 4096, DMODEL = 2048, MROWS = BATCH * SEQ, DFF = 8192, NHEADS = 16, HD = 128;
constexpr int GDN_PROJ = 8224, GDN_MAIN = 8192, CONVC = 6144, NCG = MROWS / 64;
constexpr float ALPHA_RES = 1.6817928305074292f;
constexpr float LN_EPS = 1e-5f, GDN_EPS = 1e-6f, SUBLN_EPS = 1e-5f;
constexpr int N_PHASES = 39;

constexpr size_t MiB = 1u << 20;
constexpr size_t WS_CTL = 0, CTL_ZERO_BYTES = 1 * MiB;
constexpr size_t WS_ONES = 1 * MiB, WS_ZEROS = WS_ONES + 8192, WS_MU = WS_ONES + 65536, WS_RSTD = WS_MU + 131072;
constexpr size_t WS_BETA = 2 * MiB, WS_G = 4 * MiB;
constexpr size_t WS_HALO = 9 * MiB;
constexpr size_t WS_WA = 27 * MiB, WS_WB = 60 * MiB;
constexpr size_t WS_ATTN = 27 * MiB;
constexpr size_t WS_XB = 92 * MiB;
constexpr size_t WS_Y = 220 * MiB;
constexpr size_t WS_R1 = 476 * MiB;
constexpr size_t WS_END = 988 * MiB;
constexpr size_t QTR = 128 * MiB;
constexpr int CW_TMO = 0;
constexpr int CW_BAR = 4096;

constexpr int LDS_BYTES_C = 147456;
constexpr int RING_OFF = 0, RING_BYTES = 131072;
constexpr int LDSCTL_OFF = LDS_BYTES_C - 512, MISC_OFF = LDSCTL_OFF + 320;
constexpr int LDS_BYTES = LDS_BYTES_C;
static_assert(MISC_OFF + 128 <= LDS_BYTES, "LDS map");

#define GAS __attribute__((address_space(1)))
#define LAS __attribute__((address_space(3)))
typedef unsigned short bf16;
typedef unsigned v4u __attribute__((ext_vector_type(4)));
typedef unsigned v2u __attribute__((ext_vector_type(2)));
typedef float f32x4 __attribute__((ext_vector_type(4)));
typedef float f32x16 __attribute__((ext_vector_type(16)));
typedef short bf16x8 __attribute__((ext_vector_type(8)));
typedef GAS unsigned gu32;
typedef GAS unsigned long long gu64;
#define RLX_AGENT __ATOMIC_RELAXED, __HIP_MEMORY_SCOPE_AGENT
#define LDS_WAIT() asm volatile("s_waitcnt lgkmcnt(0)" ::: "memory")
#define VM_WAIT() asm volatile("s_waitcnt vmcnt(0)" ::: "memory")
#define WG_BAR() asm volatile("s_waitcnt lgkmcnt(0)\n\ts_barrier" ::: "memory")
typedef float f32x2_t_ __attribute__((ext_vector_type(2))); typedef __bf16 bf16x2_t_ __attribute__((ext_vector_type(2)));
__device__ __forceinline__ unsigned pk2(float lo, float hi) { f32x2_t_ v = {lo, hi}; bf16x2_t_ b = __builtin_convertvector(v, bf16x2_t_); return __builtin_bit_cast(unsigned, b); }
__device__ __forceinline__ unsigned f2bf(float f) { return pk2(f, 0.f) & 0xffffu; }
__device__ __forceinline__ float bflo(unsigned w) { return __builtin_bit_cast(float, w << 16); }
__device__ __forceinline__ float bfhi(unsigned w) { return __builtin_bit_cast(float, w & 0xffff0000u); }
__device__ __forceinline__ float bf2f(bf16 h) { return __builtin_bit_cast(float, (unsigned)h << 16); }
__device__ __forceinline__ float fast_exp(float x) { return __builtin_amdgcn_exp2f(x * 1.4426950408889634f); }
__device__ __forceinline__ float silu_f(float x) { return x * __builtin_amdgcn_rcpf(1.f + __expf(-x)); }

#define XB_TMO      128
#define XB_XCNT(j)  (256  + 64 * (j))
#define XB_XSUB(j)  (1280 + 64 * (j))
#define XB_XGEN(j)  (2304 + 64 * (j))
#define XB_TOP      3328
#define XB_TOPGEN   3392
#define XCD_BAR_WORDS 3456
#define XB_SPIN_CAP (1u << 18)

__device__ __forceinline__ unsigned xb_ld(unsigned* p)              { return __hip_atomic_load(p, __ATOMIC_RELAXED, __HIP_MEMORY_SCOPE_AGENT); }
__device__ __forceinline__ unsigned xb_add(unsigned* p, unsigned v) { return __hip_atomic_fetch_add(p, v, __ATOMIC_RELAXED, __HIP_MEMORY_SCOPE_AGENT); }
__device__ __forceinline__ unsigned xb_xcc_id() { return (unsigned)__builtin_amdgcn_s_getreg((3 << 11) | 20) & 0xFu; }
#define XB_SPIN(cond, bar) do { unsigned _sp = 0; while (cond) { __builtin_amdgcn_s_sleep(1); \
    if ((++_sp & 255u) == 0u) { if (xb_ld(&(bar)[XB_TMO])) break; if (_sp > XB_SPIN_CAP) { atomicAdd(&(bar)[XB_TMO], 1u); break; } } } } while (0)

struct XcdBarrier {
    unsigned* bar; unsigned x;
    volatile LAS unsigned* st;
};
__device__ __forceinline__ XcdBarrier xcd_barrier_post(unsigned* bar, volatile LAS unsigned* st) {
    XcdBarrier b; b.bar = bar; b.x = xb_xcc_id(); b.st = st;
    if (threadIdx.x == 0) (void)xb_add(&bar[XB_XCNT(b.x)], 1u);
    return b;
}
__device__ __forceinline__ void xcd_barrier_complete(unsigned* bar, unsigned x, unsigned& nloc, unsigned& nx) {
    const unsigned G = gridDim.x * gridDim.y * gridDim.z;
    unsigned sum, cnt, mine, sp = 0u;
    for (;;) {
        sum = 0u; cnt = 0u; mine = 0u;
#pragma unroll
        for (unsigned j = 0; j < 16; ++j) { const unsigned c = xb_ld(&bar[XB_XCNT(j)]); sum += c; cnt += (c > 0u) ? 1u : 0u; mine = (j == x) ? c : mine; }
        if (sum == G) break;
        __builtin_amdgcn_s_sleep(1);
        if ((++sp & 255u) == 0u) { if (xb_ld(&bar[XB_TMO])) break; if (sp > XB_SPIN_CAP) { atomicAdd(&bar[XB_TMO], 1u); break; } }
    }
    nloc = mine > 0u ? mine : 1u; nx = cnt > 0u ? cnt : 1u;
}
__device__ __forceinline__ void xcd_barrier(const XcdBarrier& b) {
    asm volatile("s_waitcnt vmcnt(0)" ::: "memory");
    __syncthreads();
    if (threadIdx.x == 0) {
        unsigned* bar = b.bar;
        __builtin_amdgcn_s_waitcnt(0);
        unsigned nloc = b.st[0], nx = b.st[1];
        if (nloc == 0u) { xcd_barrier_complete(bar, b.x, nloc, nx); b.st[0] = nloc; b.st[1] = nx; }
        const unsigned old = xb_add(&bar[XB_XSUB(b.x)], 1u);
        const unsigned gen = old / nloc;
        if (old + 1u == (gen + 1u) * nloc) {
            __builtin_amdgcn_fence(__ATOMIC_RELEASE, "agent");
            asm volatile("s_waitcnt vmcnt(0)" ::: "memory");
            const unsigned og = xb_add(&bar[XB_TOP], 1u);
            const unsigned tg = og / nx;
            if (og + 1u == (tg + 1u) * nx) xb_add(&bar[XB_TOPGEN], 1u);
            else XB_SPIN(xb_ld(&bar[XB_TOPGEN]) == tg, bar);
            __builtin_amdgcn_fence(__ATOMIC_ACQUIRE, "agent");
            xb_add(&bar[XB_XGEN(b.x)], 1u);
            asm volatile("s_waitcnt vmcnt(0)" ::: "memory");
        } else {
            XB_SPIN(xb_ld(&bar[XB_XGEN(b.x)]) == gen, bar);
            __builtin_amdgcn_fence(__ATOMIC_ACQUIRE, "agent");
            asm volatile("s_waitcnt vmcnt(0)" ::: "memory");
        }
    }
    __syncthreads();
}

__device__ __forceinline__ float wave_sum(float v) {
#pragma unroll
    for (int o = 1; o < 64; o <<= 1) v += __shfl_xor(v, o);
    return v;
}
__device__ __forceinline__ float sum16(float v) {
    v += __shfl_xor(v, 1); v += __shfl_xor(v, 2); v += __shfl_xor(v, 4); v += __shfl_xor(v, 8); return v;
}
__device__ __forceinline__ void transpose_item(const float* W, int K, int ldw, int n_begin, int nblk, bf16* WT, int row_off, LAS float* scr, int item, int lane) {
    const int kb = item / nblk, nb = item % nblk, k0 = 64 * kb, n0 = 32 * nb;
    float wv[32];
#pragma unroll
    for (int i = 0; i < 32; ++i) wv[i] = ((const GAS float*)W)[(size_t)(k0 + 2 * i + (lane >> 5)) * ldw + n_begin + n0 + (lane & 31)];
#pragma unroll
    for (int i = 0; i < 32; ++i) scr[(2 * i + (lane >> 5)) * 33 + (lane & 31)] = wv[i];
    LDS_WAIT(); asm volatile("" ::: "memory");
    const int c = lane & 7;
#pragma unroll
    for (int j = 0; j < 4; ++j) { const int n = (lane >> 3) + 8 * j; const LAS float* s = scr + (8 * c) * 33 + n;
        v4u o; o.x = pk2(s[0 * 33], s[1 * 33]); o.y = pk2(s[2 * 33], s[3 * 33]); o.z = pk2(s[4 * 33], s[5 * 33]); o.w = pk2(s[6 * 33], s[7 * 33]);
        *(GAS v4u*)(WT + (size_t)(row_off + n0 + n) * K + k0 + 8 * c) = o; }
    LDS_WAIT(); asm volatile("" ::: "memory");
}
__device__ __forceinline__ void convert_w(LAS unsigned char* lds, int gw, int NGW, int wave, int lane, const float* W, int K, int ldw, int n_begin, int ncols, bf16* WT, int row_off) {
    LAS float* scr = (LAS float*)(lds + RING_OFF + wave * 16384);
    const int nblk = ncols / 32, nitems = (K / 64) * nblk;
    for (int it = gw; it < nitems; it += NGW) transpose_item(W, K, ldw, n_begin, nblk, WT, row_off, scr, it, lane);
}
__device__ __forceinline__ void row_to_bf16(const float* xrow, bf16* orow, int lane) {
    const GAS f32x4* xr = (const GAS f32x4*)xrow + lane; GAS v2u* o8 = (GAS v2u*)orow + lane;
#pragma unroll
    for (int j = 0; j < 8; ++j) { const f32x4 v = xr[64 * j]; v2u w; w.x = pk2(v.x, v.y); w.y = pk2(v.z, v.w); o8[64 * j] = w; }
}
__device__ __forceinline__ void ln_pass_b(const bf16* xb_in, const bf16* hb, const float* g, const float* b, bf16* xb_out, float* outf, float alpha, int gw, int NGW, int lane) {
    const GAS f32x4* gr = (const GAS f32x4*)g + 2 * lane; const GAS f32x4* br = (const GAS f32x4*)b + 2 * lane;
    for (int m = gw; m < MROWS; m += 2 * NGW) {
        const int m1 = (m + NGW < MROWS) ? m + NGW : m;
        const GAS v4u* x0 = (const GAS v4u*)(xb_in + (size_t)m * DMODEL) + lane; const GAS v4u* x1 = (const GAS v4u*)(xb_in + (size_t)m1 * DMODEL) + lane;
        const GAS v4u* h0 = (const GAS v4u*)(hb + (size_t)m * DMODEL) + lane;   const GAS v4u* h1 = (const GAS v4u*)(hb + (size_t)m1 * DMODEL) + lane;
        v4u xa[4], xc[4], ha[4], hc[4];
#pragma unroll
        for (int j = 0; j < 4; ++j) { xa[j] = x0[64 * j]; xc[j] = x1[64 * j]; ha[j] = h0[64 * j]; hc[j] = h1[64 * j]; }
        float y0[32], y1[32]; float s0 = 0.f, s1 = 0.f;
#pragma unroll
        for (int j = 0; j < 4; ++j)
#pragma unroll
            for (int k = 0; k < 4; ++k) { y0[8 * j + 2 * k] = alpha * bflo(xa[j][k]) + bflo(ha[j][k]); y0[8 * j + 2 * k + 1] = alpha * bfhi(xa[j][k]) + bfhi(ha[j][k]);
                                          y1[8 * j + 2 * k] = alpha * bflo(xc[j][k]) + bflo(hc[j][k]); y1[8 * j + 2 * k + 1] = alpha * bfhi(xc[j][k]) + bfhi(hc[j][k]); }
#pragma unroll
        for (int k = 0; k < 32; ++k) { s0 += y0[k]; s1 += y1[k]; }
#pragma unroll
        for (int o = 1; o < 64; o <<= 1) { s0 += __shfl_xor(s0, o); s1 += __shfl_xor(s1, o); }
        const float mean0 = s0 * (1.f / DMODEL), mean1 = s1 * (1.f / DMODEL); float q0 = 0.f, q1 = 0.f;
#pragma unroll
        for (int k = 0; k < 32; ++k) { y0[k] -= mean0; y1[k] -= mean1; q0 += y0[k] * y0[k]; q1 += y1[k] * y1[k]; }
#pragma unroll
        for (int o = 1; o < 64; o <<= 1) { q0 += __shfl_xor(q0, o); q1 += __shfl_xor(q1, o); }
        const float rs0 = 1.f / sqrtf(q0 * (1.f / DMODEL) + LN_EPS), rs1 = 1.f / sqrtf(q1 * (1.f / DMODEL) + LN_EPS);
#pragma unroll
        for (int j = 0; j < 4; ++j) { const f32x4 ga = gr[128 * j], gb = gr[128 * j + 1], ba = br[128 * j], bb = br[128 * j + 1];
            float o0[8], o1[8];
#pragma unroll
            for (int k = 0; k < 8; ++k) { const float gg = k < 4 ? ga[k] : gb[k - 4], bv = k < 4 ? ba[k] : bb[k - 4]; o0[k] = y0[8 * j + k] * rs0 * gg + bv; o1[k] = y1[8 * j + k] * rs1 * gg + bv; }
            if (xb_out) { v4u w0, w1; w0.x = pk2(o0[0], o0[1]); w0.y = pk2(o0[2], o0[3]); w0.z = pk2(o0[4], o0[5]); w0.w = pk2(o0[6], o0[7]); w1.x = pk2(o1[0], o1[1]); w1.y = pk2(o1[2], o1[3]); w1.z = pk2(o1[4], o1[5]); w1.w = pk2(o1[6], o1[7]);
                ((GAS v4u*)(xb_out + (size_t)m * DMODEL) + lane)[64 * j] = w0; ((GAS v4u*)(xb_out + (size_t)m1 * DMODEL) + lane)[64 * j] = w1; }
            if (outf) { GAS f32x4* p0 = (GAS f32x4*)(outf + (size_t)m * DMODEL) + 2 * lane + 128 * j; GAS f32x4* p1 = (GAS f32x4*)(outf + (size_t)m1 * DMODEL) + 2 * lane + 128 * j;
                p0[0] = (f32x4){o0[0], o0[1], o0[2], o0[3]}; p0[1] = (f32x4){o0[4], o0[5], o0[6], o0[7]}; p1[0] = (f32x4){o1[0], o1[1], o1[2], o1[3]}; p1[1] = (f32x4){o1[4], o1[5], o1[6], o1[7]}; } }
    }
}
#define MFMA32(a, b, c) __builtin_amdgcn_mfma_f32_32x32x16_bf16((a), (b), (c), 0, 0, 0)

__device__ __forceinline__ void ba_proj(const bf16* xb, const bf16* wt  , const float* a_log, const float* dt_bias, float* beta, float* g, int gw, int NGW, int lane) {
    const int r32 = lane & 31, hi = lane >> 5;
    for (int wu = gw; wu < MROWS / 32; wu += NGW) {
        const GAS bf16* ap = (const GAS bf16*)xb + (size_t)(wu * 32 + r32) * DMODEL + 8 * hi; const GAS bf16* bp = (const GAS bf16*)wt + (size_t)(GDN_MAIN + r32) * DMODEL + 8 * hi;
        f32x16 acc = {};
#pragma unroll 1
        for (int s0 = 0; s0 < DMODEL / 16; s0 += 8) {
            bf16x8 a[8], b[8];
#pragma unroll
            for (int s = 0; s < 8; ++s) { a[s] = *(const GAS bf16x8*)(ap + (s0 + s) * 16); b[s] = *(const GAS bf16x8*)(bp + (s0 + s) * 16); }
#pragma unroll
            for (int s = 0; s < 8; ++s) acc = MFMA32(a[s], b[s], acc);
        }
        const int j = r32 & 15; const float al = -__expf(((const GAS float*)a_log)[j]), db = ((const GAS float*)dt_bias)[j]; GAS float* betag = (GAS float*)beta; GAS float* gg_ = (GAS float*)g;
#pragma unroll
        for (int r = 0; r < 16; ++r) { const int t = wu * 32 + (r & 3) + 8 * (r >> 2) + 4 * hi; const float v = acc[r];
            if (r32 < 16) betag[(size_t)t * 16 + j] = __builtin_amdgcn_rcpf(1.f + __expf(-v));
            else { const float z = v + db; const float sp = z > 20.f ? z : log1pf(__expf(z)); gg_[(size_t)t * 16 + j] = al * sp; } }
    }
}

#ifndef G2_SKIP
#define G2_SKIP 0
#endif
#ifndef PROBE_G2_NOSCAT
#define PROBE_G2_NOSCAT 0
#endif
typedef short bf16x4 __attribute__((ext_vector_type(4)));
#define MFMA16K16(a, b, c) __builtin_amdgcn_mfma_f32_16x16x16bf16_1k((a), (b), (c), 0, 0, 0)
constexpr int G2_TS = 136;
constexpr int G2_AS = 68, G2_ANS = 72, G2_US = 68;
constexpr int G2_A = 0, G2_GC = G2_A + 64 * G2_AS * 4, G2_BT = G2_GC + 256, G2_AN = G2_BT + 256, G2_TB = G2_AN + 64 * G2_ANS * 2, G2_Q = G2_TB + 2048, G2_K = G2_Q + 64 * G2_TS * 2, G2_V = G2_K + 64 * G2_TS * 2,
              G2_W = G2_V + 64 * G2_TS * 2, G2_END = G2_W + 64 * G2_TS * 2;
static_assert(G2_END <= RING_BYTES, "G2 LDS");
__device__ __forceinline__ bf16x4 pack4(f32x4 v) { v2u w; w.x = pk2(v[0], v[1]); w.y = pk2(v[2], v[3]); return __builtin_bit_cast(bf16x4, w); }
__device__ __forceinline__ void gdn_chunk_phase(LAS unsigned char* lds, bf16* p_, const bf16* halo_, const float* beta_, float* g_, bf16* wbuf_, bf16* attn_, const float* conv_w_, int vcu, int G, bf16* palt_ = nullptr) {
#define G2_ST(off) ((palt ? palt + ((size_t)(off) & 0x7ffffffull) : p + (size_t)(off)))
    int tid_ = threadIdx.x; asm volatile("" : "+v"(tid_));
    const int tid0 = tid_, lane0 = tid0 & 63, wid0 = __builtin_amdgcn_readfirstlane(tid0 >> 6);
    GAS bf16* const p = (GAS bf16*)p_; const GAS bf16* const halo = (const GAS bf16*)halo_; const GAS float* const beta = (const GAS float*)beta_; GAS float* const g = (GAS float*)g_;
    GAS bf16* const wbuf = (GAS bf16*)wbuf_; GAS bf16* const attn = (GAS bf16*)attn_; const GAS float* const conv_w = (const GAS float*)conv_w_; GAS bf16* const palt = (GAS bf16*)palt_;
    LAS bf16* Qs = (LAS bf16*)(lds + G2_Q); LAS bf16* Ks = (LAS bf16*)(lds + G2_K); LAS bf16* Vs = (LAS bf16*)(lds + G2_V); LAS bf16* Ws = (LAS bf16*)(lds + G2_W);
    LAS float* As = (LAS float*)(lds + G2_A); LAS float* gcs = (LAS float*)(lds + G2_GC); LAS float* bts = (LAS float*)(lds + G2_BT);
    LAS bf16* An = (LAS bf16*)(lds + G2_AN); LAS bf16* Tb = (LAS bf16*)(lds + G2_TB); LAS bf16* Us = (LAS bf16*)(lds + G2_A);
    asm volatile("" : "+v"(Qs), "+v"(Ks), "+v"(Vs), "+v"(Ws), "+v"(As), "+v"(gcs), "+v"(bts), "+v"(An), "+v"(Tb), "+v"(Us));
    v4u rawv[3][5]; float gpre = 0.f, bpre = 0.f;
#define G2_LOAD_RAW(uu, LN, WD) do { const int cg_ = (uu) >> 4, h_ = (uu) & 15, n_ = cg_ & 63; const size_t r0_ = (size_t)cg_ * 64; const int cgp_l = (LN) & 15, tA_l = 8 * (WD) + 2 * ((LN) >> 4); \
        _Pragma("unroll") for (int X = 0; X < 3; ++X) { const int col_ = X * 2048 + h_ * HD + 8 * cgp_l; \
            _Pragma("unroll") for (int rr = 0; rr < 5; ++rr) { const int rel = tA_l - 3 + rr; v4u v = {0u, 0u, 0u, 0u}; \
                if (rel >= 0) v = *(const GAS v4u*)(p + (r0_ + rel) * GDN_MAIN + col_); \
                else if (n_ > 0) v = *(const GAS v4u*)(halo + ((size_t)(cg_ - 1) * 3 + (rel + 3)) * CONVC + col_); \
                rawv[X][rr] = v; } } \
        if ((WD) == 0) { gpre = g[(r0_ + (LN)) * 16 + h_]; bpre = beta[(r0_ + (LN)) * 16 + h_]; } } while (0)
    if (vcu < NCG * NHEADS) G2_LOAD_RAW(vcu, lane0, wid0);
    for (int u = vcu; u < NCG * NHEADS; u += G) {
        const int cg = u >> 4, h = u & 15; const size_t row0 = (size_t)cg * 64;
        int tl_ = tid0; asm volatile("" : "+v"(tl_));
        const int tid = tl_, lane = tid & 63, wid = __builtin_amdgcn_readfirstlane(tid >> 6), r32 = lane & 31, hi = lane >> 5;
        {
            const int cgp = lane & 15, sub = lane >> 4, tA = 8 * wid + 2 * sub;
#pragma unroll
            for (int X = 0; X < 3; ++X) {
                const int col = X * 2048 + h * HD + 8 * cgp;
                float raw[5][8];
                asm volatile("" : "+v"(rawv[X][0]), "+v"(rawv[X][1]), "+v"(rawv[X][2]), "+v"(rawv[X][3]), "+v"(rawv[X][4]));
#pragma unroll
                for (int rr = 0; rr < 5; ++rr) { const v4u v = rawv[X][rr];
                    raw[rr][0] = bflo(v.x); raw[rr][1] = bfhi(v.x); raw[rr][2] = bflo(v.y); raw[rr][3] = bfhi(v.y); raw[rr][4] = bflo(v.z); raw[rr][5] = bfhi(v.z); raw[rr][6] = bflo(v.w); raw[rr][7] = bfhi(v.w); }
                float o0[8], o1[8];
#pragma unroll
                for (int c = 0; c < 8; ++c) { o0[c] = 0.f; o1[c] = 0.f; }
#pragma unroll
                for (int j = 0; j < 4; ++j) { const f32x4 wa = *(const GAS f32x4*)(conv_w + (size_t)j * CONVC + col), wb = *(const GAS f32x4*)(conv_w + (size_t)j * CONVC + col + 4);
#pragma unroll
                    for (int c = 0; c < 8; ++c) { const float w = c < 4 ? wa[c] : wb[c - 4]; o0[c] += w * raw[j][c]; o1[c] += w * raw[j + 1][c]; } }
                float s0 = 0.f, s1 = 0.f;
#pragma unroll
                for (int c = 0; c < 8; ++c) { o0[c] = silu_f(o0[c]); o1[c] = silu_f(o1[c]); s0 += o0[c] * o0[c]; s1 += o1[c] * o1[c]; }
                if (X < 2) { s0 = sum16(s0); s1 = sum16(s1); const float sc = X == 0 ? 0.08838834764831845f : 1.f; const float f0 = sc * __builtin_amdgcn_rsqf(s0 + GDN_EPS), f1 = sc * __builtin_amdgcn_rsqf(s1 + GDN_EPS);
#pragma unroll
                    for (int c = 0; c < 8; ++c) { o0[c] *= f0; o1[c] *= f1; } }
                LAS bf16* T = X == 0 ? Qs : (X == 1 ? Ks : Vs);
                v4u w0, w1; w0.x = pk2(o0[0], o0[1]); w0.y = pk2(o0[2], o0[3]); w0.z = pk2(o0[4], o0[5]); w0.w = pk2(o0[6], o0[7]);
                w1.x = pk2(o1[0], o1[1]); w1.y = pk2(o1[2], o1[3]); w1.z = pk2(o1[4], o1[5]); w1.w = pk2(o1[6], o1[7]);
                *(LAS v4u*)(T + tA * G2_TS + 8 * cgp) = w0; *(LAS v4u*)(T + (tA + 1) * G2_TS + 8 * cgp) = w1;
                asm volatile("" ::: "memory");
            }
            if (wid == 0) {
                float gv = gpre;
#pragma unroll
                for (int o = 1; o < 64; o <<= 1) { const float t = __shfl_up(gv, o); if (lane >= o) gv += t; }
                gcs[lane] = gv; bts[lane] = bpre; if (!palt) g[(row0 + lane) * 16 + h] = gv;
            }
        }
        __syncthreads();
        if (u + G < NCG * NHEADS) G2_LOAD_RAW(u + G, lane, wid);
        if (!((G2_SKIP & 4) && palt)) {
            const int rb = (wid >> 1) & 1, cb = wid & 1; const bool isA = wid < 4;
            f32x16 acc = {};
            if (!(rb == 0 && cb == 1)) {
                const LAS bf16* Ar = (isA ? Ks : Qs) + (32 * rb + r32) * G2_TS + 8 * hi; const LAS bf16* Br = Ks + (32 * cb + r32) * G2_TS + 8 * hi;
#pragma unroll
                for (int s = 0; s < 8; ++s) acc = MFMA32(*(const LAS bf16x8*)(Ar + 16 * s), *(const LAS bf16x8*)(Br + 16 * s), acc);
            }
            const int j = 32 * cb + r32; const float gj = gcs[j];
#pragma unroll
            for (int r = 0; r < 16; ++r) { const int i = 32 * rb + (r & 3) + 8 * (r >> 2) + 4 * hi; const float gi = gcs[i];
                if (isA) { const float d = (i > j) ? __expf(gi - gj) : 0.f; const float a = (i > j) ? bts[i] * acc[r] * d : 0.f; As[i * G2_AS + j] = a; An[i * G2_ANS + j] = (bf16)f2bf(-a); }
                else { const float d = (i >= j) ? __expf(gi - gj) : 0.f; Ws[i * G2_TS + j] = (bf16)f2bf((i >= j) ? acc[r] * d : 0.f); } }
        }
        __syncthreads();
        if (wid == 0 && !((G2_SKIP & 2) && palt)) {
            const int b = lane >> 4, c = lane & 15; float t[16];
            const LAS float* Ab = As + (16 * b) * G2_AS + 16 * b;
#pragma unroll
            for (int i = 0; i < 16; ++i) {
                float ti = (i == c) ? 1.f : 0.f;
#pragma unroll
                for (int j4 = 0; j4 < (i + 3) / 4; ++j4) { const f32x4 a = *(const LAS f32x4*)(Ab + i * G2_AS + 4 * j4);
#pragma unroll
                    for (int k = 0; k < 4; ++k) if (4 * j4 + k < i) ti -= a[k] * t[4 * j4 + k]; }
                t[i] = ti;
            }
#pragma unroll
            for (int i = 0; i < 16; ++i) Tb[b * 256 + i * 16 + c] = (bf16)f2bf(t[i]);
        } else if (wid < 5) {
            const int tt = tid - 64, cgp = tt & 15, r0 = tt >> 4;
            { GAS bf16* at = palt ? palt + (((size_t)u * 4096 + 0x4000000ull) & 0x7ffffffull) : attn + (size_t)u * 4096;
#pragma unroll
              for (int k = 0; k < 2; ++k) { const int pc = tt + 256 * k, i = pc >> 3, c8 = pc & 7; *(GAS v4u*)(at + i * 64 + 8 * c8) = *(const LAS v4u*)(Ws + i * G2_TS + 8 * c8); } }
#pragma unroll
            for (int r = 0; r < 4; ++r) { const int i = r0 + 16 * r; const float e = __expf(gcs[i]); const v4u v = *(const LAS v4u*)(Qs + i * G2_TS + 8 * cgp); v4u w;
                w.x = pk2(bflo(v.x) * e, bfhi(v.x) * e); w.y = pk2(bflo(v.y) * e, bfhi(v.y) * e); w.z = pk2(bflo(v.z) * e, bfhi(v.z) * e); w.w = pk2(bflo(v.w) * e, bfhi(v.w) * e);
                *(GAS v4u*)G2_ST((row0 + i) * GDN_MAIN + h * HD + 8 * cgp) = w; }
        } else {
            const float gl = gcs[63];
            for (int task = tid - 320; task < 256; task += 192) { const int dk = task & 127, th = task >> 7;
                GAS bf16* dst = G2_ST((row0 + (dk >> 1)) * GDN_MAIN + 2048 + h * HD + (dk & 1) * 64 + 32 * th);
#pragma unroll
                for (int q = 0; q < 4; ++q) { float v[8];
#pragma unroll
                    for (int k = 0; k < 8; ++k) { const int tk = 32 * th + 8 * q + k; v[k] = bf2f(Ks[tk * G2_TS + dk]) * __expf(gl - gcs[tk]); }
                    v4u w; w.x = pk2(v[0], v[1]); w.y = pk2(v[2], v[3]); w.z = pk2(v[4], v[5]); w.w = pk2(v[6], v[7]); if (!(PROBE_G2_NOSCAT && palt)) *(GAS v4u*)(dst + 8 * q) = w; else asm volatile("" :: "v"(w)); } }
        }
        __syncthreads();
        if (!((G2_SKIP & 1) && palt)) {
            const int nl = lane & 15, q = lane >> 4; const bool isK = wid >= 4;
            float rsc[16];
#pragma unroll
            for (int b = 0; b < 4; ++b)
#pragma unroll
                for (int r = 0; r < 4; ++r) { const int row = 16 * b + 4 * q + r; rsc[4 * b + r] = isK ? bts[row] * __expf(gcs[row]) : bts[row]; }
            bf16x4 Tq[4], Aq[6];
#pragma unroll
            for (int b = 0; b < 4; ++b) Tq[b] = *(const LAS bf16x4*)(Tb + b * 256 + nl * 16 + 4 * q);
            Aq[0] = *(const LAS bf16x4*)(An + (16 + nl) * G2_ANS + 4 * q);
            Aq[1] = *(const LAS bf16x4*)(An + (32 + nl) * G2_ANS + 4 * q);      Aq[2] = *(const LAS bf16x4*)(An + (32 + nl) * G2_ANS + 16 + 4 * q);
            Aq[3] = *(const LAS bf16x4*)(An + (48 + nl) * G2_ANS + 4 * q);      Aq[4] = *(const LAS bf16x4*)(An + (48 + nl) * G2_ANS + 16 + 4 * q);   Aq[5] = *(const LAS bf16x4*)(An + (48 + nl) * G2_ANS + 32 + 4 * q);
#pragma unroll
            for (int t = 0; t < 2; ++t) {
                const int cc = 32 * (wid & 3) + 16 * t + nl;
                const LAS bf16* src = (isK ? Ks : Vs) + cc;
                f32x4 R[4];
#pragma unroll
                for (int b = 0; b < 4; ++b)
#pragma unroll
                    for (int r = 0; r < 4; ++r) R[b][r] = rsc[4 * b + r] * bf2f(src[(16 * b + 4 * q + r) * G2_TS]);
                const f32x4 z4 = {0.f, 0.f, 0.f, 0.f};
                const f32x4 y0 = MFMA16K16(Tq[0], pack4(R[0]), z4); const bf16x4 y0b = pack4(y0);
                f32x4 c1 = MFMA16K16(Aq[0], y0b, R[1]);
                const f32x4 y1 = MFMA16K16(Tq[1], pack4(c1), z4); const bf16x4 y1b = pack4(y1);
                f32x4 c2 = MFMA16K16(Aq[1], y0b, R[2]); c2 = MFMA16K16(Aq[2], y1b, c2);
                const f32x4 y2 = MFMA16K16(Tq[2], pack4(c2), z4); const bf16x4 y2b = pack4(y2);
                f32x4 c3 = MFMA16K16(Aq[3], y0b, R[3]); c3 = MFMA16K16(Aq[4], y1b, c3); c3 = MFMA16K16(Aq[5], y2b, c3);
                const f32x4 y3 = MFMA16K16(Tq[3], pack4(c3), z4); const bf16x4 y3b = pack4(y3);
                if (!isK) {
                    LAS bf16* dst = Us + cc * G2_US + 4 * q;
                    *(LAS bf16x4*)(dst) = y0b; *(LAS bf16x4*)(dst + 16) = y1b; *(LAS bf16x4*)(dst + 32) = y2b; *(LAS bf16x4*)(dst + 48) = y3b;
                } else {
#pragma unroll
                    for (int r = 0; r < 4; ++r) { Ws[(4 * q + r) * G2_TS + cc] = (bf16)y0b[r]; Ws[(16 + 4 * q + r) * G2_TS + cc] = (bf16)y1b[r]; Ws[(32 + 4 * q + r) * G2_TS + cc] = (bf16)y2b[r]; Ws[(48 + 4 * q + r) * G2_TS + cc] = (bf16)y3b[r]; }
                }
            }
        }
        __syncthreads();
#pragma unroll
        for (int k = 0; k < 2; ++k) { const int pc = tid + 512 * k, dv = pc >> 3, c8 = pc & 7;
            const v2u lo = *(const LAS v2u*)(Us + dv * G2_US + 8 * c8), hi2 = *(const LAS v2u*)(Us + dv * G2_US + 8 * c8 + 4);
            *(GAS v4u*)G2_ST((row0 + (dv & 63)) * GDN_MAIN + 4096 + h * HD + (dv >> 6) * 64 + 8 * c8) = (v4u){lo.x, lo.y, hi2.x, hi2.y}; }
#pragma unroll
        for (int k = 0; k < 2; ++k) { const int ch = tid + 512 * k, i = ch >> 4, c8 = ch & 15; *(GAS v4u*)((palt ? palt + (((row0 + i) * DMODEL + h * HD + 8 * c8) & 0x7ffffffull) : wbuf + (row0 + i) * DMODEL + h * HD + 8 * c8)) = *(const LAS v4u*)(Ws + i * G2_TS + 8 * c8); }
    }
#undef G2_ST
#undef G2_LOAD_RAW
}

constexpr int H2_AD = 0, H2_GC = 4096, H2_BT = 4352, H2_AN = 4608, H2_TB = H2_AN + 64 * G2_ANS * 2, H2_Q = H2_TB + 2048, H2_K = H2_Q + 64 * G2_TS * 2, H2_V = H2_K + 64 * G2_TS * 2, H2_GSZ = H2_V + 64 * G2_TS * 2;
static_assert(2 * H2_GSZ <= LDSCTL_OFF && H2_GSZ % 16 == 0, "G2 (two groups) LDS");
__device__ __forceinline__ void grp_bar(LAS unsigned* cnt, unsigned& tgt, int lane) {
    asm volatile("s_waitcnt lgkmcnt(0)" ::: "memory");
    if (lane == 0) __hip_atomic_fetch_add(cnt, 1u, __ATOMIC_RELAXED, __HIP_MEMORY_SCOPE_WORKGROUP);
    tgt += 4u;
    while (*(volatile LAS unsigned*)cnt < tgt) __builtin_amdgcn_s_sleep(1);
    asm volatile("" ::: "memory");
}
__device__ __forceinline__ void gdn_chunk_phase2(LAS unsigned char* lds, bf16* p_, const bf16* halo_, const float* beta_, float* g_, bf16* wbuf_, bf16* attn_, const float* conv_w_, int vcu, int G, bf16* palt_ = nullptr) {
#define G2_ST(off) ((palt ? palt + ((size_t)(off) & 0x7ffffffull) : p + (size_t)(off)))
    int tid_ = threadIdx.x; asm volatile("" : "+v"(tid_));
    const int tid0 = tid_;
    GAS bf16* const p = (GAS bf16*)p_; const GAS bf16* const halo = (const GAS bf16*)halo_; const GAS float* const beta = (const GAS float*)beta_; GAS float* const g = (GAS float*)g_;
    GAS bf16* const wbuf = (GAS bf16*)wbuf_; GAS bf16* const attn = (GAS bf16*)attn_; const GAS float* const conv_w = (const GAS float*)conv_w_; GAS bf16* const palt = (GAS bf16*)palt_;
    const int grp = __builtin_amdgcn_readfirstlane(tid0 >> 8);
    LAS unsigned* cnt = (LAS unsigned*)(lds + LDSCTL_OFF + 128 + 64 * grp);
    __syncthreads(); if (tid0 == 0) { *(LAS unsigned*)(lds + LDSCTL_OFF + 128) = 0u; *(LAS unsigned*)(lds + LDSCTL_OFF + 192) = 0u; } __syncthreads();
    unsigned tgt = 0u;
    LAS unsigned char* gb = lds + grp * H2_GSZ;
    LAS bf16* Qs = (LAS bf16*)(gb + H2_Q); LAS bf16* Ks = (LAS bf16*)(gb + H2_K); LAS bf16* Vs = (LAS bf16*)(gb + H2_V);
    LAS float* Ad = (LAS float*)(gb + H2_AD); LAS float* gcs = (LAS float*)(gb + H2_GC); LAS float* bts = (LAS float*)(gb + H2_BT);
    LAS bf16* An = (LAS bf16*)(gb + H2_AN); LAS bf16* Tb = (LAS bf16*)(gb + H2_TB);
    asm volatile("" : "+v"(Qs), "+v"(Ks), "+v"(Vs), "+v"(Ad), "+v"(gcs), "+v"(bts), "+v"(An), "+v"(Tb));
    v4u rawv[3][7]; float gpre = 0.f, bpre = 0.f;
#define H2_LOAD_RAW(uu, LN, W4) do { const int cg_ = (uu) >> 4, h_ = (uu) & 15, n_ = cg_ & 63; const size_t r0_ = (size_t)cg_ * 64; const int cgp_l = (LN) & 15, tA_l = 16 * (W4) + 4 * ((LN) >> 4); \
        _Pragma("unroll") for (int X = 0; X < 3; ++X) { const int col_ = X * 2048 + h_ * HD + 8 * cgp_l; \
            _Pragma("unroll") for (int rr = 0; rr < 7; ++rr) { const int rel = tA_l - 3 + rr; v4u v = {0u, 0u, 0u, 0u}; \
                if (rel >= 0) v = *(const GAS v4u*)(p + (r0_ + rel) * GDN_MAIN + col_); \
                else if (n_ > 0) v = *(const GAS v4u*)(halo + ((size_t)(cg_ - 1) * 3 + (rel + 3)) * CONVC + col_); \
                rawv[X][rr] = v; } } \
        if ((W4) == 0) { gpre = g[(r0_ + (LN)) * 16 + h_]; bpre = beta[(r0_ + (LN)) * 16 + h_]; } } while (0)
    const int u0 = 2 * vcu + grp, ustep = 2 * G;
    if (u0 < NCG * NHEADS) H2_LOAD_RAW(u0, (tid0 & 63), __builtin_amdgcn_readfirstlane((tid0 >> 6) & 3));
    for (int u = u0; u < NCG * NHEADS; u += ustep) {
        const int cg = u >> 4, h = u & 15; const size_t row0 = (size_t)cg * 64;
        int tl_ = tid0; asm volatile("" : "+v"(tl_));
        const int tid = tl_, lane = tid & 63, w4 = __builtin_amdgcn_readfirstlane((tid >> 6) & 3), gt = tid & 255, r32 = lane & 31, hi = lane >> 5;
        {
            const int cgp = lane & 15, sub = lane >> 4, tA = 16 * w4 + 4 * sub;
#pragma unroll
            for (int X = 0; X < 3; ++X) {
                const int col = X * 2048 + h * HD + 8 * cgp;
                asm volatile("" : "+v"(rawv[X][0]), "+v"(rawv[X][1]), "+v"(rawv[X][2]), "+v"(rawv[X][3]), "+v"(rawv[X][4]), "+v"(rawv[X][5]), "+v"(rawv[X][6]));
                float wj[4][8];
#pragma unroll
                for (int j = 0; j < 4; ++j) { const f32x4 wa = *(const GAS f32x4*)(conv_w + (size_t)j * CONVC + col), wb = *(const GAS f32x4*)(conv_w + (size_t)j * CONVC + col + 4);
#pragma unroll
                    for (int c = 0; c < 4; ++c) { wj[j][c] = wa[c]; wj[j][4 + c] = wb[c]; } }
                float o[4][8];
#pragma unroll
                for (int t = 0; t < 4; ++t)
#pragma unroll
                    for (int c = 0; c < 8; ++c) o[t][c] = 0.f;
#pragma unroll
                for (int rr = 0; rr < 7; ++rr) { const v4u v = rawv[X][rr]; const float rw[8] = {bflo(v.x), bfhi(v.x), bflo(v.y), bfhi(v.y), bflo(v.z), bfhi(v.z), bflo(v.w), bfhi(v.w)};
#pragma unroll
                    for (int t = 0; t < 4; ++t) { const int j = rr - t; if (j >= 0 && j < 4) {
#pragma unroll
                            for (int c = 0; c < 8; ++c) o[t][c] += wj[j][c] * rw[c]; } } }
                LAS bf16* T = X == 0 ? Qs : (X == 1 ? Ks : Vs);
#pragma unroll
                for (int t = 0; t < 4; ++t) { float s = 0.f;
#pragma unroll
                    for (int c = 0; c < 8; ++c) { o[t][c] = silu_f(o[t][c]); s += o[t][c] * o[t][c]; }
                    if (X < 2) { s = sum16(s); const float f = (X == 0 ? 0.08838834764831845f : 1.f) * __builtin_amdgcn_rsqf(s + GDN_EPS);
#pragma unroll
                        for (int c = 0; c < 8; ++c) o[t][c] *= f; }
                    v4u w0; w0.x = pk2(o[t][0], o[t][1]); w0.y = pk2(o[t][2], o[t][3]); w0.z = pk2(o[t][4], o[t][5]); w0.w = pk2(o[t][6], o[t][7]);
                    *(LAS v4u*)(T + (tA + t) * G2_TS + 8 * cgp) = w0; }
                asm volatile("" ::: "memory");
            }
            if (w4 == 0) {
                float gv = gpre;
#pragma unroll
                for (int o_ = 1; o_ < 64; o_ <<= 1) { const float t = __shfl_up(gv, o_); if (lane >= o_) gv += t; }
                gcs[lane] = gv; bts[lane] = bpre; if (!palt) g[(row0 + lane) * 16 + h] = gv;
            }
        }
        grp_bar(cnt, tgt, lane);
        if (u + ustep < NCG * NHEADS) H2_LOAD_RAW(u + ustep, lane, w4);
        {
            const int rb = w4 >> 1, cb = w4 & 1; const int j = 32 * cb + r32; const float gj = gcs[j];
            GAS bf16* at = palt ? palt + (((size_t)u * 4096 + 0x4000000ull) & 0x7ffffffull) : attn + (size_t)u * 4096;
#pragma unroll
            for (int pass = 0; pass < 2; ++pass) {
                f32x16 acc = {};
                if (!(rb == 0 && cb == 1)) {
                    const LAS bf16* Ar = (pass == 0 ? Ks : Qs) + (32 * rb + r32) * G2_TS + 8 * hi; const LAS bf16* Br = Ks + (32 * cb + r32) * G2_TS + 8 * hi;
#pragma unroll
                    for (int s = 0; s < 8; ++s) acc = MFMA32(*(const LAS bf16x8*)(Ar + 16 * s), *(const LAS bf16x8*)(Br + 16 * s), acc);
                }
#pragma unroll
                for (int r = 0; r < 16; ++r) { const int i = 32 * rb + (r & 3) + 8 * (r >> 2) + 4 * hi; const float gi = gcs[i];
                    if (pass == 0) { const float d = (i > j) ? __expf(gi - gj) : 0.f; const float a = (i > j) ? bts[i] * acc[r] * d : 0.f; An[i * G2_ANS + j] = (bf16)f2bf(-a);
                        if ((i >> 4) == (j >> 4)) Ad[(i >> 4) * 256 + (i & 15) * 16 + (j & 15)] = a; }
                    else { const float d = (i >= j) ? __expf(gi - gj) : 0.f; at[i * 64 + j] = (bf16)f2bf((i >= j) ? acc[r] * d : 0.f); } }
            }
        }
        grp_bar(cnt, tgt, lane);
        if (w4 == 0) {
            const int b = lane >> 4, c = lane & 15; float t[16];
            const LAS float* Ab = Ad + b * 256;
#pragma unroll
            for (int i = 0; i < 16; ++i) {
                float ti = (i == c) ? 1.f : 0.f;
#pragma unroll
                for (int j4 = 0; j4 < (i + 3) / 4; ++j4) { const f32x4 a = *(const LAS f32x4*)(Ab + i * 16 + 4 * j4);
#pragma unroll
                    for (int k = 0; k < 4; ++k) if (4 * j4 + k < i) ti -= a[k] * t[4 * j4 + k]; }
                t[i] = ti;
            }
#pragma unroll
            for (int i = 0; i < 16; ++i) Tb[b * 256 + i * 16 + c] = (bf16)f2bf(t[i]);
        } else {
            const int tt = gt - 64;
            for (int pc = tt; pc < 1024; pc += 192) { const int i = pc >> 4, cgp = pc & 15; const float e = __expf(gcs[i]); const v4u v = *(const LAS v4u*)(Qs + i * G2_TS + 8 * cgp); v4u w;
                w.x = pk2(bflo(v.x) * e, bfhi(v.x) * e); w.y = pk2(bflo(v.y) * e, bfhi(v.y) * e); w.z = pk2(bflo(v.z) * e, bfhi(v.z) * e); w.w = pk2(bflo(v.w) * e, bfhi(v.w) * e);
                *(GAS v4u*)G2_ST((row0 + i) * GDN_MAIN + h * HD + 8 * cgp) = w; }
            const float gl = gcs[63];
            for (int task = tt; task < 256; task += 192) { const int dk = task & 127, th = task >> 7;
                GAS bf16* dst = G2_ST((row0 + (dk >> 1)) * GDN_MAIN + 2048 + h * HD + (dk & 1) * 64 + 32 * th);
#pragma unroll
                for (int q = 0; q < 4; ++q) { float v[8];
#pragma unroll
                    for (int k = 0; k < 8; ++k) { const int tk = 32 * th + 8 * q + k; v[k] = bf2f(Ks[tk * G2_TS + dk]) * __expf(gl - gcs[tk]); }
                    v4u w; w.x = pk2(v[0], v[1]); w.y = pk2(v[2], v[3]); w.z = pk2(v[4], v[5]); w.w = pk2(v[6], v[7]); *(GAS v4u*)(dst + 8 * q) = w; } }
        }
        grp_bar(cnt, tgt, lane);
        {
            const int nl = lane & 15, q = lane >> 4; const bool isK = w4 >= 2;
            float rsc[16];
#pragma unroll
            for (int b = 0; b < 4; ++b)
#pragma unroll
                for (int r = 0; r < 4; ++r) { const int row = 16 * b + 4 * q + r; rsc[4 * b + r] = isK ? bts[row] * __expf(gcs[row]) : bts[row]; }
            bf16x4 Tq[4], Aq[6];
#pragma unroll
            for (int b = 0; b < 4; ++b) Tq[b] = *(const LAS bf16x4*)(Tb + b * 256 + nl * 16 + 4 * q);
            Aq[0] = *(const LAS bf16x4*)(An + (16 + nl) * G2_ANS + 4 * q);
            Aq[1] = *(const LAS bf16x4*)(An + (32 + nl) * G2_ANS + 4 * q);      Aq[2] = *(const LAS bf16x4*)(An + (32 + nl) * G2_ANS + 16 + 4 * q);
            Aq[3] = *(const LAS bf16x4*)(An + (48 + nl) * G2_ANS + 4 * q);      Aq[4] = *(const LAS bf16x4*)(An + (48 + nl) * G2_ANS + 16 + 4 * q);   Aq[5] = *(const LAS bf16x4*)(An + (48 + nl) * G2_ANS + 32 + 4 * q);
#pragma unroll
            for (int t = 0; t < 4; ++t) {
                const int cc = 64 * (w4 & 1) + 16 * t + nl;
                const LAS bf16* src = (isK ? Ks : Vs) + cc;
                f32x4 R[4];
#pragma unroll
                for (int b = 0; b < 4; ++b)
#pragma unroll
                    for (int r = 0; r < 4; ++r) R[b][r] = rsc[4 * b + r] * bf2f(src[(16 * b + 4 * q + r) * G2_TS]);
                const f32x4 z4 = {0.f, 0.f, 0.f, 0.f};
                const f32x4 y0 = MFMA16K16(Tq[0], pack4(R[0]), z4); const bf16x4 y0b = pack4(y0);
                f32x4 c1 = MFMA16K16(Aq[0], y0b, R[1]);
                const f32x4 y1 = MFMA16K16(Tq[1], pack4(c1), z4); const bf16x4 y1b = pack4(y1);
                f32x4 c2 = MFMA16K16(Aq[1], y0b, R[2]); c2 = MFMA16K16(Aq[2], y1b, c2);
                const f32x4 y2 = MFMA16K16(Tq[2], pack4(c2), z4); const bf16x4 y2b = pack4(y2);
                f32x4 c3 = MFMA16K16(Aq[3], y0b, R[3]); c3 = MFMA16K16(Aq[4], y1b, c3); c3 = MFMA16K16(Aq[5], y2b, c3);
                const f32x4 y3 = MFMA16K16(Tq[3], pack4(c3), z4); const bf16x4 y3b = pack4(y3);
                if (!isK) {
                    GAS bf16* dst = G2_ST((row0 + (cc & 63)) * GDN_MAIN + 4096 + h * HD + (cc >> 6) * 64 + 4 * q);
                    *(GAS bf16x4*)(dst) = y0b; *(GAS bf16x4*)(dst + 16) = y1b; *(GAS bf16x4*)(dst + 32) = y2b; *(GAS bf16x4*)(dst + 48) = y3b;
                } else {
                    GAS bf16* dst = palt ? palt + (((row0 + 4 * q) * DMODEL + h * HD + cc) & 0x7ffffffull) : wbuf + (row0 + 4 * q) * DMODEL + h * HD + cc;
#pragma unroll
                    for (int r = 0; r < 4; ++r) { dst[(size_t)r * DMODEL] = (bf16)y0b[r]; dst[(size_t)(16 + r) * DMODEL] = (bf16)y1b[r]; dst[(size_t)(32 + r) * DMODEL] = (bf16)y2b[r]; dst[(size_t)(48 + r) * DMODEL] = (bf16)y3b[r]; }
                }
            }
        }
        grp_bar(cnt, tgt, lane);
    }
#undef H2_LOAD_RAW
#undef G2_ST
    __syncthreads();
}

constexpr int G3_STS = 136, G3_VTS = 72;
constexpr int G3_ST = 0, G3_VT = G3_ST + 64 * G3_STS * 2, G3_OT = G3_VT + 64 * G3_VTS * 2, G3_WT = G3_OT + 64 * G3_VTS * 2, G3_QT = G3_WT + 64 * G3_STS * 2, G3_KT = G3_QT + 64 * G3_STS * 2,
              G3_PT = G3_KT + 128 * G3_VTS * 2, G3_UT = G3_PT + 64 * G3_VTS * 2, G3_END = G3_UT + 64 * G3_VTS * 2;
static_assert(G3_END <= RING_BYTES, "G3 LDS");
__device__ __forceinline__ void gdn_scan_phase(LAS unsigned char* lds, bf16* p_, const bf16* wbuf_, const bf16* attn_, const float* g_, int vcu, int G, bf16* oalt_ = nullptr) {
    GAS bf16* const p = (GAS bf16*)p_; const GAS bf16* const wbuf = (const GAS bf16*)wbuf_; const GAS bf16* const attn = (const GAS bf16*)attn_; const GAS float* const g = (const GAS float*)g_; GAS bf16* const oalt = (GAS bf16*)oalt_;
    int tid_ = threadIdx.x; asm volatile("" : "+v"(tid_));
    const int tid = tid_, lane = tid & 63, wid = __builtin_amdgcn_readfirstlane(tid >> 6), r32 = lane & 31, hi = lane >> 5;
    const int role = wid >> 2, a = (wid >> 1) & 1, bb = wid & 1, r = wid >> 1;
    LAS bf16* ST = (LAS bf16*)(lds + G3_ST); LAS bf16* VT = (LAS bf16*)(lds + G3_VT); LAS bf16* OT = (LAS bf16*)(lds + G3_OT);
    LAS bf16* WT = (LAS bf16*)(lds + G3_WT); LAS bf16* QT = (LAS bf16*)(lds + G3_QT); LAS bf16* KT = (LAS bf16*)(lds + G3_KT); LAS bf16* PT = (LAS bf16*)(lds + G3_PT); LAS bf16* UT = (LAS bf16*)(lds + G3_UT);
    for (int unit = vcu; unit < BATCH * NHEADS * 2; unit += G) {
        const int bh = unit >> 1, e = unit & 1, b = bh >> 4, h = bh & 15;
        for (int i = tid; i < G3_VT / 4; i += NWAVES * 64) ((LAS unsigned*)lds)[i] = 0u;
        f32x16 Sacc = {};
        const int r16a = tid >> 4, c16 = tid & 15, r8 = tid >> 3, c8 = tid & 7;
        const GAS bf16* gW = wbuf + (size_t)r16a * DMODEL + h * HD + 8 * c16;
        const GAS bf16* gQ = p + (size_t)r16a * GDN_MAIN + h * HD + 8 * c16;
        const GAS bf16* gK = p + (size_t)r16a * GDN_MAIN + 2048 + h * HD + 8 * c16;
        const GAS bf16* gP = attn + (size_t)r8 * 64 + 8 * c8;
        const GAS bf16* gU = p + (size_t)r8 * GDN_MAIN + 4096 + h * HD + e * 64 + 8 * c8;
        LAS bf16* sW = WT + r16a * G3_STS + 8 * c16; LAS bf16* sQ = QT + r16a * G3_STS + 8 * c16;
        LAS bf16* sK = KT + (2 * r16a + (c16 >> 3)) * G3_VTS + 8 * (c16 & 7);
        LAS bf16* sP = PT + r8 * G3_VTS + 8 * c8; LAS bf16* sU = UT + r8 * G3_VTS + 8 * c8;
        GAS bf16* oRow = (oalt ? oalt : p + 4096) + h * HD + e * 64; const size_t oPitch = oalt ? DMODEL : GDN_MAIN;
        const LAS bf16* aRd = (role == 0 ? WT : QT) + (32 * a + r32) * G3_STS + 8 * hi;
        const LAS bf16* sRd = ST + (32 * bb + r32) * G3_STS + 8 * hi; const LAS bf16* vRd = VT + (32 * bb + r32) * G3_VTS + 8 * hi;
        const LAS bf16* uRd = UT + (32 * bb + r32) * G3_VTS + 32 * a + 4 * hi; const LAS bf16* pRd = PT + (32 * a + r32) * G3_VTS + 8 * hi; const LAS bf16* kRd = KT + (32 * r + r32) * G3_VTS + 8 * hi;
        LAS bf16* vWr = VT + (32 * bb + r32) * G3_VTS + 32 * a + 4 * hi; LAS bf16* sWr = ST + (32 * bb + r32) * G3_STS + 32 * r + 4 * hi;
        v4u gw0, gw1, gq0, gq1, gk0, gk1, gp0, gu0; float dd;
#define G3_LOAD(nn) do { const size_t row0_ = (size_t)b * SEQ + (size_t)(nn) * 64; \
            gw0 = *(const GAS v4u*)(gW + row0_ * DMODEL); gw1 = *(const GAS v4u*)(gW + (row0_ + 32) * DMODEL); \
            gq0 = *(const GAS v4u*)(gQ + row0_ * GDN_MAIN); gq1 = *(const GAS v4u*)(gQ + (row0_ + 32) * GDN_MAIN); \
            gk0 = *(const GAS v4u*)(gK + row0_ * GDN_MAIN); gk1 = *(const GAS v4u*)(gK + (row0_ + 32) * GDN_MAIN); \
            gp0 = *(const GAS v4u*)(gP + ((size_t)(b * 64 + (nn)) * 16 + h) * 4096); gu0 = *(const GAS v4u*)(gU + row0_ * GDN_MAIN); \
            dd = __expf(g[(row0_ + 63) * 16 + h]); } while (0)
        G3_LOAD(0);
        __syncthreads();
#pragma unroll 1
        for (int n = 0; n < 64; ++n) {
            const size_t row0_ = (size_t)b * SEQ + (size_t)n * 64; const int nn = (n + 1 < 64) ? n + 1 : n;
            *(LAS v4u*)(sW) = gw0; *(LAS v4u*)(sW + 32 * G3_STS) = gw1; *(LAS v4u*)(sQ) = gq0; *(LAS v4u*)(sQ + 32 * G3_STS) = gq1;
            *(LAS v4u*)(sK) = gk0; *(LAS v4u*)(sK + 64 * G3_VTS) = gk1; *(LAS v4u*)(sP) = gp0; *(LAS v4u*)(sU) = gu0;
            const float dcur = dd;
            WG_BAR();
            G3_LOAD(nn);
            f32x16 acc_ = {};
#pragma unroll
            for (int s = 0; s < 8; ++s) acc_ = MFMA32(*(const LAS bf16x8*)(aRd + 16 * s), *(const LAS bf16x8*)(sRd + 16 * s), acc_);
            if (role == 0) {
#pragma unroll
                for (int q = 0; q < 4; ++q) { const v2u uu = *(const LAS v2u*)(uRd + 8 * q); v2u w_;
                    w_.x = pk2(bflo(uu.x) - acc_[4 * q], bfhi(uu.x) - acc_[4 * q + 1]); w_.y = pk2(bflo(uu.y) - acc_[4 * q + 2], bfhi(uu.y) - acc_[4 * q + 3]);
                    *(LAS v2u*)(vWr + 8 * q) = w_; }
            }
            WG_BAR();
            bf16x8 Vf_[4];
#pragma unroll
            for (int s = 0; s < 4; ++s) Vf_[s] = *(const LAS bf16x8*)(vRd + 16 * s);
            if (role == 1) {
#pragma unroll
                for (int s = 0; s < 4; ++s) acc_ = MFMA32(*(const LAS bf16x8*)(pRd + 16 * s), Vf_[s], acc_);
#pragma unroll
                for (int rr = 0; rr < 16; ++rr) OT[(32 * a + (rr & 3) + 8 * (rr >> 2) + 4 * hi) * G3_VTS + 32 * bb + r32] = (bf16)f2bf(acc_[rr]);
            }
            Sacc = Sacc * dcur;
#pragma unroll
            for (int s = 0; s < 4; ++s) Sacc = MFMA32(*(const LAS bf16x8*)(kRd + 16 * s), Vf_[s], Sacc);
#pragma unroll
            for (int q = 0; q < 4; ++q) { v2u w_; w_.x = pk2(Sacc[4 * q], Sacc[4 * q + 1]); w_.y = pk2(Sacc[4 * q + 2], Sacc[4 * q + 3]); *(LAS v2u*)(sWr + 8 * q) = w_; }
            WG_BAR();
            *(GAS v4u*)(oRow + (row0_ + r8) * oPitch + 8 * c8) = *(const LAS v4u*)(OT + r8 * G3_VTS + 8 * c8);
        }
#undef G3_LOAD
        VM_WAIT(); __syncthreads();
    }
}

__device__ __forceinline__ void gdn_gate_phase(bf16* p, const float* norm_w, int gw, int NGW, int lane, bf16* oalt = nullptr) {
    for (int m = gw; m < MROWS; m += NGW) {
        GAS bf16* orow = (GAS bf16*)p + (size_t)m * GDN_MAIN + 4096; const GAS bf16* zrow = (const GAS bf16*)p + (size_t)m * GDN_MAIN + 6144;
#pragma unroll
        for (int it = 0; it < 4; ++it) { const int col = it * 512 + lane * 8;
            const v4u ov = *(const GAS v4u*)(orow + col), zv = *(const GAS v4u*)(zrow + col);
            float o[8] = {bflo(ov.x), bfhi(ov.x), bflo(ov.y), bfhi(ov.y), bflo(ov.z), bfhi(ov.z), bflo(ov.w), bfhi(ov.w)};
            float z[8] = {bflo(zv.x), bfhi(zv.x), bflo(zv.y), bfhi(zv.y), bflo(zv.z), bfhi(zv.z), bflo(zv.w), bfhi(zv.w)};
            float s = 0.f;
#pragma unroll
            for (int c = 0; c < 8; ++c) s += o[c] * o[c];
            s = sum16(s); const float rs = __builtin_amdgcn_rsqf(s * (1.f / HD) + GDN_EPS);
            const f32x4 wa = *(const GAS f32x4*)((const GAS float*)norm_w + (col & 127)), wb = *(const GAS f32x4*)((const GAS float*)norm_w + (col & 127) + 4);
#pragma unroll
            for (int c = 0; c < 8; ++c) o[c] = o[c] * rs * (c < 4 ? wa[c] : wb[c - 4]) * silu_f(z[c]);
            v4u w; w.x = pk2(o[0], o[1]); w.y = pk2(o[2], o[3]); w.z = pk2(o[4], o[5]); w.w = pk2(o[6], o[7]); *(GAS v4u*)((oalt ? (GAS bf16*)oalt + (size_t)m * DMODEL : orow) + col) = w; }
    }
}

#ifndef PG8_SP2
#define PG8_SP2 true
#endif
#ifndef PG8_ALIGN
#define PG8_ALIGN true
#endif
#ifndef EN_P0
#define EN_P0 1
#endif
#ifndef EN_G1
#define EN_G1 1
#endif
#ifndef EN_G2
#define EN_G2 1
#endif
#ifndef EN_G3
#define EN_G3 1
#endif
#ifndef EN_G4
#define EN_G4 1
#endif
#ifndef EN_G5
#define EN_G5 1
#endif
#ifndef EN_G6
#define EN_G6 1
#endif
#ifndef EN_G7
#define EN_G7 1
#endif
#ifndef EN_G8
#define EN_G8 1
#endif
#ifndef EN_G9
#define EN_G9 1
#endif
#ifndef EN_D1
#define EN_D1 1
#endif
#ifndef EN_D2
#define EN_D2 1
#endif
#ifndef EN_D3
#define EN_D3 1
#endif
#ifndef EN_D4
#define EN_D4 1
#endif
#ifndef EN_D5
#define EN_D5 1
#endif
#ifndef EN_D6U
#define EN_D6U 1
#endif
#ifndef EN_D6D
#define EN_D6D 1
#endif
#ifndef EN_D7
#define EN_D7 1
#endif
#ifndef REP_P0
#define REP_P0 1
#endif
#ifndef REP_G1
#define REP_G1 1
#endif
#ifndef REP_G2
#define REP_G2 1
#endif
#ifndef REP_G3
#define REP_G3 1
#endif
#ifndef REP_G4
#define REP_G4 1
#endif
#ifndef REP_G5
#define REP_G5 1
#endif
#ifndef REP_G6
#define REP_G6 1
#endif
#ifndef REP_G7
#define REP_G7 1
#endif
#ifndef REP_G8
#define REP_G8 1
#endif
#ifndef REP_G9
#define REP_G9 1
#endif
#ifndef REP_D1
#define REP_D1 1
#endif
#ifndef REP_D2
#define REP_D2 1
#endif
#ifndef REP_D3
#define REP_D3 1
#endif
#ifndef REP_D4
#define REP_D4 1
#endif
#ifndef REP_D5
#define REP_D5 1
#endif
#ifndef REP_D6U
#define REP_D6U 1
#endif
#ifndef REP_D6D
#define REP_D6D 1
#endif
#ifndef REP_D7
#define REP_D7 1
#endif
#ifndef G2_VER
#define G2_VER 2
#endif
#if G2_VER == 2
#define G2_FN gdn_chunk_phase2
#else
#define G2_FN gdn_chunk_phase
#endif
#ifndef PROBE_DBLBAR
#define PROBE_DBLBAR 0
#endif
#ifndef REP_BA
#define REP_BA 1
#endif
#ifndef PROBE_NOSTORE
#define PROBE_NOSTORE 0
#endif
struct Args { const float* in[16]; float* out; unsigned char* ws; int ph_lo, ph_hi; };
__global__ void __launch_bounds__(NWAVES * 64, 2) yoco_fwd(Args args) {
    extern __shared__ __attribute__((aligned(16))) unsigned char lds_raw[];
    LAS unsigned char* lds = (LAS unsigned char*)lds_raw;
    volatile LAS unsigned* MISC = (volatile LAS unsigned*)(lds + MISC_OFF);
    const int tid = threadIdx.x, lane = tid & 63, wave = __builtin_amdgcn_readfirstlane(tid >> 6);
    const int G = gridDim.x, bx = blockIdx.x, vcu = (G % 8 == 0) ? (bx % 8) * (G / 8) + bx / 8 : bx;
    const int gw = vcu * NWAVES + wave, NGW = G * NWAVES, gtid = vcu * NWAVES * 64 + tid, NGT = G * NWAVES * 64;
    const float* ln_g = args.in[14]; const float* ln_b = args.in[15];
    for (int u = tid; u < (LDS_BYTES - LDSCTL_OFF) / 4; u += NWAVES * 64) ((LAS unsigned*)(lds + LDSCTL_OFF))[u] = 0u;
    __syncthreads();
    XcdBarrier bar; bar.bar = (unsigned*)(args.ws + WS_CTL) + CW_BAR; bar.x = 0; bar.st = nullptr;
    if (!MK_PER_PHASE) bar = xcd_barrier_post((unsigned*)(args.ws + WS_CTL) + CW_BAR, MISC + 8);
    const int lo = args.ph_lo, hi = args.ph_hi;
#define IN(k) (lo <= (k) && (k) < hi)
#define FRESH_LANE() int ln_ = lane; asm volatile("" : "+v"(ln_)); unsigned char* ws_ = args.ws; asm volatile("" : "+s"(ws_)); int gw_ = gw, vcu_ = vcu, bx_ = bx; asm volatile("" : "+s"(gw_), "+s"(vcu_), "+s"(bx_))
#define x_in         (args.in[0])
#define gdn_w_in     (args.in[1])
#define gdn_conv_w   (args.in[2])
#define gdn_a_log    (args.in[3])
#define gdn_dt_bias  (args.in[4])
#define gdn_norm_w   (args.in[5])
#define gdn_w_out    (args.in[6])
#define diff_w_q     (args.in[7])
#define diff_lambda  (args.in[8])
#define diff_subln_w (args.in[9])
#define diff_w_o     (args.in[10])
#define shared_w_kv  (args.in[11])
#define mlp_w_up     (args.in[12])
#define mlp_w_down   (args.in[13])
#define beta  ((float*)(ws_ + WS_BETA))
#define gdec  ((float*)(ws_ + WS_G))
#define halo  ((bf16*)(ws_ + WS_HALO))
#define WA    ((bf16*)(ws_ + WS_WA))
#define WB    ((bf16*)(ws_ + WS_WB))
#define attnb ((bf16*)(ws_ + WS_ATTN))
#define XB    ((bf16*)(ws_ + WS_XB))
#define HB    ((bf16*)(ws_ + WS_Y))
#define WBUF  ((bf16*)(ws_ + WS_Y + QTR))
#define R1    ((bf16*)(ws_ + WS_R1))
#define Kb    (R1)
#define Vb    (R1 + QTR / 2)
#define Qb    (R1 + 2 * (QTR / 2))
#define HID   (Qb)
#define SEAM(k) do { if (!MK_PER_PHASE && (k) + 1 < hi) { xcd_barrier(bar); if (PROBE_DBLBAR) xcd_barrier(bar); } } while (0)

    for (int rep_ = 0; rep_ < REP_P0; ++rep_) if (EN_P0 && IN(0)) { FRESH_LANE();
        for (int m = gw_; m < MROWS; m += NGW) row_to_bf16(x_in + (size_t)m * DMODEL, XB + (size_t)m * DMODEL, ln_);
        convert_w(lds, gw_, NGW, wave, ln_, gdn_w_in, DMODEL, GDN_PROJ, 0, GDN_PROJ, WA, 0);
        SEAM(0);
    }
    for (int l = 0; l < 2; ++l) {
        const int pb = 1 + 9 * l;
        for (int rep_ = 0; rep_ < REP_G1; ++rep_) if (EN_G1 && IN(pb + 0)) { FRESH_LANE();
            pg8::Gemm g{XB, WA, MROWS, GDN_MAIN, DMODEL, DMODEL}; pg8::StaticOrder S; S.init(MROWS, GDN_MAIN, G, bx_);
            pg8::EpiStore<0> E{R1, GDN_MAIN, 0, 0, -1, 1.f, halo};
            pg8::gemm_phase<pg8::EpiStore<0>, pg8::StaticOrder, PG8_ALIGN, PG8_SP2>(lds + RING_OFF, g, S, E);
            { int ln2_ = lane; asm volatile("" : "+v"(ln2_));
              for (int rb_ = 0; rb_ < REP_BA; ++rb_) ba_proj(XB, WA, gdn_a_log + l * 16, gdn_dt_bias + l * 16, beta, gdec, gw_, NGW, ln2_); }
            SEAM(pb + 0);
        }
        for (int rep_ = 0; rep_ < REP_G2; ++rep_) if (EN_G2 && IN(pb + 1)) { FRESH_LANE(); G2_FN(lds, R1, halo, beta, gdec, WBUF, attnb, gdn_conv_w + (size_t)l * 4 * CONVC, vcu_, G, (rep_ + 1 < REP_G2) ? (bf16*)args.out : nullptr); SEAM(pb + 1); }
        for (int rep_ = 0; rep_ < REP_G3; ++rep_) if (EN_G3 && IN(pb + 2)) { FRESH_LANE(); gdn_scan_phase(lds, R1, WBUF, attnb, gdec, vcu_, G, (rep_ + 1 < REP_G3) ? (bf16*)args.out : nullptr); SEAM(pb + 2); }
        for (int rep_ = 0; rep_ < REP_G4; ++rep_) if (EN_G4 && IN(pb + 3)) { FRESH_LANE();
            gdn_gate_phase(R1, gdn_norm_w + l * HD, gw_, NGW, ln_, (rep_ + 1 < REP_G4) ? (bf16*)args.out : nullptr);
            convert_w(lds, gw_, NGW, wave, ln_, gdn_w_out + (size_t)l * DMODEL * DMODEL, DMODEL, DMODEL, 0, DMODEL, WA, 0);
            convert_w(lds, gw_, NGW, wave, ln_, mlp_w_up + (size_t)l * DMODEL * DFF, DMODEL, DFF, 0, DFF, WB, 0);
            SEAM(pb + 3);
        }
        for (int rep_ = 0; rep_ < REP_G5; ++rep_) if (EN_G5 && IN(pb + 4)) { FRESH_LANE();
            pg8::Gemm g{R1 + 4096, WA, MROWS, DMODEL, DMODEL, GDN_MAIN}; pg8::StaticOrder S; S.init(MROWS, DMODEL, G, bx_);
            pg8::EpiStore<0> E{(rep_ + 1 < REP_G5) ? (bf16*)args.out : HB, DMODEL, 0, 0, -1, 1.f, nullptr};
            pg8::gemm_phase<pg8::EpiStore<0>, pg8::StaticOrder, PG8_ALIGN, PG8_SP2>(lds + RING_OFF, g, S, E);
            SEAM(pb + 4);
        }
        const float* g1 = ln_g + (size_t)(l * 2) * DMODEL; const float* b1 = ln_b + (size_t)(l * 2) * DMODEL;
        for (int rep_ = 0; rep_ < REP_G6; ++rep_) if (EN_G6 && IN(pb + 5)) { FRESH_LANE();
            ln_pass_b(XB, HB, g1, b1, XB, nullptr, ALPHA_RES, gw_, NGW, ln_);
            convert_w(lds, gw_, NGW, wave, ln_, mlp_w_down + (size_t)l * DFF * DMODEL, DFF, DMODEL, 0, DMODEL, WA, 0);
            SEAM(pb + 5);
        }
        for (int rep_ = 0; rep_ < REP_G7; ++rep_) if (EN_G7 && IN(pb + 6)) { FRESH_LANE();
            pg8::Gemm g{XB, WB, MROWS, DFF, DMODEL, DMODEL}; pg8::StaticOrder S; S.init(MROWS, DFF, G, bx_);
            pg8::EpiStore<1> E{R1, DFF, 0, 0, -1, 1.f, nullptr};
            pg8::gemm_phase<pg8::EpiStore<1>, pg8::StaticOrder, PG8_ALIGN, PG8_SP2>(lds + RING_OFF, g, S, E);
            SEAM(pb + 6);
        }
        for (int rep_ = 0; rep_ < REP_G8; ++rep_) if (EN_G8 && IN(pb + 7)) { FRESH_LANE();
            pg8::Gemm g{R1, WA, MROWS, DMODEL, DFF, DFF}; pg8::StaticOrder S; S.init(MROWS, DMODEL, G, bx_);
            pg8::EpiStore<0> E{(rep_ + 1 < REP_G8) ? (bf16*)args.out : HB, DMODEL, 0, 0, -1, 1.f, nullptr};
            pg8::gemm_phase<pg8::EpiStore<0>, pg8::StaticOrder, PG8_ALIGN, PG8_SP2>(lds + RING_OFF, g, S, E);
            SEAM(pb + 7);
        }
        for (int rep_ = 0; rep_ < REP_G9; ++rep_) if (EN_G9 && IN(pb + 8)) { FRESH_LANE();
            const float* g2 = ln_g + (size_t)(l * 2 + 1) * DMODEL; const float* b2 = ln_b + (size_t)(l * 2 + 1) * DMODEL;
            ln_pass_b(XB, HB, g2, b2, XB, nullptr, ALPHA_RES, gw_, NGW, ln_);
            if (l == 0) convert_w(lds, gw_, NGW, wave, ln_, gdn_w_in + (size_t)DMODEL * GDN_PROJ, DMODEL, GDN_PROJ, 0, GDN_PROJ, WA, 0);
            else { convert_w(lds, gw_, NGW, wave, ln_, shared_w_kv, DMODEL, 2 * DMODEL, 0, 2 * DMODEL, WA, 0);
                   convert_w(lds, gw_, NGW, wave, ln_, diff_w_q, DMODEL, DMODEL, 0, DMODEL, WA, 2 * DMODEL); }
            SEAM(pb + 8);
        }
    }
    for (int j = 0; j < 2; ++j) {
        const int pb = 19 + 10 * j, L = 2 + j;
        for (int rep_ = 0; rep_ < REP_D1; ++rep_) if (EN_D1 && IN(pb + 0)) { FRESH_LANE();
            const int N = (j == 0) ? 3 * DMODEL : DMODEL;
            pg8::Gemm g{XB, WA, MROWS, N, DMODEL, DMODEL}; pg8::StaticOrder S; S.init(MROWS, N, G, bx_);
            pg8::EpiStore<0> E{(j == 0) ? Kb : Qb, DMODEL, (j == 0) ? DMODEL : 0, QTR / 2, (j == 0) ? 2 : 0, dattn::C2, nullptr};
            pg8::gemm_phase<pg8::EpiStore<0>, pg8::StaticOrder, PG8_ALIGN, PG8_SP2>(lds + RING_OFF, g, S, E);
            SEAM(pb + 0);
        }
        for (int rep_ = 0; rep_ < REP_D2; ++rep_) if (EN_D2 && IN(pb + 1)) { FRESH_LANE();
            const float lambda_init = 0.8f - 0.6f * expf(-0.3f * (float)L);
            const float* lp = diff_lambda + (size_t)j * 256;
            const float e1 = wave_sum(lp[ln_] * lp[64 + ln_]), e2 = wave_sum(lp[128 + ln_] * lp[192 + ln_]);
            const dattn::Params AP{(const dattn::bf16*)Qb, (const dattn::bf16*)Kb, (const dattn::bf16*)Vb, (rep_ + 1 < REP_D2) ? (dattn::bf16*)args.out : (dattn::bf16*)Qb, diff_subln_w + j * HD, __expf(e1) - __expf(e2) + lambda_init, 1.f - lambda_init};
            dattn::phase<8>((char*)lds_raw + RING_OFF, AP, G, bx_);
            { int ln2_ = lane; asm volatile("" : "+v"(ln2_));
              convert_w(lds, gw_, NGW, wave, ln2_, diff_w_o + (size_t)j * DMODEL * DMODEL, DMODEL, DMODEL, 0, DMODEL, WB, 0);
              convert_w(lds, gw_, NGW, wave, ln2_, mlp_w_up + (size_t)L * DMODEL * DFF, DMODEL, DFF, 0, DFF, WA, 0); }
            SEAM(pb + 1);
        }
        for (int rep_ = 0; rep_ < REP_D4; ++rep_) if (EN_D4 && IN(pb + 3)) { FRESH_LANE();
            pg8::Gemm g{Qb, WB, MROWS, DMODEL, DMODEL, DMODEL}; pg8::StaticOrder S; S.init(MROWS, DMODEL, G, bx_);
            pg8::EpiStore<0> E{(rep_ + 1 < REP_D4) ? (bf16*)args.out : HB, DMODEL, 0, 0, -1, 1.f, nullptr};
            pg8::gemm_phase<pg8::EpiStore<0>, pg8::StaticOrder, PG8_ALIGN, PG8_SP2>(lds + RING_OFF, g, S, E);
            SEAM(pb + 3);
        }
        const float* g1 = ln_g + (size_t)(L * 2) * DMODEL; const float* b1 = ln_b + (size_t)(L * 2) * DMODEL;
        for (int rep_ = 0; rep_ < REP_D5; ++rep_) if (EN_D5 && IN(pb + 4)) { FRESH_LANE();
            ln_pass_b(XB, HB, g1, b1, XB, nullptr, ALPHA_RES, gw_, NGW, ln_);
            convert_w(lds, gw_, NGW, wave, ln_, mlp_w_down + (size_t)L * DFF * DMODEL, DFF, DMODEL, 0, DMODEL, WB, 0);
            SEAM(pb + 4);
        }
        for (int hf = 0; hf < 2; ++hf) {
            const size_t roff = (size_t)hf * (MROWS / 2);
            for (int rep_ = 0; rep_ < REP_D6U; ++rep_) if (EN_D6U && IN(pb + 5 + 2 * hf)) { FRESH_LANE();
                pg8::Gemm g{XB + roff * DMODEL, WA, MROWS / 2, DFF, DMODEL, DMODEL}; pg8::StaticOrder S; S.init(MROWS / 2, DFF, G, bx_);
                pg8::EpiStore<1> E{(PROBE_NOSTORE && rep_ + 1 < REP_D6U) ? (bf16*)nullptr : HID, DFF, 0, 0, -1, 1.f, nullptr};
                pg8::gemm_phase<pg8::EpiStore<1>, pg8::StaticOrder, PG8_ALIGN, PG8_SP2>(lds + RING_OFF, g, S, E);
                SEAM(pb + 5 + 2 * hf);
            }
            for (int rep_ = 0; rep_ < REP_D6D; ++rep_) if (EN_D6D && IN(pb + 6 + 2 * hf)) { FRESH_LANE();
                pg8::Gemm g{HID, WB, MROWS / 2, DMODEL, DFF, DFF}; pg8::StaticOrder S; S.init(MROWS / 2, DMODEL, G, bx_);
                pg8::EpiStore<0> E{((rep_ + 1 < REP_D6D) ? (bf16*)args.out : HB) + roff * DMODEL, DMODEL, 0, 0, -1, 1.f, nullptr};
                pg8::gemm_phase<pg8::EpiStore<0>, pg8::StaticOrder, PG8_ALIGN, PG8_SP2>(lds + RING_OFF, g, S, E);
                SEAM(pb + 6 + 2 * hf);
            }
        }
        for (int rep_ = 0; rep_ < REP_D7; ++rep_) if (EN_D7 && IN(pb + 9)) { FRESH_LANE();
            const float* g2 = ln_g + (size_t)(L * 2 + 1) * DMODEL; const float* b2 = ln_b + (size_t)(L * 2 + 1) * DMODEL;
            if (j == 0) { ln_pass_b(XB, HB, g2, b2, XB, nullptr, ALPHA_RES, gw_, NGW, ln_);
                          convert_w(lds, gw_, NGW, wave, ln_, diff_w_q + (size_t)DMODEL * DMODEL, DMODEL, DMODEL, 0, DMODEL, WA, 0); }
            else { ln_pass_b(XB, HB, g2, b2, nullptr, args.out, ALPHA_RES, gw_, NGW, ln_); }
            SEAM(pb + 9);
        }
    }
#undef IN
#undef SEAM
}

extern "C" void kernel_launch(void* const* d_in, const int* in_sizes, int n_in, void* d_out, int out_size, void* d_ws, size_t ws_size, hipStream_t stream) {
    static int grid = 0;
    if (grid == 0) {
        if (n_in != 16 || in_sizes[0] != MROWS * DMODEL || out_size != MROWS * DMODEL || ws_size < WS_END) { fprintf(stderr, "kernel_launch: unexpected shapes / workspace (n_in %d, ws %zu < %zu); nothing launched\n", n_in, ws_size, (size_t)WS_END); grid = -1; return; }
        int dev = 0, cus = 0, per_cu = 0;
        if (hipGetDevice(&dev) != hipSuccess || hipDeviceGetAttribute(&cus, hipDeviceAttributeMultiprocessorCount, dev) != hipSuccess) { grid = -1; return; }
        if (hipFuncSetAttribute((const void*)yoco_fwd, hipFuncAttributeMaxDynamicSharedMemorySize, LDS_BYTES) != hipSuccess) { fprintf(stderr, "kernel_launch: hipFuncSetAttribute failed\n"); grid = -1; return; }
        if (hipOccupancyMaxActiveBlocksPerMultiprocessor(&per_cu, (const void*)yoco_fwd, NWAVES * 64, LDS_BYTES) != hipSuccess || per_cu < 1)
            fprintf(stderr, "kernel_launch: note: occupancy query reports %d workgroups per CU\n", per_cu);
        (void)hipGetLastError();
        grid = cus;
    }
    if (grid < 0) return;
    if (hipMemsetAsync((char*)d_ws + WS_CTL, 0, CTL_ZERO_BYTES, stream) != hipSuccess) return;
    Args a{};
    for (int i = 0; i < 16; ++i) a.in[i] = (const float*)d_in[i];
    a.out = (float*)d_out; a.ws = (unsigned char*)d_ws;
#if MK_PER_PHASE
    for (int k = 0; k < N_PHASES; ++k) { a.ph_lo = k; a.ph_hi = k + 1; hipLaunchKernelGGL(yoco_fwd, dim3(grid), dim3(NWAVES * 64), LDS_BYTES, stream, a); }
#else
    a.ph_lo = 0; a.ph_hi = N_PHASES;
    hipLaunchKernelGGL(yoco_fwd, dim3(grid), dim3(NWAVES * 64), LDS_BYTES, stream, a);
#endif
    const hipError_t le = hipPeekAtLastError();
    if (le != hipSuccess) fprintf(stderr, "kernel_launch: launch failed: %s\n", hipGetErrorName(le));
}
```

```cpp
#include <hip/hip_runtime.h>
#include <hip/hip_bf16.h>
#include <cstdio>
#include <cstdint>
#include <cmath>

namespace pg8 {
#define PG8_LAS __attribute__((address_space(3)))
typedef unsigned short bf16_t;
typedef short bf16x8 __attribute__((ext_vector_type(8)));
typedef float f32x4 __attribute__((ext_vector_type(4)));
typedef unsigned u32x4 __attribute__((ext_vector_type(4)));
#define PG8_GAS __attribute__((address_space(1)))
#ifndef PG8_WGM
#define PG8_WGM 4
#endif
#ifndef PG8_STORE_SC1
#define PG8_STORE_SC1 0
#endif
constexpr int BM = 256, BK = 64, HALF = 128, HTB = HALF * BK * 2  , STAGE_BYTES = 8 * HTB, NXCD = 8;

__host__ __device__ __forceinline__ int lds_byte(int r, int c) { const int st = (r >> 4) * 2 + (c >> 5), rr = r & 15, cc = c & 31, ob = rr * 64 + cc * 2; return st * 1024 + (ob ^ (((ob >> 9) & 1) << 5)); }
__host__ __device__ __forceinline__ void stage_rc(int b, int& R, int& C) { const int st = b / 1024, sb = b % 1024, swz = sb ^ (((sb >> 9) & 1) << 5); R = (st >> 1) * 16 + swz / 64; C = (st & 1) * 32 + (swz % 64) / 2; }
__host__ __device__ __forceinline__ int perm32(int rho) { const int n = rho >> 4, i = rho & 15; return 8 * (i >> 2) + 4 * n + (i & 3); }

struct Unit { int pm, pn; };
struct Gemm { const bf16_t* A; const bf16_t* Bt; int M, N, K, lda; };

struct StaticOrder {
    int nM, nN, nwg, G, c, WGM;
    __host__ __device__ void init(int M, int N, int G_, int c_, int wgm = PG8_WGM) { nM = M / BM; nN = N / BM; nwg = nM * nN; G = G_; c = c_; WGM = wgm; }
    __host__ __device__ bool next(int i, Unit& u) const {
        const long L = (long)i * G + c; if (L >= nwg) return false;
        int wgid = (int)L; { const int q = nwg / NXCD, r = nwg % NXCD, xcd = wgid % NXCD, off = wgid / NXCD; wgid = (xcd < r ? xcd * (q + 1) : r * (q + 1) + (xcd - r) * q) + off; }
        const int nig = WGM * nN, gid = wgid / nig, fm = gid * WGM, gsz = (nM - fm) < WGM ? (nM - fm) : WGM;
        u.pm = fm + ((wgid % nig) % gsz); u.pn = (wgid % nig) / gsz; return true;
    }
    __device__ __forceinline__ void a_ready(const Unit&) const {}
    __device__ __forceinline__ void done(const Unit&) const {}
};

__device__ __forceinline__ unsigned cvt_pk_bf16(float lo, float hi) { unsigned r; asm volatile("v_cvt_pk_bf16_f32 %0, %1, %2" : "=v"(r) : "v"(lo), "v"(hi)); return r; }

template <int ACT> struct EpiStore {
    static constexpr bool PERM = true, AFTER_DRAIN = false;
    bf16_t* O; int ldc; int split_cols; size_t split_stride; int scale_tile; float scale0; bf16_t* halo;
    __device__ __forceinline__ void operator()(const f32x4 (&acc)[2][2][4][2], const Unit& u, int wr, int wc, int fr, int fq) const {
        const int row0 = u.pm * BM + wr * 64 + fr; int colt = u.pn * BM; PG8_GAS bf16_t* base = (PG8_GAS bf16_t*)O; PG8_GAS bf16_t* hal = (PG8_GAS bf16_t*)halo;
        int t = 0; if (split_cols) { t = colt / split_cols; base += (size_t)t * split_stride; colt -= t * split_cols; }
        const float sc = (t == scale_tile) ? scale0 : 1.f;
        const int col0 = colt + wc * 32 + 8 * fq;
#pragma unroll
        for (int ai = 0; ai < 2; ++ai)
#pragma unroll
            for (int m = 0; m < 4; ++m) { const int row = row0 + ai * HALF + m * 16; PG8_GAS bf16_t* rowp = base + (size_t)row * ldc + col0;
#pragma unroll
                for (int bj = 0; bj < 2; ++bj) { f32x4 v0 = acc[ai][bj][m][0], v1 = acc[ai][bj][m][1];
                    if (ACT == 1) {
#pragma unroll
                        for (int e = 0; e < 4; ++e) { const float a = fmaxf(v0[e], 0.f), b = fmaxf(v1[e], 0.f); v0[e] = a * a; v1[e] = b * b; } }
                    if (sc != 1.f) { v0 = v0 * sc; v1 = v1 * sc; }
                    u32x4 w; w.x = cvt_pk_bf16(v0[0], v0[1]); w.y = cvt_pk_bf16(v0[2], v0[3]); w.z = cvt_pk_bf16(v1[0], v1[1]); w.w = cvt_pk_bf16(v1[2], v1[3]);
#if PG8_STORE_SC1
                    if (O != nullptr) asm volatile("global_store_dwordx4 %0, %1, off sc1\n\ts_nop 1" :: "v"(rowp + bj * HALF), "v"(w) : "memory"); else asm volatile("" :: "v"(w));
#else
                    if (O != nullptr) *(PG8_GAS u32x4*)(rowp + bj * HALF) = w; else asm volatile("" :: "v"(w));
#endif
                    if (halo != nullptr && m == 3 && fr >= 13) { const int c = col0 + bj * HALF; if (c < 6144) *(PG8_GAS u32x4*)(hal + ((size_t)(row >> 6) * 3 + (fr - 13)) * 6144 + c) = w; }
                } }
    }
};
template <class Epi, class Sched, bool ALIGN_EPI = false, bool SP2 = false>
__device__ __forceinline__ void gemm_phase(PG8_LAS unsigned char* lds, const Gemm g, const Sched& S, const Epi& E) {
    int tid_ = threadIdx.x; asm volatile("" : "+v"(tid_));
    const int tid = tid_, wid = __builtin_amdgcn_readfirstlane(tid >> 6), lane = tid & 63, wr = wid >> 2, wc = wid & 3, fr = lane & 15, fq = lane >> 4;
    const int K = g.K, nt = K / BK, lda = g.lda;
    unsigned voffA[2], voffB[2];
#pragma unroll
    for (int i = 0; i < 2; ++i) { int R, C; stage_rc(tid * 16 + i * 8192, R, C); const int Rb = Epi::PERM ? ((R & ~31) + perm32(R & 31)) : R;
        voffA[i] = (unsigned)(R * lda + C) * 2u; voffB[i] = (unsigned)(Rb * K + C) * 2u; }
    const size_t kstep = (size_t)(BK * 2);
    const size_t hA = (size_t)HALF * lda * 2, hB = (size_t)HALF * K * 2;
    const size_t tA = 2 * hA, tB = 2 * hB;
    const unsigned ldsw = (unsigned)wid * 1024u;
    const int aoff = lds_byte(wr * 64 + fr, fq * 8), boff = lds_byte(wc * 32 + fr, fq * 8);
#define PG8_SA(b, h) (((b) * 2 + (h)) * HTB)
#define PG8_SB(b, h) ((4 + (b) * 2 + (h)) * HTB)
#define PG8_STAGE(bufoff, gbase, voff) do { _Pragma("unroll") for (int _i = 0; _i < 2; ++_i) \
        __builtin_amdgcn_global_load_lds((const unsigned*)((const char*)(gbase) + (voff)[_i]), (PG8_LAS unsigned*)(lds + (bufoff) + ldsw + _i * 8192), 16, 0, 0); } while (0)
#define PG8_LDA(dst, b, h) do { _Pragma("unroll") for (int m = 0; m < 4; ++m) _Pragma("unroll") for (int k = 0; k < 2; ++k) dst[m][k] = *(const PG8_LAS bf16x8*)(lds + PG8_SA(b, h) + aoff + m * 2048 + k * 1024); } while (0)
#define PG8_LDB(dst, b, h) do { _Pragma("unroll") for (int n = 0; n < 2; ++n) _Pragma("unroll") for (int k = 0; k < 2; ++k) dst[n][k] = *(const PG8_LAS bf16x8*)(lds + PG8_SB(b, h) + boff + n * 2048 + k * 1024); } while (0)
#define PG8_MMA(ai, bj, At, Bt) do { __builtin_amdgcn_s_setprio(1); _Pragma("unroll") for (int m = 0; m < 4; ++m) _Pragma("unroll") for (int n = 0; n < 2; ++n) _Pragma("unroll") for (int k = 0; k < 2; ++k) \
        acc[ai][bj][m][n] = __builtin_amdgcn_mfma_f32_16x16x32_bf16(Bt[n][k], At[m][k], acc[ai][bj][m][n], 0, 0, 0); __builtin_amdgcn_s_setprio(0); } while (0)
#define PG8_WAIT_V(n) asm volatile("s_waitcnt vmcnt(" #n ")" ::: "memory")
#define PG8_WAIT_L(n) asm volatile("s_waitcnt lgkmcnt(" #n ")" ::: "memory")
#define PG8_BAR __builtin_amdgcn_s_barrier()
#define PG8_SCHED __builtin_amdgcn_sched_barrier(0)
    Unit cur, nxt; int ui = 0;
    if (!S.next(0, cur)) return;
    f32x4 acc[2][2][4][2];
#pragma unroll
    for (int a = 0; a < 2; ++a)
#pragma unroll
        for (int b = 0; b < 2; ++b)
#pragma unroll
            for (int m = 0; m < 4; ++m)
#pragma unroll
                for (int n = 0; n < 2; ++n) acc[a][b][m][n] = (f32x4){0.f, 0.f, 0.f, 0.f};
    bf16x8 At[4][2], B0[2][2], B1[2][2];
    const char* cA = (const char*)g.A + (size_t)cur.pm * tA; const char* cB = (const char*)g.Bt + (size_t)cur.pn * tB;
    S.a_ready(cur);
    if constexpr (SP2) {
        PG8_STAGE(PG8_SB(0, 0), cB, voffB); PG8_STAGE(PG8_SB(0, 1), cB + hB, voffB); PG8_STAGE(PG8_SA(0, 0), cA, voffA); PG8_STAGE(PG8_SA(0, 1), cA + hA, voffA);
        if (wr == 1) PG8_BAR;
        PG8_WAIT_V(2); PG8_BAR;
        PG8_STAGE(PG8_SB(1, 0), cB + kstep, voffB); PG8_STAGE(PG8_SA(1, 0), cA + kstep, voffA); PG8_STAGE(PG8_SB(1, 1), cB + hB + kstep, voffB);
        PG8_WAIT_V(6); PG8_BAR;
    } else {
        PG8_STAGE(PG8_SB(0, 0), cB, voffB); PG8_STAGE(PG8_SA(0, 0), cA, voffA); PG8_STAGE(PG8_SB(0, 1), cB + hB, voffB); PG8_STAGE(PG8_SA(0, 1), cA + hA, voffA);
        if (wr == 1) PG8_BAR;
        PG8_WAIT_V(4); PG8_BAR;
        PG8_STAGE(PG8_SB(1, 0), cB + kstep, voffB); PG8_STAGE(PG8_SA(1, 0), cA + kstep, voffA); PG8_STAGE(PG8_SB(1, 1), cB + hB + kstep, voffB);
        PG8_WAIT_V(6); PG8_BAR;
    }
    for (;;) {
        const bool has_next = S.next(ui + 1, nxt);
        const char* nA = has_next ? (const char*)g.A + (size_t)nxt.pm * tA : cA; const char* nB = has_next ? (const char*)g.Bt + (size_t)nxt.pn * tB : cB;
        for (int t = 0; t < nt; t += 2) {
            const bool last = (t == nt - 2);
            const char* a1 = cA + (size_t)(t + 1) * kstep;
            const char* a2 = last ? nA : cA + (size_t)(t + 2) * kstep; const char* b2 = last ? nB : cB + (size_t)(t + 2) * kstep;
            const char* a3 = a2 + kstep; const char* b3 = b2 + kstep;
            if (last && has_next) S.a_ready(nxt);
            if constexpr (SP2) {
            PG8_LDB(B0, 0, 0); PG8_LDB(B1, 0, 1); PG8_SCHED; PG8_LDA(At, 0, 0); PG8_STAGE(PG8_SA(1, 1), a1 + hA, voffA);
            PG8_WAIT_V(8); PG8_WAIT_L(0); PG8_BAR; PG8_MMA(0, 0, At, B0); PG8_MMA(0, 1, At, B1); PG8_BAR; PG8_SCHED;
            PG8_LDA(At, 0, 1); PG8_STAGE(PG8_SB(0, 0), b2, voffB); PG8_STAGE(PG8_SB(0, 1), b2 + hB, voffB); PG8_STAGE(PG8_SA(0, 0), a2, voffA);
            PG8_WAIT_V(8); PG8_WAIT_L(0); PG8_BAR; PG8_MMA(1, 0, At, B0); PG8_MMA(1, 1, At, B1); PG8_BAR; PG8_SCHED;
            PG8_LDB(B0, 1, 0); PG8_LDB(B1, 1, 1); PG8_SCHED; PG8_LDA(At, 1, 0); PG8_STAGE(PG8_SA(0, 1), a2 + hA, voffA);
            PG8_WAIT_V(8); PG8_WAIT_L(0); PG8_BAR; PG8_MMA(0, 0, At, B0); PG8_MMA(0, 1, At, B1); PG8_BAR; PG8_SCHED;
            PG8_LDA(At, 1, 1); PG8_STAGE(PG8_SB(1, 0), b3, voffB); PG8_STAGE(PG8_SB(1, 1), b3 + hB, voffB); PG8_STAGE(PG8_SA(1, 0), a3, voffA);
            PG8_WAIT_V(8); PG8_WAIT_L(0); PG8_BAR; PG8_MMA(1, 0, At, B0); PG8_MMA(1, 1, At, B1); PG8_BAR; PG8_SCHED;
            } else {
            PG8_LDB(B0, 0, 0); PG8_SCHED; PG8_LDA(At, 0, 0); PG8_STAGE(PG8_SA(1, 1), a1 + hA, voffA);
            PG8_WAIT_L(8); PG8_BAR; PG8_WAIT_L(0); PG8_MMA(0, 0, At, B0); PG8_BAR; PG8_SCHED;
            PG8_LDB(B1, 0, 1); PG8_STAGE(PG8_SB(0, 0), b2, voffB);
            PG8_BAR; PG8_WAIT_L(0); PG8_MMA(0, 1, At, B1); PG8_BAR;
            PG8_LDA(At, 0, 1); PG8_STAGE(PG8_SA(0, 0), a2, voffA);
            PG8_BAR; PG8_WAIT_L(0); PG8_MMA(1, 0, At, B0); PG8_BAR; PG8_SCHED;
            PG8_STAGE(PG8_SB(0, 1), b2 + hB, voffB);
            PG8_WAIT_V(6); PG8_BAR; PG8_MMA(1, 1, At, B1); PG8_BAR;
            PG8_LDB(B0, 1, 0); PG8_SCHED; PG8_LDA(At, 1, 0); PG8_STAGE(PG8_SA(0, 1), a2 + hA, voffA);
            PG8_WAIT_L(8); PG8_BAR; PG8_WAIT_L(0); PG8_MMA(0, 0, At, B0); PG8_BAR; PG8_SCHED;
            PG8_LDB(B1, 1, 1); PG8_STAGE(PG8_SB(1, 0), b3, voffB);
            PG8_BAR; PG8_WAIT_L(0); PG8_MMA(0, 1, At, B1); PG8_BAR;
            PG8_LDA(At, 1, 1); PG8_STAGE(PG8_SA(1, 0), a3, voffA);
            PG8_BAR; PG8_WAIT_L(0); PG8_MMA(1, 0, At, B0); PG8_BAR; PG8_SCHED;
            PG8_STAGE(PG8_SB(1, 1), b3 + hB, voffB);
            PG8_WAIT_V(6); PG8_BAR; PG8_MMA(1, 1, At, B1); PG8_BAR;
            }
        }
        if constexpr (ALIGN_EPI) { if (wr == 0) PG8_BAR; }
        if constexpr (!Epi::AFTER_DRAIN) { E(acc, cur, wr, wc, fr, fq); S.done(cur); }
        if (!has_next) break;
#pragma unroll
        for (int a = 0; a < 2; ++a)
#pragma unroll
            for (int b = 0; b < 2; ++b)
#pragma unroll
                for (int m = 0; m < 4; ++m)
#pragma unroll
                    for (int n = 0; n < 2; ++n) acc[a][b][m][n] = (f32x4){0.f, 0.f, 0.f, 0.f};
        cur = nxt; cA = nA; cB = nB; ++ui;
        if constexpr (ALIGN_EPI) { if (wr == 1) PG8_BAR; }
    }
    PG8_WAIT_V(0);
    if constexpr (!ALIGN_EPI) { if (wr == 0) PG8_BAR; }
    PG8_BAR;
#undef PG8_SA
#undef PG8_SB
#undef PG8_STAGE
#undef PG8_LDA
#undef PG8_LDB
#undef PG8_MMA
#undef PG8_WAIT_V
#undef PG8_WAIT_L
#undef PG8_BAR
#undef PG8_SCHED
}
}
#ifndef ATTN_PRIO
#define ATTN_PRIO 0
#endif
namespace dattn {
using bf16=__hip_bfloat16;
using bf16x8=__attribute__((ext_vector_type(8)))short;
using s16x4=__attribute__((ext_vector_type(4)))short;
using f32x16=__attribute__((ext_vector_type(16)))float;
using u32x4=__attribute__((ext_vector_type(4)))unsigned;
constexpr int SEQ=4096,DM=2048,HDV=128;
constexpr int NW=8,QBLK=32,QB=128,KVBLK=64,NQB=SEQ/QB;
__device__ __forceinline__ int crow(int r,int hi){return (r&3)+8*(r>>2)+4*hi;}
#define SBAR() __builtin_amdgcn_sched_barrier(0)
__device__ __forceinline__ void cmask(f32x16&p0,f32x16&p1,int jb,int qrel,int hi){
  const float NEG=-INFINITY; int kb=64*jb+4*hi;
  #pragma unroll
  for(int r=0;r<16;++r){int kv=kb+(r&3)+8*(r>>2); if(kv>qrel)p0[r]=NEG; if(kv+32>qrel)p1[r]=NEG;}
}
constexpr float C2=0.125f*1.4426950408889634f;
constexpr int NSLOT=3, SLOTB=16384;
constexpr int LDS_K=0, LDS_V=NSLOT*SLOTB, LDS_WS=2*NSLOT*SLOTB, LDS_BYTES=LDS_WS+NW*64*4;
__device__ __forceinline__ void glds16(const void*gsrc,unsigned lds_dst){unsigned keep;
  asm volatile("s_mov_b32 %0, m0\n\ts_mov_b32 m0, %2\n\ts_nop 0\n\tglobal_load_lds_dwordx4 %1, off\n\ts_mov_b32 m0, %0":"=&s"(keep):"v"(gsrc),"s"(lds_dst):"memory");}
__device__ __forceinline__ float max3f(float a,float b,float c){float r;asm("v_max3_f32 %0, %1, %2, %3":"=v"(r):"v"(a),"v"(b),"v"(c));return r;}
__device__ __forceinline__ float max2f(float a,float b){float r;asm("v_max_f32_e32 %0, %1, %2":"=v"(r):"v"(a),"v"(b));return r;}
__device__ __forceinline__ float fadd_s(float a,float b){float r;asm("v_add_f32_e32 %0, %1, %2":"=v"(r):"v"(a),"v"(b));return r;}
__device__ __forceinline__ float fsub_s(float a,float b){float r;asm("v_sub_f32_e32 %0, %1, %2":"=v"(r):"v"(a),"v"(b));return r;}
typedef float f32x2_t __attribute__((ext_vector_type(2))); typedef __bf16 bf16x2_t __attribute__((ext_vector_type(2)));
__device__ __forceinline__ unsigned cvtpk_s(float lo,float hi){f32x2_t v={lo,hi};bf16x2_t b=__builtin_convertvector(v,bf16x2_t);return __builtin_bit_cast(unsigned,b);}
#define WAIT_BAR(N) asm volatile("s_waitcnt vmcnt(" #N ") lgkmcnt(0)\n\ts_barrier":::"memory")
typedef __attribute__((address_space(3))) const char* lds_cptr;
typedef short v4i16_t __attribute__((ext_vector_type(4)));
__device__ __forceinline__ void qkt(f32x16&p0,f32x16&p1,const char*kb,const bf16x8*qr){ const f32x16 negm=f32x16{};
  #pragma unroll
  for(int d0=0;d0<4;++d0){
    const bf16x8 b0=*reinterpret_cast<const bf16x8*>(kb+d0*2048);
    const bf16x8 b1=*reinterpret_cast<const bf16x8*>(kb+d0*2048+512);
    if(d0==0){p0=__builtin_amdgcn_mfma_f32_32x32x16_bf16(b0,qr[0],negm,0,0,0);p1=__builtin_amdgcn_mfma_f32_32x32x16_bf16(b1,qr[0],negm,0,0,0);}
    else{p0=__builtin_amdgcn_mfma_f32_32x32x16_bf16(b0,qr[d0],p0,0,0,0);p1=__builtin_amdgcn_mfma_f32_32x32x16_bf16(b1,qr[d0],p1,0,0,0);}}
}
__device__ __forceinline__ void kload8(bf16x8*kf,lds_cptr kp){
  kf[0]=*(const __attribute__((address_space(3))) bf16x8*)(kp);      kf[1]=*(const __attribute__((address_space(3))) bf16x8*)(kp+512);
  kf[2]=*(const __attribute__((address_space(3))) bf16x8*)(kp+2048); kf[3]=*(const __attribute__((address_space(3))) bf16x8*)(kp+2560);
  kf[4]=*(const __attribute__((address_space(3))) bf16x8*)(kp+4096); kf[5]=*(const __attribute__((address_space(3))) bf16x8*)(kp+4608);
  kf[6]=*(const __attribute__((address_space(3))) bf16x8*)(kp+6144); kf[7]=*(const __attribute__((address_space(3))) bf16x8*)(kp+6656);
}
__device__ __forceinline__ void kload2(bf16x8*kf,lds_cptr kp,int j){ kf[2*j]=*(const __attribute__((address_space(3))) bf16x8*)(kp+j*2048); kf[2*j+1]=*(const __attribute__((address_space(3))) bf16x8*)(kp+j*2048+512); }
__device__ __forceinline__ s16x4 vtr(lds_cptr p){ return __builtin_bit_cast(s16x4,__builtin_amdgcn_ds_read_tr16_b64_v4i16((__attribute__((address_space(3))) v4i16_t*)p)); }
__device__ __forceinline__ float rowmax(const f32x16&p0,const f32x16&p1){
  float a=max3f(p0[0],p0[1],p1[0]),b=max3f(p0[2],p0[3],p1[1]);a=max3f(a,p1[2],p1[3]);
  #pragma unroll
  for(int r=4;r<16;r+=4){a=max3f(a,p0[r],p0[r+1]);b=max3f(b,p0[r+2],p0[r+3]);a=max3f(a,p1[r],p1[r+1]);b=max3f(b,p1[r+2],p1[r+3]);}
  const float m=max2f(a,b);
  auto rr=__builtin_amdgcn_permlane32_swap(__float_as_uint(m),__float_as_uint(m),false,false);
  return max2f(__uint_as_float(rr[0]),__uint_as_float(rr[1]));
}
__device__ __forceinline__ void pv(f32x16*o,int vb,bf16x8 pa0,bf16x8 pa1,bf16x8 pa2,bf16x8 pa3){
  #pragma unroll
  for(int d0=0;d0<4;++d0){s16x4 lo[4],hi[4];
    #pragma unroll
    for(int ks=0;ks<4;++ks){
      asm volatile("ds_read_b64_tr_b16 %0,%1 offset:%c2":"=&v"(lo[ks]):"v"(vb),"i"(d0*4096+ks*1024):"memory");
      asm volatile("ds_read_b64_tr_b16 %0,%1 offset:%c2":"=&v"(hi[ks]):"v"(vb),"i"(d0*4096+ks*1024+512):"memory");}
    asm volatile("s_waitcnt lgkmcnt(0)":::"memory");SBAR();
    #define PK(k) (bf16x8){lo[k][0],lo[k][1],lo[k][2],lo[k][3],hi[k][0],hi[k][1],hi[k][2],hi[k][3]}
    o[d0]=__builtin_amdgcn_mfma_f32_32x32x16_bf16(pa0,PK(0),o[d0],0,0,0);
    o[d0]=__builtin_amdgcn_mfma_f32_32x32x16_bf16(pa1,PK(1),o[d0],0,0,0);
    o[d0]=__builtin_amdgcn_mfma_f32_32x32x16_bf16(pa2,PK(2),o[d0],0,0,0);
    o[d0]=__builtin_amdgcn_mfma_f32_32x32x16_bf16(pa3,PK(3),o[d0],0,0,0);
    #undef PK
  }
}

struct Params { const bf16* Q; const bf16* K; const bf16* V; bf16* O; const float* subln_w; float lam, post; };
template<int THRL> __device__ __forceinline__ void unit(int b,int h,int qb,const Params&P,char*shm){
  int tid_=threadIdx.x; asm volatile("":"+v"(tid_));
  const int tid=tid_,lane=tid&63,r32=lane&31,hi=lane>>5; const int wid=__builtin_amdgcn_readfirstlane(tid>>6);
  const int cmp=wid&1,rbk=wid>>1;
  if(ATTN_PRIO&&wid>=4)__builtin_amdgcn_s_setprio(1);
  const long rowbase=(long)b*SEQ; const int q0=qb*QB;
  const bf16*Qw=P.Q+(rowbase+q0+rbk*QBLK)*DM+h*HDV+cmp*64;
  const bf16*Kh=P.K+rowbase*DM+h*HDV,*Vh=P.V+rowbase*DM+h*HDV;
  const unsigned lds0=(unsigned)(uintptr_t)shm;
  float*wsf=(float*)(shm+LDS_WS)+wid*64;
  const bf16*ksrc=Kh+(long)lane*DM+wid*8;
  const bf16*vsrc=Vh+(long)(16*(wid&3)+(lane>>2))*DM+(wid>>2)*32+(lane&3)*8;
  const unsigned kdst=lds0+LDS_K+wid*1024, vdst=lds0+LDS_V+wid*1024;
  #define DMA_K(t,slot) do{ glds16(ksrc+(long)(t)*KVBLK*DM,(unsigned)__builtin_amdgcn_readfirstlane(kdst+(slot))); glds16(ksrc+(long)(t)*KVBLK*DM+64,(unsigned)__builtin_amdgcn_readfirstlane(kdst+(slot)+8192)); }while(0)
  #define DMA_V(t,slot) do{ glds16(vsrc+(long)(t)*KVBLK*DM,(unsigned)__builtin_amdgcn_readfirstlane(vdst+(slot))); glds16(vsrc+(long)(t)*KVBLK*DM+64,(unsigned)__builtin_amdgcn_readfirstlane(vdst+(slot)+8192)); }while(0)
  const int vb0=(int)(lds0+LDS_V)+((lane>>4)&1)*32+(lane&3)*8+(4*hi+((lane&15)>>2))*64;
  bf16x8 kf[8];
  const lds_cptr shm3=(lds_cptr)shm; const lds_cptr kp0=shm3+LDS_K+(cmp*8+hi)*1024+r32*16; const lds_cptr vp0=shm3+LDS_V+((lane>>4)&1)*32+(lane&3)*8+(4*hi+((lane&15)>>2))*64;
  const char*Kbase=shm+LDS_K+(cmp*8+hi)*1024+r32*16;
  const int NT=(q0+QB)/KVBLK;
  DMA_K(0,0);DMA_V(0,0);DMA_K(1,SLOTB);
  bf16x8 qr[4];
  #pragma unroll
  for(int d0=0;d0<4;++d0)qr[d0]=*(const __attribute__((address_space(1))) bf16x8*)(&Qw[(long)r32*DM+d0*16+hi*8]);
  float mhat=0.f,l_reg=0.f;f32x16 o[4];o[0]=f32x16{};o[1]=f32x16{};o[2]=f32x16{};o[3]=f32x16{};const f32x16 zero16=f32x16{};
  const int qrel=rbk*QBLK+r32;
  #define CMASK(P0,P1,t) do{int jb_=(t)-(NT-2); if(jb_>=0)cmask(P0,P1,jb_,qrel,hi);}while(0)
  bool resc=false;
  #define START(P0,P1) do{ const float rm=rowmax(P0,P1); resc=false; \
    { const float dl=rm; mhat=fadd_s(mhat,dl); \
      _Pragma("unroll") for(int r=0;r<16;++r){P0[r]=fsub_s(P0[r],dl);P1[r]=fsub_s(P1[r],dl);} } \
    _Pragma("unroll") for(int r=0;r<16;++r)P0[r]=__builtin_amdgcn_exp2f(P0[r]); }while(0)
  #define RESC() do{ if(resc){ asm volatile("s_waitcnt lgkmcnt(0)":::"memory"); \
      _Pragma("unroll") for(int d_=0;d_<4;++d_) _Pragma("unroll") for(int r=0;r<16;++r)o[d_][r]*=wsf[crow(r,hi)]; } }while(0)
  f32x16 pA0,pA1,pB0,pB1;
  int sl_prev=0,sl_cur=0,sl_next=SLOTB;
  #define ROT() do{sl_prev=sl_cur;sl_cur=sl_next;sl_next=(sl_next==(NSLOT-1)*SLOTB)?0:sl_next+SLOTB;}while(0)
  DMA_K(2,2*SLOTB);
  WAIT_BAR(6);
  qkt(pA0,pA1,Kbase,qr);asm volatile("s_nop 15\n\ts_nop 7":"+v"(pA0),"+v"(pA1));CMASK(pA0,pA1,0);
  START(pA0,pA1);
  _Pragma("unroll") for(int r=0;r<16;++r)pA1[r]=__builtin_amdgcn_exp2f(pA1[r]);
  WAIT_BAR(0);
  DMA_K(3,0);DMA_V(1,SLOTB);
  ROT();
  kload8(kf,kp0+sl_cur);
  if(NT>2){WAIT_BAR(4);}else{WAIT_BAR(0);}
  s16x4 vlo[4],vhi[4]; u32x4 pw0,pw1,pw2,pw3;
  #define PKW(P,B) cvtpk_s(P[B],P[B+1])
  #define PAF(k) __builtin_bit_cast(bf16x8,pw##k)
  #define VFR(i) (bf16x8){vlo[i][0],vlo[i][1],vlo[i][2],vlo[i][3],vhi[i][0],vhi[i][1],vhi[i][2],vhi[i][3]}
  #define PIN(x) asm volatile("":"+v"(x))
  #define MX3(a,b,c) __builtin_fmaxf(__builtin_fmaxf((a),(b)),(c))
  #define GAPA(MF,A0,A1,A2,A3,W0,W1,PW) do{ MF; sacc+=A0; sacc+=A1; sacc+=A2; sacc+=A3; PIN(sacc); W0; W1; PIN(PW); SBAR(); }while(0)
  #define EX(v) __builtin_amdgcn_exp2f((v)-mhat)
  #define VOFF(f) ((((f)&3)*4096)+(((f)>>2)*1024))
  #define VRD(i,f) do{ vlo[i]=vtr(vp_+VOFF(f)); vhi[i]=vtr(vp_+VOFF(f)+512); }while(0)
  #define GAPB(MF,X,B) do{ MF; X[B]=EX(X[B]); X[B+1]=EX(X[B+1]); PIN(X); SBAR(); }while(0)
  #define GAPBV(MF,X,B,i,f) do{ MF; X[B]=EX(X[B]); X[B+1]=EX(X[B+1]); PIN(X); VRD(i,f); SBAR(); }while(0)
  #define KRD(G,j) do{ if(G){ kload2(kf,kp0+sl_next,j); SBAR(); } }while(0)
  #define PVM(d,k,i) o[d]=__builtin_amdgcn_mfma_f32_32x32x16_bf16(PAF(k),VFR(i),o[d],0,0,0)
  #define STEP(C0,C1,P0,P1,t,GK,GV,GL) do{ SBAR(); \
    const lds_cptr vp_=vp0+sl_prev; \
    float sacc=(P0[0]+P0[1]); \
    GAPA(C0=__builtin_amdgcn_mfma_f32_32x32x16_bf16(kf[0],qr[0],zero16,0,0,0), P0[2],P0[3],P0[4],P0[5],     pw0[0]=PKW(P0,0), pw0[1]=PKW(P0,2), pw0); \
    GAPA(C1=__builtin_amdgcn_mfma_f32_32x32x16_bf16(kf[1],qr[0],zero16,0,0,0), P0[6],P0[7],P0[8],P0[9],     pw0[2]=PKW(P0,4), pw0[3]=PKW(P0,6), pw0); \
    GAPA(C0=__builtin_amdgcn_mfma_f32_32x32x16_bf16(kf[2],qr[1],C0,0,0,0),   P0[10],P0[11],P0[12],P0[13], pw1[0]=PKW(P0,8), pw1[1]=PKW(P0,10), pw1); \
    GAPA(C1=__builtin_amdgcn_mfma_f32_32x32x16_bf16(kf[3],qr[1],C1,0,0,0),   P0[14],P0[15],P1[0],P1[1],   pw1[2]=PKW(P0,12),pw1[3]=PKW(P0,14), pw1); \
    VRD(0,0); SBAR(); GAPA(C0=__builtin_amdgcn_mfma_f32_32x32x16_bf16(kf[4],qr[2],C0,0,0,0),   P1[2],P1[3],P1[4],P1[5],     pw2[0]=PKW(P1,0), pw2[1]=PKW(P1,2), pw2); \
    VRD(1,1); SBAR(); GAPA(C1=__builtin_amdgcn_mfma_f32_32x32x16_bf16(kf[5],qr[2],C1,0,0,0),   P1[6],P1[7],P1[8],P1[9],     pw2[2]=PKW(P1,4), pw2[3]=PKW(P1,6), pw2); \
    VRD(2,2); SBAR(); GAPA(C0=__builtin_amdgcn_mfma_f32_32x32x16_bf16(kf[6],qr[3],C0,0,0,0),   P1[10],P1[11],P1[12],P1[13], pw3[0]=PKW(P1,8), pw3[1]=PKW(P1,10), pw3); \
    VRD(3,3); SBAR(); GAPA(C1=__builtin_amdgcn_mfma_f32_32x32x16_bf16(kf[7],qr[3],C1,0,0,0),   P1[14],P1[15],0.f,0.f,       pw3[2]=PKW(P1,12),pw3[3]=PKW(P1,14), pw3); \
    l_reg+=sacc; \
    if(GK){DMA_K((t)+3,sl_cur);} if(GV){DMA_V((t)+1,sl_next);} \
    CMASK(C0,C1,t); \
    { float a=MX3(C0[0],C0[1],C1[0]),b=MX3(C0[2],C0[3],C1[1]); a=MX3(a,C1[2],C1[3]); \
      _Pragma("unroll") for(int r=4;r<16;r+=4){a=MX3(a,C0[r],C0[r+1]);b=MX3(b,C0[r+2],C0[r+3]);a=MX3(a,C1[r],C1[r+1]);b=MX3(b,C1[r+2],C1[r+3]);} \
      float rm=__builtin_fmaxf(a,b); { auto rr=__builtin_amdgcn_permlane32_swap(__float_as_uint(rm),__float_as_uint(rm),false,false); rm=__builtin_fmaxf(__uint_as_float(rr[0]),__uint_as_float(rr[1])); } \
      rm-=mhat; resc=false; \
      if(__builtin_expect(__any(rm>(float)THRL),0)){ const float dl=__builtin_fmaxf(rm,0.f); mhat+=dl; \
        const float f=__builtin_amdgcn_exp2f(-dl); l_reg*=f; if(hi==0)wsf[r32]=f; resc=true; } } \
    SBAR(); \
    GAPBV(PVM(0,0,0),C0,0, 0,4);  GAPBV(PVM(1,0,1),C0,2, 1,5);  GAPBV(PVM(2,0,2),C0,4, 2,6);  GAPBV(PVM(3,0,3),C0,6, 3,7); \
    GAPBV(PVM(0,1,0),C0,8, 0,8);  GAPBV(PVM(1,1,1),C0,10,1,9);  GAPBV(PVM(2,1,2),C0,12,2,10); GAPBV(PVM(3,1,3),C0,14,3,11); \
    KRD(GL,0); GAPBV(PVM(0,2,0),C1,0, 0,12); KRD(GL,1); GAPBV(PVM(1,2,1),C1,2, 1,13); KRD(GL,2); GAPBV(PVM(2,2,2),C1,4, 2,14); KRD(GL,3); GAPBV(PVM(3,2,3),C1,6, 3,15); \
    GAPB(PVM(0,3,0),C1,8); GAPB(PVM(1,3,1),C1,10); GAPB(PVM(2,3,2),C1,12); GAPB(PVM(3,3,3),C1,14); \
    }while(0)
  int t=1;
  #undef CMASK
  #define CMASK(P0,P1,t) do{}while(0)
  for(;t+3<NT;t+=2){
    STEP(pB0,pB1,pA0,pA1,t,true,true,true);     WAIT_BAR(4); RESC(); ROT();
    STEP(pA0,pA1,pB0,pB1,t+1,true,true,true);   WAIT_BAR(4); RESC(); ROT();
  }
  #undef CMASK
  #define CMASK(P0,P1,t) do{int jb_=(t)-(NT-2); if(jb_>=0)cmask(P0,P1,jb_,qrel,hi);}while(0)
  #define ENDW(tt) do{ if((tt)+3<NT){WAIT_BAR(4);} else if((tt)+2<NT){WAIT_BAR(2);} else {WAIT_BAR(0);} }while(0)
  for(;t+1<NT;t+=2){
    STEP(pB0,pB1,pA0,pA1,t,(t+3<NT),(t+1<NT),(t+1<NT));       ENDW(t);   RESC(); ROT();
    STEP(pA0,pA1,pB0,pB1,t+1,(t+4<NT),(t+2<NT),(t+2<NT));     ENDW(t+1); RESC(); ROT();
  }
  STEP(pB0,pB1,pA0,pA1,NT-1,false,false,false); RESC();
  { float sacc=pB0[0]+pB0[1]; _Pragma("unroll") for(int r=2;r<16;++r)sacc+=pB0[r]; _Pragma("unroll") for(int r=0;r<16;++r)sacc+=pB1[r]; l_reg+=sacc;
    pw0=(u32x4){PKW(pB0,0),PKW(pB0,2),PKW(pB0,4),PKW(pB0,6)};pw1=(u32x4){PKW(pB0,8),PKW(pB0,10),PKW(pB0,12),PKW(pB0,14)};pw2=(u32x4){PKW(pB1,0),PKW(pB1,2),PKW(pB1,4),PKW(pB1,6)};pw3=(u32x4){PKW(pB1,8),PKW(pB1,10),PKW(pB1,12),PKW(pB1,14)};
    SBAR(); pv(o,vb0+sl_cur,PAF(0),PAF(1),PAF(2),PAF(3)); }
  #undef PKW
  #undef PAF
  #undef VFR
  #undef PIN
  #undef MX3
  #undef GAPA
  #undef GAPB
  #undef GAPBV
  #undef EX
  #undef VOFF
  #undef VRD
  #undef KRD
  #undef PVM
  #undef STEP
  #undef ENDW
  {auto rr=__builtin_amdgcn_permlane32_swap(__float_as_uint(l_reg),__float_as_uint(l_reg),false,false);l_reg=__uint_as_float(rr[0])+__uint_as_float(rr[1]);}
  if(hi==0)wsf[32+r32]=l_reg;asm volatile("s_waitcnt lgkmcnt(0)":::"memory");
  float rli[16];
  #pragma unroll
  for(int r=0;r<16;++r)rli[r]=__builtin_amdgcn_rcpf(wsf[32+crow(r,hi)]);
  asm volatile("s_waitcnt lgkmcnt(0)\n\ts_barrier":::"memory");
  { bf16*stg=(bf16*)(shm)+wid*4096;
    #pragma unroll
    for(int r=0;r<16;++r){const int orow=crow(r,hi);
      #pragma unroll
      for(int d0=0;d0<4;++d0)stg[orow*128+d0*32+r32]=__float2bfloat16(o[d0][r]*rli[r]);} }
  asm volatile("s_waitcnt lgkmcnt(0)\n\ts_barrier":::"memory");
  { const bf16*s0=(const bf16*)(shm)+(wid&~1)*4096; const bf16*s1=s0+4096;
    bf16*Ow=P.O+(rowbase+q0+rbk*QBLK)*DM+h*HDV; const int ch=lane&15;
    typedef float f32x4_t __attribute__((ext_vector_type(4)));
    const f32x4_t wa=*(const __attribute__((address_space(1))) f32x4_t*)(P.subln_w+ch*8), wb=*(const __attribute__((address_space(1))) f32x4_t*)(P.subln_w+ch*8+4);
    #pragma unroll
    for(int i=0;i<4;++i){ const int row=16*cmp+4*i+(lane>>4);
      const u32x4 a=*(const u32x4*)(s0+row*128+ch*8), bq=*(const u32x4*)(s1+row*128+ch*8);
      float d[8];
      #pragma unroll
      for(int k=0;k<4;++k){ const unsigned ua=a[k],ub=bq[k];
        d[2*k]=__uint_as_float(ua<<16)-P.lam*__uint_as_float(ub<<16); d[2*k+1]=__uint_as_float(ua&0xffff0000u)-P.lam*__uint_as_float(ub&0xffff0000u); }
      float s=0.f;
      #pragma unroll
      for(int k=0;k<8;++k)s+=d[k]*d[k];
      s+=__shfl_xor(s,1);s+=__shfl_xor(s,2);s+=__shfl_xor(s,4);s+=__shfl_xor(s,8);
      const float rs=P.post*__builtin_amdgcn_rsqf(s*(1.f/128.f)+1e-5f);
      u32x4 w; w[0]=cvtpk_s(d[0]*rs*wa[0],d[1]*rs*wa[1]); w[1]=cvtpk_s(d[2]*rs*wa[2],d[3]*rs*wa[3]); w[2]=cvtpk_s(d[4]*rs*wb[0],d[5]*rs*wb[1]); w[3]=cvtpk_s(d[6]*rs*wb[2],d[7]*rs*wb[3]);
      *(__attribute__((address_space(1))) u32x4*)(Ow+(long)row*DM+ch*8)=w; } }
  asm volatile("s_waitcnt lgkmcnt(0)\n\ts_barrier":::"memory");
  if(ATTN_PRIO&&wid>=4)__builtin_amdgcn_s_setprio(0);
  #undef DMA_K
  #undef DMA_V
  #undef CMASK
  #undef START
  #undef RESC
  #undef ROT
}
constexpr int ATTN_LDS_BYTES=LDS_BYTES;
template<int THRL=8> __device__ __forceinline__ void phase(char*lds,const Params&P,int grid,int block){
  const int vcu=(grid%8==0)?(block%8)*(grid/8)+block/8:block;
  for(int v=vcu;v<256;v+=grid){ const int bh=v>>1,p=v&1;
    for(int i=0;i<16;++i){ const int s=2*(i>>1)+p; const int qb=(i&1)?31-s:s; unit<THRL>(bh>>4,bh&15,qb,P,lds); } }
}
#undef SBAR
#undef WAIT_BAR
}
constexpr int NWAVES = 8;
#ifndef MK_PER_PHASE
#define MK_PER_PHASE 0
#endif

constexpr int BATCH = 8, SEQ = 4096, DMODEL = 2048, MROWS = BATCH * SEQ, DFF = 8192, NHEADS = 16, HD = 128;
constexpr int GDN_PROJ = 8224, GDN_MAIN = 8192, CONVC = 6144, NCG = MROWS / 64;
constexpr float ALPHA_RES = 1.6817928305074292f;
constexpr float LN_EPS = 1e-5f, GDN_EPS = 1e-6f, SUBLN_EPS = 1e-5f;
constexpr int N_PHASES = 39;

constexpr size_t MiB = 1u << 20;
constexpr size_t WS_CTL = 0, CTL_ZERO_BYTES = 1 * MiB;
constexpr size_t WS_ONES = 1 * MiB, WS_ZEROS = WS_ONES + 8192, WS_MU = WS_ONES + 65536, WS_RSTD = WS_MU + 131072;
constexpr size_t WS_BETA = 2 * MiB, WS_G = 4 * MiB;
constexpr size_t WS_HALO = 9 * MiB;
constexpr size_t WS_WA = 27 * MiB, WS_WB = 60 * MiB;
constexpr size_t WS_ATTN = 27 * MiB;
constexpr size_t WS_XB = 92 * MiB;
constexpr size_t WS_Y = 220 * MiB;
constexpr size_t WS_R1 = 476 * MiB;
constexpr size_t WS_END = 988 * MiB;
constexpr size_t QTR = 128 * MiB;
constexpr int CW_TMO = 0;
constexpr int CW_BAR = 4096;

constexpr int LDS_BYTES_C = 147456;
constexpr int RING_OFF = 0, RING_BYTES = 131072;
constexpr int LDSCTL_OFF = LDS_BYTES_C - 512, MISC_OFF = LDSCTL_OFF + 320;
constexpr int LDS_BYTES = LDS_BYTES_C;
static_assert(MISC_OFF + 128 <= LDS_BYTES, "LDS map");

#define GAS __attribute__((address_space(1)))
#define LAS __attribute__((address_space(3)))
typedef unsigned short bf16;
typedef unsigned v4u __attribute__((ext_vector_type(4)));
typedef unsigned v2u __attribute__((ext_vector_type(2)));
typedef float f32x4 __attribute__((ext_vector_type(4)));
typedef float f32x16 __attribute__((ext_vector_type(16)));
typedef short bf16x8 __attribute__((ext_vector_type(8)));
typedef GAS unsigned gu32;
typedef GAS unsigned long long gu64;
#define RLX_AGENT __ATOMIC_RELAXED, __HIP_MEMORY_SCOPE_AGENT
#define LDS_WAIT() asm volatile("s_waitcnt lgkmcnt(0)" ::: "memory")
#define VM_WAIT() asm volatile("s_waitcnt vmcnt(0)" ::: "memory")
#define WG_BAR() asm volatile("s_waitcnt lgkmcnt(0)\n\ts_barrier" ::: "memory")
typedef float f32x2_t_ __attribute__((ext_vector_type(2))); typedef __bf16 bf16x2_t_ __attribute__((ext_vector_type(2)));
__device__ __forceinline__ unsigned pk2(float lo, float hi) { f32x2_t_ v = {lo, hi}; bf16x2_t_ b = __builtin_convertvector(v, bf16x2_t_); return __builtin_bit_cast(unsigned, b); }
__device__ __forceinline__ unsigned f2bf(float f) { return pk2(f, 0.f) & 0xffffu; }
__device__ __forceinline__ float bflo(unsigned w) { return __builtin_bit_cast(float, w << 16); }
__device__ __forceinline__ float bfhi(unsigned w) { return __builtin_bit_cast(float, w & 0xffff0000u); }
__device__ __forceinline__ float bf2f(bf16 h) { return __builtin_bit_cast(float, (unsigned)h << 16); }
__device__ __forceinline__ float fast_exp(float x) { return __builtin_amdgcn_exp2f(x * 1.4426950408889634f); }
__device__ __forceinline__ float silu_f(float x) { return x * __builtin_amdgcn_rcpf(1.f + __expf(-x)); }

#define XB_TMO      128
#define XB_XCNT(j)  (256  + 64 * (j))
#define XB_XSUB(j)  (1280 + 64 * (j))
#define XB_XGEN(j)  (2304 + 64 * (j))
#define XB_TOP      3328
#define XB_TOPGEN   3392
#define XCD_BAR_WORDS 3456
#define XB_SPIN_CAP (1u << 18)

__device__ __forceinline__ unsigned xb_ld(unsigned* p)              { return __hip_atomic_load(p, __ATOMIC_RELAXED, __HIP_MEMORY_SCOPE_AGENT); }
__device__ __forceinline__ unsigned xb_add(unsigned* p, unsigned v) { return __hip_atomic_fetch_add(p, v, __ATOMIC_RELAXED, __HIP_MEMORY_SCOPE_AGENT); }
__device__ __forceinline__ unsigned xb_xcc_id() { return (unsigned)__builtin_amdgcn_s_getreg((3 << 11) | 20) & 0xFu; }
#define XB_SPIN(cond, bar) do { unsigned _sp = 0; while (cond) { __builtin_amdgcn_s_sleep(1); \
    if ((++_sp & 255u) == 0u) { if (xb_ld(&(bar)[XB_TMO])) break; if (_sp > XB_SPIN_CAP) { atomicAdd(&(bar)[XB_TMO], 1u); break; } } } } while (0)

struct XcdBarrier {
    unsigned* bar; unsigned x;
    volatile LAS unsigned* st;
};
__device__ __forceinline__ XcdBarrier xcd_barrier_post(unsigned* bar, volatile LAS unsigned* st) {
    XcdBarrier b; b.bar = bar; b.x = xb_xcc_id(); b.st = st;
    if (threadIdx.x == 0) (void)xb_add(&bar[XB_XCNT(b.x)], 1u);
    return b;
}
__device__ __forceinline__ void xcd_barrier_complete(unsigned* bar, unsigned x, unsigned& nloc, unsigned& nx) {
    const unsigned G = gridDim.x * gridDim.y * gridDim.z;
    unsigned sum, cnt, mine, sp = 0u;
    for (;;) {
        sum = 0u; cnt = 0u; mine = 0u;
#pragma unroll
        for (unsigned j = 0; j < 16; ++j) { const unsigned c = xb_ld(&bar[XB_XCNT(j)]); sum += c; cnt += (c > 0u) ? 1u : 0u; mine = (j == x) ? c : mine; }
        if (sum == G) break;
        __builtin_amdgcn_s_sleep(1);
        if ((++sp & 255u) == 0u) { if (xb_ld(&bar[XB_TMO])) break; if (sp > XB_SPIN_CAP) { atomicAdd(&bar[XB_TMO], 1u); break; } }
    }
    nloc = mine > 0u ? mine : 1u; nx = cnt > 0u ? cnt : 1u;
}
__device__ __forceinline__ void xcd_barrier(const XcdBarrier& b) {
    asm volatile("s_waitcnt vmcnt(0)" ::: "memory");
    __syncthreads();
    if (threadIdx.x == 0) {
        unsigned* bar = b.bar;
        __builtin_amdgcn_s_waitcnt(0);
        unsigned nloc = b.st[0], nx = b.st[1];
        if (nloc == 0u) { xcd_barrier_complete(bar, b.x, nloc, nx); b.st[0] = nloc; b.st[1] = nx; }
        const unsigned old = xb_add(&bar[XB_XSUB(b.x)], 1u);
        const unsigned gen = old / nloc;
        if (old + 1u == (gen + 1u) * nloc) {
            __builtin_amdgcn_fence(__ATOMIC_RELEASE, "agent");
            asm volatile("s_waitcnt vmcnt(0)" ::: "memory");
            const unsigned og = xb_add(&bar[XB_TOP], 1u);
            const unsigned tg = og / nx;
            if (og + 1u == (tg + 1u) * nx) xb_add(&bar[XB_TOPGEN], 1u);
            else XB_SPIN(xb_ld(&bar[XB_TOPGEN]) == tg, bar);
            __builtin_amdgcn_fence(__ATOMIC_ACQUIRE, "agent");
            xb_add(&bar[XB_XGEN(b.x)], 1u);
            asm volatile("s_waitcnt vmcnt(0)" ::: "memory");
        } else {
            XB_SPIN(xb_ld(&bar[XB_XGEN(b.x)]) == gen, bar);
            __builtin_amdgcn_fence(__ATOMIC_ACQUIRE, "agent");
            asm volatile("s_waitcnt vmcnt(0)" ::: "memory");
        }
    }
    __syncthreads();
}

__device__ __forceinline__ float wave_sum(float v) {
#pragma unroll
    for (int o = 1; o < 64; o <<= 1) v += __shfl_xor(v, o);
    return v;
}
__device__ __forceinline__ float sum16(float v) {
    v += __shfl_xor(v, 1); v += __shfl_xor(v, 2); v += __shfl_xor(v, 4); v += __shfl_xor(v, 8); return v;
}
__device__ __forceinline__ void transpose_item(const float* W, int K, int ldw, int n_begin, int nblk, bf16* WT, int row_off, LAS float* scr, int item, int lane) {
    const int kb = item / nblk, nb = item % nblk, k0 = 64 * kb, n0 = 32 * nb;
    float wv[32];
#pragma unroll
    for (int i = 0; i < 32; ++i) wv[i] = ((const GAS float*)W)[(size_t)(k0 + 2 * i + (lane >> 5)) * ldw + n_begin + n0 + (lane & 31)];
#pragma unroll
    for (int i = 0; i < 32; ++i) scr[(2 * i + (lane >> 5)) * 33 + (lane & 31)] = wv[i];
    LDS_WAIT(); asm volatile("" ::: "memory");
    const int c = lane & 7;
#pragma unroll
    for (int j = 0; j < 4; ++j) { const int n = (lane >> 3) + 8 * j; const LAS float* s = scr + (8 * c) * 33 + n;
        v4u o; o.x = pk2(s[0 * 33], s[1 * 33]); o.y = pk2(s[2 * 33], s[3 * 33]); o.z = pk2(s[4 * 33], s[5 * 33]); o.w = pk2(s[6 * 33], s[7 * 33]);
        *(GAS v4u*)(WT + (size_t)(row_off + n0 + n) * K + k0 + 8 * c) = o; }
    LDS_WAIT(); asm volatile("" ::: "memory");
}
__device__ __forceinline__ void convert_w(LAS unsigned char* lds, int gw, int NGW, int wave, int lane, const float* W, int K, int ldw, int n_begin, int ncols, bf16* WT, int row_off) {
    LAS float* scr = (LAS float*)(lds + RING_OFF + wave * 16384);
    const int nblk = ncols / 32, nitems = (K / 64) * nblk;
    for (int it = gw; it < nitems; it += NGW) transpose_item(W, K, ldw, n_begin, nblk, WT, row_off, scr, it, lane);
}
__device__ __forceinline__ void row_to_bf16(const float* xrow, bf16* orow, int lane) {
    const GAS f32x4* xr = (const GAS f32x4*)xrow + lane; GAS v2u* o8 = (GAS v2u*)orow + lane;
#pragma unroll
    for (int j = 0; j < 8; ++j) { const f32x4 v = xr[64 * j]; v2u w; w.x = pk2(v.x, v.y); w.y = pk2(v.z, v.w); o8[64 * j] = w; }
}
__device__ __forceinline__ void ln_pass_b(const bf16* xb_in, const bf16* hb, const float* g, const float* b, bf16* xb_out, float* outf, float alpha, int gw, int NGW, int lane) {
    const GAS f32x4* gr = (const GAS f32x4*)g + 2 * lane; const GAS f32x4* br = (const GAS f32x4*)b + 2 * lane;
    for (int m = gw; m < MROWS; m += 2 * NGW) {
        const int m1 = (m + NGW < MROWS) ? m + NGW : m;
        const GAS v4u* x0 = (const GAS v4u*)(xb_in + (size_t)m * DMODEL) + lane; const GAS v4u* x1 = (const GAS v4u*)(xb_in + (size_t)m1 * DMODEL) + lane;
        const GAS v4u* h0 = (const GAS v4u*)(hb + (size_t)m * DMODEL) + lane;   const GAS v4u* h1 = (const GAS v4u*)(hb + (size_t)m1 * DMODEL) + lane;
        v4u xa[4], xc[4], ha[4], hc[4];
#pragma unroll
        for (int j = 0; j < 4; ++j) { xa[j] = x0[64 * j]; xc[j] = x1[64 * j]; ha[j] = h0[64 * j]; hc[j] = h1[64 * j]; }
        float y0[32], y1[32]; float s0 = 0.f, s1 = 0.f;
#pragma unroll
        for (int j = 0; j < 4; ++j)
#pragma unroll
            for (int k = 0; k < 4; ++k) { y0[8 * j + 2 * k] = alpha * bflo(xa[j][k]) + bflo(ha[j][k]); y0[8 * j + 2 * k + 1] = alpha * bfhi(xa[j][k]) + bfhi(ha[j][k]);
                                          y1[8 * j + 2 * k] = alpha * bflo(xc[j][k]) + bflo(hc[j][k]); y1[8 * j + 2 * k + 1] = alpha * bfhi(xc[j][k]) + bfhi(hc[j][k]); }
#pragma unroll
        for (int k = 0; k < 32; ++k) { s0 += y0[k]; s1 += y1[k]; }
#pragma unroll
        for (int o = 1; o < 64; o <<= 1) { s0 += __shfl_xor(s0, o); s1 += __shfl_xor(s1, o); }
        const float mean0 = s0 * (1.f / DMODEL), mean1 = s1 * (1.f / DMODEL); float q0 = 0.f, q1 = 0.f;
#pragma unroll
        for (int k = 0; k < 32; ++k) { y0[k] -= mean0; y1[k] -= mean1; q0 += y0[k] * y0[k]; q1 += y1[k] * y1[k]; }
#pragma unroll
        for (int o = 1; o < 64; o <<= 1) { q0 += __shfl_xor(q0, o); q1 += __shfl_xor(q1, o); }
        const float rs0 = 1.f / sqrtf(q0 * (1.f / DMODEL) + LN_EPS), rs1 = 1.f / sqrtf(q1 * (1.f / DMODEL) + LN_EPS);
#pragma unroll
        for (int j = 0; j < 4; ++j) { const f32x4 ga = gr[128 * j], gb = gr[128 * j + 1], ba = br[128 * j], bb = br[128 * j + 1];
            float o0[8], o1[8];
#pragma unroll
            for (int k = 0; k < 8; ++k) { const float gg = k < 4 ? ga[k] : gb[k - 4], bv = k < 4 ? ba[k] : bb[k - 4]; o0[k] = y0[8 * j + k] * rs0 * gg + bv; o1[k] = y1[8 * j + k] * rs1 * gg + bv; }
            if (xb_out) { v4u w0, w1; w0.x = pk2(o0[0], o0[1]); w0.y = pk2(o0[2], o0[3]); w0.z = pk2(o0[4], o0[5]); w0.w = pk2(o0[6], o0[7]); w1.x = pk2(o1[0], o1[1]); w1.y = pk2(o1[2], o1[3]); w1.z = pk2(o1[4], o1[5]); w1.w = pk2(o1[6], o1[7]);
                ((GAS v4u*)(xb_out + (size_t)m * DMODEL) + lane)[64 * j] = w0; ((GAS v4u*)(xb_out + (size_t)m1 * DMODEL) + lane)[64 * j] = w1; }
            if (outf) { GAS f32x4* p0 = (GAS f32x4*)(outf + (size_t)m * DMODEL) + 2 * lane + 128 * j; GAS f32x4* p1 = (GAS f32x4*)(outf + (size_t)m1 * DMODEL) + 2 * lane + 128 * j;
                p0[0] = (f32x4){o0[0], o0[1], o0[2], o0[3]}; p0[1] = (f32x4){o0[4], o0[5], o0[6], o0[7]}; p1[0] = (f32x4){o1[0], o1[1], o1[2], o1[3]}; p1[1] = (f32x4){o1[4], o1[5], o1[6], o1[7]}; } }
    }
}
#define MFMA32(a, b, c) __builtin_amdgcn_mfma_f32_32x32x16_bf16((a), (b), (c), 0, 0, 0)

__device__ __forceinline__ void ba_proj(const bf16* xb, const bf16* wt  , const float* a_log, const float* dt_bias, float* beta, float* g, int gw, int NGW, int lane) {
    const int r32 = lane & 31, hi = lane >> 5;
    for (int wu = gw; wu < MROWS / 32; wu += NGW) {
        const GAS bf16* ap = (const GAS bf16*)xb + (size_t)(wu * 32 + r32) * DMODEL + 8 * hi; const GAS bf16* bp = (const GAS bf16*)wt + (size_t)(GDN_MAIN + r32) * DMODEL + 8 * hi;
        f32x16 acc = {};
#pragma unroll 1
        for (int s0 = 0; s0 < DMODEL / 16; s0 += 8) {
            bf16x8 a[8], b[8];
#pragma unroll
            for (int s = 0; s < 8; ++s) { a[s] = *(const GAS bf16x8*)(ap + (s0 + s) * 16); b[s] = *(const GAS bf16x8*)(bp + (s0 + s) * 16); }
#pragma unroll
            for (int s = 0; s < 8; ++s) acc = MFMA32(a[s], b[s], acc);
        }
        const int j = r32 & 15; const float al = -__expf(((const GAS float*)a_log)[j]), db = ((const GAS float*)dt_bias)[j]; GAS float* betag = (GAS float*)beta; GAS float* gg_ = (GAS float*)g;
#pragma unroll
        for (int r = 0; r < 16; ++r) { const int t = wu * 32 + (r & 3) + 8 * (r >> 2) + 4 * hi; const float v = acc[r];
            if (r32 < 16) betag[(size_t)t * 16 + j] = __builtin_amdgcn_rcpf(1.f + __expf(-v));
            else { const float z = v + db; const float sp = z > 20.f ? z : log1pf(__expf(z)); gg_[(size_t)t * 16 + j] = al * sp; } }
    }
}

#ifndef G2_SKIP
#define G2_SKIP 0
#endif
#ifndef PROBE_G2_NOSCAT
#define PROBE_G2_NOSCAT 0
#endif
typedef short bf16x4 __attribute__((ext_vector_type(4)));
#define MFMA16K16(a, b, c) __builtin_amdgcn_mfma_f32_16x16x16bf16_1k((a), (b), (c), 0, 0, 0)
constexpr int G2_TS = 136;
constexpr int G2_AS = 68, G2_ANS = 72, G2_US = 68;
constexpr int G2_A = 0, G2_GC = G2_A + 64 * G2_AS * 4, G2_BT = G2_GC + 256, G2_AN = G2_BT + 256, G2_TB = G2_AN + 64 * G2_ANS * 2, G2_Q = G2_TB + 2048, G2_K = G2_Q + 64 * G2_TS * 2, G2_V = G2_K + 64 * G2_TS * 2,
              G2_W = G2_V + 64 * G2_TS * 2, G2_END = G2_W + 64 * G2_TS * 2;
static_assert(G2_END <= RING_BYTES, "G2 LDS");
__device__ __forceinline__ bf16x4 pack4(f32x4 v) { v2u w; w.x = pk2(v[0], v[1]); w.y = pk2(v[2], v[3]); return __builtin_bit_cast(bf16x4, w); }
__device__ __forceinline__ void gdn_chunk_phase(LAS unsigned char* lds, bf16* p_, const bf16* halo_, const float* beta_, float* g_, bf16* wbuf_, bf16* attn_, const float* conv_w_, int vcu, int G, bf16* palt_ = nullptr) {
#define G2_ST(off) ((palt ? palt + ((size_t)(off) & 0x7ffffffull) : p + (size_t)(off)))
    int tid_ = threadIdx.x; asm volatile("" : "+v"(tid_));
    const int tid0 = tid_, lane0 = tid0 & 63, wid0 = __builtin_amdgcn_readfirstlane(tid0 >> 6);
    GAS bf16* const p = (GAS bf16*)p_; const GAS bf16* const halo = (const GAS bf16*)halo_; const GAS float* const beta = (const GAS float*)beta_; GAS float* const g = (GAS float*)g_;
    GAS bf16* const wbuf = (GAS bf16*)wbuf_; GAS bf16* const attn = (GAS bf16*)attn_; const GAS float* const conv_w = (const GAS float*)conv_w_; GAS bf16* const palt = (GAS bf16*)palt_;
    LAS bf16* Qs = (LAS bf16*)(lds + G2_Q); LAS bf16* Ks = (LAS bf16*)(lds + G2_K); LAS bf16* Vs = (LAS bf16*)(lds + G2_V); LAS bf16* Ws = (LAS bf16*)(lds + G2_W);
    LAS float* As = (LAS float*)(lds + G2_A); LAS float* gcs = (LAS float*)(lds + G2_GC); LAS float* bts = (LAS float*)(lds + G2_BT);
    LAS bf16* An = (LAS bf16*)(lds + G2_AN); LAS bf16* Tb = (LAS bf16*)(lds + G2_TB); LAS bf16* Us = (LAS bf16*)(lds + G2_A);
    asm volatile("" : "+v"(Qs), "+v"(Ks), "+v"(Vs), "+v"(Ws), "+v"(As), "+v"(gcs), "+v"(bts), "+v"(An), "+v"(Tb), "+v"(Us));
    v4u rawv[3][5]; float gpre = 0.f, bpre = 0.f;
#define G2_LOAD_RAW(uu, LN, WD) do { const int cg_ = (uu) >> 4, h_ = (uu) & 15, n_ = cg_ & 63; const size_t r0_ = (size_t)cg_ * 64; const int cgp_l = (LN) & 15, tA_l = 8 * (WD) + 2 * ((LN) >> 4); \
        _Pragma("unroll") for (int X = 0; X < 3; ++X) { const int col_ = X * 2048 + h_ * HD + 8 * cgp_l; \
            _Pragma("unroll") for (int rr = 0; rr < 5; ++rr) { const int rel = tA_l - 3 + rr; v4u v = {0u, 0u, 0u, 0u}; \
                if (rel >= 0) v = *(const GAS v4u*)(p + (r0_ + rel) * GDN_MAIN + col_); \
                else if (n_ > 0) v = *(const GAS v4u*)(halo + ((size_t)(cg_ - 1) * 3 + (rel + 3)) * CONVC + col_); \
                rawv[X][rr] = v; } } \
        if ((WD) == 0) { gpre = g[(r0_ + (LN)) * 16 + h_]; bpre = beta[(r0_ + (LN)) * 16 + h_]; } } while (0)
    if (vcu < NCG * NHEADS) G2_LOAD_RAW(vcu, lane0, wid0);
    for (int u = vcu; u < NCG * NHEADS; u += G) {
        const int cg = u >> 4, h = u & 15; const size_t row0 = (size_t)cg * 64;
        int tl_ = tid0; asm volatile("" : "+v"(tl_));
        const int tid = tl_, lane = tid & 63, wid = __builtin_amdgcn_readfirstlane(tid >> 6), r32 = lane & 31, hi = lane >> 5;
        {
            const int cgp = lane & 15, sub = lane >> 4, tA = 8 * wid + 2 * sub;
#pragma unroll
            for (int X = 0; X < 3; ++X) {
                const int col = X * 2048 + h * HD + 8 * cgp;
                float raw[5][8];
                asm volatile("" : "+v"(rawv[X][0]), "+v"(rawv[X][1]), "+v"(rawv[X][2]), "+v"(rawv[X][3]), "+v"(rawv[X][4]));
#pragma unroll
                for (int rr = 0; rr < 5; ++rr) { const v4u v = rawv[X][rr];
                    raw[rr][0] = bflo(v.x); raw[rr][1] = bfhi(v.x); raw[rr][2] = bflo(v.y); raw[rr][3] = bfhi(v.y); raw[rr][4] = bflo(v.z); raw[rr][5] = bfhi(v.z); raw[rr][6] = bflo(v.w); raw[rr][7] = bfhi(v.w); }
                float o0[8], o1[8];
#pragma unroll
                for (int c = 0; c < 8; ++c) { o0[c] = 0.f; o1[c] = 0.f; }
#pragma unroll
                for (int j = 0; j < 4; ++j) { const f32x4 wa = *(const GAS f32x4*)(conv_w + (size_t)j * CONVC + col), wb = *(const GAS f32x4*)(conv_w + (size_t)j * CONVC + col + 4);
#pragma unroll
                    for (int c = 0; c < 8; ++c) { const float w = c < 4 ? wa[c] : wb[c - 4]; o0[c] += w * raw[j][c]; o1[c] += w * raw[j + 1][c]; } }
                float s0 = 0.f, s1 = 0.f;
#pragma unroll
                for (int c = 0; c < 8; ++c) { o0[c] = silu_f(o0[c]); o1[c] = silu_f(o1[c]); s0 += o0[c] * o0[c]; s1 += o1[c] * o1[c]; }
                if (X < 2) { s0 = sum16(s0); s1 = sum16(s1); const float sc = X == 0 ? 0.08838834764831845f : 1.f; const float f0 = sc * __builtin_amdgcn_rsqf(s0 + GDN_EPS), f1 = sc * __builtin_amdgcn_rsqf(s1 + GDN_EPS);
#pragma unroll
                    for (int c = 0; c < 8; ++c) { o0[c] *= f0; o1[c] *= f1; } }
                LAS bf16* T = X == 0 ? Qs : (X == 1 ? Ks : Vs);
                v4u w0, w1; w0.x = pk2(o0[0], o0[1]); w0.y = pk2(o0[2], o0[3]); w0.z = pk2(o0[4], o0[5]); w0.w = pk2(o0[6], o0[7]);
                w1.x = pk2(o1[0], o1[1]); w1.y = pk2(o1[2], o1[3]); w1.z = pk2(o1[4], o1[5]); w1.w = pk2(o1[6], o1[7]);
                *(LAS v4u*)(T + tA * G2_TS + 8 * cgp) = w0; *(LAS v4u*)(T + (tA + 1) * G2_TS + 8 * cgp) = w1;
                asm volatile("" ::: "memory");
            }
            if (wid == 0) {
                float gv = gpre;
#pragma unroll
                for (int o = 1; o < 64; o <<= 1) { const float t = __shfl_up(gv, o); if (lane >= o) gv += t; }
                gcs[lane] = gv; bts[lane] = bpre; if (!palt) g[(row0 + lane) * 16 + h] = gv;
            }
        }
        __syncthreads();
        if (u + G < NCG * NHEADS) G2_LOAD_RAW(u + G, lane, wid);
        if (!((G2_SKIP & 4) && palt)) {
            const int rb = (wid >> 1) & 1, cb = wid & 1; const bool isA = wid < 4;
            f32x16 acc = {};
            if (!(rb == 0 && cb == 1)) {
                const LAS bf16* Ar = (isA ? Ks : Qs) + (32 * rb + r32) * G2_TS + 8 * hi; const LAS bf16* Br = Ks + (32 * cb + r32) * G2_TS + 8 * hi;
#pragma unroll
                for (int s = 0; s < 8; ++s) acc = MFMA32(*(const LAS bf16x8*)(Ar + 16 * s), *(const LAS bf16x8*)(Br + 16 * s), acc);
            }
            const int j = 32 * cb + r32; const float gj = gcs[j];
#pragma unroll
            for (int r = 0; r < 16; ++r) { const int i = 32 * rb + (r & 3) + 8 * (r >> 2) + 4 * hi; const float gi = gcs[i];
                if (isA) { const float d = (i > j) ? __expf(gi - gj) : 0.f; const float a = (i > j) ? bts[i] * acc[r] * d : 0.f; As[i * G2_AS + j] = a; An[i * G2_ANS + j] = (bf16)f2bf(-a); }
                else { const float d = (i >= j) ? __expf(gi - gj) : 0.f; Ws[i * G2_TS + j] = (bf16)f2bf((i >= j) ? acc[r] * d : 0.f); } }
        }
        __syncthreads();
        if (wid == 0 && !((G2_SKIP & 2) && palt)) {
            const int b = lane >> 4, c = lane & 15; float t[16];
            const LAS float* Ab = As + (16 * b) * G2_AS + 16 * b;
#pragma unroll
            for (int i = 0; i < 16; ++i) {
                float ti = (i == c) ? 1.f : 0.f;
#pragma unroll
                for (int j4 = 0; j4 < (i + 3) / 4; ++j4) { const f32x4 a = *(const LAS f32x4*)(Ab + i * G2_AS + 4 * j4);
#pragma unroll
                    for (int k = 0; k < 4; ++k) if (4 * j4 + k < i) ti -= a[k] * t[4 * j4 + k]; }
                t[i] = ti;
            }
#pragma unroll
            for (int i = 0; i < 16; ++i) Tb[b * 256 + i * 16 + c] = (bf16)f2bf(t[i]);
        } else if (wid < 5) {
            const int tt = tid - 64, cgp = tt & 15, r0 = tt >> 4;
            { GAS bf16* at = palt ? palt + (((size_t)u * 4096 + 0x4000000ull) & 0x7ffffffull) : attn + (size_t)u * 4096;
#pragma unroll
              for (int k = 0; k < 2; ++k) { const int pc = tt + 256 * k, i = pc >> 3, c8 = pc & 7; *(GAS v4u*)(at + i * 64 + 8 * c8) = *(const LAS v4u*)(Ws + i * G2_TS + 8 * c8); } }
#pragma unroll
            for (int r = 0; r < 4; ++r) { const int i = r0 + 16 * r; const float e = __expf(gcs[i]); const v4u v = *(const LAS v4u*)(Qs + i * G2_TS + 8 * cgp); v4u w;
                w.x = pk2(bflo(v.x) * e, bfhi(v.x) * e); w.y = pk2(bflo(v.y) * e, bfhi(v.y) * e); w.z = pk2(bflo(v.z) * e, bfhi(v.z) * e); w.w = pk2(bflo(v.w) * e, bfhi(v.w) * e);
                *(GAS v4u*)G2_ST((row0 + i) * GDN_MAIN + h * HD + 8 * cgp) = w; }
        } else {
            const float gl = gcs[63];
            for (int task = tid - 320; task < 256; task += 192) { const int dk = task & 127, th = task >> 7;
                GAS bf16* dst = G2_ST((row0 + (dk >> 1)) * GDN_MAIN + 2048 + h * HD + (dk & 1) * 64 + 32 * th);
#pragma unroll
                for (int q = 0; q < 4; ++q) { float v[8];
#pragma unroll
                    for (int k = 0; k < 8; ++k) { const int tk = 32 * th + 8 * q + k; v[k] = bf2f(Ks[tk * G2_TS + dk]) * __expf(gl - gcs[tk]); }
                    v4u w; w.x = pk2(v[0], v[1]); w.y = pk2(v[2], v[3]); w.z = pk2(v[4], v[5]); w.w = pk2(v[6], v[7]); if (!(PROBE_G2_NOSCAT && palt)) *(GAS v4u*)(dst + 8 * q) = w; else asm volatile("" :: "v"(w)); } }
        }
        __syncthreads();
        if (!((G2_SKIP & 1) && palt)) {
            const int nl = lane & 15, q = lane >> 4; const bool isK = wid >= 4;
            float rsc[16];
#pragma unroll
            for (int b = 0; b < 4; ++b)
#pragma unroll
                for (int r = 0; r < 4; ++r) { const int row = 16 * b + 4 * q + r; rsc[4 * b + r] = isK ? bts[row] * __expf(gcs[row]) : bts[row]; }
            bf16x4 Tq[4], Aq[6];
#pragma unroll
            for (int b = 0; b < 4; ++b) Tq[b] = *(const LAS bf16x4*)(Tb + b * 256 + nl * 16 + 4 * q);
            Aq[0] = *(const LAS bf16x4*)(An + (16 + nl) * G2_ANS + 4 * q);
            Aq[1] = *(const LAS bf16x4*)(An + (32 + nl) * G2_ANS + 4 * q);      Aq[2] = *(const LAS bf16x4*)(An + (32 + nl) * G2_ANS + 16 + 4 * q);
            Aq[3] = *(const LAS bf16x4*)(An + (48 + nl) * G2_ANS + 4 * q);      Aq[4] = *(const LAS bf16x4*)(An + (48 + nl) * G2_ANS + 16 + 4 * q);   Aq[5] = *(const LAS bf16x4*)(An + (48 + nl) * G2_ANS + 32 + 4 * q);
#pragma unroll
            for (int t = 0; t < 2; ++t) {
                const int cc = 32 * (wid & 3) + 16 * t + nl;
                const LAS bf16* src = (isK ? Ks : Vs) + cc;
                f32x4 R[4];
#pragma unroll
                for (int b = 0; b < 4; ++b)
#pragma unroll
                    for (int r = 0; r < 4; ++r) R[b][r] = rsc[4 * b + r] * bf2f(src[(16 * b + 4 * q + r) * G2_TS]);
                const f32x4 z4 = {0.f, 0.f, 0.f, 0.f};
                const f32x4 y0 = MFMA16K16(Tq[0], pack4(R[0]), z4); const bf16x4 y0b = pack4(y0);
                f32x4 c1 = MFMA16K16(Aq[0], y0b, R[1]);
                const f32x4 y1 = MFMA16K16(Tq[1], pack4(c1), z4); const bf16x4 y1b = pack4(y1);
                f32x4 c2 = MFMA16K16(Aq[1], y0b, R[2]); c2 = MFMA16K16(Aq[2], y1b, c2);
                const f32x4 y2 = MFMA16K16(Tq[2], pack4(c2), z4); const bf16x4 y2b = pack4(y2);
                f32x4 c3 = MFMA16K16(Aq[3], y0b, R[3]); c3 = MFMA16K16(Aq[4], y1b, c3); c3 = MFMA16K16(Aq[5], y2b, c3);
                const f32x4 y3 = MFMA16K16(Tq[3], pack4(c3), z4); const bf16x4 y3b = pack4(y3);
                if (!isK) {
                    LAS bf16* dst = Us + cc * G2_US + 4 * q;
                    *(LAS bf16x4*)(dst) = y0b; *(LAS bf16x4*)(dst + 16) = y1b; *(LAS bf16x4*)(dst + 32) = y2b; *(LAS bf16x4*)(dst + 48) = y3b;
                } else {
#pragma unroll
                    for (int r = 0; r < 4; ++r) { Ws[(4 * q + r) * G2_TS + cc] = (bf16)y0b[r]; Ws[(16 + 4 * q + r) * G2_TS + cc] = (bf16)y1b[r]; Ws[(32 + 4 * q + r) * G2_TS + cc] = (bf16)y2b[r]; Ws[(48 + 4 * q + r) * G2_TS + cc] = (bf16)y3b[r]; }
                }
            }
        }
        __syncthreads();
#pragma unroll
        for (int k = 0; k < 2; ++k) { const int pc = tid + 512 * k, dv = pc >> 3, c8 = pc & 7;
            const v2u lo = *(const LAS v2u*)(Us + dv * G2_US + 8 * c8), hi2 = *(const LAS v2u*)(Us + dv * G2_US + 8 * c8 + 4);
            *(GAS v4u*)G2_ST((row0 + (dv & 63)) * GDN_MAIN + 4096 + h * HD + (dv >> 6) * 64 + 8 * c8) = (v4u){lo.x, lo.y, hi2.x, hi2.y}; }
#pragma unroll
        for (int k = 0; k < 2; ++k) { const int ch = tid + 512 * k, i = ch >> 4, c8 = ch & 15; *(GAS v4u*)((palt ? palt + (((row0 + i) * DMODEL + h * HD + 8 * c8) & 0x7ffffffull) : wbuf + (row0 + i) * DMODEL + h * HD + 8 * c8)) = *(const LAS v4u*)(Ws + i * G2_TS + 8 * c8); }
    }
#undef G2_ST
#undef G2_LOAD_RAW
}

constexpr int H2_AD = 0, H2_GC = 4096, H2_BT = 4352, H2_AN = 4608, H2_TB = H2_AN + 64 * G2_ANS * 2, H2_Q = H2_TB + 2048, H2_K = H2_Q + 64 * G2_TS * 2, H2_V = H2_K + 64 * G2_TS * 2, H2_GSZ = H2_V + 64 * G2_TS * 2;
static_assert(2 * H2_GSZ <= LDSCTL_OFF && H2_GSZ % 16 == 0, "G2 (two groups) LDS");
__device__ __forceinline__ void grp_bar(LAS unsigned* cnt, unsigned& tgt, int lane) {
    asm volatile("s_waitcnt lgkmcnt(0)" ::: "memory");
    if (lane == 0) __hip_atomic_fetch_add(cnt, 1u, __ATOMIC_RELAXED, __HIP_MEMORY_SCOPE_WORKGROUP);
    tgt += 4u;
    while (*(volatile LAS unsigned*)cnt < tgt) __builtin_amdgcn_s_sleep(1);
    asm volatile("" ::: "memory");
}
__device__ __forceinline__ void gdn_chunk_phase2(LAS unsigned char* lds, bf16* p_, const bf16* halo_, const float* beta_, float* g_, bf16* wbuf_, bf16* attn_, const float* conv_w_, int vcu, int G, bf16* palt_ = nullptr) {
#define G2_ST(off) ((palt ? palt + ((size_t)(off) & 0x7ffffffull) : p + (size_t)(off)))
    int tid_ = threadIdx.x; asm volatile("" : "+v"(tid_));
    const int tid0 = tid_;
    GAS bf16* const p = (GAS bf16*)p_; const GAS bf16* const halo = (const GAS bf16*)halo_; const GAS float* const beta = (const GAS float*)beta_; GAS float* const g = (GAS float*)g_;
    GAS bf16* const wbuf = (GAS bf16*)wbuf_; GAS bf16* const attn = (GAS bf16*)attn_; const GAS float* const conv_w = (const GAS float*)conv_w_; GAS bf16* const palt = (GAS bf16*)palt_;
    const int grp = __builtin_amdgcn_readfirstlane(tid0 >> 8);
    LAS unsigned* cnt = (LAS unsigned*)(lds + LDSCTL_OFF + 128 + 64 * grp);
    __syncthreads(); if (tid0 == 0) { *(LAS unsigned*)(lds + LDSCTL_OFF + 128) = 0u; *(LAS unsigned*)(lds + LDSCTL_OFF + 192) = 0u; } __syncthreads();
    unsigned tgt = 0u;
    LAS unsigned char* gb = lds + grp * H2_GSZ;
    LAS bf16* Qs = (LAS bf16*)(gb + H2_Q); LAS bf16* Ks = (LAS bf16*)(gb + H2_K); LAS bf16* Vs = (LAS bf16*)(gb + H2_V);
    LAS float* Ad = (LAS float*)(gb + H2_AD); LAS float* gcs = (LAS float*)(gb + H2_GC); LAS float* bts = (LAS float*)(gb + H2_BT);
    LAS bf16* An = (LAS bf16*)(gb + H2_AN); LAS bf16* Tb = (LAS bf16*)(gb + H2_TB);
    asm volatile("" : "+v"(Qs), "+v"(Ks), "+v"(Vs), "+v"(Ad), "+v"(gcs), "+v"(bts), "+v"(An), "+v"(Tb));
    v4u rawv[3][7]; float gpre = 0.f, bpre = 0.f;
#define H2_LOAD_RAW(uu, LN, W4) do { const int cg_ = (uu) >> 4, h_ = (uu) & 15, n_ = cg_ & 63; const size_t r0_ = (size_t)cg_ * 64; const int cgp_l = (LN) & 15, tA_l = 16 * (W4) + 4 * ((LN) >> 4); \
        _Pragma("unroll") for (int X = 0; X < 3; ++X) { const int col_ = X * 2048 + h_ * HD + 8 * cgp_l; \
            _Pragma("unroll") for (int rr = 0; rr < 7; ++rr) { const int rel = tA_l - 3 + rr; v4u v = {0u, 0u, 0u, 0u}; \
                if (rel >= 0) v = *(const GAS v4u*)(p + (r0_ + rel) * GDN_MAIN + col_); \
                else if (n_ > 0) v = *(const GAS v4u*)(halo + ((size_t)(cg_ - 1) * 3 + (rel + 3)) * CONVC + col_); \
                rawv[X][rr] = v; } } \
        if ((W4) == 0) { gpre = g[(r0_ + (LN)) * 16 + h_]; bpre = beta[(r0_ + (LN)) * 16 + h_]; } } while (0)
    const int u0 = 2 * vcu + grp, ustep = 2 * G;
    if (u0 < NCG * NHEADS) H2_LOAD_RAW(u0, (tid0 & 63), __builtin_amdgcn_readfirstlane((tid0 >> 6) & 3));
    for (int u = u0; u < NCG * NHEADS; u += ustep) {
        const int cg = u >> 4, h = u & 15; const size_t row0 = (size_t)cg * 64;
        int tl_ = tid0; asm volatile("" : "+v"(tl_));
        const int tid = tl_, lane = tid & 63, w4 = __builtin_amdgcn_readfirstlane((tid >> 6) & 3), gt = tid & 255, r32 = lane & 31, hi = lane >> 5;
        {
            const int cgp = lane & 15, sub = lane >> 4, tA = 16 * w4 + 4 * sub;
#pragma unroll
            for (int X = 0; X < 3; ++X) {
                const int col = X * 2048 + h * HD + 8 * cgp;
                asm volatile("" : "+v"(rawv[X][0]), "+v"(rawv[X][1]), "+v"(rawv[X][2]), "+v"(rawv[X][3]), "+v"(rawv[X][4]), "+v"(rawv[X][5]), "+v"(rawv[X][6]));
                float wj[4][8];
#pragma unroll
                for (int j = 0; j < 4; ++j) { const f32x4 wa = *(const GAS f32x4*)(conv_w + (size_t)j * CONVC + col), wb = *(const GAS f32x4*)(conv_w + (size_t)j * CONVC + col + 4);
#pragma unroll
                    for (int c = 0; c < 4; ++c) { wj[j][c] = wa[c]; wj[j][4 + c] = wb[c]; } }
                float o[4][8];
#pragma unroll
                for (int t = 0; t < 4; ++t)
#pragma unroll
                    for (int c = 0; c < 8; ++c) o[t][c] = 0.f;
#pragma unroll
                for (int rr = 0; rr < 7; ++rr) { const v4u v = rawv[X][rr]; const float rw[8] = {bflo(v.x), bfhi(v.x), bflo(v.y), bfhi(v.y), bflo(v.z), bfhi(v.z), bflo(v.w), bfhi(v.w)};
#pragma unroll
                    for (int t = 0; t < 4; ++t) { const int j = rr - t; if (j >= 0 && j < 4) {
#pragma unroll
                            for (int c = 0; c < 8; ++c) o[t][c] += wj[j][c] * rw[c]; } } }
                LAS bf16* T = X == 0 ? Qs : (X == 1 ? Ks : Vs);
#pragma unroll
                for (int t = 0; t < 4; ++t) { float s = 0.f;
#pragma unroll
                    for (int c = 0; c < 8; ++c) { o[t][c] = silu_f(o[t][c]); s += o[t][c] * o[t][c]; }
                    if (X < 2) { s = sum16(s); const float f = (X == 0 ? 0.08838834764831845f : 1.f) * __builtin_amdgcn_rsqf(s + GDN_EPS);
#pragma unroll
                        for (int c = 0; c < 8; ++c) o[t][c] *= f; }
                    v4u w0; w0.x = pk2(o[t][0], o[t][1]); w0.y = pk2(o[t][2], o[t][3]); w0.z = pk2(o[t][4], o[t][5]); w0.w = pk2(o[t][6], o[t][7]);
                    *(LAS v4u*)(T + (tA + t) * G2_TS + 8 * cgp) = w0; }
                asm volatile("" ::: "memory");
            }
            if (w4 == 0) {
                float gv = gpre;
#pragma unroll
                for (int o_ = 1; o_ < 64; o_ <<= 1) { const float t = __shfl_up(gv, o_); if (lane >= o_) gv += t; }
                gcs[lane] = gv; bts[lane] = bpre; if (!palt) g[(row0 + lane) * 16 + h] = gv;
            }
        }
        grp_bar(cnt, tgt, lane);
        if (u + ustep < NCG * NHEADS) H2_LOAD_RAW(u + ustep, lane, w4);
        {
            const int rb = w4 >> 1, cb = w4 & 1; const int j = 32 * cb + r32; const float gj = gcs[j];
            GAS bf16* at = palt ? palt + (((size_t)u * 4096 + 0x4000000ull) & 0x7ffffffull) : attn + (size_t)u * 4096;
#pragma unroll
            for (int pass = 0; pass < 2; ++pass) {
                f32x16 acc = {};
                if (!(rb == 0 && cb == 1)) {
                    const LAS bf16* Ar = (pass == 0 ? Ks : Qs) + (32 * rb + r32) * G2_TS + 8 * hi; const LAS bf16* Br = Ks + (32 * cb + r32) * G2_TS + 8 * hi;
#pragma unroll
                    for (int s = 0; s < 8; ++s) acc = MFMA32(*(const LAS bf16x8*)(Ar + 16 * s), *(const LAS bf16x8*)(Br + 16 * s), acc);
                }
#pragma unroll
                for (int r = 0; r < 16; ++r) { const int i = 32 * rb + (r & 3) + 8 * (r >> 2) + 4 * hi; const float gi = gcs[i];
                    if (pass == 0) { const float d = (i > j) ? __expf(gi - gj) : 0.f; const float a = (i > j) ? bts[i] * acc[r] * d : 0.f; An[i * G2_ANS + j] = (bf16)f2bf(-a);
                        if ((i >> 4) == (j >> 4)) Ad[(i >> 4) * 256 + (i & 15) * 16 + (j & 15)] = a; }
                    else { const float d = (i >= j) ? __expf(gi - gj) : 0.f; at[i * 64 + j] = (bf16)f2bf((i >= j) ? acc[r] * d : 0.f); } }
            }
        }
        grp_bar(cnt, tgt, lane);
        if (w4 == 0) {
            const int b = lane >> 4, c = lane & 15; float t[16];
            const LAS float* Ab = Ad + b * 256;
#pragma unroll
            for (int i = 0; i < 16; ++i) {
                float ti = (i == c) ? 1.f : 0.f;
#pragma unroll
                for (int j4 = 0; j4 < (i + 3) / 4; ++j4) { const f32x4 a = *(const LAS f32x4*)(Ab + i * 16 + 4 * j4);
#pragma unroll
                    for (int k = 0; k < 4; ++k) if (4 * j4 + k < i) ti -= a[k] * t[4 * j4 + k]; }
                t[i] = ti;
            }
#pragma unroll
            for (int i = 0; i < 16; ++i) Tb[b * 256 + i * 16 + c] = (bf16)f2bf(t[i]);
        } else {
            const int tt = gt - 64;
            for (int pc = tt; pc < 1024; pc += 192) { const int i = pc >> 4, cgp = pc & 15; const float e = __expf(gcs[i]); const v4u v = *(const LAS v4u*)(Qs + i * G2_TS + 8 * cgp); v4u w;
                w.x = pk2(bflo(v.x) * e, bfhi(v.x) * e); w.y = pk2(bflo(v.y) * e, bfhi(v.y) * e); w.z = pk2(bflo(v.z) * e, bfhi(v.z) * e); w.w = pk2(bflo(v.w) * e, bfhi(v.w) * e);
                *(GAS v4u*)G2_ST((row0 + i) * GDN_MAIN + h * HD + 8 * cgp) = w; }
            const float gl = gcs[63];
            for (int task = tt; task < 256; task += 192) { const int dk = task & 127, th = task >> 7;
                GAS bf16* dst = G2_ST((row0 + (dk >> 1)) * GDN_MAIN + 2048 + h * HD + (dk & 1) * 64 + 32 * th);
#pragma unroll
                for (int q = 0; q < 4; ++q) { float v[8];
#pragma unroll
                    for (int k = 0; k < 8; ++k) { const int tk = 32 * th + 8 * q + k; v[k] = bf2f(Ks[tk * G2_TS + dk]) * __expf(gl - gcs[tk]); }
                    v4u w; w.x = pk2(v[0], v[1]); w.y = pk2(v[2], v[3]); w.z = pk2(v[4], v[5]); w.w = pk2(v[6], v[7]); *(GAS v4u*)(dst + 8 * q) = w; } }
        }
        grp_bar(cnt, tgt, lane);
        {
            const int nl = lane & 15, q = lane >> 4; const bool isK = w4 >= 2;
            float rsc[16];
#pragma unroll
            for (int b = 0; b < 4; ++b)
#pragma unroll
                for (int r = 0; r < 4; ++r) { const int row = 16 * b + 4 * q + r; rsc[4 * b + r] = isK ? bts[row] * __expf(gcs[row]) : bts[row]; }
            bf16x4 Tq[4], Aq[6];
#pragma unroll
            for (int b = 0; b < 4; ++b) Tq[b] = *(const LAS bf16x4*)(Tb + b * 256 + nl * 16 + 4 * q);
            Aq[0] = *(const LAS bf16x4*)(An + (16 + nl) * G2_ANS + 4 * q);
            Aq[1] = *(const LAS bf16x4*)(An + (32 + nl) * G2_ANS + 4 * q);      Aq[2] = *(const LAS bf16x4*)(An + (32 + nl) * G2_ANS + 16 + 4 * q);
            Aq[3] = *(const LAS bf16x4*)(An + (48 + nl) * G2_ANS + 4 * q);      Aq[4] = *(const LAS bf16x4*)(An + (48 + nl) * G2_ANS + 16 + 4 * q);   Aq[5] = *(const LAS bf16x4*)(An + (48 + nl) * G2_ANS + 32 + 4 * q);
#pragma unroll
            for (int t = 0; t < 4; ++t) {
                const int cc = 64 * (w4 & 1) + 16 * t + nl;
                const LAS bf16* src = (isK ? Ks : Vs) + cc;
                f32x4 R[4];
#pragma unroll
                for (int b = 0; b < 4; ++b)
#pragma unroll
                    for (int r = 0; r < 4; ++r) R[b][r] = rsc[4 * b + r] * bf2f(src[(16 * b + 4 * q + r) * G2_TS]);
                const f32x4 z4 = {0.f, 0.f, 0.f, 0.f};
                const f32x4 y0 = MFMA16K16(Tq[0], pack4(R[0]), z4); const bf16x4 y0b = pack4(y0);
                f32x4 c1 = MFMA16K16(Aq[0], y0b, R[1]);
                const f32x4 y1 = MFMA16K16(Tq[1], pack4(c1), z4); const bf16x4 y1b = pack4(y1);
                f32x4 c2 = MFMA16K16(Aq[1], y0b, R[2]); c2 = MFMA16K16(Aq[2], y1b, c2);
                const f32x4 y2 = MFMA16K16(Tq[2], pack4(c2), z4); const bf16x4 y2b = pack4(y2);
                f32x4 c3 = MFMA16K16(Aq[3], y0b, R[3]); c3 = MFMA16K16(Aq[4], y1b, c3); c3 = MFMA16K16(Aq[5], y2b, c3);
                const f32x4 y3 = MFMA16K16(Tq[3], pack4(c3), z4); const bf16x4 y3b = pack4(y3);
                if (!isK) {
                    GAS bf16* dst = G2_ST((row0 + (cc & 63)) * GDN_MAIN + 4096 + h * HD + (cc >> 6) * 64 + 4 * q);
                    *(GAS bf16x4*)(dst) = y0b; *(GAS bf16x4*)(dst + 16) = y1b; *(GAS bf16x4*)(dst + 32) = y2b; *(GAS bf16x4*)(dst + 48) = y3b;
                } else {
                    GAS bf16* dst = palt ? palt + (((row0 + 4 * q) * DMODEL + h * HD + cc) & 0x7ffffffull) : wbuf + (row0 + 4 * q) * DMODEL + h * HD + cc;
#pragma unroll
                    for (int r = 0; r < 4; ++r) { dst[(size_t)r * DMODEL] = (bf16)y0b[r]; dst[(size_t)(16 + r) * DMODEL] = (bf16)y1b[r]; dst[(size_t)(32 + r) * DMODEL] = (bf16)y2b[r]; dst[(size_t)(48 + r) * DMODEL] = (bf16)y3b[r]; }
                }
            }
        }
        grp_bar(cnt, tgt, lane);
    }
#undef H2_LOAD_RAW
#undef G2_ST
    __syncthreads();
}

constexpr int G3_STS = 136, G3_VTS = 72;
constexpr int G3_ST = 0, G3_VT = G3_ST + 64 * G3_STS * 2, G3_OT = G3_VT + 64 * G3_VTS * 2, G3_WT = G3_OT + 64 * G3_VTS * 2, G3_QT = G3_WT + 64 * G3_STS * 2, G3_KT = G3_QT + 64 * G3_STS * 2,
              G3_PT = G3_KT + 128 * G3_VTS * 2, G3_UT = G3_PT + 64 * G3_VTS * 2, G3_END = G3_UT + 64 * G3_VTS * 2;
static_assert(G3_END <= RING_BYTES, "G3 LDS");
__device__ __forceinline__ void gdn_scan_phase(LAS unsigned char* lds, bf16* p_, const bf16* wbuf_, const bf16* attn_, const float* g_, int vcu, int G, bf16* oalt_ = nullptr) {
    GAS bf16* const p = (GAS bf16*)p_; const GAS bf16* const wbuf = (const GAS bf16*)wbuf_; const GAS bf16* const attn = (const GAS bf16*)attn_; const GAS float* const g = (const GAS float*)g_; GAS bf16* const oalt = (GAS bf16*)oalt_;
    int tid_ = threadIdx.x; asm volatile("" : "+v"(tid_));
    const int tid = tid_, lane = tid & 63, wid = __builtin_amdgcn_readfirstlane(tid >> 6), r32 = lane & 31, hi = lane >> 5;
    const int role = wid >> 2, a = (wid >> 1) & 1, bb = wid & 1, r = wid >> 1;
    LAS bf16* ST = (LAS bf16*)(lds + G3_ST); LAS bf16* VT = (LAS bf16*)(lds + G3_VT); LAS bf16* OT = (LAS bf16*)(lds + G3_OT);
    LAS bf16* WT = (LAS bf16*)(lds + G3_WT); LAS bf16* QT = (LAS bf16*)(lds + G3_QT); LAS bf16* KT = (LAS bf16*)(lds + G3_KT); LAS bf16* PT = (LAS bf16*)(lds + G3_PT); LAS bf16* UT = (LAS bf16*)(lds + G3_UT);
    for (int unit = vcu; unit < BATCH * NHEADS * 2; unit += G) {
        const int bh = unit >> 1, e = unit & 1, b = bh >> 4, h = bh & 15;
        for (int i = tid; i < G3_VT / 4; i += NWAVES * 64) ((LAS unsigned*)lds)[i] = 0u;
        f32x16 Sacc = {};
        const int r16a = tid >> 4, c16 = tid & 15, r8 = tid >> 3, c8 = tid & 7;
        const GAS bf16* gW = wbuf + (size_t)r16a * DMODEL + h * HD + 8 * c16;
        const GAS bf16* gQ = p + (size_t)r16a * GDN_MAIN + h * HD + 8 * c16;
        const GAS bf16* gK = p + (size_t)r16a * GDN_MAIN + 2048 + h * HD + 8 * c16;
        const GAS bf16* gP = attn + (size_t)r8 * 64 + 8 * c8;
        const GAS bf16* gU = p + (size_t)r8 * GDN_MAIN + 4096 + h * HD + e * 64 + 8 * c8;
        LAS bf16* sW = WT + r16a * G3_STS + 8 * c16; LAS bf16* sQ = QT + r16a * G3_STS + 8 * c16;
        LAS bf16* sK = KT + (2 * r16a + (c16 >> 3)) * G3_VTS + 8 * (c16 & 7);
        LAS bf16* sP = PT + r8 * G3_VTS + 8 * c8; LAS bf16* sU = UT + r8 * G3_VTS + 8 * c8;
        GAS bf16* oRow = (oalt ? oalt : p + 4096) + h * HD + e * 64; const size_t oPitch = oalt ? DMODEL : GDN_MAIN;
        const LAS bf16* aRd = (role == 0 ? WT : QT) + (32 * a + r32) * G3_STS + 8 * hi;
        const LAS bf16* sRd = ST + (32 * bb + r32) * G3_STS + 8 * hi; const LAS bf16* vRd = VT + (32 * bb + r32) * G3_VTS + 8 * hi;
        const LAS bf16* uRd = UT + (32 * bb + r32) * G3_VTS + 32 * a + 4 * hi; const LAS bf16* pRd = PT + (32 * a + r32) * G3_VTS + 8 * hi; const LAS bf16* kRd = KT + (32 * r + r32) * G3_VTS + 8 * hi;
        LAS bf16* vWr = VT + (32 * bb + r32) * G3_VTS + 32 * a + 4 * hi; LAS bf16* sWr = ST + (32 * bb + r32) * G3_STS + 32 * r + 4 * hi;
        v4u gw0, gw1, gq0, gq1, gk0, gk1, gp0, gu0; float dd;
#define G3_LOAD(nn) do { const size_t row0_ = (size_t)b * SEQ + (size_t)(nn) * 64; \
            gw0 = *(const GAS v4u*)(gW + row0_ * DMODEL); gw1 = *(const GAS v4u*)(gW + (row0_ + 32) * DMODEL); \
            gq0 = *(const GAS v4u*)(gQ + row0_ * GDN_MAIN); gq1 = *(const GAS v4u*)(gQ + (row0_ + 32) * GDN_MAIN); \
            gk0 = *(const GAS v4u*)(gK + row0_ * GDN_MAIN); gk1 = *(const GAS v4u*)(gK + (row0_ + 32) * GDN_MAIN); \
            gp0 = *(const GAS v4u*)(gP + ((size_t)(b * 64 + (nn)) * 16 + h) * 4096); gu0 = *(const GAS v4u*)(gU + row0_ * GDN_MAIN); \
            dd = __expf(g[(row0_ + 63) * 16 + h]); } while (0)
        G3_LOAD(0);
        __syncthreads();
#pragma unroll 1
        for (int n = 0; n < 64; ++n) {
            const size_t row0_ = (size_t)b * SEQ + (size_t)n * 64; const int nn = (n + 1 < 64) ? n + 1 : n;
            *(LAS v4u*)(sW) = gw0; *(LAS v4u*)(sW + 32 * G3_STS) = gw1; *(LAS v4u*)(sQ) = gq0; *(LAS v4u*)(sQ + 32 * G3_STS) = gq1;
            *(LAS v4u*)(sK) = gk0; *(LAS v4u*)(sK + 64 * G3_VTS) = gk1; *(LAS v4u*)(sP) = gp0; *(LAS v4u*)(sU) = gu0;
            const float dcur = dd;
            WG_BAR();
            G3_LOAD(nn);
            f32x16 acc_ = {};
#pragma unroll
            for (int s = 0; s < 8; ++s) acc_ = MFMA32(*(const LAS bf16x8*)(aRd + 16 * s), *(const LAS bf16x8*)(sRd + 16 * s), acc_);
            if (role == 0) {
#pragma unroll
                for (int q = 0; q < 4; ++q) { const v2u uu = *(const LAS v2u*)(uRd + 8 * q); v2u w_;
                    w_.x = pk2(bflo(uu.x) - acc_[4 * q], bfhi(uu.x) - acc_[4 * q + 1]); w_.y = pk2(bflo(uu.y) - acc_[4 * q + 2], bfhi(uu.y) - acc_[4 * q + 3]);
                    *(LAS v2u*)(vWr + 8 * q) = w_; }
            }
            WG_BAR();
            bf16x8 Vf_[4];
#pragma unroll
            for (int s = 0; s < 4; ++s) Vf_[s] = *(const LAS bf16x8*)(vRd + 16 * s);
            if (role == 1) {
#pragma unroll
                for (int s = 0; s < 4; ++s) acc_ = MFMA32(*(const LAS bf16x8*)(pRd + 16 * s), Vf_[s], acc_);
#pragma unroll
                for (int rr = 0; rr < 16; ++rr) OT[(32 * a + (rr & 3) + 8 * (rr >> 2) + 4 * hi) * G3_VTS + 32 * bb + r32] = (bf16)f2bf(acc_[rr]);
            }
            Sacc = Sacc * dcur;
#pragma unroll
            for (int s = 0; s < 4; ++s) Sacc = MFMA32(*(const LAS bf16x8*)(kRd + 16 * s), Vf_[s], Sacc);
#pragma unroll
            for (int q = 0; q < 4; ++q) { v2u w_; w_.x = pk2(Sacc[4 * q], Sacc[4 * q + 1]); w_.y = pk2(Sacc[4 * q + 2], Sacc[4 * q + 3]); *(LAS v2u*)(sWr + 8 * q) = w_; }
            WG_BAR();
            *(GAS v4u*)(oRow + (row0_ + r8) * oPitch + 8 * c8) = *(const LAS v4u*)(OT + r8 * G3_VTS + 8 * c8);
        }
#undef G3_LOAD
        VM_WAIT(); __syncthreads();
    }
}

__device__ __forceinline__ void gdn_gate_phase(bf16* p, const float* norm_w, int gw, int NGW, int lane, bf16* oalt = nullptr) {
    for (int m = gw; m < MROWS; m += NGW) {
        GAS bf16* orow = (GAS bf16*)p + (size_t)m * GDN_MAIN + 4096; const GAS bf16* zrow = (const GAS bf16*)p + (size_t)m * GDN_MAIN + 6144;
#pragma unroll
        for (int it = 0; it < 4; ++it) { const int col = it * 512 + lane * 8;
            const v4u ov = *(const GAS v4u*)(orow + col), zv = *(const GAS v4u*)(zrow + col);
            float o[8] = {bflo(ov.x), bfhi(ov.x), bflo(ov.y), bfhi(ov.y), bflo(ov.z), bfhi(ov.z), bflo(ov.w), bfhi(ov.w)};
            float z[8] = {bflo(zv.x), bfhi(zv.x), bflo(zv.y), bfhi(zv.y), bflo(zv.z), bfhi(zv.z), bflo(zv.w), bfhi(zv.w)};
            float s = 0.f;
#pragma unroll
            for (int c = 0; c < 8; ++c) s += o[c] * o[c];
            s = sum16(s); const float rs = __builtin_amdgcn_rsqf(s * (1.f / HD) + GDN_EPS);
            const f32x4 wa = *(const GAS f32x4*)((const GAS float*)norm_w + (col & 127)), wb = *(const GAS f32x4*)((const GAS float*)norm_w + (col & 127) + 4);
#pragma unroll
            for (int c = 0; c < 8; ++c) o[c] = o[c] * rs * (c < 4 ? wa[c] : wb[c - 4]) * silu_f(z[c]);
            v4u w; w.x = pk2(o[0], o[1]); w.y = pk2(o[2], o[3]); w.z = pk2(o[4], o[5]); w.w = pk2(o[6], o[7]); *(GAS v4u*)((oalt ? (GAS bf16*)oalt + (size_t)m * DMODEL : orow) + col) = w; }
    }
}

#ifndef PG8_SP2
#define PG8_SP2 true
#endif
#ifndef PG8_ALIGN
#define PG8_ALIGN true
#endif
#ifndef EN_P0
#define EN_P0 1
#endif
#ifndef EN_G1
#define EN_G1 1
#endif
#ifndef EN_G2
#define EN_G2 1
#endif
#ifndef EN_G3
#define EN_G3 1
#endif
#ifndef EN_G4
#define EN_G4 1
#endif
#ifndef EN_G5
#define EN_G5 1
#endif
#ifndef EN_G6
#define EN_G6 1
#endif
#ifndef EN_G7
#define EN_G7 1
#endif
#ifndef EN_G8
#define EN_G8 1
#endif
#ifndef EN_G9
#define EN_G9 1
#endif
#ifndef EN_D1
#define EN_D1 1
#endif
#ifndef EN_D2
#define EN_D2 1
#endif
#ifndef EN_D3
#define EN_D3 1
#endif
#ifndef EN_D4
#define EN_D4 1
#endif
#ifndef EN_D5
#define EN_D5 1
#endif
#ifndef EN_D6U
#define EN_D6U 1
#endif
#ifndef EN_D6D
#define EN_D6D 1
#endif
#ifndef EN_D7
#define EN_D7 1
#endif
#ifndef REP_P0
#define REP_P0 1
#endif
#ifndef REP_G1
#define REP_G1 1
#endif
#ifndef REP_G2
#define REP_G2 1
#endif
#ifndef REP_G3
#define REP_G3 1
#endif
#ifndef REP_G4
#define REP_G4 1
#endif
#ifndef REP_G5
#define REP_G5 1
#endif
#ifndef REP_G6
#define REP_G6 1
#endif
#ifndef REP_G7
#define REP_G7 1
#endif
#ifndef REP_G8
#define REP_G8 1
#endif
#ifndef REP_G9
#define REP_G9 1
#endif
#ifndef REP_D1
#define REP_D1 1
#endif
#ifndef REP_D2
#define REP_D2 1
#endif
#ifndef REP_D3
#define REP_D3 1
#endif
#ifndef REP_D4
#define REP_D4 1
#endif
#ifndef REP_D5
#define REP_D5 1
#endif
#ifndef REP_D6U
#define REP_D6U 1
#endif
#ifndef REP_D6D
#define REP_D6D 1
#endif
#ifndef REP_D7
#define REP_D7 1
#endif
#ifndef G2_VER
#define G2_VER 2
#endif
#if G2_VER == 2
#define G2_FN gdn_chunk_phase2
#else
#define G2_FN gdn_chunk_phase
#endif
#ifndef WGM_BIG
#define WGM_BIG 8
#endif
#ifndef WGM_SMALL
#define WGM_SMALL 4
#endif
#ifndef WGM_DOWN
#define WGM_DOWN 4
#endif
#ifndef PROBE_DBLBAR
#define PROBE_DBLBAR 0
#endif
#ifndef REP_BA
#define REP_BA 1
#endif
#ifndef PROBE_NOSTORE
#define PROBE_NOSTORE 0
#endif
struct Args { const float* in[16]; float* out; unsigned char* ws; int ph_lo, ph_hi; };
__global__ void __launch_bounds__(NWAVES * 64, 2) yoco_fwd(Args args) {
    extern __shared__ __attribute__((aligned(16))) unsigned char lds_raw[];
    LAS unsigned char* lds = (LAS unsigned char*)lds_raw;
    volatile LAS unsigned* MISC = (volatile LAS unsigned*)(lds + MISC_OFF);
    const int tid = threadIdx.x, lane = tid & 63, wave = __builtin_amdgcn_readfirstlane(tid >> 6);
    const int G = gridDim.x, bx = blockIdx.x, vcu = (G % 8 == 0) ? (bx % 8) * (G / 8) + bx / 8 : bx;
    const int gw = vcu * NWAVES + wave, NGW = G * NWAVES, gtid = vcu * NWAVES * 64 + tid, NGT = G * NWAVES * 64;
    const float* ln_g = args.in[14]; const float* ln_b = args.in[15];
    for (int u = tid; u < (LDS_BYTES - LDSCTL_OFF) / 4; u += NWAVES * 64) ((LAS unsigned*)(lds + LDSCTL_OFF))[u] = 0u;
    __syncthreads();
    XcdBarrier bar; bar.bar = (unsigned*)(args.ws + WS_CTL) + CW_BAR; bar.x = 0; bar.st = nullptr;
    if (!MK_PER_PHASE) bar = xcd_barrier_post((unsigned*)(args.ws + WS_CTL) + CW_BAR, MISC + 8);
    const int lo = args.ph_lo, hi = args.ph_hi;
#define IN(k) (lo <= (k) && (k) < hi)
#define FRESH_LANE() int ln_ = lane; asm volatile("" : "+v"(ln_)); unsigned char* ws_ = args.ws; asm volatile("" : "+s"(ws_)); int gw_ = gw, vcu_ = vcu, bx_ = bx; asm volatile("" : "+s"(gw_), "+s"(vcu_), "+s"(bx_))
#define x_in         (args.in[0])
#define gdn_w_in     (args.in[1])
#define gdn_conv_w   (args.in[2])
#define gdn_a_log    (args.in[3])
#define gdn_dt_bias  (args.in[4])
#define gdn_norm_w   (args.in[5])
#define gdn_w_out    (args.in[6])
#define diff_w_q     (args.in[7])
#define diff_lambda  (args.in[8])
#define diff_subln_w (args.in[9])
#define diff_w_o     (args.in[10])
#define shared_w_kv  (args.in[11])
#define mlp_w_up     (args.in[12])
#define mlp_w_down   (args.in[13])
#define beta  ((float*)(ws_ + WS_BETA))
#define gdec  ((float*)(ws_ + WS_G))
#define halo  ((bf16*)(ws_ + WS_HALO))
#define WA    ((bf16*)(ws_ + WS_WA))
#define WB    ((bf16*)(ws_ + WS_WB))
#define attnb ((bf16*)(ws_ + WS_ATTN))
#define XB    ((bf16*)(ws_ + WS_XB))
#define HB    ((bf16*)(ws_ + WS_Y))
#define WBUF  ((bf16*)(ws_ + WS_Y + QTR))
#define R1    ((bf16*)(ws_ + WS_R1))
#define Kb    (R1)
#define Vb    (R1 + QTR / 2)
#define Qb    (R1 + 2 * (QTR / 2))
#define HID   (Qb)
#define SEAM(k) do { if (!MK_PER_PHASE && (k) + 1 < hi) { xcd_barrier(bar); if (PROBE_DBLBAR) xcd_barrier(bar); } } while (0)

    for (int rep_ = 0; rep_ < REP_P0; ++rep_) if (EN_P0 && IN(0)) { FRESH_LANE();
        for (int m = gw_; m < MROWS; m += NGW) row_to_bf16(x_in + (size_t)m * DMODEL, XB + (size_t)m * DMODEL, ln_);
        convert_w(lds, gw_, NGW, wave, ln_, gdn_w_in, DMODEL, GDN_PROJ, 0, GDN_PROJ, WA, 0);
        SEAM(0);
    }
    for (int l = 0; l < 2; ++l) {
        const int pb = 1 + 9 * l;
        for (int rep_ = 0; rep_ < REP_G1; ++rep_) if (EN_G1 && IN(pb + 0)) { FRESH_LANE();
            pg8::Gemm g{XB, WA, MROWS, GDN_MAIN, DMODEL, DMODEL}; pg8::StaticOrder S; S.init(MROWS, GDN_MAIN, G, bx_, WGM_BIG);
            pg8::EpiStore<0> E{R1, GDN_MAIN, 0, 0, -1, 1.f, halo};
            pg8::gemm_phase<pg8::EpiStore<0>, pg8::StaticOrder, PG8_ALIGN, PG8_SP2>(lds + RING_OFF, g, S, E);
            { int ln2_ = lane; asm volatile("" : "+v"(ln2_));
              for (int rb_ = 0; rb_ < REP_BA; ++rb_) ba_proj(XB, WA, gdn_a_log + l * 16, gdn_dt_bias + l * 16, beta, gdec, gw_, NGW, ln2_); }
            SEAM(pb + 0);
        }
        for (int rep_ = 0; rep_ < REP_G2; ++rep_) if (EN_G2 && IN(pb + 1)) { FRESH_LANE(); G2_FN(lds, R1, halo, beta, gdec, WBUF, attnb, gdn_conv_w + (size_t)l * 4 * CONVC, vcu_, G, (rep_ + 1 < REP_G2) ? (bf16*)args.out : nullptr); SEAM(pb + 1); }
        for (int rep_ = 0; rep_ < REP_G3; ++rep_) if (EN_G3 && IN(pb + 2)) { FRESH_LANE(); gdn_scan_phase(lds, R1, WBUF, attnb, gdec, vcu_, G, (rep_ + 1 < REP_G3) ? (bf16*)args.out : nullptr); SEAM(pb + 2); }
        for (int rep_ = 0; rep_ < REP_G4; ++rep_) if (EN_G4 && IN(pb + 3)) { FRESH_LANE();
            gdn_gate_phase(R1, gdn_norm_w + l * HD, gw_, NGW, ln_, (rep_ + 1 < REP_G4) ? (bf16*)args.out : nullptr);
            convert_w(lds, gw_, NGW, wave, ln_, gdn_w_out + (size_t)l * DMODEL * DMODEL, DMODEL, DMODEL, 0, DMODEL, WA, 0);
            convert_w(lds, gw_, NGW, wave, ln_, mlp_w_up + (size_t)l * DMODEL * DFF, DMODEL, DFF, 0, DFF, WB, 0);
            SEAM(pb + 3);
        }
        for (int rep_ = 0; rep_ < REP_G5; ++rep_) if (EN_G5 && IN(pb + 4)) { FRESH_LANE();
            pg8::Gemm g{R1 + 4096, WA, MROWS, DMODEL, DMODEL, GDN_MAIN}; pg8::StaticOrder S; S.init(MROWS, DMODEL, G, bx_, WGM_SMALL);
            pg8::EpiStore<0> E{(rep_ + 1 < REP_G5) ? (bf16*)args.out : HB, DMODEL, 0, 0, -1, 1.f, nullptr};
            pg8::gemm_phase<pg8::EpiStore<0>, pg8::StaticOrder, PG8_ALIGN, PG8_SP2>(lds + RING_OFF, g, S, E);
            SEAM(pb + 4);
        }
        const float* g1 = ln_g + (size_t)(l * 2) * DMODEL; const float* b1 = ln_b + (size_t)(l * 2) * DMODEL;
        for (int rep_ = 0; rep_ < REP_G6; ++rep_) if (EN_G6 && IN(pb + 5)) { FRESH_LANE();
            ln_pass_b(XB, HB, g1, b1, XB, nullptr, ALPHA_RES, gw_, NGW, ln_);
            convert_w(lds, gw_, NGW, wave, ln_, mlp_w_down + (size_t)l * DFF * DMODEL, DFF, DMODEL, 0, DMODEL, WA, 0);
            SEAM(pb + 5);
        }
        for (int rep_ = 0; rep_ < REP_G7; ++rep_) if (EN_G7 && IN(pb + 6)) { FRESH_LANE();
            pg8::Gemm g{XB, WB, MROWS, DFF, DMODEL, DMODEL}; pg8::StaticOrder S; S.init(MROWS, DFF, G, bx_, WGM_BIG);
            pg8::EpiStore<1> E{R1, DFF, 0, 0, -1, 1.f, nullptr};
            pg8::gemm_phase<pg8::EpiStore<1>, pg8::StaticOrder, PG8_ALIGN, PG8_SP2>(lds + RING_OFF, g, S, E);
            SEAM(pb + 6);
        }
        for (int rep_ = 0; rep_ < REP_G8; ++rep_) if (EN_G8 && IN(pb + 7)) { FRESH_LANE();
            pg8::Gemm g{R1, WA, MROWS, DMODEL, DFF, DFF}; pg8::StaticOrder S; S.init(MROWS, DMODEL, G, bx_, WGM_DOWN);
            pg8::EpiStore<0> E{(rep_ + 1 < REP_G8) ? (bf16*)args.out : HB, DMODEL, 0, 0, -1, 1.f, nullptr};
            pg8::gemm_phase<pg8::EpiStore<0>, pg8::StaticOrder, PG8_ALIGN, PG8_SP2>(lds + RING_OFF, g, S, E);
            SEAM(pb + 7);
        }
        for (int rep_ = 0; rep_ < REP_G9; ++rep_) if (EN_G9 && IN(pb + 8)) { FRESH_LANE();
            const float* g2 = ln_g + (size_t)(l * 2 + 1) * DMODEL; const float* b2 = ln_b + (size_t)(l * 2 + 1) * DMODEL;
            ln_pass_b(XB, HB, g2, b2, XB, nullptr, ALPHA_RES, gw_, NGW, ln_);
            if (l == 0) convert_w(lds, gw_, NGW, wave, ln_, gdn_w_in + (size_t)DMODEL * GDN_PROJ, DMODEL, GDN_PROJ, 0, GDN_PROJ, WA, 0);
            else { convert_w(lds, gw_, NGW, wave, ln_, shared_w_kv, DMODEL, 2 * DMODEL, 0, 2 * DMODEL, WA, 0);
                   convert_w(lds, gw_, NGW, wave, ln_, diff_w_q, DMODEL, DMODEL, 0, DMODEL, WA, 2 * DMODEL); }
            SEAM(pb + 8);
        }
    }
    for (int j = 0; j < 2; ++j) {
        const int pb = 19 + 10 * j, L = 2 + j;
        for (int rep_ = 0; rep_ < REP_D1; ++rep_) if (EN_D1 && IN(pb + 0)) { FRESH_LANE();
            const int N = (j == 0) ? 3 * DMODEL : DMODEL;
            pg8::Gemm g{XB, WA, MROWS, N, DMODEL, DMODEL}; pg8::StaticOrder S; S.init(MROWS, N, G, bx_, WGM_BIG);
            pg8::EpiStore<0> E{(j == 0) ? Kb : Qb, DMODEL, (j == 0) ? DMODEL : 0, QTR / 2, (j == 0) ? 2 : 0, dattn::C2, nullptr};
            pg8::gemm_phase<pg8::EpiStore<0>, pg8::StaticOrder, PG8_ALIGN, PG8_SP2>(lds + RING_OFF, g, S, E);
            SEAM(pb + 0);
        }
        for (int rep_ = 0; rep_ < REP_D2; ++rep_) if (EN_D2 && IN(pb + 1)) { FRESH_LANE();
            const float lambda_init = 0.8f - 0.6f * expf(-0.3f * (float)L);
            const float* lp = diff_lambda + (size_t)j * 256;
            const float e1 = wave_sum(lp[ln_] * lp[64 + ln_]), e2 = wave_sum(lp[128 + ln_] * lp[192 + ln_]);
            const dattn::Params AP{(const dattn::bf16*)Qb, (const dattn::bf16*)Kb, (const dattn::bf16*)Vb, (rep_ + 1 < REP_D2) ? (dattn::bf16*)args.out : (dattn::bf16*)Qb, diff_subln_w + j * HD, __expf(e1) - __expf(e2) + lambda_init, 1.f - lambda_init};
            dattn::phase<8>((char*)lds_raw + RING_OFF, AP, G, bx_);
            { int ln2_ = lane; asm volatile("" : "+v"(ln2_));
              convert_w(lds, gw_, NGW, wave, ln2_, diff_w_o + (size_t)j * DMODEL * DMODEL, DMODEL, DMODEL, 0, DMODEL, WB, 0);
              convert_w(lds, gw_, NGW, wave, ln2_, mlp_w_up + (size_t)L * DMODEL * DFF, DMODEL, DFF, 0, DFF, WA, 0); }
            SEAM(pb + 1);
        }
        for (int rep_ = 0; rep_ < REP_D4; ++rep_) if (EN_D4 && IN(pb + 3)) { FRESH_LANE();
            pg8::Gemm g{Qb, WB, MROWS, DMODEL, DMODEL, DMODEL}; pg8::StaticOrder S; S.init(MROWS, DMODEL, G, bx_, WGM_SMALL);
            pg8::EpiStore<0> E{(rep_ + 1 < REP_D4) ? (bf16*)args.out : HB, DMODEL, 0, 0, -1, 1.f, nullptr};
            pg8::gemm_phase<pg8::EpiStore<0>, pg8::StaticOrder, PG8_ALIGN, PG8_SP2>(lds + RING_OFF, g, S, E);
            SEAM(pb + 3);
        }
        const float* g1 = ln_g + (size_t)(L * 2) * DMODEL; const float* b1 = ln_b + (size_t)(L * 2) * DMODEL;
        for (int rep_ = 0; rep_ < REP_D5; ++rep_) if (EN_D5 && IN(pb + 4)) { FRESH_LANE();
            ln_pass_b(XB, HB, g1, b1, XB, nullptr, ALPHA_RES, gw_, NGW, ln_);
            convert_w(lds, gw_, NGW, wave, ln_, mlp_w_down + (size_t)L * DFF * DMODEL, DFF, DMODEL, 0, DMODEL, WB, 0);
            SEAM(pb + 4);
        }
        for (int hf = 0; hf < 2; ++hf) {
            const size_t roff = (size_t)hf * (MROWS / 2);
            for (int rep_ = 0; rep_ < REP_D6U; ++rep_) if (EN_D6U && IN(pb + 5 + 2 * hf)) { FRESH_LANE();
                pg8::Gemm g{XB + roff * DMODEL, WA, MROWS / 2, DFF, DMODEL, DMODEL}; pg8::StaticOrder S; S.init(MROWS / 2, DFF, G, bx_, WGM_BIG);
                pg8::EpiStore<1> E{(PROBE_NOSTORE && rep_ + 1 < REP_D6U) ? (bf16*)nullptr : HID, DFF, 0, 0, -1, 1.f, nullptr};
                pg8::gemm_phase<pg8::EpiStore<1>, pg8::StaticOrder, PG8_ALIGN, PG8_SP2>(lds + RING_OFF, g, S, E);
                SEAM(pb + 5 + 2 * hf);
            }
            for (int rep_ = 0; rep_ < REP_D6D; ++rep_) if (EN_D6D && IN(pb + 6 + 2 * hf)) { FRESH_LANE();
                pg8::Gemm g{HID, WB, MROWS / 2, DMODEL, DFF, DFF}; pg8::StaticOrder S; S.init(MROWS / 2, DMODEL, G, bx_, WGM_DOWN);
                pg8::EpiStore<0> E{((rep_ + 1 < REP_D6D) ? (bf16*)args.out : HB) + roff * DMODEL, DMODEL, 0, 0, -1, 1.f, nullptr};
                pg8::gemm_phase<pg8::EpiStore<0>, pg8::StaticOrder, PG8_ALIGN, PG8_SP2>(lds + RING_OFF, g, S, E);
                SEAM(pb + 6 + 2 * hf);
            }
        }
        for (int rep_ = 0; rep_ < REP_D7; ++rep_) if (EN_D7 && IN(pb + 9)) { FRESH_LANE();
            const float* g2 = ln_g + (size_t)(L * 2 + 1) * DMODEL; const float* b2 = ln_b + (size_t)(L * 2 + 1) * DMODEL;
            if (j == 0) { ln_pass_b(XB, HB, g2, b2, XB, nullptr, ALPHA_RES, gw_, NGW, ln_);
                          convert_w(lds, gw_, NGW, wave, ln_, diff_w_q + (size_t)DMODEL * DMODEL, DMODEL, DMODEL, 0, DMODEL, WA, 0); }
            else { ln_pass_b(XB, HB, g2, b2, nullptr, args.out, ALPHA_RES, gw_, NGW, ln_); }
            SEAM(pb + 9);
        }
    }
#undef IN
#undef SEAM
}

extern "C" void kernel_launch(void* const* d_in, const int* in_sizes, int n_in, void* d_out, int out_size, void* d_ws, size_t ws_size, hipStream_t stream) {
    static int grid = 0;
    if (grid == 0) {
        if (n_in != 16 || in_sizes[0] != MROWS * DMODEL || out_size != MROWS * DMODEL || ws_size < WS_END) { fprintf(stderr, "kernel_launch: unexpected shapes / workspace (n_in %d, ws %zu < %zu); nothing launched\n", n_in, ws_size, (size_t)WS_END); grid = -1; return; }
        int dev = 0, cus = 0, per_cu = 0;
        if (hipGetDevice(&dev) != hipSuccess || hipDeviceGetAttribute(&cus, hipDeviceAttributeMultiprocessorCount, dev) != hipSuccess) { grid = -1; return; }
        if (hipFuncSetAttribute((const void*)yoco_fwd, hipFuncAttributeMaxDynamicSharedMemorySize, LDS_BYTES) != hipSuccess) { fprintf(stderr, "kernel_launch: hipFuncSetAttribute failed\n"); grid = -1; return; }
        if (hipOccupancyMaxActiveBlocksPerMultiprocessor(&per_cu, (const void*)yoco_fwd, NWAVES * 64, LDS_BYTES) != hipSuccess || per_cu < 1)
            fprintf(stderr, "kernel_launch: note: occupancy query reports %d workgroups per CU\n", per_cu);
        (void)hipGetLastError();
        grid = cus;
    }
    if (grid < 0) return;
    if (hipMemsetAsync((char*)d_ws + WS_CTL, 0, CTL_ZERO_BYTES, stream) != hipSuccess) return;
    Args a{};
    for (int i = 0; i < 16; ++i) a.in[i] = (const float*)d_in[i];
    a.out = (float*)d_out; a.ws = (unsigned char*)d_ws;
#if MK_PER_PHASE
    for (int k = 0; k < N_PHASES; ++k) { a.ph_lo = k; a.ph_hi = k + 1; hipLaunchKernelGGL(yoco_fwd, dim3(grid), dim3(NWAVES * 64), LDS_BYTES, stream, a); }
#else
    a.ph_lo = 0; a.ph_hi = N_PHASES;
    hipLaunchKernelGGL(yoco_fwd, dim3(grid), dim3(NWAVES * 64), LDS_BYTES, stream, a);
#endif
    const hipError_t le = hipPeekAtLastError();
    if (le != hipSuccess) fprintf(stderr, "kernel_launch: launch failed: %s\n", hipGetErrorName(le));
}
```

```cpp
#include <hip/hip_runtime.h>
#include <hip/hip_bf16.h>
#include <cstdio>
#include <cstdint>
#include <cmath>

namespace pg8 {
#define PG8_LAS __attribute__((address_space(3)))
typedef unsigned short bf16_t;
typedef short bf16x8 __attribute__((ext_vector_type(8)));
typedef float f32x4 __attribute__((ext_vector_type(4)));
typedef unsigned u32x4 __attribute__((ext_vector_type(4)));
#define PG8_GAS __attribute__((address_space(1)))
#ifndef PG8_WGM
#define PG8_WGM 4
#endif
#ifndef PG8_STORE_NT
#define PG8_STORE_NT 0
#endif
#ifndef PG8_STORE_SC1
#define PG8_STORE_SC1 0
#endif
constexpr int BM = 256, BK = 64, HALF = 128, HTB = HALF * BK * 2  , STAGE_BYTES = 8 * HTB, NXCD = 8;

__host__ __device__ __forceinline__ int lds_byte(int r, int c) { const int st = (r >> 4) * 2 + (c >> 5), rr = r & 15, cc = c & 31, ob = rr * 64 + cc * 2; return st * 1024 + (ob ^ (((ob >> 9) & 1) << 5)); }
__host__ __device__ __forceinline__ void stage_rc(int b, int& R, int& C) { const int st = b / 1024, sb = b % 1024, swz = sb ^ (((sb >> 9) & 1) << 5); R = (st >> 1) * 16 + swz / 64; C = (st & 1) * 32 + (swz % 64) / 2; }
__host__ __device__ __forceinline__ int perm32(int rho) { const int n = rho >> 4, i = rho & 15; return 8 * (i >> 2) + 4 * n + (i & 3); }

struct Unit { int pm, pn; };
struct Gemm { const bf16_t* A; const bf16_t* Bt; int M, N, K, lda; const bf16_t* A2; int msplit; };

struct StaticOrder {
    int nM, nN, nwg, G, c, WGM;
    __host__ __device__ void init(int M, int N, int G_, int c_, int wgm = PG8_WGM) { nM = M / BM; nN = N / BM; nwg = nM * nN; G = G_; c = c_; WGM = wgm; }
    __host__ __device__ bool next(int i, Unit& u) const {
        if (WGM < 0) {
            const int ncx = nN / NXCD, e = i * (G / NXCD) + c / NXCD; if (e >= nM * ncx) return false;
            u.pm = e / ncx; u.pn = (c % NXCD) * ncx + e % ncx; return true; }
        const long L = (long)i * G + c; if (L >= nwg) return false;
        int wgid = (int)L; { const int q = nwg / NXCD, r = nwg % NXCD, xcd = wgid % NXCD, off = wgid / NXCD; wgid = (xcd < r ? xcd * (q + 1) : r * (q + 1) + (xcd - r) * q) + off; }
        const int nig = WGM * nN, gid = wgid / nig, fm = gid * WGM, gsz = (nM - fm) < WGM ? (nM - fm) : WGM;
        u.pm = fm + ((wgid % nig) % gsz); u.pn = (wgid % nig) / gsz; return true;
    }
    __device__ __forceinline__ void a_ready(const Unit&) const {}
    __device__ __forceinline__ void done(const Unit&) const {}
};

__device__ __forceinline__ unsigned cvt_pk_bf16(float lo, float hi) { unsigned r; asm volatile("v_cvt_pk_bf16_f32 %0, %1, %2" : "=v"(r) : "v"(lo), "v"(hi)); return r; }

template <int ACT> struct EpiStore {
    static constexpr bool PERM = true, AFTER_DRAIN = false;
    bf16_t* O; int ldc; int split_cols; size_t split_stride; int scale_tile; float scale0; bf16_t* halo; bf16_t* O2; int row_split;
    __device__ __forceinline__ void operator()(const f32x4 (&acc)[2][2][4][2], const Unit& u, int wr, int wc, int fr, int fq) const {
        const int row0 = u.pm * BM + wr * 64 + fr; int colt = u.pn * BM; PG8_GAS bf16_t* base = (PG8_GAS bf16_t*)O; PG8_GAS bf16_t* hal = (PG8_GAS bf16_t*)halo;
        int t = 0; if (split_cols) { t = colt / split_cols; base += (size_t)t * split_stride; colt -= t * split_cols; }
        if (O2 != nullptr && u.pm * BM >= row_split) base = (PG8_GAS bf16_t*)O2 - (size_t)row_split * ldc;
        const float sc = (t == scale_tile) ? scale0 : 1.f;
        const int col0 = colt + wc * 32 + 8 * fq;
#pragma unroll
        for (int ai = 0; ai < 2; ++ai)
#pragma unroll
            for (int m = 0; m < 4; ++m) { const int row = row0 + ai * HALF + m * 16; PG8_GAS bf16_t* rowp = base + (size_t)row * ldc + col0;
#pragma unroll
                for (int bj = 0; bj < 2; ++bj) { f32x4 v0 = acc[ai][bj][m][0], v1 = acc[ai][bj][m][1];
                    if (ACT == 1) {
#pragma unroll
                        for (int e = 0; e < 4; ++e) { const float a = fmaxf(v0[e], 0.f), b = fmaxf(v1[e], 0.f); v0[e] = a * a; v1[e] = b * b; } }
                    if (sc != 1.f) { v0 = v0 * sc; v1 = v1 * sc; }
                    u32x4 w; w.x = cvt_pk_bf16(v0[0], v0[1]); w.y = cvt_pk_bf16(v0[2], v0[3]); w.z = cvt_pk_bf16(v1[0], v1[1]); w.w = cvt_pk_bf16(v1[2], v1[3]);
#if PG8_STORE_SC1
                    if (O != nullptr) asm volatile("global_store_dwordx4 %0, %1, off sc1\n\ts_nop 1" :: "v"(rowp + bj * HALF), "v"(w) : "memory"); else asm volatile("" :: "v"(w));
#else
                    if (O != nullptr) { if (PG8_STORE_NT) __builtin_nontemporal_store(w, (PG8_GAS u32x4*)(rowp + bj * HALF)); else *(PG8_GAS u32x4*)(rowp + bj * HALF) = w; } else asm volatile("" :: "v"(w));
#endif
                    if (halo != nullptr && m == 3 && fr >= 13) { const int c = col0 + bj * HALF; if (c < 6144) *(PG8_GAS u32x4*)(hal + ((size_t)(row >> 6) * 3 + (fr - 13)) * 6144 + c) = w; }
                } }
    }
};
struct EpiLn {
    static constexpr bool PERM = false, AFTER_DRAIN = false;
    static constexpr float alpha = 1.6817928305074292f  , eps = 1e-5f;
    const bf16_t* xold; bf16_t* xnew; float* outf; const float* g; const float* b;
    unsigned long long* slots; unsigned* cnt; unsigned* tmo; int panel0;
    PG8_LAS unsigned char* scr;
    __device__ __forceinline__ void operator()(f32x4 (&acc)[2][2][4][2], const Unit& u, int wr, int wc, int fr, int fq) const {
        typedef float f32x2v __attribute__((ext_vector_type(2))); typedef unsigned u32x2v __attribute__((ext_vector_type(2)));
        const int tid = threadIdx.x, lane = tid & 63, wid = __builtin_amdgcn_readfirstlane(tid >> 6);
        PG8_LAS f32x2v* P = (PG8_LAS f32x2v*)scr;
        PG8_LAS f32x2v* S = (PG8_LAS f32x2v*)(scr + 8192);
        PG8_LAS unsigned* flag = (PG8_LAS unsigned*)(scr + 8192 + 2048);
        const int row0 = u.pm * BM + wr * 64 + fr, col0 = u.pn * BM + wc * 32 + 4 * fq;
        const PG8_GAS bf16_t* xo = (const PG8_GAS bf16_t*)xold;
#pragma unroll
        for (int ai = 0; ai < 2; ++ai) { u32x2v xv[4][2][2];
#pragma unroll
            for (int m = 0; m < 4; ++m) { const unsigned off = (unsigned)(row0 + ai * HALF + m * 16) * 2048u + (unsigned)col0;
#pragma unroll
                for (int bj = 0; bj < 2; ++bj)
#pragma unroll
                    for (int n = 0; n < 2; ++n) xv[m][bj][n] = *(const PG8_GAS u32x2v*)(xo + off + bj * HALF + n * 16); }
#pragma unroll
            for (int m = 0; m < 4; ++m)
#pragma unroll
                for (int bj = 0; bj < 2; ++bj)
#pragma unroll
                    for (int n = 0; n < 2; ++n) { const u32x2v w = xv[m][bj][n]; f32x4 x;
                        x[0] = __builtin_bit_cast(float, w.x << 16); x[1] = __builtin_bit_cast(float, w.x & 0xffff0000u); x[2] = __builtin_bit_cast(float, w.y << 16); x[3] = __builtin_bit_cast(float, w.y & 0xffff0000u);
                        acc[ai][bj][m][n] = x * alpha + acc[ai][bj][m][n]; }
            asm volatile("" ::: "memory"); }
#pragma unroll
        for (int ai = 0; ai < 2; ++ai)
#pragma unroll
            for (int m = 0; m < 4; ++m) {
                float s = 0.f;
#pragma unroll
                for (int bj = 0; bj < 2; ++bj)
#pragma unroll
                    for (int n = 0; n < 2; ++n) { const f32x4 x = acc[ai][bj][m][n]; s += (x[0] + x[1]) + (x[2] + x[3]); }
                s += __shfl_xor(s, 16); s += __shfl_xor(s, 32);
                const float mw = s * (1.0f / 64.0f); float q = 0.f;
#pragma unroll
                for (int bj = 0; bj < 2; ++bj)
#pragma unroll
                    for (int n = 0; n < 2; ++n) { const f32x4 d = acc[ai][bj][m][n] - mw; q += (d[0] * d[0] + d[1] * d[1]) + (d[2] * d[2] + d[3] * d[3]); }
                q += __shfl_xor(q, 16); q += __shfl_xor(q, 32);
                if (fq == 0) P[(ai * HALF + wr * 64 + m * 16 + fr) * 4 + wc] = (f32x2v){mw, q};
            }
        asm volatile("s_waitcnt lgkmcnt(0)" ::: "memory"); __builtin_amdgcn_s_barrier(); asm volatile("" ::: "memory");
        const int panel = panel0 + u.pm; const int row = wid * 32 + (lane & 31);
        if (lane < 32) {
            const f32x2v a = P[row * 4 + 0], bq = P[row * 4 + 1], c = P[row * 4 + 2], d = P[row * 4 + 3];
            const float mt = (a.x + bq.x + c.x + d.x) * 0.25f;
            const float da = a.x - mt, db = bq.x - mt, dc = c.x - mt, dd = d.x - mt;
            const float m2 = (a.y + bq.y) + (c.y + d.y) + 64.0f * ((da * da + db * db) + (dc * dc + dd * dd));
            unsigned long long* slot = slots + ((size_t)(panel * BM + row) * 8 + u.pn);
            __hip_atomic_store(slot, ((unsigned long long)__float_as_uint(m2) << 32) | __float_as_uint(mt), __ATOMIC_RELAXED, __HIP_MEMORY_SCOPE_AGENT);
        }
        asm volatile("s_waitcnt vmcnt(0)" ::: "memory");
        if (lane == 0) __hip_atomic_fetch_add(cnt + 64 * panel, 1u, __ATOMIC_RELAXED, __HIP_MEMORY_SCOPE_AGENT);
        if (wid == 0) {
            bool dead = false; const unsigned long long t0 = __builtin_amdgcn_s_memrealtime();
            for (;;) {
                if ((unsigned)__builtin_amdgcn_readfirstlane(__hip_atomic_load(cnt + 64 * panel, __ATOMIC_RELAXED, __HIP_MEMORY_SCOPE_AGENT)) >= 64u) break;
                if (__builtin_amdgcn_s_memrealtime() - t0 > 2000000ull) { if (lane == 0) __hip_atomic_store(tmo, 1u, __ATOMIC_RELAXED, __HIP_MEMORY_SCOPE_AGENT); dead = true; break; }
                __builtin_amdgcn_s_sleep(2);
            }
            __builtin_amdgcn_fence(__ATOMIC_ACQUIRE, "agent");
            if (lane == 0) flag[0] = dead ? 1u : 0u;
        }
        asm volatile("s_waitcnt vmcnt(0) lgkmcnt(0)" ::: "memory"); __builtin_amdgcn_s_barrier(); asm volatile("" ::: "memory");
        const bool bad = flag[0] != 0u;
        if (lane < 32) {
            const unsigned long long* slot = slots + (size_t)(panel * BM + row) * 8; float mt[8], m2[8]; float ms = 0.f;
#pragma unroll
            for (int t = 0; t < 8; ++t) { const unsigned long long w = __hip_atomic_load(slot + t, __ATOMIC_RELAXED, __HIP_MEMORY_SCOPE_AGENT); mt[t] = __uint_as_float((unsigned)w); m2[t] = __uint_as_float((unsigned)(w >> 32)); ms += mt[t]; }
            const float mean = ms * 0.125f; float q = 0.f;
#pragma unroll
            for (int t = 0; t < 8; ++t) { const float dm = mt[t] - mean; q += m2[t] + 256.0f * dm * dm; }
            S[row] = (f32x2v){mean, 1.0f / sqrtf(q * (1.0f / 2048.0f) + eps)};
        }
        asm volatile("s_waitcnt lgkmcnt(0)" ::: "memory"); __builtin_amdgcn_s_barrier(); asm volatile("" ::: "memory");
        const PG8_GAS float* gg = (const PG8_GAS float*)g; const PG8_GAS float* bg = (const PG8_GAS float*)b; const float qnan = __builtin_nanf("");
#pragma unroll
        for (int bj = 0; bj < 2; ++bj)
#pragma unroll
            for (int n = 0; n < 2; ++n) { const f32x4 gv = *(const PG8_GAS f32x4*)(gg + col0 + bj * HALF + n * 16), bv = *(const PG8_GAS f32x4*)(bg + col0 + bj * HALF + n * 16);
#pragma unroll
                for (int ai = 0; ai < 2; ++ai)
#pragma unroll
                    for (int m = 0; m < 4; ++m) { const int r = ai * HALF + wr * 64 + m * 16 + fr; const f32x2v sr = S[r]; const unsigned off = (unsigned)(u.pm * BM + r) * 2048u + (unsigned)(col0 + bj * HALF + n * 16);
                        f32x4 o = ((acc[ai][bj][m][n] - sr.x) * sr.y) * gv + bv; if (bad) o = (f32x4){qnan, qnan, qnan, qnan};
                        if (outf) *(PG8_GAS f32x4*)((PG8_GAS float*)outf + off) = o;
                        else { u32x2v w; w.x = cvt_pk_bf16(o[0], o[1]); w.y = cvt_pk_bf16(o[2], o[3]); *(PG8_GAS u32x2v*)((PG8_GAS bf16_t*)xnew + off) = w; } } }
        asm volatile("s_waitcnt lgkmcnt(0)" ::: "memory"); __builtin_amdgcn_s_barrier(); asm volatile("" ::: "memory");
    }
};

template <class Epi, class Sched, bool ALIGN_EPI = false, bool SP2 = false>
__device__ __forceinline__ void gemm_phase(PG8_LAS unsigned char* lds, const Gemm g, const Sched& S, const Epi& E) {
    int tid_ = threadIdx.x; asm volatile("" : "+v"(tid_));
    const int tid = tid_, wid = __builtin_amdgcn_readfirstlane(tid >> 6), lane = tid & 63, wr = wid >> 2, wc = wid & 3, fr = lane & 15, fq = lane >> 4;
    const int K = g.K, nt = K / BK, lda = g.lda;
    unsigned voffA[2], voffB[2];
#pragma unroll
    for (int i = 0; i < 2; ++i) { int R, C; stage_rc(tid * 16 + i * 8192, R, C); const int Rb = Epi::PERM ? ((R & ~31) + perm32(R & 31)) : R;
        voffA[i] = (unsigned)(R * lda + C) * 2u; voffB[i] = (unsigned)(Rb * K + C) * 2u; }
    const size_t kstep = (size_t)(BK * 2);
    const size_t hA = (size_t)HALF * lda * 2, hB = (size_t)HALF * K * 2;
    const size_t tA = 2 * hA, tB = 2 * hB;
    const unsigned ldsw = (unsigned)wid * 1024u;
    const int aoff = lds_byte(wr * 64 + fr, fq * 8), boff = lds_byte(wc * 32 + fr, fq * 8);
#define PG8_SA(b, h) (((b) * 2 + (h)) * HTB)
#define PG8_SB(b, h) ((4 + (b) * 2 + (h)) * HTB)
#define PG8_STAGE(bufoff, gbase, voff) do { _Pragma("unroll") for (int _i = 0; _i < 2; ++_i) \
        __builtin_amdgcn_global_load_lds((const unsigned*)((const char*)(gbase) + (voff)[_i]), (PG8_LAS unsigned*)(lds + (bufoff) + ldsw + _i * 8192), 16, 0, 0); } while (0)
#define PG8_LDA(dst, b, h) do { _Pragma("unroll") for (int m = 0; m < 4; ++m) _Pragma("unroll") for (int k = 0; k < 2; ++k) dst[m][k] = *(const PG8_LAS bf16x8*)(lds + PG8_SA(b, h) + aoff + m * 2048 + k * 1024); } while (0)
#define PG8_LDB(dst, b, h) do { _Pragma("unroll") for (int n = 0; n < 2; ++n) _Pragma("unroll") for (int k = 0; k < 2; ++k) dst[n][k] = *(const PG8_LAS bf16x8*)(lds + PG8_SB(b, h) + boff + n * 2048 + k * 1024); } while (0)
#define PG8_MMA(ai, bj, At, Bt) do { __builtin_amdgcn_s_setprio(1); _Pragma("unroll") for (int m = 0; m < 4; ++m) _Pragma("unroll") for (int n = 0; n < 2; ++n) _Pragma("unroll") for (int k = 0; k < 2; ++k) \
        acc[ai][bj][m][n] = __builtin_amdgcn_mfma_f32_16x16x32_bf16(Bt[n][k], At[m][k], acc[ai][bj][m][n], 0, 0, 0); __builtin_amdgcn_s_setprio(0); } while (0)
#define PG8_WAIT_V(n) asm volatile("s_waitcnt vmcnt(" #n ")" ::: "memory")
#define PG8_WAIT_L(n) asm volatile("s_waitcnt lgkmcnt(" #n ")" ::: "memory")
#define PG8_BAR __builtin_amdgcn_s_barrier()
#define PG8_SCHED __builtin_amdgcn_sched_barrier(0)
    Unit cur, nxt; int ui = 0;
    if (!S.next(0, cur)) return;
    f32x4 acc[2][2][4][2];
#pragma unroll
    for (int a = 0; a < 2; ++a)
#pragma unroll
        for (int b = 0; b < 2; ++b)
#pragma unroll
            for (int m = 0; m < 4; ++m)
#pragma unroll
                for (int n = 0; n < 2; ++n) acc[a][b][m][n] = (f32x4){0.f, 0.f, 0.f, 0.f};
    bf16x8 At[4][2], B0[2][2], B1[2][2];
#define PG8_AOF(pm_) ((g.A2 != nullptr && (pm_) >= g.msplit) ? (const char*)g.A2 + (size_t)((pm_) - g.msplit) * tA : (const char*)g.A + (size_t)(pm_) * tA)
    const char* cA = PG8_AOF(cur.pm); const char* cB = (const char*)g.Bt + (size_t)cur.pn * tB;
    S.a_ready(cur);
    if constexpr (SP2) {
        PG8_STAGE(PG8_SB(0, 0), cB, voffB); PG8_STAGE(PG8_SB(0, 1), cB + hB, voffB); PG8_STAGE(PG8_SA(0, 0), cA, voffA); PG8_STAGE(PG8_SA(0, 1), cA + hA, voffA);
        if (wr == 1) PG8_BAR;
        PG8_WAIT_V(2); PG8_BAR;
        PG8_STAGE(PG8_SB(1, 0), cB + kstep, voffB); PG8_STAGE(PG8_SA(1, 0), cA + kstep, voffA); PG8_STAGE(PG8_SB(1, 1), cB + hB + kstep, voffB);
        PG8_WAIT_V(6); PG8_BAR;
    } else {
        PG8_STAGE(PG8_SB(0, 0), cB, voffB); PG8_STAGE(PG8_SA(0, 0), cA, voffA); PG8_STAGE(PG8_SB(0, 1), cB + hB, voffB); PG8_STAGE(PG8_SA(0, 1), cA + hA, voffA);
        if (wr == 1) PG8_BAR;
        PG8_WAIT_V(4); PG8_BAR;
        PG8_STAGE(PG8_SB(1, 0), cB + kstep, voffB); PG8_STAGE(PG8_SA(1, 0), cA + kstep, voffA); PG8_STAGE(PG8_SB(1, 1), cB + hB + kstep, voffB);
        PG8_WAIT_V(6); PG8_BAR;
    }
    for (;;) {
        const bool has_next = S.next(ui + 1, nxt);
        const char* nA = has_next ? PG8_AOF(nxt.pm) : cA; const char* nB = has_next ? (const char*)g.Bt + (size_t)nxt.pn * tB : cB;
        for (int t = 0; t < nt; t += 2) {
            const bool last = (t == nt - 2);
            const char* a1 = cA + (size_t)(t + 1) * kstep;
            const char* a2 = last ? nA : cA + (size_t)(t + 2) * kstep; const char* b2 = last ? nB : cB + (size_t)(t + 2) * kstep;
            const char* a3 = a2 + kstep; const char* b3 = b2 + kstep;
            if (last && has_next) S.a_ready(nxt);
            if constexpr (SP2) {
            PG8_LDB(B0, 0, 0); PG8_LDB(B1, 0, 1); PG8_SCHED; PG8_LDA(At, 0, 0); PG8_STAGE(PG8_SA(1, 1), a1 + hA, voffA);
            PG8_WAIT_V(8); PG8_WAIT_L(0); PG8_BAR; PG8_MMA(0, 0, At, B0); PG8_MMA(0, 1, At, B1); PG8_BAR; PG8_SCHED;
            PG8_LDA(At, 0, 1); PG8_STAGE(PG8_SB(0, 0), b2, voffB); PG8_STAGE(PG8_SB(0, 1), b2 + hB, voffB); PG8_STAGE(PG8_SA(0, 0), a2, voffA);
            PG8_WAIT_V(8); PG8_WAIT_L(0); PG8_BAR; PG8_MMA(1, 0, At, B0); PG8_MMA(1, 1, At, B1); PG8_BAR; PG8_SCHED;
            PG8_LDB(B0, 1, 0); PG8_LDB(B1, 1, 1); PG8_SCHED; PG8_LDA(At, 1, 0); PG8_STAGE(PG8_SA(0, 1), a2 + hA, voffA);
            PG8_WAIT_V(8); PG8_WAIT_L(0); PG8_BAR; PG8_MMA(0, 0, At, B0); PG8_MMA(0, 1, At, B1); PG8_BAR; PG8_SCHED;
            PG8_LDA(At, 1, 1); PG8_STAGE(PG8_SB(1, 0), b3, voffB); PG8_STAGE(PG8_SB(1, 1), b3 + hB, voffB); PG8_STAGE(PG8_SA(1, 0), a3, voffA);
            PG8_WAIT_V(8); PG8_WAIT_L(0); PG8_BAR; PG8_MMA(1, 0, At, B0); PG8_MMA(1, 1, At, B1); PG8_BAR; PG8_SCHED;
            } else {
            PG8_LDB(B0, 0, 0); PG8_SCHED; PG8_LDA(At, 0, 0); PG8_STAGE(PG8_SA(1, 1), a1 + hA, voffA);
            PG8_WAIT_L(8); PG8_BAR; PG8_WAIT_L(0); PG8_MMA(0, 0, At, B0); PG8_BAR; PG8_SCHED;
            PG8_LDB(B1, 0, 1); PG8_STAGE(PG8_SB(0, 0), b2, voffB);
            PG8_BAR; PG8_WAIT_L(0); PG8_MMA(0, 1, At, B1); PG8_BAR;
            PG8_LDA(At, 0, 1); PG8_STAGE(PG8_SA(0, 0), a2, voffA);
            PG8_BAR; PG8_WAIT_L(0); PG8_MMA(1, 0, At, B0); PG8_BAR; PG8_SCHED;
            PG8_STAGE(PG8_SB(0, 1), b2 + hB, voffB);
            PG8_WAIT_V(6); PG8_BAR; PG8_MMA(1, 1, At, B1); PG8_BAR;
            PG8_LDB(B0, 1, 0); PG8_SCHED; PG8_LDA(At, 1, 0); PG8_STAGE(PG8_SA(0, 1), a2 + hA, voffA);
            PG8_WAIT_L(8); PG8_BAR; PG8_WAIT_L(0); PG8_MMA(0, 0, At, B0); PG8_BAR; PG8_SCHED;
            PG8_LDB(B1, 1, 1); PG8_STAGE(PG8_SB(1, 0), b3, voffB);
            PG8_BAR; PG8_WAIT_L(0); PG8_MMA(0, 1, At, B1); PG8_BAR;
            PG8_LDA(At, 1, 1); PG8_STAGE(PG8_SA(1, 0), a3, voffA);
            PG8_BAR; PG8_WAIT_L(0); PG8_MMA(1, 0, At, B0); PG8_BAR; PG8_SCHED;
            PG8_STAGE(PG8_SB(1, 1), b3 + hB, voffB);
            PG8_WAIT_V(6); PG8_BAR; PG8_MMA(1, 1, At, B1); PG8_BAR;
            }
        }
        if constexpr (ALIGN_EPI) { if (wr == 0) PG8_BAR; }
        if constexpr (!Epi::AFTER_DRAIN) { E(acc, cur, wr, wc, fr, fq); S.done(cur); }
        if (!has_next) break;
#pragma unroll
        for (int a = 0; a < 2; ++a)
#pragma unroll
            for (int b = 0; b < 2; ++b)
#pragma unroll
                for (int m = 0; m < 4; ++m)
#pragma unroll
                    for (int n = 0; n < 2; ++n) acc[a][b][m][n] = (f32x4){0.f, 0.f, 0.f, 0.f};
        cur = nxt; cA = nA; cB = nB; ++ui;
        if constexpr (ALIGN_EPI) { if (wr == 1) PG8_BAR; }
    }
    PG8_WAIT_V(0);
    if constexpr (!ALIGN_EPI) { if (wr == 0) PG8_BAR; }
    PG8_BAR;
#undef PG8_AOF
#undef PG8_SA
#undef PG8_SB
#undef PG8_STAGE
#undef PG8_LDA
#undef PG8_LDB
#undef PG8_MMA
#undef PG8_WAIT_V
#undef PG8_WAIT_L
#undef PG8_BAR
#undef PG8_SCHED
}
}
#ifndef ATTN_SHARE8
#define ATTN_SHARE8 1
#endif
#ifndef ATTN_PRIO
#define ATTN_PRIO 0
#endif
namespace dattn {
using bf16=__hip_bfloat16;
using bf16x8=__attribute__((ext_vector_type(8)))short;
using s16x4=__attribute__((ext_vector_type(4)))short;
using f32x16=__attribute__((ext_vector_type(16)))float;
using u32x4=__attribute__((ext_vector_type(4)))unsigned;
constexpr int SEQ=4096,DM=2048,HDV=128;
constexpr int NW=8,QBLK=32,QB=128,KVBLK=64,NQB=SEQ/QB;
__device__ __forceinline__ int crow(int r,int hi){return (r&3)+8*(r>>2)+4*hi;}
#define SBAR() __builtin_amdgcn_sched_barrier(0)
__device__ __forceinline__ void cmask(f32x16&p0,f32x16&p1,int jb,int qrel,int hi){
  const float NEG=-INFINITY; int kb=64*jb+4*hi;
  #pragma unroll
  for(int r=0;r<16;++r){int kv=kb+(r&3)+8*(r>>2); if(kv>qrel)p0[r]=NEG; if(kv+32>qrel)p1[r]=NEG;}
}
constexpr float C2=0.125f*1.4426950408889634f;
constexpr int NSLOT=3, SLOTB=16384;
constexpr int LDS_K=0, LDS_V=NSLOT*SLOTB, LDS_WS=2*NSLOT*SLOTB, LDS_KX=LDS_WS+NW*64*4, LDS_SW=LDS_KX+SLOTB, LDS_QX=LDS_SW+512, LDS_BYTES=LDS_QX+NW*4096;
__device__ __forceinline__ void glds16(const void*gsrc,unsigned lds_dst){unsigned keep;
  asm volatile("s_mov_b32 %0, m0\n\ts_mov_b32 m0, %2\n\ts_nop 0\n\tglobal_load_lds_dwordx4 %1, off\n\ts_mov_b32 m0, %0":"=&s"(keep):"v"(gsrc),"s"(lds_dst):"memory");}
__device__ __forceinline__ void gld16(bf16x8&d,const void*g){ asm volatile("global_load_dwordx4 %0, %1, off":"=v"(d):"v"(g):"memory"); }
__device__ __forceinline__ float max3f(float a,float b,float c){float r;asm("v_max3_f32 %0, %1, %2, %3":"=v"(r):"v"(a),"v"(b),"v"(c));return r;}
__device__ __forceinline__ float max2f(float a,float b){float r;asm("v_max_f32_e32 %0, %1, %2":"=v"(r):"v"(a),"v"(b));return r;}
__device__ __forceinline__ float fadd_s(float a,float b){float r;asm("v_add_f32_e32 %0, %1, %2":"=v"(r):"v"(a),"v"(b));return r;}
__device__ __forceinline__ float fsub_s(float a,float b){float r;asm("v_sub_f32_e32 %0, %1, %2":"=v"(r):"v"(a),"v"(b));return r;}
typedef float f32x2_t __attribute__((ext_vector_type(2))); typedef __bf16 bf16x2_t __attribute__((ext_vector_type(2)));
__device__ __forceinline__ unsigned cvtpk_s(float lo,float hi){f32x2_t v={lo,hi};bf16x2_t b=__builtin_convertvector(v,bf16x2_t);return __builtin_bit_cast(unsigned,b);}
#define WAIT_BAR(N) asm volatile("s_waitcnt vmcnt(" #N ") lgkmcnt(0)\n\ts_barrier":::"memory")
typedef __attribute__((address_space(3))) const char* lds_cptr;
typedef short v4i16_t __attribute__((ext_vector_type(4)));
__device__ __forceinline__ void qkt(f32x16&p0,f32x16&p1,const char*kb,const bf16x8*qr){ const f32x16 negm=f32x16{};
  #pragma unroll
  for(int d0=0;d0<4;++d0){
    const bf16x8 b0=*reinterpret_cast<const bf16x8*>(kb+d0*2048);
    const bf16x8 b1=*reinterpret_cast<const bf16x8*>(kb+d0*2048+512);
    if(d0==0){p0=__builtin_amdgcn_mfma_f32_32x32x16_bf16(b0,qr[0],negm,0,0,0);p1=__builtin_amdgcn_mfma_f32_32x32x16_bf16(b1,qr[0],negm,0,0,0);}
    else{p0=__builtin_amdgcn_mfma_f32_32x32x16_bf16(b0,qr[d0],p0,0,0,0);p1=__builtin_amdgcn_mfma_f32_32x32x16_bf16(b1,qr[d0],p1,0,0,0);}}
}
__device__ __forceinline__ void kload8(bf16x8*kf,lds_cptr kp){
  kf[0]=*(const __attribute__((address_space(3))) bf16x8*)(kp);      kf[1]=*(const __attribute__((address_space(3))) bf16x8*)(kp+512);
  kf[2]=*(const __attribute__((address_space(3))) bf16x8*)(kp+2048); kf[3]=*(const __attribute__((address_space(3))) bf16x8*)(kp+2560);
  kf[4]=*(const __attribute__((address_space(3))) bf16x8*)(kp+4096); kf[5]=*(const __attribute__((address_space(3))) bf16x8*)(kp+4608);
  kf[6]=*(const __attribute__((address_space(3))) bf16x8*)(kp+6144); kf[7]=*(const __attribute__((address_space(3))) bf16x8*)(kp+6656);
}
__device__ __forceinline__ void kload2(bf16x8*kf,lds_cptr kp,int j){ kf[2*j]=*(const __attribute__((address_space(3))) bf16x8*)(kp+j*2048); kf[2*j+1]=*(const __attribute__((address_space(3))) bf16x8*)(kp+j*2048+512); }
__device__ __forceinline__ s16x4 vtr(lds_cptr p){ return __builtin_bit_cast(s16x4,__builtin_amdgcn_ds_read_tr16_b64_v4i16((__attribute__((address_space(3))) v4i16_t*)p)); }
__device__ __forceinline__ float rowmax(const f32x16&p0,const f32x16&p1){
  float a=max3f(p0[0],p0[1],p1[0]),b=max3f(p0[2],p0[3],p1[1]);a=max3f(a,p1[2],p1[3]);
  #pragma unroll
  for(int r=4;r<16;r+=4){a=max3f(a,p0[r],p0[r+1]);b=max3f(b,p0[r+2],p0[r+3]);a=max3f(a,p1[r],p1[r+1]);b=max3f(b,p1[r+2],p1[r+3]);}
  const float m=max2f(a,b);
  auto rr=__builtin_amdgcn_permlane32_swap(__float_as_uint(m),__float_as_uint(m),false,false);
  return max2f(__uint_as_float(rr[0]),__uint_as_float(rr[1]));
}
__device__ __forceinline__ void pv(f32x16*o,int vb,bf16x8 pa0,bf16x8 pa1,bf16x8 pa2,bf16x8 pa3){
  #pragma unroll
  for(int d0=0;d0<4;++d0){s16x4 lo[4],hi[4];
    #pragma unroll
    for(int ks=0;ks<4;++ks){
      asm volatile("ds_read_b64_tr_b16 %0,%1 offset:%c2":"=&v"(lo[ks]):"v"(vb),"i"(d0*4096+ks*1024):"memory");
      asm volatile("ds_read_b64_tr_b16 %0,%1 offset:%c2":"=&v"(hi[ks]):"v"(vb),"i"(d0*4096+ks*1024+512):"memory");}
    asm volatile("s_waitcnt lgkmcnt(0)":::"memory");SBAR();
    #define PK(k) (bf16x8){lo[k][0],lo[k][1],lo[k][2],lo[k][3],hi[k][0],hi[k][1],hi[k][2],hi[k][3]}
    o[d0]=__builtin_amdgcn_mfma_f32_32x32x16_bf16(pa0,PK(0),o[d0],0,0,0);
    o[d0]=__builtin_amdgcn_mfma_f32_32x32x16_bf16(pa1,PK(1),o[d0],0,0,0);
    o[d0]=__builtin_amdgcn_mfma_f32_32x32x16_bf16(pa2,PK(2),o[d0],0,0,0);
    o[d0]=__builtin_amdgcn_mfma_f32_32x32x16_bf16(pa3,PK(3),o[d0],0,0,0);
    #undef PK
  }
}

struct Params { const bf16* Q; const bf16* K; const bf16* V; bf16* O; const float* subln_w; float lam, post; };
template<int THRL> __device__ __forceinline__ void unit(int b,int h,int qb,const Params&P,char*shm,const bool pre,const bool has_next,const int nb,const int nh,const int nqb){
  int tid_=threadIdx.x; asm volatile("":"+v"(tid_));
  const int tid=tid_,lane=tid&63,r32=lane&31,hi=lane>>5; const int wid=__builtin_amdgcn_readfirstlane(tid>>6);
  const int cmp=wid&1,rbk=wid>>1;
  if(ATTN_PRIO&&wid>=4)__builtin_amdgcn_s_setprio(1);
  const long rowbase=(long)b*SEQ; const int q0=qb*QB;
  const bf16*Qw=P.Q+(rowbase+q0+rbk*QBLK)*DM+h*HDV+cmp*64;
  const bf16*Kh=P.K+rowbase*DM+h*HDV,*Vh=P.V+rowbase*DM+h*HDV;
  const unsigned lds0=(unsigned)(uintptr_t)shm;
  float*wsf=(float*)(shm+LDS_WS)+wid*64;
  const bf16*ksrc=Kh+(long)lane*DM+wid*8;
  const bf16*vsrc=Vh+(long)(16*(wid&3)+(lane>>2))*DM+(wid>>2)*32+(lane&3)*8;
  const unsigned kdst=lds0+LDS_K+wid*1024, vdst=lds0+LDS_V+wid*1024;
  #define DMA_K(t,slot) do{ glds16(ksrc+(long)(t)*KVBLK*DM,(unsigned)__builtin_amdgcn_readfirstlane(kdst+(slot))); glds16(ksrc+(long)(t)*KVBLK*DM+64,(unsigned)__builtin_amdgcn_readfirstlane(kdst+(slot)+8192)); }while(0)
  #define DMA_V(t,slot) do{ glds16(vsrc+(long)(t)*KVBLK*DM,(unsigned)__builtin_amdgcn_readfirstlane(vdst+(slot))); glds16(vsrc+(long)(t)*KVBLK*DM+64,(unsigned)__builtin_amdgcn_readfirstlane(vdst+(slot)+8192)); }while(0)
  const int vb0=(int)(lds0+LDS_V)+((lane>>4)&1)*32+(lane&3)*8+(4*hi+((lane&15)>>2))*64;
  bf16x8 kf[8];
  const lds_cptr shm3=(lds_cptr)shm; const lds_cptr kp0=shm3+LDS_K+(cmp*8+hi)*1024+r32*16; const lds_cptr vp0=shm3+LDS_V+((lane>>4)&1)*32+(lane&3)*8+(4*hi+((lane&15)>>2))*64;
  const char*Kbase=shm+LDS_KX+(cmp*8+hi)*1024+r32*16;
  const unsigned kxdst=lds0+LDS_KX+wid*1024;
  #define DMA_KX(src) do{ glds16((src),(unsigned)__builtin_amdgcn_readfirstlane(kxdst)); glds16((src)+64,(unsigned)__builtin_amdgcn_readfirstlane(kxdst+8192)); }while(0)
  const int NT=(q0+QB)/KVBLK;
  if(!pre){DMA_KX(ksrc);} DMA_V(0,0);DMA_K(1,SLOTB);
  const unsigned qxdst=lds0+LDS_QX+wid*4096;
  #define DMA_Q(Qp) do{ _Pragma("unroll") for(int d0=0;d0<4;++d0)glds16(&(Qp)[(long)r32*DM+d0*16+hi*8],(unsigned)__builtin_amdgcn_readfirstlane(qxdst+d0*1024)); }while(0)
  if(!pre){DMA_Q(Qw);}
  float mhat=0.f,l_reg=0.f;f32x16 o[4];o[0]=f32x16{};o[1]=f32x16{};o[2]=f32x16{};o[3]=f32x16{};const f32x16 zero16=f32x16{};
  const int qrel=rbk*QBLK+r32;
  #define CMASK(P0,P1,t) do{int jb_=(t)-(NT-2); if(jb_>=0)cmask(P0,P1,jb_,qrel,hi);}while(0)
  bool resc=false;
  #define START(P0,P1) do{ const float rm=rowmax(P0,P1); resc=false; \
    { const float dl=rm; mhat=fadd_s(mhat,dl); \
      _Pragma("unroll") for(int r=0;r<16;++r){P0[r]=fsub_s(P0[r],dl);P1[r]=fsub_s(P1[r],dl);} } \
    _Pragma("unroll") for(int r=0;r<16;++r)P0[r]=__builtin_amdgcn_exp2f(P0[r]); }while(0)
  #define RESC() do{ if(resc){ asm volatile("s_waitcnt lgkmcnt(0)":::"memory"); \
      _Pragma("unroll") for(int d_=0;d_<4;++d_) _Pragma("unroll") for(int r=0;r<16;++r)o[d_][r]*=wsf[crow(r,hi)]; } }while(0)
  f32x16 pA0,pA1,pB0,pB1;
  int sl_prev=0,sl_cur=0,sl_next=SLOTB;
  #define ROT() do{sl_prev=sl_cur;sl_cur=sl_next;sl_next=(sl_next==(NSLOT-1)*SLOTB)?0:sl_next+SLOTB;}while(0)
  DMA_K(2,2*SLOTB);
  if(pre){WAIT_BAR(6);}
  else   {WAIT_BAR(2);}
  bf16x8 qr[4];
  #pragma unroll
  for(int d0=0;d0<4;++d0)qr[d0]=*(const __attribute__((address_space(3))) bf16x8*)(shm3+LDS_QX+wid*4096+d0*1024+lane*16);
  SBAR();
  qkt(pA0,pA1,Kbase,qr);asm volatile("s_nop 15\n\ts_nop 7":"+v"(pA0),"+v"(pA1));CMASK(pA0,pA1,0);
  START(pA0,pA1);
  _Pragma("unroll") for(int r=0;r<16;++r)pA1[r]=__builtin_amdgcn_exp2f(pA1[r]);
  WAIT_BAR(0);
  DMA_K(3,0);DMA_V(1,SLOTB);
  ROT();
  kload8(kf,kp0+sl_cur);
  if(NT>2){WAIT_BAR(4);}else{WAIT_BAR(0);}
  s16x4 vlo[4],vhi[4]; u32x4 pw0,pw1,pw2,pw3;
  #define PKW(P,B) cvtpk_s(P[B],P[B+1])
  #define PAF(k) __builtin_bit_cast(bf16x8,pw##k)
  #define VFR(i) (bf16x8){vlo[i][0],vlo[i][1],vlo[i][2],vlo[i][3],vhi[i][0],vhi[i][1],vhi[i][2],vhi[i][3]}
  #define PIN(x) asm volatile("":"+v"(x))
  #define MX3(a,b,c) __builtin_fmaxf(__builtin_fmaxf((a),(b)),(c))
  #define GAPA(MF,A0,A1,A2,A3,W0,W1,PW) do{ MF; sacc+=A0; sacc+=A1; sacc+=A2; sacc+=A3; PIN(sacc); W0; W1; PIN(PW); SBAR(); }while(0)
  #define EX(v) __builtin_amdgcn_exp2f((v)-mhat)
  #define VOFF(f) ((((f)&3)*4096)+(((f)>>2)*1024))
  #define VRD(i,f) do{ vlo[i]=vtr(vp_+VOFF(f)); vhi[i]=vtr(vp_+VOFF(f)+512); }while(0)
  #define GAPB(MF,X,B) do{ MF; X[B]=EX(X[B]); X[B+1]=EX(X[B+1]); PIN(X); SBAR(); }while(0)
  #define GAPBV(MF,X,B,i,f) do{ MF; X[B]=EX(X[B]); X[B+1]=EX(X[B+1]); PIN(X); VRD(i,f); SBAR(); }while(0)
  #define KRD(G,j) do{ if(G){ kload2(kf,kp0+sl_next,j); SBAR(); } }while(0)
  #define PVM(d,k,i) o[d]=__builtin_amdgcn_mfma_f32_32x32x16_bf16(PAF(k),VFR(i),o[d],0,0,0)
  #define STEP(C0,C1,P0,P1,t,GK,GV,GL) do{ SBAR(); \
    const lds_cptr vp_=vp0+sl_prev; \
    float sacc=(P0[0]+P0[1]); \
    GAPA(C0=__builtin_amdgcn_mfma_f32_32x32x16_bf16(kf[0],qr[0],zero16,0,0,0), P0[2],P0[3],P0[4],P0[5],     pw0[0]=PKW(P0,0), pw0[1]=PKW(P0,2), pw0); \
    GAPA(C1=__builtin_amdgcn_mfma_f32_32x32x16_bf16(kf[1],qr[0],zero16,0,0,0), P0[6],P0[7],P0[8],P0[9],     pw0[2]=PKW(P0,4), pw0[3]=PKW(P0,6), pw0); \
    GAPA(C0=__builtin_amdgcn_mfma_f32_32x32x16_bf16(kf[2],qr[1],C0,0,0,0),   P0[10],P0[11],P0[12],P0[13], pw1[0]=PKW(P0,8), pw1[1]=PKW(P0,10), pw1); \
    GAPA(C1=__builtin_amdgcn_mfma_f32_32x32x16_bf16(kf[3],qr[1],C1,0,0,0),   P0[14],P0[15],P1[0],P1[1],   pw1[2]=PKW(P0,12),pw1[3]=PKW(P0,14), pw1); \
    VRD(0,0); SBAR(); GAPA(C0=__builtin_amdgcn_mfma_f32_32x32x16_bf16(kf[4],qr[2],C0,0,0,0),   P1[2],P1[3],P1[4],P1[5],     pw2[0]=PKW(P1,0), pw2[1]=PKW(P1,2), pw2); \
    VRD(1,1); SBAR(); GAPA(C1=__builtin_amdgcn_mfma_f32_32x32x16_bf16(kf[5],qr[2],C1,0,0,0),   P1[6],P1[7],P1[8],P1[9],     pw2[2]=PKW(P1,4), pw2[3]=PKW(P1,6), pw2); \
    VRD(2,2); SBAR(); GAPA(C0=__builtin_amdgcn_mfma_f32_32x32x16_bf16(kf[6],qr[3],C0,0,0,0),   P1[10],P1[11],P1[12],P1[13], pw3[0]=PKW(P1,8), pw3[1]=PKW(P1,10), pw3); \
    VRD(3,3); SBAR(); GAPA(C1=__builtin_amdgcn_mfma_f32_32x32x16_bf16(kf[7],qr[3],C1,0,0,0),   P1[14],P1[15],0.f,0.f,       pw3[2]=PKW(P1,12),pw3[3]=PKW(P1,14), pw3); \
    l_reg+=sacc; \
    if(GK){DMA_K((t)+3,sl_cur);} if(GV){DMA_V((t)+1,sl_next);} \
    CMASK(C0,C1,t); \
    { float a=MX3(C0[0],C0[1],C1[0]),b=MX3(C0[2],C0[3],C1[1]); a=MX3(a,C1[2],C1[3]); \
      _Pragma("unroll") for(int r=4;r<16;r+=4){a=MX3(a,C0[r],C0[r+1]);b=MX3(b,C0[r+2],C0[r+3]);a=MX3(a,C1[r],C1[r+1]);b=MX3(b,C1[r+2],C1[r+3]);} \
      float rm=__builtin_fmaxf(a,b); { auto rr=__builtin_amdgcn_permlane32_swap(__float_as_uint(rm),__float_as_uint(rm),false,false); rm=__builtin_fmaxf(__uint_as_float(rr[0]),__uint_as_float(rr[1])); } \
      rm-=mhat; resc=false; \
      if(__builtin_expect(__any(rm>(float)THRL),0)){ const float dl=__builtin_fmaxf(rm,0.f); mhat+=dl; \
        const float f=__builtin_amdgcn_exp2f(-dl); l_reg*=f; if(hi==0)wsf[r32]=f; resc=true; } } \
    SBAR(); \
    GAPBV(PVM(0,0,0),C0,0, 0,4);  GAPBV(PVM(1,0,1),C0,2, 1,5);  GAPBV(PVM(2,0,2),C0,4, 2,6);  GAPBV(PVM(3,0,3),C0,6, 3,7); \
    GAPBV(PVM(0,1,0),C0,8, 0,8);  GAPBV(PVM(1,1,1),C0,10,1,9);  GAPBV(PVM(2,1,2),C0,12,2,10); GAPBV(PVM(3,1,3),C0,14,3,11); \
    KRD(GL,0); GAPBV(PVM(0,2,0),C1,0, 0,12); KRD(GL,1); GAPBV(PVM(1,2,1),C1,2, 1,13); KRD(GL,2); GAPBV(PVM(2,2,2),C1,4, 2,14); KRD(GL,3); GAPBV(PVM(3,2,3),C1,6, 3,15); \
    GAPB(PVM(0,3,0),C1,8); GAPB(PVM(1,3,1),C1,10); GAPB(PVM(2,3,2),C1,12); GAPB(PVM(3,3,3),C1,14); \
    }while(0)
  int t=1;
  #undef CMASK
  #define CMASK(P0,P1,t) do{}while(0)
  for(;t+3<NT;t+=2){
    STEP(pB0,pB1,pA0,pA1,t,true,true,true);     WAIT_BAR(4); RESC(); ROT();
    STEP(pA0,pA1,pB0,pB1,t+1,true,true,true);   WAIT_BAR(4); RESC(); ROT();
  }
  #undef CMASK
  #define CMASK(P0,P1,t) do{int jb_=(t)-(NT-2); if(jb_>=0)cmask(P0,P1,jb_,qrel,hi);}while(0)
  #define ENDW(tt) do{ if((tt)+3<NT){WAIT_BAR(4);} else if((tt)+2<NT){WAIT_BAR(2);} else {WAIT_BAR(0);} }while(0)
  for(;t+1<NT;t+=2){
    STEP(pB0,pB1,pA0,pA1,t,(t+3<NT),(t+1<NT),(t+1<NT));       ENDW(t);   RESC(); ROT();
    STEP(pA0,pA1,pB0,pB1,t+1,(t+4<NT),(t+2<NT),(t+2<NT));     ENDW(t+1); RESC(); ROT();
  }
  STEP(pB0,pB1,pA0,pA1,NT-1,false,false,false); RESC();
  typedef float f32x4_t __attribute__((ext_vector_type(4)));
  const f32x4_t wa=*(const __attribute__((address_space(3))) f32x4_t*)(shm3+LDS_SW+(lane&15)*32), wb=*(const __attribute__((address_space(3))) f32x4_t*)(shm3+LDS_SW+(lane&15)*32+16);
  if(has_next){ const long rbn=(long)nb*SEQ; const bf16*ksn=P.K+rbn*DM+nh*HDV+(long)lane*DM+wid*8; DMA_KX(ksn);
    const bf16*Qn=P.Q+(rbn+nqb*QB+rbk*QBLK)*DM+nh*HDV+cmp*64;
    DMA_Q(Qn); }
  { float sacc=pB0[0]+pB0[1]; _Pragma("unroll") for(int r=2;r<16;++r)sacc+=pB0[r]; _Pragma("unroll") for(int r=0;r<16;++r)sacc+=pB1[r]; l_reg+=sacc;
    pw0=(u32x4){PKW(pB0,0),PKW(pB0,2),PKW(pB0,4),PKW(pB0,6)};pw1=(u32x4){PKW(pB0,8),PKW(pB0,10),PKW(pB0,12),PKW(pB0,14)};pw2=(u32x4){PKW(pB1,0),PKW(pB1,2),PKW(pB1,4),PKW(pB1,6)};pw3=(u32x4){PKW(pB1,8),PKW(pB1,10),PKW(pB1,12),PKW(pB1,14)};
    SBAR(); pv(o,vb0+sl_cur,PAF(0),PAF(1),PAF(2),PAF(3)); }
  #undef PKW
  #undef PAF
  #undef VFR
  #undef PIN
  #undef MX3
  #undef GAPA
  #undef GAPB
  #undef GAPBV
  #undef EX
  #undef VOFF
  #undef VRD
  #undef KRD
  #undef PVM
  #undef STEP
  #undef ENDW
  {auto rr=__builtin_amdgcn_permlane32_swap(__float_as_uint(l_reg),__float_as_uint(l_reg),false,false);l_reg=__uint_as_float(rr[0])+__uint_as_float(rr[1]);}
  if(hi==0)wsf[32+r32]=l_reg;asm volatile("s_waitcnt lgkmcnt(0)":::"memory");
  float rli[16];
  #pragma unroll
  for(int r=0;r<16;++r)rli[r]=__builtin_amdgcn_rcpf(wsf[32+crow(r,hi)]);
  asm volatile("s_waitcnt lgkmcnt(0)\n\ts_barrier":::"memory");
  { bf16*stg=(bf16*)(shm)+wid*4096;
    #pragma unroll
    for(int r=0;r<16;++r){const int orow=crow(r,hi);
      #pragma unroll
      for(int d0=0;d0<4;++d0)stg[orow*128+d0*32+r32]=__float2bfloat16(o[d0][r]*rli[r]);} }
  asm volatile("s_waitcnt lgkmcnt(0)\n\ts_barrier":::"memory");
  { const bf16*s0=(const bf16*)(shm)+(wid&~1)*4096; const bf16*s1=s0+4096;
    bf16*Ow=P.O+(rowbase+q0+rbk*QBLK)*DM+h*HDV; const int ch=lane&15;
    #pragma unroll
    for(int i=0;i<4;++i){ const int row=16*cmp+4*i+(lane>>4);
      const u32x4 a=*(const u32x4*)(s0+row*128+ch*8), bq=*(const u32x4*)(s1+row*128+ch*8);
      float d[8];
      #pragma unroll
      for(int k=0;k<4;++k){ const unsigned ua=a[k],ub=bq[k];
        d[2*k]=__uint_as_float(ua<<16)-P.lam*__uint_as_float(ub<<16); d[2*k+1]=__uint_as_float(ua&0xffff0000u)-P.lam*__uint_as_float(ub&0xffff0000u); }
      float s=0.f;
      #pragma unroll
      for(int k=0;k<8;++k)s+=d[k]*d[k];
      s+=__shfl_xor(s,1);s+=__shfl_xor(s,2);s+=__shfl_xor(s,4);s+=__shfl_xor(s,8);
      const float rs=P.post*__builtin_amdgcn_rsqf(s*(1.f/128.f)+1e-5f);
      u32x4 w; w[0]=cvtpk_s(d[0]*rs*wa[0],d[1]*rs*wa[1]); w[1]=cvtpk_s(d[2]*rs*wa[2],d[3]*rs*wa[3]); w[2]=cvtpk_s(d[4]*rs*wb[0],d[5]*rs*wb[1]); w[3]=cvtpk_s(d[6]*rs*wb[2],d[7]*rs*wb[3]);
      *(__attribute__((address_space(1))) u32x4*)(Ow+(long)row*DM+ch*8)=w; } }
  asm volatile("s_waitcnt lgkmcnt(0)\n\ts_barrier":::"memory");
  if(ATTN_PRIO&&wid>=4)__builtin_amdgcn_s_setprio(0);
  #undef DMA_K
  #undef DMA_KX
  #undef DMA_Q
  #undef DMA_V
  #undef CMASK
  #undef START
  #undef RESC
  #undef ROT
}
constexpr int ATTN_LDS_BYTES=LDS_BYTES;
template<int THRL=8> __device__ __forceinline__ void phase(char*lds,const Params&P,int grid,int block){
  const int vcu=(grid%8==0)?(block%8)*(grid/8)+block/8:block;
#if ATTN_SHARE8 == 1
  if(threadIdx.x<128)((float*)(lds+LDS_SW))[threadIdx.x]=P.subln_w[threadIdx.x];
  __syncthreads();
  for(int v=vcu;v<256;v+=grid){ const int grp=v>>3,k=v&7;
    for(int idx=0;idx<16;++idx){ const int bh=grp*4+(idx>>2),i=idx&3; const int qb=(i==0)?31-k:(i==1)?k:(i==2)?16+k:15-k;
      const int nx=idx+1,bhn=grp*4+((nx>>2)&3),in_=nx&3; const int qbn=(in_==0)?31-k:(in_==1)?k:(in_==2)?16+k:15-k;
      unit<THRL>(bh>>4,bh&15,qb,P,lds,idx>0,nx<16,bhn>>4,bhn&15,qbn); } }
#elif ATTN_SHARE8 == 2
  for(int v=vcu;v<256;v+=grid){ const int grp=v>>5,k=v&31;
    for(int w=0;w<16;++w){ const int bh=grp*16+w; const int qb=(w&1)?31-k:k; unit<THRL>(bh>>4,bh&15,qb,P,lds); } }
#elif ATTN_SHARE8 == 3
  for(int v=vcu;v<256;v+=grid){ const int grp=v>>4,k=v&15;
    for(int w=0;w<8;++w){ const int bh=grp*8+w;
      for(int i=0;i<2;++i){ const int qb=(i==0)?31-k:k; unit<THRL>(bh>>4,bh&15,qb,P,lds); } } }
#else
  for(int v=vcu;v<256;v+=grid){ const int bh=v>>1,p=v&1;
    for(int i=0;i<16;++i){ const int s=2*(i>>1)+p; const int qb=(i&1)?31-s:s; unit<THRL>(bh>>4,bh&15,qb,P,lds); } }
#endif
}
#undef SBAR
#undef WAIT_BAR
}
constexpr int NWAVES = 8;
#ifndef MK_PER_PHASE
#define MK_PER_PHASE 0
#endif

constexpr int BATCH = 8, SEQ = 4096, DMODEL = 2048, MROWS = BATCH * SEQ, DFF = 8192, NHEADS = 16, HD = 128;
constexpr int GDN_PROJ = 8224, GDN_MAIN = 8192, CONVC = 6144, NCG = MROWS / 64;
constexpr float ALPHA_RES = 1.6817928305074292f;
constexpr float LN_EPS = 1e-5f, GDN_EPS = 1e-6f, SUBLN_EPS = 1e-5f;
constexpr int N_PHASES = 39;

constexpr size_t MiB = 1u << 20;
constexpr size_t WS_CTL = 0, CTL_ZERO_BYTES = 1 * MiB;
constexpr size_t WS_ONES = 1 * MiB, WS_ZEROS = WS_ONES + 8192, WS_MU = WS_ONES + 65536, WS_RSTD = WS_MU + 131072;
constexpr size_t WS_BETA = 2 * MiB, WS_G = 4 * MiB;
constexpr size_t WS_HALO = 9 * MiB;
constexpr size_t WS_WA = 27 * MiB, WS_WB = 60 * MiB;
constexpr size_t WS_ATTN = 27 * MiB;
constexpr size_t WS_XB = 92 * MiB;
constexpr size_t WS_Y = 220 * MiB;
constexpr size_t WS_R1 = 476 * MiB;
constexpr size_t WS_END = 988 * MiB;
constexpr size_t QTR = 128 * MiB;
constexpr int CW_TMO = 0;
constexpr int CW_BAR = 4096;

constexpr int LDS_BYTES_C = 151552;
constexpr int RING_OFF = 0, RING_BYTES = 131072;
constexpr int LDSCTL_OFF = LDS_BYTES_C - 512, MISC_OFF = LDSCTL_OFF + 320;
constexpr int LDS_BYTES = LDS_BYTES_C;
static_assert(MISC_OFF + 128 <= LDS_BYTES, "LDS map");

#define GAS __attribute__((address_space(1)))
#define LAS __attribute__((address_space(3)))
typedef unsigned short bf16;
typedef unsigned v4u __attribute__((ext_vector_type(4)));
typedef unsigned v2u __attribute__((ext_vector_type(2)));
typedef float f32x4 __attribute__((ext_vector_type(4)));
typedef float f32x16 __attribute__((ext_vector_type(16)));
typedef short bf16x8 __attribute__((ext_vector_type(8)));
typedef GAS unsigned gu32;
typedef GAS unsigned long long gu64;
#define RLX_AGENT __ATOMIC_RELAXED, __HIP_MEMORY_SCOPE_AGENT
#define LDS_WAIT() asm volatile("s_waitcnt lgkmcnt(0)" ::: "memory")
#define VM_WAIT() asm volatile("s_waitcnt vmcnt(0)" ::: "memory")
#define WG_BAR() asm volatile("s_waitcnt lgkmcnt(0)\n\ts_barrier" ::: "memory")
typedef float f32x2_t_ __attribute__((ext_vector_type(2))); typedef __bf16 bf16x2_t_ __attribute__((ext_vector_type(2)));
__device__ __forceinline__ unsigned pk2(float lo, float hi) { f32x2_t_ v = {lo, hi}; bf16x2_t_ b = __builtin_convertvector(v, bf16x2_t_); return __builtin_bit_cast(unsigned, b); }
__device__ __forceinline__ unsigned f2bf(float f) { return pk2(f, 0.f) & 0xffffu; }
__device__ __forceinline__ float bflo(unsigned w) { return __builtin_bit_cast(float, w << 16); }
__device__ __forceinline__ float bfhi(unsigned w) { return __builtin_bit_cast(float, w & 0xffff0000u); }
__device__ __forceinline__ float bf2f(bf16 h) { return __builtin_bit_cast(float, (unsigned)h << 16); }
__device__ __forceinline__ float fast_exp(float x) { return __builtin_amdgcn_exp2f(x * 1.4426950408889634f); }
__device__ __forceinline__ float silu_f(float x) { return x * __builtin_amdgcn_rcpf(1.f + __expf(-x)); }

#define XB_TMO      128
#define XB_XCNT(j)  (256  + 64 * (j))
#define XB_XSUB(j)  (1280 + 64 * (j))
#define XB_XGEN(j)  (2304 + 64 * (j))
#define XB_TOP      3328
#define XB_TOPGEN   3392
#define XCD_BAR_WORDS 3456
#define XB_SPIN_CAP (1u << 18)

__device__ __forceinline__ unsigned xb_ld(unsigned* p)              { return __hip_atomic_load(p, __ATOMIC_RELAXED, __HIP_MEMORY_SCOPE_AGENT); }
__device__ __forceinline__ unsigned xb_add(unsigned* p, unsigned v) { return __hip_atomic_fetch_add(p, v, __ATOMIC_RELAXED, __HIP_MEMORY_SCOPE_AGENT); }
__device__ __forceinline__ unsigned xb_xcc_id() { return (unsigned)__builtin_amdgcn_s_getreg((3 << 11) | 20) & 0xFu; }
#define XB_SPIN(cond, bar) do { unsigned _sp = 0; while (cond) { __builtin_amdgcn_s_sleep(1); \
    if ((++_sp & 255u) == 0u) { if (xb_ld(&(bar)[XB_TMO])) break; if (_sp > XB_SPIN_CAP) { atomicAdd(&(bar)[XB_TMO], 1u); break; } } } } while (0)

struct XcdBarrier {
    unsigned* bar; unsigned x;
    volatile LAS unsigned* st;
};
__device__ __forceinline__ XcdBarrier xcd_barrier_post(unsigned* bar, volatile LAS unsigned* st) {
    XcdBarrier b; b.bar = bar; b.x = xb_xcc_id(); b.st = st;
    if (threadIdx.x == 0) (void)xb_add(&bar[XB_XCNT(b.x)], 1u);
    return b;
}
__device__ __forceinline__ void xcd_barrier_complete(unsigned* bar, unsigned x, unsigned& nloc, unsigned& nx) {
    const unsigned G = gridDim.x * gridDim.y * gridDim.z;
    unsigned sum, cnt, mine, sp = 0u;
    for (;;) {
        sum = 0u; cnt = 0u; mine = 0u;
#pragma unroll
        for (unsigned j = 0; j < 16; ++j) { const unsigned c = xb_ld(&bar[XB_XCNT(j)]); sum += c; cnt += (c > 0u) ? 1u : 0u; mine = (j == x) ? c : mine; }
        if (sum == G) break;
        __builtin_amdgcn_s_sleep(1);
        if ((++sp & 255u) == 0u) { if (xb_ld(&bar[XB_TMO])) break; if (sp > XB_SPIN_CAP) { atomicAdd(&bar[XB_TMO], 1u); break; } }
    }
    nloc = mine > 0u ? mine : 1u; nx = cnt > 0u ? cnt : 1u;
}
__device__ __forceinline__ void xcd_barrier(const XcdBarrier& b) {
    asm volatile("s_waitcnt vmcnt(0)" ::: "memory");
    __syncthreads();
    if (threadIdx.x == 0) {
        unsigned* bar = b.bar;
        __builtin_amdgcn_s_waitcnt(0);
        unsigned nloc = b.st[0], nx = b.st[1];
        if (nloc == 0u) { xcd_barrier_complete(bar, b.x, nloc, nx); b.st[0] = nloc; b.st[1] = nx; }
        const unsigned old = xb_add(&bar[XB_XSUB(b.x)], 1u);
        const unsigned gen = old / nloc;
        if (old + 1u == (gen + 1u) * nloc) {
            __builtin_amdgcn_fence(__ATOMIC_RELEASE, "agent");
            asm volatile("s_waitcnt vmcnt(0)" ::: "memory");
            const unsigned og = xb_add(&bar[XB_TOP], 1u);
            const unsigned tg = og / nx;
            if (og + 1u == (tg + 1u) * nx) xb_add(&bar[XB_TOPGEN], 1u);
            else XB_SPIN(xb_ld(&bar[XB_TOPGEN]) == tg, bar);
            __builtin_amdgcn_fence(__ATOMIC_ACQUIRE, "agent");
            xb_add(&bar[XB_XGEN(b.x)], 1u);
            asm volatile("s_waitcnt vmcnt(0)" ::: "memory");
        } else {
            XB_SPIN(xb_ld(&bar[XB_XGEN(b.x)]) == gen, bar);
            __builtin_amdgcn_fence(__ATOMIC_ACQUIRE, "agent");
            asm volatile("s_waitcnt vmcnt(0)" ::: "memory");
        }
    }
    __syncthreads();
}

__device__ __forceinline__ float wave_sum(float v) {
#pragma unroll
    for (int o = 1; o < 64; o <<= 1) v += __shfl_xor(v, o);
    return v;
}
__device__ __forceinline__ float sum16(float v) {
    v += __shfl_xor(v, 1); v += __shfl_xor(v, 2); v += __shfl_xor(v, 4); v += __shfl_xor(v, 8); return v;
}
__device__ __forceinline__ void transpose_item(const float* W, int K, int ldw, int n_begin, int nblk, bf16* WT, int row_off, LAS float* scr, int item, int lane) {
    const int kb = item / nblk, nb = item % nblk, k0 = 64 * kb, n0 = 32 * nb;
    float wv[32];
#pragma unroll
    for (int i = 0; i < 32; ++i) wv[i] = ((const GAS float*)W)[(size_t)(k0 + 2 * i + (lane >> 5)) * ldw + n_begin + n0 + (lane & 31)];
#pragma unroll
    for (int i = 0; i < 32; ++i) scr[(2 * i + (lane >> 5)) * 33 + (lane & 31)] = wv[i];
    LDS_WAIT(); asm volatile("" ::: "memory");
    const int c = lane & 7;
#pragma unroll
    for (int j = 0; j < 4; ++j) { const int n = (lane >> 3) + 8 * j; const LAS float* s = scr + (8 * c) * 33 + n;
        v4u o; o.x = pk2(s[0 * 33], s[1 * 33]); o.y = pk2(s[2 * 33], s[3 * 33]); o.z = pk2(s[4 * 33], s[5 * 33]); o.w = pk2(s[6 * 33], s[7 * 33]);
        *(GAS v4u*)(WT + (size_t)(row_off + n0 + n) * K + k0 + 8 * c) = o; }
    LDS_WAIT(); asm volatile("" ::: "memory");
}
__device__ __forceinline__ void convert_w(LAS unsigned char* lds, int gw, int NGW, int wave, int lane, const float* W, int K, int ldw, int n_begin, int ncols, bf16* WT, int row_off) {
    LAS float* scr = (LAS float*)(lds + RING_OFF + wave * 16384);
    const int nblk = ncols / 32, nitems = (K / 64) * nblk;
    for (int it = gw; it < nitems; it += NGW) transpose_item(W, K, ldw, n_begin, nblk, WT, row_off, scr, it, lane);
}
__device__ __forceinline__ void row_to_bf16(const float* xrow, bf16* orow, int lane) {
    const GAS f32x4* xr = (const GAS f32x4*)xrow + lane; GAS v2u* o8 = (GAS v2u*)orow + lane;
#pragma unroll
    for (int j = 0; j < 8; ++j) { const f32x4 v = xr[64 * j]; v2u w; w.x = pk2(v.x, v.y); w.y = pk2(v.z, v.w); o8[64 * j] = w; }
}
__device__ __forceinline__ void ln_pass_b(const bf16* xb_in, const bf16* hb, const float* g, const float* b, bf16* xb_out, float* outf, float alpha, int gw, int NGW, int lane) {
    const GAS f32x4* gr = (const GAS f32x4*)g + 2 * lane; const GAS f32x4* br = (const GAS f32x4*)b + 2 * lane;
    for (int m = gw; m < MROWS; m += 2 * NGW) {
        const int m1 = (m + NGW < MROWS) ? m + NGW : m;
        const GAS v4u* x0 = (const GAS v4u*)(xb_in + (size_t)m * DMODEL) + lane; const GAS v4u* x1 = (const GAS v4u*)(xb_in + (size_t)m1 * DMODEL) + lane;
        const GAS v4u* h0 = (const GAS v4u*)(hb + (size_t)m * DMODEL) + lane;   const GAS v4u* h1 = (const GAS v4u*)(hb + (size_t)m1 * DMODEL) + lane;
        v4u xa[4], xc[4], ha[4], hc[4];
#pragma unroll
        for (int j = 0; j < 4; ++j) { xa[j] = x0[64 * j]; xc[j] = x1[64 * j]; ha[j] = h0[64 * j]; hc[j] = h1[64 * j]; }
        float y0[32], y1[32]; float s0 = 0.f, s1 = 0.f;
#pragma unroll
        for (int j = 0; j < 4; ++j)
#pragma unroll
            for (int k = 0; k < 4; ++k) { y0[8 * j + 2 * k] = alpha * bflo(xa[j][k]) + bflo(ha[j][k]); y0[8 * j + 2 * k + 1] = alpha * bfhi(xa[j][k]) + bfhi(ha[j][k]);
                                          y1[8 * j + 2 * k] = alpha * bflo(xc[j][k]) + bflo(hc[j][k]); y1[8 * j + 2 * k + 1] = alpha * bfhi(xc[j][k]) + bfhi(hc[j][k]); }
#pragma unroll
        for (int k = 0; k < 32; ++k) { s0 += y0[k]; s1 += y1[k]; }
#pragma unroll
        for (int o = 1; o < 64; o <<= 1) { s0 += __shfl_xor(s0, o); s1 += __shfl_xor(s1, o); }
        const float mean0 = s0 * (1.f / DMODEL), mean1 = s1 * (1.f / DMODEL); float q0 = 0.f, q1 = 0.f;
#pragma unroll
        for (int k = 0; k < 32; ++k) { y0[k] -= mean0; y1[k] -= mean1; q0 += y0[k] * y0[k]; q1 += y1[k] * y1[k]; }
#pragma unroll
        for (int o = 1; o < 64; o <<= 1) { q0 += __shfl_xor(q0, o); q1 += __shfl_xor(q1, o); }
        const float rs0 = 1.f / sqrtf(q0 * (1.f / DMODEL) + LN_EPS), rs1 = 1.f / sqrtf(q1 * (1.f / DMODEL) + LN_EPS);
#pragma unroll
        for (int j = 0; j < 4; ++j) { const f32x4 ga = gr[128 * j], gb = gr[128 * j + 1], ba = br[128 * j], bb = br[128 * j + 1];
            float o0[8], o1[8];
#pragma unroll
            for (int k = 0; k < 8; ++k) { const float gg = k < 4 ? ga[k] : gb[k - 4], bv = k < 4 ? ba[k] : bb[k - 4]; o0[k] = y0[8 * j + k] * rs0 * gg + bv; o1[k] = y1[8 * j + k] * rs1 * gg + bv; }
            if (xb_out) { v4u w0, w1; w0.x = pk2(o0[0], o0[1]); w0.y = pk2(o0[2], o0[3]); w0.z = pk2(o0[4], o0[5]); w0.w = pk2(o0[6], o0[7]); w1.x = pk2(o1[0], o1[1]); w1.y = pk2(o1[2], o1[3]); w1.z = pk2(o1[4], o1[5]); w1.w = pk2(o1[6], o1[7]);
                ((GAS v4u*)(xb_out + (size_t)m * DMODEL) + lane)[64 * j] = w0; ((GAS v4u*)(xb_out + (size_t)m1 * DMODEL) + lane)[64 * j] = w1; }
            if (outf) { GAS f32x4* p0 = (GAS f32x4*)(outf + (size_t)m * DMODEL) + 2 * lane + 128 * j; GAS f32x4* p1 = (GAS f32x4*)(outf + (size_t)m1 * DMODEL) + 2 * lane + 128 * j;
                p0[0] = (f32x4){o0[0], o0[1], o0[2], o0[3]}; p0[1] = (f32x4){o0[4], o0[5], o0[6], o0[7]}; p1[0] = (f32x4){o1[0], o1[1], o1[2], o1[3]}; p1[1] = (f32x4){o1[4], o1[5], o1[6], o1[7]}; } }
    }
}
#define MFMA32(a, b, c) __builtin_amdgcn_mfma_f32_32x32x16_bf16((a), (b), (c), 0, 0, 0)

__device__ __forceinline__ void ba_proj(LAS unsigned char* lds, const bf16* xb, const bf16* wt  , const float* a_log, const float* dt_bias, float* beta, float* g, int gw, int NGW, int lane) {
    const int r32 = lane & 31, hi = lane >> 5, half = gw & 1, NP = NGW >> 1;
    LAS float* xch = (LAS float*)lds + ((gw >> 1) & 3) * 1024;
    for (int wu0 = 0; wu0 < MROWS / 32; wu0 += NP) {
        const int wu = wu0 + (gw >> 1); const bool valid = wu < MROWS / 32;
        f32x16 acc = {};
        if (valid) {
            const GAS bf16* ap = (const GAS bf16*)xb + (size_t)(wu * 32 + r32) * DMODEL + half * (DMODEL / 2) + 8 * hi; const GAS bf16* bp = (const GAS bf16*)wt + (size_t)(GDN_MAIN + r32) * DMODEL + half * (DMODEL / 2) + 8 * hi;
#pragma unroll 1
            for (int s0 = 0; s0 < DMODEL / 32; s0 += 8) {
                bf16x8 a[8], b[8];
#pragma unroll
                for (int s = 0; s < 8; ++s) { a[s] = *(const GAS bf16x8*)(ap + (s0 + s) * 16); b[s] = *(const GAS bf16x8*)(bp + (s0 + s) * 16); }
#pragma unroll
                for (int s = 0; s < 8; ++s) acc = MFMA32(a[s], b[s], acc);
            }
            if (half) {
#pragma unroll
                for (int r = 0; r < 16; ++r) xch[r * 64 + lane] = acc[r];
            }
        }
        __syncthreads();
        if (valid && !half) {
            const int j = r32 & 15; const float al = -__expf(((const GAS float*)a_log)[j]), db = ((const GAS float*)dt_bias)[j]; GAS float* betag = (GAS float*)beta; GAS float* gg_ = (GAS float*)g;
#pragma unroll
            for (int r = 0; r < 16; ++r) { const int t = wu * 32 + (r & 3) + 8 * (r >> 2) + 4 * hi; const float v = acc[r] + xch[r * 64 + lane];
                if (r32 < 16) betag[(size_t)t * 16 + j] = __builtin_amdgcn_rcpf(1.f + __expf(-v));
                else { const float z = v + db; const float sp = z > 20.f ? z : log1pf(__expf(z)); gg_[(size_t)t * 16 + j] = al * sp; } }
        }
        __syncthreads();
    }
}

#ifndef G2_SKIP
#define G2_SKIP 0
#endif
#ifndef PROBE_G2_NOSCAT
#define PROBE_G2_NOSCAT 0
#endif
typedef short bf16x4 __attribute__((ext_vector_type(4)));
#define MFMA16K16(a, b, c) __builtin_amdgcn_mfma_f32_16x16x16bf16_1k((a), (b), (c), 0, 0, 0)
constexpr int G2_TS = 136;
constexpr int G2_AS = 68, G2_ANS = 72, G2_US = 68;
constexpr int G2_A = 0, G2_GC = G2_A + 64 * G2_AS * 4, G2_BT = G2_GC + 256, G2_AN = G2_BT + 256, G2_TB = G2_AN + 64 * G2_ANS * 2, G2_Q = G2_TB + 2048, G2_K = G2_Q + 64 * G2_TS * 2, G2_V = G2_K + 64 * G2_TS * 2,
              G2_W = G2_V + 64 * G2_TS * 2, G2_END = G2_W + 64 * G2_TS * 2;
static_assert(G2_END <= RING_BYTES, "G2 LDS");
__device__ __forceinline__ bf16x4 pack4(f32x4 v) { v2u w; w.x = pk2(v[0], v[1]); w.y = pk2(v[2], v[3]); return __builtin_bit_cast(bf16x4, w); }
__device__ __forceinline__ void gdn_chunk_phase(LAS unsigned char* lds, bf16* p_, const bf16* halo_, const float* beta_, float* g_, bf16* wbuf_, bf16* attn_, const float* conv_w_, int vcu, int G, bf16* palt_ = nullptr) {
#define G2_ST(off) ((palt ? palt + ((size_t)(off) & 0x7ffffffull) : p + (size_t)(off)))
    int tid_ = threadIdx.x; asm volatile("" : "+v"(tid_));
    const int tid0 = tid_, lane0 = tid0 & 63, wid0 = __builtin_amdgcn_readfirstlane(tid0 >> 6);
    GAS bf16* const p = (GAS bf16*)p_; const GAS bf16* const halo = (const GAS bf16*)halo_; const GAS float* const beta = (const GAS float*)beta_; GAS float* const g = (GAS float*)g_;
    GAS bf16* const wbuf = (GAS bf16*)wbuf_; GAS bf16* const attn = (GAS bf16*)attn_; const GAS float* const conv_w = (const GAS float*)conv_w_; GAS bf16* const palt = (GAS bf16*)palt_;
    LAS bf16* Qs = (LAS bf16*)(lds + G2_Q); LAS bf16* Ks = (LAS bf16*)(lds + G2_K); LAS bf16* Vs = (LAS bf16*)(lds + G2_V); LAS bf16* Ws = (LAS bf16*)(lds + G2_W);
    LAS float* As = (LAS float*)(lds + G2_A); LAS float* gcs = (LAS float*)(lds + G2_GC); LAS float* bts = (LAS float*)(lds + G2_BT);
    LAS bf16* An = (LAS bf16*)(lds + G2_AN); LAS bf16* Tb = (LAS bf16*)(lds + G2_TB); LAS bf16* Us = (LAS bf16*)(lds + G2_A);
    asm volatile("" : "+v"(Qs), "+v"(Ks), "+v"(Vs), "+v"(Ws), "+v"(As), "+v"(gcs), "+v"(bts), "+v"(An), "+v"(Tb), "+v"(Us));
    v4u rawv[3][5]; float gpre = 0.f, bpre = 0.f;
#define G2_LOAD_RAW(uu, LN, WD) do { const int cg_ = (uu) >> 4, h_ = (uu) & 15, n_ = cg_ & 63; const size_t r0_ = (size_t)cg_ * 64; const int cgp_l = (LN) & 15, tA_l = 8 * (WD) + 2 * ((LN) >> 4); \
        _Pragma("unroll") for (int X = 0; X < 3; ++X) { const int col_ = X * 2048 + h_ * HD + 8 * cgp_l; \
            _Pragma("unroll") for (int rr = 0; rr < 5; ++rr) { const int rel = tA_l - 3 + rr; v4u v = {0u, 0u, 0u, 0u}; \
                if (rel >= 0) v = *(const GAS v4u*)(p + (r0_ + rel) * GDN_MAIN + col_); \
                else if (n_ > 0) v = *(const GAS v4u*)(halo + ((size_t)(cg_ - 1) * 3 + (rel + 3)) * CONVC + col_); \
                rawv[X][rr] = v; } } \
        if ((WD) == 0) { gpre = g[(r0_ + (LN)) * 16 + h_]; bpre = beta[(r0_ + (LN)) * 16 + h_]; } } while (0)
    if (vcu < NCG * NHEADS) G2_LOAD_RAW(vcu, lane0, wid0);
    for (int u = vcu; u < NCG * NHEADS; u += G) {
        const int cg = u >> 4, h = u & 15; const size_t row0 = (size_t)cg * 64;
        int tl_ = tid0; asm volatile("" : "+v"(tl_));
        const int tid = tl_, lane = tid & 63, wid = __builtin_amdgcn_readfirstlane(tid >> 6), r32 = lane & 31, hi = lane >> 5;
        {
            const int cgp = lane & 15, sub = lane >> 4, tA = 8 * wid + 2 * sub;
#pragma unroll
            for (int X = 0; X < 3; ++X) {
                const int col = X * 2048 + h * HD + 8 * cgp;
                float raw[5][8];
                asm volatile("" : "+v"(rawv[X][0]), "+v"(rawv[X][1]), "+v"(rawv[X][2]), "+v"(rawv[X][3]), "+v"(rawv[X][4]));
#pragma unroll
                for (int rr = 0; rr < 5; ++rr) { const v4u v = rawv[X][rr];
                    raw[rr][0] = bflo(v.x); raw[rr][1] = bfhi(v.x); raw[rr][2] = bflo(v.y); raw[rr][3] = bfhi(v.y); raw[rr][4] = bflo(v.z); raw[rr][5] = bfhi(v.z); raw[rr][6] = bflo(v.w); raw[rr][7] = bfhi(v.w); }
                float o0[8], o1[8];
#pragma unroll
                for (int c = 0; c < 8; ++c) { o0[c] = 0.f; o1[c] = 0.f; }
#pragma unroll
                for (int j = 0; j < 4; ++j) { const f32x4 wa = *(const GAS f32x4*)(conv_w + (size_t)j * CONVC + col), wb = *(const GAS f32x4*)(conv_w + (size_t)j * CONVC + col + 4);
#pragma unroll
                    for (int c = 0; c < 8; ++c) { const float w = c < 4 ? wa[c] : wb[c - 4]; o0[c] += w * raw[j][c]; o1[c] += w * raw[j + 1][c]; } }
                float s0 = 0.f, s1 = 0.f;
#pragma unroll
                for (int c = 0; c < 8; ++c) { o0[c] = silu_f(o0[c]); o1[c] = silu_f(o1[c]); s0 += o0[c] * o0[c]; s1 += o1[c] * o1[c]; }
                if (X < 2) { s0 = sum16(s0); s1 = sum16(s1); const float sc = X == 0 ? 0.08838834764831845f : 1.f; const float f0 = sc * __builtin_amdgcn_rsqf(s0 + GDN_EPS), f1 = sc * __builtin_amdgcn_rsqf(s1 + GDN_EPS);
#pragma unroll
                    for (int c = 0; c < 8; ++c) { o0[c] *= f0; o1[c] *= f1; } }
                LAS bf16* T = X == 0 ? Qs : (X == 1 ? Ks : Vs);
                v4u w0, w1; w0.x = pk2(o0[0], o0[1]); w0.y = pk2(o0[2], o0[3]); w0.z = pk2(o0[4], o0[5]); w0.w = pk2(o0[6], o0[7]);
                w1.x = pk2(o1[0], o1[1]); w1.y = pk2(o1[2], o1[3]); w1.z = pk2(o1[4], o1[5]); w1.w = pk2(o1[6], o1[7]);
                *(LAS v4u*)(T + tA * G2_TS + 8 * cgp) = w0; *(LAS v4u*)(T + (tA + 1) * G2_TS + 8 * cgp) = w1;
                asm volatile("" ::: "memory");
            }
            if (wid == 0) {
                float gv = gpre;
#pragma unroll
                for (int o = 1; o < 64; o <<= 1) { const float t = __shfl_up(gv, o); if (lane >= o) gv += t; }
                gcs[lane] = gv; bts[lane] = bpre; if (!palt) g[(row0 + lane) * 16 + h] = gv;
            }
        }
        __syncthreads();
        if (u + G < NCG * NHEADS) G2_LOAD_RAW(u + G, lane, wid);
        if (!((G2_SKIP & 4) && palt)) {
            const int rb = (wid >> 1) & 1, cb = wid & 1; const bool isA = wid < 4;
            f32x16 acc = {};
            if (!(rb == 0 && cb == 1)) {
                const LAS bf16* Ar = (isA ? Ks : Qs) + (32 * rb + r32) * G2_TS + 8 * hi; const LAS bf16* Br = Ks + (32 * cb + r32) * G2_TS + 8 * hi;
#pragma unroll
                for (int s = 0; s < 8; ++s) acc = MFMA32(*(const LAS bf16x8*)(Ar + 16 * s), *(const LAS bf16x8*)(Br + 16 * s), acc);
            }
            const int j = 32 * cb + r32; const float gj = gcs[j];
#pragma unroll
            for (int r = 0; r < 16; ++r) { const int i = 32 * rb + (r & 3) + 8 * (r >> 2) + 4 * hi; const float gi = gcs[i];
                if (isA) { const float d = (i > j) ? __expf(gi - gj) : 0.f; const float a = (i > j) ? bts[i] * acc[r] * d : 0.f; As[i * G2_AS + j] = a; An[i * G2_ANS + j] = (bf16)f2bf(-a); }
                else { const float d = (i >= j) ? __expf(gi - gj) : 0.f; Ws[i * G2_TS + j] = (bf16)f2bf((i >= j) ? acc[r] * d : 0.f); } }
        }
        __syncthreads();
        if (wid == 0 && !((G2_SKIP & 2) && palt)) {
            const int b = lane >> 4, c = lane & 15; float t[16];
            const LAS float* Ab = As + (16 * b) * G2_AS + 16 * b;
#pragma unroll
            for (int i = 0; i < 16; ++i) {
                float ti = (i == c) ? 1.f : 0.f;
#pragma unroll
                for (int j4 = 0; j4 < (i + 3) / 4; ++j4) { const f32x4 a = *(const LAS f32x4*)(Ab + i * G2_AS + 4 * j4);
#pragma unroll
                    for (int k = 0; k < 4; ++k) if (4 * j4 + k < i) ti -= a[k] * t[4 * j4 + k]; }
                t[i] = ti;
            }
#pragma unroll
            for (int i = 0; i < 16; ++i) Tb[b * 256 + i * 16 + c] = (bf16)f2bf(t[i]);
        } else if (wid < 5) {
            const int tt = tid - 64, cgp = tt & 15, r0 = tt >> 4;
            { GAS bf16* at = palt ? palt + (((size_t)u * 4096 + 0x4000000ull) & 0x7ffffffull) : attn + (size_t)u * 4096;
#pragma unroll
              for (int k = 0; k < 2; ++k) { const int pc = tt + 256 * k, i = pc >> 3, c8 = pc & 7; *(GAS v4u*)(at + i * 64 + 8 * c8) = *(const LAS v4u*)(Ws + i * G2_TS + 8 * c8); } }
#pragma unroll
            for (int r = 0; r < 4; ++r) { const int i = r0 + 16 * r; const float e = __expf(gcs[i]); const v4u v = *(const LAS v4u*)(Qs + i * G2_TS + 8 * cgp); v4u w;
                w.x = pk2(bflo(v.x) * e, bfhi(v.x) * e); w.y = pk2(bflo(v.y) * e, bfhi(v.y) * e); w.z = pk2(bflo(v.z) * e, bfhi(v.z) * e); w.w = pk2(bflo(v.w) * e, bfhi(v.w) * e);
                *(GAS v4u*)G2_ST((row0 + i) * GDN_MAIN + h * HD + 8 * cgp) = w; }
        } else {
            const float gl = gcs[63];
            for (int task = tid - 320; task < 256; task += 192) { const int dk = task & 127, th = task >> 7;
                GAS bf16* dst = G2_ST((row0 + (dk >> 1)) * GDN_MAIN + 2048 + h * HD + (dk & 1) * 64 + 32 * th);
#pragma unroll
                for (int q = 0; q < 4; ++q) { float v[8];
#pragma unroll
                    for (int k = 0; k < 8; ++k) { const int tk = 32 * th + 8 * q + k; v[k] = bf2f(Ks[tk * G2_TS + dk]) * __expf(gl - gcs[tk]); }
                    v4u w; w.x = pk2(v[0], v[1]); w.y = pk2(v[2], v[3]); w.z = pk2(v[4], v[5]); w.w = pk2(v[6], v[7]); if (!(PROBE_G2_NOSCAT && palt)) *(GAS v4u*)(dst + 8 * q) = w; else asm volatile("" :: "v"(w)); } }
        }
        __syncthreads();
        if (!((G2_SKIP & 1) && palt)) {
            const int nl = lane & 15, q = lane >> 4; const bool isK = wid >= 4;
            float rsc[16];
#pragma unroll
            for (int b = 0; b < 4; ++b)
#pragma unroll
                for (int r = 0; r < 4; ++r) { const int row = 16 * b + 4 * q + r; rsc[4 * b + r] = isK ? bts[row] * __expf(gcs[row]) : bts[row]; }
            bf16x4 Tq[4], Aq[6];
#pragma unroll
            for (int b = 0; b < 4; ++b) Tq[b] = *(const LAS bf16x4*)(Tb + b * 256 + nl * 16 + 4 * q);
            Aq[0] = *(const LAS bf16x4*)(An + (16 + nl) * G2_ANS + 4 * q);
            Aq[1] = *(const LAS bf16x4*)(An + (32 + nl) * G2_ANS + 4 * q);      Aq[2] = *(const LAS bf16x4*)(An + (32 + nl) * G2_ANS + 16 + 4 * q);
            Aq[3] = *(const LAS bf16x4*)(An + (48 + nl) * G2_ANS + 4 * q);      Aq[4] = *(const LAS bf16x4*)(An + (48 + nl) * G2_ANS + 16 + 4 * q);   Aq[5] = *(const LAS bf16x4*)(An + (48 + nl) * G2_ANS + 32 + 4 * q);
#pragma unroll
            for (int t = 0; t < 2; ++t) {
                const int cc = 32 * (wid & 3) + 16 * t + nl;
                const LAS bf16* src = (isK ? Ks : Vs) + cc;
                f32x4 R[4];
#pragma unroll
                for (int b = 0; b < 4; ++b)
#pragma unroll
                    for (int r = 0; r < 4; ++r) R[b][r] = rsc[4 * b + r] * bf2f(src[(16 * b + 4 * q + r) * G2_TS]);
                const f32x4 z4 = {0.f, 0.f, 0.f, 0.f};
                const f32x4 y0 = MFMA16K16(Tq[0], pack4(R[0]), z4); const bf16x4 y0b = pack4(y0);
                f32x4 c1 = MFMA16K16(Aq[0], y0b, R[1]);
                const f32x4 y1 = MFMA16K16(Tq[1], pack4(c1), z4); const bf16x4 y1b = pack4(y1);
                f32x4 c2 = MFMA16K16(Aq[1], y0b, R[2]); c2 = MFMA16K16(Aq[2], y1b, c2);
                const f32x4 y2 = MFMA16K16(Tq[2], pack4(c2), z4); const bf16x4 y2b = pack4(y2);
                f32x4 c3 = MFMA16K16(Aq[3], y0b, R[3]); c3 = MFMA16K16(Aq[4], y1b, c3); c3 = MFMA16K16(Aq[5], y2b, c3);
                const f32x4 y3 = MFMA16K16(Tq[3], pack4(c3), z4); const bf16x4 y3b = pack4(y3);
                if (!isK) {
                    LAS bf16* dst = Us + cc * G2_US + 4 * q;
                    *(LAS bf16x4*)(dst) = y0b; *(LAS bf16x4*)(dst + 16) = y1b; *(LAS bf16x4*)(dst + 32) = y2b; *(LAS bf16x4*)(dst + 48) = y3b;
                } else {
#pragma unroll
                    for (int r = 0; r < 4; ++r) { Ws[(4 * q + r) * G2_TS + cc] = (bf16)y0b[r]; Ws[(16 + 4 * q + r) * G2_TS + cc] = (bf16)y1b[r]; Ws[(32 + 4 * q + r) * G2_TS + cc] = (bf16)y2b[r]; Ws[(48 + 4 * q + r) * G2_TS + cc] = (bf16)y3b[r]; }
                }
            }
        }
        __syncthreads();
#pragma unroll
        for (int k = 0; k < 2; ++k) { const int pc = tid + 512 * k, dv = pc >> 3, c8 = pc & 7;
            const v2u lo = *(const LAS v2u*)(Us + dv * G2_US + 8 * c8), hi2 = *(const LAS v2u*)(Us + dv * G2_US + 8 * c8 + 4);
            *(GAS v4u*)G2_ST((row0 + (dv & 63)) * GDN_MAIN + 4096 + h * HD + (dv >> 6) * 64 + 8 * c8) = (v4u){lo.x, lo.y, hi2.x, hi2.y}; }
#pragma unroll
        for (int k = 0; k < 2; ++k) { const int ch = tid + 512 * k, i = ch >> 4, c8 = ch & 15; *(GAS v4u*)((palt ? palt + (((row0 + i) * DMODEL + h * HD + 8 * c8) & 0x7ffffffull) : wbuf + (row0 + i) * DMODEL + h * HD + 8 * c8)) = *(const LAS v4u*)(Ws + i * G2_TS + 8 * c8); }
    }
#undef G2_ST
#undef G2_LOAD_RAW
}

constexpr int H2_AD = 0, H2_GC = 4096, H2_BT = 4352, H2_AN = 4608, H2_TB = H2_AN + 64 * G2_ANS * 2, H2_Q = H2_TB + 2048, H2_K = H2_Q + 64 * G2_TS * 2, H2_V = H2_K + 64 * G2_TS * 2, H2_GSZ = H2_V + 64 * G2_TS * 2;
static_assert(2 * H2_GSZ <= LDSCTL_OFF && H2_GSZ % 16 == 0, "G2 (two groups) LDS");
__device__ __forceinline__ void grp_bar(LAS unsigned* cnt, unsigned& tgt, int lane) {
    asm volatile("s_waitcnt lgkmcnt(0)" ::: "memory");
    if (lane == 0) __hip_atomic_fetch_add(cnt, 1u, __ATOMIC_RELAXED, __HIP_MEMORY_SCOPE_WORKGROUP);
    tgt += 4u;
    while (*(volatile LAS unsigned*)cnt < tgt) __builtin_amdgcn_s_sleep(1);
    asm volatile("" ::: "memory");
}
__device__ __forceinline__ void gdn_chunk_phase2(LAS unsigned char* lds, bf16* p_, const bf16* halo_, const float* beta_, float* g_, bf16* wbuf_, bf16* attn_, const float* conv_w_, int vcu, int G, bf16* palt_ = nullptr) {
#define G2_ST(off) ((palt ? palt + ((size_t)(off) & 0x7ffffffull) : p + (size_t)(off)))
    int tid_ = threadIdx.x; asm volatile("" : "+v"(tid_));
    const int tid0 = tid_;
    GAS bf16* const p = (GAS bf16*)p_; const GAS bf16* const halo = (const GAS bf16*)halo_; const GAS float* const beta = (const GAS float*)beta_; GAS float* const g = (GAS float*)g_;
    GAS bf16* const wbuf = (GAS bf16*)wbuf_; GAS bf16* const attn = (GAS bf16*)attn_; const GAS float* const conv_w = (const GAS float*)conv_w_; GAS bf16* const palt = (GAS bf16*)palt_;
    const int grp = __builtin_amdgcn_readfirstlane(tid0 >> 8);
    LAS unsigned* cnt = (LAS unsigned*)(lds + LDSCTL_OFF + 128 + 64 * grp);
    __syncthreads(); if (tid0 == 0) { *(LAS unsigned*)(lds + LDSCTL_OFF + 128) = 0u; *(LAS unsigned*)(lds + LDSCTL_OFF + 192) = 0u; } __syncthreads();
    unsigned tgt = 0u;
    LAS unsigned char* gb = lds + grp * H2_GSZ;
    LAS bf16* Qs = (LAS bf16*)(gb + H2_Q); LAS bf16* Ks = (LAS bf16*)(gb + H2_K); LAS bf16* Vs = (LAS bf16*)(gb + H2_V);
    LAS float* Ad = (LAS float*)(gb + H2_AD); LAS float* gcs = (LAS float*)(gb + H2_GC); LAS float* bts = (LAS float*)(gb + H2_BT);
    LAS bf16* An = (LAS bf16*)(gb + H2_AN); LAS bf16* Tb = (LAS bf16*)(gb + H2_TB);
    asm volatile("" : "+v"(Qs), "+v"(Ks), "+v"(Vs), "+v"(Ad), "+v"(gcs), "+v"(bts), "+v"(An), "+v"(Tb));
    v4u rawv[3][7]; float gpre = 0.f, bpre = 0.f;
#define H2_LOAD_RAW(uu, LN, W4) do { const int cg_ = (uu) >> 4, h_ = (uu) & 15, n_ = cg_ & 63; const size_t r0_ = (size_t)cg_ * 64; const int cgp_l = (LN) & 15, tA_l = 16 * (W4) + 4 * ((LN) >> 4); \
        _Pragma("unroll") for (int X = 0; X < 3; ++X) { const int col_ = X * 2048 + h_ * HD + 8 * cgp_l; \
            _Pragma("unroll") for (int rr = 0; rr < 7; ++rr) { const int rel = tA_l - 3 + rr; v4u v = {0u, 0u, 0u, 0u}; \
                if (rel >= 0) v = *(const GAS v4u*)(p + (r0_ + rel) * GDN_MAIN + col_); \
                else if (n_ > 0) v = *(const GAS v4u*)(halo + ((size_t)(cg_ - 1) * 3 + (rel + 3)) * CONVC + col_); \
                rawv[X][rr] = v; } } \
        if ((W4) == 0) { gpre = g[(r0_ + (LN)) * 16 + h_]; bpre = beta[(r0_ + (LN)) * 16 + h_]; } } while (0)
    const int u0 = 2 * vcu + grp, ustep = 2 * G;
    if (u0 < NCG * NHEADS) H2_LOAD_RAW(u0, (tid0 & 63), __builtin_amdgcn_readfirstlane((tid0 >> 6) & 3));
    for (int u = u0; u < NCG * NHEADS; u += ustep) {
        const int cg = u >> 4, h = u & 15; const size_t row0 = (size_t)cg * 64;
        int tl_ = tid0; asm volatile("" : "+v"(tl_));
        const int tid = tl_, lane = tid & 63, w4 = __builtin_amdgcn_readfirstlane((tid >> 6) & 3), gt = tid & 255, r32 = lane & 31, hi = lane >> 5;
        {
            const int cgp = lane & 15, sub = lane >> 4, tA = 16 * w4 + 4 * sub;
#pragma unroll
            for (int X = 0; X < 3; ++X) {
                const int col = X * 2048 + h * HD + 8 * cgp;
                asm volatile("" : "+v"(rawv[X][0]), "+v"(rawv[X][1]), "+v"(rawv[X][2]), "+v"(rawv[X][3]), "+v"(rawv[X][4]), "+v"(rawv[X][5]), "+v"(rawv[X][6]));
                float wj[4][8];
#pragma unroll
                for (int j = 0; j < 4; ++j) { const f32x4 wa = *(const GAS f32x4*)(conv_w + (size_t)j * CONVC + col), wb = *(const GAS f32x4*)(conv_w + (size_t)j * CONVC + col + 4);
#pragma unroll
                    for (int c = 0; c < 4; ++c) { wj[j][c] = wa[c]; wj[j][4 + c] = wb[c]; } }
                float o[4][8];
#pragma unroll
                for (int t = 0; t < 4; ++t)
#pragma unroll
                    for (int c = 0; c < 8; ++c) o[t][c] = 0.f;
#pragma unroll
                for (int rr = 0; rr < 7; ++rr) { const v4u v = rawv[X][rr]; const float rw[8] = {bflo(v.x), bfhi(v.x), bflo(v.y), bfhi(v.y), bflo(v.z), bfhi(v.z), bflo(v.w), bfhi(v.w)};
#pragma unroll
                    for (int t = 0; t < 4; ++t) { const int j = rr - t; if (j >= 0 && j < 4) {
#pragma unroll
                            for (int c = 0; c < 8; ++c) o[t][c] += wj[j][c] * rw[c]; } } }
                LAS bf16* T = X == 0 ? Qs : (X == 1 ? Ks : Vs);
#pragma unroll
                for (int t = 0; t < 4; ++t) { float s = 0.f;
#pragma unroll
                    for (int c = 0; c < 8; ++c) { o[t][c] = silu_f(o[t][c]); s += o[t][c] * o[t][c]; }
                    if (X < 2) { s = sum16(s); const float f = (X == 0 ? 0.08838834764831845f : 1.f) * __builtin_amdgcn_rsqf(s + GDN_EPS);
#pragma unroll
                        for (int c = 0; c < 8; ++c) o[t][c] *= f; }
                    v4u w0; w0.x = pk2(o[t][0], o[t][1]); w0.y = pk2(o[t][2], o[t][3]); w0.z = pk2(o[t][4], o[t][5]); w0.w = pk2(o[t][6], o[t][7]);
                    *(LAS v4u*)(T + (tA + t) * G2_TS + 8 * cgp) = w0; }
                asm volatile("" ::: "memory");
            }
            if (w4 == 0) {
                float gv = gpre;
#pragma unroll
                for (int o_ = 1; o_ < 64; o_ <<= 1) { const float t = __shfl_up(gv, o_); if (lane >= o_) gv += t; }
                gcs[lane] = gv; bts[lane] = bpre; if (!palt) g[(row0 + lane) * 16 + h] = gv;
            }
        }
        grp_bar(cnt, tgt, lane);
        if (u + ustep < NCG * NHEADS) H2_LOAD_RAW(u + ustep, lane, w4);
        {
            const int rb = w4 >> 1, cb = w4 & 1; const int j = 32 * cb + r32; const float gj = gcs[j];
            GAS bf16* at = palt ? palt + (((size_t)u * 4096 + 0x4000000ull) & 0x7ffffffull) : attn + (size_t)u * 4096;
#pragma unroll
            for (int pass = 0; pass < 2; ++pass) {
                f32x16 acc = {};
                if (!(rb == 0 && cb == 1)) {
                    const LAS bf16* Ar = (pass == 0 ? Ks : Qs) + (32 * rb + r32) * G2_TS + 8 * hi; const LAS bf16* Br = Ks + (32 * cb + r32) * G2_TS + 8 * hi;
#pragma unroll
                    for (int s = 0; s < 8; ++s) acc = MFMA32(*(const LAS bf16x8*)(Ar + 16 * s), *(const LAS bf16x8*)(Br + 16 * s), acc);
                }
#pragma unroll
                for (int r = 0; r < 16; ++r) { const int i = 32 * rb + (r & 3) + 8 * (r >> 2) + 4 * hi; const float gi = gcs[i];
                    if (pass == 0) { const float d = (i > j) ? __expf(gi - gj) : 0.f; const float a = (i > j) ? bts[i] * acc[r] * d : 0.f; An[i * G2_ANS + j] = (bf16)f2bf(-a);
                        if ((i >> 4) == (j >> 4)) Ad[(i >> 4) * 256 + (i & 15) * 16 + (j & 15)] = a; }
                    else { const float d = (i >= j) ? __expf(gi - gj) : 0.f; at[i * 64 + j] = (bf16)f2bf((i >= j) ? acc[r] * d : 0.f); } }
            }
        }
        grp_bar(cnt, tgt, lane);
        if (w4 == 0) {
            const int b = lane >> 4, c = lane & 15; float t[16];
            const LAS float* Ab = Ad + b * 256;
#pragma unroll
            for (int i = 0; i < 16; ++i) {
                float ti = (i == c) ? 1.f : 0.f;
#pragma unroll
                for (int j4 = 0; j4 < (i + 3) / 4; ++j4) { const f32x4 a = *(const LAS f32x4*)(Ab + i * 16 + 4 * j4);
#pragma unroll
                    for (int k = 0; k < 4; ++k) if (4 * j4 + k < i) ti -= a[k] * t[4 * j4 + k]; }
                t[i] = ti;
            }
#pragma unroll
            for (int i = 0; i < 16; ++i) Tb[b * 256 + i * 16 + c] = (bf16)f2bf(t[i]);
        } else {
            const int tt = gt - 64;
            for (int pc = tt; pc < 1024; pc += 192) { const int i = pc >> 4, cgp = pc & 15; const float e = __expf(gcs[i]); const v4u v = *(const LAS v4u*)(Qs + i * G2_TS + 8 * cgp); v4u w;
                w.x = pk2(bflo(v.x) * e, bfhi(v.x) * e); w.y = pk2(bflo(v.y) * e, bfhi(v.y) * e); w.z = pk2(bflo(v.z) * e, bfhi(v.z) * e); w.w = pk2(bflo(v.w) * e, bfhi(v.w) * e);
                *(GAS v4u*)G2_ST((row0 + i) * GDN_MAIN + h * HD + 8 * cgp) = w; }
            const float gl = gcs[63];
            for (int task = tt; task < 256; task += 192) { const int dk = task & 127, th = task >> 7;
                GAS bf16* dst = G2_ST((row0 + (dk >> 1)) * GDN_MAIN + 2048 + h * HD + (dk & 1) * 64 + 32 * th);
#pragma unroll
                for (int q = 0; q < 4; ++q) { float v[8];
#pragma unroll
                    for (int k = 0; k < 8; ++k) { const int tk = 32 * th + 8 * q + k; v[k] = bf2f(Ks[tk * G2_TS + dk]) * __expf(gl - gcs[tk]); }
                    v4u w; w.x = pk2(v[0], v[1]); w.y = pk2(v[2], v[3]); w.z = pk2(v[4], v[5]); w.w = pk2(v[6], v[7]); *(GAS v4u*)(dst + 8 * q) = w; } }
        }
        grp_bar(cnt, tgt, lane);
        {
            const int nl = lane & 15, q = lane >> 4; const bool isK = w4 >= 2;
            float rsc[16];
#pragma unroll
            for (int b = 0; b < 4; ++b)
#pragma unroll
                for (int r = 0; r < 4; ++r) { const int row = 16 * b + 4 * q + r; rsc[4 * b + r] = isK ? bts[row] * __expf(gcs[row]) : bts[row]; }
            bf16x4 Tq[4], Aq[6];
#pragma unroll
            for (int b = 0; b < 4; ++b) Tq[b] = *(const LAS bf16x4*)(Tb + b * 256 + nl * 16 + 4 * q);
            Aq[0] = *(const LAS bf16x4*)(An + (16 + nl) * G2_ANS + 4 * q);
            Aq[1] = *(const LAS bf16x4*)(An + (32 + nl) * G2_ANS + 4 * q);      Aq[2] = *(const LAS bf16x4*)(An + (32 + nl) * G2_ANS + 16 + 4 * q);
            Aq[3] = *(const LAS bf16x4*)(An + (48 + nl) * G2_ANS + 4 * q);      Aq[4] = *(const LAS bf16x4*)(An + (48 + nl) * G2_ANS + 16 + 4 * q);   Aq[5] = *(const LAS bf16x4*)(An + (48 + nl) * G2_ANS + 32 + 4 * q);
#pragma unroll
            for (int t = 0; t < 4; ++t) {
                const int cc = 64 * (w4 & 1) + 16 * t + nl;
                const LAS bf16* src = (isK ? Ks : Vs) + cc;
                f32x4 R[4];
#pragma unroll
                for (int b = 0; b < 4; ++b)
#pragma unroll
                    for (int r = 0; r < 4; ++r) R[b][r] = rsc[4 * b + r] * bf2f(src[(16 * b + 4 * q + r) * G2_TS]);
                const f32x4 z4 = {0.f, 0.f, 0.f, 0.f};
                const f32x4 y0 = MFMA16K16(Tq[0], pack4(R[0]), z4); const bf16x4 y0b = pack4(y0);
                f32x4 c1 = MFMA16K16(Aq[0], y0b, R[1]);
                const f32x4 y1 = MFMA16K16(Tq[1], pack4(c1), z4); const bf16x4 y1b = pack4(y1);
                f32x4 c2 = MFMA16K16(Aq[1], y0b, R[2]); c2 = MFMA16K16(Aq[2], y1b, c2);
                const f32x4 y2 = MFMA16K16(Tq[2], pack4(c2), z4); const bf16x4 y2b = pack4(y2);
                f32x4 c3 = MFMA16K16(Aq[3], y0b, R[3]); c3 = MFMA16K16(Aq[4], y1b, c3); c3 = MFMA16K16(Aq[5], y2b, c3);
                const f32x4 y3 = MFMA16K16(Tq[3], pack4(c3), z4); const bf16x4 y3b = pack4(y3);
                if (!isK) {
                    GAS bf16* dst = G2_ST((row0 + (cc & 63)) * GDN_MAIN + 4096 + h * HD + (cc >> 6) * 64 + 4 * q);
                    *(GAS bf16x4*)(dst) = y0b; *(GAS bf16x4*)(dst + 16) = y1b; *(GAS bf16x4*)(dst + 32) = y2b; *(GAS bf16x4*)(dst + 48) = y3b;
                } else {
                    GAS bf16* dst = palt ? palt + (((row0 + 4 * q) * DMODEL + h * HD + cc) & 0x7ffffffull) : wbuf + (row0 + 4 * q) * DMODEL + h * HD + cc;
#pragma unroll
                    for (int r = 0; r < 4; ++r) { dst[(size_t)r * DMODEL] = (bf16)y0b[r]; dst[(size_t)(16 + r) * DMODEL] = (bf16)y1b[r]; dst[(size_t)(32 + r) * DMODEL] = (bf16)y2b[r]; dst[(size_t)(48 + r) * DMODEL] = (bf16)y3b[r]; }
                }
            }
        }
        grp_bar(cnt, tgt, lane);
    }
#undef H2_LOAD_RAW
#undef G2_ST
    __syncthreads();
}

constexpr int G3_STS = 136, G3_VTS = 72;
constexpr int G3_ST = 0, G3_VT = G3_ST + 64 * G3_STS * 2, G3_OT = G3_VT + 64 * G3_VTS * 2, G3_WT = G3_OT + 64 * G3_VTS * 2, G3_QT = G3_WT + 64 * G3_STS * 2, G3_KT = G3_QT + 64 * G3_STS * 2,
              G3_PT = G3_KT + 128 * G3_VTS * 2, G3_UT = G3_PT + 64 * G3_VTS * 2, G3_END = G3_UT + 64 * G3_VTS * 2;
static_assert(G3_END <= RING_BYTES, "G3 LDS");
__device__ __forceinline__ void gdn_scan_phase(LAS unsigned char* lds, bf16* p_, const bf16* wbuf_, const bf16* attn_, const float* g_, int vcu, int G, bf16* oalt_ = nullptr) {
    GAS bf16* const p = (GAS bf16*)p_; const GAS bf16* const wbuf = (const GAS bf16*)wbuf_; const GAS bf16* const attn = (const GAS bf16*)attn_; const GAS float* const g = (const GAS float*)g_; GAS bf16* const oalt = (GAS bf16*)oalt_;
    int tid_ = threadIdx.x; asm volatile("" : "+v"(tid_));
    const int tid = tid_, lane = tid & 63, wid = __builtin_amdgcn_readfirstlane(tid >> 6), r32 = lane & 31, hi = lane >> 5;
    const int role = wid >> 2, a = (wid >> 1) & 1, bb = wid & 1, r = wid >> 1;
    LAS bf16* ST = (LAS bf16*)(lds + G3_ST); LAS bf16* VT = (LAS bf16*)(lds + G3_VT); LAS bf16* OT = (LAS bf16*)(lds + G3_OT);
    LAS bf16* WT = (LAS bf16*)(lds + G3_WT); LAS bf16* QT = (LAS bf16*)(lds + G3_QT); LAS bf16* KT = (LAS bf16*)(lds + G3_KT); LAS bf16* PT = (LAS bf16*)(lds + G3_PT); LAS bf16* UT = (LAS bf16*)(lds + G3_UT);
    for (int unit = vcu; unit < BATCH * NHEADS * 2; unit += G) {
        const int bh = unit >> 1, e = unit & 1, b = bh >> 4, h = bh & 15;
        for (int i = tid; i < G3_VT / 4; i += NWAVES * 64) ((LAS unsigned*)lds)[i] = 0u;
        f32x16 Sacc = {};
        const int r16a = tid >> 4, c16 = tid & 15, r8 = tid >> 3, c8 = tid & 7;
        const GAS bf16* gW = wbuf + (size_t)r16a * DMODEL + h * HD + 8 * c16;
        const GAS bf16* gQ = p + (size_t)r16a * GDN_MAIN + h * HD + 8 * c16;
        const GAS bf16* gK = p + (size_t)r16a * GDN_MAIN + 2048 + h * HD + 8 * c16;
        const GAS bf16* gP = attn + (size_t)r8 * 64 + 8 * c8;
        const GAS bf16* gU = p + (size_t)r8 * GDN_MAIN + 4096 + h * HD + e * 64 + 8 * c8;
        LAS bf16* sW = WT + r16a * G3_STS + 8 * c16; LAS bf16* sQ = QT + r16a * G3_STS + 8 * c16;
        LAS bf16* sK = KT + (2 * r16a + (c16 >> 3)) * G3_VTS + 8 * (c16 & 7);
        LAS bf16* sP = PT + r8 * G3_VTS + 8 * c8; LAS bf16* sU = UT + r8 * G3_VTS + 8 * c8;
        GAS bf16* oRow = (oalt ? oalt : p + 4096) + h * HD + e * 64; const size_t oPitch = oalt ? DMODEL : GDN_MAIN;
        const LAS bf16* aRd = (role == 0 ? WT : QT) + (32 * a + r32) * G3_STS + 8 * hi;
        const LAS bf16* sRd = ST + (32 * bb + r32) * G3_STS + 8 * hi; const LAS bf16* vRd = VT + (32 * bb + r32) * G3_VTS + 8 * hi;
        const LAS bf16* uRd = UT + (32 * bb + r32) * G3_VTS + 32 * a + 4 * hi; const LAS bf16* pRd = PT + (32 * a + r32) * G3_VTS + 8 * hi; const LAS bf16* kRd = KT + (32 * r + r32) * G3_VTS + 8 * hi;
        LAS bf16* vWr = VT + (32 * bb + r32) * G3_VTS + 32 * a + 4 * hi; LAS bf16* sWr = ST + (32 * bb + r32) * G3_STS + 32 * r + 4 * hi;
        v4u gw0, gw1, gq0, gq1, gk0, gk1, gp0, gu0; float dd;
#define G3_LOAD(nn) do { const size_t row0_ = (size_t)b * SEQ + (size_t)(nn) * 64; \
            gw0 = *(const GAS v4u*)(gW + row0_ * DMODEL); gw1 = *(const GAS v4u*)(gW + (row0_ + 32) * DMODEL); \
            gq0 = *(const GAS v4u*)(gQ + row0_ * GDN_MAIN); gq1 = *(const GAS v4u*)(gQ + (row0_ + 32) * GDN_MAIN); \
            gk0 = *(const GAS v4u*)(gK + row0_ * GDN_MAIN); gk1 = *(const GAS v4u*)(gK + (row0_ + 32) * GDN_MAIN); \
            gp0 = *(const GAS v4u*)(gP + ((size_t)(b * 64 + (nn)) * 16 + h) * 4096); gu0 = *(const GAS v4u*)(gU + row0_ * GDN_MAIN); \
            dd = __expf(g[(row0_ + 63) * 16 + h]); } while (0)
        G3_LOAD(0);
        __syncthreads();
#pragma unroll 1
        for (int n = 0; n < 64; ++n) {
            const size_t row0_ = (size_t)b * SEQ + (size_t)n * 64; const int nn = (n + 1 < 64) ? n + 1 : n;
            *(LAS v4u*)(sW) = gw0; *(LAS v4u*)(sW + 32 * G3_STS) = gw1; *(LAS v4u*)(sQ) = gq0; *(LAS v4u*)(sQ + 32 * G3_STS) = gq1;
            *(LAS v4u*)(sK) = gk0; *(LAS v4u*)(sK + 64 * G3_VTS) = gk1; *(LAS v4u*)(sP) = gp0; *(LAS v4u*)(sU) = gu0;
            const float dcur = dd;
            WG_BAR();
            G3_LOAD(nn);
            f32x16 acc_ = {};
#pragma unroll
            for (int s = 0; s < 8; ++s) acc_ = MFMA32(*(const LAS bf16x8*)(aRd + 16 * s), *(const LAS bf16x8*)(sRd + 16 * s), acc_);
            if (role == 0) {
#pragma unroll
                for (int q = 0; q < 4; ++q) { const v2u uu = *(const LAS v2u*)(uRd + 8 * q); v2u w_;
                    w_.x = pk2(bflo(uu.x) - acc_[4 * q], bfhi(uu.x) - acc_[4 * q + 1]); w_.y = pk2(bflo(uu.y) - acc_[4 * q + 2], bfhi(uu.y) - acc_[4 * q + 3]);
                    *(LAS v2u*)(vWr + 8 * q) = w_; }
            }
            WG_BAR();
            bf16x8 Vf_[4];
#pragma unroll
            for (int s = 0; s < 4; ++s) Vf_[s] = *(const LAS bf16x8*)(vRd + 16 * s);
            if (role == 1) {
#pragma unroll
                for (int s = 0; s < 4; ++s) acc_ = MFMA32(*(const LAS bf16x8*)(pRd + 16 * s), Vf_[s], acc_);
#pragma unroll
                for (int rr = 0; rr < 16; ++rr) OT[(32 * a + (rr & 3) + 8 * (rr >> 2) + 4 * hi) * G3_VTS + 32 * bb + r32] = (bf16)f2bf(acc_[rr]);
            }
            Sacc = Sacc * dcur;
#pragma unroll
            for (int s = 0; s < 4; ++s) Sacc = MFMA32(*(const LAS bf16x8*)(kRd + 16 * s), Vf_[s], Sacc);
#pragma unroll
            for (int q = 0; q < 4; ++q) { v2u w_; w_.x = pk2(Sacc[4 * q], Sacc[4 * q + 1]); w_.y = pk2(Sacc[4 * q + 2], Sacc[4 * q + 3]); *(LAS v2u*)(sWr + 8 * q) = w_; }
            WG_BAR();
            *(GAS v4u*)(oRow + (row0_ + r8) * oPitch + 8 * c8) = *(const LAS v4u*)(OT + r8 * G3_VTS + 8 * c8);
        }
#undef G3_LOAD
        VM_WAIT(); __syncthreads();
    }
}

__device__ __forceinline__ void gdn_gate_phase(bf16* p, const float* norm_w, int gw, int NGW, int lane, bf16* oalt = nullptr) {
    for (int m = gw; m < MROWS; m += NGW) {
        GAS bf16* orow = (GAS bf16*)p + (size_t)m * GDN_MAIN + 4096; const GAS bf16* zrow = (const GAS bf16*)p + (size_t)m * GDN_MAIN + 6144;
#pragma unroll
        for (int it = 0; it < 4; ++it) { const int col = it * 512 + lane * 8;
            const v4u ov = *(const GAS v4u*)(orow + col), zv = *(const GAS v4u*)(zrow + col);
            float o[8] = {bflo(ov.x), bfhi(ov.x), bflo(ov.y), bfhi(ov.y), bflo(ov.z), bfhi(ov.z), bflo(ov.w), bfhi(ov.w)};
            float z[8] = {bflo(zv.x), bfhi(zv.x), bflo(zv.y), bfhi(zv.y), bflo(zv.z), bfhi(zv.z), bflo(zv.w), bfhi(zv.w)};
            float s = 0.f;
#pragma unroll
            for (int c = 0; c < 8; ++c) s += o[c] * o[c];
            s = sum16(s); const float rs = __builtin_amdgcn_rsqf(s * (1.f / HD) + GDN_EPS);
            const f32x4 wa = *(const GAS f32x4*)((const GAS float*)norm_w + (col & 127)), wb = *(const GAS f32x4*)((const GAS float*)norm_w + (col & 127) + 4);
#pragma unroll
            for (int c = 0; c < 8; ++c) o[c] = o[c] * rs * (c < 4 ? wa[c] : wb[c - 4]) * silu_f(z[c]);
            v4u w; w.x = pk2(o[0], o[1]); w.y = pk2(o[2], o[3]); w.z = pk2(o[4], o[5]); w.w = pk2(o[6], o[7]); *(GAS v4u*)((oalt ? (GAS bf16*)oalt + (size_t)m * DMODEL : orow) + col) = w; }
    }
}

#ifndef PG8_SP2
#define PG8_SP2 true
#endif
#ifndef PG8_ALIGN
#define PG8_ALIGN true
#endif
#ifndef EN_P0
#define EN_P0 1
#endif
#ifndef EN_G1
#define EN_G1 1
#endif
#ifndef EN_G2
#define EN_G2 1
#endif
#ifndef EN_G3
#define EN_G3 1
#endif
#ifndef EN_G4
#define EN_G4 1
#endif
#ifndef EN_G5
#define EN_G5 1
#endif
#ifndef EN_G6
#define EN_G6 1
#endif
#ifndef EN_G7
#define EN_G7 1
#endif
#ifndef EN_G8
#define EN_G8 1
#endif
#ifndef EN_G9
#define EN_G9 1
#endif
#ifndef EN_D1
#define EN_D1 1
#endif
#ifndef EN_D2
#define EN_D2 1
#endif
#ifndef EN_D3
#define EN_D3 1
#endif
#ifndef EN_D4
#define EN_D4 1
#endif
#ifndef EN_D5
#define EN_D5 1
#endif
#ifndef EN_D6U
#define EN_D6U 1
#endif
#ifndef EN_D6D
#define EN_D6D 1
#endif
#ifndef EN_D7
#define EN_D7 1
#endif
#ifndef REP_P0
#define REP_P0 1
#endif
#ifndef REP_G1
#define REP_G1 1
#endif
#ifndef REP_G2
#define REP_G2 1
#endif
#ifndef REP_G3
#define REP_G3 1
#endif
#ifndef REP_G4
#define REP_G4 1
#endif
#ifndef REP_G5
#define REP_G5 1
#endif
#ifndef REP_G6
#define REP_G6 1
#endif
#ifndef REP_G7
#define REP_G7 1
#endif
#ifndef REP_G8
#define REP_G8 1
#endif
#ifndef REP_G9
#define REP_G9 1
#endif
#ifndef REP_D1
#define REP_D1 1
#endif
#ifndef REP_D2
#define REP_D2 1
#endif
#ifndef REP_D3
#define REP_D3 1
#endif
#ifndef REP_D4
#define REP_D4 1
#endif
#ifndef REP_D5
#define REP_D5 1
#endif
#ifndef REP_D6U
#define REP_D6U 1
#endif
#ifndef REP_D6D
#define REP_D6D 1
#endif
#ifndef REP_D7
#define REP_D7 1
#endif
#ifndef G2_VER
#define G2_VER 2
#endif
#if G2_VER == 2
#define G2_FN gdn_chunk_phase2
#else
#define G2_FN gdn_chunk_phase
#endif
#ifndef LN_FUSED
#define LN_FUSED 0
#endif
#ifndef MLP_SPLIT
#define MLP_SPLIT 1
#endif
#define DSTRIDE (6 + 2 * MLP_SPLIT)
#define N_PHASES_K (19 + 2 * DSTRIDE)
#ifndef WGM_BIG
#define WGM_BIG 8
#endif
#ifndef WGM_SMALL
#define WGM_SMALL 4
#endif
#ifndef WGM_DOWN
#define WGM_DOWN 4
#endif
#ifndef PROBE_DBLBAR
#define PROBE_DBLBAR 0
#endif
#ifndef REP_BA
#define REP_BA 1
#endif
#ifndef PROBE_NOSTORE
#define PROBE_NOSTORE 0
#endif
struct Args { const float* in[16]; float* out; unsigned char* ws; int ph_lo, ph_hi; };
__global__ void __launch_bounds__(NWAVES * 64, 2) yoco_fwd(Args args) {
    extern __shared__ __attribute__((aligned(16))) unsigned char lds_raw[];
    LAS unsigned char* lds = (LAS unsigned char*)lds_raw;
    volatile LAS unsigned* MISC = (volatile LAS unsigned*)(lds + MISC_OFF);
    const int tid = threadIdx.x, lane = tid & 63, wave = __builtin_amdgcn_readfirstlane(tid >> 6);
    const int G = gridDim.x, bx = blockIdx.x, vcu = (G % 8 == 0) ? (bx % 8) * (G / 8) + bx / 8 : bx;
    const int gw = vcu * NWAVES + wave, NGW = G * NWAVES, gtid = vcu * NWAVES * 64 + tid, NGT = G * NWAVES * 64;
    const float* ln_g = args.in[14]; const float* ln_b = args.in[15];
    for (int u = tid; u < (LDS_BYTES - LDSCTL_OFF) / 4; u += NWAVES * 64) ((LAS unsigned*)(lds + LDSCTL_OFF))[u] = 0u;
    __syncthreads();
    XcdBarrier bar; bar.bar = (unsigned*)(args.ws + WS_CTL) + CW_BAR; bar.x = 0; bar.st = nullptr;
    if (!MK_PER_PHASE) bar = xcd_barrier_post((unsigned*)(args.ws + WS_CTL) + CW_BAR, MISC + 8);
    const int lo = args.ph_lo, hi = args.ph_hi;
#define IN(k) (lo <= (k) && (k) < hi)
#define FRESH_LANE() int ln_ = lane; asm volatile("" : "+v"(ln_)); unsigned char* ws_ = args.ws; asm volatile("" : "+s"(ws_)); int gw_ = gw, vcu_ = vcu, bx_ = bx; asm volatile("" : "+s"(gw_), "+s"(vcu_), "+s"(bx_))
#define x_in         (args.in[0])
#define gdn_w_in     (args.in[1])
#define gdn_conv_w   (args.in[2])
#define gdn_a_log    (args.in[3])
#define gdn_dt_bias  (args.in[4])
#define gdn_norm_w   (args.in[5])
#define gdn_w_out    (args.in[6])
#define diff_w_q     (args.in[7])
#define diff_lambda  (args.in[8])
#define diff_subln_w (args.in[9])
#define diff_w_o     (args.in[10])
#define shared_w_kv  (args.in[11])
#define mlp_w_up     (args.in[12])
#define mlp_w_down   (args.in[13])
#define beta  ((float*)(ws_ + WS_BETA))
#define gdec  ((float*)(ws_ + WS_G))
#define halo  ((bf16*)(ws_ + WS_HALO))
#define WA    ((bf16*)(ws_ + WS_WA))
#define WB    ((bf16*)(ws_ + WS_WB))
#define attnb ((bf16*)(ws_ + WS_ATTN))
#define XB    ((bf16*)(ws_ + WS_XB))
#define LNSLOTS ((unsigned long long*)(ws_ + WS_Y))
#define LNCNT(sl) ((unsigned*)(ws_ + WS_CTL) + 16384 + (sl) * 8192)
#define LNTMO ((unsigned*)(ws_ + WS_CTL) + 8)
#define HB    ((bf16*)(ws_ + WS_Y))
#define WBUF  ((bf16*)(ws_ + WS_Y + QTR))
#define R1    ((bf16*)(ws_ + WS_R1))
#define Kb    (R1)
#define Vb    (R1 + QTR / 2)
#define Qb    (R1 + 2 * (QTR / 2))
#define HID   (Qb)
#define SEAM(k) do { if (!MK_PER_PHASE && (k) + 1 < hi) { xcd_barrier(bar); if (PROBE_DBLBAR) xcd_barrier(bar); } } while (0)

    for (int rep_ = 0; rep_ < REP_P0; ++rep_) if (EN_P0 && IN(0)) { FRESH_LANE();
        for (int m = gw_; m < MROWS; m += NGW) row_to_bf16(x_in + (size_t)m * DMODEL, XB + (size_t)m * DMODEL, ln_);
        convert_w(lds, gw_, NGW, wave, ln_, gdn_w_in, DMODEL, GDN_PROJ, 0, GDN_PROJ, WA, 0);
        SEAM(0);
    }
    for (int l = 0; l < 2; ++l) {
        const int pb = 1 + 9 * l;
        for (int rep_ = 0; rep_ < REP_G1; ++rep_) if (EN_G1 && IN(pb + 0)) { FRESH_LANE();
            pg8::Gemm g{XB, WA, MROWS, GDN_MAIN, DMODEL, DMODEL}; pg8::StaticOrder S; S.init(MROWS, GDN_MAIN, G, bx_, WGM_BIG);
            pg8::EpiStore<0> E{R1, GDN_MAIN, 0, 0, -1, 1.f, halo};
            pg8::gemm_phase<pg8::EpiStore<0>, pg8::StaticOrder, PG8_ALIGN, PG8_SP2>(lds + RING_OFF, g, S, E);
            { int ln2_ = lane; asm volatile("" : "+v"(ln2_));
              for (int rb_ = 0; rb_ < REP_BA; ++rb_) ba_proj(lds + RING_OFF, XB, WA, gdn_a_log + l * 16, gdn_dt_bias + l * 16, beta, gdec, gw_, NGW, ln2_); }
            SEAM(pb + 0);
        }
        for (int rep_ = 0; rep_ < REP_G2; ++rep_) if (EN_G2 && IN(pb + 1)) { FRESH_LANE(); G2_FN(lds, R1, halo, beta, gdec, WBUF, attnb, gdn_conv_w + (size_t)l * 4 * CONVC, vcu_, G, (rep_ + 1 < REP_G2) ? (bf16*)args.out : nullptr); SEAM(pb + 1); }
        for (int rep_ = 0; rep_ < REP_G3; ++rep_) if (EN_G3 && IN(pb + 2)) { FRESH_LANE(); gdn_scan_phase(lds, R1, WBUF, attnb, gdec, vcu_, G, (rep_ + 1 < REP_G3) ? (bf16*)args.out : nullptr); SEAM(pb + 2); }
        for (int rep_ = 0; rep_ < REP_G4; ++rep_) if (EN_G4 && IN(pb + 3)) { FRESH_LANE();
            gdn_gate_phase(R1, gdn_norm_w + l * HD, gw_, NGW, ln_, (rep_ + 1 < REP_G4) ? (bf16*)args.out : nullptr);
            convert_w(lds, gw_, NGW, wave, ln_, gdn_w_out + (size_t)l * DMODEL * DMODEL, DMODEL, DMODEL, 0, DMODEL, WA, 0);
            convert_w(lds, gw_, NGW, wave, ln_, mlp_w_up + (size_t)l * DMODEL * DFF, DMODEL, DFF, 0, DFF, WB, 0);
            SEAM(pb + 3);
        }
        for (int rep_ = 0; rep_ < REP_G5; ++rep_) if (EN_G5 && IN(pb + 4)) { FRESH_LANE();
            pg8::Gemm g{R1 + 4096, WA, MROWS, DMODEL, DMODEL, GDN_MAIN}; pg8::StaticOrder S; S.init(MROWS, DMODEL, G, bx_, WGM_SMALL);
#if LN_FUSED
            pg8::EpiLn E{XB, XB, nullptr, ln_g + (size_t)(l * 2) * DMODEL, ln_b + (size_t)(l * 2) * DMODEL, LNSLOTS, LNCNT(2 * l), LNTMO, 0, lds + RING_BYTES};
            pg8::gemm_phase<pg8::EpiLn, pg8::StaticOrder, true, PG8_SP2>(lds + RING_OFF, g, S, E);
#else
            pg8::EpiStore<0> E{(rep_ + 1 < REP_G5) ? (bf16*)args.out : HB, DMODEL, 0, 0, -1, 1.f, nullptr};
            pg8::gemm_phase<pg8::EpiStore<0>, pg8::StaticOrder, PG8_ALIGN, PG8_SP2>(lds + RING_OFF, g, S, E);
#endif
            SEAM(pb + 4);
        }
        const float* g1 = ln_g + (size_t)(l * 2) * DMODEL; const float* b1 = ln_b + (size_t)(l * 2) * DMODEL;
        for (int rep_ = 0; rep_ < REP_G6; ++rep_) if (!LN_FUSED && EN_G6 && IN(pb + 5)) { FRESH_LANE();
            ln_pass_b(XB, HB, g1, b1, XB, nullptr, ALPHA_RES, gw_, NGW, ln_);
            convert_w(lds, gw_, NGW, wave, ln_, mlp_w_down + (size_t)l * DFF * DMODEL, DFF, DMODEL, 0, DMODEL, WA, 0);
            SEAM(pb + 5);
        }
        for (int rep_ = 0; rep_ < REP_G7; ++rep_) if (EN_G7 && IN(pb + 6)) { FRESH_LANE();
            pg8::Gemm g{XB, WB, MROWS, DFF, DMODEL, DMODEL}; pg8::StaticOrder S; S.init(MROWS, DFF, G, bx_, WGM_BIG);
            pg8::EpiStore<1> E{R1, DFF, 0, 0, -1, 1.f, nullptr};
            pg8::gemm_phase<pg8::EpiStore<1>, pg8::StaticOrder, PG8_ALIGN, PG8_SP2>(lds + RING_OFF, g, S, E);
#if LN_FUSED
            { int ln2_ = lane; asm volatile("" : "+v"(ln2_)); convert_w(lds, gw_, NGW, wave, ln2_, mlp_w_down + (size_t)l * DFF * DMODEL, DFF, DMODEL, 0, DMODEL, WA, 0); }
#endif
            SEAM(pb + 6);
        }
        for (int rep_ = 0; rep_ < REP_G8; ++rep_) if (EN_G8 && IN(pb + 7)) { FRESH_LANE();
            pg8::Gemm g{R1, WA, MROWS, DMODEL, DFF, DFF}; pg8::StaticOrder S; S.init(MROWS, DMODEL, G, bx_, WGM_DOWN);
#if LN_FUSED
            pg8::EpiLn E{XB, XB, nullptr, ln_g + (size_t)(l * 2 + 1) * DMODEL, ln_b + (size_t)(l * 2 + 1) * DMODEL, LNSLOTS, LNCNT(2 * l + 1), LNTMO, 0, lds + RING_BYTES};
            pg8::gemm_phase<pg8::EpiLn, pg8::StaticOrder, true, PG8_SP2>(lds + RING_OFF, g, S, E);
#else
            pg8::EpiStore<0> E{(rep_ + 1 < REP_G8) ? (bf16*)args.out : HB, DMODEL, 0, 0, -1, 1.f, nullptr};
            pg8::gemm_phase<pg8::EpiStore<0>, pg8::StaticOrder, PG8_ALIGN, PG8_SP2>(lds + RING_OFF, g, S, E);
#endif
            SEAM(pb + 7);
        }
        for (int rep_ = 0; rep_ < REP_G9; ++rep_) if (EN_G9 && IN(pb + 8)) { FRESH_LANE();
            const float* g2 = ln_g + (size_t)(l * 2 + 1) * DMODEL; const float* b2 = ln_b + (size_t)(l * 2 + 1) * DMODEL;
            if (!LN_FUSED) ln_pass_b(XB, HB, g2, b2, XB, nullptr, ALPHA_RES, gw_, NGW, ln_);
            if (l == 0) convert_w(lds, gw_, NGW, wave, ln_, gdn_w_in + (size_t)DMODEL * GDN_PROJ, DMODEL, GDN_PROJ, 0, GDN_PROJ, WA, 0);
            else { convert_w(lds, gw_, NGW, wave, ln_, shared_w_kv, DMODEL, 2 * DMODEL, 0, 2 * DMODEL, WA, 0);
                   convert_w(lds, gw_, NGW, wave, ln_, diff_w_q, DMODEL, DMODEL, 0, DMODEL, WA, 2 * DMODEL); }
            SEAM(pb + 8);
        }
    }
    for (int j = 0; j < 2; ++j) {
        const int pb = 19 + DSTRIDE * j, L = 2 + j;
        for (int rep_ = 0; rep_ < REP_D1; ++rep_) if (EN_D1 && IN(pb + 0)) { FRESH_LANE();
            const int N = (j == 0) ? 3 * DMODEL : DMODEL;
            pg8::Gemm g{XB, WA, MROWS, N, DMODEL, DMODEL}; pg8::StaticOrder S; S.init(MROWS, N, G, bx_, WGM_BIG);
            pg8::EpiStore<0> E{(j == 0) ? Kb : Qb, DMODEL, (j == 0) ? DMODEL : 0, QTR / 2, (j == 0) ? 2 : 0, dattn::C2, nullptr};
            pg8::gemm_phase<pg8::EpiStore<0>, pg8::StaticOrder, PG8_ALIGN, PG8_SP2>(lds + RING_OFF, g, S, E);
            SEAM(pb + 0);
        }
        for (int rep_ = 0; rep_ < REP_D2; ++rep_) if (EN_D2 && IN(pb + 1)) { FRESH_LANE();
            const float lambda_init = 0.8f - 0.6f * expf(-0.3f * (float)L);
            const float* lp = diff_lambda + (size_t)j * 256;
            const float e1 = wave_sum(lp[ln_] * lp[64 + ln_]), e2 = wave_sum(lp[128 + ln_] * lp[192 + ln_]);
            const dattn::Params AP{(const dattn::bf16*)Qb, (const dattn::bf16*)Kb, (const dattn::bf16*)Vb, (rep_ + 1 < REP_D2) ? (dattn::bf16*)args.out : (dattn::bf16*)Qb, diff_subln_w + j * HD, __expf(e1) - __expf(e2) + lambda_init, 1.f - lambda_init};
            dattn::phase<8>((char*)lds_raw + RING_OFF, AP, G, bx_);
            { int ln2_ = lane; asm volatile("" : "+v"(ln2_));
              convert_w(lds, gw_, NGW, wave, ln2_, diff_w_o + (size_t)j * DMODEL * DMODEL, DMODEL, DMODEL, 0, DMODEL, WB, 0);
              convert_w(lds, gw_, NGW, wave, ln2_, mlp_w_up + (size_t)L * DMODEL * DFF, DMODEL, DFF, 0, DFF, WA, 0); }
            SEAM(pb + 1);
        }
        for (int rep_ = 0; rep_ < REP_D4; ++rep_) if (EN_D4 && IN(pb + 3)) { FRESH_LANE();
            pg8::Gemm g{Qb, WB, MROWS, DMODEL, DMODEL, DMODEL}; pg8::StaticOrder S; S.init(MROWS, DMODEL, G, bx_, WGM_SMALL);
#if LN_FUSED
            pg8::EpiLn E{XB, XB, nullptr, ln_g + (size_t)(L * 2) * DMODEL, ln_b + (size_t)(L * 2) * DMODEL, LNSLOTS, LNCNT(2 * L), LNTMO, 0, lds + RING_BYTES};
            pg8::gemm_phase<pg8::EpiLn, pg8::StaticOrder, true, PG8_SP2>(lds + RING_OFF, g, S, E);
#else
            pg8::EpiStore<0> E{(rep_ + 1 < REP_D4) ? (bf16*)args.out : HB, DMODEL, 0, 0, -1, 1.f, nullptr};
            pg8::gemm_phase<pg8::EpiStore<0>, pg8::StaticOrder, PG8_ALIGN, PG8_SP2>(lds + RING_OFF, g, S, E);
#endif
            SEAM(pb + 3);
        }
        const float* g1 = ln_g + (size_t)(L * 2) * DMODEL; const float* b1 = ln_b + (size_t)(L * 2) * DMODEL;
        for (int rep_ = 0; rep_ < REP_D5; ++rep_) if (!LN_FUSED && EN_D5 && IN(pb + 4)) { FRESH_LANE();
            ln_pass_b(XB, HB, g1, b1, XB, nullptr, ALPHA_RES, gw_, NGW, ln_);
            convert_w(lds, gw_, NGW, wave, ln_, mlp_w_down + (size_t)L * DFF * DMODEL, DFF, DMODEL, 0, DMODEL, WB, 0);
            SEAM(pb + 4);
        }
        for (int hf = 0; hf < MLP_SPLIT; ++hf) {
            const size_t roff = (size_t)hf * (MROWS / MLP_SPLIT);
            for (int rep_ = 0; rep_ < REP_D6U; ++rep_) if (EN_D6U && IN(pb + 5 + 2 * hf)) { FRESH_LANE();
                pg8::Gemm g{XB + roff * DMODEL, WA, MROWS / MLP_SPLIT, DFF, DMODEL, DMODEL}; pg8::StaticOrder S; S.init(MROWS / MLP_SPLIT, DFF, G, bx_, WGM_BIG);
                pg8::EpiStore<1> E{(PROBE_NOSTORE && rep_ + 1 < REP_D6U) ? (bf16*)nullptr : HID, DFF, 0, 0, -1, 1.f, nullptr, (MLP_SPLIT == 1) ? (bf16*)args.out : (bf16*)nullptr, MROWS / 2};
                pg8::gemm_phase<pg8::EpiStore<1>, pg8::StaticOrder, PG8_ALIGN, PG8_SP2>(lds + RING_OFF, g, S, E);
#if LN_FUSED
                if (hf == 0) { int ln2_ = lane; asm volatile("" : "+v"(ln2_)); convert_w(lds, gw_, NGW, wave, ln2_, mlp_w_down + (size_t)L * DFF * DMODEL, DFF, DMODEL, 0, DMODEL, WB, 0); }
#endif
                SEAM(pb + 5 + 2 * hf);
            }
            for (int rep_ = 0; rep_ < REP_D6D; ++rep_) if (EN_D6D && IN(pb + 6 + 2 * hf)) { FRESH_LANE();
                pg8::Gemm g{HID, WB, MROWS / MLP_SPLIT, DMODEL, DFF, DFF, (MLP_SPLIT == 1) ? (const bf16*)args.out : (const bf16*)nullptr, MROWS / 2 / 256}; pg8::StaticOrder S; S.init(MROWS / MLP_SPLIT, DMODEL, G, bx_, WGM_DOWN);
#if LN_FUSED
                pg8::EpiLn E{XB + roff * DMODEL, XB + roff * DMODEL, (j == 1) ? args.out + roff * DMODEL : (float*)nullptr, ln_g + (size_t)(L * 2 + 1) * DMODEL, ln_b + (size_t)(L * 2 + 1) * DMODEL,
                             LNSLOTS, LNCNT(2 * L + 1), LNTMO, hf * (MROWS / MLP_SPLIT / 256), lds + RING_BYTES};
                pg8::gemm_phase<pg8::EpiLn, pg8::StaticOrder, true, PG8_SP2>(lds + RING_OFF, g, S, E);
                if (j == 0 && hf == MLP_SPLIT - 1) { int ln2_ = lane; asm volatile("" : "+v"(ln2_)); convert_w(lds, gw_, NGW, wave, ln2_, diff_w_q + (size_t)DMODEL * DMODEL, DMODEL, DMODEL, 0, DMODEL, WA, 0); }
#else
                pg8::EpiStore<0> E{((rep_ + 1 < REP_D6D) ? (bf16*)args.out : HB) + roff * DMODEL, DMODEL, 0, 0, -1, 1.f, nullptr};
                pg8::gemm_phase<pg8::EpiStore<0>, pg8::StaticOrder, PG8_ALIGN, PG8_SP2>(lds + RING_OFF, g, S, E);
#endif
                SEAM(pb + 6 + 2 * hf);
            }
        }
        for (int rep_ = 0; rep_ < REP_D7; ++rep_) if (!LN_FUSED && EN_D7 && IN(pb + 5 + 2 * MLP_SPLIT)) { FRESH_LANE();
            const float* g2 = ln_g + (size_t)(L * 2 + 1) * DMODEL; const float* b2 = ln_b + (size_t)(L * 2 + 1) * DMODEL;
            if (j == 0) { ln_pass_b(XB, HB, g2, b2, XB, nullptr, ALPHA_RES, gw_, NGW, ln_);
                          convert_w(lds, gw_, NGW, wave, ln_, diff_w_q + (size_t)DMODEL * DMODEL, DMODEL, DMODEL, 0, DMODEL, WA, 0); }
            else { ln_pass_b(XB, HB, g2, b2, nullptr, args.out, ALPHA_RES, gw_, NGW, ln_); }
            SEAM(pb + 5 + 2 * MLP_SPLIT);
        }
    }
#undef IN
#undef SEAM
}

extern "C" void kernel_launch(void* const* d_in, const int* in_sizes, int n_in, void* d_out, int out_size, void* d_ws, size_t ws_size, hipStream_t stream) {
    static int grid = 0;
    if (grid == 0) {
        if (n_in != 16 || in_sizes[0] != MROWS * DMODEL || out_size != MROWS * DMODEL || ws_size < WS_END) { fprintf(stderr, "kernel_launch: unexpected shapes / workspace (n_in %d, ws %zu < %zu); nothing launched\n", n_in, ws_size, (size_t)WS_END); grid = -1; return; }
        int dev = 0, cus = 0, per_cu = 0;
        if (hipGetDevice(&dev) != hipSuccess || hipDeviceGetAttribute(&cus, hipDeviceAttributeMultiprocessorCount, dev) != hipSuccess) { grid = -1; return; }
        if (hipFuncSetAttribute((const void*)yoco_fwd, hipFuncAttributeMaxDynamicSharedMemorySize, LDS_BYTES) != hipSuccess) { fprintf(stderr, "kernel_launch: hipFuncSetAttribute failed\n"); grid = -1; return; }
        if (hipOccupancyMaxActiveBlocksPerMultiprocessor(&per_cu, (const void*)yoco_fwd, NWAVES * 64, LDS_BYTES) != hipSuccess || per_cu < 1)
            fprintf(stderr, "kernel_launch: note: occupancy query reports %d workgroups per CU\n", per_cu);
        (void)hipGetLastError();
        grid = cus;
    }
    if (grid < 0) return;
    if (hipMemsetAsync((char*)d_ws + WS_CTL, 0, CTL_ZERO_BYTES, stream) != hipSuccess) return;
    Args a{};
    for (int i = 0; i < 16; ++i) a.in[i] = (const float*)d_in[i];
    a.out = (float*)d_out; a.ws = (unsigned char*)d_ws;
#if MK_PER_PHASE
    for (int k = 0; k < N_PHASES_K; ++k) { a.ph_lo = k; a.ph_hi = k + 1; hipLaunchKernelGGL(yoco_fwd, dim3(grid), dim3(NWAVES * 64), LDS_BYTES, stream, a); }
#else
    a.ph_lo = 0; a.ph_hi = N_PHASES_K;
    hipLaunchKernelGGL(yoco_fwd, dim3(grid), dim3(NWAVES * 64), LDS_BYTES, stream, a);
#endif
    const hipError_t le = hipPeekAtLastError();
    if (le != hipSuccess) fprintf(stderr, "kernel_launch: launch failed: %s\n", hipGetErrorName(le));
}
```

```cpp
#include <hip/hip_runtime.h>
#include <hip/hip_bf16.h>
#include <cstdio>
#include <cstdint>
#include <cmath>

namespace pg8 {
#define PG8_LAS __attribute__((address_space(3)))
typedef unsigned short bf16_t;
typedef short bf16x8 __attribute__((ext_vector_type(8)));
typedef float f32x4 __attribute__((ext_vector_type(4)));
typedef unsigned u32x4 __attribute__((ext_vector_type(4)));
#define PG8_GAS __attribute__((address_space(1)))
#ifndef PG8_WGM
#define PG8_WGM 4
#endif
#ifndef PG8_STORE_NT
#define PG8_STORE_NT 0
#endif
#ifndef PG8_STORE_SC1
#define PG8_STORE_SC1 0
#endif
constexpr int BM = 256, BK = 64, HALF = 128, HTB = HALF * BK * 2  , STAGE_BYTES = 8 * HTB, NXCD = 8;

__host__ __device__ __forceinline__ int lds_byte(int r, int c) { const int st = (r >> 4) * 2 + (c >> 5), rr = r & 15, cc = c & 31, ob = rr * 64 + cc * 2; return st * 1024 + (ob ^ (((ob >> 9) & 1) << 5)); }
__host__ __device__ __forceinline__ void stage_rc(int b, int& R, int& C) { const int st = b / 1024, sb = b % 1024, swz = sb ^ (((sb >> 9) & 1) << 5); R = (st >> 1) * 16 + swz / 64; C = (st & 1) * 32 + (swz % 64) / 2; }
__host__ __device__ __forceinline__ int perm32(int rho) { const int n = rho >> 4, i = rho & 15; return 8 * (i >> 2) + 4 * n + (i & 3); }

struct Unit { int pm, pn; };
struct Gemm { const bf16_t* A; const bf16_t* Bt; int M, N, K, lda; const bf16_t* A2; int msplit; };

struct StaticOrder {
    int nM, nN, nwg, G, c, WGM;
    __host__ __device__ void init(int M, int N, int G_, int c_, int wgm = PG8_WGM) { nM = M / BM; nN = N / BM; nwg = nM * nN; G = G_; c = c_; WGM = wgm; }
    __host__ __device__ bool next(int i, Unit& u) const {
        if (WGM < 0) {
            const int ncx = nN / NXCD, e = i * (G / NXCD) + c / NXCD; if (e >= nM * ncx) return false;
            u.pm = e / ncx; u.pn = (c % NXCD) * ncx + e % ncx; return true; }
        const long L = (long)i * G + c; if (L >= nwg) return false;
        int wgid = (int)L; { const int q = nwg / NXCD, r = nwg % NXCD, xcd = wgid % NXCD, off = wgid / NXCD; wgid = (xcd < r ? xcd * (q + 1) : r * (q + 1) + (xcd - r) * q) + off; }
        const int nig = WGM * nN, gid = wgid / nig, fm = gid * WGM, gsz = (nM - fm) < WGM ? (nM - fm) : WGM;
        u.pm = fm + ((wgid % nig) % gsz); u.pn = (wgid % nig) / gsz; return true;
    }
    __device__ __forceinline__ void a_ready(const Unit&) const {}
    __device__ __forceinline__ void done(const Unit&) const {}
};

__device__ __forceinline__ unsigned cvt_pk_bf16(float lo, float hi) { unsigned r; asm volatile("v_cvt_pk_bf16_f32 %0, %1, %2" : "=v"(r) : "v"(lo), "v"(hi)); return r; }

template <int ACT> struct EpiStore {
    static constexpr bool PERM = true, AFTER_DRAIN = false;
    bf16_t* O; int ldc; int split_cols; size_t split_stride; int scale_tile; float scale0; bf16_t* halo; bf16_t* O2; int row_split;
    __device__ __forceinline__ void operator()(const f32x4 (&acc)[2][2][4][2], const Unit& u, int wr, int wc, int fr, int fq) const {
        const int row0 = u.pm * BM + wr * 64 + fr; int colt = u.pn * BM; PG8_GAS bf16_t* base = (PG8_GAS bf16_t*)O; PG8_GAS bf16_t* hal = (PG8_GAS bf16_t*)halo;
        int t = 0; if (split_cols) { t = colt / split_cols; base += (size_t)t * split_stride; colt -= t * split_cols; }
        if (O2 != nullptr && u.pm * BM >= row_split) base = (PG8_GAS bf16_t*)O2 - (size_t)row_split * ldc;
        const float sc = (t == scale_tile) ? scale0 : 1.f;
        const int col0 = colt + wc * 32 + 8 * fq;
#pragma unroll
        for (int ai = 0; ai < 2; ++ai)
#pragma unroll
            for (int m = 0; m < 4; ++m) { const int row = row0 + ai * HALF + m * 16; PG8_GAS bf16_t* rowp = base + (size_t)row * ldc + col0;
#pragma unroll
                for (int bj = 0; bj < 2; ++bj) { f32x4 v0 = acc[ai][bj][m][0], v1 = acc[ai][bj][m][1];
                    if (ACT == 1) {
#pragma unroll
                        for (int e = 0; e < 4; ++e) { const float a = fmaxf(v0[e], 0.f), b = fmaxf(v1[e], 0.f); v0[e] = a * a; v1[e] = b * b; } }
                    if (sc != 1.f) { v0 = v0 * sc; v1 = v1 * sc; }
                    u32x4 w; w.x = cvt_pk_bf16(v0[0], v0[1]); w.y = cvt_pk_bf16(v0[2], v0[3]); w.z = cvt_pk_bf16(v1[0], v1[1]); w.w = cvt_pk_bf16(v1[2], v1[3]);
#if PG8_STORE_SC1
                    if (O != nullptr) asm volatile("global_store_dwordx4 %0, %1, off sc1\n\ts_nop 1" :: "v"(rowp + bj * HALF), "v"(w) : "memory"); else asm volatile("" :: "v"(w));
#else
                    if (O != nullptr) { if (PG8_STORE_NT) __builtin_nontemporal_store(w, (PG8_GAS u32x4*)(rowp + bj * HALF)); else *(PG8_GAS u32x4*)(rowp + bj * HALF) = w; } else asm volatile("" :: "v"(w));
#endif
                    if (halo != nullptr && m == 3 && fr >= 13) { const int c = col0 + bj * HALF; if (c < 6144) *(PG8_GAS u32x4*)(hal + ((size_t)(row >> 6) * 3 + (fr - 13)) * 6144 + c) = w; }
                } }
    }
};
struct EpiLn {
    static constexpr bool PERM = false, AFTER_DRAIN = false;
    static constexpr float alpha = 1.6817928305074292f  , eps = 1e-5f;
    const bf16_t* xold; bf16_t* xnew; float* outf; const float* g; const float* b;
    unsigned long long* slots; unsigned* cnt; unsigned* tmo; int panel0;
    PG8_LAS unsigned char* scr;
    __device__ __forceinline__ void operator()(f32x4 (&acc)[2][2][4][2], const Unit& u, int wr, int wc, int fr, int fq) const {
        typedef float f32x2v __attribute__((ext_vector_type(2))); typedef unsigned u32x2v __attribute__((ext_vector_type(2)));
        const int tid = threadIdx.x, lane = tid & 63, wid = __builtin_amdgcn_readfirstlane(tid >> 6);
        PG8_LAS f32x2v* P = (PG8_LAS f32x2v*)scr;
        PG8_LAS f32x2v* S = (PG8_LAS f32x2v*)(scr + 8192);
        PG8_LAS unsigned* flag = (PG8_LAS unsigned*)(scr + 8192 + 2048);
        const int row0 = u.pm * BM + wr * 64 + fr, col0 = u.pn * BM + wc * 32 + 4 * fq;
        const PG8_GAS bf16_t* xo = (const PG8_GAS bf16_t*)xold;
#pragma unroll
        for (int ai = 0; ai < 2; ++ai) { u32x2v xv[4][2][2];
#pragma unroll
            for (int m = 0; m < 4; ++m) { const unsigned off = (unsigned)(row0 + ai * HALF + m * 16) * 2048u + (unsigned)col0;
#pragma unroll
                for (int bj = 0; bj < 2; ++bj)
#pragma unroll
                    for (int n = 0; n < 2; ++n) xv[m][bj][n] = *(const PG8_GAS u32x2v*)(xo + off + bj * HALF + n * 16); }
#pragma unroll
            for (int m = 0; m < 4; ++m)
#pragma unroll
                for (int bj = 0; bj < 2; ++bj)
#pragma unroll
                    for (int n = 0; n < 2; ++n) { const u32x2v w = xv[m][bj][n]; f32x4 x;
                        x[0] = __builtin_bit_cast(float, w.x << 16); x[1] = __builtin_bit_cast(float, w.x & 0xffff0000u); x[2] = __builtin_bit_cast(float, w.y << 16); x[3] = __builtin_bit_cast(float, w.y & 0xffff0000u);
                        acc[ai][bj][m][n] = x * alpha + acc[ai][bj][m][n]; }
            asm volatile("" ::: "memory"); }
#pragma unroll
        for (int ai = 0; ai < 2; ++ai)
#pragma unroll
            for (int m = 0; m < 4; ++m) {
                float s = 0.f;
#pragma unroll
                for (int bj = 0; bj < 2; ++bj)
#pragma unroll
                    for (int n = 0; n < 2; ++n) { const f32x4 x = acc[ai][bj][m][n]; s += (x[0] + x[1]) + (x[2] + x[3]); }
                s += __shfl_xor(s, 16); s += __shfl_xor(s, 32);
                const float mw = s * (1.0f / 64.0f); float q = 0.f;
#pragma unroll
                for (int bj = 0; bj < 2; ++bj)
#pragma unroll
                    for (int n = 0; n < 2; ++n) { const f32x4 d = acc[ai][bj][m][n] - mw; q += (d[0] * d[0] + d[1] * d[1]) + (d[2] * d[2] + d[3] * d[3]); }
                q += __shfl_xor(q, 16); q += __shfl_xor(q, 32);
                if (fq == 0) P[(ai * HALF + wr * 64 + m * 16 + fr) * 4 + wc] = (f32x2v){mw, q};
            }
        asm volatile("s_waitcnt lgkmcnt(0)" ::: "memory"); __builtin_amdgcn_s_barrier(); asm volatile("" ::: "memory");
        const int panel = panel0 + u.pm; const int row = wid * 32 + (lane & 31);
        if (lane < 32) {
            const f32x2v a = P[row * 4 + 0], bq = P[row * 4 + 1], c = P[row * 4 + 2], d = P[row * 4 + 3];
            const float mt = (a.x + bq.x + c.x + d.x) * 0.25f;
            const float da = a.x - mt, db = bq.x - mt, dc = c.x - mt, dd = d.x - mt;
            const float m2 = (a.y + bq.y) + (c.y + d.y) + 64.0f * ((da * da + db * db) + (dc * dc + dd * dd));
            unsigned long long* slot = slots + ((size_t)(panel * BM + row) * 8 + u.pn);
            __hip_atomic_store(slot, ((unsigned long long)__float_as_uint(m2) << 32) | __float_as_uint(mt), __ATOMIC_RELAXED, __HIP_MEMORY_SCOPE_AGENT);
        }
        asm volatile("s_waitcnt vmcnt(0)" ::: "memory");
        if (lane == 0) __hip_atomic_fetch_add(cnt + 64 * panel, 1u, __ATOMIC_RELAXED, __HIP_MEMORY_SCOPE_AGENT);
        if (wid == 0) {
            bool dead = false; const unsigned long long t0 = __builtin_amdgcn_s_memrealtime();
            for (;;) {
                if ((unsigned)__builtin_amdgcn_readfirstlane(__hip_atomic_load(cnt + 64 * panel, __ATOMIC_RELAXED, __HIP_MEMORY_SCOPE_AGENT)) >= 64u) break;
                if (__builtin_amdgcn_s_memrealtime() - t0 > 2000000ull) { if (lane == 0) __hip_atomic_store(tmo, 1u, __ATOMIC_RELAXED, __HIP_MEMORY_SCOPE_AGENT); dead = true; break; }
                __builtin_amdgcn_s_sleep(2);
            }
            __builtin_amdgcn_fence(__ATOMIC_ACQUIRE, "agent");
            if (lane == 0) flag[0] = dead ? 1u : 0u;
        }
        asm volatile("s_waitcnt vmcnt(0) lgkmcnt(0)" ::: "memory"); __builtin_amdgcn_s_barrier(); asm volatile("" ::: "memory");
        const bool bad = flag[0] != 0u;
        if (lane < 32) {
            const unsigned long long* slot = slots + (size_t)(panel * BM + row) * 8; float mt[8], m2[8]; float ms = 0.f;
#pragma unroll
            for (int t = 0; t < 8; ++t) { const unsigned long long w = __hip_atomic_load(slot + t, __ATOMIC_RELAXED, __HIP_MEMORY_SCOPE_AGENT); mt[t] = __uint_as_float((unsigned)w); m2[t] = __uint_as_float((unsigned)(w >> 32)); ms += mt[t]; }
            const float mean = ms * 0.125f; float q = 0.f;
#pragma unroll
            for (int t = 0; t < 8; ++t) { const float dm = mt[t] - mean; q += m2[t] + 256.0f * dm * dm; }
            S[row] = (f32x2v){mean, 1.0f / sqrtf(q * (1.0f / 2048.0f) + eps)};
        }
        asm volatile("s_waitcnt lgkmcnt(0)" ::: "memory"); __builtin_amdgcn_s_barrier(); asm volatile("" ::: "memory");
        const PG8_GAS float* gg = (const PG8_GAS float*)g; const PG8_GAS float* bg = (const PG8_GAS float*)b; const float qnan = __builtin_nanf("");
#pragma unroll
        for (int bj = 0; bj < 2; ++bj)
#pragma unroll
            for (int n = 0; n < 2; ++n) { const f32x4 gv = *(const PG8_GAS f32x4*)(gg + col0 + bj * HALF + n * 16), bv = *(const PG8_GAS f32x4*)(bg + col0 + bj * HALF + n * 16);
#pragma unroll
                for (int ai = 0; ai < 2; ++ai)
#pragma unroll
                    for (int m = 0; m < 4; ++m) { const int r = ai * HALF + wr * 64 + m * 16 + fr; const f32x2v sr = S[r]; const unsigned off = (unsigned)(u.pm * BM + r) * 2048u + (unsigned)(col0 + bj * HALF + n * 16);
                        f32x4 o = ((acc[ai][bj][m][n] - sr.x) * sr.y) * gv + bv; if (bad) o = (f32x4){qnan, qnan, qnan, qnan};
                        if (outf) *(PG8_GAS f32x4*)((PG8_GAS float*)outf + off) = o;
                        else { u32x2v w; w.x = cvt_pk_bf16(o[0], o[1]); w.y = cvt_pk_bf16(o[2], o[3]); *(PG8_GAS u32x2v*)((PG8_GAS bf16_t*)xnew + off) = w; } } }
        asm volatile("s_waitcnt lgkmcnt(0)" ::: "memory"); __builtin_amdgcn_s_barrier(); asm volatile("" ::: "memory");
    }
};

template <class Epi, class Sched, bool ALIGN_EPI = false, bool SP2 = false>
__device__ __forceinline__ void gemm_phase(PG8_LAS unsigned char* lds, const Gemm g, const Sched& S, const Epi& E) {
    int tid_ = threadIdx.x; asm volatile("" : "+v"(tid_));
    const int tid = tid_, wid = __builtin_amdgcn_readfirstlane(tid >> 6), lane = tid & 63, wr = wid >> 2, wc = wid & 3, fr = lane & 15, fq = lane >> 4;
    const int K = g.K, nt = K / BK, lda = g.lda;
    unsigned voffA[2], voffB[2];
#pragma unroll
    for (int i = 0; i < 2; ++i) { int R, C; stage_rc(tid * 16 + i * 8192, R, C); const int Rb = Epi::PERM ? ((R & ~31) + perm32(R & 31)) : R;
        voffA[i] = (unsigned)(R * lda + C) * 2u; voffB[i] = (unsigned)(Rb * K + C) * 2u; }
    const size_t kstep = (size_t)(BK * 2);
    const size_t hA = (size_t)HALF * lda * 2, hB = (size_t)HALF * K * 2;
    const size_t tA = 2 * hA, tB = 2 * hB;
    const unsigned ldsw = (unsigned)wid * 1024u;
    const int aoff = lds_byte(wr * 64 + fr, fq * 8), boff = lds_byte(wc * 32 + fr, fq * 8);
#define PG8_SA(b, h) (((b) * 2 + (h)) * HTB)
#define PG8_SB(b, h) ((4 + (b) * 2 + (h)) * HTB)
#define PG8_STAGE(bufoff, gbase, voff) do { _Pragma("unroll") for (int _i = 0; _i < 2; ++_i) \
        __builtin_amdgcn_global_load_lds((const unsigned*)((const char*)(gbase) + (voff)[_i]), (PG8_LAS unsigned*)(lds + (bufoff) + ldsw + _i * 8192), 16, 0, 0); } while (0)
#define PG8_LDA(dst, b, h) do { _Pragma("unroll") for (int m = 0; m < 4; ++m) _Pragma("unroll") for (int k = 0; k < 2; ++k) dst[m][k] = *(const PG8_LAS bf16x8*)(lds + PG8_SA(b, h) + aoff + m * 2048 + k * 1024); } while (0)
#define PG8_LDB(dst, b, h) do { _Pragma("unroll") for (int n = 0; n < 2; ++n) _Pragma("unroll") for (int k = 0; k < 2; ++k) dst[n][k] = *(const PG8_LAS bf16x8*)(lds + PG8_SB(b, h) + boff + n * 2048 + k * 1024); } while (0)
#define PG8_MMA(ai, bj, At, Bt) do { __builtin_amdgcn_s_setprio(1); _Pragma("unroll") for (int m = 0; m < 4; ++m) _Pragma("unroll") for (int n = 0; n < 2; ++n) _Pragma("unroll") for (int k = 0; k < 2; ++k) \
        acc[ai][bj][m][n] = __builtin_amdgcn_mfma_f32_16x16x32_bf16(Bt[n][k], At[m][k], acc[ai][bj][m][n], 0, 0, 0); __builtin_amdgcn_s_setprio(0); } while (0)
#define PG8_WAIT_V(n) asm volatile("s_waitcnt vmcnt(" #n ")" ::: "memory")
#define PG8_WAIT_L(n) asm volatile("s_waitcnt lgkmcnt(" #n ")" ::: "memory")
#define PG8_BAR __builtin_amdgcn_s_barrier()
#define PG8_SCHED __builtin_amdgcn_sched_barrier(0)
    Unit cur, nxt; int ui = 0;
    if (!S.next(0, cur)) return;
    f32x4 acc[2][2][4][2];
#pragma unroll
    for (int a = 0; a < 2; ++a)
#pragma unroll
        for (int b = 0; b < 2; ++b)
#pragma unroll
            for (int m = 0; m < 4; ++m)
#pragma unroll
                for (int n = 0; n < 2; ++n) acc[a][b][m][n] = (f32x4){0.f, 0.f, 0.f, 0.f};
    bf16x8 At[4][2], B0[2][2], B1[2][2];
#define PG8_AOF(pm_) ((g.A2 != nullptr && (pm_) >= g.msplit) ? (const char*)g.A2 + (size_t)((pm_) - g.msplit) * tA : (const char*)g.A + (size_t)(pm_) * tA)
    const char* cA = PG8_AOF(cur.pm); const char* cB = (const char*)g.Bt + (size_t)cur.pn * tB;
    S.a_ready(cur);
    if constexpr (SP2) {
        PG8_STAGE(PG8_SB(0, 0), cB, voffB); PG8_STAGE(PG8_SB(0, 1), cB + hB, voffB); PG8_STAGE(PG8_SA(0, 0), cA, voffA); PG8_STAGE(PG8_SA(0, 1), cA + hA, voffA);
        if (wr == 1) PG8_BAR;
        PG8_WAIT_V(2); PG8_BAR;
        PG8_STAGE(PG8_SB(1, 0), cB + kstep, voffB); PG8_STAGE(PG8_SA(1, 0), cA + kstep, voffA); PG8_STAGE(PG8_SB(1, 1), cB + hB + kstep, voffB);
        PG8_WAIT_V(6); PG8_BAR;
    } else {
        PG8_STAGE(PG8_SB(0, 0), cB, voffB); PG8_STAGE(PG8_SA(0, 0), cA, voffA); PG8_STAGE(PG8_SB(0, 1), cB + hB, voffB); PG8_STAGE(PG8_SA(0, 1), cA + hA, voffA);
        if (wr == 1) PG8_BAR;
        PG8_WAIT_V(4); PG8_BAR;
        PG8_STAGE(PG8_SB(1, 0), cB + kstep, voffB); PG8_STAGE(PG8_SA(1, 0), cA + kstep, voffA); PG8_STAGE(PG8_SB(1, 1), cB + hB + kstep, voffB);
        PG8_WAIT_V(6); PG8_BAR;
    }
    for (;;) {
        const bool has_next = S.next(ui + 1, nxt);
        const char* nA = has_next ? PG8_AOF(nxt.pm) : cA; const char* nB = has_next ? (const char*)g.Bt + (size_t)nxt.pn * tB : cB;
        for (int t = 0; t < nt; t += 2) {
            const bool last = (t == nt - 2);
            const char* a1 = cA + (size_t)(t + 1) * kstep;
            const char* a2 = last ? nA : cA + (size_t)(t + 2) * kstep; const char* b2 = last ? nB : cB + (size_t)(t + 2) * kstep;
            const char* a3 = a2 + kstep; const char* b3 = b2 + kstep;
            if (last && has_next) S.a_ready(nxt);
            if constexpr (SP2) {
            PG8_LDB(B0, 0, 0); PG8_LDB(B1, 0, 1); PG8_SCHED; PG8_LDA(At, 0, 0); PG8_STAGE(PG8_SA(1, 1), a1 + hA, voffA);
            PG8_WAIT_V(8); PG8_WAIT_L(0); PG8_BAR; PG8_MMA(0, 0, At, B0); PG8_MMA(0, 1, At, B1); PG8_BAR; PG8_SCHED;
            PG8_LDA(At, 0, 1); PG8_STAGE(PG8_SB(0, 0), b2, voffB); PG8_STAGE(PG8_SB(0, 1), b2 + hB, voffB); PG8_STAGE(PG8_SA(0, 0), a2, voffA);
            PG8_WAIT_V(8); PG8_WAIT_L(0); PG8_BAR; PG8_MMA(1, 0, At, B0); PG8_MMA(1, 1, At, B1); PG8_BAR; PG8_SCHED;
            PG8_LDB(B0, 1, 0); PG8_LDB(B1, 1, 1); PG8_SCHED; PG8_LDA(At, 1, 0); PG8_STAGE(PG8_SA(0, 1), a2 + hA, voffA);
            PG8_WAIT_V(8); PG8_WAIT_L(0); PG8_BAR; PG8_MMA(0, 0, At, B0); PG8_MMA(0, 1, At, B1); PG8_BAR; PG8_SCHED;
            PG8_LDA(At, 1, 1); PG8_STAGE(PG8_SB(1, 0), b3, voffB); PG8_STAGE(PG8_SB(1, 1), b3 + hB, voffB); PG8_STAGE(PG8_SA(1, 0), a3, voffA);
            PG8_WAIT_V(8); PG8_WAIT_L(0); PG8_BAR; PG8_MMA(1, 0, At, B0); PG8_MMA(1, 1, At, B1); PG8_BAR; PG8_SCHED;
            } else {
            PG8_LDB(B0, 0, 0); PG8_SCHED; PG8_LDA(At, 0, 0); PG8_STAGE(PG8_SA(1, 1), a1 + hA, voffA);
            PG8_WAIT_L(8); PG8_BAR; PG8_WAIT_L(0); PG8_MMA(0, 0, At, B0); PG8_BAR; PG8_SCHED;
            PG8_LDB(B1, 0, 1); PG8_STAGE(PG8_SB(0, 0), b2, voffB);
            PG8_BAR; PG8_WAIT_L(0); PG8_MMA(0, 1, At, B1); PG8_BAR;
            PG8_LDA(At, 0, 1); PG8_STAGE(PG8_SA(0, 0), a2, voffA);
            PG8_BAR; PG8_WAIT_L(0); PG8_MMA(1, 0, At, B0); PG8_BAR; PG8_SCHED;
            PG8_STAGE(PG8_SB(0, 1), b2 + hB, voffB);
            PG8_WAIT_V(6); PG8_BAR; PG8_MMA(1, 1, At, B1); PG8_BAR;
            PG8_LDB(B0, 1, 0); PG8_SCHED; PG8_LDA(At, 1, 0); PG8_STAGE(PG8_SA(0, 1), a2 + hA, voffA);
            PG8_WAIT_L(8); PG8_BAR; PG8_WAIT_L(0); PG8_MMA(0, 0, At, B0); PG8_BAR; PG8_SCHED;
            PG8_LDB(B1, 1, 1); PG8_STAGE(PG8_SB(1, 0), b3, voffB);
            PG8_BAR; PG8_WAIT_L(0); PG8_MMA(0, 1, At, B1); PG8_BAR;
            PG8_LDA(At, 1, 1); PG8_STAGE(PG8_SA(1, 0), a3, voffA);
            PG8_BAR; PG8_WAIT_L(0); PG8_MMA(1, 0, At, B0); PG8_BAR; PG8_SCHED;
            PG8_STAGE(PG8_SB(1, 1), b3 + hB, voffB);
            PG8_WAIT_V(6); PG8_BAR; PG8_MMA(1, 1, At, B1); PG8_BAR;
            }
        }
        if constexpr (ALIGN_EPI) { if (wr == 0) PG8_BAR; }
        if constexpr (!Epi::AFTER_DRAIN) { E(acc, cur, wr, wc, fr, fq); S.done(cur); }
        if (!has_next) break;
#pragma unroll
        for (int a = 0; a < 2; ++a)
#pragma unroll
            for (int b = 0; b < 2; ++b)
#pragma unroll
                for (int m = 0; m < 4; ++m)
#pragma unroll
                    for (int n = 0; n < 2; ++n) acc[a][b][m][n] = (f32x4){0.f, 0.f, 0.f, 0.f};
        cur = nxt; cA = nA; cB = nB; ++ui;
        if constexpr (ALIGN_EPI) { if (wr == 1) PG8_BAR; }
    }
    PG8_WAIT_V(0);
    if constexpr (!ALIGN_EPI) { if (wr == 0) PG8_BAR; }
    PG8_BAR;
#undef PG8_AOF
#undef PG8_SA
#undef PG8_SB
#undef PG8_STAGE
#undef PG8_LDA
#undef PG8_LDB
#undef PG8_MMA
#undef PG8_WAIT_V
#undef PG8_WAIT_L
#undef PG8_BAR
#undef PG8_SCHED
}
}
#ifndef ATTN_SHARE8
#define ATTN_SHARE8 1
#endif
#ifndef ATTN_PRIO
#define ATTN_PRIO 0
#endif
namespace dattn {
using bf16=__hip_bfloat16;
using bf16x8=__attribute__((ext_vector_type(8)))short;
using s16x4=__attribute__((ext_vector_type(4)))short;
using f32x16=__attribute__((ext_vector_type(16)))float;
using u32x4=__attribute__((ext_vector_type(4)))unsigned;
constexpr int SEQ=4096,DM=2048,HDV=128;
constexpr int NW=8,QBLK=32,QB=128,KVBLK=64,NQB=SEQ/QB;
__device__ __forceinline__ int crow(int r,int hi){return (r&3)+8*(r>>2)+4*hi;}
#define SBAR() __builtin_amdgcn_sched_barrier(0)
__device__ __forceinline__ void cmask(f32x16&p0,f32x16&p1,int jb,int qrel,int hi){
  const float NEG=-INFINITY; int kb=64*jb+4*hi;
  #pragma unroll
  for(int r=0;r<16;++r){int kv=kb+(r&3)+8*(r>>2); if(kv>qrel)p0[r]=NEG; if(kv+32>qrel)p1[r]=NEG;}
}
constexpr float C2=0.125f*1.4426950408889634f;
constexpr int NSLOT=3, SLOTB=16384;
constexpr int LDS_K=0, LDS_V=NSLOT*SLOTB, LDS_WS=2*NSLOT*SLOTB, LDS_KX=LDS_WS+NW*64*4, LDS_SW=LDS_KX+SLOTB, LDS_QX=LDS_SW+512, LDS_BYTES=LDS_QX+NW*4096;
__device__ __forceinline__ void glds16(const void*gsrc,unsigned lds_dst){unsigned keep;
  asm volatile("s_mov_b32 %0, m0\n\ts_mov_b32 m0, %2\n\ts_nop 0\n\tglobal_load_lds_dwordx4 %1, off\n\ts_mov_b32 m0, %0":"=&s"(keep):"v"(gsrc),"s"(lds_dst):"memory");}
__device__ __forceinline__ void gld16(bf16x8&d,const void*g){ asm volatile("global_load_dwordx4 %0, %1, off":"=v"(d):"v"(g):"memory"); }
__device__ __forceinline__ float max3f(float a,float b,float c){float r;asm("v_max3_f32 %0, %1, %2, %3":"=v"(r):"v"(a),"v"(b),"v"(c));return r;}
__device__ __forceinline__ float max2f(float a,float b){float r;asm("v_max_f32_e32 %0, %1, %2":"=v"(r):"v"(a),"v"(b));return r;}
__device__ __forceinline__ float fadd_s(float a,float b){float r;asm("v_add_f32_e32 %0, %1, %2":"=v"(r):"v"(a),"v"(b));return r;}
__device__ __forceinline__ float fsub_s(float a,float b){float r;asm("v_sub_f32_e32 %0, %1, %2":"=v"(r):"v"(a),"v"(b));return r;}
typedef float f32x2_t __attribute__((ext_vector_type(2))); typedef __bf16 bf16x2_t __attribute__((ext_vector_type(2)));
__device__ __forceinline__ unsigned cvtpk_s(float lo,float hi){f32x2_t v={lo,hi};bf16x2_t b=__builtin_convertvector(v,bf16x2_t);return __builtin_bit_cast(unsigned,b);}
#define WAIT_BAR(N) asm volatile("s_waitcnt vmcnt(" #N ") lgkmcnt(0)\n\ts_barrier":::"memory")
typedef __attribute__((address_space(3))) const char* lds_cptr;
typedef short v4i16_t __attribute__((ext_vector_type(4)));
__device__ __forceinline__ void qkt(f32x16&p0,f32x16&p1,const char*kb,const bf16x8*qr){ const f32x16 negm=f32x16{};
  #pragma unroll
  for(int d0=0;d0<4;++d0){
    const bf16x8 b0=*reinterpret_cast<const bf16x8*>(kb+d0*2048);
    const bf16x8 b1=*reinterpret_cast<const bf16x8*>(kb+d0*2048+512);
    if(d0==0){p0=__builtin_amdgcn_mfma_f32_32x32x16_bf16(b0,qr[0],negm,0,0,0);p1=__builtin_amdgcn_mfma_f32_32x32x16_bf16(b1,qr[0],negm,0,0,0);}
    else{p0=__builtin_amdgcn_mfma_f32_32x32x16_bf16(b0,qr[d0],p0,0,0,0);p1=__builtin_amdgcn_mfma_f32_32x32x16_bf16(b1,qr[d0],p1,0,0,0);}}
}
__device__ __forceinline__ void kload8(bf16x8*kf,lds_cptr kp){
  kf[0]=*(const __attribute__((address_space(3))) bf16x8*)(kp);      kf[1]=*(const __attribute__((address_space(3))) bf16x8*)(kp+512);
  kf[2]=*(const __attribute__((address_space(3))) bf16x8*)(kp+2048); kf[3]=*(const __attribute__((address_space(3))) bf16x8*)(kp+2560);
  kf[4]=*(const __attribute__((address_space(3))) bf16x8*)(kp+4096); kf[5]=*(const __attribute__((address_space(3))) bf16x8*)(kp+4608);
  kf[6]=*(const __attribute__((address_space(3))) bf16x8*)(kp+6144); kf[7]=*(const __attribute__((address_space(3))) bf16x8*)(kp+6656);
}
__device__ __forceinline__ void kload2(bf16x8*kf,lds_cptr kp,int j){ kf[2*j]=*(const __attribute__((address_space(3))) bf16x8*)(kp+j*2048); kf[2*j+1]=*(const __attribute__((address_space(3))) bf16x8*)(kp+j*2048+512); }
__device__ __forceinline__ s16x4 vtr(lds_cptr p){ return __builtin_bit_cast(s16x4,__builtin_amdgcn_ds_read_tr16_b64_v4i16((__attribute__((address_space(3))) v4i16_t*)p)); }
__device__ __forceinline__ float rowmax(const f32x16&p0,const f32x16&p1){
  float a=max3f(p0[0],p0[1],p1[0]),b=max3f(p0[2],p0[3],p1[1]);a=max3f(a,p1[2],p1[3]);
  #pragma unroll
  for(int r=4;r<16;r+=4){a=max3f(a,p0[r],p0[r+1]);b=max3f(b,p0[r+2],p0[r+3]);a=max3f(a,p1[r],p1[r+1]);b=max3f(b,p1[r+2],p1[r+3]);}
  const float m=max2f(a,b);
  auto rr=__builtin_amdgcn_permlane32_swap(__float_as_uint(m),__float_as_uint(m),false,false);
  return max2f(__uint_as_float(rr[0]),__uint_as_float(rr[1]));
}
__device__ __forceinline__ void pv(f32x16*o,int vb,bf16x8 pa0,bf16x8 pa1,bf16x8 pa2,bf16x8 pa3){
  #pragma unroll
  for(int d0=0;d0<4;++d0){s16x4 lo[4],hi[4];
    #pragma unroll
    for(int ks=0;ks<4;++ks){
      asm volatile("ds_read_b64_tr_b16 %0,%1 offset:%c2":"=&v"(lo[ks]):"v"(vb),"i"(d0*4096+ks*1024):"memory");
      asm volatile("ds_read_b64_tr_b16 %0,%1 offset:%c2":"=&v"(hi[ks]):"v"(vb),"i"(d0*4096+ks*1024+512):"memory");}
    asm volatile("s_waitcnt lgkmcnt(0)":::"memory");SBAR();
    #define PK(k) (bf16x8){lo[k][0],lo[k][1],lo[k][2],lo[k][3],hi[k][0],hi[k][1],hi[k][2],hi[k][3]}
    o[d0]=__builtin_amdgcn_mfma_f32_32x32x16_bf16(pa0,PK(0),o[d0],0,0,0);
    o[d0]=__builtin_amdgcn_mfma_f32_32x32x16_bf16(pa1,PK(1),o[d0],0,0,0);
    o[d0]=__builtin_amdgcn_mfma_f32_32x32x16_bf16(pa2,PK(2),o[d0],0,0,0);
    o[d0]=__builtin_amdgcn_mfma_f32_32x32x16_bf16(pa3,PK(3),o[d0],0,0,0);
    #undef PK
  }
}

struct Params { const bf16* Q; const bf16* K; const bf16* V; bf16* O; const float* subln_w; float lam, post; };
template<int THRL> __device__ __forceinline__ void unit(int b,int h,int qb,const Params&P,char*shm,const bool pre,const bool has_next,const int nb,const int nh,const int nqb){
  int tid_=threadIdx.x; asm volatile("":"+v"(tid_));
  const int tid=tid_,lane=tid&63,r32=lane&31,hi=lane>>5; const int wid=__builtin_amdgcn_readfirstlane(tid>>6);
  const int cmp=wid&1,rbk=wid>>1;
  if(ATTN_PRIO&&wid>=4)__builtin_amdgcn_s_setprio(1);
  const long rowbase=(long)b*SEQ; const int q0=qb*QB;
  const bf16*Qw=P.Q+(rowbase+q0+rbk*QBLK)*DM+h*HDV+cmp*64;
  const bf16*Kh=P.K+rowbase*DM+h*HDV,*Vh=P.V+rowbase*DM+h*HDV;
  const unsigned lds0=(unsigned)(uintptr_t)shm;
  float*wsf=(float*)(shm+LDS_WS)+wid*64;
  const bf16*ksrc=Kh+(long)lane*DM+wid*8;
  const bf16*vsrc=Vh+(long)(16*(wid&3)+(lane>>2))*DM+(wid>>2)*32+(lane&3)*8;
  const unsigned kdst=lds0+LDS_K+wid*1024, vdst=lds0+LDS_V+wid*1024;
  #define DMA_K(t,slot) do{ glds16(ksrc+(long)(t)*KVBLK*DM,(unsigned)__builtin_amdgcn_readfirstlane(kdst+(slot))); glds16(ksrc+(long)(t)*KVBLK*DM+64,(unsigned)__builtin_amdgcn_readfirstlane(kdst+(slot)+8192)); }while(0)
  #define DMA_V(t,slot) do{ glds16(vsrc+(long)(t)*KVBLK*DM,(unsigned)__builtin_amdgcn_readfirstlane(vdst+(slot))); glds16(vsrc+(long)(t)*KVBLK*DM+64,(unsigned)__builtin_amdgcn_readfirstlane(vdst+(slot)+8192)); }while(0)
  const int vb0=(int)(lds0+LDS_V)+((lane>>4)&1)*32+(lane&3)*8+(4*hi+((lane&15)>>2))*64;
  bf16x8 kf[8];
  const lds_cptr shm3=(lds_cptr)shm; const lds_cptr kp0=shm3+LDS_K+(cmp*8+hi)*1024+r32*16; const lds_cptr vp0=shm3+LDS_V+((lane>>4)&1)*32+(lane&3)*8+(4*hi+((lane&15)>>2))*64;
  const char*Kbase=shm+LDS_KX+(cmp*8+hi)*1024+r32*16;
  const unsigned kxdst=lds0+LDS_KX+wid*1024;
  #define DMA_KX(src) do{ glds16((src),(unsigned)__builtin_amdgcn_readfirstlane(kxdst)); glds16((src)+64,(unsigned)__builtin_amdgcn_readfirstlane(kxdst+8192)); }while(0)
  const int NT=(q0+QB)/KVBLK;
  if(!pre){DMA_KX(ksrc);} DMA_V(0,0);DMA_K(1,SLOTB);
  const unsigned qxdst=lds0+LDS_QX+wid*4096;
  #define DMA_Q(Qp) do{ _Pragma("unroll") for(int d0=0;d0<4;++d0)glds16(&(Qp)[(long)r32*DM+d0*16+hi*8],(unsigned)__builtin_amdgcn_readfirstlane(qxdst+d0*1024)); }while(0)
  if(!pre){DMA_Q(Qw);}
  float mhat=0.f,l_reg=0.f;f32x16 o[4];o[0]=f32x16{};o[1]=f32x16{};o[2]=f32x16{};o[3]=f32x16{};const f32x16 zero16=f32x16{};
  const int qrel=rbk*QBLK+r32;
  #define CMASK(P0,P1,t) do{int jb_=(t)-(NT-2); if(jb_>=0)cmask(P0,P1,jb_,qrel,hi);}while(0)
  bool resc=false;
  #define START(P0,P1) do{ const float rm=rowmax(P0,P1); resc=false; \
    { const float dl=rm; mhat=fadd_s(mhat,dl); \
      _Pragma("unroll") for(int r=0;r<16;++r){P0[r]=fsub_s(P0[r],dl);P1[r]=fsub_s(P1[r],dl);} } \
    _Pragma("unroll") for(int r=0;r<16;++r)P0[r]=__builtin_amdgcn_exp2f(P0[r]); }while(0)
  #define RESC() do{ if(resc){ asm volatile("s_waitcnt lgkmcnt(0)":::"memory"); \
      _Pragma("unroll") for(int d_=0;d_<4;++d_) _Pragma("unroll") for(int r=0;r<16;++r)o[d_][r]*=wsf[crow(r,hi)]; } }while(0)
  f32x16 pA0,pA1,pB0,pB1;
  int sl_prev=0,sl_cur=0,sl_next=SLOTB;
  #define ROT() do{sl_prev=sl_cur;sl_cur=sl_next;sl_next=(sl_next==(NSLOT-1)*SLOTB)?0:sl_next+SLOTB;}while(0)
  DMA_K(2,2*SLOTB);
  if(pre){WAIT_BAR(6);}
  else   {WAIT_BAR(2);}
  bf16x8 qr[4];
  #pragma unroll
  for(int d0=0;d0<4;++d0)qr[d0]=*(const __attribute__((address_space(3))) bf16x8*)(shm3+LDS_QX+wid*4096+d0*1024+lane*16);
  SBAR();
  qkt(pA0,pA1,Kbase,qr);asm volatile("s_nop 15\n\ts_nop 7":"+v"(pA0),"+v"(pA1));CMASK(pA0,pA1,0);
  START(pA0,pA1);
  _Pragma("unroll") for(int r=0;r<16;++r)pA1[r]=__builtin_amdgcn_exp2f(pA1[r]);
  WAIT_BAR(0);
  DMA_K(3,0);DMA_V(1,SLOTB);
  ROT();
  kload8(kf,kp0+sl_cur);
  if(NT>2){WAIT_BAR(4);}else{WAIT_BAR(0);}
  s16x4 vlo[4],vhi[4]; u32x4 pw0,pw1,pw2,pw3;
  #define PKW(P,B) cvtpk_s(P[B],P[B+1])
  #define PAF(k) __builtin_bit_cast(bf16x8,pw##k)
  #define VFR(i) (bf16x8){vlo[i][0],vlo[i][1],vlo[i][2],vlo[i][3],vhi[i][0],vhi[i][1],vhi[i][2],vhi[i][3]}
  #define PIN(x) asm volatile("":"+v"(x))
  #define MX3(a,b,c) __builtin_fmaxf(__builtin_fmaxf((a),(b)),(c))
  #define GAPA(MF,A0,A1,A2,A3,W0,W1,PW) do{ MF; sacc+=A0; sacc+=A1; sacc+=A2; sacc+=A3; PIN(sacc); W0; W1; PIN(PW); SBAR(); }while(0)
  #define EX(v) __builtin_amdgcn_exp2f((v)-mhat)
  #define VOFF(f) ((((f)&3)*4096)+(((f)>>2)*1024))
  #define VRD(i,f) do{ vlo[i]=vtr(vp_+VOFF(f)); vhi[i]=vtr(vp_+VOFF(f)+512); }while(0)
  #define GAPB(MF,X,B) do{ MF; X[B]=EX(X[B]); X[B+1]=EX(X[B+1]); PIN(X); SBAR(); }while(0)
  #define GAPBV(MF,X,B,i,f) do{ MF; X[B]=EX(X[B]); X[B+1]=EX(X[B+1]); PIN(X); VRD(i,f); SBAR(); }while(0)
  #define KRD(G,j) do{ if(G){ kload2(kf,kp0+sl_next,j); SBAR(); } }while(0)
  #define PVM(d,k,i) o[d]=__builtin_amdgcn_mfma_f32_32x32x16_bf16(PAF(k),VFR(i),o[d],0,0,0)
  #define STEP(C0,C1,P0,P1,t,GK,GV,GL) do{ SBAR(); \
    const lds_cptr vp_=vp0+sl_prev; \
    float sacc=(P0[0]+P0[1]); \
    GAPA(C0=__builtin_amdgcn_mfma_f32_32x32x16_bf16(kf[0],qr[0],zero16,0,0,0), P0[2],P0[3],P0[4],P0[5],     pw0[0]=PKW(P0,0), pw0[1]=PKW(P0,2), pw0); \
    GAPA(C1=__builtin_amdgcn_mfma_f32_32x32x16_bf16(kf[1],qr[0],zero16,0,0,0), P0[6],P0[7],P0[8],P0[9],     pw0[2]=PKW(P0,4), pw0[3]=PKW(P0,6), pw0); \
    GAPA(C0=__builtin_amdgcn_mfma_f32_32x32x16_bf16(kf[2],qr[1],C0,0,0,0),   P0[10],P0[11],P0[12],P0[13], pw1[0]=PKW(P0,8), pw1[1]=PKW(P0,10), pw1); \
    GAPA(C1=__builtin_amdgcn_mfma_f32_32x32x16_bf16(kf[3],qr[1],C1,0,0,0),   P0[14],P0[15],P1[0],P1[1],   pw1[2]=PKW(P0,12),pw1[3]=PKW(P0,14), pw1); \
    VRD(0,0); SBAR(); GAPA(C0=__builtin_amdgcn_mfma_f32_32x32x16_bf16(kf[4],qr[2],C0,0,0,0),   P1[2],P1[3],P1[4],P1[5],     pw2[0]=PKW(P1,0), pw2[1]=PKW(P1,2), pw2); \
    VRD(1,1); SBAR(); GAPA(C1=__builtin_amdgcn_mfma_f32_32x32x16_bf16(kf[5],qr[2],C1,0,0,0),   P1[6],P1[7],P1[8],P1[9],     pw2[2]=PKW(P1,4), pw2[3]=PKW(P1,6), pw2); \
    VRD(2,2); SBAR(); GAPA(C0=__builtin_amdgcn_mfma_f32_32x32x16_bf16(kf[6],qr[3],C0,0,0,0),   P1[10],P1[11],P1[12],P1[13], pw3[0]=PKW(P1,8), pw3[1]=PKW(P1,10), pw3); \
    VRD(3,3); SBAR(); GAPA(C1=__builtin_amdgcn_mfma_f32_32x32x16_bf16(kf[7],qr[3],C1,0,0,0),   P1[14],P1[15],0.f,0.f,       pw3[2]=PKW(P1,12),pw3[3]=PKW(P1,14), pw3); \
    l_reg+=sacc; \
    if(GK){DMA_K((t)+3,sl_cur);} if(GV){DMA_V((t)+1,sl_next);} \
    CMASK(C0,C1,t); \
    { float a=MX3(C0[0],C0[1],C1[0]),b=MX3(C0[2],C0[3],C1[1]); a=MX3(a,C1[2],C1[3]); \
      _Pragma("unroll") for(int r=4;r<16;r+=4){a=MX3(a,C0[r],C0[r+1]);b=MX3(b,C0[r+2],C0[r+3]);a=MX3(a,C1[r],C1[r+1]);b=MX3(b,C1[r+2],C1[r+3]);} \
      float rm=__builtin_fmaxf(a,b); { auto rr=__builtin_amdgcn_permlane32_swap(__float_as_uint(rm),__float_as_uint(rm),false,false); rm=__builtin_fmaxf(__uint_as_float(rr[0]),__uint_as_float(rr[1])); } \
      rm-=mhat; resc=false; \
      if(__builtin_expect(__any(rm>(float)THRL),0)){ const float dl=__builtin_fmaxf(rm,0.f); mhat+=dl; \
        const float f=__builtin_amdgcn_exp2f(-dl); l_reg*=f; if(hi==0)wsf[r32]=f; resc=true; } } \
    SBAR(); \
    GAPBV(PVM(0,0,0),C0,0, 0,4);  GAPBV(PVM(1,0,1),C0,2, 1,5);  GAPBV(PVM(2,0,2),C0,4, 2,6);  GAPBV(PVM(3,0,3),C0,6, 3,7); \
    GAPBV(PVM(0,1,0),C0,8, 0,8);  GAPBV(PVM(1,1,1),C0,10,1,9);  GAPBV(PVM(2,1,2),C0,12,2,10); GAPBV(PVM(3,1,3),C0,14,3,11); \
    KRD(GL,0); GAPBV(PVM(0,2,0),C1,0, 0,12); KRD(GL,1); GAPBV(PVM(1,2,1),C1,2, 1,13); KRD(GL,2); GAPBV(PVM(2,2,2),C1,4, 2,14); KRD(GL,3); GAPBV(PVM(3,2,3),C1,6, 3,15); \
    GAPB(PVM(0,3,0),C1,8); GAPB(PVM(1,3,1),C1,10); GAPB(PVM(2,3,2),C1,12); GAPB(PVM(3,3,3),C1,14); \
    }while(0)
  int t=1;
  #undef CMASK
  #define CMASK(P0,P1,t) do{}while(0)
  for(;t+3<NT;t+=2){
    STEP(pB0,pB1,pA0,pA1,t,true,true,true);     WAIT_BAR(4); RESC(); ROT();
    STEP(pA0,pA1,pB0,pB1,t+1,true,true,true);   WAIT_BAR(4); RESC(); ROT();
  }
  #undef CMASK
  #define CMASK(P0,P1,t) do{int jb_=(t)-(NT-2); if(jb_>=0)cmask(P0,P1,jb_,qrel,hi);}while(0)
  #define ENDW(tt) do{ if((tt)+3<NT){WAIT_BAR(4);} else if((tt)+2<NT){WAIT_BAR(2);} else {WAIT_BAR(0);} }while(0)
  for(;t+1<NT;t+=2){
    STEP(pB0,pB1,pA0,pA1,t,(t+3<NT),(t+1<NT),(t+1<NT));       ENDW(t);   RESC(); ROT();
    STEP(pA0,pA1,pB0,pB1,t+1,(t+4<NT),(t+2<NT),(t+2<NT));     ENDW(t+1); RESC(); ROT();
  }
  STEP(pB0,pB1,pA0,pA1,NT-1,false,false,false); RESC();
  typedef float f32x4_t __attribute__((ext_vector_type(4)));
  const f32x4_t wa=*(const __attribute__((address_space(3))) f32x4_t*)(shm3+LDS_SW+(lane&15)*32), wb=*(const __attribute__((address_space(3))) f32x4_t*)(shm3+LDS_SW+(lane&15)*32+16);
  if(has_next){ const long rbn=(long)nb*SEQ; const bf16*ksn=P.K+rbn*DM+nh*HDV+(long)lane*DM+wid*8; DMA_KX(ksn);
    const bf16*Qn=P.Q+(rbn+nqb*QB+rbk*QBLK)*DM+nh*HDV+cmp*64;
    DMA_Q(Qn); }
  { float sacc=pB0[0]+pB0[1]; _Pragma("unroll") for(int r=2;r<16;++r)sacc+=pB0[r]; _Pragma("unroll") for(int r=0;r<16;++r)sacc+=pB1[r]; l_reg+=sacc;
    pw0=(u32x4){PKW(pB0,0),PKW(pB0,2),PKW(pB0,4),PKW(pB0,6)};pw1=(u32x4){PKW(pB0,8),PKW(pB0,10),PKW(pB0,12),PKW(pB0,14)};pw2=(u32x4){PKW(pB1,0),PKW(pB1,2),PKW(pB1,4),PKW(pB1,6)};pw3=(u32x4){PKW(pB1,8),PKW(pB1,10),PKW(pB1,12),PKW(pB1,14)};
    SBAR(); pv(o,vb0+sl_cur,PAF(0),PAF(1),PAF(2),PAF(3)); }
  #undef PKW
  #undef PAF
  #undef VFR
  #undef PIN
  #undef MX3
  #undef GAPA
  #undef GAPB
  #undef GAPBV
  #undef EX
  #undef VOFF
  #undef VRD
  #undef KRD
  #undef PVM
  #undef STEP
  #undef ENDW
  {auto rr=__builtin_amdgcn_permlane32_swap(__float_as_uint(l_reg),__float_as_uint(l_reg),false,false);l_reg=__uint_as_float(rr[0])+__uint_as_float(rr[1]);}
  if(hi==0)wsf[32+r32]=l_reg;asm volatile("s_waitcnt lgkmcnt(0)":::"memory");
  float rli[16];
  #pragma unroll
  for(int r=0;r<16;++r)rli[r]=__builtin_amdgcn_rcpf(wsf[32+crow(r,hi)]);
  asm volatile("s_waitcnt lgkmcnt(0)\n\ts_barrier":::"memory");
  { bf16*stg=(bf16*)(shm)+wid*4096;
    #pragma unroll
    for(int r=0;r<16;++r){const int orow=crow(r,hi);
      #pragma unroll
      for(int d0=0;d0<4;++d0)stg[orow*128+d0*32+r32]=__float2bfloat16(o[d0][r]*rli[r]);} }
  asm volatile("s_waitcnt lgkmcnt(0)\n\ts_barrier":::"memory");
  { const bf16*s0=(const bf16*)(shm)+(wid&~1)*4096; const bf16*s1=s0+4096;
    bf16*Ow=P.O+(rowbase+q0+rbk*QBLK)*DM+h*HDV; const int ch=lane&15;
    #pragma unroll
    for(int i=0;i<4;++i){ const int row=16*cmp+4*i+(lane>>4);
      const u32x4 a=*(const u32x4*)(s0+row*128+ch*8), bq=*(const u32x4*)(s1+row*128+ch*8);
      float d[8];
      #pragma unroll
      for(int k=0;k<4;++k){ const unsigned ua=a[k],ub=bq[k];
        d[2*k]=__uint_as_float(ua<<16)-P.lam*__uint_as_float(ub<<16); d[2*k+1]=__uint_as_float(ua&0xffff0000u)-P.lam*__uint_as_float(ub&0xffff0000u); }
      float s=0.f;
      #pragma unroll
      for(int k=0;k<8;++k)s+=d[k]*d[k];
      s+=__shfl_xor(s,1);s+=__shfl_xor(s,2);s+=__shfl_xor(s,4);s+=__shfl_xor(s,8);
      const float rs=P.post*__builtin_amdgcn_rsqf(s*(1.f/128.f)+1e-5f);
      u32x4 w; w[0]=cvtpk_s(d[0]*rs*wa[0],d[1]*rs*wa[1]); w[1]=cvtpk_s(d[2]*rs*wa[2],d[3]*rs*wa[3]); w[2]=cvtpk_s(d[4]*rs*wb[0],d[5]*rs*wb[1]); w[3]=cvtpk_s(d[6]*rs*wb[2],d[7]*rs*wb[3]);
      *(__attribute__((address_space(1))) u32x4*)(Ow+(long)row*DM+ch*8)=w; } }
  asm volatile("s_waitcnt lgkmcnt(0)\n\ts_barrier":::"memory");
  if(ATTN_PRIO&&wid>=4)__builtin_amdgcn_s_setprio(0);
  #undef DMA_K
  #undef DMA_KX
  #undef DMA_Q
  #undef DMA_V
  #undef CMASK
  #undef START
  #undef RESC
  #undef ROT
}
constexpr int ATTN_LDS_BYTES=LDS_BYTES;
template<int THRL=8> __device__ __forceinline__ void phase(char*lds,const Params&P,int grid,int block){
  const int vcu=(grid%8==0)?(block%8)*(grid/8)+block/8:block;
#if ATTN_SHARE8 == 1
  if(threadIdx.x<128)((float*)(lds+LDS_SW))[threadIdx.x]=P.subln_w[threadIdx.x];
  __syncthreads();
  for(int v=vcu;v<256;v+=grid){ const int grp=v>>3,k=v&7;
    for(int idx=0;idx<16;++idx){ const int bh=grp*4+(idx>>2),i=idx&3; const int qb=(i==0)?31-k:(i==1)?k:(i==2)?16+k:15-k;
      const int nx=idx+1,bhn=grp*4+((nx>>2)&3),in_=nx&3; const int qbn=(in_==0)?31-k:(in_==1)?k:(in_==2)?16+k:15-k;
      unit<THRL>(bh>>4,bh&15,qb,P,lds,idx>0,nx<16,bhn>>4,bhn&15,qbn); } }
#elif ATTN_SHARE8 == 2
  for(int v=vcu;v<256;v+=grid){ const int grp=v>>5,k=v&31;
    for(int w=0;w<16;++w){ const int bh=grp*16+w; const int qb=(w&1)?31-k:k; unit<THRL>(bh>>4,bh&15,qb,P,lds); } }
#elif ATTN_SHARE8 == 3
  for(int v=vcu;v<256;v+=grid){ const int grp=v>>4,k=v&15;
    for(int w=0;w<8;++w){ const int bh=grp*8+w;
      for(int i=0;i<2;++i){ const int qb=(i==0)?31-k:k; unit<THRL>(bh>>4,bh&15,qb,P,lds); } } }
#else
  for(int v=vcu;v<256;v+=grid){ const int bh=v>>1,p=v&1;
    for(int i=0;i<16;++i){ const int s=2*(i>>1)+p; const int qb=(i&1)?31-s:s; unit<THRL>(bh>>4,bh&15,qb,P,lds); } }
#endif
}
#undef SBAR
#undef WAIT_BAR
}
constexpr int NWAVES = 8;
#ifndef MK_PER_PHASE
#define MK_PER_PHASE 0
#endif

constexpr int BATCH = 8, SEQ = 4096, DMODEL = 2048, MROWS = BATCH * SEQ, DFF = 8192, NHEADS = 16, HD = 128;
constexpr int GDN_PROJ = 8224, GDN_MAIN = 8192, CONVC = 6144, NCG = MROWS / 64;
constexpr float ALPHA_RES = 1.6817928305074292f;
constexpr float LN_EPS = 1e-5f, GDN_EPS = 1e-6f, SUBLN_EPS = 1e-5f;
constexpr int N_PHASES = 39;

constexpr size_t MiB = 1u << 20;
constexpr size_t WS_CTL = 0, CTL_ZERO_BYTES = 1 * MiB;
constexpr size_t WS_ONES = 1 * MiB, WS_ZEROS = WS_ONES + 8192, WS_MU = WS_ONES + 65536, WS_RSTD = WS_MU + 131072;
constexpr size_t WS_BETA = 2 * MiB, WS_G = 4 * MiB;
constexpr size_t WS_HALO = 9 * MiB;
constexpr size_t WS_WA = 27 * MiB, WS_WB = 60 * MiB;
constexpr size_t WS_ATTN = 27 * MiB;
constexpr size_t WS_XB = 92 * MiB;
constexpr size_t WS_Y = 220 * MiB;
constexpr size_t WS_R1 = 476 * MiB;
constexpr size_t WS_END = 988 * MiB;
constexpr size_t QTR = 128 * MiB;
constexpr int CW_TMO = 0;
constexpr int CW_BAR = 4096;

constexpr int LDS_BYTES_C = 151552;
constexpr int RING_OFF = 0, RING_BYTES = 131072;
constexpr int LDSCTL_OFF = LDS_BYTES_C - 512, MISC_OFF = LDSCTL_OFF + 320;
constexpr int LDS_BYTES = LDS_BYTES_C;
static_assert(MISC_OFF + 128 <= LDS_BYTES, "LDS map");

#define GAS __attribute__((address_space(1)))
#define LAS __attribute__((address_space(3)))
typedef unsigned short bf16;
typedef unsigned v4u __attribute__((ext_vector_type(4)));
typedef unsigned v2u __attribute__((ext_vector_type(2)));
typedef float f32x4 __attribute__((ext_vector_type(4)));
typedef float f32x16 __attribute__((ext_vector_type(16)));
typedef short bf16x8 __attribute__((ext_vector_type(8)));
typedef GAS unsigned gu32;
typedef GAS unsigned long long gu64;
#define RLX_AGENT __ATOMIC_RELAXED, __HIP_MEMORY_SCOPE_AGENT
#define LDS_WAIT() asm volatile("s_waitcnt lgkmcnt(0)" ::: "memory")
#define VM_WAIT() asm volatile("s_waitcnt vmcnt(0)" ::: "memory")
#define WG_BAR() asm volatile("s_waitcnt lgkmcnt(0)\n\ts_barrier" ::: "memory")
typedef float f32x2_t_ __attribute__((ext_vector_type(2))); typedef __bf16 bf16x2_t_ __attribute__((ext_vector_type(2)));
__device__ __forceinline__ unsigned pk2(float lo, float hi) { f32x2_t_ v = {lo, hi}; bf16x2_t_ b = __builtin_convertvector(v, bf16x2_t_); return __builtin_bit_cast(unsigned, b); }
__device__ __forceinline__ unsigned f2bf(float f) { return pk2(f, 0.f) & 0xffffu; }
__device__ __forceinline__ float bflo(unsigned w) { return __builtin_bit_cast(float, w << 16); }
__device__ __forceinline__ float bfhi(unsigned w) { return __builtin_bit_cast(float, w & 0xffff0000u); }
__device__ __forceinline__ float bf2f(bf16 h) { return __builtin_bit_cast(float, (unsigned)h << 16); }
__device__ __forceinline__ float fast_exp(float x) { return __builtin_amdgcn_exp2f(x * 1.4426950408889634f); }
__device__ __forceinline__ float silu_f(float x) { return x * __builtin_amdgcn_rcpf(1.f + __expf(-x)); }

#define XB_TMO      128
#define XB_XCNT(j)  (256  + 64 * (j))
#define XB_XSUB(j)  (1280 + 64 * (j))
#define XB_XGEN(j)  (2304 + 64 * (j))
#define XB_TOP      3328
#define XB_TOPGEN   3392
#define XCD_BAR_WORDS 3456
#define XB_SPIN_CAP (1u << 18)

__device__ __forceinline__ unsigned xb_ld(unsigned* p)              { return __hip_atomic_load(p, __ATOMIC_RELAXED, __HIP_MEMORY_SCOPE_AGENT); }
__device__ __forceinline__ unsigned xb_add(unsigned* p, unsigned v) { return __hip_atomic_fetch_add(p, v, __ATOMIC_RELAXED, __HIP_MEMORY_SCOPE_AGENT); }
__device__ __forceinline__ unsigned xb_xcc_id() { return (unsigned)__builtin_amdgcn_s_getreg((3 << 11) | 20) & 0xFu; }
#define XB_SPIN(cond, bar) do { unsigned _sp = 0; while (cond) { __builtin_amdgcn_s_sleep(1); \
    if ((++_sp & 255u) == 0u) { if (xb_ld(&(bar)[XB_TMO])) break; if (_sp > XB_SPIN_CAP) { atomicAdd(&(bar)[XB_TMO], 1u); break; } } } } while (0)

struct XcdBarrier {
    unsigned* bar; unsigned x;
    volatile LAS unsigned* st;
};
__device__ __forceinline__ XcdBarrier xcd_barrier_post(unsigned* bar, volatile LAS unsigned* st) {
    XcdBarrier b; b.bar = bar; b.x = xb_xcc_id(); b.st = st;
    if (threadIdx.x == 0) (void)xb_add(&bar[XB_XCNT(b.x)], 1u);
    return b;
}
__device__ __forceinline__ void xcd_barrier_complete(unsigned* bar, unsigned x, unsigned& nloc, unsigned& nx) {
    const unsigned G = gridDim.x * gridDim.y * gridDim.z;
    unsigned sum, cnt, mine, sp = 0u;
    for (;;) {
        sum = 0u; cnt = 0u; mine = 0u;
#pragma unroll
        for (unsigned j = 0; j < 16; ++j) { const unsigned c = xb_ld(&bar[XB_XCNT(j)]); sum += c; cnt += (c > 0u) ? 1u : 0u; mine = (j == x) ? c : mine; }
        if (sum == G) break;
        __builtin_amdgcn_s_sleep(1);
        if ((++sp & 255u) == 0u) { if (xb_ld(&bar[XB_TMO])) break; if (sp > XB_SPIN_CAP) { atomicAdd(&bar[XB_TMO], 1u); break; } }
    }
    nloc = mine > 0u ? mine : 1u; nx = cnt > 0u ? cnt : 1u;
}
__device__ __forceinline__ void xcd_barrier(const XcdBarrier& b) {
    asm volatile("s_waitcnt vmcnt(0)" ::: "memory");
    __syncthreads();
    if (threadIdx.x == 0) {
        unsigned* bar = b.bar;
        __builtin_amdgcn_s_waitcnt(0);
        unsigned nloc = b.st[0], nx = b.st[1];
        if (nloc == 0u) { xcd_barrier_complete(bar, b.x, nloc, nx); b.st[0] = nloc; b.st[1] = nx; }
        const unsigned old = xb_add(&bar[XB_XSUB(b.x)], 1u);
        const unsigned gen = old / nloc;
        if (old + 1u == (gen + 1u) * nloc) {
            __builtin_amdgcn_fence(__ATOMIC_RELEASE, "agent");
            asm volatile("s_waitcnt vmcnt(0)" ::: "memory");
            const unsigned og = xb_add(&bar[XB_TOP], 1u);
            const unsigned tg = og / nx;
            if (og + 1u == (tg + 1u) * nx) xb_add(&bar[XB_TOPGEN], 1u);
            else XB_SPIN(xb_ld(&bar[XB_TOPGEN]) == tg, bar);
            __builtin_amdgcn_fence(__ATOMIC_ACQUIRE, "agent");
            xb_add(&bar[XB_XGEN(b.x)], 1u);
            asm volatile("s_waitcnt vmcnt(0)" ::: "memory");
        } else {
            XB_SPIN(xb_ld(&bar[XB_XGEN(b.x)]) == gen, bar);
            __builtin_amdgcn_fence(__ATOMIC_ACQUIRE, "agent");
            asm volatile("s_waitcnt vmcnt(0)" ::: "memory");
        }
    }
    __syncthreads();
}

__device__ __forceinline__ float wave_sum(float v) {
#pragma unroll
    for (int o = 1; o < 64; o <<= 1) v += __shfl_xor(v, o);
    return v;
}
__device__ __forceinline__ float sum16(float v) {
    v += __shfl_xor(v, 1); v += __shfl_xor(v, 2); v += __shfl_xor(v, 4); v += __shfl_xor(v, 8); return v;
}
__device__ __forceinline__ void transpose_item(const float* W, int K, int ldw, int n_begin, int nblk, bf16* WT, int row_off, LAS float* scr, int item, int lane) {
    const int kb = item / nblk, nb = item % nblk, k0 = 64 * kb, n0 = 32 * nb;
    float wv[32];
#pragma unroll
    for (int i = 0; i < 32; ++i) wv[i] = ((const GAS float*)W)[(size_t)(k0 + 2 * i + (lane >> 5)) * ldw + n_begin + n0 + (lane & 31)];
#pragma unroll
    for (int i = 0; i < 32; ++i) scr[(2 * i + (lane >> 5)) * 33 + (lane & 31)] = wv[i];
    LDS_WAIT(); asm volatile("" ::: "memory");
    const int c = lane & 7;
#pragma unroll
    for (int j = 0; j < 4; ++j) { const int n = (lane >> 3) + 8 * j; const LAS float* s = scr + (8 * c) * 33 + n;
        v4u o; o.x = pk2(s[0 * 33], s[1 * 33]); o.y = pk2(s[2 * 33], s[3 * 33]); o.z = pk2(s[4 * 33], s[5 * 33]); o.w = pk2(s[6 * 33], s[7 * 33]);
        *(GAS v4u*)(WT + (size_t)(row_off + n0 + n) * K + k0 + 8 * c) = o; }
    LDS_WAIT(); asm volatile("" ::: "memory");
}
__device__ __forceinline__ void convert_w(LAS unsigned char* lds, int gw, int NGW, int wave, int lane, const float* W, int K, int ldw, int n_begin, int ncols, bf16* WT, int row_off) {
    LAS float* scr = (LAS float*)(lds + RING_OFF + wave * 16384);
    const int nblk = ncols / 32, nitems = (K / 64) * nblk;
    for (int it = gw; it < nitems; it += NGW) transpose_item(W, K, ldw, n_begin, nblk, WT, row_off, scr, it, lane);
}
__device__ __forceinline__ void row_to_bf16(const float* xrow, bf16* orow, int lane) {
    const GAS f32x4* xr = (const GAS f32x4*)xrow + lane; GAS v2u* o8 = (GAS v2u*)orow + lane;
#pragma unroll
    for (int j = 0; j < 8; ++j) { const f32x4 v = xr[64 * j]; v2u w; w.x = pk2(v.x, v.y); w.y = pk2(v.z, v.w); o8[64 * j] = w; }
}
__device__ __forceinline__ void ln_pass_b(const bf16* xb_in, const bf16* hb, const float* g, const float* b, bf16* xb_out, float* outf, float alpha, int gw, int NGW, int lane) {
    const GAS f32x4* gr = (const GAS f32x4*)g + 2 * lane; const GAS f32x4* br = (const GAS f32x4*)b + 2 * lane;
    for (int m = gw; m < MROWS; m += 2 * NGW) {
        const int m1 = (m + NGW < MROWS) ? m + NGW : m;
        const GAS v4u* x0 = (const GAS v4u*)(xb_in + (size_t)m * DMODEL) + lane; const GAS v4u* x1 = (const GAS v4u*)(xb_in + (size_t)m1 * DMODEL) + lane;
        const GAS v4u* h0 = (const GAS v4u*)(hb + (size_t)m * DMODEL) + lane;   const GAS v4u* h1 = (const GAS v4u*)(hb + (size_t)m1 * DMODEL) + lane;
        v4u xa[4], xc[4], ha[4], hc[4];
#pragma unroll
        for (int j = 0; j < 4; ++j) { xa[j] = x0[64 * j]; xc[j] = x1[64 * j]; ha[j] = h0[64 * j]; hc[j] = h1[64 * j]; }
        float y0[32], y1[32]; float s0 = 0.f, s1 = 0.f;
#pragma unroll
        for (int j = 0; j < 4; ++j)
#pragma unroll
            for (int k = 0; k < 4; ++k) { y0[8 * j + 2 * k] = alpha * bflo(xa[j][k]) + bflo(ha[j][k]); y0[8 * j + 2 * k + 1] = alpha * bfhi(xa[j][k]) + bfhi(ha[j][k]);
                                          y1[8 * j + 2 * k] = alpha * bflo(xc[j][k]) + bflo(hc[j][k]); y1[8 * j + 2 * k + 1] = alpha * bfhi(xc[j][k]) + bfhi(hc[j][k]); }
#pragma unroll
        for (int k = 0; k < 32; ++k) { s0 += y0[k]; s1 += y1[k]; }
#pragma unroll
        for (int o = 1; o < 64; o <<= 1) { s0 += __shfl_xor(s0, o); s1 += __shfl_xor(s1, o); }
        const float mean0 = s0 * (1.f / DMODEL), mean1 = s1 * (1.f / DMODEL); float q0 = 0.f, q1 = 0.f;
#pragma unroll
        for (int k = 0; k < 32; ++k) { y0[k] -= mean0; y1[k] -= mean1; q0 += y0[k] * y0[k]; q1 += y1[k] * y1[k]; }
#pragma unroll
        for (int o = 1; o < 64; o <<= 1) { q0 += __shfl_xor(q0, o); q1 += __shfl_xor(q1, o); }
        const float rs0 = 1.f / sqrtf(q0 * (1.f / DMODEL) + LN_EPS), rs1 = 1.f / sqrtf(q1 * (1.f / DMODEL) + LN_EPS);
#pragma unroll
        for (int j = 0; j < 4; ++j) { const f32x4 ga = gr[128 * j], gb = gr[128 * j + 1], ba = br[128 * j], bb = br[128 * j + 1];
            float o0[8], o1[8];
#pragma unroll
            for (int k = 0; k < 8; ++k) { const float gg = k < 4 ? ga[k] : gb[k - 4], bv = k < 4 ? ba[k] : bb[k - 4]; o0[k] = y0[8 * j + k] * rs0 * gg + bv; o1[k] = y1[8 * j + k] * rs1 * gg + bv; }
            if (xb_out) { v4u w0, w1; w0.x = pk2(o0[0], o0[1]); w0.y = pk2(o0[2], o0[3]); w0.z = pk2(o0[4], o0[5]); w0.w = pk2(o0[6], o0[7]); w1.x = pk2(o1[0], o1[1]); w1.y = pk2(o1[2], o1[3]); w1.z = pk2(o1[4], o1[5]); w1.w = pk2(o1[6], o1[7]);
                ((GAS v4u*)(xb_out + (size_t)m * DMODEL) + lane)[64 * j] = w0; ((GAS v4u*)(xb_out + (size_t)m1 * DMODEL) + lane)[64 * j] = w1; }
            if (outf) { GAS f32x4* p0 = (GAS f32x4*)(outf + (size_t)m * DMODEL) + 2 * lane + 128 * j; GAS f32x4* p1 = (GAS f32x4*)(outf + (size_t)m1 * DMODEL) + 2 * lane + 128 * j;
                p0[0] = (f32x4){o0[0], o0[1], o0[2], o0[3]}; p0[1] = (f32x4){o0[4], o0[5], o0[6], o0[7]}; p1[0] = (f32x4){o1[0], o1[1], o1[2], o1[3]}; p1[1] = (f32x4){o1[4], o1[5], o1[6], o1[7]}; } }
    }
}
#define MFMA32(a, b, c) __builtin_amdgcn_mfma_f32_32x32x16_bf16((a), (b), (c), 0, 0, 0)

__device__ __forceinline__ void ba_proj(LAS unsigned char* lds, const bf16* xb, const bf16* wt  , const float* a_log, const float* dt_bias, float* beta, float* g, int gw, int NGW, int lane) {
    const int r32 = lane & 31, hi = lane >> 5, half = gw & 1, NP = NGW >> 1;
    LAS float* xch = (LAS float*)lds + ((gw >> 1) & 3) * 1024;
    for (int wu0 = 0; wu0 < MROWS / 32; wu0 += NP) {
        const int wu = wu0 + (gw >> 1); const bool valid = wu < MROWS / 32;
        f32x16 acc = {};
        if (valid) {
            const GAS bf16* ap = (const GAS bf16*)xb + (size_t)(wu * 32 + r32) * DMODEL + half * (DMODEL / 2) + 8 * hi; const GAS bf16* bp = (const GAS bf16*)wt + (size_t)(GDN_MAIN + r32) * DMODEL + half * (DMODEL / 2) + 8 * hi;
#pragma unroll 1
            for (int s0 = 0; s0 < DMODEL / 32; s0 += 8) {
                bf16x8 a[8], b[8];
#pragma unroll
                for (int s = 0; s < 8; ++s) { a[s] = *(const GAS bf16x8*)(ap + (s0 + s) * 16); b[s] = *(const GAS bf16x8*)(bp + (s0 + s) * 16); }
#pragma unroll
                for (int s = 0; s < 8; ++s) acc = MFMA32(a[s], b[s], acc);
            }
            if (half) {
#pragma unroll
                for (int r = 0; r < 16; ++r) xch[r * 64 + lane] = acc[r];
            }
        }
        __syncthreads();
        if (valid && !half) {
            const int j = r32 & 15; const float al = -__expf(((const GAS float*)a_log)[j]), db = ((const GAS float*)dt_bias)[j]; GAS float* betag = (GAS float*)beta; GAS float* gg_ = (GAS float*)g;
#pragma unroll
            for (int r = 0; r < 16; ++r) { const int t = wu * 32 + (r & 3) + 8 * (r >> 2) + 4 * hi; const float v = acc[r] + xch[r * 64 + lane];
                if (r32 < 16) betag[(size_t)t * 16 + j] = __builtin_amdgcn_rcpf(1.f + __expf(-v));
                else { const float z = v + db; const float sp = z > 20.f ? z : log1pf(__expf(z)); gg_[(size_t)t * 16 + j] = al * sp; } }
        }
        __syncthreads();
    }
}

#ifndef G2_SKIP
#define G2_SKIP 0
#endif
#ifndef PROBE_G2_NOSCAT
#define PROBE_G2_NOSCAT 0
#endif
typedef short bf16x4 __attribute__((ext_vector_type(4)));
#define MFMA16K16(a, b, c) __builtin_amdgcn_mfma_f32_16x16x16bf16_1k((a), (b), (c), 0, 0, 0)
constexpr int G2_TS = 136;
constexpr int G2_AS = 68, G2_ANS = 72, G2_US = 68;
constexpr int G2_A = 0, G2_GC = G2_A + 64 * G2_AS * 4, G2_BT = G2_GC + 256, G2_AN = G2_BT + 256, G2_TB = G2_AN + 64 * G2_ANS * 2, G2_Q = G2_TB + 2048, G2_K = G2_Q + 64 * G2_TS * 2, G2_V = G2_K + 64 * G2_TS * 2,
              G2_W = G2_V + 64 * G2_TS * 2, G2_END = G2_W + 64 * G2_TS * 2;
static_assert(G2_END <= RING_BYTES, "G2 LDS");
__device__ __forceinline__ bf16x4 pack4(f32x4 v) { v2u w; w.x = pk2(v[0], v[1]); w.y = pk2(v[2], v[3]); return __builtin_bit_cast(bf16x4, w); }
__device__ __forceinline__ void gdn_chunk_phase(LAS unsigned char* lds, bf16* p_, const bf16* halo_, const float* beta_, float* g_, bf16* wbuf_, bf16* attn_, const float* conv_w_, int vcu, int G, bf16* palt_ = nullptr) {
#define G2_ST(off) ((palt ? palt + ((size_t)(off) & 0x7ffffffull) : p + (size_t)(off)))
    int tid_ = threadIdx.x; asm volatile("" : "+v"(tid_));
    const int tid0 = tid_, lane0 = tid0 & 63, wid0 = __builtin_amdgcn_readfirstlane(tid0 >> 6);
    GAS bf16* const p = (GAS bf16*)p_; const GAS bf16* const halo = (const GAS bf16*)halo_; const GAS float* const beta = (const GAS float*)beta_; GAS float* const g = (GAS float*)g_;
    GAS bf16* const wbuf = (GAS bf16*)wbuf_; GAS bf16* const attn = (GAS bf16*)attn_; const GAS float* const conv_w = (const GAS float*)conv_w_; GAS bf16* const palt = (GAS bf16*)palt_;
    LAS bf16* Qs = (LAS bf16*)(lds + G2_Q); LAS bf16* Ks = (LAS bf16*)(lds + G2_K); LAS bf16* Vs = (LAS bf16*)(lds + G2_V); LAS bf16* Ws = (LAS bf16*)(lds + G2_W);
    LAS float* As = (LAS float*)(lds + G2_A); LAS float* gcs = (LAS float*)(lds + G2_GC); LAS float* bts = (LAS float*)(lds + G2_BT);
    LAS bf16* An = (LAS bf16*)(lds + G2_AN); LAS bf16* Tb = (LAS bf16*)(lds + G2_TB); LAS bf16* Us = (LAS bf16*)(lds + G2_A);
    asm volatile("" : "+v"(Qs), "+v"(Ks), "+v"(Vs), "+v"(Ws), "+v"(As), "+v"(gcs), "+v"(bts), "+v"(An), "+v"(Tb), "+v"(Us));
    v4u rawv[3][5]; float gpre = 0.f, bpre = 0.f;
#define G2_LOAD_RAW(uu, LN, WD) do { const int cg_ = (uu) >> 4, h_ = (uu) & 15, n_ = cg_ & 63; const size_t r0_ = (size_t)cg_ * 64; const int cgp_l = (LN) & 15, tA_l = 8 * (WD) + 2 * ((LN) >> 4); \
        _Pragma("unroll") for (int X = 0; X < 3; ++X) { const int col_ = X * 2048 + h_ * HD + 8 * cgp_l; \
            _Pragma("unroll") for (int rr = 0; rr < 5; ++rr) { const int rel = tA_l - 3 + rr; v4u v = {0u, 0u, 0u, 0u}; \
                if (rel >= 0) v = *(const GAS v4u*)(p + (r0_ + rel) * GDN_MAIN + col_); \
                else if (n_ > 0) v = *(const GAS v4u*)(halo + ((size_t)(cg_ - 1) * 3 + (rel + 3)) * CONVC + col_); \
                rawv[X][rr] = v; } } \
        if ((WD) == 0) { gpre = g[(r0_ + (LN)) * 16 + h_]; bpre = beta[(r0_ + (LN)) * 16 + h_]; } } while (0)
    if (vcu < NCG * NHEADS) G2_LOAD_RAW(vcu, lane0, wid0);
    for (int u = vcu; u < NCG * NHEADS; u += G) {
        const int cg = u >> 4, h = u & 15; const size_t row0 = (size_t)cg * 64;
        int tl_ = tid0; asm volatile("" : "+v"(tl_));
        const int tid = tl_, lane = tid & 63, wid = __builtin_amdgcn_readfirstlane(tid >> 6), r32 = lane & 31, hi = lane >> 5;
        {
            const int cgp = lane & 15, sub = lane >> 4, tA = 8 * wid + 2 * sub;
#pragma unroll
            for (int X = 0; X < 3; ++X) {
                const int col = X * 2048 + h * HD + 8 * cgp;
                float raw[5][8];
                asm volatile("" : "+v"(rawv[X][0]), "+v"(rawv[X][1]), "+v"(rawv[X][2]), "+v"(rawv[X][3]), "+v"(rawv[X][4]));
#pragma unroll
                for (int rr = 0; rr < 5; ++rr) { const v4u v = rawv[X][rr];
                    raw[rr][0] = bflo(v.x); raw[rr][1] = bfhi(v.x); raw[rr][2] = bflo(v.y); raw[rr][3] = bfhi(v.y); raw[rr][4] = bflo(v.z); raw[rr][5] = bfhi(v.z); raw[rr][6] = bflo(v.w); raw[rr][7] = bfhi(v.w); }
                float o0[8], o1[8];
#pragma unroll
                for (int c = 0; c < 8; ++c) { o0[c] = 0.f; o1[c] = 0.f; }
#pragma unroll
                for (int j = 0; j < 4; ++j) { const f32x4 wa = *(const GAS f32x4*)(conv_w + (size_t)j * CONVC + col), wb = *(const GAS f32x4*)(conv_w + (size_t)j * CONVC + col + 4);
#pragma unroll
                    for (int c = 0; c < 8; ++c) { const float w = c < 4 ? wa[c] : wb[c - 4]; o0[c] += w * raw[j][c]; o1[c] += w * raw[j + 1][c]; } }
                float s0 = 0.f, s1 = 0.f;
#pragma unroll
                for (int c = 0; c < 8; ++c) { o0[c] = silu_f(o0[c]); o1[c] = silu_f(o1[c]); s0 += o0[c] * o0[c]; s1 += o1[c] * o1[c]; }
                if (X < 2) { s0 = sum16(s0); s1 = sum16(s1); const float sc = X == 0 ? 0.08838834764831845f : 1.f; const float f0 = sc * __builtin_amdgcn_rsqf(s0 + GDN_EPS), f1 = sc * __builtin_amdgcn_rsqf(s1 + GDN_EPS);
#pragma unroll
                    for (int c = 0; c < 8; ++c) { o0[c] *= f0; o1[c] *= f1; } }
                LAS bf16* T = X == 0 ? Qs : (X == 1 ? Ks : Vs);
                v4u w0, w1; w0.x = pk2(o0[0], o0[1]); w0.y = pk2(o0[2], o0[3]); w0.z = pk2(o0[4], o0[5]); w0.w = pk2(o0[6], o0[7]);
                w1.x = pk2(o1[0], o1[1]); w1.y = pk2(o1[2], o1[3]); w1.z = pk2(o1[4], o1[5]); w1.w = pk2(o1[6], o1[7]);
                *(LAS v4u*)(T + tA * G2_TS + 8 * cgp) = w0; *(LAS v4u*)(T + (tA + 1) * G2_TS + 8 * cgp) = w1;
                asm volatile("" ::: "memory");
            }
            if (wid == 0) {
                float gv = gpre;
#pragma unroll
                for (int o = 1; o < 64; o <<= 1) { const float t = __shfl_up(gv, o); if (lane >= o) gv += t; }
                gcs[lane] = gv; bts[lane] = bpre; if (!palt) g[(row0 + lane) * 16 + h] = gv;
            }
        }
        __syncthreads();
        if (u + G < NCG * NHEADS) G2_LOAD_RAW(u + G, lane, wid);
        if (!((G2_SKIP & 4) && palt)) {
            const int rb = (wid >> 1) & 1, cb = wid & 1; const bool isA = wid < 4;
            f32x16 acc = {};
            if (!(rb == 0 && cb == 1)) {
                const LAS bf16* Ar = (isA ? Ks : Qs) + (32 * rb + r32) * G2_TS + 8 * hi; const LAS bf16* Br = Ks + (32 * cb + r32) * G2_TS + 8 * hi;
#pragma unroll
                for (int s = 0; s < 8; ++s) acc = MFMA32(*(const LAS bf16x8*)(Ar + 16 * s), *(const LAS bf16x8*)(Br + 16 * s), acc);
            }
            const int j = 32 * cb + r32; const float gj = gcs[j];
#pragma unroll
            for (int r = 0; r < 16; ++r) { const int i = 32 * rb + (r & 3) + 8 * (r >> 2) + 4 * hi; const float gi = gcs[i];
                if (isA) { const float d = (i > j) ? __expf(gi - gj) : 0.f; const float a = (i > j) ? bts[i] * acc[r] * d : 0.f; As[i * G2_AS + j] = a; An[i * G2_ANS + j] = (bf16)f2bf(-a); }
                else { const float d = (i >= j) ? __expf(gi - gj) : 0.f; Ws[i * G2_TS + j] = (bf16)f2bf((i >= j) ? acc[r] * d : 0.f); } }
        }
        __syncthreads();
        if (wid == 0 && !((G2_SKIP & 2) && palt)) {
            const int b = lane >> 4, c = lane & 15; float t[16];
            const LAS float* Ab = As + (16 * b) * G2_AS + 16 * b;
#pragma unroll
            for (int i = 0; i < 16; ++i) {
                float ti = (i == c) ? 1.f : 0.f;
#pragma unroll
                for (int j4 = 0; j4 < (i + 3) / 4; ++j4) { const f32x4 a = *(const LAS f32x4*)(Ab + i * G2_AS + 4 * j4);
#pragma unroll
                    for (int k = 0; k < 4; ++k) if (4 * j4 + k < i) ti -= a[k] * t[4 * j4 + k]; }
                t[i] = ti;
            }
#pragma unroll
            for (int i = 0; i < 16; ++i) Tb[b * 256 + i * 16 + c] = (bf16)f2bf(t[i]);
        } else if (wid < 5) {
            const int tt = tid - 64, cgp = tt & 15, r0 = tt >> 4;
            { GAS bf16* at = palt ? palt + (((size_t)u * 4096 + 0x4000000ull) & 0x7ffffffull) : attn + (size_t)u * 4096;
#pragma unroll
              for (int k = 0; k < 2; ++k) { const int pc = tt + 256 * k, i = pc >> 3, c8 = pc & 7; *(GAS v4u*)(at + i * 64 + 8 * c8) = *(const LAS v4u*)(Ws + i * G2_TS + 8 * c8); } }
#pragma unroll
            for (int r = 0; r < 4; ++r) { const int i = r0 + 16 * r; const float e = __expf(gcs[i]); const v4u v = *(const LAS v4u*)(Qs + i * G2_TS + 8 * cgp); v4u w;
                w.x = pk2(bflo(v.x) * e, bfhi(v.x) * e); w.y = pk2(bflo(v.y) * e, bfhi(v.y) * e); w.z = pk2(bflo(v.z) * e, bfhi(v.z) * e); w.w = pk2(bflo(v.w) * e, bfhi(v.w) * e);
                *(GAS v4u*)G2_ST((row0 + i) * GDN_MAIN + h * HD + 8 * cgp) = w; }
        } else {
            const float gl = gcs[63];
            for (int task = tid - 320; task < 256; task += 192) { const int dk = task & 127, th = task >> 7;
                GAS bf16* dst = G2_ST((row0 + (dk >> 1)) * GDN_MAIN + 2048 + h * HD + (dk & 1) * 64 + 32 * th);
#pragma unroll
                for (int q = 0; q < 4; ++q) { float v[8];
#pragma unroll
                    for (int k = 0; k < 8; ++k) { const int tk = 32 * th + 8 * q + k; v[k] = bf2f(Ks[tk * G2_TS + dk]) * __expf(gl - gcs[tk]); }
                    v4u w; w.x = pk2(v[0], v[1]); w.y = pk2(v[2], v[3]); w.z = pk2(v[4], v[5]); w.w = pk2(v[6], v[7]); if (!(PROBE_G2_NOSCAT && palt)) *(GAS v4u*)(dst + 8 * q) = w; else asm volatile("" :: "v"(w)); } }
        }
        __syncthreads();
        if (!((G2_SKIP & 1) && palt)) {
            const int nl = lane & 15, q = lane >> 4; const bool isK = wid >= 4;
            float rsc[16];
#pragma unroll
            for (int b = 0; b < 4; ++b)
#pragma unroll
                for (int r = 0; r < 4; ++r) { const int row = 16 * b + 4 * q + r; rsc[4 * b + r] = isK ? bts[row] * __expf(gcs[row]) : bts[row]; }
            bf16x4 Tq[4], Aq[6];
#pragma unroll
            for (int b = 0; b < 4; ++b) Tq[b] = *(const LAS bf16x4*)(Tb + b * 256 + nl * 16 + 4 * q);
            Aq[0] = *(const LAS bf16x4*)(An + (16 + nl) * G2_ANS + 4 * q);
            Aq[1] = *(const LAS bf16x4*)(An + (32 + nl) * G2_ANS + 4 * q);      Aq[2] = *(const LAS bf16x4*)(An + (32 + nl) * G2_ANS + 16 + 4 * q);
            Aq[3] = *(const LAS bf16x4*)(An + (48 + nl) * G2_ANS + 4 * q);      Aq[4] = *(const LAS bf16x4*)(An + (48 + nl) * G2_ANS + 16 + 4 * q);   Aq[5] = *(const LAS bf16x4*)(An + (48 + nl) * G2_ANS + 32 + 4 * q);
#pragma unroll
            for (int t = 0; t < 2; ++t) {
                const int cc = 32 * (wid & 3) + 16 * t + nl;
                const LAS bf16* src = (isK ? Ks : Vs) + cc;
                f32x4 R[4];
#pragma unroll
                for (int b = 0; b < 4; ++b)
#pragma unroll
                    for (int r = 0; r < 4; ++r) R[b][r] = rsc[4 * b + r] * bf2f(src[(16 * b + 4 * q + r) * G2_TS]);
                const f32x4 z4 = {0.f, 0.f, 0.f, 0.f};
                const f32x4 y0 = MFMA16K16(Tq[0], pack4(R[0]), z4); const bf16x4 y0b = pack4(y0);
                f32x4 c1 = MFMA16K16(Aq[0], y0b, R[1]);
                const f32x4 y1 = MFMA16K16(Tq[1], pack4(c1), z4); const bf16x4 y1b = pack4(y1);
                f32x4 c2 = MFMA16K16(Aq[1], y0b, R[2]); c2 = MFMA16K16(Aq[2], y1b, c2);
                const f32x4 y2 = MFMA16K16(Tq[2], pack4(c2), z4); const bf16x4 y2b = pack4(y2);
                f32x4 c3 = MFMA16K16(Aq[3], y0b, R[3]); c3 = MFMA16K16(Aq[4], y1b, c3); c3 = MFMA16K16(Aq[5], y2b, c3);
                const f32x4 y3 = MFMA16K16(Tq[3], pack4(c3), z4); const bf16x4 y3b = pack4(y3);
                if (!isK) {
                    LAS bf16* dst = Us + cc * G2_US + 4 * q;
                    *(LAS bf16x4*)(dst) = y0b; *(LAS bf16x4*)(dst + 16) = y1b; *(LAS bf16x4*)(dst + 32) = y2b; *(LAS bf16x4*)(dst + 48) = y3b;
                } else {
#pragma unroll
                    for (int r = 0; r < 4; ++r) { Ws[(4 * q + r) * G2_TS + cc] = (bf16)y0b[r]; Ws[(16 + 4 * q + r) * G2_TS + cc] = (bf16)y1b[r]; Ws[(32 + 4 * q + r) * G2_TS + cc] = (bf16)y2b[r]; Ws[(48 + 4 * q + r) * G2_TS + cc] = (bf16)y3b[r]; }
                }
            }
        }
        __syncthreads();
#pragma unroll
        for (int k = 0; k < 2; ++k) { const int pc = tid + 512 * k, dv = pc >> 3, c8 = pc & 7;
            const v2u lo = *(const LAS v2u*)(Us + dv * G2_US + 8 * c8), hi2 = *(const LAS v2u*)(Us + dv * G2_US + 8 * c8 + 4);
            *(GAS v4u*)G2_ST((row0 + (dv & 63)) * GDN_MAIN + 4096 + h * HD + (dv >> 6) * 64 + 8 * c8) = (v4u){lo.x, lo.y, hi2.x, hi2.y}; }
#pragma unroll
        for (int k = 0; k < 2; ++k) { const int ch = tid + 512 * k, i = ch >> 4, c8 = ch & 15; *(GAS v4u*)((palt ? palt + (((row0 + i) * DMODEL + h * HD + 8 * c8) & 0x7ffffffull) : wbuf + (row0 + i) * DMODEL + h * HD + 8 * c8)) = *(const LAS v4u*)(Ws + i * G2_TS + 8 * c8); }
    }
#undef G2_ST
#undef G2_LOAD_RAW
}

constexpr int H2_AD = 0, H2_GC = 4096, H2_BT = 4352, H2_AN = 4608, H2_TB = H2_AN + 64 * G2_ANS * 2, H2_Q = H2_TB + 2048, H2_K = H2_Q + 64 * G2_TS * 2, H2_V = H2_K + 64 * G2_TS * 2, H2_GSZ = H2_V + 64 * G2_TS * 2;
static_assert(2 * H2_GSZ <= LDSCTL_OFF && H2_GSZ % 16 == 0, "G2 (two groups) LDS");
__device__ __forceinline__ void grp_bar(LAS unsigned* cnt, unsigned& tgt, int lane) {
    asm volatile("s_waitcnt lgkmcnt(0)" ::: "memory");
    if (lane == 0) __hip_atomic_fetch_add(cnt, 1u, __ATOMIC_RELAXED, __HIP_MEMORY_SCOPE_WORKGROUP);
    tgt += 4u;
    while (*(volatile LAS unsigned*)cnt < tgt) __builtin_amdgcn_s_sleep(1);
    asm volatile("" ::: "memory");
}
__device__ __forceinline__ void gdn_chunk_phase2(LAS unsigned char* lds, bf16* p_, const bf16* halo_, const float* beta_, float* g_, bf16* wbuf_, bf16* attn_, const float* conv_w_, int vcu, int G, bf16* palt_ = nullptr) {
#define G2_ST(off) ((palt ? palt + ((size_t)(off) & 0x7ffffffull) : p + (size_t)(off)))
    int tid_ = threadIdx.x; asm volatile("" : "+v"(tid_));
    const int tid0 = tid_;
    GAS bf16* const p = (GAS bf16*)p_; const GAS bf16* const halo = (const GAS bf16*)halo_; const GAS float* const beta = (const GAS float*)beta_; GAS float* const g = (GAS float*)g_;
    GAS bf16* const wbuf = (GAS bf16*)wbuf_; GAS bf16* const attn = (GAS bf16*)attn_; const GAS float* const conv_w = (const GAS float*)conv_w_; GAS bf16* const palt = (GAS bf16*)palt_;
    const int grp = __builtin_amdgcn_readfirstlane(tid0 >> 8);
    LAS unsigned* cnt = (LAS unsigned*)(lds + LDSCTL_OFF + 128 + 64 * grp);
    __syncthreads(); if (tid0 == 0) { *(LAS unsigned*)(lds + LDSCTL_OFF + 128) = 0u; *(LAS unsigned*)(lds + LDSCTL_OFF + 192) = 0u; } __syncthreads();
    unsigned tgt = 0u;
    LAS unsigned char* gb = lds + grp * H2_GSZ;
    LAS bf16* Qs = (LAS bf16*)(gb + H2_Q); LAS bf16* Ks = (LAS bf16*)(gb + H2_K); LAS bf16* Vs = (LAS bf16*)(gb + H2_V);
    LAS float* Ad = (LAS float*)(gb + H2_AD); LAS float* gcs = (LAS float*)(gb + H2_GC); LAS float* bts = (LAS float*)(gb + H2_BT);
    LAS bf16* An = (LAS bf16*)(gb + H2_AN); LAS bf16* Tb = (LAS bf16*)(gb + H2_TB);
    asm volatile("" : "+v"(Qs), "+v"(Ks), "+v"(Vs), "+v"(Ad), "+v"(gcs), "+v"(bts), "+v"(An), "+v"(Tb));
    v4u rawv[3][7]; float gpre = 0.f, bpre = 0.f;
#define H2_LOAD_RAW(uu, LN, W4) do { const int cg_ = (uu) >> 4, h_ = (uu) & 15, n_ = cg_ & 63; const size_t r0_ = (size_t)cg_ * 64; const int cgp_l = (LN) & 15, tA_l = 16 * (W4) + 4 * ((LN) >> 4); \
        _Pragma("unroll") for (int X = 0; X < 3; ++X) { const int col_ = X * 2048 + h_ * HD + 8 * cgp_l; \
            _Pragma("unroll") for (int rr = 0; rr < 7; ++rr) { const int rel = tA_l - 3 + rr; v4u v = {0u, 0u, 0u, 0u}; \
                if (rel >= 0) v = *(const GAS v4u*)(p + (r0_ + rel) * GDN_MAIN + col_); \
                else if (n_ > 0) v = *(const GAS v4u*)(halo + ((size_t)(cg_ - 1) * 3 + (rel + 3)) * CONVC + col_); \
                rawv[X][rr] = v; } } \
        if ((W4) == 0) { gpre = g[(r0_ + (LN)) * 16 + h_]; bpre = beta[(r0_ + (LN)) * 16 + h_]; } } while (0)
    const int u0 = 2 * vcu + grp, ustep = 2 * G;
    if (u0 < NCG * NHEADS) H2_LOAD_RAW(u0, (tid0 & 63), __builtin_amdgcn_readfirstlane((tid0 >> 6) & 3));
    for (int u = u0; u < NCG * NHEADS; u += ustep) {
        const int cg = u >> 4, h = u & 15; const size_t row0 = (size_t)cg * 64;
        int tl_ = tid0; asm volatile("" : "+v"(tl_));
        const int tid = tl_, lane = tid & 63, w4 = __builtin_amdgcn_readfirstlane((tid >> 6) & 3), gt = tid & 255, r32 = lane & 31, hi = lane >> 5;
        {
            const int cgp = lane & 15, sub = lane >> 4, tA = 16 * w4 + 4 * sub;
#pragma unroll
            for (int X = 0; X < 3; ++X) {
                const int col = X * 2048 + h * HD + 8 * cgp;
                asm volatile("" : "+v"(rawv[X][0]), "+v"(rawv[X][1]), "+v"(rawv[X][2]), "+v"(rawv[X][3]), "+v"(rawv[X][4]), "+v"(rawv[X][5]), "+v"(rawv[X][6]));
                float wj[4][8];
#pragma unroll
                for (int j = 0; j < 4; ++j) { const f32x4 wa = *(const GAS f32x4*)(conv_w + (size_t)j * CONVC + col), wb = *(const GAS f32x4*)(conv_w + (size_t)j * CONVC + col + 4);
#pragma unroll
                    for (int c = 0; c < 4; ++c) { wj[j][c] = wa[c]; wj[j][4 + c] = wb[c]; } }
                float o[4][8];
#pragma unroll
                for (int t = 0; t < 4; ++t)
#pragma unroll
                    for (int c = 0; c < 8; ++c) o[t][c] = 0.f;
#pragma unroll
                for (int rr = 0; rr < 7; ++rr) { const v4u v = rawv[X][rr]; const float rw[8] = {bflo(v.x), bfhi(v.x), bflo(v.y), bfhi(v.y), bflo(v.z), bfhi(v.z), bflo(v.w), bfhi(v.w)};
#pragma unroll
                    for (int t = 0; t < 4; ++t) { const int j = rr - t; if (j >= 0 && j < 4) {
#pragma unroll
                            for (int c = 0; c < 8; ++c) o[t][c] += wj[j][c] * rw[c]; } } }
                LAS bf16* T = X == 0 ? Qs : (X == 1 ? Ks : Vs);
#pragma unroll
                for (int t = 0; t < 4; ++t) { float s = 0.f;
#pragma unroll
                    for (int c = 0; c < 8; ++c) { o[t][c] = silu_f(o[t][c]); s += o[t][c] * o[t][c]; }
                    if (X < 2) { s = sum16(s); const float f = (X == 0 ? 0.08838834764831845f : 1.f) * __builtin_amdgcn_rsqf(s + GDN_EPS);
#pragma unroll
                        for (int c = 0; c < 8; ++c) o[t][c] *= f; }
                    v4u w0; w0.x = pk2(o[t][0], o[t][1]); w0.y = pk2(o[t][2], o[t][3]); w0.z = pk2(o[t][4], o[t][5]); w0.w = pk2(o[t][6], o[t][7]);
                    *(LAS v4u*)(T + (tA + t) * G2_TS + 8 * cgp) = w0; }
                asm volatile("" ::: "memory");
            }
            if (w4 == 0) {
                float gv = gpre;
#pragma unroll
                for (int o_ = 1; o_ < 64; o_ <<= 1) { const float t = __shfl_up(gv, o_); if (lane >= o_) gv += t; }
                gcs[lane] = gv; bts[lane] = bpre; if (!palt) g[(row0 + lane) * 16 + h] = gv;
            }
        }
        grp_bar(cnt, tgt, lane);
        if (u + ustep < NCG * NHEADS) H2_LOAD_RAW(u + ustep, lane, w4);
        {
            const int rb = w4 >> 1, cb = w4 & 1; const int j = 32 * cb + r32; const float gj = gcs[j];
            GAS bf16* at = palt ? palt + (((size_t)u * 4096 + 0x4000000ull) & 0x7ffffffull) : attn + (size_t)u * 4096;
#pragma unroll
            for (int pass = 0; pass < 2; ++pass) {
                f32x16 acc = {};
                if (!(rb == 0 && cb == 1)) {
                    const LAS bf16* Ar = (pass == 0 ? Ks : Qs) + (32 * rb + r32) * G2_TS + 8 * hi; const LAS bf16* Br = Ks + (32 * cb + r32) * G2_TS + 8 * hi;
#pragma unroll
                    for (int s = 0; s < 8; ++s) acc = MFMA32(*(const LAS bf16x8*)(Ar + 16 * s), *(const LAS bf16x8*)(Br + 16 * s), acc);
                }
#pragma unroll
                for (int r = 0; r < 16; ++r) { const int i = 32 * rb + (r & 3) + 8 * (r >> 2) + 4 * hi; const float gi = gcs[i];
                    if (pass == 0) { const float d = (i > j) ? __expf(gi - gj) : 0.f; const float a = (i > j) ? bts[i] * acc[r] * d : 0.f; An[i * G2_ANS + j] = (bf16)f2bf(-a);
                        if ((i >> 4) == (j >> 4)) Ad[(i >> 4) * 256 + (i & 15) * 16 + (j & 15)] = a; }
                    else { const float d = (i >= j) ? __expf(gi - gj) : 0.f; at[i * 64 + j] = (bf16)f2bf((i >= j) ? acc[r] * d : 0.f); } }
            }
        }
        grp_bar(cnt, tgt, lane);
        if (w4 == 0) {
            const int b = lane >> 4, c = lane & 15; float t[16];
            const LAS float* Ab = Ad + b * 256;
#pragma unroll
            for (int i = 0; i < 16; ++i) {
                float ti = (i == c) ? 1.f : 0.f;
#pragma unroll
                for (int j4 = 0; j4 < (i + 3) / 4; ++j4) { const f32x4 a = *(const LAS f32x4*)(Ab + i * 16 + 4 * j4);
#pragma unroll
                    for (int k = 0; k < 4; ++k) if (4 * j4 + k < i) ti -= a[k] * t[4 * j4 + k]; }
                t[i] = ti;
            }
#pragma unroll
            for (int i = 0; i < 16; ++i) Tb[b * 256 + i * 16 + c] = (bf16)f2bf(t[i]);
        } else {
            const int tt = gt - 64;
            for (int pc = tt; pc < 1024; pc += 192) { const int i = pc >> 4, cgp = pc & 15; const float e = __expf(gcs[i]); const v4u v = *(const LAS v4u*)(Qs + i * G2_TS + 8 * cgp); v4u w;
                w.x = pk2(bflo(v.x) * e, bfhi(v.x) * e); w.y = pk2(bflo(v.y) * e, bfhi(v.y) * e); w.z = pk2(bflo(v.z) * e, bfhi(v.z) * e); w.w = pk2(bflo(v.w) * e, bfhi(v.w) * e);
                *(GAS v4u*)G2_ST((row0 + i) * GDN_MAIN + h * HD + 8 * cgp) = w; }
            const float gl = gcs[63];
            for (int task = tt; task < 256; task += 192) { const int dk = task & 127, th = task >> 7;
                GAS bf16* dst = G2_ST((row0 + (dk >> 1)) * GDN_MAIN + 2048 + h * HD + (dk & 1) * 64 + 32 * th);
#pragma unroll
                for (int q = 0; q < 4; ++q) { float v[8];
#pragma unroll
                    for (int k = 0; k < 8; ++k) { const int tk = 32 * th + 8 * q + k; v[k] = bf2f(Ks[tk * G2_TS + dk]) * __expf(gl - gcs[tk]); }
                    v4u w; w.x = pk2(v[0], v[1]); w.y = pk2(v[2], v[3]); w.z = pk2(v[4], v[5]); w.w = pk2(v[6], v[7]); *(GAS v4u*)(dst + 8 * q) = w; } }
        }
        grp_bar(cnt, tgt, lane);
        {
            const int nl = lane & 15, q = lane >> 4; const bool isK = w4 >= 2;
            float rsc[16];
#pragma unroll
            for (int b = 0; b < 4; ++b)
#pragma unroll
                for (int r = 0; r < 4; ++r) { const int row = 16 * b + 4 * q + r; rsc[4 * b + r] = isK ? bts[row] * __expf(gcs[row]) : bts[row]; }
            bf16x4 Tq[4], Aq[6];
#pragma unroll
            for (int b = 0; b < 4; ++b) Tq[b] = *(const LAS bf16x4*)(Tb + b * 256 + nl * 16 + 4 * q);
            Aq[0] = *(const LAS bf16x4*)(An + (16 + nl) * G2_ANS + 4 * q);
            Aq[1] = *(const LAS bf16x4*)(An + (32 + nl) * G2_ANS + 4 * q);      Aq[2] = *(const LAS bf16x4*)(An + (32 + nl) * G2_ANS + 16 + 4 * q);
            Aq[3] = *(const LAS bf16x4*)(An + (48 + nl) * G2_ANS + 4 * q);      Aq[4] = *(const LAS bf16x4*)(An + (48 + nl) * G2_ANS + 16 + 4 * q);   Aq[5] = *(const LAS bf16x4*)(An + (48 + nl) * G2_ANS + 32 + 4 * q);
#pragma unroll
            for (int t = 0; t < 4; ++t) {
                const int cc = 64 * (w4 & 1) + 16 * t + nl;
                const LAS bf16* src = (isK ? Ks : Vs) + cc;
                f32x4 R[4];
#pragma unroll
                for (int b = 0; b < 4; ++b)
#pragma unroll
                    for (int r = 0; r < 4; ++r) R[b][r] = rsc[4 * b + r] * bf2f(src[(16 * b + 4 * q + r) * G2_TS]);
                const f32x4 z4 = {0.f, 0.f, 0.f, 0.f};
                const f32x4 y0 = MFMA16K16(Tq[0], pack4(R[0]), z4); const bf16x4 y0b = pack4(y0);
                f32x4 c1 = MFMA16K16(Aq[0], y0b, R[1]);
                const f32x4 y1 = MFMA16K16(Tq[1], pack4(c1), z4); const bf16x4 y1b = pack4(y1);
                f32x4 c2 = MFMA16K16(Aq[1], y0b, R[2]); c2 = MFMA16K16(Aq[2], y1b, c2);
                const f32x4 y2 = MFMA16K16(Tq[2], pack4(c2), z4); const bf16x4 y2b = pack4(y2);
                f32x4 c3 = MFMA16K16(Aq[3], y0b, R[3]); c3 = MFMA16K16(Aq[4], y1b, c3); c3 = MFMA16K16(Aq[5], y2b, c3);
                const f32x4 y3 = MFMA16K16(Tq[3], pack4(c3), z4); const bf16x4 y3b = pack4(y3);
                if (!isK) {
                    GAS bf16* dst = G2_ST((row0 + (cc & 63)) * GDN_MAIN + 4096 + h * HD + (cc >> 6) * 64 + 4 * q);
                    *(GAS bf16x4*)(dst) = y0b; *(GAS bf16x4*)(dst + 16) = y1b; *(GAS bf16x4*)(dst + 32) = y2b; *(GAS bf16x4*)(dst + 48) = y3b;
                } else {
                    GAS bf16* dst = palt ? palt + (((row0 + 4 * q) * DMODEL + h * HD + cc) & 0x7ffffffull) : wbuf + (row0 + 4 * q) * DMODEL + h * HD + cc;
#pragma unroll
                    for (int r = 0; r < 4; ++r) { dst[(size_t)r * DMODEL] = (bf16)y0b[r]; dst[(size_t)(16 + r) * DMODEL] = (bf16)y1b[r]; dst[(size_t)(32 + r) * DMODEL] = (bf16)y2b[r]; dst[(size_t)(48 + r) * DMODEL] = (bf16)y3b[r]; }
                }
            }
        }
        grp_bar(cnt, tgt, lane);
    }
#undef H2_LOAD_RAW
#undef G2_ST
    __syncthreads();
}

constexpr int G3_STS = 136, G3_VTS = 72;
constexpr int G3_ST = 0, G3_VT = G3_ST + 64 * G3_STS * 2, G3_OT = G3_VT + 64 * G3_VTS * 2, G3_WT = G3_OT + 64 * G3_VTS * 2, G3_QT = G3_WT + 64 * G3_STS * 2, G3_KT = G3_QT + 64 * G3_STS * 2,
              G3_PT = G3_KT + 128 * G3_VTS * 2, G3_UT = G3_PT + 64 * G3_VTS * 2, G3_END = G3_UT + 64 * G3_VTS * 2;
static_assert(G3_END <= RING_BYTES, "G3 LDS");
__device__ __forceinline__ void gdn_scan_phase(LAS unsigned char* lds, bf16* p_, const bf16* wbuf_, const bf16* attn_, const float* g_, int vcu, int G, bf16* oalt_ = nullptr) {
    GAS bf16* const p = (GAS bf16*)p_; const GAS bf16* const wbuf = (const GAS bf16*)wbuf_; const GAS bf16* const attn = (const GAS bf16*)attn_; const GAS float* const g = (const GAS float*)g_; GAS bf16* const oalt = (GAS bf16*)oalt_;
    int tid_ = threadIdx.x; asm volatile("" : "+v"(tid_));
    const int tid = tid_, lane = tid & 63, wid = __builtin_amdgcn_readfirstlane(tid >> 6), r32 = lane & 31, hi = lane >> 5;
    const int role = wid >> 2, a = (wid >> 1) & 1, bb = wid & 1, r = wid >> 1;
    LAS bf16* ST = (LAS bf16*)(lds + G3_ST); LAS bf16* VT = (LAS bf16*)(lds + G3_VT); LAS bf16* OT = (LAS bf16*)(lds + G3_OT);
    LAS bf16* WT = (LAS bf16*)(lds + G3_WT); LAS bf16* QT = (LAS bf16*)(lds + G3_QT); LAS bf16* KT = (LAS bf16*)(lds + G3_KT); LAS bf16* PT = (LAS bf16*)(lds + G3_PT); LAS bf16* UT = (LAS bf16*)(lds + G3_UT);
    for (int unit = vcu; unit < BATCH * NHEADS * 2; unit += G) {
        const int bh = unit >> 1, e = unit & 1, b = bh >> 4, h = bh & 15;
        for (int i = tid; i < G3_VT / 4; i += NWAVES * 64) ((LAS unsigned*)lds)[i] = 0u;
        f32x16 Sacc = {};
        const int r16a = tid >> 4, c16 = tid & 15, r8 = tid >> 3, c8 = tid & 7;
        const GAS bf16* gW = wbuf + (size_t)r16a * DMODEL + h * HD + 8 * c16;
        const GAS bf16* gQ = p + (size_t)r16a * GDN_MAIN + h * HD + 8 * c16;
        const GAS bf16* gK = p + (size_t)r16a * GDN_MAIN + 2048 + h * HD + 8 * c16;
        const GAS bf16* gP = attn + (size_t)r8 * 64 + 8 * c8;
        const GAS bf16* gU = p + (size_t)r8 * GDN_MAIN + 4096 + h * HD + e * 64 + 8 * c8;
        LAS bf16* sW = WT + r16a * G3_STS + 8 * c16; LAS bf16* sQ = QT + r16a * G3_STS + 8 * c16;
        LAS bf16* sK = KT + (2 * r16a + (c16 >> 3)) * G3_VTS + 8 * (c16 & 7);
        LAS bf16* sP = PT + r8 * G3_VTS + 8 * c8; LAS bf16* sU = UT + r8 * G3_VTS + 8 * c8;
        GAS bf16* oRow = (oalt ? oalt : p + 4096) + h * HD + e * 64; const size_t oPitch = oalt ? DMODEL : GDN_MAIN;
        const LAS bf16* aRd = (role == 0 ? WT : QT) + (32 * a + r32) * G3_STS + 8 * hi;
        const LAS bf16* sRd = ST + (32 * bb + r32) * G3_STS + 8 * hi; const LAS bf16* vRd = VT + (32 * bb + r32) * G3_VTS + 8 * hi;
        const LAS bf16* uRd = UT + (32 * bb + r32) * G3_VTS + 32 * a + 4 * hi; const LAS bf16* pRd = PT + (32 * a + r32) * G3_VTS + 8 * hi; const LAS bf16* kRd = KT + (32 * r + r32) * G3_VTS + 8 * hi;
        LAS bf16* vWr = VT + (32 * bb + r32) * G3_VTS + 32 * a + 4 * hi; LAS bf16* sWr = ST + (32 * bb + r32) * G3_STS + 32 * r + 4 * hi;
        v4u gw0, gw1, gq0, gq1, gk0, gk1, gp0, gu0; float dd;
#define G3_LOAD(nn) do { const size_t row0_ = (size_t)b * SEQ + (size_t)(nn) * 64; \
            gw0 = *(const GAS v4u*)(gW + row0_ * DMODEL); gw1 = *(const GAS v4u*)(gW + (row0_ + 32) * DMODEL); \
            gq0 = *(const GAS v4u*)(gQ + row0_ * GDN_MAIN); gq1 = *(const GAS v4u*)(gQ + (row0_ + 32) * GDN_MAIN); \
            gk0 = *(const GAS v4u*)(gK + row0_ * GDN_MAIN); gk1 = *(const GAS v4u*)(gK + (row0_ + 32) * GDN_MAIN); \
            gp0 = *(const GAS v4u*)(gP + ((size_t)(b * 64 + (nn)) * 16 + h) * 4096); gu0 = *(const GAS v4u*)(gU + row0_ * GDN_MAIN); \
            dd = __expf(g[(row0_ + 63) * 16 + h]); } while (0)
        G3_LOAD(0);
        __syncthreads();
#pragma unroll 1
        for (int n = 0; n < 64; ++n) {
            const size_t row0_ = (size_t)b * SEQ + (size_t)n * 64; const int nn = (n + 1 < 64) ? n + 1 : n;
            *(LAS v4u*)(sW) = gw0; *(LAS v4u*)(sW + 32 * G3_STS) = gw1; *(LAS v4u*)(sQ) = gq0; *(LAS v4u*)(sQ + 32 * G3_STS) = gq1;
            *(LAS v4u*)(sK) = gk0; *(LAS v4u*)(sK + 64 * G3_VTS) = gk1; *(LAS v4u*)(sP) = gp0; *(LAS v4u*)(sU) = gu0;
            const float dcur = dd;
            WG_BAR();
            G3_LOAD(nn);
            f32x16 acc_ = {};
#pragma unroll
            for (int s = 0; s < 8; ++s) acc_ = MFMA32(*(const LAS bf16x8*)(aRd + 16 * s), *(const LAS bf16x8*)(sRd + 16 * s), acc_);
            if (role == 0) {
#pragma unroll
                for (int q = 0; q < 4; ++q) { const v2u uu = *(const LAS v2u*)(uRd + 8 * q); v2u w_;
                    w_.x = pk2(bflo(uu.x) - acc_[4 * q], bfhi(uu.x) - acc_[4 * q + 1]); w_.y = pk2(bflo(uu.y) - acc_[4 * q + 2], bfhi(uu.y) - acc_[4 * q + 3]);
                    *(LAS v2u*)(vWr + 8 * q) = w_; }
            }
            WG_BAR();
            bf16x8 Vf_[4];
#pragma unroll
            for (int s = 0; s < 4; ++s) Vf_[s] = *(const LAS bf16x8*)(vRd + 16 * s);
            if (role == 1) {
#pragma unroll
                for (int s = 0; s < 4; ++s) acc_ = MFMA32(*(const LAS bf16x8*)(pRd + 16 * s), Vf_[s], acc_);
#pragma unroll
                for (int rr = 0; rr < 16; ++rr) OT[(32 * a + (rr & 3) + 8 * (rr >> 2) + 4 * hi) * G3_VTS + 32 * bb + r32] = (bf16)f2bf(acc_[rr]);
            }
            Sacc = Sacc * dcur;
#pragma unroll
            for (int s = 0; s < 4; ++s) Sacc = MFMA32(*(const LAS bf16x8*)(kRd + 16 * s), Vf_[s], Sacc);
#pragma unroll
            for (int q = 0; q < 4; ++q) { v2u w_; w_.x = pk2(Sacc[4 * q], Sacc[4 * q + 1]); w_.y = pk2(Sacc[4 * q + 2], Sacc[4 * q + 3]); *(LAS v2u*)(sWr + 8 * q) = w_; }
            WG_BAR();
            *(GAS v4u*)(oRow + (row0_ + r8) * oPitch + 8 * c8) = *(const LAS v4u*)(OT + r8 * G3_VTS + 8 * c8);
        }
#undef G3_LOAD
        VM_WAIT(); __syncthreads();
    }
}

__device__ __forceinline__ void gdn_gate_phase(bf16* p, const float* norm_w, int gw, int NGW, int lane, bf16* oalt = nullptr) {
    for (int m = gw; m < MROWS; m += NGW) {
        GAS bf16* orow = (GAS bf16*)p + (size_t)m * GDN_MAIN + 4096; const GAS bf16* zrow = (const GAS bf16*)p + (size_t)m * GDN_MAIN + 6144;
#pragma unroll
        for (int it = 0; it < 4; ++it) { const int col = it * 512 + lane * 8;
            const v4u ov = *(const GAS v4u*)(orow + col), zv = *(const GAS v4u*)(zrow + col);
            float o[8] = {bflo(ov.x), bfhi(ov.x), bflo(ov.y), bfhi(ov.y), bflo(ov.z), bfhi(ov.z), bflo(ov.w), bfhi(ov.w)};
            float z[8] = {bflo(zv.x), bfhi(zv.x), bflo(zv.y), bfhi(zv.y), bflo(zv.z), bfhi(zv.z), bflo(zv.w), bfhi(zv.w)};
            float s = 0.f;
#pragma unroll
            for (int c = 0; c < 8; ++c) s += o[c] * o[c];
            s = sum16(s); const float rs = __builtin_amdgcn_rsqf(s * (1.f / HD) + GDN_EPS);
            const f32x4 wa = *(const GAS f32x4*)((const GAS float*)norm_w + (col & 127)), wb = *(const GAS f32x4*)((const GAS float*)norm_w + (col & 127) + 4);
#pragma unroll
            for (int c = 0; c < 8; ++c) o[c] = o[c] * rs * (c < 4 ? wa[c] : wb[c - 4]) * silu_f(z[c]);
            v4u w; w.x = pk2(o[0], o[1]); w.y = pk2(o[2], o[3]); w.z = pk2(o[4], o[5]); w.w = pk2(o[6], o[7]); *(GAS v4u*)((oalt ? (GAS bf16*)oalt + (size_t)m * DMODEL : orow) + col) = w; }
    }
}

#ifndef PG8_SP2
#define PG8_SP2 true
#endif
#ifndef PG8_ALIGN
#define PG8_ALIGN true
#endif
#ifndef EN_P0
#define EN_P0 1
#endif
#ifndef EN_G1
#define EN_G1 1
#endif
#ifndef EN_G2
#define EN_G2 1
#endif
#ifndef EN_G3
#define EN_G3 1
#endif
#ifndef EN_G4
#define EN_G4 1
#endif
#ifndef EN_G5
#define EN_G5 1
#endif
#ifndef EN_G6
#define EN_G6 1
#endif
#ifndef EN_G7
#define EN_G7 1
#endif
#ifndef EN_G8
#define EN_G8 1
#endif
#ifndef EN_G9
#define EN_G9 1
#endif
#ifndef EN_D1
#define EN_D1 1
#endif
#ifndef EN_D2
#define EN_D2 1
#endif
#ifndef EN_D3
#define EN_D3 1
#endif
#ifndef EN_D4
#define EN_D4 1
#endif
#ifndef EN_D5
#define EN_D5 1
#endif
#ifndef EN_D6U
#define EN_D6U 1
#endif
#ifndef EN_D6D
#define EN_D6D 1
#endif
#ifndef EN_D7
#define EN_D7 1
#endif
#ifndef REP_P0
#define REP_P0 1
#endif
#ifndef REP_G1
#define REP_G1 1
#endif
#ifndef REP_G2
#define REP_G2 1
#endif
#ifndef REP_G3
#define REP_G3 1
#endif
#ifndef REP_G4
#define REP_G4 1
#endif
#ifndef REP_G5
#define REP_G5 1
#endif
#ifndef REP_G6
#define REP_G6 1
#endif
#ifndef REP_G7
#define REP_G7 1
#endif
#ifndef REP_G8
#define REP_G8 1
#endif
#ifndef REP_G9
#define REP_G9 1
#endif
#ifndef REP_D1
#define REP_D1 1
#endif
#ifndef REP_D2
#define REP_D2 1
#endif
#ifndef REP_D3
#define REP_D3 1
#endif
#ifndef REP_D4
#define REP_D4 1
#endif
#ifndef REP_D5
#define REP_D5 1
#endif
#ifndef REP_D6U
#define REP_D6U 1
#endif
#ifndef REP_D6D
#define REP_D6D 1
#endif
#ifndef REP_D7
#define REP_D7 1
#endif
#ifndef G2_VER
#define G2_VER 2
#endif
#if G2_VER == 2
#define G2_FN gdn_chunk_phase2
#else
#define G2_FN gdn_chunk_phase
#endif
#ifndef LN_FUSED
#define LN_FUSED 0
#endif
#ifndef MLP_SPLIT
#define MLP_SPLIT 1
#endif
#define DSTRIDE (6 + 2 * MLP_SPLIT)
#define N_PHASES_K (19 + 2 * DSTRIDE)
#ifndef WGM_BIG
#define WGM_BIG 8
#endif
#ifndef WGM_SMALL
#define WGM_SMALL 4
#endif
#ifndef WGM_DOWN
#define WGM_DOWN 4
#endif
#ifndef PROBE_DBLBAR
#define PROBE_DBLBAR 0
#endif
#ifndef REP_BA
#define REP_BA 1
#endif
#ifndef PROBE_NOSTORE
#define PROBE_NOSTORE 0
#endif
#ifndef XSPLIT
#define XSPLIT 1
#endif
struct Args { const float* in[16]; float* out; unsigned char* ws; int ph_lo, ph_hi; };
__global__ void __launch_bounds__(NWAVES * 64, 2) yoco_fwd(Args args) {
    extern __shared__ __attribute__((aligned(16))) unsigned char lds_raw[];
    LAS unsigned char* lds = (LAS unsigned char*)lds_raw;
    volatile LAS unsigned* MISC = (volatile LAS unsigned*)(lds + MISC_OFF);
    const int tid = threadIdx.x, lane = tid & 63, wave = __builtin_amdgcn_readfirstlane(tid >> 6);
    const int G = gridDim.x, bx = blockIdx.x, vcu = (G % 8 == 0) ? (bx % 8) * (G / 8) + bx / 8 : bx;
    const int gw = vcu * NWAVES + wave, NGW = G * NWAVES, gtid = vcu * NWAVES * 64 + tid, NGT = G * NWAVES * 64;
    const float* ln_g = args.in[14]; const float* ln_b = args.in[15];
    for (int u = tid; u < (LDS_BYTES - LDSCTL_OFF) / 4; u += NWAVES * 64) ((LAS unsigned*)(lds + LDSCTL_OFF))[u] = 0u;
    __syncthreads();
    XcdBarrier bar; bar.bar = (unsigned*)(args.ws + WS_CTL) + CW_BAR; bar.x = 0; bar.st = nullptr;
    if (!MK_PER_PHASE) bar = xcd_barrier_post((unsigned*)(args.ws + WS_CTL) + CW_BAR, MISC + 8);
    const int lo = args.ph_lo, hi = args.ph_hi;
#define IN(k) (lo <= (k) && (k) < hi)
#define FRESH_LANE() int ln_ = lane; asm volatile("" : "+v"(ln_)); unsigned char* ws_ = args.ws; asm volatile("" : "+s"(ws_)); int gw_ = gw, vcu_ = vcu, bx_ = bx; asm volatile("" : "+s"(gw_), "+s"(vcu_), "+s"(bx_))
#define x_in         (args.in[0])
#define gdn_w_in     (args.in[1])
#define gdn_conv_w   (args.in[2])
#define gdn_a_log    (args.in[3])
#define gdn_dt_bias  (args.in[4])
#define gdn_norm_w   (args.in[5])
#define gdn_w_out    (args.in[6])
#define diff_w_q     (args.in[7])
#define diff_lambda  (args.in[8])
#define diff_subln_w (args.in[9])
#define diff_w_o     (args.in[10])
#define shared_w_kv  (args.in[11])
#define mlp_w_up     (args.in[12])
#define mlp_w_down   (args.in[13])
#define beta  ((float*)(ws_ + WS_BETA))
#define gdec  ((float*)(ws_ + WS_G))
#define halo  ((bf16*)(ws_ + WS_HALO))
#define WA    ((bf16*)(ws_ + WS_WA))
#define WB    ((bf16*)(ws_ + WS_WB))
#define attnb ((bf16*)(ws_ + WS_ATTN))
#define XB    ((bf16*)(ws_ + WS_XB))
#define LNSLOTS ((unsigned long long*)(ws_ + WS_Y))
#define LNCNT(sl) ((unsigned*)(ws_ + WS_CTL) + 16384 + (sl) * 8192)
#define LNTMO ((unsigned*)(ws_ + WS_CTL) + 8)
#define HB    ((bf16*)(ws_ + WS_Y))
#define WBUF  ((bf16*)(ws_ + WS_Y + QTR))
#define R1    ((bf16*)(ws_ + WS_R1))
#define Kb    (R1)
#define Vb    (R1 + QTR / 2)
#define Qb    (R1 + 2 * (QTR / 2))
#define HID   (Qb)
#define SEAM(k) do { if (!MK_PER_PHASE && (k) + 1 < hi) { xcd_barrier(bar); if (PROBE_DBLBAR) xcd_barrier(bar); } } while (0)

    for (int rep_ = 0; rep_ < REP_P0; ++rep_) if (EN_P0 && IN(0)) { FRESH_LANE();
        for (int m = gw_; m < MROWS; m += NGW) row_to_bf16(x_in + (size_t)m * DMODEL, XB + (size_t)m * DMODEL, ln_);
        convert_w(lds, gw_, NGW, wave, ln_, gdn_w_in, DMODEL, GDN_PROJ, 0, GDN_PROJ, WA, 0);
        SEAM(0);
    }
    for (int l = 0; l < 2; ++l) {
        const int pb = 1 + 9 * l;
        for (int rep_ = 0; rep_ < REP_G1; ++rep_) if (EN_G1 && IN(pb + 0)) { FRESH_LANE();
#pragma unroll 1
            for (int s2_ = 0; s2_ < 2; ++s2_) {
                int ln2_ = lane; asm volatile("" : "+v"(ln2_));
                const bool side = ((s2_ == 0) == (XSPLIT && (bx_ & 1) != 0));
                if (side) { for (int rb_ = 0; rb_ < REP_BA; ++rb_) ba_proj(lds + RING_OFF, XB, WA, gdn_a_log + l * 16, gdn_dt_bias + l * 16, beta, gdec, gw_, NGW, ln2_); }
                else {
                    pg8::Gemm g{XB, WA, MROWS, GDN_MAIN, DMODEL, DMODEL}; pg8::StaticOrder S; S.init(MROWS, GDN_MAIN, G, bx_, WGM_BIG);
                    pg8::EpiStore<0> E{R1, GDN_MAIN, 0, 0, -1, 1.f, halo};
                    pg8::gemm_phase<pg8::EpiStore<0>, pg8::StaticOrder, PG8_ALIGN, PG8_SP2>(lds + RING_OFF, g, S, E); }
            }
            SEAM(pb + 0);
        }
        for (int rep_ = 0; rep_ < REP_G2; ++rep_) if (EN_G2 && IN(pb + 1)) { FRESH_LANE(); G2_FN(lds, R1, halo, beta, gdec, WBUF, attnb, gdn_conv_w + (size_t)l * 4 * CONVC, vcu_, G, (rep_ + 1 < REP_G2) ? (bf16*)args.out : nullptr); SEAM(pb + 1); }
        for (int rep_ = 0; rep_ < REP_G3; ++rep_) if (EN_G3 && IN(pb + 2)) { FRESH_LANE(); gdn_scan_phase(lds, R1, WBUF, attnb, gdec, vcu_, G, (rep_ + 1 < REP_G3) ? (bf16*)args.out : nullptr); SEAM(pb + 2); }
        for (int rep_ = 0; rep_ < REP_G4; ++rep_) if (EN_G4 && IN(pb + 3)) { FRESH_LANE();
            gdn_gate_phase(R1, gdn_norm_w + l * HD, gw_, NGW, ln_, (rep_ + 1 < REP_G4) ? (bf16*)args.out : nullptr);
            convert_w(lds, gw_, NGW, wave, ln_, gdn_w_out + (size_t)l * DMODEL * DMODEL, DMODEL, DMODEL, 0, DMODEL, WA, 0);
            convert_w(lds, gw_, NGW, wave, ln_, mlp_w_up + (size_t)l * DMODEL * DFF, DMODEL, DFF, 0, DFF, WB, 0);
            SEAM(pb + 3);
        }
        for (int rep_ = 0; rep_ < REP_G5; ++rep_) if (EN_G5 && IN(pb + 4)) { FRESH_LANE();
            pg8::Gemm g{R1 + 4096, WA, MROWS, DMODEL, DMODEL, GDN_MAIN}; pg8::StaticOrder S; S.init(MROWS, DMODEL, G, bx_, WGM_SMALL);
#if LN_FUSED
            pg8::EpiLn E{XB, XB, nullptr, ln_g + (size_t)(l * 2) * DMODEL, ln_b + (size_t)(l * 2) * DMODEL, LNSLOTS, LNCNT(2 * l), LNTMO, 0, lds + RING_BYTES};
            pg8::gemm_phase<pg8::EpiLn, pg8::StaticOrder, true, PG8_SP2>(lds + RING_OFF, g, S, E);
#else
            pg8::EpiStore<0> E{(rep_ + 1 < REP_G5) ? (bf16*)args.out : HB, DMODEL, 0, 0, -1, 1.f, nullptr};
            pg8::gemm_phase<pg8::EpiStore<0>, pg8::StaticOrder, PG8_ALIGN, PG8_SP2>(lds + RING_OFF, g, S, E);
#endif
            SEAM(pb + 4);
        }
        const float* g1 = ln_g + (size_t)(l * 2) * DMODEL; const float* b1 = ln_b + (size_t)(l * 2) * DMODEL;
        for (int rep_ = 0; rep_ < REP_G6; ++rep_) if (!LN_FUSED && EN_G6 && IN(pb + 5)) { FRESH_LANE();
            ln_pass_b(XB, HB, g1, b1, XB, nullptr, ALPHA_RES, gw_, NGW, ln_);
            SEAM(pb + 5);
        }
        for (int rep_ = 0; rep_ < REP_G7; ++rep_) if (EN_G7 && IN(pb + 6)) { FRESH_LANE();
#pragma unroll 1
            for (int s2_ = 0; s2_ < 2; ++s2_) {
                int ln2_ = lane; asm volatile("" : "+v"(ln2_));
                const bool side = ((s2_ == 0) == (XSPLIT && (bx_ & 1) != 0));
                if (side) { if (!LN_FUSED) { convert_w(lds, gw_, NGW, wave, ln2_, mlp_w_down + (size_t)l * DFF * DMODEL, DFF, DMODEL, 0, DMODEL, WA, 0); __syncthreads(); } }
                else {
                    pg8::Gemm g{XB, WB, MROWS, DFF, DMODEL, DMODEL}; pg8::StaticOrder S; S.init(MROWS, DFF, G, bx_, WGM_BIG);
                    pg8::EpiStore<1> E{R1, DFF, 0, 0, -1, 1.f, nullptr};
                    pg8::gemm_phase<pg8::EpiStore<1>, pg8::StaticOrder, PG8_ALIGN, PG8_SP2>(lds + RING_OFF, g, S, E); }
            }
#if LN_FUSED
            { int ln2_ = lane; asm volatile("" : "+v"(ln2_)); convert_w(lds, gw_, NGW, wave, ln2_, mlp_w_down + (size_t)l * DFF * DMODEL, DFF, DMODEL, 0, DMODEL, WA, 0); }
#endif
            SEAM(pb + 6);
        }
        for (int rep_ = 0; rep_ < REP_G8; ++rep_) if (EN_G8 && IN(pb + 7)) { FRESH_LANE();
            pg8::Gemm g{R1, WA, MROWS, DMODEL, DFF, DFF}; pg8::StaticOrder S; S.init(MROWS, DMODEL, G, bx_, WGM_DOWN);
#if LN_FUSED
            pg8::EpiLn E{XB, XB, nullptr, ln_g + (size_t)(l * 2 + 1) * DMODEL, ln_b + (size_t)(l * 2 + 1) * DMODEL, LNSLOTS, LNCNT(2 * l + 1), LNTMO, 0, lds + RING_BYTES};
            pg8::gemm_phase<pg8::EpiLn, pg8::StaticOrder, true, PG8_SP2>(lds + RING_OFF, g, S, E);
#else
            pg8::EpiStore<0> E{(rep_ + 1 < REP_G8) ? (bf16*)args.out : HB, DMODEL, 0, 0, -1, 1.f, nullptr};
            pg8::gemm_phase<pg8::EpiStore<0>, pg8::StaticOrder, PG8_ALIGN, PG8_SP2>(lds + RING_OFF, g, S, E);
#endif
            SEAM(pb + 7);
        }
        for (int rep_ = 0; rep_ < REP_G9; ++rep_) if (EN_G9 && IN(pb + 8)) { FRESH_LANE();
            const float* g2 = ln_g + (size_t)(l * 2 + 1) * DMODEL; const float* b2 = ln_b + (size_t)(l * 2 + 1) * DMODEL;
            if (!LN_FUSED) ln_pass_b(XB, HB, g2, b2, XB, nullptr, ALPHA_RES, gw_, NGW, ln_);
            if (l == 0) convert_w(lds, gw_, NGW, wave, ln_, gdn_w_in + (size_t)DMODEL * GDN_PROJ, DMODEL, GDN_PROJ, 0, GDN_PROJ, WA, 0);
            else { convert_w(lds, gw_, NGW, wave, ln_, shared_w_kv, DMODEL, 2 * DMODEL, 0, 2 * DMODEL, WA, 0);
                   convert_w(lds, gw_, NGW, wave, ln_, diff_w_q, DMODEL, DMODEL, 0, DMODEL, WA, 2 * DMODEL); }
            SEAM(pb + 8);
        }
    }
    for (int j = 0; j < 2; ++j) {
        const int pb = 19 + DSTRIDE * j, L = 2 + j;
        for (int rep_ = 0; rep_ < REP_D1; ++rep_) if (EN_D1 && IN(pb + 0)) { FRESH_LANE();
            const int N = (j == 0) ? 3 * DMODEL : DMODEL;
            pg8::Gemm g{XB, WA, MROWS, N, DMODEL, DMODEL}; pg8::StaticOrder S; S.init(MROWS, N, G, bx_, WGM_BIG);
            pg8::EpiStore<0> E{(j == 0) ? Kb : Qb, DMODEL, (j == 0) ? DMODEL : 0, QTR / 2, (j == 0) ? 2 : 0, dattn::C2, nullptr};
            pg8::gemm_phase<pg8::EpiStore<0>, pg8::StaticOrder, PG8_ALIGN, PG8_SP2>(lds + RING_OFF, g, S, E);
            SEAM(pb + 0);
        }
        for (int rep_ = 0; rep_ < REP_D2; ++rep_) if (EN_D2 && IN(pb + 1)) { FRESH_LANE();
            const float lambda_init = 0.8f - 0.6f * expf(-0.3f * (float)L);
            const float* lp = diff_lambda + (size_t)j * 256;
            const float e1 = wave_sum(lp[ln_] * lp[64 + ln_]), e2 = wave_sum(lp[128 + ln_] * lp[192 + ln_]);
            const dattn::Params AP{(const dattn::bf16*)Qb, (const dattn::bf16*)Kb, (const dattn::bf16*)Vb, (rep_ + 1 < REP_D2) ? (dattn::bf16*)args.out : (dattn::bf16*)Qb, diff_subln_w + j * HD, __expf(e1) - __expf(e2) + lambda_init, 1.f - lambda_init};
            dattn::phase<8>((char*)lds_raw + RING_OFF, AP, G, bx_);
            { int ln2_ = lane; asm volatile("" : "+v"(ln2_));
              convert_w(lds, gw_, NGW, wave, ln2_, diff_w_o + (size_t)j * DMODEL * DMODEL, DMODEL, DMODEL, 0, DMODEL, WB, 0);
              convert_w(lds, gw_, NGW, wave, ln2_, mlp_w_up + (size_t)L * DMODEL * DFF, DMODEL, DFF, 0, DFF, WA, 0); }
            SEAM(pb + 1);
        }
        for (int rep_ = 0; rep_ < REP_D4; ++rep_) if (EN_D4 && IN(pb + 3)) { FRESH_LANE();
            pg8::Gemm g{Qb, WB, MROWS, DMODEL, DMODEL, DMODEL}; pg8::StaticOrder S; S.init(MROWS, DMODEL, G, bx_, WGM_SMALL);
#if LN_FUSED
            pg8::EpiLn E{XB, XB, nullptr, ln_g + (size_t)(L * 2) * DMODEL, ln_b + (size_t)(L * 2) * DMODEL, LNSLOTS, LNCNT(2 * L), LNTMO, 0, lds + RING_BYTES};
            pg8::gemm_phase<pg8::EpiLn, pg8::StaticOrder, true, PG8_SP2>(lds + RING_OFF, g, S, E);
#else
            pg8::EpiStore<0> E{(rep_ + 1 < REP_D4) ? (bf16*)args.out : HB, DMODEL, 0, 0, -1, 1.f, nullptr};
            pg8::gemm_phase<pg8::EpiStore<0>, pg8::StaticOrder, PG8_ALIGN, PG8_SP2>(lds + RING_OFF, g, S, E);
#endif
            SEAM(pb + 3);
        }
        const float* g1 = ln_g + (size_t)(L * 2) * DMODEL; const float* b1 = ln_b + (size_t)(L * 2) * DMODEL;
        for (int rep_ = 0; rep_ < REP_D5; ++rep_) if (!LN_FUSED && EN_D5 && IN(pb + 4)) { FRESH_LANE();
            ln_pass_b(XB, HB, g1, b1, XB, nullptr, ALPHA_RES, gw_, NGW, ln_);
            SEAM(pb + 4);
        }
        for (int hf = 0; hf < MLP_SPLIT; ++hf) {
            const size_t roff = (size_t)hf * (MROWS / MLP_SPLIT);
            for (int rep_ = 0; rep_ < REP_D6U; ++rep_) if (EN_D6U && IN(pb + 5 + 2 * hf)) { FRESH_LANE();
#pragma unroll 1
                for (int s2_ = 0; s2_ < 2; ++s2_) {
                    int ln2_ = lane; asm volatile("" : "+v"(ln2_));
                    const bool side = ((s2_ == 0) == (XSPLIT && (bx_ & 1) != 0));
                    if (side) { if (!LN_FUSED && hf == 0) { convert_w(lds, gw_, NGW, wave, ln2_, mlp_w_down + (size_t)L * DFF * DMODEL, DFF, DMODEL, 0, DMODEL, WB, 0); __syncthreads(); } }
                    else {
                pg8::Gemm g{XB + roff * DMODEL, WA, MROWS / MLP_SPLIT, DFF, DMODEL, DMODEL}; pg8::StaticOrder S; S.init(MROWS / MLP_SPLIT, DFF, G, bx_, WGM_BIG);
                    pg8::EpiStore<1> E{(PROBE_NOSTORE && rep_ + 1 < REP_D6U) ? (bf16*)nullptr : HID, DFF, 0, 0, -1, 1.f, nullptr, (MLP_SPLIT == 1) ? (bf16*)args.out : (bf16*)nullptr, MROWS / 2};
                    pg8::gemm_phase<pg8::EpiStore<1>, pg8::StaticOrder, PG8_ALIGN, PG8_SP2>(lds + RING_OFF, g, S, E);
}
                }
#if LN_FUSED
                if (hf == 0) { int ln2_ = lane; asm volatile("" : "+v"(ln2_)); convert_w(lds, gw_, NGW, wave, ln2_, mlp_w_down + (size_t)L * DFF * DMODEL, DFF, DMODEL, 0, DMODEL, WB, 0); }
#endif
                SEAM(pb + 5 + 2 * hf);
            }
            for (int rep_ = 0; rep_ < REP_D6D; ++rep_) if (EN_D6D && IN(pb + 6 + 2 * hf)) { FRESH_LANE();
                pg8::Gemm g{HID, WB, MROWS / MLP_SPLIT, DMODEL, DFF, DFF, (MLP_SPLIT == 1) ? (const bf16*)args.out : (const bf16*)nullptr, MROWS / 2 / 256}; pg8::StaticOrder S; S.init(MROWS / MLP_SPLIT, DMODEL, G, bx_, WGM_DOWN);
#if LN_FUSED
                pg8::EpiLn E{XB + roff * DMODEL, XB + roff * DMODEL, (j == 1) ? args.out + roff * DMODEL : (float*)nullptr, ln_g + (size_t)(L * 2 + 1) * DMODEL, ln_b + (size_t)(L * 2 + 1) * DMODEL,
                             LNSLOTS, LNCNT(2 * L + 1), LNTMO, hf * (MROWS / MLP_SPLIT / 256), lds + RING_BYTES};
                pg8::gemm_phase<pg8::EpiLn, pg8::StaticOrder, true, PG8_SP2>(lds + RING_OFF, g, S, E);
                if (j == 0 && hf == MLP_SPLIT - 1) { int ln2_ = lane; asm volatile("" : "+v"(ln2_)); convert_w(lds, gw_, NGW, wave, ln2_, diff_w_q + (size_t)DMODEL * DMODEL, DMODEL, DMODEL, 0, DMODEL, WA, 0); }
#else
                pg8::EpiStore<0> E{((rep_ + 1 < REP_D6D) ? (bf16*)args.out : HB) + roff * DMODEL, DMODEL, 0, 0, -1, 1.f, nullptr};
                pg8::gemm_phase<pg8::EpiStore<0>, pg8::StaticOrder, PG8_ALIGN, PG8_SP2>(lds + RING_OFF, g, S, E);
#endif
                SEAM(pb + 6 + 2 * hf);
            }
        }
        for (int rep_ = 0; rep_ < REP_D7; ++rep_) if (!LN_FUSED && EN_D7 && IN(pb + 5 + 2 * MLP_SPLIT)) { FRESH_LANE();
            const float* g2 = ln_g + (size_t)(L * 2 + 1) * DMODEL; const float* b2 = ln_b + (size_t)(L * 2 + 1) * DMODEL;
            if (j == 0) { ln_pass_b(XB, HB, g2, b2, XB, nullptr, ALPHA_RES, gw_, NGW, ln_);
                          convert_w(lds, gw_, NGW, wave, ln_, diff_w_q + (size_t)DMODEL * DMODEL, DMODEL, DMODEL, 0, DMODEL, WA, 0); }
            else { ln_pass_b(XB, HB, g2, b2, nullptr, args.out, ALPHA_RES, gw_, NGW, ln_); }
            SEAM(pb + 5 + 2 * MLP_SPLIT);
        }
    }
#undef IN
#undef SEAM
}

extern "C" void kernel_launch(void* const* d_in, const int* in_sizes, int n_in, void* d_out, int out_size, void* d_ws, size_t ws_size, hipStream_t stream) {
    static int grid = 0;
    if (grid == 0) {
        if (n_in != 16 || in_sizes[0] != MROWS * DMODEL || out_size != MROWS * DMODEL || ws_size < WS_END) { fprintf(stderr, "kernel_launch: unexpected shapes / workspace (n_in %d, ws %zu < %zu); nothing launched\n", n_in, ws_size, (size_t)WS_END); grid = -1; return; }
        int dev = 0, cus = 0, per_cu = 0;
        if (hipGetDevice(&dev) != hipSuccess || hipDeviceGetAttribute(&cus, hipDeviceAttributeMultiprocessorCount, dev) != hipSuccess) { grid = -1; return; }
        if (hipFuncSetAttribute((const void*)yoco_fwd, hipFuncAttributeMaxDynamicSharedMemorySize, LDS_BYTES) != hipSuccess) { fprintf(stderr, "kernel_launch: hipFuncSetAttribute failed\n"); grid = -1; return; }
        if (hipOccupancyMaxActiveBlocksPerMultiprocessor(&per_cu, (const void*)yoco_fwd, NWAVES * 64, LDS_BYTES) != hipSuccess || per_cu < 1)
            fprintf(stderr, "kernel_launch: note: occupancy query reports %d workgroups per CU\n", per_cu);
        (void)hipGetLastError();
        grid = cus;
    }
    if (grid < 0) return;
    if (hipMemsetAsync((char*)d_ws + WS_CTL, 0, CTL_ZERO_BYTES, stream) != hipSuccess) return;
    Args a{};
    for (int i = 0; i < 16; ++i) a.in[i] = (const float*)d_in[i];
    a.out = (float*)d_out; a.ws = (unsigned char*)d_ws;
#if MK_PER_PHASE
    for (int k = 0; k < N_PHASES_K; ++k) { a.ph_lo = k; a.ph_hi = k + 1; hipLaunchKernelGGL(yoco_fwd, dim3(grid), dim3(NWAVES * 64), LDS_BYTES, stream, a); }
#else
    a.ph_lo = 0; a.ph_hi = N_PHASES_K;
    hipLaunchKernelGGL(yoco_fwd, dim3(grid), dim3(NWAVES * 64), LDS_BYTES, stream, a);
#endif
    const hipError_t le = hipPeekAtLastError();
    if (le != hipSuccess) fprintf(stderr, "kernel_launch: launch failed: %s\n", hipGetErrorName(le));
}
```

```cpp
#include <hip/hip_runtime.h>
#include <hip/hip_bf16.h>
#include <cstdio>
#include <cstdint>
#include <cmath>

namespace pg8 {
#define PG8_LAS __attribute__((address_space(3)))
typedef unsigned short bf16_t;
typedef short bf16x8 __attribute__((ext_vector_type(8)));
typedef float f32x4 __attribute__((ext_vector_type(4)));
typedef unsigned u32x4 __attribute__((ext_vector_type(4)));
#define PG8_GAS __attribute__((address_space(1)))
#ifndef PG8_WGM
#define PG8_WGM 4
#endif
#ifndef PG8_STORE_NT
#define PG8_STORE_NT 0
#endif
#ifndef PG8_STORE_SC1
#define PG8_STORE_SC1 0
#endif
constexpr int BM = 256, BK = 64, HALF = 128, HTB = HALF * BK * 2  , STAGE_BYTES = 8 * HTB, NXCD = 8;

__host__ __device__ __forceinline__ int lds_byte(int r, int c) { const int st = (r >> 4) * 2 + (c >> 5), rr = r & 15, cc = c & 31, ob = rr * 64 + cc * 2; return st * 1024 + (ob ^ (((ob >> 9) & 1) << 5)); }
__host__ __device__ __forceinline__ void stage_rc(int b, int& R, int& C) { const int st = b / 1024, sb = b % 1024, swz = sb ^ (((sb >> 9) & 1) << 5); R = (st >> 1) * 16 + swz / 64; C = (st & 1) * 32 + (swz % 64) / 2; }
__host__ __device__ __forceinline__ int perm32(int rho) { const int n = rho >> 4, i = rho & 15; return 8 * (i >> 2) + 4 * n + (i & 3); }

struct Unit { int pm, pn; };
struct Gemm { const bf16_t* A; const bf16_t* Bt; int M, N, K, lda; const bf16_t* A2; int msplit; };

struct StaticOrder {
    int nM, nN, nwg, G, c, WGM;
    __host__ __device__ void init(int M, int N, int G_, int c_, int wgm = PG8_WGM) { nM = M / BM; nN = N / BM; nwg = nM * nN; G = G_; c = c_; WGM = wgm; }
    __host__ __device__ bool next(int i, Unit& u) const {
        if (WGM < 0) {
            const int ncx = nN / NXCD, e = i * (G / NXCD) + c / NXCD; if (e >= nM * ncx) return false;
            u.pm = e / ncx; u.pn = (c % NXCD) * ncx + e % ncx; return true; }
        const long L = (long)i * G + c; if (L >= nwg) return false;
        int wgid = (int)L; { const int q = nwg / NXCD, r = nwg % NXCD, xcd = wgid % NXCD, off = wgid / NXCD; wgid = (xcd < r ? xcd * (q + 1) : r * (q + 1) + (xcd - r) * q) + off; }
        const int nig = WGM * nN, gid = wgid / nig, fm = gid * WGM, gsz = (nM - fm) < WGM ? (nM - fm) : WGM;
        u.pm = fm + ((wgid % nig) % gsz); u.pn = (wgid % nig) / gsz; return true;
    }
    __device__ __forceinline__ void a_ready(const Unit&) const {}
    __device__ __forceinline__ void done(const Unit&) const {}
};

__device__ __forceinline__ unsigned cvt_pk_bf16(float lo, float hi) { unsigned r; asm volatile("v_cvt_pk_bf16_f32 %0, %1, %2" : "=v"(r) : "v"(lo), "v"(hi)); return r; }

template <int ACT> struct EpiStore {
    static constexpr bool PERM = true, AFTER_DRAIN = false;
    bf16_t* O; int ldc; int split_cols; size_t split_stride; int scale_tile; float scale0; bf16_t* halo; bf16_t* O2; int row_split;
    __device__ __forceinline__ void operator()(const f32x4 (&acc)[2][2][4][2], const Unit& u, int wr, int wc, int fr, int fq) const {
        const int row0 = u.pm * BM + wr * 64 + fr; int colt = u.pn * BM; PG8_GAS bf16_t* base = (PG8_GAS bf16_t*)O; PG8_GAS bf16_t* hal = (PG8_GAS bf16_t*)halo;
        int t = 0; if (split_cols) { t = colt / split_cols; base += (size_t)t * split_stride; colt -= t * split_cols; }
        if (O2 != nullptr && u.pm * BM >= row_split) base = (PG8_GAS bf16_t*)O2 - (size_t)row_split * ldc;
        const float sc = (t == scale_tile) ? scale0 : 1.f;
        const int col0 = colt + wc * 32 + 8 * fq;
#pragma unroll
        for (int ai = 0; ai < 2; ++ai)
#pragma unroll
            for (int m = 0; m < 4; ++m) { const int row = row0 + ai * HALF + m * 16; PG8_GAS bf16_t* rowp = base + (size_t)row * ldc + col0;
#pragma unroll
                for (int bj = 0; bj < 2; ++bj) { f32x4 v0 = acc[ai][bj][m][0], v1 = acc[ai][bj][m][1];
                    if (ACT == 1) {
#pragma unroll
                        for (int e = 0; e < 4; ++e) { const float a = fmaxf(v0[e], 0.f), b = fmaxf(v1[e], 0.f); v0[e] = a * a; v1[e] = b * b; } }
                    if (sc != 1.f) { v0 = v0 * sc; v1 = v1 * sc; }
                    u32x4 w; w.x = cvt_pk_bf16(v0[0], v0[1]); w.y = cvt_pk_bf16(v0[2], v0[3]); w.z = cvt_pk_bf16(v1[0], v1[1]); w.w = cvt_pk_bf16(v1[2], v1[3]);
#if PG8_STORE_SC1
                    if (O != nullptr) asm volatile("global_store_dwordx4 %0, %1, off sc1\n\ts_nop 1" :: "v"(rowp + bj * HALF), "v"(w) : "memory"); else asm volatile("" :: "v"(w));
#else
                    if (O != nullptr) { if (PG8_STORE_NT) __builtin_nontemporal_store(w, (PG8_GAS u32x4*)(rowp + bj * HALF)); else *(PG8_GAS u32x4*)(rowp + bj * HALF) = w; } else asm volatile("" :: "v"(w));
#endif
                    if (halo != nullptr && m == 3 && fr >= 13) { const int c = col0 + bj * HALF; if (c < 6144) *(PG8_GAS u32x4*)(hal + ((size_t)(row >> 6) * 3 + (fr - 13)) * 6144 + c) = w; }
                } }
    }
};
struct EpiLn {
    static constexpr bool PERM = false, AFTER_DRAIN = false;
    static constexpr float alpha = 1.6817928305074292f  , eps = 1e-5f;
    const bf16_t* xold; bf16_t* xnew; float* outf; const float* g; const float* b;
    unsigned long long* slots; unsigned* cnt; unsigned* tmo; int panel0;
    PG8_LAS unsigned char* scr;
    __device__ __forceinline__ void operator()(f32x4 (&acc)[2][2][4][2], const Unit& u, int wr, int wc, int fr, int fq) const {
        typedef float f32x2v __attribute__((ext_vector_type(2))); typedef unsigned u32x2v __attribute__((ext_vector_type(2)));
        const int tid = threadIdx.x, lane = tid & 63, wid = __builtin_amdgcn_readfirstlane(tid >> 6);
        PG8_LAS f32x2v* P = (PG8_LAS f32x2v*)scr;
        PG8_LAS f32x2v* S = (PG8_LAS f32x2v*)(scr + 8192);
        PG8_LAS unsigned* flag = (PG8_LAS unsigned*)(scr + 8192 + 2048);
        const int row0 = u.pm * BM + wr * 64 + fr, col0 = u.pn * BM + wc * 32 + 4 * fq;
        const PG8_GAS bf16_t* xo = (const PG8_GAS bf16_t*)xold;
#pragma unroll
        for (int ai = 0; ai < 2; ++ai) { u32x2v xv[4][2][2];
#pragma unroll
            for (int m = 0; m < 4; ++m) { const unsigned off = (unsigned)(row0 + ai * HALF + m * 16) * 2048u + (unsigned)col0;
#pragma unroll
                for (int bj = 0; bj < 2; ++bj)
#pragma unroll
                    for (int n = 0; n < 2; ++n) xv[m][bj][n] = *(const PG8_GAS u32x2v*)(xo + off + bj * HALF + n * 16); }
#pragma unroll
            for (int m = 0; m < 4; ++m)
#pragma unroll
                for (int bj = 0; bj < 2; ++bj)
#pragma unroll
                    for (int n = 0; n < 2; ++n) { const u32x2v w = xv[m][bj][n]; f32x4 x;
                        x[0] = __builtin_bit_cast(float, w.x << 16); x[1] = __builtin_bit_cast(float, w.x & 0xffff0000u); x[2] = __builtin_bit_cast(float, w.y << 16); x[3] = __builtin_bit_cast(float, w.y & 0xffff0000u);
                        acc[ai][bj][m][n] = x * alpha + acc[ai][bj][m][n]; }
            asm volatile("" ::: "memory"); }
#pragma unroll
        for (int ai = 0; ai < 2; ++ai)
#pragma unroll
            for (int m = 0; m < 4; ++m) {
                float s = 0.f;
#pragma unroll
                for (int bj = 0; bj < 2; ++bj)
#pragma unroll
                    for (int n = 0; n < 2; ++n) { const f32x4 x = acc[ai][bj][m][n]; s += (x[0] + x[1]) + (x[2] + x[3]); }
                s += __shfl_xor(s, 16); s += __shfl_xor(s, 32);
                const float mw = s * (1.0f / 64.0f); float q = 0.f;
#pragma unroll
                for (int bj = 0; bj < 2; ++bj)
#pragma unroll
                    for (int n = 0; n < 2; ++n) { const f32x4 d = acc[ai][bj][m][n] - mw; q += (d[0] * d[0] + d[1] * d[1]) + (d[2] * d[2] + d[3] * d[3]); }
                q += __shfl_xor(q, 16); q += __shfl_xor(q, 32);
                if (fq == 0) P[(ai * HALF + wr * 64 + m * 16 + fr) * 4 + wc] = (f32x2v){mw, q};
            }
        asm volatile("s_waitcnt lgkmcnt(0)" ::: "memory"); __builtin_amdgcn_s_barrier(); asm volatile("" ::: "memory");
        const int panel = panel0 + u.pm; const int row = wid * 32 + (lane & 31);
        if (lane < 32) {
            const f32x2v a = P[row * 4 + 0], bq = P[row * 4 + 1], c = P[row * 4 + 2], d = P[row * 4 + 3];
            const float mt = (a.x + bq.x + c.x + d.x) * 0.25f;
            const float da = a.x - mt, db = bq.x - mt, dc = c.x - mt, dd = d.x - mt;
            const float m2 = (a.y + bq.y) + (c.y + d.y) + 64.0f * ((da * da + db * db) + (dc * dc + dd * dd));
            unsigned long long* slot = slots + ((size_t)(panel * BM + row) * 8 + u.pn);
            __hip_atomic_store(slot, ((unsigned long long)__float_as_uint(m2) << 32) | __float_as_uint(mt), __ATOMIC_RELAXED, __HIP_MEMORY_SCOPE_AGENT);
        }
        asm volatile("s_waitcnt vmcnt(0)" ::: "memory");
        if (lane == 0) __hip_atomic_fetch_add(cnt + 64 * panel, 1u, __ATOMIC_RELAXED, __HIP_MEMORY_SCOPE_AGENT);
        if (wid == 0) {
            bool dead = false; const unsigned long long t0 = __builtin_amdgcn_s_memrealtime();
            for (;;) {
                if ((unsigned)__builtin_amdgcn_readfirstlane(__hip_atomic_load(cnt + 64 * panel, __ATOMIC_RELAXED, __HIP_MEMORY_SCOPE_AGENT)) >= 64u) break;
                if (__builtin_amdgcn_s_memrealtime() - t0 > 2000000ull) { if (lane == 0) __hip_atomic_store(tmo, 1u, __ATOMIC_RELAXED, __HIP_MEMORY_SCOPE_AGENT); dead = true; break; }
                __builtin_amdgcn_s_sleep(2);
            }
            __builtin_amdgcn_fence(__ATOMIC_ACQUIRE, "agent");
            if (lane == 0) flag[0] = dead ? 1u : 0u;
        }
        asm volatile("s_waitcnt vmcnt(0) lgkmcnt(0)" ::: "memory"); __builtin_amdgcn_s_barrier(); asm volatile("" ::: "memory");
        const bool bad = flag[0] != 0u;
        if (lane < 32) {
            const unsigned long long* slot = slots + (size_t)(panel * BM + row) * 8; float mt[8], m2[8]; float ms = 0.f;
#pragma unroll
            for (int t = 0; t < 8; ++t) { const unsigned long long w = __hip_atomic_load(slot + t, __ATOMIC_RELAXED, __HIP_MEMORY_SCOPE_AGENT); mt[t] = __uint_as_float((unsigned)w); m2[t] = __uint_as_float((unsigned)(w >> 32)); ms += mt[t]; }
            const float mean = ms * 0.125f; float q = 0.f;
#pragma unroll
            for (int t = 0; t < 8; ++t) { const float dm = mt[t] - mean; q += m2[t] + 256.0f * dm * dm; }
            S[row] = (f32x2v){mean, 1.0f / sqrtf(q * (1.0f / 2048.0f) + eps)};
        }
        asm volatile("s_waitcnt lgkmcnt(0)" ::: "memory"); __builtin_amdgcn_s_barrier(); asm volatile("" ::: "memory");
        const PG8_GAS float* gg = (const PG8_GAS float*)g; const PG8_GAS float* bg = (const PG8_GAS float*)b; const float qnan = __builtin_nanf("");
#pragma unroll
        for (int bj = 0; bj < 2; ++bj)
#pragma unroll
            for (int n = 0; n < 2; ++n) { const f32x4 gv = *(const PG8_GAS f32x4*)(gg + col0 + bj * HALF + n * 16), bv = *(const PG8_GAS f32x4*)(bg + col0 + bj * HALF + n * 16);
#pragma unroll
                for (int ai = 0; ai < 2; ++ai)
#pragma unroll
                    for (int m = 0; m < 4; ++m) { const int r = ai * HALF + wr * 64 + m * 16 + fr; const f32x2v sr = S[r]; const unsigned off = (unsigned)(u.pm * BM + r) * 2048u + (unsigned)(col0 + bj * HALF + n * 16);
                        f32x4 o = ((acc[ai][bj][m][n] - sr.x) * sr.y) * gv + bv; if (bad) o = (f32x4){qnan, qnan, qnan, qnan};
                        if (outf) *(PG8_GAS f32x4*)((PG8_GAS float*)outf + off) = o;
                        else { u32x2v w; w.x = cvt_pk_bf16(o[0], o[1]); w.y = cvt_pk_bf16(o[2], o[3]); *(PG8_GAS u32x2v*)((PG8_GAS bf16_t*)xnew + off) = w; } } }
        asm volatile("s_waitcnt lgkmcnt(0)" ::: "memory"); __builtin_amdgcn_s_barrier(); asm volatile("" ::: "memory");
    }
};

template <class Epi, class Sched, bool ALIGN_EPI = false, bool SP2 = false>
__device__ __forceinline__ void gemm_phase(PG8_LAS unsigned char* lds, const Gemm g, const Sched& S, const Epi& E) {
    int tid_ = threadIdx.x; asm volatile("" : "+v"(tid_));
    const int tid = tid_, wid = __builtin_amdgcn_readfirstlane(tid >> 6), lane = tid & 63, wr = wid >> 2, wc = wid & 3, fr = lane & 15, fq = lane >> 4;
    const int K = g.K, nt = K / BK, lda = g.lda;
    unsigned voffA[2], voffB[2];
#pragma unroll
    for (int i = 0; i < 2; ++i) { int R, C; stage_rc(tid * 16 + i * 8192, R, C); const int Rb = Epi::PERM ? ((R & ~31) + perm32(R & 31)) : R;
        voffA[i] = (unsigned)(R * lda + C) * 2u; voffB[i] = (unsigned)(Rb * K + C) * 2u; }
    const size_t kstep = (size_t)(BK * 2);
    const size_t hA = (size_t)HALF * lda * 2, hB = (size_t)HALF * K * 2;
    const size_t tA = 2 * hA, tB = 2 * hB;
    const unsigned ldsw = (unsigned)wid * 1024u;
    const int aoff = lds_byte(wr * 64 + fr, fq * 8), boff = lds_byte(wc * 32 + fr, fq * 8);
#define PG8_SA(b, h) (((b) * 2 + (h)) * HTB)
#define PG8_SB(b, h) ((4 + (b) * 2 + (h)) * HTB)
#define PG8_STAGE(bufoff, gbase, voff) do { _Pragma("unroll") for (int _i = 0; _i < 2; ++_i) \
        __builtin_amdgcn_global_load_lds((const unsigned*)((const char*)(gbase) + (voff)[_i]), (PG8_LAS unsigned*)(lds + (bufoff) + ldsw + _i * 8192), 16, 0, 0); } while (0)
#define PG8_LDA(dst, b, h) do { _Pragma("unroll") for (int m = 0; m < 4; ++m) _Pragma("unroll") for (int k = 0; k < 2; ++k) dst[m][k] = *(const PG8_LAS bf16x8*)(lds + PG8_SA(b, h) + aoff + m * 2048 + k * 1024); } while (0)
#define PG8_LDB(dst, b, h) do { _Pragma("unroll") for (int n = 0; n < 2; ++n) _Pragma("unroll") for (int k = 0; k < 2; ++k) dst[n][k] = *(const PG8_LAS bf16x8*)(lds + PG8_SB(b, h) + boff + n * 2048 + k * 1024); } while (0)
#define PG8_MMA(ai, bj, At, Bt) do { __builtin_amdgcn_s_setprio(1); _Pragma("unroll") for (int m = 0; m < 4; ++m) _Pragma("unroll") for (int n = 0; n < 2; ++n) _Pragma("unroll") for (int k = 0; k < 2; ++k) \
        acc[ai][bj][m][n] = __builtin_amdgcn_mfma_f32_16x16x32_bf16(Bt[n][k], At[m][k], acc[ai][bj][m][n], 0, 0, 0); __builtin_amdgcn_s_setprio(0); } while (0)
#define PG8_WAIT_V(n) asm volatile("s_waitcnt vmcnt(" #n ")" ::: "memory")
#define PG8_WAIT_L(n) asm volatile("s_waitcnt lgkmcnt(" #n ")" ::: "memory")
#define PG8_BAR __builtin_amdgcn_s_barrier()
#define PG8_SCHED __builtin_amdgcn_sched_barrier(0)
    Unit cur, nxt; int ui = 0;
    if (!S.next(0, cur)) return;
    f32x4 acc[2][2][4][2];
#pragma unroll
    for (int a = 0; a < 2; ++a)
#pragma unroll
        for (int b = 0; b < 2; ++b)
#pragma unroll
            for (int m = 0; m < 4; ++m)
#pragma unroll
                for (int n = 0; n < 2; ++n) acc[a][b][m][n] = (f32x4){0.f, 0.f, 0.f, 0.f};
    bf16x8 At[4][2], B0[2][2], B1[2][2];
#define PG8_AOF(pm_) ((g.A2 != nullptr && (pm_) >= g.msplit) ? (const char*)g.A2 + (size_t)((pm_) - g.msplit) * tA : (const char*)g.A + (size_t)(pm_) * tA)
    const char* cA = PG8_AOF(cur.pm); const char* cB = (const char*)g.Bt + (size_t)cur.pn * tB;
    S.a_ready(cur);
    if constexpr (SP2) {
        PG8_STAGE(PG8_SB(0, 0), cB, voffB); PG8_STAGE(PG8_SB(0, 1), cB + hB, voffB); PG8_STAGE(PG8_SA(0, 0), cA, voffA); PG8_STAGE(PG8_SA(0, 1), cA + hA, voffA);
        if (wr == 1) PG8_BAR;
        PG8_WAIT_V(2); PG8_BAR;
        PG8_STAGE(PG8_SB(1, 0), cB + kstep, voffB); PG8_STAGE(PG8_SA(1, 0), cA + kstep, voffA); PG8_STAGE(PG8_SB(1, 1), cB + hB + kstep, voffB);
        PG8_WAIT_V(6); PG8_BAR;
    } else {
        PG8_STAGE(PG8_SB(0, 0), cB, voffB); PG8_STAGE(PG8_SA(0, 0), cA, voffA); PG8_STAGE(PG8_SB(0, 1), cB + hB, voffB); PG8_STAGE(PG8_SA(0, 1), cA + hA, voffA);
        if (wr == 1) PG8_BAR;
        PG8_WAIT_V(4); PG8_BAR;
        PG8_STAGE(PG8_SB(1, 0), cB + kstep, voffB); PG8_STAGE(PG8_SA(1, 0), cA + kstep, voffA); PG8_STAGE(PG8_SB(1, 1), cB + hB + kstep, voffB);
        PG8_WAIT_V(6); PG8_BAR;
    }
    for (;;) {
        const bool has_next = S.next(ui + 1, nxt);
        const char* nA = has_next ? PG8_AOF(nxt.pm) : cA; const char* nB = has_next ? (const char*)g.Bt + (size_t)nxt.pn * tB : cB;
        for (int t = 0; t < nt; t += 2) {
            const bool last = (t == nt - 2);
            const char* a1 = cA + (size_t)(t + 1) * kstep;
            const char* a2 = last ? nA : cA + (size_t)(t + 2) * kstep; const char* b2 = last ? nB : cB + (size_t)(t + 2) * kstep;
            const char* a3 = a2 + kstep; const char* b3 = b2 + kstep;
            if (last && has_next) S.a_ready(nxt);
            if constexpr (SP2) {
            PG8_LDB(B0, 0, 0); PG8_LDB(B1, 0, 1); PG8_SCHED; PG8_LDA(At, 0, 0); PG8_STAGE(PG8_SA(1, 1), a1 + hA, voffA);
            PG8_WAIT_V(8); PG8_WAIT_L(0); PG8_BAR; PG8_MMA(0, 0, At, B0); PG8_MMA(0, 1, At, B1); PG8_BAR; PG8_SCHED;
            PG8_LDA(At, 0, 1); PG8_STAGE(PG8_SB(0, 0), b2, voffB); PG8_STAGE(PG8_SB(0, 1), b2 + hB, voffB); PG8_STAGE(PG8_SA(0, 0), a2, voffA);
            PG8_WAIT_V(8); PG8_WAIT_L(0); PG8_BAR; PG8_MMA(1, 0, At, B0); PG8_MMA(1, 1, At, B1); PG8_BAR; PG8_SCHED;
            PG8_LDB(B0, 1, 0); PG8_LDB(B1, 1, 1); PG8_SCHED; PG8_LDA(At, 1, 0); PG8_STAGE(PG8_SA(0, 1), a2 + hA, voffA);
            PG8_WAIT_V(8); PG8_WAIT_L(0); PG8_BAR; PG8_MMA(0, 0, At, B0); PG8_MMA(0, 1, At, B1); PG8_BAR; PG8_SCHED;
            PG8_LDA(At, 1, 1); PG8_STAGE(PG8_SB(1, 0), b3, voffB); PG8_STAGE(PG8_SB(1, 1), b3 + hB, voffB); PG8_STAGE(PG8_SA(1, 0), a3, voffA);
            PG8_WAIT_V(8); PG8_WAIT_L(0); PG8_BAR; PG8_MMA(1, 0, At, B0); PG8_MMA(1, 1, At, B1); PG8_BAR; PG8_SCHED;
            } else {
            PG8_LDB(B0, 0, 0); PG8_SCHED; PG8_LDA(At, 0, 0); PG8_STAGE(PG8_SA(1, 1), a1 + hA, voffA);
            PG8_WAIT_L(8); PG8_BAR; PG8_WAIT_L(0); PG8_MMA(0, 0, At, B0); PG8_BAR; PG8_SCHED;
            PG8_LDB(B1, 0, 1); PG8_STAGE(PG8_SB(0, 0), b2, voffB);
            PG8_BAR; PG8_WAIT_L(0); PG8_MMA(0, 1, At, B1); PG8_BAR;
            PG8_LDA(At, 0, 1); PG8_STAGE(PG8_SA(0, 0), a2, voffA);
            PG8_BAR; PG8_WAIT_L(0); PG8_MMA(1, 0, At, B0); PG8_BAR; PG8_SCHED;
            PG8_STAGE(PG8_SB(0, 1), b2 + hB, voffB);
            PG8_WAIT_V(6); PG8_BAR; PG8_MMA(1, 1, At, B1); PG8_BAR;
            PG8_LDB(B0, 1, 0); PG8_SCHED; PG8_LDA(At, 1, 0); PG8_STAGE(PG8_SA(0, 1), a2 + hA, voffA);
            PG8_WAIT_L(8); PG8_BAR; PG8_WAIT_L(0); PG8_MMA(0, 0, At, B0); PG8_BAR; PG8_SCHED;
            PG8_LDB(B1, 1, 1); PG8_STAGE(PG8_SB(1, 0), b3, voffB);
            PG8_BAR; PG8_WAIT_L(0); PG8_MMA(0, 1, At, B1); PG8_BAR;
            PG8_LDA(At, 1, 1); PG8_STAGE(PG8_SA(1, 0), a3, voffA);
            PG8_BAR; PG8_WAIT_L(0); PG8_MMA(1, 0, At, B0); PG8_BAR; PG8_SCHED;
            PG8_STAGE(PG8_SB(1, 1), b3 + hB, voffB);
            PG8_WAIT_V(6); PG8_BAR; PG8_MMA(1, 1, At, B1); PG8_BAR;
            }
        }
        if constexpr (ALIGN_EPI) { if (wr == 0) PG8_BAR; }
        if constexpr (!Epi::AFTER_DRAIN) { E(acc, cur, wr, wc, fr, fq); S.done(cur); }
        if (!has_next) break;
#pragma unroll
        for (int a = 0; a < 2; ++a)
#pragma unroll
            for (int b = 0; b < 2; ++b)
#pragma unroll
                for (int m = 0; m < 4; ++m)
#pragma unroll
                    for (int n = 0; n < 2; ++n) acc[a][b][m][n] = (f32x4){0.f, 0.f, 0.f, 0.f};
        cur = nxt; cA = nA; cB = nB; ++ui;
        if constexpr (ALIGN_EPI) { if (wr == 1) PG8_BAR; }
    }
    PG8_WAIT_V(0);
    if constexpr (!ALIGN_EPI) { if (wr == 0) PG8_BAR; }
    PG8_BAR;
#undef PG8_AOF
#undef PG8_SA
#undef PG8_SB
#undef PG8_STAGE
#undef PG8_LDA
#undef PG8_LDB
#undef PG8_MMA
#undef PG8_WAIT_V
#undef PG8_WAIT_L
#undef PG8_BAR
#undef PG8_SCHED
}
}
#ifndef ATTN_SHARE8
#define ATTN_SHARE8 1
#endif
#ifndef ATTN_PRIO
#define ATTN_PRIO 0
#endif
namespace dattn {
using bf16=__hip_bfloat16;
using bf16x8=__attribute__((ext_vector_type(8)))short;
using s16x4=__attribute__((ext_vector_type(4)))short;
using f32x16=__attribute__((ext_vector_type(16)))float;
using u32x4=__attribute__((ext_vector_type(4)))unsigned;
constexpr int SEQ=4096,DM=2048,HDV=128;
constexpr int NW=8,QBLK=32,QB=128,KVBLK=64,NQB=SEQ/QB;
__device__ __forceinline__ int crow(int r,int hi){return (r&3)+8*(r>>2)+4*hi;}
#define SBAR() __builtin_amdgcn_sched_barrier(0)
__device__ __forceinline__ void cmask(f32x16&p0,f32x16&p1,int jb,int qrel,int hi){
  const float NEG=-INFINITY; int kb=64*jb+4*hi;
  #pragma unroll
  for(int r=0;r<16;++r){int kv=kb+(r&3)+8*(r>>2); if(kv>qrel)p0[r]=NEG; if(kv+32>qrel)p1[r]=NEG;}
}
constexpr float C2=0.125f*1.4426950408889634f;
constexpr int NSLOT=3, SLOTB=16384;
constexpr int LDS_K=0, LDS_V=NSLOT*SLOTB, LDS_WS=2*NSLOT*SLOTB, LDS_KX=LDS_WS+NW*64*4, LDS_SW=LDS_KX+SLOTB, LDS_QX=LDS_SW+512, LDS_BYTES=LDS_QX+NW*4096;
__device__ __forceinline__ void glds16(const void*gsrc,unsigned lds_dst){unsigned keep;
  asm volatile("s_mov_b32 %0, m0\n\ts_mov_b32 m0, %2\n\ts_nop 0\n\tglobal_load_lds_dwordx4 %1, off\n\ts_mov_b32 m0, %0":"=&s"(keep):"v"(gsrc),"s"(lds_dst):"memory");}
__device__ __forceinline__ void gld16(bf16x8&d,const void*g){ asm volatile("global_load_dwordx4 %0, %1, off":"=v"(d):"v"(g):"memory"); }
__device__ __forceinline__ float max3f(float a,float b,float c){float r;asm("v_max3_f32 %0, %1, %2, %3":"=v"(r):"v"(a),"v"(b),"v"(c));return r;}
__device__ __forceinline__ float max2f(float a,float b){float r;asm("v_max_f32_e32 %0, %1, %2":"=v"(r):"v"(a),"v"(b));return r;}
__device__ __forceinline__ float fadd_s(float a,float b){float r;asm("v_add_f32_e32 %0, %1, %2":"=v"(r):"v"(a),"v"(b));return r;}
__device__ __forceinline__ float fsub_s(float a,float b){float r;asm("v_sub_f32_e32 %0, %1, %2":"=v"(r):"v"(a),"v"(b));return r;}
typedef float f32x2_t __attribute__((ext_vector_type(2))); typedef __bf16 bf16x2_t __attribute__((ext_vector_type(2)));
__device__ __forceinline__ unsigned cvtpk_s(float lo,float hi){f32x2_t v={lo,hi};bf16x2_t b=__builtin_convertvector(v,bf16x2_t);return __builtin_bit_cast(unsigned,b);}
#define WAIT_BAR(N) asm volatile("s_waitcnt vmcnt(" #N ") lgkmcnt(0)\n\ts_barrier":::"memory")
typedef __attribute__((address_space(3))) const char* lds_cptr;
typedef short v4i16_t __attribute__((ext_vector_type(4)));
__device__ __forceinline__ void qkt(f32x16&p0,f32x16&p1,const char*kb,const bf16x8*qr){ const f32x16 negm=f32x16{};
  #pragma unroll
  for(int d0=0;d0<4;++d0){
    const bf16x8 b0=*reinterpret_cast<const bf16x8*>(kb+d0*2048);
    const bf16x8 b1=*reinterpret_cast<const bf16x8*>(kb+d0*2048+512);
    if(d0==0){p0=__builtin_amdgcn_mfma_f32_32x32x16_bf16(b0,qr[0],negm,0,0,0);p1=__builtin_amdgcn_mfma_f32_32x32x16_bf16(b1,qr[0],negm,0,0,0);}
    else{p0=__builtin_amdgcn_mfma_f32_32x32x16_bf16(b0,qr[d0],p0,0,0,0);p1=__builtin_amdgcn_mfma_f32_32x32x16_bf16(b1,qr[d0],p1,0,0,0);}}
}
__device__ __forceinline__ void kload8(bf16x8*kf,lds_cptr kp){
  kf[0]=*(const __attribute__((address_space(3))) bf16x8*)(kp);      kf[1]=*(const __attribute__((address_space(3))) bf16x8*)(kp+512);
  kf[2]=*(const __attribute__((address_space(3))) bf16x8*)(kp+2048); kf[3]=*(const __attribute__((address_space(3))) bf16x8*)(kp+2560);
  kf[4]=*(const __attribute__((address_space(3))) bf16x8*)(kp+4096); kf[5]=*(const __attribute__((address_space(3))) bf16x8*)(kp+4608);
  kf[6]=*(const __attribute__((address_space(3))) bf16x8*)(kp+6144); kf[7]=*(const __attribute__((address_space(3))) bf16x8*)(kp+6656);
}
__device__ __forceinline__ void kload2(bf16x8*kf,lds_cptr kp,int j){ kf[2*j]=*(const __attribute__((address_space(3))) bf16x8*)(kp+j*2048); kf[2*j+1]=*(const __attribute__((address_space(3))) bf16x8*)(kp+j*2048+512); }
__device__ __forceinline__ s16x4 vtr(lds_cptr p){ return __builtin_bit_cast(s16x4,__builtin_amdgcn_ds_read_tr16_b64_v4i16((__attribute__((address_space(3))) v4i16_t*)p)); }
__device__ __forceinline__ float rowmax(const f32x16&p0,const f32x16&p1){
  float a=max3f(p0[0],p0[1],p1[0]),b=max3f(p0[2],p0[3],p1[1]);a=max3f(a,p1[2],p1[3]);
  #pragma unroll
  for(int r=4;r<16;r+=4){a=max3f(a,p0[r],p0[r+1]);b=max3f(b,p0[r+2],p0[r+3]);a=max3f(a,p1[r],p1[r+1]);b=max3f(b,p1[r+2],p1[r+3]);}
  const float m=max2f(a,b);
  auto rr=__builtin_amdgcn_permlane32_swap(__float_as_uint(m),__float_as_uint(m),false,false);
  return max2f(__uint_as_float(rr[0]),__uint_as_float(rr[1]));
}
__device__ __forceinline__ void pv(f32x16*o,int vb,bf16x8 pa0,bf16x8 pa1,bf16x8 pa2,bf16x8 pa3){
  #pragma unroll
  for(int d0=0;d0<4;++d0){s16x4 lo[4],hi[4];
    #pragma unroll
    for(int ks=0;ks<4;++ks){
      asm volatile("ds_read_b64_tr_b16 %0,%1 offset:%c2":"=&v"(lo[ks]):"v"(vb),"i"(d0*4096+ks*1024):"memory");
      asm volatile("ds_read_b64_tr_b16 %0,%1 offset:%c2":"=&v"(hi[ks]):"v"(vb),"i"(d0*4096+ks*1024+512):"memory");}
    asm volatile("s_waitcnt lgkmcnt(0)":::"memory");SBAR();
    #define PK(k) (bf16x8){lo[k][0],lo[k][1],lo[k][2],lo[k][3],hi[k][0],hi[k][1],hi[k][2],hi[k][3]}
    o[d0]=__builtin_amdgcn_mfma_f32_32x32x16_bf16(pa0,PK(0),o[d0],0,0,0);
    o[d0]=__builtin_amdgcn_mfma_f32_32x32x16_bf16(pa1,PK(1),o[d0],0,0,0);
    o[d0]=__builtin_amdgcn_mfma_f32_32x32x16_bf16(pa2,PK(2),o[d0],0,0,0);
    o[d0]=__builtin_amdgcn_mfma_f32_32x32x16_bf16(pa3,PK(3),o[d0],0,0,0);
    #undef PK
  }
}

struct Params { const bf16* Q; const bf16* K; const bf16* V; bf16* O; const float* subln_w; float lam, post; };
template<int THRL> __device__ __forceinline__ void unit(int b,int h,int qb,const Params&P,char*shm,const bool pre,const bool has_next,const int nb,const int nh,const int nqb){
  int tid_=threadIdx.x; asm volatile("":"+v"(tid_));
  const int tid=tid_,lane=tid&63,r32=lane&31,hi=lane>>5; const int wid=__builtin_amdgcn_readfirstlane(tid>>6);
  const int cmp=wid&1,rbk=wid>>1;
  if(ATTN_PRIO&&wid>=4)__builtin_amdgcn_s_setprio(1);
  const long rowbase=(long)b*SEQ; const int q0=qb*QB;
  const bf16*Qw=P.Q+(rowbase+q0+rbk*QBLK)*DM+h*HDV+cmp*64;
  const bf16*Kh=P.K+rowbase*DM+h*HDV,*Vh=P.V+rowbase*DM+h*HDV;
  const unsigned lds0=(unsigned)(uintptr_t)shm;
  float*wsf=(float*)(shm+LDS_WS)+wid*64;
  const bf16*ksrc=Kh+(long)lane*DM+wid*8;
  const bf16*vsrc=Vh+(long)(16*(wid&3)+(lane>>2))*DM+(wid>>2)*32+(lane&3)*8;
  const unsigned kdst=lds0+LDS_K+wid*1024, vdst=lds0+LDS_V+wid*1024;
  #define DMA_K(t,slot) do{ glds16(ksrc+(long)(t)*KVBLK*DM,(unsigned)__builtin_amdgcn_readfirstlane(kdst+(slot))); glds16(ksrc+(long)(t)*KVBLK*DM+64,(unsigned)__builtin_amdgcn_readfirstlane(kdst+(slot)+8192)); }while(0)
  #define DMA_V(t,slot) do{ glds16(vsrc+(long)(t)*KVBLK*DM,(unsigned)__builtin_amdgcn_readfirstlane(vdst+(slot))); glds16(vsrc+(long)(t)*KVBLK*DM+64,(unsigned)__builtin_amdgcn_readfirstlane(vdst+(slot)+8192)); }while(0)
  const int vb0=(int)(lds0+LDS_V)+((lane>>4)&1)*32+(lane&3)*8+(4*hi+((lane&15)>>2))*64;
  bf16x8 kf[8];
  const lds_cptr shm3=(lds_cptr)shm; const lds_cptr kp0=shm3+LDS_K+(cmp*8+hi)*1024+r32*16; const lds_cptr vp0=shm3+LDS_V+((lane>>4)&1)*32+(lane&3)*8+(4*hi+((lane&15)>>2))*64;
  const char*Kbase=shm+LDS_KX+(cmp*8+hi)*1024+r32*16;
  const unsigned kxdst=lds0+LDS_KX+wid*1024;
  #define DMA_KX(src) do{ glds16((src),(unsigned)__builtin_amdgcn_readfirstlane(kxdst)); glds16((src)+64,(unsigned)__builtin_amdgcn_readfirstlane(kxdst+8192)); }while(0)
  const int NT=(q0+QB)/KVBLK;
  if(!pre){DMA_KX(ksrc);} DMA_V(0,0);DMA_K(1,SLOTB);
  const unsigned qxdst=lds0+LDS_QX+wid*4096;
  #define DMA_Q(Qp) do{ _Pragma("unroll") for(int d0=0;d0<4;++d0)glds16(&(Qp)[(long)r32*DM+d0*16+hi*8],(unsigned)__builtin_amdgcn_readfirstlane(qxdst+d0*1024)); }while(0)
  if(!pre){DMA_Q(Qw);}
  float mhat=0.f,l_reg=0.f;f32x16 o[4];o[0]=f32x16{};o[1]=f32x16{};o[2]=f32x16{};o[3]=f32x16{};const f32x16 zero16=f32x16{};
  const int qrel=rbk*QBLK+r32;
  #define CMASK(P0,P1,t) do{int jb_=(t)-(NT-2); if(jb_>=0)cmask(P0,P1,jb_,qrel,hi);}while(0)
  bool resc=false;
  #define START(P0,P1) do{ const float rm=rowmax(P0,P1); resc=false; \
    { const float dl=rm; mhat=fadd_s(mhat,dl); \
      _Pragma("unroll") for(int r=0;r<16;++r){P0[r]=fsub_s(P0[r],dl);P1[r]=fsub_s(P1[r],dl);} } \
    _Pragma("unroll") for(int r=0;r<16;++r)P0[r]=__builtin_amdgcn_exp2f(P0[r]); }while(0)
  #define RESC() do{ if(resc){ asm volatile("s_waitcnt lgkmcnt(0)":::"memory"); \
      _Pragma("unroll") for(int d_=0;d_<4;++d_) _Pragma("unroll") for(int r=0;r<16;++r)o[d_][r]*=wsf[crow(r,hi)]; } }while(0)
  f32x16 pA0,pA1,pB0,pB1;
  int sl_prev=0,sl_cur=0,sl_next=SLOTB;
  #define ROT() do{sl_prev=sl_cur;sl_cur=sl_next;sl_next=(sl_next==(NSLOT-1)*SLOTB)?0:sl_next+SLOTB;}while(0)
  DMA_K(2,2*SLOTB);
  if(pre){WAIT_BAR(6);}
  else   {WAIT_BAR(2);}
  bf16x8 qr[4];
  #pragma unroll
  for(int d0=0;d0<4;++d0)qr[d0]=*(const __attribute__((address_space(3))) bf16x8*)(shm3+LDS_QX+wid*4096+d0*1024+lane*16);
  SBAR();
  qkt(pA0,pA1,Kbase,qr);asm volatile("s_nop 15\n\ts_nop 7":"+v"(pA0),"+v"(pA1));CMASK(pA0,pA1,0);
  START(pA0,pA1);
  _Pragma("unroll") for(int r=0;r<16;++r)pA1[r]=__builtin_amdgcn_exp2f(pA1[r]);
  WAIT_BAR(0);
  DMA_K(3,0);DMA_V(1,SLOTB);
  ROT();
  kload8(kf,kp0+sl_cur);
  if(NT>2){WAIT_BAR(4);}else{WAIT_BAR(0);}
  s16x4 vlo[4],vhi[4]; u32x4 pw0,pw1,pw2,pw3;
  #define PKW(P,B) cvtpk_s(P[B],P[B+1])
  #define PAF(k) __builtin_bit_cast(bf16x8,pw##k)
  #define VFR(i) (bf16x8){vlo[i][0],vlo[i][1],vlo[i][2],vlo[i][3],vhi[i][0],vhi[i][1],vhi[i][2],vhi[i][3]}
  #define PIN(x) asm volatile("":"+v"(x))
  #define MX3(a,b,c) __builtin_fmaxf(__builtin_fmaxf((a),(b)),(c))
  #define GAPA(MF,A0,A1,A2,A3,W0,W1,PW) do{ MF; sacc+=A0; sacc+=A1; sacc+=A2; sacc+=A3; PIN(sacc); W0; W1; PIN(PW); SBAR(); }while(0)
  #define EX(v) __builtin_amdgcn_exp2f((v)-mhat)
  #define VOFF(f) ((((f)&3)*4096)+(((f)>>2)*1024))
  #define VRD(i,f) do{ vlo[i]=vtr(vp_+VOFF(f)); vhi[i]=vtr(vp_+VOFF(f)+512); }while(0)
  #define GAPB(MF,X,B) do{ MF; X[B]=EX(X[B]); X[B+1]=EX(X[B+1]); PIN(X); SBAR(); }while(0)
  #define GAPBV(MF,X,B,i,f) do{ MF; X[B]=EX(X[B]); X[B+1]=EX(X[B+1]); PIN(X); VRD(i,f); SBAR(); }while(0)
  #define KRD(G,j) do{ if(G){ kload2(kf,kp0+sl_next,j); SBAR(); } }while(0)
  #define PVM(d,k,i) o[d]=__builtin_amdgcn_mfma_f32_32x32x16_bf16(PAF(k),VFR(i),o[d],0,0,0)
  #define STEP(C0,C1,P0,P1,t,GK,GV,GL) do{ SBAR(); \
    const lds_cptr vp_=vp0+sl_prev; \
    float sacc=(P0[0]+P0[1]); \
    GAPA(C0=__builtin_amdgcn_mfma_f32_32x32x16_bf16(kf[0],qr[0],zero16,0,0,0), P0[2],P0[3],P0[4],P0[5],     pw0[0]=PKW(P0,0), pw0[1]=PKW(P0,2), pw0); \
    GAPA(C1=__builtin_amdgcn_mfma_f32_32x32x16_bf16(kf[1],qr[0],zero16,0,0,0), P0[6],P0[7],P0[8],P0[9],     pw0[2]=PKW(P0,4), pw0[3]=PKW(P0,6), pw0); \
    GAPA(C0=__builtin_amdgcn_mfma_f32_32x32x16_bf16(kf[2],qr[1],C0,0,0,0),   P0[10],P0[11],P0[12],P0[13], pw1[0]=PKW(P0,8), pw1[1]=PKW(P0,10), pw1); \
    GAPA(C1=__builtin_amdgcn_mfma_f32_32x32x16_bf16(kf[3],qr[1],C1,0,0,0),   P0[14],P0[15],P1[0],P1[1],   pw1[2]=PKW(P0,12),pw1[3]=PKW(P0,14), pw1); \
    VRD(0,0); SBAR(); GAPA(C0=__builtin_amdgcn_mfma_f32_32x32x16_bf16(kf[4],qr[2],C0,0,0,0),   P1[2],P1[3],P1[4],P1[5],     pw2[0]=PKW(P1,0), pw2[1]=PKW(P1,2), pw2); \
    VRD(1,1); SBAR(); GAPA(C1=__builtin_amdgcn_mfma_f32_32x32x16_bf16(kf[5],qr[2],C1,0,0,0),   P1[6],P1[7],P1[8],P1[9],     pw2[2]=PKW(P1,4), pw2[3]=PKW(P1,6), pw2); \
    VRD(2,2); SBAR(); GAPA(C0=__builtin_amdgcn_mfma_f32_32x32x16_bf16(kf[6],qr[3],C0,0,0,0),   P1[10],P1[11],P1[12],P1[13], pw3[0]=PKW(P1,8), pw3[1]=PKW(P1,10), pw3); \
    VRD(3,3); SBAR(); GAPA(C1=__builtin_amdgcn_mfma_f32_32x32x16_bf16(kf[7],qr[3],C1,0,0,0),   P1[14],P1[15],0.f,0.f,       pw3[2]=PKW(P1,12),pw3[3]=PKW(P1,14), pw3); \
    l_reg+=sacc; \
    if(GK){DMA_K((t)+3,sl_cur);} if(GV){DMA_V((t)+1,sl_next);} \
    CMASK(C0,C1,t); \
    { float a=MX3(C0[0],C0[1],C1[0]),b=MX3(C0[2],C0[3],C1[1]); a=MX3(a,C1[2],C1[3]); \
      _Pragma("unroll") for(int r=4;r<16;r+=4){a=MX3(a,C0[r],C0[r+1]);b=MX3(b,C0[r+2],C0[r+3]);a=MX3(a,C1[r],C1[r+1]);b=MX3(b,C1[r+2],C1[r+3]);} \
      float rm=__builtin_fmaxf(a,b); { auto rr=__builtin_amdgcn_permlane32_swap(__float_as_uint(rm),__float_as_uint(rm),false,false); rm=__builtin_fmaxf(__uint_as_float(rr[0]),__uint_as_float(rr[1])); } \
      rm-=mhat; resc=false; \
      if(__builtin_expect(__any(rm>(float)THRL),0)){ const float dl=__builtin_fmaxf(rm,0.f); mhat+=dl; \
        const float f=__builtin_amdgcn_exp2f(-dl); l_reg*=f; if(hi==0)wsf[r32]=f; resc=true; } } \
    SBAR(); \
    GAPBV(PVM(0,0,0),C0,0, 0,4);  GAPBV(PVM(1,0,1),C0,2, 1,5);  GAPBV(PVM(2,0,2),C0,4, 2,6);  GAPBV(PVM(3,0,3),C0,6, 3,7); \
    GAPBV(PVM(0,1,0),C0,8, 0,8);  GAPBV(PVM(1,1,1),C0,10,1,9);  GAPBV(PVM(2,1,2),C0,12,2,10); GAPBV(PVM(3,1,3),C0,14,3,11); \
    KRD(GL,0); GAPBV(PVM(0,2,0),C1,0, 0,12); KRD(GL,1); GAPBV(PVM(1,2,1),C1,2, 1,13); KRD(GL,2); GAPBV(PVM(2,2,2),C1,4, 2,14); KRD(GL,3); GAPBV(PVM(3,2,3),C1,6, 3,15); \
    GAPB(PVM(0,3,0),C1,8); GAPB(PVM(1,3,1),C1,10); GAPB(PVM(2,3,2),C1,12); GAPB(PVM(3,3,3),C1,14); \
    }while(0)
  int t=1;
  #undef CMASK
  #define CMASK(P0,P1,t) do{}while(0)
  for(;t+3<NT;t+=2){
    STEP(pB0,pB1,pA0,pA1,t,true,true,true);     WAIT_BAR(4); RESC(); ROT();
    STEP(pA0,pA1,pB0,pB1,t+1,true,true,true);   WAIT_BAR(4); RESC(); ROT();
  }
  #undef CMASK
  #define CMASK(P0,P1,t) do{int jb_=(t)-(NT-2); if(jb_>=0)cmask(P0,P1,jb_,qrel,hi);}while(0)
  #define ENDW(tt) do{ if((tt)+3<NT){WAIT_BAR(4);} else if((tt)+2<NT){WAIT_BAR(2);} else {WAIT_BAR(0);} }while(0)
  for(;t+1<NT;t+=2){
    STEP(pB0,pB1,pA0,pA1,t,(t+3<NT),(t+1<NT),(t+1<NT));       ENDW(t);   RESC(); ROT();
    STEP(pA0,pA1,pB0,pB1,t+1,(t+4<NT),(t+2<NT),(t+2<NT));     ENDW(t+1); RESC(); ROT();
  }
  STEP(pB0,pB1,pA0,pA1,NT-1,false,false,false); RESC();
  typedef float f32x4_t __attribute__((ext_vector_type(4)));
  const f32x4_t wa=*(const __attribute__((address_space(3))) f32x4_t*)(shm3+LDS_SW+(lane&15)*32), wb=*(const __attribute__((address_space(3))) f32x4_t*)(shm3+LDS_SW+(lane&15)*32+16);
  if(has_next){ const long rbn=(long)nb*SEQ; const bf16*ksn=P.K+rbn*DM+nh*HDV+(long)lane*DM+wid*8; DMA_KX(ksn);
    const bf16*Qn=P.Q+(rbn+nqb*QB+rbk*QBLK)*DM+nh*HDV+cmp*64;
    DMA_Q(Qn); }
  { float sacc=pB0[0]+pB0[1]; _Pragma("unroll") for(int r=2;r<16;++r)sacc+=pB0[r]; _Pragma("unroll") for(int r=0;r<16;++r)sacc+=pB1[r]; l_reg+=sacc;
    pw0=(u32x4){PKW(pB0,0),PKW(pB0,2),PKW(pB0,4),PKW(pB0,6)};pw1=(u32x4){PKW(pB0,8),PKW(pB0,10),PKW(pB0,12),PKW(pB0,14)};pw2=(u32x4){PKW(pB1,0),PKW(pB1,2),PKW(pB1,4),PKW(pB1,6)};pw3=(u32x4){PKW(pB1,8),PKW(pB1,10),PKW(pB1,12),PKW(pB1,14)};
    SBAR(); pv(o,vb0+sl_cur,PAF(0),PAF(1),PAF(2),PAF(3)); }
  #undef PKW
  #undef PAF
  #undef VFR
  #undef PIN
  #undef MX3
  #undef GAPA
  #undef GAPB
  #undef GAPBV
  #undef EX
  #undef VOFF
  #undef VRD
  #undef KRD
  #undef PVM
  #undef STEP
  #undef ENDW
  {auto rr=__builtin_amdgcn_permlane32_swap(__float_as_uint(l_reg),__float_as_uint(l_reg),false,false);l_reg=__uint_as_float(rr[0])+__uint_as_float(rr[1]);}
  if(hi==0)wsf[32+r32]=l_reg;asm volatile("s_waitcnt lgkmcnt(0)":::"memory");
  float rli[16];
  #pragma unroll
  for(int r=0;r<16;++r)rli[r]=__builtin_amdgcn_rcpf(wsf[32+crow(r,hi)]);
  asm volatile("s_waitcnt lgkmcnt(0)\n\ts_barrier":::"memory");
  { bf16*stg=(bf16*)(shm)+wid*4096;
    #pragma unroll
    for(int r=0;r<16;++r){const int orow=crow(r,hi);
      #pragma unroll
      for(int d0=0;d0<4;++d0)stg[orow*128+d0*32+r32]=__float2bfloat16(o[d0][r]*rli[r]);} }
  asm volatile("s_waitcnt lgkmcnt(0)\n\ts_barrier":::"memory");
  { const bf16*s0=(const bf16*)(shm)+(wid&~1)*4096; const bf16*s1=s0+4096;
    bf16*Ow=P.O+(rowbase+q0+rbk*QBLK)*DM+h*HDV; const int ch=lane&15;
    #pragma unroll
    for(int i=0;i<4;++i){ const int row=16*cmp+4*i+(lane>>4);
      const u32x4 a=*(const u32x4*)(s0+row*128+ch*8), bq=*(const u32x4*)(s1+row*128+ch*8);
      float d[8];
      #pragma unroll
      for(int k=0;k<4;++k){ const unsigned ua=a[k],ub=bq[k];
        d[2*k]=__uint_as_float(ua<<16)-P.lam*__uint_as_float(ub<<16); d[2*k+1]=__uint_as_float(ua&0xffff0000u)-P.lam*__uint_as_float(ub&0xffff0000u); }
      float s=0.f;
      #pragma unroll
      for(int k=0;k<8;++k)s+=d[k]*d[k];
      s+=__shfl_xor(s,1);s+=__shfl_xor(s,2);s+=__shfl_xor(s,4);s+=__shfl_xor(s,8);
      const float rs=P.post*__builtin_amdgcn_rsqf(s*(1.f/128.f)+1e-5f);
      u32x4 w; w[0]=cvtpk_s(d[0]*rs*wa[0],d[1]*rs*wa[1]); w[1]=cvtpk_s(d[2]*rs*wa[2],d[3]*rs*wa[3]); w[2]=cvtpk_s(d[4]*rs*wb[0],d[5]*rs*wb[1]); w[3]=cvtpk_s(d[6]*rs*wb[2],d[7]*rs*wb[3]);
      *(__attribute__((address_space(1))) u32x4*)(Ow+(long)row*DM+ch*8)=w; } }
  asm volatile("s_waitcnt lgkmcnt(0)\n\ts_barrier":::"memory");
  if(ATTN_PRIO&&wid>=4)__builtin_amdgcn_s_setprio(0);
  #undef DMA_K
  #undef DMA_KX
  #undef DMA_Q
  #undef DMA_V
  #undef CMASK
  #undef START
  #undef RESC
  #undef ROT
}
constexpr int ATTN_LDS_BYTES=LDS_BYTES;
template<int THRL=8> __device__ __forceinline__ void phase(char*lds,const Params&P,int grid,int block){
  const int vcu=(grid%8==0)?(block%8)*(grid/8)+block/8:block;
#if ATTN_SHARE8 == 1
  if(threadIdx.x<128)((float*)(lds+LDS_SW))[threadIdx.x]=P.subln_w[threadIdx.x];
  __syncthreads();
  for(int v=vcu;v<256;v+=grid){ const int grp=v>>3,k=v&7;
    for(int idx=0;idx<16;++idx){ const int bh=grp*4+(idx>>2),i=idx&3; const int qb=(i==0)?31-k:(i==1)?k:(i==2)?16+k:15-k;
      const int nx=idx+1,bhn=grp*4+((nx>>2)&3),in_=nx&3; const int qbn=(in_==0)?31-k:(in_==1)?k:(in_==2)?16+k:15-k;
      unit<THRL>(bh>>4,bh&15,qb,P,lds,idx>0,nx<16,bhn>>4,bhn&15,qbn); } }
#elif ATTN_SHARE8 == 2
  for(int v=vcu;v<256;v+=grid){ const int grp=v>>5,k=v&31;
    for(int w=0;w<16;++w){ const int bh=grp*16+w; const int qb=(w&1)?31-k:k; unit<THRL>(bh>>4,bh&15,qb,P,lds); } }
#elif ATTN_SHARE8 == 3
  for(int v=vcu;v<256;v+=grid){ const int grp=v>>4,k=v&15;
    for(int w=0;w<8;++w){ const int bh=grp*8+w;
      for(int i=0;i<2;++i){ const int qb=(i==0)?31-k:k; unit<THRL>(bh>>4,bh&15,qb,P,lds); } } }
#else
  for(int v=vcu;v<256;v+=grid){ const int bh=v>>1,p=v&1;
    for(int i=0;i<16;++i){ const int s=2*(i>>1)+p; const int qb=(i&1)?31-s:s; unit<THRL>(bh>>4,bh&15,qb,P,lds); } }
#endif
}
#undef SBAR
#undef WAIT_BAR
}
constexpr int NWAVES = 8;
#ifndef MK_PER_PHASE
#define MK_PER_PHASE 0
#endif

constexpr int BATCH = 8, SEQ = 4096, DMODEL = 2048, MROWS = BATCH * SEQ, DFF = 8192, NHEADS = 16, HD = 128;
constexpr int GDN_PROJ = 8224, GDN_MAIN = 8192, CONVC = 6144, NCG = MROWS / 64;
constexpr float ALPHA_RES = 1.6817928305074292f;
constexpr float LN_EPS = 1e-5f, GDN_EPS = 1e-6f, SUBLN_EPS = 1e-5f;
constexpr int N_PHASES = 39;

constexpr size_t MiB = 1u << 20;
constexpr size_t WS_CTL = 0, CTL_ZERO_BYTES = 1 * MiB;
constexpr size_t WS_ONES = 1 * MiB, WS_ZEROS = WS_ONES + 8192, WS_MU = WS_ONES + 65536, WS_RSTD = WS_MU + 131072;
constexpr size_t WS_BETA = 2 * MiB, WS_G = 4 * MiB;
constexpr size_t WS_HALO = 9 * MiB;
constexpr size_t WS_WA = 27 * MiB, WS_WB = 60 * MiB;
constexpr size_t WS_ATTN = 27 * MiB;
constexpr size_t WS_XB = 92 * MiB;
constexpr size_t WS_Y = 220 * MiB;
constexpr size_t WS_R1 = 476 * MiB;
constexpr size_t WS_END = 988 * MiB;
constexpr size_t QTR = 128 * MiB;
constexpr int CW_TMO = 0;
constexpr int CW_BAR = 4096;

constexpr int LDS_BYTES_C = 151552;
constexpr int RING_OFF = 0, RING_BYTES = 131072;
constexpr int LDSCTL_OFF = LDS_BYTES_C - 512, MISC_OFF = LDSCTL_OFF + 320;
constexpr int LDS_BYTES = LDS_BYTES_C;
static_assert(MISC_OFF + 128 <= LDS_BYTES, "LDS map");

#define GAS __attribute__((address_space(1)))
#define LAS __attribute__((address_space(3)))
typedef unsigned short bf16;
typedef unsigned v4u __attribute__((ext_vector_type(4)));
typedef unsigned v2u __attribute__((ext_vector_type(2)));
typedef float f32x4 __attribute__((ext_vector_type(4)));
typedef float f32x16 __attribute__((ext_vector_type(16)));
typedef short bf16x8 __attribute__((ext_vector_type(8)));
typedef GAS unsigned gu32;
typedef GAS unsigned long long gu64;
#define RLX_AGENT __ATOMIC_RELAXED, __HIP_MEMORY_SCOPE_AGENT
#define LDS_WAIT() asm volatile("s_waitcnt lgkmcnt(0)" ::: "memory")
#define VM_WAIT() asm volatile("s_waitcnt vmcnt(0)" ::: "memory")
#define WG_BAR() asm volatile("s_waitcnt lgkmcnt(0)\n\ts_barrier" ::: "memory")
typedef float f32x2_t_ __attribute__((ext_vector_type(2))); typedef __bf16 bf16x2_t_ __attribute__((ext_vector_type(2)));
__device__ __forceinline__ unsigned pk2(float lo, float hi) { f32x2_t_ v = {lo, hi}; bf16x2_t_ b = __builtin_convertvector(v, bf16x2_t_); return __builtin_bit_cast(unsigned, b); }
__device__ __forceinline__ unsigned f2bf(float f) { return pk2(f, 0.f) & 0xffffu; }
__device__ __forceinline__ float bflo(unsigned w) { return __builtin_bit_cast(float, w << 16); }
__device__ __forceinline__ float bfhi(unsigned w) { return __builtin_bit_cast(float, w & 0xffff0000u); }
__device__ __forceinline__ float bf2f(bf16 h) { return __builtin_bit_cast(float, (unsigned)h << 16); }
__device__ __forceinline__ float fast_exp(float x) { return __builtin_amdgcn_exp2f(x * 1.4426950408889634f); }
__device__ __forceinline__ float silu_f(float x) { return x * __builtin_amdgcn_rcpf(1.f + __expf(-x)); }

#define XB_TMO      128
#define XB_XCNT(j)  (256  + 64 * (j))
#define XB_XSUB(j)  (1280 + 64 * (j))
#define XB_XGEN(j)  (2304 + 64 * (j))
#define XB_TOP      3328
#define XB_TOPGEN   3392
#define XCD_BAR_WORDS 3456
#define XB_SPIN_CAP (1u << 18)

__device__ __forceinline__ unsigned xb_ld(unsigned* p)              { return __hip_atomic_load(p, __ATOMIC_RELAXED, __HIP_MEMORY_SCOPE_AGENT); }
__device__ __forceinline__ unsigned xb_add(unsigned* p, unsigned v) { return __hip_atomic_fetch_add(p, v, __ATOMIC_RELAXED, __HIP_MEMORY_SCOPE_AGENT); }
__device__ __forceinline__ unsigned xb_xcc_id() { return (unsigned)__builtin_amdgcn_s_getreg((3 << 11) | 20) & 0xFu; }
#define XB_SPIN(cond, bar) do { unsigned _sp = 0; while (cond) { __builtin_amdgcn_s_sleep(1); \
    if ((++_sp & 255u) == 0u) { if (xb_ld(&(bar)[XB_TMO])) break; if (_sp > XB_SPIN_CAP) { atomicAdd(&(bar)[XB_TMO], 1u); break; } } } } while (0)

struct XcdBarrier {
    unsigned* bar; unsigned x;
    volatile LAS unsigned* st;
};
__device__ __forceinline__ XcdBarrier xcd_barrier_post(unsigned* bar, volatile LAS unsigned* st) {
    XcdBarrier b; b.bar = bar; b.x = xb_xcc_id(); b.st = st;
    if (threadIdx.x == 0) (void)xb_add(&bar[XB_XCNT(b.x)], 1u);
    return b;
}
__device__ __forceinline__ void xcd_barrier_complete(unsigned* bar, unsigned x, unsigned& nloc, unsigned& nx) {
    const unsigned G = gridDim.x * gridDim.y * gridDim.z;
    unsigned sum, cnt, mine, sp = 0u;
    for (;;) {
        sum = 0u; cnt = 0u; mine = 0u;
#pragma unroll
        for (unsigned j = 0; j < 16; ++j) { const unsigned c = xb_ld(&bar[XB_XCNT(j)]); sum += c; cnt += (c > 0u) ? 1u : 0u; mine = (j == x) ? c : mine; }
        if (sum == G) break;
        __builtin_amdgcn_s_sleep(1);
        if ((++sp & 255u) == 0u) { if (xb_ld(&bar[XB_TMO])) break; if (sp > XB_SPIN_CAP) { atomicAdd(&bar[XB_TMO], 1u); break; } }
    }
    nloc = mine > 0u ? mine : 1u; nx = cnt > 0u ? cnt : 1u;
}
__device__ __forceinline__ void xcd_barrier(const XcdBarrier& b) {
    asm volatile("s_waitcnt vmcnt(0)" ::: "memory");
    __syncthreads();
    if (threadIdx.x == 0) {
        unsigned* bar = b.bar;
        __builtin_amdgcn_s_waitcnt(0);
        unsigned nloc = b.st[0], nx = b.st[1];
        if (nloc == 0u) { xcd_barrier_complete(bar, b.x, nloc, nx); b.st[0] = nloc; b.st[1] = nx; }
        const unsigned old = xb_add(&bar[XB_XSUB(b.x)], 1u);
        const unsigned gen = old / nloc;
        if (old + 1u == (gen + 1u) * nloc) {
            __builtin_amdgcn_fence(__ATOMIC_RELEASE, "agent");
            asm volatile("s_waitcnt vmcnt(0)" ::: "memory");
            const unsigned og = xb_add(&bar[XB_TOP], 1u);
            const unsigned tg = og / nx;
            if (og + 1u == (tg + 1u) * nx) xb_add(&bar[XB_TOPGEN], 1u);
            else XB_SPIN(xb_ld(&bar[XB_TOPGEN]) == tg, bar);
            __builtin_amdgcn_fence(__ATOMIC_ACQUIRE, "agent");
            xb_add(&bar[XB_XGEN(b.x)], 1u);
            asm volatile("s_waitcnt vmcnt(0)" ::: "memory");
        } else {
            XB_SPIN(xb_ld(&bar[XB_XGEN(b.x)]) == gen, bar);
            __builtin_amdgcn_fence(__ATOMIC_ACQUIRE, "agent");
            asm volatile("s_waitcnt vmcnt(0)" ::: "memory");
        }
    }
    __syncthreads();
}

__device__ __forceinline__ float wave_sum(float v) {
#pragma unroll
    for (int o = 1; o < 64; o <<= 1) v += __shfl_xor(v, o);
    return v;
}
__device__ __forceinline__ float sum16(float v) {
    v += __shfl_xor(v, 1); v += __shfl_xor(v, 2); v += __shfl_xor(v, 4); v += __shfl_xor(v, 8); return v;
}
__device__ __forceinline__ void transpose_item(const float* W, int K, int ldw, int n_begin, int nblk, bf16* WT, int row_off, LAS float* scr, int item, int lane) {
    const int kb = item / nblk, nb = item % nblk, k0 = 64 * kb, n0 = 32 * nb;
    float wv[32];
#pragma unroll
    for (int i = 0; i < 32; ++i) wv[i] = ((const GAS float*)W)[(size_t)(k0 + 2 * i + (lane >> 5)) * ldw + n_begin + n0 + (lane & 31)];
#pragma unroll
    for (int i = 0; i < 32; ++i) scr[(2 * i + (lane >> 5)) * 33 + (lane & 31)] = wv[i];
    LDS_WAIT(); asm volatile("" ::: "memory");
    const int c = lane & 7;
#pragma unroll
    for (int j = 0; j < 4; ++j) { const int n = (lane >> 3) + 8 * j; const LAS float* s = scr + (8 * c) * 33 + n;
        v4u o; o.x = pk2(s[0 * 33], s[1 * 33]); o.y = pk2(s[2 * 33], s[3 * 33]); o.z = pk2(s[4 * 33], s[5 * 33]); o.w = pk2(s[6 * 33], s[7 * 33]);
        *(GAS v4u*)(WT + (size_t)(row_off + n0 + n) * K + k0 + 8 * c) = o; }
    LDS_WAIT(); asm volatile("" ::: "memory");
}
__device__ __forceinline__ void convert_w(LAS unsigned char* lds, int gw, int NGW, int wave, int lane, const float* W, int K, int ldw, int n_begin, int ncols, bf16* WT, int row_off, int k0 = 0, int k1 = 0x7fffffff) {
    LAS float* scr = (LAS float*)(lds + RING_OFF + wave * 16384);
    const int nblk = ncols / 32, nitems = (K / 64) * nblk;
    int k = 0;
    for (int it = gw; it < nitems; it += NGW, ++k) if (k >= k0 && k < k1) transpose_item(W, K, ldw, n_begin, nblk, WT, row_off, scr, it, lane);
}
__device__ __forceinline__ void row_to_bf16(const float* xrow, bf16* orow, int lane) {
    const GAS f32x4* xr = (const GAS f32x4*)xrow + lane; GAS v2u* o8 = (GAS v2u*)orow + lane;
#pragma unroll
    for (int j = 0; j < 8; ++j) { const f32x4 v = xr[64 * j]; v2u w; w.x = pk2(v.x, v.y); w.y = pk2(v.z, v.w); o8[64 * j] = w; }
}
__device__ __forceinline__ void ln_pass_b(const bf16* xb_in, const bf16* hb, const float* g, const float* b, bf16* xb_out, float* outf, float alpha, int gw, int NGW, int lane) {
    const GAS f32x4* gr = (const GAS f32x4*)g + 2 * lane; const GAS f32x4* br = (const GAS f32x4*)b + 2 * lane;
    for (int m = gw; m < MROWS; m += 2 * NGW) {
        const int m1 = (m + NGW < MROWS) ? m + NGW : m;
        const GAS v4u* x0 = (const GAS v4u*)(xb_in + (size_t)m * DMODEL) + lane; const GAS v4u* x1 = (const GAS v4u*)(xb_in + (size_t)m1 * DMODEL) + lane;
        const GAS v4u* h0 = (const GAS v4u*)(hb + (size_t)m * DMODEL) + lane;   const GAS v4u* h1 = (const GAS v4u*)(hb + (size_t)m1 * DMODEL) + lane;
        v4u xa[4], xc[4], ha[4], hc[4];
#pragma unroll
        for (int j = 0; j < 4; ++j) { xa[j] = x0[64 * j]; xc[j] = x1[64 * j]; ha[j] = h0[64 * j]; hc[j] = h1[64 * j]; }
        float y0[32], y1[32]; float s0 = 0.f, s1 = 0.f;
#pragma unroll
        for (int j = 0; j < 4; ++j)
#pragma unroll
            for (int k = 0; k < 4; ++k) { y0[8 * j + 2 * k] = alpha * bflo(xa[j][k]) + bflo(ha[j][k]); y0[8 * j + 2 * k + 1] = alpha * bfhi(xa[j][k]) + bfhi(ha[j][k]);
                                          y1[8 * j + 2 * k] = alpha * bflo(xc[j][k]) + bflo(hc[j][k]); y1[8 * j + 2 * k + 1] = alpha * bfhi(xc[j][k]) + bfhi(hc[j][k]); }
#pragma unroll
        for (int k = 0; k < 32; ++k) { s0 += y0[k]; s1 += y1[k]; }
#pragma unroll
        for (int o = 1; o < 64; o <<= 1) { s0 += __shfl_xor(s0, o); s1 += __shfl_xor(s1, o); }
        const float mean0 = s0 * (1.f / DMODEL), mean1 = s1 * (1.f / DMODEL); float q0 = 0.f, q1 = 0.f;
#pragma unroll
        for (int k = 0; k < 32; ++k) { y0[k] -= mean0; y1[k] -= mean1; q0 += y0[k] * y0[k]; q1 += y1[k] * y1[k]; }
#pragma unroll
        for (int o = 1; o < 64; o <<= 1) { q0 += __shfl_xor(q0, o); q1 += __shfl_xor(q1, o); }
        const float rs0 = 1.f / sqrtf(q0 * (1.f / DMODEL) + LN_EPS), rs1 = 1.f / sqrtf(q1 * (1.f / DMODEL) + LN_EPS);
#pragma unroll
        for (int j = 0; j < 4; ++j) { const f32x4 ga = gr[128 * j], gb = gr[128 * j + 1], ba = br[128 * j], bb = br[128 * j + 1];
            float o0[8], o1[8];
#pragma unroll
            for (int k = 0; k < 8; ++k) { const float gg = k < 4 ? ga[k] : gb[k - 4], bv = k < 4 ? ba[k] : bb[k - 4]; o0[k] = y0[8 * j + k] * rs0 * gg + bv; o1[k] = y1[8 * j + k] * rs1 * gg + bv; }
            if (xb_out) { v4u w0, w1; w0.x = pk2(o0[0], o0[1]); w0.y = pk2(o0[2], o0[3]); w0.z = pk2(o0[4], o0[5]); w0.w = pk2(o0[6], o0[7]); w1.x = pk2(o1[0], o1[1]); w1.y = pk2(o1[2], o1[3]); w1.z = pk2(o1[4], o1[5]); w1.w = pk2(o1[6], o1[7]);
                ((GAS v4u*)(xb_out + (size_t)m * DMODEL) + lane)[64 * j] = w0; ((GAS v4u*)(xb_out + (size_t)m1 * DMODEL) + lane)[64 * j] = w1; }
            if (outf) { GAS f32x4* p0 = (GAS f32x4*)(outf + (size_t)m * DMODEL) + 2 * lane + 128 * j; GAS f32x4* p1 = (GAS f32x4*)(outf + (size_t)m1 * DMODEL) + 2 * lane + 128 * j;
                p0[0] = (f32x4){o0[0], o0[1], o0[2], o0[3]}; p0[1] = (f32x4){o0[4], o0[5], o0[6], o0[7]}; p1[0] = (f32x4){o1[0], o1[1], o1[2], o1[3]}; p1[1] = (f32x4){o1[4], o1[5], o1[6], o1[7]}; } }
    }
}
#define MFMA32(a, b, c) __builtin_amdgcn_mfma_f32_32x32x16_bf16((a), (b), (c), 0, 0, 0)

__device__ __forceinline__ void ba_proj(LAS unsigned char* lds, const bf16* xb, const bf16* wt  , const float* a_log, const float* dt_bias, float* beta, float* g, int gw, int NGW, int lane) {
    const int r32 = lane & 31, hi = lane >> 5, half = gw & 1, NP = NGW >> 1;
    LAS float* xch = (LAS float*)lds + ((gw >> 1) & 3) * 1024;
    for (int wu0 = 0; wu0 < MROWS / 32; wu0 += NP) {
        const int wu = wu0 + (gw >> 1); const bool valid = wu < MROWS / 32;
        f32x16 acc = {};
        if (valid) {
            const GAS bf16* ap = (const GAS bf16*)xb + (size_t)(wu * 32 + r32) * DMODEL + half * (DMODEL / 2) + 8 * hi; const GAS bf16* bp = (const GAS bf16*)wt + (size_t)(GDN_MAIN + r32) * DMODEL + half * (DMODEL / 2) + 8 * hi;
#pragma unroll 1
            for (int s0 = 0; s0 < DMODEL / 32; s0 += 8) {
                bf16x8 a[8], b[8];
#pragma unroll
                for (int s = 0; s < 8; ++s) { a[s] = *(const GAS bf16x8*)(ap + (s0 + s) * 16); b[s] = *(const GAS bf16x8*)(bp + (s0 + s) * 16); }
#pragma unroll
                for (int s = 0; s < 8; ++s) acc = MFMA32(a[s], b[s], acc);
            }
            if (half) {
#pragma unroll
                for (int r = 0; r < 16; ++r) xch[r * 64 + lane] = acc[r];
            }
        }
        __syncthreads();
        if (valid && !half) {
            const int j = r32 & 15; const float al = -__expf(((const GAS float*)a_log)[j]), db = ((const GAS float*)dt_bias)[j]; GAS float* betag = (GAS float*)beta; GAS float* gg_ = (GAS float*)g;
#pragma unroll
            for (int r = 0; r < 16; ++r) { const int t = wu * 32 + (r & 3) + 8 * (r >> 2) + 4 * hi; const float v = acc[r] + xch[r * 64 + lane];
                if (r32 < 16) betag[(size_t)t * 16 + j] = __builtin_amdgcn_rcpf(1.f + __expf(-v));
                else { const float z = v + db; const float sp = z > 20.f ? z : log1pf(__expf(z)); gg_[(size_t)t * 16 + j] = al * sp; } }
        }
        __syncthreads();
    }
}

#ifndef G2_SKIP
#define G2_SKIP 0
#endif
#ifndef PROBE_G2_NOSCAT
#define PROBE_G2_NOSCAT 0
#endif
typedef short bf16x4 __attribute__((ext_vector_type(4)));
#define MFMA16K16(a, b, c) __builtin_amdgcn_mfma_f32_16x16x16bf16_1k((a), (b), (c), 0, 0, 0)
constexpr int G2_TS = 136;
constexpr int G2_AS = 68, G2_ANS = 72, G2_US = 68;
constexpr int G2_A = 0, G2_GC = G2_A + 64 * G2_AS * 4, G2_BT = G2_GC + 256, G2_AN = G2_BT + 256, G2_TB = G2_AN + 64 * G2_ANS * 2, G2_Q = G2_TB + 2048, G2_K = G2_Q + 64 * G2_TS * 2, G2_V = G2_K + 64 * G2_TS * 2,
              G2_W = G2_V + 64 * G2_TS * 2, G2_END = G2_W + 64 * G2_TS * 2;
static_assert(G2_END <= RING_BYTES, "G2 LDS");
__device__ __forceinline__ bf16x4 pack4(f32x4 v) { v2u w; w.x = pk2(v[0], v[1]); w.y = pk2(v[2], v[3]); return __builtin_bit_cast(bf16x4, w); }
__device__ __forceinline__ void gdn_chunk_phase(LAS unsigned char* lds, bf16* p_, const bf16* halo_, const float* beta_, float* g_, bf16* wbuf_, bf16* attn_, const float* conv_w_, int vcu, int G, bf16* palt_ = nullptr) {
#define G2_ST(off) ((palt ? palt + ((size_t)(off) & 0x7ffffffull) : p + (size_t)(off)))
    int tid_ = threadIdx.x; asm volatile("" : "+v"(tid_));
    const int tid0 = tid_, lane0 = tid0 & 63, wid0 = __builtin_amdgcn_readfirstlane(tid0 >> 6);
    GAS bf16* const p = (GAS bf16*)p_; const GAS bf16* const halo = (const GAS bf16*)halo_; const GAS float* const beta = (const GAS float*)beta_; GAS float* const g = (GAS float*)g_;
    GAS bf16* const wbuf = (GAS bf16*)wbuf_; GAS bf16* const attn = (GAS bf16*)attn_; const GAS float* const conv_w = (const GAS float*)conv_w_; GAS bf16* const palt = (GAS bf16*)palt_;
    LAS bf16* Qs = (LAS bf16*)(lds + G2_Q); LAS bf16* Ks = (LAS bf16*)(lds + G2_K); LAS bf16* Vs = (LAS bf16*)(lds + G2_V); LAS bf16* Ws = (LAS bf16*)(lds + G2_W);
    LAS float* As = (LAS float*)(lds + G2_A); LAS float* gcs = (LAS float*)(lds + G2_GC); LAS float* bts = (LAS float*)(lds + G2_BT);
    LAS bf16* An = (LAS bf16*)(lds + G2_AN); LAS bf16* Tb = (LAS bf16*)(lds + G2_TB); LAS bf16* Us = (LAS bf16*)(lds + G2_A);
    asm volatile("" : "+v"(Qs), "+v"(Ks), "+v"(Vs), "+v"(Ws), "+v"(As), "+v"(gcs), "+v"(bts), "+v"(An), "+v"(Tb), "+v"(Us));
    v4u rawv[3][5]; float gpre = 0.f, bpre = 0.f;
#define G2_LOAD_RAW(uu, LN, WD) do { const int cg_ = (uu) >> 4, h_ = (uu) & 15, n_ = cg_ & 63; const size_t r0_ = (size_t)cg_ * 64; const int cgp_l = (LN) & 15, tA_l = 8 * (WD) + 2 * ((LN) >> 4); \
        _Pragma("unroll") for (int X = 0; X < 3; ++X) { const int col_ = X * 2048 + h_ * HD + 8 * cgp_l; \
            _Pragma("unroll") for (int rr = 0; rr < 5; ++rr) { const int rel = tA_l - 3 + rr; v4u v = {0u, 0u, 0u, 0u}; \
                if (rel >= 0) v = *(const GAS v4u*)(p + (r0_ + rel) * GDN_MAIN + col_); \
                else if (n_ > 0) v = *(const GAS v4u*)(halo + ((size_t)(cg_ - 1) * 3 + (rel + 3)) * CONVC + col_); \
                rawv[X][rr] = v; } } \
        if ((WD) == 0) { gpre = g[(r0_ + (LN)) * 16 + h_]; bpre = beta[(r0_ + (LN)) * 16 + h_]; } } while (0)
    if (vcu < NCG * NHEADS) G2_LOAD_RAW(vcu, lane0, wid0);
    for (int u = vcu; u < NCG * NHEADS; u += G) {
        const int cg = u >> 4, h = u & 15; const size_t row0 = (size_t)cg * 64;
        int tl_ = tid0; asm volatile("" : "+v"(tl_));
        const int tid = tl_, lane = tid & 63, wid = __builtin_amdgcn_readfirstlane(tid >> 6), r32 = lane & 31, hi = lane >> 5;
        {
            const int cgp = lane & 15, sub = lane >> 4, tA = 8 * wid + 2 * sub;
#pragma unroll
            for (int X = 0; X < 3; ++X) {
                const int col = X * 2048 + h * HD + 8 * cgp;
                float raw[5][8];
                asm volatile("" : "+v"(rawv[X][0]), "+v"(rawv[X][1]), "+v"(rawv[X][2]), "+v"(rawv[X][3]), "+v"(rawv[X][4]));
#pragma unroll
                for (int rr = 0; rr < 5; ++rr) { const v4u v = rawv[X][rr];
                    raw[rr][0] = bflo(v.x); raw[rr][1] = bfhi(v.x); raw[rr][2] = bflo(v.y); raw[rr][3] = bfhi(v.y); raw[rr][4] = bflo(v.z); raw[rr][5] = bfhi(v.z); raw[rr][6] = bflo(v.w); raw[rr][7] = bfhi(v.w); }
                float o0[8], o1[8];
#pragma unroll
                for (int c = 0; c < 8; ++c) { o0[c] = 0.f; o1[c] = 0.f; }
#pragma unroll
                for (int j = 0; j < 4; ++j) { const f32x4 wa = *(const GAS f32x4*)(conv_w + (size_t)j * CONVC + col), wb = *(const GAS f32x4*)(conv_w + (size_t)j * CONVC + col + 4);
#pragma unroll
                    for (int c = 0; c < 8; ++c) { const float w = c < 4 ? wa[c] : wb[c - 4]; o0[c] += w * raw[j][c]; o1[c] += w * raw[j + 1][c]; } }
                float s0 = 0.f, s1 = 0.f;
#pragma unroll
                for (int c = 0; c < 8; ++c) { o0[c] = silu_f(o0[c]); o1[c] = silu_f(o1[c]); s0 += o0[c] * o0[c]; s1 += o1[c] * o1[c]; }
                if (X < 2) { s0 = sum16(s0); s1 = sum16(s1); const float sc = X == 0 ? 0.08838834764831845f : 1.f; const float f0 = sc * __builtin_amdgcn_rsqf(s0 + GDN_EPS), f1 = sc * __builtin_amdgcn_rsqf(s1 + GDN_EPS);
#pragma unroll
                    for (int c = 0; c < 8; ++c) { o0[c] *= f0; o1[c] *= f1; } }
                LAS bf16* T = X == 0 ? Qs : (X == 1 ? Ks : Vs);
                v4u w0, w1; w0.x = pk2(o0[0], o0[1]); w0.y = pk2(o0[2], o0[3]); w0.z = pk2(o0[4], o0[5]); w0.w = pk2(o0[6], o0[7]);
                w1.x = pk2(o1[0], o1[1]); w1.y = pk2(o1[2], o1[3]); w1.z = pk2(o1[4], o1[5]); w1.w = pk2(o1[6], o1[7]);
                *(LAS v4u*)(T + tA * G2_TS + 8 * cgp) = w0; *(LAS v4u*)(T + (tA + 1) * G2_TS + 8 * cgp) = w1;
                asm volatile("" ::: "memory");
            }
            if (wid == 0) {
                float gv = gpre;
#pragma unroll
                for (int o = 1; o < 64; o <<= 1) { const float t = __shfl_up(gv, o); if (lane >= o) gv += t; }
                gcs[lane] = gv; bts[lane] = bpre; if (!palt) g[(row0 + lane) * 16 + h] = gv;
            }
        }
        __syncthreads();
        if (u + G < NCG * NHEADS) G2_LOAD_RAW(u + G, lane, wid);
        if (!((G2_SKIP & 4) && palt)) {
            const int rb = (wid >> 1) & 1, cb = wid & 1; const bool isA = wid < 4;
            f32x16 acc = {};
            if (!(rb == 0 && cb == 1)) {
                const LAS bf16* Ar = (isA ? Ks : Qs) + (32 * rb + r32) * G2_TS + 8 * hi; const LAS bf16* Br = Ks + (32 * cb + r32) * G2_TS + 8 * hi;
#pragma unroll
                for (int s = 0; s < 8; ++s) acc = MFMA32(*(const LAS bf16x8*)(Ar + 16 * s), *(const LAS bf16x8*)(Br + 16 * s), acc);
            }
            const int j = 32 * cb + r32; const float gj = gcs[j];
#pragma unroll
            for (int r = 0; r < 16; ++r) { const int i = 32 * rb + (r & 3) + 8 * (r >> 2) + 4 * hi; const float gi = gcs[i];
                if (isA) { const float d = (i > j) ? __expf(gi - gj) : 0.f; const float a = (i > j) ? bts[i] * acc[r] * d : 0.f; As[i * G2_AS + j] = a; An[i * G2_ANS + j] = (bf16)f2bf(-a); }
                else { const float d = (i >= j) ? __expf(gi - gj) : 0.f; Ws[i * G2_TS + j] = (bf16)f2bf((i >= j) ? acc[r] * d : 0.f); } }
        }
        __syncthreads();
        if (wid == 0 && !((G2_SKIP & 2) && palt)) {
            const int b = lane >> 4, c = lane & 15; float t[16];
            const LAS float* Ab = As + (16 * b) * G2_AS + 16 * b;
#pragma unroll
            for (int i = 0; i < 16; ++i) {
                float ti = (i == c) ? 1.f : 0.f;
#pragma unroll
                for (int j4 = 0; j4 < (i + 3) / 4; ++j4) { const f32x4 a = *(const LAS f32x4*)(Ab + i * G2_AS + 4 * j4);
#pragma unroll
                    for (int k = 0; k < 4; ++k) if (4 * j4 + k < i) ti -= a[k] * t[4 * j4 + k]; }
                t[i] = ti;
            }
#pragma unroll
            for (int i = 0; i < 16; ++i) Tb[b * 256 + i * 16 + c] = (bf16)f2bf(t[i]);
        } else if (wid < 5) {
            const int tt = tid - 64, cgp = tt & 15, r0 = tt >> 4;
            { GAS bf16* at = palt ? palt + (((size_t)u * 4096 + 0x4000000ull) & 0x7ffffffull) : attn + (size_t)u * 4096;
#pragma unroll
              for (int k = 0; k < 2; ++k) { const int pc = tt + 256 * k, i = pc >> 3, c8 = pc & 7; *(GAS v4u*)(at + i * 64 + 8 * c8) = *(const LAS v4u*)(Ws + i * G2_TS + 8 * c8); } }
#pragma unroll
            for (int r = 0; r < 4; ++r) { const int i = r0 + 16 * r; const float e = __expf(gcs[i]); const v4u v = *(const LAS v4u*)(Qs + i * G2_TS + 8 * cgp); v4u w;
                w.x = pk2(bflo(v.x) * e, bfhi(v.x) * e); w.y = pk2(bflo(v.y) * e, bfhi(v.y) * e); w.z = pk2(bflo(v.z) * e, bfhi(v.z) * e); w.w = pk2(bflo(v.w) * e, bfhi(v.w) * e);
                *(GAS v4u*)G2_ST((row0 + i) * GDN_MAIN + h * HD + 8 * cgp) = w; }
        } else {
            const float gl = gcs[63];
            for (int task = tid - 320; task < 256; task += 192) { const int dk = task & 127, th = task >> 7;
                GAS bf16* dst = G2_ST((row0 + (dk >> 1)) * GDN_MAIN + 2048 + h * HD + (dk & 1) * 64 + 32 * th);
#pragma unroll
                for (int q = 0; q < 4; ++q) { float v[8];
#pragma unroll
                    for (int k = 0; k < 8; ++k) { const int tk = 32 * th + 8 * q + k; v[k] = bf2f(Ks[tk * G2_TS + dk]) * __expf(gl - gcs[tk]); }
                    v4u w; w.x = pk2(v[0], v[1]); w.y = pk2(v[2], v[3]); w.z = pk2(v[4], v[5]); w.w = pk2(v[6], v[7]); if (!(PROBE_G2_NOSCAT && palt)) *(GAS v4u*)(dst + 8 * q) = w; else asm volatile("" :: "v"(w)); } }
        }
        __syncthreads();
        if (!((G2_SKIP & 1) && palt)) {
            const int nl = lane & 15, q = lane >> 4; const bool isK = wid >= 4;
            float rsc[16];
#pragma unroll
            for (int b = 0; b < 4; ++b)
#pragma unroll
                for (int r = 0; r < 4; ++r) { const int row = 16 * b + 4 * q + r; rsc[4 * b + r] = isK ? bts[row] * __expf(gcs[row]) : bts[row]; }
            bf16x4 Tq[4], Aq[6];
#pragma unroll
            for (int b = 0; b < 4; ++b) Tq[b] = *(const LAS bf16x4*)(Tb + b * 256 + nl * 16 + 4 * q);
            Aq[0] = *(const LAS bf16x4*)(An + (16 + nl) * G2_ANS + 4 * q);
            Aq[1] = *(const LAS bf16x4*)(An + (32 + nl) * G2_ANS + 4 * q);      Aq[2] = *(const LAS bf16x4*)(An + (32 + nl) * G2_ANS + 16 + 4 * q);
            Aq[3] = *(const LAS bf16x4*)(An + (48 + nl) * G2_ANS + 4 * q);      Aq[4] = *(const LAS bf16x4*)(An + (48 + nl) * G2_ANS + 16 + 4 * q);   Aq[5] = *(const LAS bf16x4*)(An + (48 + nl) * G2_ANS + 32 + 4 * q);
#pragma unroll
            for (int t = 0; t < 2; ++t) {
                const int cc = 32 * (wid & 3) + 16 * t + nl;
                const LAS bf16* src = (isK ? Ks : Vs) + cc;
                f32x4 R[4];
#pragma unroll
                for (int b = 0; b < 4; ++b)
#pragma unroll
                    for (int r = 0; r < 4; ++r) R[b][r] = rsc[4 * b + r] * bf2f(src[(16 * b + 4 * q + r) * G2_TS]);
                const f32x4 z4 = {0.f, 0.f, 0.f, 0.f};
                const f32x4 y0 = MFMA16K16(Tq[0], pack4(R[0]), z4); const bf16x4 y0b = pack4(y0);
                f32x4 c1 = MFMA16K16(Aq[0], y0b, R[1]);
                const f32x4 y1 = MFMA16K16(Tq[1], pack4(c1), z4); const bf16x4 y1b = pack4(y1);
                f32x4 c2 = MFMA16K16(Aq[1], y0b, R[2]); c2 = MFMA16K16(Aq[2], y1b, c2);
                const f32x4 y2 = MFMA16K16(Tq[2], pack4(c2), z4); const bf16x4 y2b = pack4(y2);
                f32x4 c3 = MFMA16K16(Aq[3], y0b, R[3]); c3 = MFMA16K16(Aq[4], y1b, c3); c3 = MFMA16K16(Aq[5], y2b, c3);
                const f32x4 y3 = MFMA16K16(Tq[3], pack4(c3), z4); const bf16x4 y3b = pack4(y3);
                if (!isK) {
                    LAS bf16* dst = Us + cc * G2_US + 4 * q;
                    *(LAS bf16x4*)(dst) = y0b; *(LAS bf16x4*)(dst + 16) = y1b; *(LAS bf16x4*)(dst + 32) = y2b; *(LAS bf16x4*)(dst + 48) = y3b;
                } else {
#pragma unroll
                    for (int r = 0; r < 4; ++r) { Ws[(4 * q + r) * G2_TS + cc] = (bf16)y0b[r]; Ws[(16 + 4 * q + r) * G2_TS + cc] = (bf16)y1b[r]; Ws[(32 + 4 * q + r) * G2_TS + cc] = (bf16)y2b[r]; Ws[(48 + 4 * q + r) * G2_TS + cc] = (bf16)y3b[r]; }
                }
            }
        }
        __syncthreads();
#pragma unroll
        for (int k = 0; k < 2; ++k) { const int pc = tid + 512 * k, dv = pc >> 3, c8 = pc & 7;
            const v2u lo = *(const LAS v2u*)(Us + dv * G2_US + 8 * c8), hi2 = *(const LAS v2u*)(Us + dv * G2_US + 8 * c8 + 4);
            *(GAS v4u*)G2_ST((row0 + (dv & 63)) * GDN_MAIN + 4096 + h * HD + (dv >> 6) * 64 + 8 * c8) = (v4u){lo.x, lo.y, hi2.x, hi2.y}; }
#pragma unroll
        for (int k = 0; k < 2; ++k) { const int ch = tid + 512 * k, i = ch >> 4, c8 = ch & 15; *(GAS v4u*)((palt ? palt + (((row0 + i) * DMODEL + h * HD + 8 * c8) & 0x7ffffffull) : wbuf + (row0 + i) * DMODEL + h * HD + 8 * c8)) = *(const LAS v4u*)(Ws + i * G2_TS + 8 * c8); }
    }
#undef G2_ST
#undef G2_LOAD_RAW
}

constexpr int H2_AD = 0, H2_GC = 4096, H2_BT = 4352, H2_AN = 4608, H2_TB = H2_AN + 64 * G2_ANS * 2, H2_Q = H2_TB + 2048, H2_K = H2_Q + 64 * G2_TS * 2, H2_V = H2_K + 64 * G2_TS * 2, H2_GSZ = H2_V + 64 * G2_TS * 2;
static_assert(2 * H2_GSZ <= LDSCTL_OFF && H2_GSZ % 16 == 0, "G2 (two groups) LDS");
__device__ __forceinline__ void grp_bar(LAS unsigned* cnt, unsigned& tgt, int lane) {
    asm volatile("s_waitcnt lgkmcnt(0)" ::: "memory");
    if (lane == 0) __hip_atomic_fetch_add(cnt, 1u, __ATOMIC_RELAXED, __HIP_MEMORY_SCOPE_WORKGROUP);
    tgt += 4u;
    while (*(volatile LAS unsigned*)cnt < tgt) __builtin_amdgcn_s_sleep(1);
    asm volatile("" ::: "memory");
}
__device__ __forceinline__ void gdn_chunk_phase2(LAS unsigned char* lds, bf16* p_, const bf16* halo_, const float* beta_, float* g_, bf16* wbuf_, bf16* attn_, const float* conv_w_, int vcu, int G, bf16* palt_ = nullptr) {
#define G2_ST(off) ((palt ? palt + ((size_t)(off) & 0x7ffffffull) : p + (size_t)(off)))
    int tid_ = threadIdx.x; asm volatile("" : "+v"(tid_));
    const int tid0 = tid_;
    GAS bf16* const p = (GAS bf16*)p_; const GAS bf16* const halo = (const GAS bf16*)halo_; const GAS float* const beta = (const GAS float*)beta_; GAS float* const g = (GAS float*)g_;
    GAS bf16* const wbuf = (GAS bf16*)wbuf_; GAS bf16* const attn = (GAS bf16*)attn_; const GAS float* const conv_w = (const GAS float*)conv_w_; GAS bf16* const palt = (GAS bf16*)palt_;
    const int grp = __builtin_amdgcn_readfirstlane(tid0 >> 8);
    LAS unsigned* cnt = (LAS unsigned*)(lds + LDSCTL_OFF + 128 + 64 * grp);
    __syncthreads(); if (tid0 == 0) { *(LAS unsigned*)(lds + LDSCTL_OFF + 128) = 0u; *(LAS unsigned*)(lds + LDSCTL_OFF + 192) = 0u; } __syncthreads();
    unsigned tgt = 0u;
    LAS unsigned char* gb = lds + grp * H2_GSZ;
    LAS bf16* Qs = (LAS bf16*)(gb + H2_Q); LAS bf16* Ks = (LAS bf16*)(gb + H2_K); LAS bf16* Vs = (LAS bf16*)(gb + H2_V);
    LAS float* Ad = (LAS float*)(gb + H2_AD); LAS float* gcs = (LAS float*)(gb + H2_GC); LAS float* bts = (LAS float*)(gb + H2_BT);
    LAS bf16* An = (LAS bf16*)(gb + H2_AN); LAS bf16* Tb = (LAS bf16*)(gb + H2_TB);
    asm volatile("" : "+v"(Qs), "+v"(Ks), "+v"(Vs), "+v"(Ad), "+v"(gcs), "+v"(bts), "+v"(An), "+v"(Tb));
    v4u rawv[3][7]; float gpre = 0.f, bpre = 0.f;
#define H2_LOAD_RAW(uu, LN, W4) do { const int cg_ = (uu) >> 4, h_ = (uu) & 15, n_ = cg_ & 63; const size_t r0_ = (size_t)cg_ * 64; const int cgp_l = (LN) & 15, tA_l = 16 * (W4) + 4 * ((LN) >> 4); \
        _Pragma("unroll") for (int X = 0; X < 3; ++X) { const int col_ = X * 2048 + h_ * HD + 8 * cgp_l; \
            _Pragma("unroll") for (int rr = 0; rr < 7; ++rr) { const int rel = tA_l - 3 + rr; v4u v = {0u, 0u, 0u, 0u}; \
                if (rel >= 0) v = *(const GAS v4u*)(p + (r0_ + rel) * GDN_MAIN + col_); \
                else if (n_ > 0) v = *(const GAS v4u*)(halo + ((size_t)(cg_ - 1) * 3 + (rel + 3)) * CONVC + col_); \
                rawv[X][rr] = v; } } \
        if ((W4) == 0) { gpre = g[(r0_ + (LN)) * 16 + h_]; bpre = beta[(r0_ + (LN)) * 16 + h_]; } } while (0)
    const int u0 = 2 * vcu + grp, ustep = 2 * G;
    if (u0 < NCG * NHEADS) H2_LOAD_RAW(u0, (tid0 & 63), __builtin_amdgcn_readfirstlane((tid0 >> 6) & 3));
    for (int u = u0; u < NCG * NHEADS; u += ustep) {
        const int cg = u >> 4, h = u & 15; const size_t row0 = (size_t)cg * 64;
        int tl_ = tid0; asm volatile("" : "+v"(tl_));
        const int tid = tl_, lane = tid & 63, w4 = __builtin_amdgcn_readfirstlane((tid >> 6) & 3), gt = tid & 255, r32 = lane & 31, hi = lane >> 5;
        {
            const int cgp = lane & 15, sub = lane >> 4, tA = 16 * w4 + 4 * sub;
#pragma unroll
            for (int X = 0; X < 3; ++X) {
                const int col = X * 2048 + h * HD + 8 * cgp;
                asm volatile("" : "+v"(rawv[X][0]), "+v"(rawv[X][1]), "+v"(rawv[X][2]), "+v"(rawv[X][3]), "+v"(rawv[X][4]), "+v"(rawv[X][5]), "+v"(rawv[X][6]));
                float wj[4][8];
#pragma unroll
                for (int j = 0; j < 4; ++j) { const f32x4 wa = *(const GAS f32x4*)(conv_w + (size_t)j * CONVC + col), wb = *(const GAS f32x4*)(conv_w + (size_t)j * CONVC + col + 4);
#pragma unroll
                    for (int c = 0; c < 4; ++c) { wj[j][c] = wa[c]; wj[j][4 + c] = wb[c]; } }
                float o[4][8];
#pragma unroll
                for (int t = 0; t < 4; ++t)
#pragma unroll
                    for (int c = 0; c < 8; ++c) o[t][c] = 0.f;
#pragma unroll
                for (int rr = 0; rr < 7; ++rr) { const v4u v = rawv[X][rr]; const float rw[8] = {bflo(v.x), bfhi(v.x), bflo(v.y), bfhi(v.y), bflo(v.z), bfhi(v.z), bflo(v.w), bfhi(v.w)};
#pragma unroll
                    for (int t = 0; t < 4; ++t) { const int j = rr - t; if (j >= 0 && j < 4) {
#pragma unroll
                            for (int c = 0; c < 8; ++c) o[t][c] += wj[j][c] * rw[c]; } } }
                LAS bf16* T = X == 0 ? Qs : (X == 1 ? Ks : Vs);
#pragma unroll
                for (int t = 0; t < 4; ++t) { float s = 0.f;
#pragma unroll
                    for (int c = 0; c < 8; ++c) { o[t][c] = silu_f(o[t][c]); s += o[t][c] * o[t][c]; }
                    if (X < 2) { s = sum16(s); const float f = (X == 0 ? 0.08838834764831845f : 1.f) * __builtin_amdgcn_rsqf(s + GDN_EPS);
#pragma unroll
                        for (int c = 0; c < 8; ++c) o[t][c] *= f; }
                    v4u w0; w0.x = pk2(o[t][0], o[t][1]); w0.y = pk2(o[t][2], o[t][3]); w0.z = pk2(o[t][4], o[t][5]); w0.w = pk2(o[t][6], o[t][7]);
                    *(LAS v4u*)(T + (tA + t) * G2_TS + 8 * cgp) = w0; }
                asm volatile("" ::: "memory");
            }
            if (w4 == 0) {
                float gv = gpre;
#pragma unroll
                for (int o_ = 1; o_ < 64; o_ <<= 1) { const float t = __shfl_up(gv, o_); if (lane >= o_) gv += t; }
                gcs[lane] = gv; bts[lane] = bpre; if (!palt) g[(row0 + lane) * 16 + h] = gv;
            }
        }
        grp_bar(cnt, tgt, lane);
        if (u + ustep < NCG * NHEADS) H2_LOAD_RAW(u + ustep, lane, w4);
        {
            const int rb = w4 >> 1, cb = w4 & 1; const int j = 32 * cb + r32; const float gj = gcs[j];
            GAS bf16* at = palt ? palt + (((size_t)u * 4096 + 0x4000000ull) & 0x7ffffffull) : attn + (size_t)u * 4096;
#pragma unroll
            for (int pass = 0; pass < 2; ++pass) {
                f32x16 acc = {};
                if (!(rb == 0 && cb == 1)) {
                    const LAS bf16* Ar = (pass == 0 ? Ks : Qs) + (32 * rb + r32) * G2_TS + 8 * hi; const LAS bf16* Br = Ks + (32 * cb + r32) * G2_TS + 8 * hi;
#pragma unroll
                    for (int s = 0; s < 8; ++s) acc = MFMA32(*(const LAS bf16x8*)(Ar + 16 * s), *(const LAS bf16x8*)(Br + 16 * s), acc);
                }
#pragma unroll
                for (int r = 0; r < 16; ++r) { const int i = 32 * rb + (r & 3) + 8 * (r >> 2) + 4 * hi; const float gi = gcs[i];
                    if (pass == 0) { const float d = (i > j) ? __expf(gi - gj) : 0.f; const float a = (i > j) ? bts[i] * acc[r] * d : 0.f; An[i * G2_ANS + j] = (bf16)f2bf(-a);
                        if ((i >> 4) == (j >> 4)) Ad[(i >> 4) * 256 + (i & 15) * 16 + (j & 15)] = a; }
                    else { const float d = (i >= j) ? __expf(gi - gj) : 0.f; at[i * 64 + j] = (bf16)f2bf((i >= j) ? acc[r] * d : 0.f); } }
            }
        }
        grp_bar(cnt, tgt, lane);
        if (w4 == 0) {
            const int b = lane >> 4, c = lane & 15; float t[16];
            const LAS float* Ab = Ad + b * 256;
#pragma unroll
            for (int i = 0; i < 16; ++i) {
                float ti = (i == c) ? 1.f : 0.f;
#pragma unroll
                for (int j4 = 0; j4 < (i + 3) / 4; ++j4) { const f32x4 a = *(const LAS f32x4*)(Ab + i * 16 + 4 * j4);
#pragma unroll
                    for (int k = 0; k < 4; ++k) if (4 * j4 + k < i) ti -= a[k] * t[4 * j4 + k]; }
                t[i] = ti;
            }
#pragma unroll
            for (int i = 0; i < 16; ++i) Tb[b * 256 + i * 16 + c] = (bf16)f2bf(t[i]);
        } else {
            const int tt = gt - 64;
            for (int pc = tt; pc < 1024; pc += 192) { const int i = pc >> 4, cgp = pc & 15; const float e = __expf(gcs[i]); const v4u v = *(const LAS v4u*)(Qs + i * G2_TS + 8 * cgp); v4u w;
                w.x = pk2(bflo(v.x) * e, bfhi(v.x) * e); w.y = pk2(bflo(v.y) * e, bfhi(v.y) * e); w.z = pk2(bflo(v.z) * e, bfhi(v.z) * e); w.w = pk2(bflo(v.w) * e, bfhi(v.w) * e);
                *(GAS v4u*)G2_ST((row0 + i) * GDN_MAIN + h * HD + 8 * cgp) = w; }
            const float gl = gcs[63];
            for (int task = tt; task < 256; task += 192) { const int dk = task & 127, th = task >> 7;
                GAS bf16* dst = G2_ST((row0 + (dk >> 1)) * GDN_MAIN + 2048 + h * HD + (dk & 1) * 64 + 32 * th);
#pragma unroll
                for (int q = 0; q < 4; ++q) { float v[8];
#pragma unroll
                    for (int k = 0; k < 8; ++k) { const int tk = 32 * th + 8 * q + k; v[k] = bf2f(Ks[tk * G2_TS + dk]) * __expf(gl - gcs[tk]); }
                    v4u w; w.x = pk2(v[0], v[1]); w.y = pk2(v[2], v[3]); w.z = pk2(v[4], v[5]); w.w = pk2(v[6], v[7]); *(GAS v4u*)(dst + 8 * q) = w; } }
        }
        grp_bar(cnt, tgt, lane);
        {
            const int nl = lane & 15, q = lane >> 4; const bool isK = w4 >= 2;
            float rsc[16];
#pragma unroll
            for (int b = 0; b < 4; ++b)
#pragma unroll
                for (int r = 0; r < 4; ++r) { const int row = 16 * b + 4 * q + r; rsc[4 * b + r] = isK ? bts[row] * __expf(gcs[row]) : bts[row]; }
            bf16x4 Tq[4], Aq[6];
#pragma unroll
            for (int b = 0; b < 4; ++b) Tq[b] = *(const LAS bf16x4*)(Tb + b * 256 + nl * 16 + 4 * q);
            Aq[0] = *(const LAS bf16x4*)(An + (16 + nl) * G2_ANS + 4 * q);
            Aq[1] = *(const LAS bf16x4*)(An + (32 + nl) * G2_ANS + 4 * q);      Aq[2] = *(const LAS bf16x4*)(An + (32 + nl) * G2_ANS + 16 + 4 * q);
            Aq[3] = *(const LAS bf16x4*)(An + (48 + nl) * G2_ANS + 4 * q);      Aq[4] = *(const LAS bf16x4*)(An + (48 + nl) * G2_ANS + 16 + 4 * q);   Aq[5] = *(const LAS bf16x4*)(An + (48 + nl) * G2_ANS + 32 + 4 * q);
#pragma unroll
            for (int t = 0; t < 4; ++t) {
                const int cc = 64 * (w4 & 1) + 16 * t + nl;
                const LAS bf16* src = (isK ? Ks : Vs) + cc;
                f32x4 R[4];
#pragma unroll
                for (int b = 0; b < 4; ++b)
#pragma unroll
                    for (int r = 0; r < 4; ++r) R[b][r] = rsc[4 * b + r] * bf2f(src[(16 * b + 4 * q + r) * G2_TS]);
                const f32x4 z4 = {0.f, 0.f, 0.f, 0.f};
                const f32x4 y0 = MFMA16K16(Tq[0], pack4(R[0]), z4); const bf16x4 y0b = pack4(y0);
                f32x4 c1 = MFMA16K16(Aq[0], y0b, R[1]);
                const f32x4 y1 = MFMA16K16(Tq[1], pack4(c1), z4); const bf16x4 y1b = pack4(y1);
                f32x4 c2 = MFMA16K16(Aq[1], y0b, R[2]); c2 = MFMA16K16(Aq[2], y1b, c2);
                const f32x4 y2 = MFMA16K16(Tq[2], pack4(c2), z4); const bf16x4 y2b = pack4(y2);
                f32x4 c3 = MFMA16K16(Aq[3], y0b, R[3]); c3 = MFMA16K16(Aq[4], y1b, c3); c3 = MFMA16K16(Aq[5], y2b, c3);
                const f32x4 y3 = MFMA16K16(Tq[3], pack4(c3), z4); const bf16x4 y3b = pack4(y3);
                if (!isK) {
                    GAS bf16* dst = G2_ST((row0 + (cc & 63)) * GDN_MAIN + 4096 + h * HD + (cc >> 6) * 64 + 4 * q);
                    *(GAS bf16x4*)(dst) = y0b; *(GAS bf16x4*)(dst + 16) = y1b; *(GAS bf16x4*)(dst + 32) = y2b; *(GAS bf16x4*)(dst + 48) = y3b;
                } else {
                    GAS bf16* dst = palt ? palt + (((row0 + 4 * q) * DMODEL + h * HD + cc) & 0x7ffffffull) : wbuf + (row0 + 4 * q) * DMODEL + h * HD + cc;
#pragma unroll
                    for (int r = 0; r < 4; ++r) { dst[(size_t)r * DMODEL] = (bf16)y0b[r]; dst[(size_t)(16 + r) * DMODEL] = (bf16)y1b[r]; dst[(size_t)(32 + r) * DMODEL] = (bf16)y2b[r]; dst[(size_t)(48 + r) * DMODEL] = (bf16)y3b[r]; }
                }
            }
        }
        grp_bar(cnt, tgt, lane);
    }
#undef H2_LOAD_RAW
#undef G2_ST
    __syncthreads();
}

constexpr int G3_STS = 136, G3_VTS = 72;
constexpr int G3_ST = 0, G3_VT = G3_ST + 64 * G3_STS * 2, G3_OT = G3_VT + 64 * G3_VTS * 2, G3_WT = G3_OT + 64 * G3_VTS * 2, G3_QT = G3_WT + 64 * G3_STS * 2, G3_KT = G3_QT + 64 * G3_STS * 2,
              G3_PT = G3_KT + 128 * G3_VTS * 2, G3_UT = G3_PT + 64 * G3_VTS * 2, G3_END = G3_UT + 64 * G3_VTS * 2;
static_assert(G3_END <= RING_BYTES, "G3 LDS");
__device__ __forceinline__ void gdn_scan_phase(LAS unsigned char* lds, bf16* p_, const bf16* wbuf_, const bf16* attn_, const float* g_, int vcu, int G, bf16* oalt_ = nullptr) {
    GAS bf16* const p = (GAS bf16*)p_; const GAS bf16* const wbuf = (const GAS bf16*)wbuf_; const GAS bf16* const attn = (const GAS bf16*)attn_; const GAS float* const g = (const GAS float*)g_; GAS bf16* const oalt = (GAS bf16*)oalt_;
    int tid_ = threadIdx.x; asm volatile("" : "+v"(tid_));
    const int tid = tid_, lane = tid & 63, wid = __builtin_amdgcn_readfirstlane(tid >> 6), r32 = lane & 31, hi = lane >> 5;
    const int role = wid >> 2, a = (wid >> 1) & 1, bb = wid & 1, r = wid >> 1;
    LAS bf16* ST = (LAS bf16*)(lds + G3_ST); LAS bf16* VT = (LAS bf16*)(lds + G3_VT); LAS bf16* OT = (LAS bf16*)(lds + G3_OT);
    LAS bf16* WT = (LAS bf16*)(lds + G3_WT); LAS bf16* QT = (LAS bf16*)(lds + G3_QT); LAS bf16* KT = (LAS bf16*)(lds + G3_KT); LAS bf16* PT = (LAS bf16*)(lds + G3_PT); LAS bf16* UT = (LAS bf16*)(lds + G3_UT);
    for (int unit = vcu; unit < BATCH * NHEADS * 2; unit += G) {
        const int bh = unit >> 1, e = unit & 1, b = bh >> 4, h = bh & 15;
        for (int i = tid; i < G3_VT / 4; i += NWAVES * 64) ((LAS unsigned*)lds)[i] = 0u;
        f32x16 Sacc = {};
        const int r16a = tid >> 4, c16 = tid & 15, r8 = tid >> 3, c8 = tid & 7;
        const GAS bf16* gW = wbuf + (size_t)r16a * DMODEL + h * HD + 8 * c16;
        const GAS bf16* gQ = p + (size_t)r16a * GDN_MAIN + h * HD + 8 * c16;
        const GAS bf16* gK = p + (size_t)r16a * GDN_MAIN + 2048 + h * HD + 8 * c16;
        const GAS bf16* gP = attn + (size_t)r8 * 64 + 8 * c8;
        const GAS bf16* gU = p + (size_t)r8 * GDN_MAIN + 4096 + h * HD + e * 64 + 8 * c8;
        LAS bf16* sW = WT + r16a * G3_STS + 8 * c16; LAS bf16* sQ = QT + r16a * G3_STS + 8 * c16;
        LAS bf16* sK = KT + (2 * r16a + (c16 >> 3)) * G3_VTS + 8 * (c16 & 7);
        LAS bf16* sP = PT + r8 * G3_VTS + 8 * c8; LAS bf16* sU = UT + r8 * G3_VTS + 8 * c8;
        GAS bf16* oRow = (oalt ? oalt : p + 4096) + h * HD + e * 64; const size_t oPitch = oalt ? DMODEL : GDN_MAIN;
        const LAS bf16* aRd = (role == 0 ? WT : QT) + (32 * a + r32) * G3_STS + 8 * hi;
        const LAS bf16* sRd = ST + (32 * bb + r32) * G3_STS + 8 * hi; const LAS bf16* vRd = VT + (32 * bb + r32) * G3_VTS + 8 * hi;
        const LAS bf16* uRd = UT + (32 * bb + r32) * G3_VTS + 32 * a + 4 * hi; const LAS bf16* pRd = PT + (32 * a + r32) * G3_VTS + 8 * hi; const LAS bf16* kRd = KT + (32 * r + r32) * G3_VTS + 8 * hi;
        LAS bf16* vWr = VT + (32 * bb + r32) * G3_VTS + 32 * a + 4 * hi; LAS bf16* sWr = ST + (32 * bb + r32) * G3_STS + 32 * r + 4 * hi;
        v4u gw0, gw1, gq0, gq1, gk0, gk1, gp0, gu0; float dd;
#define G3_LOAD(nn) do { const size_t row0_ = (size_t)b * SEQ + (size_t)(nn) * 64; \
            gw0 = *(const GAS v4u*)(gW + row0_ * DMODEL); gw1 = *(const GAS v4u*)(gW + (row0_ + 32) * DMODEL); \
            gq0 = *(const GAS v4u*)(gQ + row0_ * GDN_MAIN); gq1 = *(const GAS v4u*)(gQ + (row0_ + 32) * GDN_MAIN); \
            gk0 = *(const GAS v4u*)(gK + row0_ * GDN_MAIN); gk1 = *(const GAS v4u*)(gK + (row0_ + 32) * GDN_MAIN); \
            gp0 = *(const GAS v4u*)(gP + ((size_t)(b * 64 + (nn)) * 16 + h) * 4096); gu0 = *(const GAS v4u*)(gU + row0_ * GDN_MAIN); \
            dd = __expf(g[(row0_ + 63) * 16 + h]); } while (0)
        G3_LOAD(0);
        __syncthreads();
#pragma unroll 1
        for (int n = 0; n < 64; ++n) {
            const size_t row0_ = (size_t)b * SEQ + (size_t)n * 64; const int nn = (n + 1 < 64) ? n + 1 : n;
            *(LAS v4u*)(sW) = gw0; *(LAS v4u*)(sW + 32 * G3_STS) = gw1; *(LAS v4u*)(sQ) = gq0; *(LAS v4u*)(sQ + 32 * G3_STS) = gq1;
            *(LAS v4u*)(sK) = gk0; *(LAS v4u*)(sK + 64 * G3_VTS) = gk1; *(LAS v4u*)(sP) = gp0; *(LAS v4u*)(sU) = gu0;
            const float dcur = dd;
            WG_BAR();
            G3_LOAD(nn);
            f32x16 acc_ = {};
#pragma unroll
            for (int s = 0; s < 8; ++s) acc_ = MFMA32(*(const LAS bf16x8*)(aRd + 16 * s), *(const LAS bf16x8*)(sRd + 16 * s), acc_);
            if (role == 0) {
#pragma unroll
                for (int q = 0; q < 4; ++q) { const v2u uu = *(const LAS v2u*)(uRd + 8 * q); v2u w_;
                    w_.x = pk2(bflo(uu.x) - acc_[4 * q], bfhi(uu.x) - acc_[4 * q + 1]); w_.y = pk2(bflo(uu.y) - acc_[4 * q + 2], bfhi(uu.y) - acc_[4 * q + 3]);
                    *(LAS v2u*)(vWr + 8 * q) = w_; }
            }
            WG_BAR();
            bf16x8 Vf_[4];
#pragma unroll
            for (int s = 0; s < 4; ++s) Vf_[s] = *(const LAS bf16x8*)(vRd + 16 * s);
            if (role == 1) {
#pragma unroll
                for (int s = 0; s < 4; ++s) acc_ = MFMA32(*(const LAS bf16x8*)(pRd + 16 * s), Vf_[s], acc_);
#pragma unroll
                for (int rr = 0; rr < 16; ++rr) OT[(32 * a + (rr & 3) + 8 * (rr >> 2) + 4 * hi) * G3_VTS + 32 * bb + r32] = (bf16)f2bf(acc_[rr]);
            }
            Sacc = Sacc * dcur;
#pragma unroll
            for (int s = 0; s < 4; ++s) Sacc = MFMA32(*(const LAS bf16x8*)(kRd + 16 * s), Vf_[s], Sacc);
#pragma unroll
            for (int q = 0; q < 4; ++q) { v2u w_; w_.x = pk2(Sacc[4 * q], Sacc[4 * q + 1]); w_.y = pk2(Sacc[4 * q + 2], Sacc[4 * q + 3]); *(LAS v2u*)(sWr + 8 * q) = w_; }
            WG_BAR();
            *(GAS v4u*)(oRow + (row0_ + r8) * oPitch + 8 * c8) = *(const LAS v4u*)(OT + r8 * G3_VTS + 8 * c8);
        }
#undef G3_LOAD
        VM_WAIT(); __syncthreads();
    }
}

__device__ __forceinline__ void gdn_gate_phase(bf16* p, const float* norm_w, int gw, int NGW, int lane, bf16* oalt = nullptr) {
    for (int m = gw; m < MROWS; m += NGW) {
        GAS bf16* orow = (GAS bf16*)p + (size_t)m * GDN_MAIN + 4096; const GAS bf16* zrow = (const GAS bf16*)p + (size_t)m * GDN_MAIN + 6144;
#pragma unroll
        for (int it = 0; it < 4; ++it) { const int col = it * 512 + lane * 8;
            const v4u ov = *(const GAS v4u*)(orow + col), zv = *(const GAS v4u*)(zrow + col);
            float o[8] = {bflo(ov.x), bfhi(ov.x), bflo(ov.y), bfhi(ov.y), bflo(ov.z), bfhi(ov.z), bflo(ov.w), bfhi(ov.w)};
            float z[8] = {bflo(zv.x), bfhi(zv.x), bflo(zv.y), bfhi(zv.y), bflo(zv.z), bfhi(zv.z), bflo(zv.w), bfhi(zv.w)};
            float s = 0.f;
#pragma unroll
            for (int c = 0; c < 8; ++c) s += o[c] * o[c];
            s = sum16(s); const float rs = __builtin_amdgcn_rsqf(s * (1.f / HD) + GDN_EPS);
            const f32x4 wa = *(const GAS f32x4*)((const GAS float*)norm_w + (col & 127)), wb = *(const GAS f32x4*)((const GAS float*)norm_w + (col & 127) + 4);
#pragma unroll
            for (int c = 0; c < 8; ++c) o[c] = o[c] * rs * (c < 4 ? wa[c] : wb[c - 4]) * silu_f(z[c]);
            v4u w; w.x = pk2(o[0], o[1]); w.y = pk2(o[2], o[3]); w.z = pk2(o[4], o[5]); w.w = pk2(o[6], o[7]); *(GAS v4u*)((oalt ? (GAS bf16*)oalt + (size_t)m * DMODEL : orow) + col) = w; }
    }
}

#ifndef PG8_SP2
#define PG8_SP2 true
#endif
#ifndef PG8_ALIGN
#define PG8_ALIGN true
#endif
#ifndef EN_P0
#define EN_P0 1
#endif
#ifndef EN_G1
#define EN_G1 1
#endif
#ifndef EN_G2
#define EN_G2 1
#endif
#ifndef EN_G3
#define EN_G3 1
#endif
#ifndef EN_G4
#define EN_G4 1
#endif
#ifndef EN_G5
#define EN_G5 1
#endif
#ifndef EN_G6
#define EN_G6 1
#endif
#ifndef EN_G7
#define EN_G7 1
#endif
#ifndef EN_G8
#define EN_G8 1
#endif
#ifndef EN_G9
#define EN_G9 1
#endif
#ifndef EN_D1
#define EN_D1 1
#endif
#ifndef EN_D2
#define EN_D2 1
#endif
#ifndef EN_D3
#define EN_D3 1
#endif
#ifndef EN_D4
#define EN_D4 1
#endif
#ifndef EN_D5
#define EN_D5 1
#endif
#ifndef EN_D6U
#define EN_D6U 1
#endif
#ifndef EN_D6D
#define EN_D6D 1
#endif
#ifndef EN_D7
#define EN_D7 1
#endif
#ifndef REP_P0
#define REP_P0 1
#endif
#ifndef REP_G1
#define REP_G1 1
#endif
#ifndef REP_G2
#define REP_G2 1
#endif
#ifndef REP_G3
#define REP_G3 1
#endif
#ifndef REP_G4
#define REP_G4 1
#endif
#ifndef REP_G5
#define REP_G5 1
#endif
#ifndef REP_G6
#define REP_G6 1
#endif
#ifndef REP_G7
#define REP_G7 1
#endif
#ifndef REP_G8
#define REP_G8 1
#endif
#ifndef REP_G9
#define REP_G9 1
#endif
#ifndef REP_D1
#define REP_D1 1
#endif
#ifndef REP_D2
#define REP_D2 1
#endif
#ifndef REP_D3
#define REP_D3 1
#endif
#ifndef REP_D4
#define REP_D4 1
#endif
#ifndef REP_D5
#define REP_D5 1
#endif
#ifndef REP_D6U
#define REP_D6U 1
#endif
#ifndef REP_D6D
#define REP_D6D 1
#endif
#ifndef REP_D7
#define REP_D7 1
#endif
#ifndef G2_VER
#define G2_VER 2
#endif
#if G2_VER == 2
#define G2_FN gdn_chunk_phase2
#else
#define G2_FN gdn_chunk_phase
#endif
#ifndef LN_FUSED
#define LN_FUSED 0
#endif
#ifndef MLP_SPLIT
#define MLP_SPLIT 1
#endif
#define DSTRIDE (6 + 2 * MLP_SPLIT)
#define N_PHASES_K (19 + 2 * DSTRIDE)
#ifndef WGM_BIG
#define WGM_BIG 8
#endif
#ifndef WGM_SMALL
#define WGM_SMALL 4
#endif
#ifndef WGM_DOWN
#define WGM_DOWN 4
#endif
#ifndef PROBE_DBLBAR
#define PROBE_DBLBAR 0
#endif
#ifndef REP_BA
#define REP_BA 1
#endif
#ifndef PROBE_NOSTORE
#define PROBE_NOSTORE 0
#endif
#ifndef XSPLIT
#define XSPLIT 1
#endif
struct Args { const float* in[16]; float* out; unsigned char* ws; int ph_lo, ph_hi; };
__global__ void __launch_bounds__(NWAVES * 64, 2) yoco_fwd(Args args) {
    extern __shared__ __attribute__((aligned(16))) unsigned char lds_raw[];
    LAS unsigned char* lds = (LAS unsigned char*)lds_raw;
    volatile LAS unsigned* MISC = (volatile LAS unsigned*)(lds + MISC_OFF);
    const int tid = threadIdx.x, lane = tid & 63, wave = __builtin_amdgcn_readfirstlane(tid >> 6);
    const int G = gridDim.x, bx = blockIdx.x, vcu = (G % 8 == 0) ? (bx % 8) * (G / 8) + bx / 8 : bx;
    const int gw = vcu * NWAVES + wave, NGW = G * NWAVES, gtid = vcu * NWAVES * 64 + tid, NGT = G * NWAVES * 64;
    const float* ln_g = args.in[14]; const float* ln_b = args.in[15];
    for (int u = tid; u < (LDS_BYTES - LDSCTL_OFF) / 4; u += NWAVES * 64) ((LAS unsigned*)(lds + LDSCTL_OFF))[u] = 0u;
    __syncthreads();
    XcdBarrier bar; bar.bar = (unsigned*)(args.ws + WS_CTL) + CW_BAR; bar.x = 0; bar.st = nullptr;
    if (!MK_PER_PHASE) bar = xcd_barrier_post((unsigned*)(args.ws + WS_CTL) + CW_BAR, MISC + 8);
    const int lo = args.ph_lo, hi = args.ph_hi;
#define IN(k) (lo <= (k) && (k) < hi)
#define FRESH_LANE() int ln_ = lane; asm volatile("" : "+v"(ln_)); unsigned char* ws_ = args.ws; asm volatile("" : "+s"(ws_)); int gw_ = gw, vcu_ = vcu, bx_ = bx; asm volatile("" : "+s"(gw_), "+s"(vcu_), "+s"(bx_))
#define x_in         (args.in[0])
#define gdn_w_in     (args.in[1])
#define gdn_conv_w   (args.in[2])
#define gdn_a_log    (args.in[3])
#define gdn_dt_bias  (args.in[4])
#define gdn_norm_w   (args.in[5])
#define gdn_w_out    (args.in[6])
#define diff_w_q     (args.in[7])
#define diff_lambda  (args.in[8])
#define diff_subln_w (args.in[9])
#define diff_w_o     (args.in[10])
#define shared_w_kv  (args.in[11])
#define mlp_w_up     (args.in[12])
#define mlp_w_down   (args.in[13])
#define beta  ((float*)(ws_ + WS_BETA))
#define gdec  ((float*)(ws_ + WS_G))
#define halo  ((bf16*)(ws_ + WS_HALO))
#define WA    ((bf16*)(ws_ + WS_WA))
#define WB    ((bf16*)(ws_ + WS_WB))
#define attnb ((bf16*)(ws_ + WS_ATTN))
#define XB    ((bf16*)(ws_ + WS_XB))
#define LNSLOTS ((unsigned long long*)(ws_ + WS_Y))
#define LNCNT(sl) ((unsigned*)(ws_ + WS_CTL) + 16384 + (sl) * 8192)
#define LNTMO ((unsigned*)(ws_ + WS_CTL) + 8)
#define HB    ((bf16*)(ws_ + WS_Y))
#define WBUF  ((bf16*)(ws_ + WS_Y + QTR))
#define R1    ((bf16*)(ws_ + WS_R1))
#define Kb    (R1)
#define Vb    (R1 + QTR / 2)
#define Qb    (R1 + 2 * (QTR / 2))
#define HID   (Qb)
#define SEAM(k) do { if (!MK_PER_PHASE && (k) + 1 < hi) { xcd_barrier(bar); if (PROBE_DBLBAR) xcd_barrier(bar); } } while (0)

    for (int rep_ = 0; rep_ < REP_P0; ++rep_) if (EN_P0 && IN(0)) { FRESH_LANE();
        for (int m = gw_; m < MROWS; m += NGW) row_to_bf16(x_in + (size_t)m * DMODEL, XB + (size_t)m * DMODEL, ln_);
        convert_w(lds, gw_, NGW, wave, ln_, gdn_w_in, DMODEL, GDN_PROJ, 0, GDN_PROJ, WA, 0);
        SEAM(0);
    }
    for (int l = 0; l < 2; ++l) {
        const int pb = 1 + 9 * l;
        for (int rep_ = 0; rep_ < REP_G1; ++rep_) if (EN_G1 && IN(pb + 0)) { FRESH_LANE();
#pragma unroll 1
            for (int s2_ = 0; s2_ < 2; ++s2_) {
                int ln2_ = lane; asm volatile("" : "+v"(ln2_));
                const bool side = ((s2_ == 0) == (XSPLIT && (bx_ & 1) != 0));
                if (side) { for (int rb_ = 0; rb_ < REP_BA; ++rb_) ba_proj(lds + RING_OFF, XB, WA, gdn_a_log + l * 16, gdn_dt_bias + l * 16, beta, gdec, gw_, NGW, ln2_); }
                else {
                    pg8::Gemm g{XB, WA, MROWS, GDN_MAIN, DMODEL, DMODEL}; pg8::StaticOrder S; S.init(MROWS, GDN_MAIN, G, bx_, WGM_BIG);
                    pg8::EpiStore<0> E{R1, GDN_MAIN, 0, 0, -1, 1.f, halo};
                    pg8::gemm_phase<pg8::EpiStore<0>, pg8::StaticOrder, PG8_ALIGN, PG8_SP2>(lds + RING_OFF, g, S, E); }
            }
            SEAM(pb + 0);
        }
        for (int rep_ = 0; rep_ < REP_G2; ++rep_) if (EN_G2 && IN(pb + 1)) { FRESH_LANE(); G2_FN(lds, R1, halo, beta, gdec, WBUF, attnb, gdn_conv_w + (size_t)l * 4 * CONVC, vcu_, G, (rep_ + 1 < REP_G2) ? (bf16*)args.out : nullptr); SEAM(pb + 1); }
        for (int rep_ = 0; rep_ < REP_G3; ++rep_) if (EN_G3 && IN(pb + 2)) { FRESH_LANE(); gdn_scan_phase(lds, R1, WBUF, attnb, gdec, vcu_, G, (rep_ + 1 < REP_G3) ? (bf16*)args.out : nullptr); SEAM(pb + 2); }
        for (int rep_ = 0; rep_ < REP_G4; ++rep_) if (EN_G4 && IN(pb + 3)) { FRESH_LANE();
            gdn_gate_phase(R1, gdn_norm_w + l * HD, gw_, NGW, ln_, (rep_ + 1 < REP_G4) ? (bf16*)args.out : nullptr);
            convert_w(lds, gw_, NGW, wave, ln_, gdn_w_out + (size_t)l * DMODEL * DMODEL, DMODEL, DMODEL, 0, DMODEL, WA, 0);
            convert_w(lds, gw_, NGW, wave, ln_, mlp_w_up + (size_t)l * DMODEL * DFF, DMODEL, DFF, 0, DFF, WB, 0);
            SEAM(pb + 3);
        }
        for (int rep_ = 0; rep_ < REP_G5; ++rep_) if (EN_G5 && IN(pb + 4)) { FRESH_LANE();
            pg8::Gemm g{R1 + 4096, WA, MROWS, DMODEL, DMODEL, GDN_MAIN}; pg8::StaticOrder S; S.init(MROWS, DMODEL, G, bx_, WGM_SMALL);
#if LN_FUSED
            pg8::EpiLn E{XB, XB, nullptr, ln_g + (size_t)(l * 2) * DMODEL, ln_b + (size_t)(l * 2) * DMODEL, LNSLOTS, LNCNT(2 * l), LNTMO, 0, lds + RING_BYTES};
            pg8::gemm_phase<pg8::EpiLn, pg8::StaticOrder, true, PG8_SP2>(lds + RING_OFF, g, S, E);
#else
            pg8::EpiStore<0> E{(rep_ + 1 < REP_G5) ? (bf16*)args.out : HB, DMODEL, 0, 0, -1, 1.f, nullptr};
            pg8::gemm_phase<pg8::EpiStore<0>, pg8::StaticOrder, PG8_ALIGN, PG8_SP2>(lds + RING_OFF, g, S, E);
#endif
            SEAM(pb + 4);
        }
        const float* g1 = ln_g + (size_t)(l * 2) * DMODEL; const float* b1 = ln_b + (size_t)(l * 2) * DMODEL;
        for (int rep_ = 0; rep_ < REP_G6; ++rep_) if (!LN_FUSED && EN_G6 && IN(pb + 5)) { FRESH_LANE();
            ln_pass_b(XB, HB, g1, b1, XB, nullptr, ALPHA_RES, gw_, NGW, ln_);
            SEAM(pb + 5);
        }
        for (int rep_ = 0; rep_ < REP_G7; ++rep_) if (EN_G7 && IN(pb + 6)) { FRESH_LANE();
            {
                const int kb_ = XSPLIT ? ((bx_ & 7) * 4) / 7 : 0;
                if (!LN_FUSED) { int ln2_ = lane; asm volatile("" : "+v"(ln2_)); convert_w(lds, gw_, NGW, wave, ln2_, mlp_w_down + (size_t)l * DFF * DMODEL, DFF, DMODEL, 0, DMODEL, WA, 0, 0, kb_); __syncthreads(); }
                pg8::Gemm g{XB, WB, MROWS, DFF, DMODEL, DMODEL}; pg8::StaticOrder S; S.init(MROWS, DFF, G, bx_, WGM_BIG);
                pg8::EpiStore<1> E{R1, DFF, 0, 0, -1, 1.f, nullptr};
                pg8::gemm_phase<pg8::EpiStore<1>, pg8::StaticOrder, PG8_ALIGN, PG8_SP2>(lds + RING_OFF, g, S, E);
                if (!LN_FUSED) { int ln2_ = lane; asm volatile("" : "+v"(ln2_)); convert_w(lds, gw_, NGW, wave, ln2_, mlp_w_down + (size_t)l * DFF * DMODEL, DFF, DMODEL, 0, DMODEL, WA, 0, kb_, 0x7fffffff); }
            }
#if LN_FUSED
            { int ln2_ = lane; asm volatile("" : "+v"(ln2_)); convert_w(lds, gw_, NGW, wave, ln2_, mlp_w_down + (size_t)l * DFF * DMODEL, DFF, DMODEL, 0, DMODEL, WA, 0); }
#endif
            SEAM(pb + 6);
        }
        for (int rep_ = 0; rep_ < REP_G8; ++rep_) if (EN_G8 && IN(pb + 7)) { FRESH_LANE();
            pg8::Gemm g{R1, WA, MROWS, DMODEL, DFF, DFF}; pg8::StaticOrder S; S.init(MROWS, DMODEL, G, bx_, WGM_DOWN);
#if LN_FUSED
            pg8::EpiLn E{XB, XB, nullptr, ln_g + (size_t)(l * 2 + 1) * DMODEL, ln_b + (size_t)(l * 2 + 1) * DMODEL, LNSLOTS, LNCNT(2 * l + 1), LNTMO, 0, lds + RING_BYTES};
            pg8::gemm_phase<pg8::EpiLn, pg8::StaticOrder, true, PG8_SP2>(lds + RING_OFF, g, S, E);
#else
            pg8::EpiStore<0> E{(rep_ + 1 < REP_G8) ? (bf16*)args.out : HB, DMODEL, 0, 0, -1, 1.f, nullptr};
            pg8::gemm_phase<pg8::EpiStore<0>, pg8::StaticOrder, PG8_ALIGN, PG8_SP2>(lds + RING_OFF, g, S, E);
#endif
            SEAM(pb + 7);
        }
        for (int rep_ = 0; rep_ < REP_G9; ++rep_) if (EN_G9 && IN(pb + 8)) { FRESH_LANE();
            const float* g2 = ln_g + (size_t)(l * 2 + 1) * DMODEL; const float* b2 = ln_b + (size_t)(l * 2 + 1) * DMODEL;
            if (!LN_FUSED) ln_pass_b(XB, HB, g2, b2, XB, nullptr, ALPHA_RES, gw_, NGW, ln_);
            if (l == 0) convert_w(lds, gw_, NGW, wave, ln_, gdn_w_in + (size_t)DMODEL * GDN_PROJ, DMODEL, GDN_PROJ, 0, GDN_PROJ, WA, 0);
            else { convert_w(lds, gw_, NGW, wave, ln_, shared_w_kv, DMODEL, 2 * DMODEL, 0, 2 * DMODEL, WA, 0);
                   convert_w(lds, gw_, NGW, wave, ln_, diff_w_q, DMODEL, DMODEL, 0, DMODEL, WA, 2 * DMODEL); }
            SEAM(pb + 8);
        }
    }
    for (int j = 0; j < 2; ++j) {
        const int pb = 19 + DSTRIDE * j, L = 2 + j;
        for (int rep_ = 0; rep_ < REP_D1; ++rep_) if (EN_D1 && IN(pb + 0)) { FRESH_LANE();
            const int N = (j == 0) ? 3 * DMODEL : DMODEL;
            pg8::Gemm g{XB, WA, MROWS, N, DMODEL, DMODEL}; pg8::StaticOrder S; S.init(MROWS, N, G, bx_, WGM_BIG);
            pg8::EpiStore<0> E{(j == 0) ? Kb : Qb, DMODEL, (j == 0) ? DMODEL : 0, QTR / 2, (j == 0) ? 2 : 0, dattn::C2, nullptr};
            pg8::gemm_phase<pg8::EpiStore<0>, pg8::StaticOrder, PG8_ALIGN, PG8_SP2>(lds + RING_OFF, g, S, E);
            SEAM(pb + 0);
        }
        for (int rep_ = 0; rep_ < REP_D2; ++rep_) if (EN_D2 && IN(pb + 1)) { FRESH_LANE();
            const float lambda_init = 0.8f - 0.6f * expf(-0.3f * (float)L);
            const float* lp = diff_lambda + (size_t)j * 256;
            const float e1 = wave_sum(lp[ln_] * lp[64 + ln_]), e2 = wave_sum(lp[128 + ln_] * lp[192 + ln_]);
            const dattn::Params AP{(const dattn::bf16*)Qb, (const dattn::bf16*)Kb, (const dattn::bf16*)Vb, (rep_ + 1 < REP_D2) ? (dattn::bf16*)args.out : (dattn::bf16*)Qb, diff_subln_w + j * HD, __expf(e1) - __expf(e2) + lambda_init, 1.f - lambda_init};
            dattn::phase<8>((char*)lds_raw + RING_OFF, AP, G, bx_);
            { int ln2_ = lane; asm volatile("" : "+v"(ln2_));
              convert_w(lds, gw_, NGW, wave, ln2_, diff_w_o + (size_t)j * DMODEL * DMODEL, DMODEL, DMODEL, 0, DMODEL, WB, 0);
              convert_w(lds, gw_, NGW, wave, ln2_, mlp_w_up + (size_t)L * DMODEL * DFF, DMODEL, DFF, 0, DFF, WA, 0); }
            SEAM(pb + 1);
        }
        for (int rep_ = 0; rep_ < REP_D4; ++rep_) if (EN_D4 && IN(pb + 3)) { FRESH_LANE();
            pg8::Gemm g{Qb, WB, MROWS, DMODEL, DMODEL, DMODEL}; pg8::StaticOrder S; S.init(MROWS, DMODEL, G, bx_, WGM_SMALL);
#if LN_FUSED
            pg8::EpiLn E{XB, XB, nullptr, ln_g + (size_t)(L * 2) * DMODEL, ln_b + (size_t)(L * 2) * DMODEL, LNSLOTS, LNCNT(2 * L), LNTMO, 0, lds + RING_BYTES};
            pg8::gemm_phase<pg8::EpiLn, pg8::StaticOrder, true, PG8_SP2>(lds + RING_OFF, g, S, E);
#else
            pg8::EpiStore<0> E{(rep_ + 1 < REP_D4) ? (bf16*)args.out : HB, DMODEL, 0, 0, -1, 1.f, nullptr};
            pg8::gemm_phase<pg8::EpiStore<0>, pg8::StaticOrder, PG8_ALIGN, PG8_SP2>(lds + RING_OFF, g, S, E);
#endif
            SEAM(pb + 3);
        }
        const float* g1 = ln_g + (size_t)(L * 2) * DMODEL; const float* b1 = ln_b + (size_t)(L * 2) * DMODEL;
        for (int rep_ = 0; rep_ < REP_D5; ++rep_) if (!LN_FUSED && EN_D5 && IN(pb + 4)) { FRESH_LANE();
            ln_pass_b(XB, HB, g1, b1, XB, nullptr, ALPHA_RES, gw_, NGW, ln_);
            SEAM(pb + 4);
        }
        for (int hf = 0; hf < MLP_SPLIT; ++hf) {
            const size_t roff = (size_t)hf * (MROWS / MLP_SPLIT);
            for (int rep_ = 0; rep_ < REP_D6U; ++rep_) if (EN_D6U && IN(pb + 5 + 2 * hf)) { FRESH_LANE();
                {
                    const int kb_ = XSPLIT ? ((bx_ & 7) * 4) / 7 : 0;
                    if (!LN_FUSED && hf == 0) { int ln2_ = lane; asm volatile("" : "+v"(ln2_)); convert_w(lds, gw_, NGW, wave, ln2_, mlp_w_down + (size_t)L * DFF * DMODEL, DFF, DMODEL, 0, DMODEL, WB, 0, 0, kb_); __syncthreads(); }
                    pg8::Gemm g{XB + roff * DMODEL, WA, MROWS / MLP_SPLIT, DFF, DMODEL, DMODEL}; pg8::StaticOrder S; S.init(MROWS / MLP_SPLIT, DFF, G, bx_, WGM_BIG);
                    pg8::EpiStore<1> E{(PROBE_NOSTORE && rep_ + 1 < REP_D6U) ? (bf16*)nullptr : HID, DFF, 0, 0, -1, 1.f, nullptr, (MLP_SPLIT == 1) ? (bf16*)args.out : (bf16*)nullptr, MROWS / 2};
                    pg8::gemm_phase<pg8::EpiStore<1>, pg8::StaticOrder, PG8_ALIGN, PG8_SP2>(lds + RING_OFF, g, S, E);
                    if (!LN_FUSED && hf == 0) { int ln2_ = lane; asm volatile("" : "+v"(ln2_)); convert_w(lds, gw_, NGW, wave, ln2_, mlp_w_down + (size_t)L * DFF * DMODEL, DFF, DMODEL, 0, DMODEL, WB, 0, kb_, 0x7fffffff); }
                }
#if LN_FUSED
                if (hf == 0) { int ln2_ = lane; asm volatile("" : "+v"(ln2_)); convert_w(lds, gw_, NGW, wave, ln2_, mlp_w_down + (size_t)L * DFF * DMODEL, DFF, DMODEL, 0, DMODEL, WB, 0); }
#endif
                SEAM(pb + 5 + 2 * hf);
            }
            for (int rep_ = 0; rep_ < REP_D6D; ++rep_) if (EN_D6D && IN(pb + 6 + 2 * hf)) { FRESH_LANE();
                pg8::Gemm g{HID, WB, MROWS / MLP_SPLIT, DMODEL, DFF, DFF, (MLP_SPLIT == 1) ? (const bf16*)args.out : (const bf16*)nullptr, MROWS / 2 / 256}; pg8::StaticOrder S; S.init(MROWS / MLP_SPLIT, DMODEL, G, bx_, WGM_DOWN);
#if LN_FUSED
                pg8::EpiLn E{XB + roff * DMODEL, XB + roff * DMODEL, (j == 1) ? args.out + roff * DMODEL : (float*)nullptr, ln_g + (size_t)(L * 2 + 1) * DMODEL, ln_b + (size_t)(L * 2 + 1) * DMODEL,
                             LNSLOTS, LNCNT(2 * L + 1), LNTMO, hf * (MROWS / MLP_SPLIT / 256), lds + RING_BYTES};
                pg8::gemm_phase<pg8::EpiLn, pg8::StaticOrder, true, PG8_SP2>(lds + RING_OFF, g, S, E);
                if (j == 0 && hf == MLP_SPLIT - 1) { int ln2_ = lane; asm volatile("" : "+v"(ln2_)); convert_w(lds, gw_, NGW, wave, ln2_, diff_w_q + (size_t)DMODEL * DMODEL, DMODEL, DMODEL, 0, DMODEL, WA, 0); }
#else
                pg8::EpiStore<0> E{((rep_ + 1 < REP_D6D) ? (bf16*)args.out : HB) + roff * DMODEL, DMODEL, 0, 0, -1, 1.f, nullptr};
                pg8::gemm_phase<pg8::EpiStore<0>, pg8::StaticOrder, PG8_ALIGN, PG8_SP2>(lds + RING_OFF, g, S, E);
#endif
                SEAM(pb + 6 + 2 * hf);
            }
        }
        for (int rep_ = 0; rep_ < REP_D7; ++rep_) if (!LN_FUSED && EN_D7 && IN(pb + 5 + 2 * MLP_SPLIT)) { FRESH_LANE();
            const float* g2 = ln_g + (size_t)(L * 2 + 1) * DMODEL; const float* b2 = ln_b + (size_t)(L * 2 + 1) * DMODEL;
            if (j == 0) { ln_pass_b(XB, HB, g2, b2, XB, nullptr, ALPHA_RES, gw_, NGW, ln_);
                          convert_w(lds, gw_, NGW, wave, ln_, diff_w_q + (size_t)DMODEL * DMODEL, DMODEL, DMODEL, 0, DMODEL, WA, 0); }
            else { ln_pass_b(XB, HB, g2, b2, nullptr, args.out, ALPHA_RES, gw_, NGW, ln_); }
            SEAM(pb + 5 + 2 * MLP_SPLIT);
        }
    }
#undef IN
#undef SEAM
}

extern "C" void kernel_launch(void* const* d_in, const int* in_sizes, int n_in, void* d_out, int out_size, void* d_ws, size_t ws_size, hipStream_t stream) {
    static int grid = 0;
    if (grid == 0) {
        if (n_in != 16 || in_sizes[0] != MROWS * DMODEL || out_size != MROWS * DMODEL || ws_size < WS_END) { fprintf(stderr, "kernel_launch: unexpected shapes / workspace (n_in %d, ws %zu < %zu); nothing launched\n", n_in, ws_size, (size_t)WS_END); grid = -1; return; }
        int dev = 0, cus = 0, per_cu = 0;
        if (hipGetDevice(&dev) != hipSuccess || hipDeviceGetAttribute(&cus, hipDeviceAttributeMultiprocessorCount, dev) != hipSuccess) { grid = -1; return; }
        if (hipFuncSetAttribute((const void*)yoco_fwd, hipFuncAttributeMaxDynamicSharedMemorySize, LDS_BYTES) != hipSuccess) { fprintf(stderr, "kernel_launch: hipFuncSetAttribute failed\n"); grid = -1; return; }
        if (hipOccupancyMaxActiveBlocksPerMultiprocessor(&per_cu, (const void*)yoco_fwd, NWAVES * 64, LDS_BYTES) != hipSuccess || per_cu < 1)
            fprintf(stderr, "kernel_launch: note: occupancy query reports %d workgroups per CU\n", per_cu);
        (void)hipGetLastError();
        grid = cus;
    }
    if (grid < 0) return;
    if (hipMemsetAsync((char*)d_ws + WS_CTL, 0, CTL_ZERO_BYTES, stream) != hipSuccess) return;
    Args a{};
    for (int i = 0; i < 16; ++i) a.in[i] = (const float*)d_in[i];
    a.out = (float*)d_out; a.ws = (unsigned char*)d_ws;
#if MK_PER_PHASE
    for (int k = 0; k < N_PHASES_K; ++k) { a.ph_lo = k; a.ph_hi = k + 1; hipLaunchKernelGGL(yoco_fwd, dim3(grid), dim3(NWAVES * 64), LDS_BYTES, stream, a); }
#else
    a.ph_lo = 0; a.ph_hi = N_PHASES_K;
    hipLaunchKernelGGL(yoco_fwd, dim3(grid), dim3(NWAVES * 64), LDS_BYTES, stream, a);
#endif
    const hipError_t le = hipPeekAtLastError();
    if (le != hipSuccess) fprintf(stderr, "kernel_launch: launch failed: %s\n", hipGetErrorName(le));
}
```
